# Optimizing an MI355X kernel written in HIP

```python
import math
import jax, jax.numpy as jnp
from jax import lax
import numpy as np

D_MODEL = 2048
BATCH = 1
SEQ = 16384
DEPTH = 2

MEM_LEN = 256
DIFF_HEADS = 8
DIFF_HEAD_DIM = 64
DIFF_V_DIM = 2 * DIFF_HEAD_DIM
DIFF_ROT_DIM = DIFF_HEAD_DIM // 4
DIFF_QK_W = DIFF_HEADS * 2 * DIFF_HEAD_DIM
DIFF_V_W = DIFF_HEADS * DIFF_V_DIM
MLA_HEADS = 8
MLA_Q_RANK = 512
MLA_KV_RANK = 256
MLA_NOPE = 128
MLA_ROPE = 64
MLA_V = 128
MLA_W = MLA_HEADS * MLA_V
SSM_CH = 1024
SSM_GROUP = 16
SSM_GROUPS = SSM_CH // SSM_GROUP
SSM_STATE = 64
DT_MIN = 0.001
DT_MAX = 0.1
N_BRANCH = 3
BRANCH_W = 1024
X_HEADS = 4
X_HEAD_DIM = 128
X_W = X_HEADS * X_HEAD_DIM
D_FF = 5632
N_EXPERTS = 8
TOP_K = 2
N_DENSE = (DEPTH + 1) // 2
N_MOE = DEPTH // 2
ROPE_THETA = 500000.0
Q_BLOCK = 128
LN_EPS = 1e-5
RMS_EPS = 1e-6
NEG_BIG = -1e30
ALPHA = (2 * DEPTH) ** 0.25
BETA = (8 * DEPTH) ** -0.25
IN_SIZES = (DIFF_QK_W, DIFF_QK_W, DIFF_V_W, MLA_Q_RANK, MLA_KV_RANK, MLA_ROPE, SSM_CH, N_BRANCH * D_MODEL)
D_IN = sum(IN_SIZES)

kernel_name = "hybrid_gated_diffattn_mla_s5_moe_postnorm"


def layer_norm(x, g, b):
    xf = x.astype(jnp.float32)
    mu = jnp.mean(xf, axis=-1, keepdims=True)
    var = jnp.mean(jnp.square(xf - mu), axis=-1, keepdims=True)
    y = (xf - mu) * lax.rsqrt(var + LN_EPS) * g.astype(jnp.float32) + b.astype(jnp.float32)
    return y.astype(x.dtype)


def rms_norm(x, g):
    xf = x.astype(jnp.float32)
    y = xf * lax.rsqrt(jnp.mean(jnp.square(xf), axis=-1, keepdims=True) + RMS_EPS) * g.astype(jnp.float32)
    return y.astype(x.dtype)


def rope(x, positions):
    d = x.shape[-1]
    inv_freq = jnp.power(jnp.float32(ROPE_THETA), -jnp.arange(0, d, 2, dtype=jnp.float32) / d)
    ang = positions.astype(jnp.float32)[:, :, None, None] * inv_freq
    cos, sin = jnp.cos(ang), jnp.sin(ang)
    x1, x2 = jnp.split(x.astype(jnp.float32), 2, axis=-1)
    return jnp.concatenate([x1 * cos - x2 * sin, x2 * cos + x1 * sin], axis=-1).astype(x.dtype)


def partial_rope(x, positions, rot_dim):
    return jnp.concatenate([rope(x[..., :rot_dim], positions), x[..., rot_dim:]], axis=-1)


def _merge_blocks(out):
    nb, b, q, h, d = out.shape
    return jnp.moveaxis(out, 0, 1).reshape(b, nb * q, h, d)


def diff_attention(q, k, v, lam):
    seq = q.shape[1]
    scale = q.shape[-1] ** -0.5
    k_idx = jnp.arange(seq)

    def block(i):
        start = i * Q_BLOCK
        qb = lax.dynamic_slice_in_dim(q, start, Q_BLOCK, axis=1)
        s = jnp.einsum('bqhmd,bkhmd->bhmqk', qb, k).astype(jnp.float32) * scale
        mask = (start + jnp.arange(Q_BLOCK))[:, None] >= k_idx[None, :]
        p = jax.nn.softmax(jnp.where(mask, s, NEG_BIG), axis=-1)
        w = p[:, :, 0] - lam * p[:, :, 1]
        return jnp.einsum('bhqk,bkhd->bqhd', w.astype(v.dtype), v)

    return _merge_blocks(lax.map(block, jnp.arange(seq // Q_BLOCK)))


def causal_attention(q, k, v):
    seq = q.shape[1]
    scale = q.shape[-1] ** -0.5
    k_idx = jnp.arange(seq)

    def block(i):
        start = i * Q_BLOCK
        qb = lax.dynamic_slice_in_dim(q, start, Q_BLOCK, axis=1)
        s = jnp.einsum('bqhd,bkhd->bhqk', qb, k).astype(jnp.float32) * scale
        mask = (start + jnp.arange(Q_BLOCK))[:, None] >= k_idx[None, :]
        p = jax.nn.softmax(jnp.where(mask, s, NEG_BIG), axis=-1)
        return jnp.einsum('bhqk,bkhd->bqhd', p.astype(v.dtype), v)

    return _merge_blocks(lax.map(block, jnp.arange(seq // Q_BLOCK)))


def s5_ssm(u, lam_re, lam_im, b_re, b_im, c_re, c_im, d_skip, log_dt):
    bsz, seq, _ = u.shape
    f32 = jnp.float32
    uf = u.astype(f32).reshape(bsz, seq, SSM_GROUPS, SSM_GROUP)
    lam = lax.complex(lam_re.astype(f32), lam_im.astype(f32))
    dt = jnp.exp(log_dt.astype(f32))[:, None]
    lam_bar = jnp.exp(lam * dt)
    b = lax.complex(b_re.astype(f32), b_im.astype(f32))
    b_bar = ((lam_bar - 1.0) / lam)[..., None] * b
    bu = jnp.einsum('gnp,bsgp->bsgn', b_bar, uf.astype(jnp.complex64))
    a = jnp.broadcast_to(lam_bar, bu.shape)

    def combine(left, right):
        a_l, b_l = left
        a_r, b_r = right
        return a_r * a_l, a_r * b_l + b_r

    _, states = lax.associative_scan(combine, (a, bu), axis=1)
    c = lax.complex(c_re.astype(f32), c_im.astype(f32))
    y = jnp.einsum('gpn,bsgn->bsgp', c, states).real.reshape(bsz, seq, SSM_CH)
    y = y + d_skip.astype(f32) * u.astype(f32)
    return y.astype(u.dtype)


def token_mixers(h, positions, layer, w_in, w_q_up, w_kv_up, q_norm_g, kv_norm_g, diff_lambda,
                 diff_subln_g, ssm_lam_re, ssm_lam_im, ssm_b_re, ssm_b_im, ssm_c_re, ssm_c_im,
                 ssm_d, ssm_log_dt, ssm_glu_w, w_branch, w_out):
    bsz, seq, _ = h.shape
    points = np.cumsum(IN_SIZES)[:-1].tolist()
    dq, dk, dv, mq, mkv, mkr, su, gate_logits = jnp.split(h @ w_in, points, axis=-1)

    lam_init = 0.8 - 0.6 * math.exp(-0.3 * layer)
    lf = diff_lambda.astype(jnp.float32)
    lam = jnp.exp(jnp.sum(lf[0] * lf[1])) - jnp.exp(jnp.sum(lf[2] * lf[3])) + lam_init
    q = partial_rope(dq.reshape(bsz, seq, DIFF_HEADS * 2, DIFF_HEAD_DIM), positions, DIFF_ROT_DIM)
    k = partial_rope(dk.reshape(bsz, seq, DIFF_HEADS * 2, DIFF_HEAD_DIM), positions, DIFF_ROT_DIM)
    q = q.reshape(bsz, seq, DIFF_HEADS, 2, DIFF_HEAD_DIM)
    k = k.reshape(bsz, seq, DIFF_HEADS, 2, DIFF_HEAD_DIM)
    v = dv.reshape(bsz, seq, DIFF_HEADS, DIFF_V_DIM)
    o = rms_norm(diff_attention(q, k, v, lam), diff_subln_g) * (1.0 - lam_init)
    o_diff = o.reshape(bsz, seq, DIFF_V_W)

    c_q = rms_norm(mq, q_norm_g)
    qm = (c_q @ w_q_up).reshape(bsz, seq, MLA_HEADS, MLA_NOPE + MLA_ROPE)
    q_nope, q_rot = jnp.split(qm, [MLA_NOPE], axis=-1)
    qm = jnp.concatenate([q_nope, rope(q_rot, positions)], axis=-1)
    c_kv = rms_norm(mkv, kv_norm_g)
    kvm = (c_kv @ w_kv_up).reshape(bsz, seq, MLA_HEADS, MLA_NOPE + MLA_V)
    k_nope, vm = jnp.split(kvm, [MLA_NOPE], axis=-1)
    k_rot = rope(mkr.reshape(bsz, seq, 1, MLA_ROPE), positions)
    km = jnp.concatenate([k_nope, jnp.broadcast_to(k_rot, (bsz, seq, MLA_HEADS, MLA_ROPE))], axis=-1)
    o_mla = causal_attention(qm, km, vm).reshape(bsz, seq, MLA_W)

    y = jax.nn.gelu(s5_ssm(su, ssm_lam_re, ssm_lam_im, ssm_b_re, ssm_b_im, ssm_c_re, ssm_c_im,
                           ssm_d, ssm_log_dt))
    y_lin, y_gate = jnp.split(y @ ssm_glu_w, 2, axis=-1)
    o_ssm = y_lin * jax.nn.sigmoid(y_gate)

    branches = jnp.stack([o_diff, o_mla, o_ssm], axis=2)
    proj = jnp.einsum('bsnc,ncd->bsnd', branches, w_branch)
    gates = jax.nn.sigmoid(gate_logits.reshape(bsz, seq, N_BRANCH, D_MODEL))
    return jnp.sum(gates * proj, axis=2) @ w_out


def memory_cross_attention(h, mem, w_xq, w_xkv, w_xo):
    bsz, seq, _ = h.shape
    q = (h @ w_xq).reshape(bsz, seq, X_HEADS, X_HEAD_DIM)
    k, v = jnp.split(mem @ w_xkv, 2, axis=-1)
    k = k.reshape(bsz, -1, X_HEADS, X_HEAD_DIM)
    v = v.reshape(bsz, -1, X_HEADS, X_HEAD_DIM)
    s = jnp.einsum('bqhd,bkhd->bhqk', q, k).astype(jnp.float32) * X_HEAD_DIM ** -0.5
    p = jax.nn.softmax(s, axis=-1)
    o = jnp.einsum('bhqk,bkhd->bqhd', p.astype(v.dtype), v).reshape(bsz, seq, X_W)
    return o @ w_xo


def swiglu(h, w_gate_up, w_down):
    g, u = jnp.split(h @ w_gate_up, 2, axis=-1)
    return (jax.nn.silu(g) * u) @ w_down


def moe_swiglu(h, w_router, w_gate_up, w_down):
    logits = (h @ w_router).astype(jnp.float32)
    top_vals, top_idx = lax.top_k(logits, TOP_K)
    top_w = jax.nn.softmax(top_vals, axis=-1)
    combine = jnp.sum(jax.nn.one_hot(top_idx, N_EXPERTS, dtype=jnp.float32) * top_w[..., None], axis=-2)
    combine = combine.astype(h.dtype)
    out = jnp.zeros_like(h)
    for e in range(N_EXPERTS):
        out = out + combine[..., e:e + 1] * swiglu(h, w_gate_up[e], w_down[e])
    return out


def setup_inputs(seed: int = 0) -> dict:
    key = jax.random.key(seed)
    ks = iter(jax.random.split(key, 48))
    f32 = jnp.float32

    def nrm(shape, scale):
        return jax.random.normal(next(ks), shape, f32) * scale

    def gain(shape):
        return 1.0 + nrm(shape, 0.02)

    L, G, N, P = DEPTH, SSM_GROUPS, SSM_STATE, SSM_GROUP
    x = nrm((BATCH, SEQ, D_MODEL), 1.0)
    mem = nrm((BATCH, MEM_LEN, D_MODEL), 1.0)
    positions = (jnp.arange(SEQ, dtype=jnp.int32)[None, :]
                 + jax.random.randint(next(ks), (BATCH, 1), 0, 4096, dtype=jnp.int32))
    log_dt = jax.random.uniform(next(ks), (L, G), f32, math.log(DT_MIN), math.log(DT_MAX))
    lam_im = jnp.pi * jnp.arange(N, dtype=f32)[None, None, :] + nrm((L, G, N), 0.01)
    return {
        "x": x,
        "mem": mem,
        "positions": positions,
        "w_in": nrm((L, D_MODEL, D_IN), D_MODEL ** -0.5),
        "w_q_up": nrm((L, MLA_Q_RANK, MLA_HEADS * (MLA_NOPE + MLA_ROPE)), MLA_Q_RANK ** -0.5),
        "w_kv_up": nrm((L, MLA_KV_RANK, MLA_HEADS * (MLA_NOPE + MLA_V)), MLA_KV_RANK ** -0.5),
        "q_norm_g": gain((L, MLA_Q_RANK)),
        "kv_norm_g": gain((L, MLA_KV_RANK)),
        "diff_lambda": nrm((L, 4, DIFF_HEAD_DIM), 0.1),
        "diff_subln_g": gain((L, DIFF_V_DIM)),
        "ssm_lam_re": -0.5 + nrm((L, G, N), 0.01),
        "ssm_lam_im": lam_im,
        "ssm_b_re": nrm((L, G, N, P), (2 * P) ** -0.5),
        "ssm_b_im": nrm((L, G, N, P), (2 * P) ** -0.5),
        "ssm_c_re": nrm((L, G, P, N), (2 * N) ** -0.5),
        "ssm_c_im": nrm((L, G, P, N), (2 * N) ** -0.5),
        "ssm_d": nrm((L, SSM_CH), 1.0),
        "ssm_log_dt": log_dt,
        "ssm_glu_w": nrm((L, SSM_CH, 2 * SSM_CH), SSM_CH ** -0.5),
        "w_branch": nrm((L, N_BRANCH, BRANCH_W, D_MODEL), BRANCH_W ** -0.5),
        "w_out": nrm((L, D_MODEL, D_MODEL), BETA * D_MODEL ** -0.5),
        "ln_mix_g": gain((L, D_MODEL)),
        "ln_mix_b": nrm((L, D_MODEL), 0.02),
        "w_xq": nrm((L, D_MODEL, X_W), D_MODEL ** -0.5),
        "w_xkv": nrm((L, D_MODEL, 2 * X_W), D_MODEL ** -0.5),
        "w_xo": nrm((L, X_W, D_MODEL), BETA * X_W ** -0.5),
        "ln_x_g": gain((L, D_MODEL)),
        "ln_x_b": nrm((L, D_MODEL), 0.02),
        "ffn_w_gate_up": nrm((N_DENSE, D_MODEL, 2 * D_FF), D_MODEL ** -0.5),
        "ffn_w_down": nrm((N_DENSE, D_FF, D_MODEL), BETA * D_FF ** -0.5),
        "moe_router": nrm((N_MOE, D_MODEL, N_EXPERTS), D_MODEL ** -0.5),
        "moe_w_gate_up": nrm((N_MOE, N_EXPERTS, D_MODEL, 2 * D_FF), D_MODEL ** -0.5),
        "moe_w_down": nrm((N_MOE, N_EXPERTS, D_FF, D_MODEL), BETA * D_FF ** -0.5),
        "ln_ffn_g": gain((L, D_MODEL)),
        "ln_ffn_b": nrm((L, D_MODEL), 0.02),
    }


def reference(x, mem, positions, w_in, w_q_up, w_kv_up, q_norm_g, kv_norm_g, diff_lambda,
              diff_subln_g, ssm_lam_re, ssm_lam_im, ssm_b_re, ssm_b_im, ssm_c_re, ssm_c_im, ssm_d,
              ssm_log_dt, ssm_glu_w, w_branch, w_out, ln_mix_g, ln_mix_b, w_xq, w_xkv, w_xo,
              ln_x_g, ln_x_b, ffn_w_gate_up, ffn_w_down, moe_router, moe_w_gate_up, moe_w_down,
              ln_ffn_g, ln_ffn_b):
    for l in range(DEPTH):
        mix = token_mixers(x, positions, l, w_in[l], w_q_up[l], w_kv_up[l], q_norm_g[l],
                           kv_norm_g[l], diff_lambda[l], diff_subln_g[l], ssm_lam_re[l],
                           ssm_lam_im[l], ssm_b_re[l], ssm_b_im[l], ssm_c_re[l], ssm_c_im[l],
                           ssm_d[l], ssm_log_dt[l], ssm_glu_w[l], w_branch[l], w_out[l])
        x = layer_norm(ALPHA * x + mix, ln_mix_g[l], ln_mix_b[l])
        xa = memory_cross_attention(x, mem, w_xq[l], w_xkv[l], w_xo[l])
        x = layer_norm(ALPHA * x + xa, ln_x_g[l], ln_x_b[l])
        if l % 2 == 0:
            f = swiglu(x, ffn_w_gate_up[l // 2], ffn_w_down[l // 2])
        else:
            f = moe_swiglu(x, moe_router[l // 2], moe_w_gate_up[l // 2], moe_w_down[l // 2])
        x = layer_norm(ALPHA * x + f, ln_ffn_g[l], ln_ffn_b[l])
    return x
```

```cpp
#include <hip/hip_runtime.h>
#include <cstdio>
#include <cstdint>
#include <cmath>

#ifndef MK_MULTI
#define MK_MULTI 0
#endif
#ifndef MK_DBG
#define MK_DBG 0
#endif

#define GAS __attribute__((address_space(1)))
#define LAS __attribute__((address_space(3)))
typedef unsigned short bf16_t;
typedef short bf16x8 __attribute__((ext_vector_type(8)));
typedef short s16x4 __attribute__((ext_vector_type(4)));
typedef float f32x2 __attribute__((ext_vector_type(2)));
typedef float f32x4 __attribute__((ext_vector_type(4)));
typedef float f32x16 __attribute__((ext_vector_type(16)));
typedef unsigned u32x2 __attribute__((ext_vector_type(2)));
typedef unsigned u32x4 __attribute__((ext_vector_type(4)));
typedef GAS unsigned gu32;
#define RLX_AGENT __ATOMIC_RELAXED, __HIP_MEMORY_SCOPE_AGENT
#define LDS_WAIT() asm volatile("s_waitcnt lgkmcnt(0)" ::: "memory")
#define VM_WAIT() asm volatile("s_waitcnt vmcnt(0)" ::: "memory")
#define SBAR() __builtin_amdgcn_sched_barrier(0)

constexpr int M = 16384, D = 2048, DEPTH = 2, MEM_LEN = 256;
constexpr int NIN = 11264, NIN_BF = 3072  , NIN_G8 = 8192  ;
constexpr int NIN_SRC = 11072;
constexpr int DFF = 5632, NEXP = 8;
constexpr int SSM_L = 32, SSM_NCH = M / SSM_L  , SSM_KX = 640  ;
constexpr float LN_EPS = 1e-5f, RMS_EPS = 1e-6f;
constexpr float ALPHA = 1.4142135623730951f;
constexpr float LOG2E = 1.4426950408889634f;
constexpr float C2_DIFF = 0.125f * LOG2E;
constexpr float C2_MLA = 0.07216878364870323f * LOG2E;
constexpr float C2_X = 0.08838834764831845f * LOG2E;
constexpr int MOE_MAXROWS = 34816;

typedef __bf16 bf16x2_t __attribute__((ext_vector_type(2)));
__device__ __forceinline__ unsigned cvt_pk_bf16(float lo, float hi) { const f32x2 v = {lo, hi}; const bf16x2_t b = __builtin_convertvector(v, bf16x2_t); return __builtin_bit_cast(unsigned, b); }
__device__ __forceinline__ float bf_lo(unsigned w) { return __uint_as_float(w << 16); }
__device__ __forceinline__ float bf_hi(unsigned w) { return __uint_as_float(w & 0xffff0000u); }
__device__ __forceinline__ u32x4 pack8(f32x4 a, f32x4 b) { u32x4 w; w.x = cvt_pk_bf16(a[0], a[1]); w.y = cvt_pk_bf16(a[2], a[3]); w.z = cvt_pk_bf16(b[0], b[1]); w.w = cvt_pk_bf16(b[2], b[3]); return w; }
__device__ __forceinline__ u32x2 pack8_fp8(f32x4 a, f32x4 b) { int w0 = 0, w1 = 0;
    w0 = __builtin_amdgcn_cvt_pk_fp8_f32(a[0], a[1], w0, false); w0 = __builtin_amdgcn_cvt_pk_fp8_f32(a[2], a[3], w0, true);
    w1 = __builtin_amdgcn_cvt_pk_fp8_f32(b[0], b[1], w1, false); w1 = __builtin_amdgcn_cvt_pk_fp8_f32(b[2], b[3], w1, true);
    u32x2 r; r.x = (unsigned)w0; r.y = (unsigned)w1; return r; }
__device__ __forceinline__ float fast_sigmoid(float x) { return __builtin_amdgcn_rcpf(1.f + __builtin_amdgcn_exp2f(-x * LOG2E)); }
constexpr int LDS_WTAB = 131072 + 8192 + 1024;
__device__ __forceinline__ int opaque_tid() {
    const unsigned hw = __builtin_amdgcn_s_getreg(0x2804);
    const int wave = __builtin_amdgcn_readfirstlane(((volatile LAS int*)LDS_WTAB)[hw]);
    int lane; asm volatile("v_mbcnt_lo_u32_b32 %0, -1, 0\n\tv_mbcnt_hi_u32_b32 %0, -1, %0" : "=v"(lane));
    return wave * 64 + lane;
}
__device__ __forceinline__ float shflx(float v, int off, int lane) { return __int_as_float(__builtin_amdgcn_ds_bpermute((lane ^ off) << 2, __float_as_int(v))); }
__device__ __forceinline__ float wave_sum(float v, int lane) {
#pragma unroll
    for (int o = 1; o < 64; o <<= 1) v += shflx(v, o, lane);
    return v;
}

namespace pg8 {
constexpr int BM = 256, BK = 64, HALF = 128, HTB = HALF * BK * 2, STAGE_BYTES = 8 * HTB, NXCD = 8, WGM = 8;
__host__ __device__ __forceinline__ int lds_byte(int r, int c) { const int st = (r >> 4) * 2 + (c >> 5), rr = r & 15, cc = c & 31, ob = rr * 64 + cc * 2; return st * 1024 + (ob ^ (((ob >> 9) & 1) << 5)); }
__host__ __device__ __forceinline__ void stage_rc(int b, int& R, int& C) { const int st = b / 1024, sb = b % 1024, swz = sb ^ (((sb >> 9) & 1) << 5); R = (st >> 1) * 16 + swz / 64; C = (st & 1) * 32 + (swz % 64) / 2; }
__host__ __device__ __forceinline__ int perm32(int rho) { const int n = rho >> 4, i = rho & 15; return 8 * (i >> 2) + 4 * n + (i & 3); }

__device__ __forceinline__ size_t uni64(size_t v) { const unsigned lo_ = __builtin_amdgcn_readfirstlane((unsigned)v), hi_ = __builtin_amdgcn_readfirstlane((unsigned)(v >> 32)); return ((size_t)hi_ << 32) | lo_; }
struct Unit { int pm, pn, z; size_t offA, offB; };
struct Gemm { const void* A; const void* Bt; int ldaB, ldbB, KB; int wscale; };
typedef int v8i __attribute__((ext_vector_type(8)));
typedef int v4i __attribute__((ext_vector_type(4)));

struct TileOrder {
    int nM, nN, nwg;
    __device__ __forceinline__ void init(int nM_, int nN_) { nM = nM_; nN = nN_; nwg = nM * nN; }
    __device__ __forceinline__ bool map(long L, int& pm, int& pn) const {
        if (L >= nwg) return false;
        int wgid = (int)L; { const int q = nwg / NXCD, r = nwg % NXCD, xcd = wgid % NXCD, off = wgid / NXCD; wgid = (xcd < r ? xcd * (q + 1) : r * (q + 1) + (xcd - r) * q) + off; }
        const int nig = WGM * nN, gid = wgid / nig, fm = gid * WGM, gsz = (nM - fm) < WGM ? (nM - fm) : WGM;
        pm = __builtin_amdgcn_readfirstlane(fm + ((wgid % nig) % gsz)); pn = __builtin_amdgcn_readfirstlane((wgid % nig) / gsz); return true;
    }
};

template <bool FP8, int WSC, class Epi, class Sched>
__device__ __forceinline__ void gemm_phase_t(LAS unsigned char* lds, const Gemm g, const Sched& S, const Epi& E) {
    const int tid = opaque_tid(), wid = __builtin_amdgcn_readfirstlane(tid >> 6), lane = tid & 63, wr = wid >> 2, wc = wid & 3, fr = lane & 15, fq = lane >> 4;
    const int nt = g.KB / (BK * 2);
    unsigned voffA[2], voffB[2];
#pragma unroll
    for (int i = 0; i < 2; ++i) { int R, C; stage_rc(tid * 16 + i * 8192, R, C); const int Rb = (R & ~31) + perm32(R & 31);
        voffA[i] = (unsigned)(R * g.ldaB + C * 2); voffB[i] = (unsigned)(Rb * g.ldbB + C * 2); }
    const size_t kstep = (size_t)(BK * 2);
    const size_t hstepA = (size_t)HALF * g.ldaB, hstepB = (size_t)HALF * g.ldbB;
    const unsigned ldsw = (unsigned)wid * 1024u;
    const unsigned lds_u = __builtin_amdgcn_readfirstlane((unsigned)(uintptr_t)lds + ldsw);
    const int aoff = lds_byte(wr * 64 + fr, fq * 8), boff = lds_byte(wc * 32 + fr, fq * 8);
#define PG8_SA(b, h) (((b) * 2 + (h)) * HTB)
#define PG8_SB(b, h) ((4 + (b) * 2 + (h)) * HTB)
#define PG8_STAGE(bufoff, gbase, voff) do { _Pragma("unroll") for (int _i = 0; _i < 2; ++_i) \
        { unsigned _keep; asm volatile("s_mov_b32 %0, m0\n\ts_mov_b32 m0, %1\n\ts_nop 0\n\tglobal_load_lds_dwordx4 %2, %3\n\ts_mov_b32 m0, %0" : "=&s"(_keep) : "s"(lds_u + (unsigned)((bufoff) + _i * 8192)), "v"((voff)[_i]), "s"(gbase) : "memory"); } } while (0)
#define PG8_LD32(p) __builtin_shufflevector(*(const LAS v4i*)(p), *(const LAS v4i*)((p) + 1024), 0, 1, 2, 3, 4, 5, 6, 7)
#define PG8_LDA(dst, b, h) do { _Pragma("unroll") for (int m = 0; m < 4; ++m) dst[m] = PG8_LD32(lds + PG8_SA(b, h) + aoff + m * 2048); } while (0)
#define PG8_LDB(dst, b, h) do { _Pragma("unroll") for (int n = 0; n < 2; ++n) dst[n] = PG8_LD32(lds + PG8_SB(b, h) + boff + n * 2048); } while (0)
#define PG8_H0(x) __builtin_bit_cast(bf16x8, __builtin_shufflevector((x), (x), 0, 1, 2, 3))
#define PG8_H1(x) __builtin_bit_cast(bf16x8, __builtin_shufflevector((x), (x), 4, 5, 6, 7))
#define PG8_MMA(ai, bj, At, Bt) do { __builtin_amdgcn_s_setprio(1); _Pragma("unroll") for (int m = 0; m < 4; ++m) _Pragma("unroll") for (int n = 0; n < 2; ++n) { \
        if constexpr (FP8) asm volatile("v_mfma_scale_f32_16x16x128_f8f6f4 %0, %1, %2, %0, %3, %3 op_sel_hi:[0,0,0]" : "+v"(acc[ai][bj][m][n]) : "v"(Bt[n]), "v"(At[m]), "v"(wsc_v));     \
        else { acc[ai][bj][m][n] = __builtin_amdgcn_mfma_f32_16x16x32_bf16(PG8_H0(Bt[n]), PG8_H0(At[m]), acc[ai][bj][m][n], 0, 0, 0); acc[ai][bj][m][n] = __builtin_amdgcn_mfma_f32_16x16x32_bf16(PG8_H1(Bt[n]), PG8_H1(At[m]), acc[ai][bj][m][n], 0, 0, 0); } } \
        __builtin_amdgcn_s_setprio(0); } while (0)
#define PG8_WAIT_V(n) asm volatile("s_waitcnt vmcnt(" #n ")" ::: "memory")
#define PG8_WAIT_L(n) asm volatile("s_waitcnt lgkmcnt(" #n ")" ::: "memory")
#define PG8_BAR __builtin_amdgcn_s_barrier()
#define PG8_SCHED __builtin_amdgcn_sched_barrier(0)
    Unit cur, nxt; int ui = 0;
    if (!S.next(0, cur)) return;
    f32x4 acc[2][2][4][2];
#pragma unroll
    for (int a = 0; a < 2; ++a)
#pragma unroll
        for (int b = 0; b < 2; ++b)
#pragma unroll
            for (int m = 0; m < 4; ++m)
#pragma unroll
                for (int n = 0; n < 2; ++n) acc[a][b][m][n] = (f32x4){0.f, 0.f, 0.f, 0.f};
    v8i At[4], B0[2], B1[2]; const int wsc_v = WSC; (void)wsc_v;
    const char* cA = (const char*)g.A + uni64(cur.offA); const char* cB = (const char*)g.Bt + uni64(cur.offB);
    PG8_STAGE(PG8_SB(0, 0), cB, voffB); PG8_STAGE(PG8_SB(0, 1), cB + hstepB, voffB); PG8_STAGE(PG8_SA(0, 0), cA, voffA); PG8_STAGE(PG8_SA(0, 1), cA + hstepA, voffA);
    if (wr == 1) PG8_BAR;
    PG8_WAIT_V(2); PG8_BAR;
    PG8_STAGE(PG8_SB(1, 0), cB + kstep, voffB); PG8_STAGE(PG8_SA(1, 0), cA + kstep, voffA); PG8_STAGE(PG8_SB(1, 1), cB + hstepB + kstep, voffB);
    PG8_WAIT_V(6); PG8_BAR;
    for (;;) {
        const bool has_next = S.next(ui + 1, nxt);
        const char* nA = has_next ? (const char*)g.A + uni64(nxt.offA) : cA; const char* nB = has_next ? (const char*)g.Bt + uni64(nxt.offB) : cB;
        for (int t = 0; t < nt; t += 2) {
            const bool last = (t == nt - 2);
            const char* a1 = cA + (size_t)(t + 1) * kstep;
            const char* a2 = last ? nA : cA + (size_t)(t + 2) * kstep; const char* b2 = last ? nB : cB + (size_t)(t + 2) * kstep;
            const char* a3 = a2 + kstep; const char* b3 = b2 + kstep;
            PG8_LDB(B0, 0, 0); PG8_LDB(B1, 0, 1); PG8_SCHED; PG8_LDA(At, 0, 0); PG8_STAGE(PG8_SA(1, 1), a1 + hstepA, voffA);
            PG8_WAIT_V(8); PG8_WAIT_L(0); PG8_BAR; PG8_MMA(0, 0, At, B0); PG8_MMA(0, 1, At, B1); PG8_BAR; PG8_SCHED;
            PG8_LDA(At, 0, 1); PG8_STAGE(PG8_SB(0, 0), b2, voffB); PG8_STAGE(PG8_SB(0, 1), b2 + hstepB, voffB); PG8_STAGE(PG8_SA(0, 0), a2, voffA);
            PG8_WAIT_V(8); PG8_WAIT_L(0); PG8_BAR; PG8_MMA(1, 0, At, B0); PG8_MMA(1, 1, At, B1); PG8_BAR; PG8_SCHED;
            PG8_LDB(B0, 1, 0); PG8_LDB(B1, 1, 1); PG8_SCHED; PG8_LDA(At, 1, 0); PG8_STAGE(PG8_SA(0, 1), a2 + hstepA, voffA);
            PG8_WAIT_V(8); PG8_WAIT_L(0); PG8_BAR; PG8_MMA(0, 0, At, B0); PG8_MMA(0, 1, At, B1); PG8_BAR; PG8_SCHED;
            PG8_LDA(At, 1, 1); PG8_STAGE(PG8_SB(1, 0), b3, voffB); PG8_STAGE(PG8_SB(1, 1), b3 + hstepB, voffB); PG8_STAGE(PG8_SA(1, 0), a3, voffA);
            PG8_WAIT_V(8); PG8_WAIT_L(0); PG8_BAR; PG8_MMA(1, 0, At, B0); PG8_MMA(1, 1, At, B1); PG8_BAR; PG8_SCHED;
        }
        if (wr == 0) PG8_BAR;
        if constexpr (FP8) asm volatile("s_nop 15\n\ts_nop 15" ::: "memory");
        E(acc, cur, wr, wc, fr, fq);
        if (!has_next) break;
#pragma unroll
        for (int a = 0; a < 2; ++a)
#pragma unroll
            for (int b = 0; b < 2; ++b)
#pragma unroll
                for (int m = 0; m < 4; ++m)
#pragma unroll
                    for (int n = 0; n < 2; ++n) acc[a][b][m][n] = (f32x4){0.f, 0.f, 0.f, 0.f};
        cur = nxt; cA = nA; cB = nB; ++ui;
        if (wr == 1) PG8_BAR;
    }
    PG8_WAIT_V(0);
    PG8_BAR;
#undef PG8_SA
#undef PG8_SB
#undef PG8_STAGE
#undef PG8_LDA
#undef PG8_LDB
#undef PG8_MMA
#undef PG8_H0
#undef PG8_H1
#undef PG8_LD32
#undef PG8_WAIT_V
#undef PG8_WAIT_L
#undef PG8_BAR
#undef PG8_SCHED
}
template <class Epi, class Sched> __device__ __forceinline__ void gemm_phase(LAS unsigned char* lds, const Gemm g, const Sched& S, const Epi& E) { gemm_phase_t<false, 0>(lds, g, S, E); }
}

struct SchedPlain {
    pg8::TileOrder T; int G, c; size_t tA, tB;
    __device__ __forceinline__ void init(int nM, int nN, int lda, int ldb, int G_, int c_) { T.init(nM, nN); G = G_; c = c_; tA = (size_t)256 * lda * 2; tB = (size_t)256 * ldb * 2; }
    __device__ __forceinline__ bool next(int i, pg8::Unit& u) const { if (!T.map((long)i * G + c, u.pm, u.pn)) return false; u.z = 0; u.offA = u.pm * tA; u.offB = u.pn * tB; return true; }
};
struct SchedBatch {
    int nM, nN, nZ, G, c; size_t tA, tB, zA, zB;
    __device__ __forceinline__ bool next(int i, pg8::Unit& u) const {
        const long L = (long)i * G + c; const int per = nM * nN; if (L >= (long)per * nZ) return false;
        const int z = __builtin_amdgcn_readfirstlane((int)(L / per)), r = __builtin_amdgcn_readfirstlane((int)(L % per)); u.z = z; u.pm = __builtin_amdgcn_readfirstlane(r / nN); u.pn = __builtin_amdgcn_readfirstlane(r % nN); u.offA = z * zA + u.pm * tA; u.offB = z * zB + u.pn * tB; return true; }
};
struct SchedBranch {
    pg8::TileOrder T; int G, c; size_t tA, tB, zA, zB;
    __device__ __forceinline__ bool next(int i, pg8::Unit& u) const { const int t = i / 3, z = i - 3 * t; if (!T.map((long)t * G + c, u.pm, u.pn)) return false; u.z = z; u.offA = z * zA + u.pm * tA; u.offB = z * zB + u.pn * tB; return true; }
};
struct SchedMoe {
    pg8::TileOrder T; int G, c; size_t tA, tB, zB; int off[7];
    __device__ __forceinline__ bool next(int i, pg8::Unit& u) const {
        if (!T.map((long)i * G + c, u.pm, u.pn)) return false; const int r0 = u.pm * 256; int e = 0;
#pragma unroll
        for (int k = 0; k < 7; ++k) e += (r0 >= off[k]) ? 1 : 0;
        e = __builtin_amdgcn_readfirstlane(e); u.z = e; u.offA = u.pm * tA; u.offB = e * zB + u.pn * tB; return true; }
};

#define EPI_ARGS const f32x4 (&acc)[2][2][4][2], const pg8::Unit& u, int wr, int wc, int fr, int fq
#define EPI_ROW(ai, m) (u.pm * 256 + (ai) * 128 + wr * 64 + (m) * 16 + fr)
#define EPI_CB(bj) ((bj) * 128 + wc * 32 + fq * 8)
#define FOR_AI_M _Pragma("unroll") for (int ai = 0; ai < 2; ++ai) _Pragma("unroll") for (int m = 0; m < 4; ++m)
#define FOR_BJ _Pragma("unroll") for (int bj = 0; bj < 2; ++bj)

__device__ __forceinline__ void rope4(f32x4& v0, f32x4& v1, const f32x4 t0, const f32x4 t1) {
    const float a0 = v0[0] * t0[0] - v0[1] * t0[1], b0 = v0[1] * t0[0] + v0[0] * t0[1];
    const float a1 = v0[2] * t0[2] - v0[3] * t0[3], b1 = v0[3] * t0[2] + v0[2] * t0[3];
    const float a2 = v1[0] * t1[0] - v1[1] * t1[1], b2 = v1[1] * t1[0] + v1[0] * t1[1];
    const float a3 = v1[2] * t1[2] - v1[3] * t1[3], b3 = v1[3] * t1[2] + v1[2] * t1[3];
    v0 = (f32x4){a0, b0, a1, b1}; v1 = (f32x4){a2, b2, a3, b3};
}

struct EpiInProj {
    bf16_t *QD, *KD, *VD, *MQ, *MKV, *KM, *SU, *GATES; float *ssq_q, *ssq_kv; const float* tabd; const float* tabm;
    int pn_add;
    __device__ __forceinline__ void operator()(EPI_ARGS) const {
        const int pn = u.pn + pn_add;
        if (pn < 8) {
            bf16_t* O = pn < 4 ? QD : KD; const float sc = pn < 4 ? C2_DIFF : 1.f; const int colt = (pn & 3) * 256;
            const bool rp = ((wc & 1) == 0) && fq < 2;
#pragma unroll
            for (int ai = 0; ai < 2; ++ai) { f32x4 tt[4][2];
#pragma unroll
                for (int m = 0; m < 4; ++m) { tt[m][0] = (f32x4){1.f, 0.f, 1.f, 0.f}; tt[m][1] = (f32x4){1.f, 0.f, 1.f, 0.f};
                    if (rp) { const f32x4* tp = (const f32x4*)(tabd + (size_t)EPI_ROW(ai, m) * 16 + fq * 8); tt[m][0] = tp[0]; tt[m][1] = tp[1]; } }
#pragma unroll
                for (int m = 0; m < 4; ++m) { const int row = EPI_ROW(ai, m);
                    FOR_BJ { f32x4 v0 = acc[ai][bj][m][0], v1 = acc[ai][bj][m][1]; rope4(v0, v1, tt[m][0], tt[m][1]); v0 = v0 * sc; v1 = v1 * sc;
                        *(u32x4*)(O + (size_t)row * 1024 + colt + EPI_CB(bj)) = pack8(v0, v1); } } }
        } else if (pn < 12) {
            const int colt = (pn - 8) * 256;
            FOR_AI_M { const int row = EPI_ROW(ai, m); FOR_BJ { *(u32x4*)(VD + (size_t)row * 1024 + colt + EPI_CB(bj)) = pack8(acc[ai][bj][m][0], acc[ai][bj][m][1]); } }
        } else if (pn < 15) {
            bf16_t* O = pn < 14 ? MQ : MKV; const int ld = pn < 14 ? 512 : 256, colt = pn < 14 ? (pn - 12) * 256 : 0; float* ssq = pn < 14 ? ssq_q + (pn - 12) * 4 + wc : ssq_kv + wc; const int ns = pn < 14 ? 8 : 4;
            FOR_AI_M { const int row = EPI_ROW(ai, m); float s = 0.f;
                FOR_BJ { const f32x4 v0 = acc[ai][bj][m][0], v1 = acc[ai][bj][m][1]; s += (v0[0] * v0[0] + v0[1] * v0[1]) + (v0[2] * v0[2] + v0[3] * v0[3]) + (v1[0] * v1[0] + v1[1] * v1[1]) + (v1[2] * v1[2] + v1[3] * v1[3]);
                    *(u32x4*)(O + (size_t)row * ld + colt + EPI_CB(bj)) = pack8(v0, v1); }
                s += shflx(s, 16, fq * 16 + fr); s += shflx(s, 32, fq * 16 + fr);
                if (fq == 0) ssq[(size_t)row * ns] = s; }
        } else if (pn == 15) {
            if (wc < 2) {
                FOR_AI_M { const int row = EPI_ROW(ai, m); const f32x4* tp = (const f32x4*)(tabm + (size_t)row * 64 + (wc * 16 + fq * 4) * 2);
                    f32x4 v0 = acc[ai][0][m][0], v1 = acc[ai][0][m][1]; rope4(v0, v1, tp[0], tp[1]); const u32x4 w = pack8(v0, v1);
#pragma unroll
                    for (int h = 0; h < 8; ++h) *(u32x4*)(KM + (size_t)row * 1536 + h * 192 + 128 + wc * 32 + fq * 8) = w; }
            }
        } else if (pn < 20) {
            FOR_AI_M { const int row = EPI_ROW(ai, m); const int c = row >> 5, j = row & 31;
                FOR_BJ { const int ch = (pn - 16) * 256 + EPI_CB(bj), g = ch >> 4, q = ch & 15;
                    *(u32x4*)(SU + ((size_t)(g * SSM_NCH + c) * SSM_KX + j * 16 + q)) = pack8(acc[ai][bj][m][0], acc[ai][bj][m][1]); } }
        } else {
            const int colt = (pn - 20) * 256;
            FOR_AI_M { const int row = EPI_ROW(ai, m);
                FOR_BJ { f32x4 v0 = acc[ai][bj][m][0], v1 = acc[ai][bj][m][1];
#pragma unroll
                    for (int e = 0; e < 4; ++e) { v0[e] = fast_sigmoid(v0[e]); v1[e] = fast_sigmoid(v1[e]); }
                    *(u32x4*)(GATES + (size_t)row * 6144 + colt + EPI_CB(bj)) = pack8(v0, v1); } }
        }
    }
};
struct EpiQup {
    bf16_t* QM; const float* ssq; const float* tabm;
    __device__ __forceinline__ void operator()(EPI_ARGS) const {
#pragma unroll
        for (int ai = 0; ai < 2; ++ai) { f32x4 sq[4][2];
#pragma unroll
            for (int m = 0; m < 4; ++m) { const int row = EPI_ROW(ai, m); sq[m][0] = *(const f32x4*)(ssq + (size_t)row * 8); sq[m][1] = *(const f32x4*)(ssq + (size_t)row * 8 + 4); }
#pragma unroll
            for (int m = 0; m < 4; ++m) { const int row = EPI_ROW(ai, m); const f32x4 s0 = sq[m][0], s1 = sq[m][1];
                const float rq = __builtin_amdgcn_rsqf((((s0[0] + s0[1]) + (s0[2] + s0[3])) + ((s1[0] + s1[1]) + (s1[2] + s1[3]))) * (1.f / 512.f) + RMS_EPS) * C2_MLA;
                FOR_BJ { const int col = u.pn * 256 + EPI_CB(bj), h = col / 192, hc = col - h * 192; f32x4 v0 = acc[ai][bj][m][0], v1 = acc[ai][bj][m][1];
                    if (hc >= 128) { const f32x4* tp = (const f32x4*)(tabm + (size_t)row * 64 + (hc - 128)); rope4(v0, v1, tp[0], tp[1]); }
                    v0 = v0 * rq; v1 = v1 * rq; *(u32x4*)(QM + (size_t)row * 1536 + col) = pack8(v0, v1); } } }
    }
};
struct EpiKVup {
    bf16_t *KM, *VM; const float* ssq;
    __device__ __forceinline__ void operator()(EPI_ARGS) const {
#pragma unroll
        for (int ai = 0; ai < 2; ++ai) { float rk[4];
#pragma unroll
            for (int m = 0; m < 4; ++m) { const f32x4 s0 = *(const f32x4*)(ssq + (size_t)EPI_ROW(ai, m) * 4); rk[m] = ((s0[0] + s0[1]) + (s0[2] + s0[3])); }
#pragma unroll
            for (int m = 0; m < 4; ++m) { const int row = EPI_ROW(ai, m); const float r = __builtin_amdgcn_rsqf(rk[m] * (1.f / 256.f) + RMS_EPS); const int c = wc * 32 + fq * 8;
                *(u32x4*)(KM + (size_t)row * 1536 + u.pn * 192 + c) = pack8(acc[ai][0][m][0] * r, acc[ai][0][m][1] * r);
                *(u32x4*)(VM + (size_t)row * 1024 + u.pn * 128 + c) = pack8(acc[ai][1][m][0] * r, acc[ai][1][m][1] * r); } }
    }
};
struct EpiSloc {
    float* SLOC;
    __device__ __forceinline__ void operator()(EPI_ARGS) const {
        FOR_AI_M { const int c = EPI_ROW(ai, m); float* o = SLOC + ((size_t)(u.z * SSM_NCH + c) * 128 + wc * 32 + fq * 8);
            *(f32x4*)o = acc[ai][0][m][0]; *(f32x4*)(o + 4) = acc[ai][0][m][1]; }
    }
};
__device__ __forceinline__ float gelu_tanh(float x) { const float t = 1.5957691216057308f * (x + 0.044715f * x * x * x); return x * fast_sigmoid(t); }
struct EpiSsmY {
    bf16_t* YG; const bf16_t* SU; const float* dskip;
    __device__ __forceinline__ void operator()(EPI_ARGS) const {
        const int g = u.z; f32x4 d0[2], d1[2];
        FOR_BJ { const int col = u.pn * 256 + EPI_CB(bj), ch = g * 16 + (col & 15); d0[bj] = *(const f32x4*)(dskip + ch); d1[bj] = *(const f32x4*)(dskip + ch + 4); }
#pragma unroll
        for (int ai = 0; ai < 2; ++ai) { u32x4 uu[4][2];
#pragma unroll
            for (int m = 0; m < 4; ++m) { const int c = EPI_ROW(ai, m);
                FOR_BJ { const int col = u.pn * 256 + EPI_CB(bj), i = col >> 4, p0 = col & 15; uu[m][bj] = *(const u32x4*)(SU + ((size_t)(g * SSM_NCH + c) * SSM_KX + i * 16 + p0)); } }
#pragma unroll
            for (int m = 0; m < 4; ++m) { const int c = EPI_ROW(ai, m);
                FOR_BJ { const int col = u.pn * 256 + EPI_CB(bj), i = col >> 4, p0 = col & 15, t = c * SSM_L + i, ch = g * 16 + p0; const u32x4 w = uu[m][bj];
                    f32x4 v0 = acc[ai][bj][m][0], v1 = acc[ai][bj][m][1];
                    v0[0] += d0[bj][0] * bf_lo(w.x); v0[1] += d0[bj][1] * bf_hi(w.x); v0[2] += d0[bj][2] * bf_lo(w.y); v0[3] += d0[bj][3] * bf_hi(w.y);
                    v1[0] += d1[bj][0] * bf_lo(w.z); v1[1] += d1[bj][1] * bf_hi(w.z); v1[2] += d1[bj][2] * bf_lo(w.w); v1[3] += d1[bj][3] * bf_hi(w.w);
#pragma unroll
                    for (int e = 0; e < 4; ++e) { v0[e] = gelu_tanh(v0[e]); v1[e] = gelu_tanh(v1[e]); }
                    *(u32x4*)(YG + (size_t)t * 1024 + ch) = pack8(v0, v1); } } }
    }
};
template <int ACT  > struct EpiGated {
    bf16_t* O; int ldo;
    __device__ __forceinline__ void operator()(EPI_ARGS) const {
        FOR_AI_M { const int row = EPI_ROW(ai, m); f32x4 r[2];
#pragma unroll
            for (int n = 0; n < 2; ++n)
#pragma unroll
                for (int e = 0; e < 4; ++e) { const float a = acc[ai][0][m][n][e], b = acc[ai][1][m][n][e]; r[n][e] = ACT == 0 ? a * fast_sigmoid(b) : a * fast_sigmoid(a) * b; }
            *(u32x4*)(O + (size_t)row * ldo + u.pn * 128 + wc * 32 + fq * 8) = pack8(r[0], r[1]); }
    }
};
struct EpiSwigluF8 {
    unsigned char* O; int ldo;
    __device__ __forceinline__ void operator()(EPI_ARGS) const {
        FOR_AI_M { const int row = EPI_ROW(ai, m); f32x4 r[2];
#pragma unroll
            for (int n = 0; n < 2; ++n)
#pragma unroll
                for (int e = 0; e < 4; ++e) { const float a = acc[ai][0][m][n][e], b = acc[ai][1][m][n][e]; r[n][e] = a * fast_sigmoid(a) * b; }
            *(u32x2*)(O + (size_t)row * ldo + u.pn * 128 + wc * 32 + fq * 8) = pack8_fp8(r[0], r[1]); }
    }
};
struct EpiGatesF8 {
    bf16_t* GATES;
    __device__ __forceinline__ void operator()(EPI_ARGS) const {
        FOR_AI_M { const int row = EPI_ROW(ai, m);
            FOR_BJ { f32x4 v0 = acc[ai][bj][m][0], v1 = acc[ai][bj][m][1];
#pragma unroll
                for (int e = 0; e < 4; ++e) { v0[e] = fast_sigmoid(v0[e]); v1[e] = fast_sigmoid(v1[e]); }
                *(u32x4*)(GATES + (size_t)row * 6144 + u.pn * 256 + EPI_CB(bj)) = pack8(v0, v1); } }
    }
};
struct EpiBranch {
    const bf16_t* GATES; bf16_t* P; bf16_t* MG;
    __device__ __forceinline__ void operator()(EPI_ARGS) const {
        const int z = u.z;
#pragma unroll
        for (int ai = 0; ai < 2; ++ai)
#pragma unroll
            for (int mh = 0; mh < 2; ++mh) { u32x4 gg[2][2], pa[2][2], pb[2][2];
#pragma unroll
                for (int mm = 0; mm < 2; ++mm) { const int row = EPI_ROW(ai, mh * 2 + mm);
                    FOR_BJ { const int col = u.pn * 256 + EPI_CB(bj); gg[mm][bj] = *(const u32x4*)(GATES + (size_t)row * 6144 + z * 2048 + col);
                        if (z == 2) { const size_t o = (size_t)row * 2048 + col; pa[mm][bj] = *(const u32x4*)(P + o); pb[mm][bj] = *(const u32x4*)(P + (size_t)M * 2048 + o); } } }
#pragma unroll
                for (int mm = 0; mm < 2; ++mm) { const int m = mh * 2 + mm, row = EPI_ROW(ai, m);
                    FOR_BJ { const int col = u.pn * 256 + EPI_CB(bj); const u32x4 g = gg[mm][bj];
                        f32x4 v0 = acc[ai][bj][m][0], v1 = acc[ai][bj][m][1];
                        v0[0] *= bf_lo(g.x); v0[1] *= bf_hi(g.x); v0[2] *= bf_lo(g.y); v0[3] *= bf_hi(g.y);
                        v1[0] *= bf_lo(g.z); v1[1] *= bf_hi(g.z); v1[2] *= bf_lo(g.w); v1[3] *= bf_hi(g.w);
                        const size_t o = (size_t)row * 2048 + col;
                        if (z < 2) *(u32x4*)(P + (size_t)z * M * 2048 + o) = pack8(v0, v1);
                        else { const u32x4 a = pa[mm][bj], b = pb[mm][bj];
                            v0[0] += bf_lo(a.x) + bf_lo(b.x); v0[1] += bf_hi(a.x) + bf_hi(b.x); v0[2] += bf_lo(a.y) + bf_lo(b.y); v0[3] += bf_hi(a.y) + bf_hi(b.y);
                            v1[0] += bf_lo(a.z) + bf_lo(b.z); v1[1] += bf_hi(a.z) + bf_hi(b.z); v1[2] += bf_lo(a.w) + bf_lo(b.w); v1[3] += bf_hi(a.w) + bf_hi(b.w);
                            *(u32x4*)(MG + o) = pack8(v0, v1); } } } }
    }
};
struct EpiResid {
    bf16_t* X;
    __device__ __forceinline__ void operator()(EPI_ARGS) const {
#pragma unroll
        for (int ai = 0; ai < 2; ++ai) { u32x4 r[4][2];
#pragma unroll
            for (int m = 0; m < 4; ++m) { const int row = EPI_ROW(ai, m);
                FOR_BJ { r[m][bj] = *(const u32x4*)(X + (size_t)row * 2048 + u.pn * 256 + EPI_CB(bj)); } }
#pragma unroll
            for (int m = 0; m < 4; ++m) { const int row = EPI_ROW(ai, m);
                FOR_BJ { const u32x4 w = r[m][bj]; f32x4 v0 = acc[ai][bj][m][0], v1 = acc[ai][bj][m][1];
                    v0[0] += ALPHA * bf_lo(w.x); v0[1] += ALPHA * bf_hi(w.x); v0[2] += ALPHA * bf_lo(w.y); v0[3] += ALPHA * bf_hi(w.y);
                    v1[0] += ALPHA * bf_lo(w.z); v1[1] += ALPHA * bf_hi(w.z); v1[2] += ALPHA * bf_lo(w.w); v1[3] += ALPHA * bf_hi(w.w);
                    *(u32x4*)(X + (size_t)row * 2048 + u.pn * 256 + EPI_CB(bj)) = pack8(v0, v1); } } }
    }
};
struct EpiBf16 {
    bf16_t* O; int ldo; float scale;
    __device__ __forceinline__ void operator()(EPI_ARGS) const {
        FOR_AI_M { const int row = EPI_ROW(ai, m); FOR_BJ { *(u32x4*)(O + (size_t)row * ldo + u.pn * 256 + EPI_CB(bj)) = pack8(acc[ai][bj][m][0] * scale, acc[ai][bj][m][1] * scale); } }
    }
};
struct EpiBf16Half {
    bf16_t* O; int ldo; float scale;
    __device__ __forceinline__ void operator()(EPI_ARGS) const {
#pragma unroll
        for (int m = 0; m < 4; ++m) { const int row = u.pm * 128 + wr * 64 + m * 16 + fr;
            FOR_BJ { *(u32x4*)(O + (size_t)row * ldo + u.pn * 256 + EPI_CB(bj)) = pack8(acc[0][bj][m][0] * scale, acc[0][bj][m][1] * scale); } }
    }
};
struct EpiMoeDown {
    float* OG; const float* wslot;
    __device__ __forceinline__ void operator()(EPI_ARGS) const {
        float w[2][4];
        FOR_AI_M w[ai][m] = wslot[EPI_ROW(ai, m)];
        FOR_AI_M { const int row = EPI_ROW(ai, m);
            FOR_BJ { float* o = OG + (size_t)row * 2048 + u.pn * 256 + EPI_CB(bj); *(f32x4*)o = acc[ai][bj][m][0] * w[ai][m]; *(f32x4*)(o + 4) = acc[ai][bj][m][1] * w[ai][m]; } }
    }
};

namespace att {
constexpr int KVBLK = 64, SHM_V = KVBLK * 128 * 2;
constexpr float THRL = 8.f;
__device__ __forceinline__ int crow(int r, int hi) { return (r & 3) + 8 * (r >> 2) + 4 * hi; }
template <int PITCH> __device__ __forceinline__ int kfl(int row) { return (PITCH % 256 == 128) ? ((row >> 1) & 7) : (row & 15); }
template <int PITCH> __device__ __forceinline__ int kswz(int row, int colB) { return row * PITCH + (colB ^ (kfl<PITCH>(row) << 4)); }
__device__ __forceinline__ int v_st(int k, int c) { const int kk = (k & ~0xC) | ((k & 4) << 1) | ((k & 8) >> 1); return ((kk >> 3) * 4 + (c >> 5)) * 512 + ((kk & 7) * 32 + (c & 31)) * 2; }
__device__ __forceinline__ int v_rd_base(int lane) { return ((lane & 3) << 3) | (((lane >> 2) & 3) << 6) | (((lane >> 4) & 1) << 5) | (((lane >> 5) & 1) << 8); }
constexpr int v_rd_off(int d0, int ks, int half) { return d0 * 512 + ks * 4096 + half * 2048; }

__device__ __forceinline__ void mask_tile(f32x16& p0, f32x16& p1, int dq) {
    const float NEG = -__builtin_inff();
#pragma unroll
    for (int r = 0; r < 16; ++r) { const int c = (r & 3) + 8 * (r >> 2); if (dq - c < 0) p0[r] = NEG; if (dq - c - 32 < 0) p1[r] = NEG; }
}
__device__ __forceinline__ void partialSM(f32x16& p0, f32x16& p1, float& m_reg, float& alpha) {
    float pmax = p0[0];
#pragma unroll
    for (int r = 1; r < 16; ++r) pmax = fmaxf(pmax, p0[r]);
#pragma unroll
    for (int r = 0; r < 16; ++r) pmax = fmaxf(pmax, p1[r]);
    { auto rr = __builtin_amdgcn_permlane32_swap(__float_as_uint(pmax), __float_as_uint(pmax), false, false); pmax = fmaxf(__uint_as_float(rr[0]), __uint_as_float(rr[1])); }
    float mn;
    if (__builtin_expect(__all(pmax - m_reg <= THRL), 1)) { mn = m_reg; alpha = 1.f; }
    else { mn = fmaxf(m_reg, pmax); alpha = __builtin_amdgcn_exp2f(m_reg - mn); m_reg = mn; }
#pragma unroll
    for (int r = 0; r < 16; ++r) { p0[r] -= mn; p1[r] -= mn; }
#pragma unroll
    for (int r = 0; r < 16; ++r) p0[r] = __builtin_amdgcn_exp2f(p0[r]);
}
__device__ __forceinline__ void finishSM(f32x16& p0, f32x16& p1, float alpha, float& l_reg, bf16x8& pa0, bf16x8& pa1, bf16x8& pa2, bf16x8& pa3) {
#pragma unroll
    for (int r = 0; r < 16; ++r) p1[r] = __builtin_amdgcn_exp2f(p1[r]);
    float ps = 0;
#pragma unroll
    for (int r = 0; r < 16; ++r) ps += p0[r];
#pragma unroll
    for (int r = 0; r < 16; ++r) ps += p1[r];
    { auto rr = __builtin_amdgcn_permlane32_swap(__float_as_uint(ps), __float_as_uint(ps), false, false); ps = __uint_as_float(rr[0]) + __uint_as_float(rr[1]); }
    l_reg = l_reg * alpha + ps;
#define PK4(P, B_, OUT) do { unsigned a0 = cvt_pk_bf16(P[B_+0], P[B_+1]), a1 = cvt_pk_bf16(P[B_+2], P[B_+3]); unsigned b0 = cvt_pk_bf16(P[B_+4], P[B_+5]), b1 = cvt_pk_bf16(P[B_+6], P[B_+7]); \
        auto r0 = __builtin_amdgcn_permlane32_swap(a0, b0, false, false); auto r1 = __builtin_amdgcn_permlane32_swap(a1, b1, false, false); \
        u32x4 w = {r0[0], r1[0], r0[1], r1[1]}; OUT = *reinterpret_cast<bf16x8*>(&w); } while (0)
    PK4(p0, 0, pa0); PK4(p0, 8, pa1); PK4(p1, 0, pa2); PK4(p1, 8, pa3);
#undef PK4
}
template <int PITCH, int ND0>
__device__ __forceinline__ void qkt(f32x16& p0, f32x16& p1, const char* Kb, int r32, int hi, int kch0, const bf16x8* qr) {
    p0 = f32x16{}; p1 = f32x16{};
    const char* kb[4];
#pragma unroll
    for (int dd = 0; dd < 4; ++dd) kb[dd] = Kb + kswz<PITCH>(r32, (kch0 + dd * 2 + hi) * 16);
#pragma unroll
    for (int d0 = 0; d0 < ND0; ++d0) { const char* a = (PITCH % 256 == 0) ? Kb + kswz<PITCH>(r32, (kch0 + d0 * 2 + hi) * 16) : kb[d0 & 3] + (d0 >> 2) * 128;
        const bf16x8 b0 = *reinterpret_cast<const bf16x8*>(a);
        const bf16x8 b1 = *reinterpret_cast<const bf16x8*>(a + 32 * PITCH);
        p0 = __builtin_amdgcn_mfma_f32_32x32x16_bf16(b0, qr[d0], p0, 0, 0, 0);
        p1 = __builtin_amdgcn_mfma_f32_32x32x16_bf16(b1, qr[d0], p1, 0, 0, 0); }
}
__device__ __forceinline__ void pv_tile(f32x16* o, int vb0, bf16x8 pa0, bf16x8 pa1, bf16x8 pa2, bf16x8 pa3) {
    s16x4 va[8], vb[8];
#define TRRD(dst, off) asm volatile("ds_read_b64_tr_b16 %0, %1 offset:%2" : "=&v"(dst) : "v"(vb0), "i"(off) : "memory")
#define PV_RD(v, d0) do { constexpr int b_ = v_rd_off(d0, 0, 0); TRRD(v[0], b_); TRRD(v[1], b_ + 2048); TRRD(v[2], b_ + 4096); TRRD(v[3], b_ + 6144); TRRD(v[4], b_ + 8192); TRRD(v[5], b_ + 10240); TRRD(v[6], b_ + 12288); TRRD(v[7], b_ + 14336); } while (0)
#define PV_MM(v, d0) do { \
        o[d0] = __builtin_amdgcn_mfma_f32_32x32x16_bf16(pa0, (bf16x8){v[0][0], v[0][1], v[0][2], v[0][3], v[1][0], v[1][1], v[1][2], v[1][3]}, o[d0], 0, 0, 0); \
        o[d0] = __builtin_amdgcn_mfma_f32_32x32x16_bf16(pa1, (bf16x8){v[2][0], v[2][1], v[2][2], v[2][3], v[3][0], v[3][1], v[3][2], v[3][3]}, o[d0], 0, 0, 0); \
        o[d0] = __builtin_amdgcn_mfma_f32_32x32x16_bf16(pa2, (bf16x8){v[4][0], v[4][1], v[4][2], v[4][3], v[5][0], v[5][1], v[5][2], v[5][3]}, o[d0], 0, 0, 0); \
        o[d0] = __builtin_amdgcn_mfma_f32_32x32x16_bf16(pa3, (bf16x8){v[6][0], v[6][1], v[6][2], v[6][3], v[7][0], v[7][1], v[7][2], v[7][3]}, o[d0], 0, 0, 0); } while (0)
#define PV_W8(v) asm volatile("s_waitcnt lgkmcnt(8)" : "+v"(v[0]), "+v"(v[1]), "+v"(v[2]), "+v"(v[3]), "+v"(v[4]), "+v"(v[5]), "+v"(v[6]), "+v"(v[7]) :: "memory")
#define PV_W0(v) asm volatile("s_waitcnt lgkmcnt(0)" : "+v"(v[0]), "+v"(v[1]), "+v"(v[2]), "+v"(v[3]), "+v"(v[4]), "+v"(v[5]), "+v"(v[6]), "+v"(v[7]) :: "memory")
    PV_RD(va, 0); PV_RD(vb, 1); PV_W8(va); SBAR(); PV_MM(va, 0);
    PV_RD(va, 2); PV_W8(vb); SBAR(); PV_MM(vb, 1);
    PV_RD(vb, 3); PV_W8(va); SBAR(); PV_MM(va, 2);
    PV_W0(vb); SBAR(); PV_MM(vb, 3);
#undef PV_W0
#undef PV_W8
#undef PV_MM
#undef PV_RD
#undef TRRD
}

template <int KT, int ND0, bool CAUSAL, bool PIPE>
__device__ __forceinline__ void attn_core(const bf16_t* Qlane, const bf16_t* __restrict__ Kh, int ldk, const bf16_t* __restrict__ Vh, int ldv, int NT, int qpos, int qlo, int kch0,
                                          char* lds, f32x16 (&o)[4], float& l_reg) {
    constexpr int PITCH = KT * 2, SHM_K = KVBLK * PITCH, NKL = KT / 64, CPR = KT / 8;
    const int tid = opaque_tid(), wid = __builtin_amdgcn_readfirstlane(tid >> 6), lane = tid & 63, r32 = lane & 31, hi = lane >> 5;
    char* V_lds = lds; char* K_lds = lds + 2 * SHM_V;
    float* ws = (float*)(lds + 2 * SHM_V + 2 * SHM_K) + wid * 64; float* al_l = ws + 32;
    float m_reg = -1e30f; l_reg = 0.f;
#pragma unroll
    for (int d = 0; d < 4; ++d) o[d] = f32x16{};
    bf16x8 qr[ND0];
#pragma unroll
    for (int d0 = 0; d0 < ND0; ++d0) qr[d0] = *reinterpret_cast<const bf16x8*>(Qlane + d0 * 16);
    const int sr = tid >> 4, sc = (tid & 15) * 8, vst0 = v_st(sr, sc), vst1 = v_st(32 + sr, sc);
    const int vb0 = (int)(uintptr_t)V_lds + v_rd_base(lane);
    int krow[NKL], kcc[NKL];
#pragma unroll
    for (int i = 0; i < NKL; ++i) { const int cid = tid + 512 * i; krow[i] = cid / CPR; kcc[i] = cid - krow[i] * CPR; }
    bf16x8 st_v0, st_v1, st_k[NKL];
#define SLOAD(k0) do { st_v0 = *reinterpret_cast<const bf16x8*>(Vh + (size_t)((k0) + sr) * ldv + sc); st_v1 = *reinterpret_cast<const bf16x8*>(Vh + (size_t)((k0) + 32 + sr) * ldv + sc); \
        _Pragma("unroll") for (int i_ = 0; i_ < NKL; ++i_) st_k[i_] = *reinterpret_cast<const bf16x8*>(Kh + (size_t)((k0) + krow[i_]) * ldk + kcc[i_] * 8); } while (0)
#define SWRITE(b) do { *(bf16x8*)(V_lds + (b) * SHM_V + vst0) = st_v0; *(bf16x8*)(V_lds + (b) * SHM_V + vst1) = st_v1; \
        _Pragma("unroll") for (int i_ = 0; i_ < NKL; ++i_) *(bf16x8*)(K_lds + (b) * SHM_K + kswz<PITCH>(krow[i_], kcc[i_] * 16)) = st_k[i_]; } while (0)
#define RESC(a) do { if (__any((a) < 1.f)) { if (hi == 0) al_l[r32] = (a); asm volatile("s_waitcnt lgkmcnt(0)" ::: "memory"); \
        _Pragma("unroll") for (int d_ = 0; d_ < 4; ++d_) _Pragma("unroll") for (int r = 0; r < 16; ++r) o[d_][r] *= al_l[crow(r, hi)]; } } while (0)
#define MASKT(P0_, P1_, t) do { if (CAUSAL) { const int kb_ = (t) * KVBLK; if (kb_ + KVBLK - 1 > qlo) mask_tile(P0_, P1_, qpos - kb_ - 4 * hi); } } while (0)
    if constexpr (PIPE) {
    f32x16 pA0, pA1, pB0, pB1; float alA, alB; bf16x8 pa0, pa1, pa2, pa3;
    SLOAD(0); VM_WAIT(); SWRITE(0); __syncthreads();
    qkt<PITCH, ND0>(pA0, pA1, K_lds, r32, hi, kch0, qr); MASKT(pA0, pA1, 0); partialSM(pA0, pA1, m_reg, alA);
    SLOAD(KVBLK); VM_WAIT(); SWRITE(1); __syncthreads();
    for (int j = 1; j + 1 < NT; j += 2) {
        SBAR(); qkt<PITCH, ND0>(pB0, pB1, K_lds + SHM_K, r32, hi, kch0, qr);
        finishSM(pA0, pA1, alA, l_reg, pa0, pa1, pa2, pa3); SBAR();
        SLOAD((j + 1) * KVBLK); SBAR();
        pv_tile(o, vb0, pa0, pa1, pa2, pa3); MASKT(pB0, pB1, j); partialSM(pB0, pB1, m_reg, alB);
        __syncthreads(); VM_WAIT(); SWRITE(0);
        RESC(alB); __syncthreads();
        SBAR(); qkt<PITCH, ND0>(pA0, pA1, K_lds, r32, hi, kch0, qr);
        finishSM(pB0, pB1, alB, l_reg, pa0, pa1, pa2, pa3); SBAR();
        SLOAD((j + 2) * KVBLK); SBAR();
        pv_tile(o, vb0 + SHM_V, pa0, pa1, pa2, pa3); MASKT(pA0, pA1, j + 1); partialSM(pA0, pA1, m_reg, alA);
        __syncthreads(); VM_WAIT(); SWRITE(1);
        RESC(alA); __syncthreads();
    }
    SBAR(); qkt<PITCH, ND0>(pB0, pB1, K_lds + SHM_K, r32, hi, kch0, qr);
    finishSM(pA0, pA1, alA, l_reg, pa0, pa1, pa2, pa3); SBAR();
    pv_tile(o, vb0, pa0, pa1, pa2, pa3); MASKT(pB0, pB1, NT - 1); partialSM(pB0, pB1, m_reg, alB);
    RESC(alB);
    finishSM(pB0, pB1, alB, l_reg, pa0, pa1, pa2, pa3); SBAR();
    pv_tile(o, vb0 + SHM_V, pa0, pa1, pa2, pa3);
    } else {
    f32x16 p0, p1; float al; bf16x8 pa0, pa1, pa2, pa3;
    SLOAD(0); VM_WAIT(); SWRITE(0); __syncthreads();
    for (int t = 0; t < NT; t += 2) {
        SBAR(); SLOAD((t + 1) * KVBLK); SBAR();
        qkt<PITCH, ND0>(p0, p1, K_lds, r32, hi, kch0, qr); MASKT(p0, p1, t); partialSM(p0, p1, m_reg, al); RESC(al);
        finishSM(p0, p1, al, l_reg, pa0, pa1, pa2, pa3); SBAR();
        pv_tile(o, vb0, pa0, pa1, pa2, pa3);
        VM_WAIT(); SWRITE(1); __syncthreads();
        SBAR(); if (t + 2 < NT) SLOAD((t + 2) * KVBLK); SBAR();
        qkt<PITCH, ND0>(p0, p1, K_lds + SHM_K, r32, hi, kch0, qr); MASKT(p0, p1, t + 1); partialSM(p0, p1, m_reg, al); RESC(al);
        finishSM(p0, p1, al, l_reg, pa0, pa1, pa2, pa3); SBAR();
        pv_tile(o, vb0 + SHM_V, pa0, pa1, pa2, pa3);
        if (t + 2 < NT) { VM_WAIT(); SWRITE(0); } __syncthreads();
    }
    }
#undef SLOAD
#undef SWRITE
#undef RESC
#undef MASKT
}

template <bool NEGM = true>
__device__ __forceinline__ void partialSM_rel(f32x16& p0, f32x16& p1, float& m_reg, f32x16& negm, float& alpha, bool first) {
    float pmax = p0[0];
#pragma unroll
    for (int r = 1; r < 16; ++r) pmax = fmaxf(pmax, p0[r]);
#pragma unroll
    for (int r = 0; r < 16; ++r) pmax = fmaxf(pmax, p1[r]);
    { auto rr = __builtin_amdgcn_permlane32_swap(__float_as_uint(pmax), __float_as_uint(pmax), false, false); pmax = fmaxf(__uint_as_float(rr[0]), __uint_as_float(rr[1])); }
    if (__builtin_expect(!first && __all(pmax <= THRL), 1)) { alpha = 1.f; }
    else { const float dl = first ? pmax : fmaxf(pmax, 0.f); alpha = first ? 1.f : __builtin_amdgcn_exp2f(-dl); m_reg += dl;
#pragma unroll
        for (int r = 0; r < 16; ++r) { p0[r] -= dl; p1[r] -= dl; }
        if constexpr (NEGM) {
#pragma unroll
            for (int r = 0; r < 16; ++r) negm[r] = -m_reg; } }
#pragma unroll
    for (int r = 0; r < 16; ++r) p0[r] = __builtin_amdgcn_exp2f(p0[r]);
}
template <int PITCH, int ND0>
__device__ __forceinline__ void qkt_rel(f32x16& p0, f32x16& p1, const char* Kb, int r32, int hi, int kch0, const bf16x8* qr, const f32x16& negm) {
    const char* kb[4];
#pragma unroll
    for (int dd = 0; dd < 4; ++dd) kb[dd] = Kb + kswz<PITCH>(r32, (kch0 + dd * 2 + hi) * 16);
#pragma unroll
    for (int d0 = 0; d0 < ND0; ++d0) { const char* a = (PITCH % 256 == 0) ? Kb + kswz<PITCH>(r32, (kch0 + d0 * 2 + hi) * 16) : kb[d0 & 3] + (d0 >> 2) * 128;
        const bf16x8 b0 = *reinterpret_cast<const bf16x8*>(a);
        const bf16x8 b1 = *reinterpret_cast<const bf16x8*>(a + 32 * PITCH);
        p0 = __builtin_amdgcn_mfma_f32_32x32x16_bf16(b0, qr[d0], d0 == 0 ? negm : p0, 0, 0, 0);
        p1 = __builtin_amdgcn_mfma_f32_32x32x16_bf16(b1, qr[d0], d0 == 0 ? negm : p1, 0, 0, 0); }
}

template <int PITCH, int ND0, int PF>
__device__ __forceinline__ void qkt_rel_pf(f32x16& p0, f32x16& p1, const char* Kb, int r32, int hi, int kch0, const bf16x8* qr, const f32x16& negm_) {
    static_assert(PITCH % 256 == 128 || ND0 <= 4, "the +128 B immediate offsets need the 3-bit swizzle");
    f32x16 negm = negm_;
    int kb[4];
#pragma unroll
    for (int dd = 0; dd < 4; ++dd) kb[dd] = (int)(uintptr_t)Kb + kswz<PITCH>(r32, (kch0 + dd * 2 + hi) * 16);
    bf16x8 f[PF + 1][2];
#define KRD(d) do { asm volatile("ds_read_b128 %0, %1 offset:%2" : "=v"(f[(d) % (PF + 1)][0]) : "v"(kb[(d) & 3]), "i"(((d) >> 2) * 128)); \
                    asm volatile("ds_read_b128 %0, %1 offset:%2" : "=v"(f[(d) % (PF + 1)][1]) : "v"(kb[(d) & 3]), "i"(((d) >> 2) * 128 + 32 * PITCH)); } while (0)
#pragma unroll
    for (int d = 0; d < PF && d < ND0; ++d) KRD(d);
#pragma unroll
    for (int d0 = 0; d0 < ND0; ++d0) {
        if (d0 + PF < ND0) KRD(d0 + PF);
        const int ahead = (d0 + PF < ND0 ? PF : ND0 - 1 - d0) * 2;
        if (ahead >= 4) asm volatile("s_waitcnt lgkmcnt(4)" : "+v"(f[d0 % (PF + 1)][0]), "+v"(f[d0 % (PF + 1)][1]));
        else if (ahead == 2) asm volatile("s_waitcnt lgkmcnt(2)" : "+v"(f[d0 % (PF + 1)][0]), "+v"(f[d0 % (PF + 1)][1]));
        else asm volatile("s_waitcnt lgkmcnt(0)" : "+v"(f[d0 % (PF + 1)][0]), "+v"(f[d0 % (PF + 1)][1]));
        p0 = __builtin_amdgcn_mfma_f32_32x32x16_bf16(f[d0 % (PF + 1)][0], qr[d0], d0 == 0 ? negm : p0, 0, 0, 0);
        p1 = __builtin_amdgcn_mfma_f32_32x32x16_bf16(f[d0 % (PF + 1)][1], qr[d0], d0 == 0 ? negm : p1, 0, 0, 0);
    }
#undef KRD
}

template <int PITCH, int ND0>
__device__ __forceinline__ void pv_qk(f32x16* o, int vb0, bf16x8 pa0, bf16x8 pa1, bf16x8 pa2, bf16x8 pa3,
                                      f32x16& p0, f32x16& p1, const char* Kb, int r32, int hi, int kch0, const bf16x8* qr, const f32x16& negm_) {
    constexpr int PF = 2;
    static_assert(PITCH % 256 == 128 || ND0 <= 4, "the +128 B immediate offsets need the 3-bit swizzle");
    f32x16 negm = negm_;
    s16x4 va[8], vb[8];
    int kb[4];
#pragma unroll
    for (int dd = 0; dd < 4; ++dd) kb[dd] = (int)(uintptr_t)Kb + kswz<PITCH>(r32, (kch0 + dd * 2 + hi) * 16);
    bf16x8 f[PF + 1][2];
#define TRRD(dst, off) asm volatile("ds_read_b64_tr_b16 %0, %1 offset:%2" : "=&v"(dst) : "v"(vb0), "i"(off) : "memory")
#define PV_RD(v, d0) do { constexpr int b_ = v_rd_off(d0, 0, 0); TRRD(v[0], b_); TRRD(v[1], b_ + 2048); TRRD(v[2], b_ + 4096); TRRD(v[3], b_ + 6144); TRRD(v[4], b_ + 8192); TRRD(v[5], b_ + 10240); TRRD(v[6], b_ + 12288); TRRD(v[7], b_ + 14336); } while (0)
#define PV_MM(v, d0) do { \
        o[d0] = __builtin_amdgcn_mfma_f32_32x32x16_bf16(pa0, (bf16x8){v[0][0], v[0][1], v[0][2], v[0][3], v[1][0], v[1][1], v[1][2], v[1][3]}, o[d0], 0, 0, 0); \
        o[d0] = __builtin_amdgcn_mfma_f32_32x32x16_bf16(pa1, (bf16x8){v[2][0], v[2][1], v[2][2], v[2][3], v[3][0], v[3][1], v[3][2], v[3][3]}, o[d0], 0, 0, 0); \
        o[d0] = __builtin_amdgcn_mfma_f32_32x32x16_bf16(pa2, (bf16x8){v[4][0], v[4][1], v[4][2], v[4][3], v[5][0], v[5][1], v[5][2], v[5][3]}, o[d0], 0, 0, 0); \
        o[d0] = __builtin_amdgcn_mfma_f32_32x32x16_bf16(pa3, (bf16x8){v[6][0], v[6][1], v[6][2], v[6][3], v[7][0], v[7][1], v[7][2], v[7][3]}, o[d0], 0, 0, 0); } while (0)
#define PV_WN(v, n) asm volatile("s_waitcnt lgkmcnt(%8)" : "+v"(v[0]), "+v"(v[1]), "+v"(v[2]), "+v"(v[3]), "+v"(v[4]), "+v"(v[5]), "+v"(v[6]), "+v"(v[7]) : "n"(n) : "memory")
#define KRD(d) do { asm volatile("ds_read_b128 %0, %1 offset:%2" : "=v"(f[(d) % (PF + 1)][0]) : "v"(kb[(d) & 3]), "i"(((d) >> 2) * 128) : "memory"); \
                    asm volatile("ds_read_b128 %0, %1 offset:%2" : "=v"(f[(d) % (PF + 1)][1]) : "v"(kb[(d) & 3]), "i"(((d) >> 2) * 128 + 32 * PITCH) : "memory"); } while (0)
    PV_RD(va, 0); PV_RD(vb, 1); PV_WN(va, 8); SBAR(); PV_MM(va, 0);
    PV_RD(va, 2); PV_WN(vb, 8); SBAR(); PV_MM(vb, 1);
    PV_RD(vb, 3); PV_WN(va, 8); SBAR(); PV_MM(va, 2);
    KRD(0); KRD(1);
    PV_WN(vb, 4); SBAR(); PV_MM(vb, 3);
    SBAR();
#pragma unroll
    for (int d0 = 0; d0 < ND0; ++d0) {
        if (d0 + PF < ND0) KRD(d0 + PF);
        const int ahead = (d0 + PF < ND0 ? PF : ND0 - 1 - d0) * 2;
        if (ahead >= 4) asm volatile("s_waitcnt lgkmcnt(4)" : "+v"(f[d0 % (PF + 1)][0]), "+v"(f[d0 % (PF + 1)][1]) :: "memory");
        else if (ahead == 2) asm volatile("s_waitcnt lgkmcnt(2)" : "+v"(f[d0 % (PF + 1)][0]), "+v"(f[d0 % (PF + 1)][1]) :: "memory");
        else asm volatile("s_waitcnt lgkmcnt(0)" : "+v"(f[d0 % (PF + 1)][0]), "+v"(f[d0 % (PF + 1)][1]) :: "memory");
        p0 = __builtin_amdgcn_mfma_f32_32x32x16_bf16(f[d0 % (PF + 1)][0], qr[d0], d0 == 0 ? negm : p0, 0, 0, 0);
        p1 = __builtin_amdgcn_mfma_f32_32x32x16_bf16(f[d0 % (PF + 1)][1], qr[d0], d0 == 0 ? negm : p1, 0, 0, 0);
    }
#undef KRD
#undef PV_WN
#undef PV_MM
#undef PV_RD
#undef TRRD
}

__device__ __forceinline__ void glds16(unsigned lds_addr, const void* sbase, unsigned voff) {
    unsigned keep;
    asm volatile("s_mov_b32 %0, m0\n\ts_mov_b32 m0, %1\n\ts_nop 0\n\tglobal_load_lds_dwordx4 %2, %3\n\ts_mov_b32 m0, %0" : "=&s"(keep) : "s"(lds_addr), "v"(voff), "s"(sbase) : "memory");
}
template <int KT, int ND0, bool CAUSAL>
__device__ __forceinline__ void attn_core_ring(const bf16_t* Qlane, const bf16_t* __restrict__ Kh, int ldk, const bf16_t* __restrict__ Vh, int ldv, int NT, int qpos, int qlo, int kch0,
                                               char* lds, f32x16 (&o)[4], float& l_reg) {
    constexpr int PITCH = KT * 2, SHM_K = KVBLK * PITCH, NKP = SHM_K / 8192, NVP = SHM_V / 8192;
    const int tid = opaque_tid(), wid = __builtin_amdgcn_readfirstlane(tid >> 6), lane = tid & 63, r32 = lane & 31, hi = lane >> 5;
    char* V_lds = lds; char* K_lds = lds + 3 * SHM_V;
    float* ws = (float*)(lds + 3 * SHM_V + 3 * SHM_K) + wid * 64; float* al_l = ws + 32;
    float m_reg = 0.f; l_reg = 0.f; f32x16 negm = f32x16{};
#pragma unroll
    for (int d = 0; d < 4; ++d) o[d] = f32x16{};
    bf16x8 qr[ND0];
#pragma unroll
    for (int d0 = 0; d0 < ND0; ++d0) qr[d0] = *reinterpret_cast<const bf16x8*>(Qlane + d0 * 16);
    const int vb0 = (int)(uintptr_t)V_lds + v_rd_base(lane);
    unsigned koff[NKP], voff[NVP];
#pragma unroll
    for (int i = 0; i < NKP; ++i) { const int a = (wid * NKP + i) * 1024 + lane * 16, row = a / PITCH, cpos = (a - row * PITCH) >> 4, f = kfl<PITCH>(row);
        const int chunk = cpos ^ f; koff[i] = (unsigned)(row * ldk * 2 + chunk * 16); }
#pragma unroll
    for (int i = 0; i < NVP; ++i) { const int a = (wid * NVP + i) * 1024 + lane * 16, sub = a >> 9, rem = a & 511, kk = (sub >> 2) * 8 + (rem >> 6), c = (sub & 3) * 32 + ((rem & 63) >> 1);
        const int k = (kk & ~0xC) | ((kk & 4) << 1) | ((kk & 8) >> 1); voff[i] = (unsigned)(k * ldv * 2 + c * 2); }
    const unsigned ldsK = (unsigned)(uintptr_t)K_lds + (unsigned)(wid * NKP) * 1024u, ldsV = (unsigned)(uintptr_t)V_lds + (unsigned)(wid * NVP) * 1024u;
#define DMA_TILE(t, slot) do { const char* kb_ = (const char*)Kh + (size_t)(t) * KVBLK * ldk * 2; const char* vb_ = (const char*)Vh + (size_t)(t) * KVBLK * ldv * 2; \
        _Pragma("unroll") for (int i_ = 0; i_ < NKP; ++i_) glds16(ldsK + (slot) * SHM_K + i_ * 1024, kb_, koff[i_]); \
        _Pragma("unroll") for (int i_ = 0; i_ < NVP; ++i_) glds16(ldsV + (slot) * SHM_V + i_ * 1024, vb_, voff[i_]); } while (0)
#define RING_SYNC(more) do { if (more) asm volatile("s_waitcnt vmcnt(%0)" :: "n"(NKP + NVP) : "memory"); else asm volatile("s_waitcnt vmcnt(0)" ::: "memory"); \
        asm volatile("s_waitcnt lgkmcnt(0)" ::: "memory"); __builtin_amdgcn_s_barrier(); asm volatile("" ::: "memory"); } while (0)
#define RESC(a) do { if (__any((a) < 1.f)) { if (hi == 0) al_l[r32] = (a); asm volatile("s_waitcnt lgkmcnt(0)" ::: "memory"); \
        _Pragma("unroll") for (int d_ = 0; d_ < 4; ++d_) _Pragma("unroll") for (int r = 0; r < 16; ++r) o[d_][r] *= al_l[crow(r, hi)]; } } while (0)
#define MASKT(P0_, P1_, t) do { if (CAUSAL) { const int kb_ = (t) * KVBLK; if (kb_ + KVBLK - 1 > qlo) mask_tile(P0_, P1_, qpos - kb_ - 4 * hi); } } while (0)
    f32x16 p0, p1; float al; bf16x8 pa0, pa1, pa2, pa3;
    asm volatile("s_waitcnt vmcnt(0)" ::: "memory");
#pragma unroll
    for (int d0 = 0; d0 < ND0; ++d0) asm volatile("" : "+v"(qr[d0]));
    DMA_TILE(0, 0); if (NT > 1) DMA_TILE(1, 1);
    RING_SYNC(NT > 1);
    int slot = 0;
    for (int t = 0; t < NT; ++t) {
        const int s2 = slot == 0 ? 2 : slot - 1;
        SBAR(); if (t + 2 < NT) DMA_TILE(t + 2, s2); SBAR();
        qkt_rel_pf<PITCH, ND0, 2>(p0, p1, K_lds + slot * SHM_K, r32, hi, kch0, qr, negm); MASKT(p0, p1, t); partialSM_rel(p0, p1, m_reg, negm, al, t == 0); RESC(al);
        finishSM(p0, p1, al, l_reg, pa0, pa1, pa2, pa3); SBAR();
        pv_tile(o, vb0 + slot * SHM_V, pa0, pa1, pa2, pa3);
        RING_SYNC(t + 2 < NT);
        slot = slot == 2 ? 0 : slot + 1;
    }
#undef DMA_TILE
#undef RING_SYNC
#undef RESC
#undef MASKT
}
template <int KT, int ND0, bool CAUSAL, bool NEGM>
__device__ __forceinline__ void attn_core_pp(const bf16_t* Qlane, const bf16_t* __restrict__ Kh, int ldk, const bf16_t* __restrict__ Vh, int ldv, int NT, int qpos, int qlo, int kch0,
                                             char* lds, f32x16 (&o)[4], float& l_reg) {
    constexpr int PITCH = KT * 2, SHM_K = KVBLK * PITCH, NKP = SHM_K / 8192, NVP = SHM_V / 8192;
    const int tid = opaque_tid(), wid = __builtin_amdgcn_readfirstlane(tid >> 6), lane = tid & 63, r32 = lane & 31, hi = lane >> 5;
    const bool grpB = wid >= 4;
    char* V_lds = lds; char* K_lds = lds + 3 * SHM_V;
    float* ws = (float*)(lds + 3 * SHM_V + 3 * SHM_K) + wid * 64; float* al_l = ws + 32;
    float m_reg = 0.f; l_reg = 0.f; f32x16 negm = f32x16{};
#pragma unroll
    for (int d = 0; d < 4; ++d) o[d] = f32x16{};
    bf16x8 qr[ND0];
#pragma unroll
    for (int d0 = 0; d0 < ND0; ++d0) qr[d0] = *reinterpret_cast<const bf16x8*>(Qlane + d0 * 16);
    const int vb0 = (int)(uintptr_t)V_lds + v_rd_base(lane);
    unsigned koff[NKP], voff[NVP];
#pragma unroll
    for (int i = 0; i < NKP; ++i) { const int a = (wid * NKP + i) * 1024 + lane * 16, row = a / PITCH, cpos = (a - row * PITCH) >> 4, f = kfl<PITCH>(row);
        const int chunk = cpos ^ f; koff[i] = (unsigned)(row * ldk * 2 + chunk * 16); }
#pragma unroll
    for (int i = 0; i < NVP; ++i) { const int a = (wid * NVP + i) * 1024 + lane * 16, sub = a >> 9, rem = a & 511, kk = (sub >> 2) * 8 + (rem >> 6), c = (sub & 3) * 32 + ((rem & 63) >> 1);
        const int k = (kk & ~0xC) | ((kk & 4) << 1) | ((kk & 8) >> 1); voff[i] = (unsigned)(k * ldv * 2 + c * 2); }
    const unsigned ldsK = (unsigned)(uintptr_t)K_lds + (unsigned)(wid * NKP) * 1024u, ldsV = (unsigned)(uintptr_t)V_lds + (unsigned)(wid * NVP) * 1024u;
#define DMA_K(t, slot) do { const char* kb_ = (const char*)Kh + (size_t)(t) * KVBLK * ldk * 2; _Pragma("unroll") for (int i_ = 0; i_ < NKP; ++i_) glds16(ldsK + (slot) * SHM_K + i_ * 1024, kb_, koff[i_]); } while (0)
#define DMA_V(t, slot) do { const char* vb_ = (const char*)Vh + (size_t)(t) * KVBLK * ldv * 2; _Pragma("unroll") for (int i_ = 0; i_ < NVP; ++i_) glds16(ldsV + (slot) * SHM_V + i_ * 1024, vb_, voff[i_]); } while (0)
#define ISSUE(u, ksl, vsl) do { if ((u) < NT) DMA_K(u, ksl); if ((u) - 1 < NT) DMA_V((u) - 1, vsl); } while (0)
#define PAIR_WAIT(t) do { if ((t) + 2 < NT) asm volatile("s_waitcnt vmcnt(%0)" :: "n"(NKP + NVP) : "memory"); else if ((t) + 2 == NT) asm volatile("s_waitcnt vmcnt(%0)" :: "n"(NVP) : "memory"); \
        else asm volatile("s_waitcnt vmcnt(0)" ::: "memory"); } while (0)
#define BAR() do { SBAR(); asm volatile("s_waitcnt lgkmcnt(0)" ::: "memory"); __builtin_amdgcn_s_barrier(); asm volatile("" ::: "memory"); SBAR(); } while (0)
#define RESC(a) do { if (__any((a) < 1.f)) { if (hi == 0) al_l[r32] = (a); asm volatile("s_waitcnt lgkmcnt(0)" ::: "memory"); \
        _Pragma("unroll") for (int d_ = 0; d_ < 4; ++d_) _Pragma("unroll") for (int r = 0; r < 16; ++r) o[d_][r] *= al_l[crow(r, hi)]; } } while (0)
#define MASKT(P0_, P1_, t) do { if (CAUSAL) { const int kb_ = (t) * KVBLK; if (kb_ + KVBLK - 1 > qlo) mask_tile(P0_, P1_, qpos - kb_ - 4 * hi); } } while (0)
    f32x16 p0, p1; float al; bf16x8 pa0, pa1, pa2, pa3;
    asm volatile("s_waitcnt vmcnt(0)" ::: "memory");
#pragma unroll
    for (int d0 = 0; d0 < ND0; ++d0) asm volatile("" : "+v"(qr[d0]));
    DMA_K(0, 0);
    if (NT > 1) DMA_K(1, 1);
    DMA_V(0, 0);
    if (NT > 1) asm volatile("s_waitcnt vmcnt(%0)" :: "n"(NKP + NVP) : "memory"); else asm volatile("s_waitcnt vmcnt(%0)" :: "n"(NVP) : "memory");
    BAR();
    if (grpB) { ISSUE(2, 2, 1); BAR(); }
#define QK_(ksl) do { if constexpr (NEGM) qkt_rel_pf<PITCH, ND0, 2>(p0, p1, K_lds + (ksl) * SHM_K, r32, hi, kch0, qr, negm); \
        else { f32x16 c_; const float nm_ = -m_reg; _Pragma("unroll") for (int r = 0; r < 16; ++r) c_[r] = nm_; qkt_rel_pf<PITCH, ND0, 2>(p0, p1, K_lds + (ksl) * SHM_K, r32, hi, kch0, qr, c_); } } while (0)
#define Y_(t_, first_) do { MASKT(p0, p1, t_); partialSM_rel<NEGM>(p0, p1, m_reg, negm, al, first_); RESC(al); finishSM(p0, p1, al, l_reg, pa0, pa1, pa2, pa3); } while (0)
    QK_(0);
    if (grpB) PAIR_WAIT(0);
    BAR();
    if (grpB) ISSUE(3, 0, 2); else ISSUE(2, 2, 1);
    SBAR();
    Y_(0, true);
    if (!grpB) PAIR_WAIT(0);
    BAR();
    int ks = 1;
    for (int t = 1; t < NT; ++t) {
        const int kp = ks == 0 ? 2 : ks - 1, kn = ks == 2 ? 0 : ks + 1;
        if constexpr (NEGM) pv_qk<PITCH, ND0>(o, vb0 + kp * SHM_V, pa0, pa1, pa2, pa3, p0, p1, K_lds + ks * SHM_K, r32, hi, kch0, qr, negm);
        else { f32x16 c_; const float nm_ = -m_reg; _Pragma("unroll") for (int r = 0; r < 16; ++r) c_[r] = nm_; pv_qk<PITCH, ND0>(o, vb0 + kp * SHM_V, pa0, pa1, pa2, pa3, p0, p1, K_lds + ks * SHM_K, r32, hi, kch0, qr, c_); }
        if (grpB) PAIR_WAIT(t);
        BAR();
        if (grpB) ISSUE(t + 3, ks, kp); else ISSUE(t + 2, kp, kn);
        SBAR();
        Y_(t, false);
        if (!grpB) PAIR_WAIT(t);
        BAR();
        ks = kn;
    }
    pv_tile(o, vb0 + (ks == 0 ? 2 : ks - 1) * SHM_V, pa0, pa1, pa2, pa3);
    BAR();
#undef QK_
#undef Y_
    if (!grpB) BAR();
#undef DMA_K
#undef DMA_V
#undef ISSUE
#undef PAIR_WAIT
#undef BAR
#undef RESC
#undef MASKT
}
__device__ __forceinline__ void normalize_o(f32x16 (&o)[4], float l_reg, float* ws, int r32, int hi) {
    if (hi == 0) ws[r32] = l_reg; asm volatile("s_waitcnt lgkmcnt(0)" ::: "memory");
#pragma unroll
    for (int r = 0; r < 16; ++r) { const float rl = __builtin_amdgcn_rcpf(ws[crow(r, hi)]);
#pragma unroll
        for (int d0 = 0; d0 < 4; ++d0) o[d0][r] *= rl; }
}
__device__ __forceinline__ void store_o_bf16(const f32x16 (&o)[4], bf16_t* Ow, int ldo, int r32, int hi) {
#pragma unroll
    for (int r = 0; r < 16; ++r) { const int orow = crow(r, hi);
#pragma unroll
        for (int d0 = 0; d0 < 4; ++d0) { const float v = o[d0][r]; const float vn = shflx(v, 1, hi * 32 + r32);
            if ((r32 & 1) == 0) *(unsigned*)(Ow + (size_t)orow * ldo + d0 * 32 + r32) = cvt_pk_bf16(v, vn); } }
}
}

constexpr size_t MiB = 1u << 20;
constexpr size_t WS_CTL = 0, CTL_ZERO_BYTES = 4 * MiB;
constexpr size_t WS_SSQ = 1 * MiB;
constexpr size_t WS_W = 4 * MiB, LW_BYTES = 269 * MiB / 2;
constexpr size_t LW_IN = 0, LW_QUP = 44 * MiB, LW_KVUP = LW_QUP + 3 * MiB / 2, LW_GLU = LW_KVUP + 1 * MiB, LW_BR = LW_GLU + 4 * MiB, LW_OUT = LW_BR + 12 * MiB,
                 LW_XQ = LW_OUT + 8 * MiB, LW_XKV = LW_XQ + 2 * MiB, LW_XO = LW_XKV + 4 * MiB, LW_TEXT = LW_XO + 2 * MiB, LW_WSL = LW_TEXT + 40 * MiB;
static_assert(LW_WSL + 16 * MiB == LW_BYTES, "layer weight block");
constexpr size_t WS_FFN = WS_W + 2 * LW_BYTES;
constexpr size_t WS_MOE = WS_FFN + 66 * MiB;
constexpr size_t WS_XS = WS_MOE + 8 * 66 * MiB + 1 * MiB;
static_assert(WS_XS == 868 * MiB, "map");
constexpr size_t WS_XN = WS_XS + 128 * MiB;
constexpr size_t WS_TABD = WS_XN + 64 * MiB, WS_TABM = WS_TABD + 1 * MiB, WS_XKV = WS_TABM + 4 * MiB, WS_MEMB = WS_XKV + 1 * MiB, WS_ROUTE = WS_MEMB + 1 * MiB, WS_ORDER = WS_ROUTE + 1 * MiB;
constexpr size_t WS_A32 = WS_ORDER + 64 * 1024;
constexpr size_t WS_PSQ = WS_ORDER + 1 * MiB;
constexpr size_t WS_MIX = WS_TABD + 12 * MiB;
static_assert(WS_MIX == 1072 * MiB, "map");
constexpr size_t WS_QD = WS_MIX, WS_KD = WS_QD + 32 * MiB, WS_VD = WS_KD + 32 * MiB, WS_MQ = WS_VD + 32 * MiB, WS_MKV = WS_MQ + 16 * MiB, WS_KM = WS_MKV + 8 * MiB, WS_VM = WS_KM + 48 * MiB,
                 WS_QM = WS_VM + 32 * MiB, WS_SU = WS_QM + 48 * MiB, WS_GATES = WS_SU + 40 * MiB, WS_SLOC = WS_GATES + 192 * MiB, WS_YG = WS_SLOC + 16 * MiB, WS_BR = WS_YG + 32 * MiB,
                 WS_TMP = WS_BR + 96 * MiB, WS_MG = WS_TMP + 128 * MiB, WS_XQ = WS_MG + 64 * MiB, WS_XO = WS_XQ + 16 * MiB, WS_XN8 = WS_XO + 16 * MiB  , WS_END = WS_XN8 + 32 * MiB;
static_assert(WS_END == 1952 * MiB, "map");
constexpr size_t WS_XG = WS_MIX, WS_HG = WS_XG + 136 * MiB, WS_OG = WS_HG + 374 * MiB;
static_assert(WS_OG + 272 * MiB <= WS_XQ, "ffn overlay");
constexpr int CW_TMO = 0, CW_DBG = 2, CW_BAR = 4096, CW_ATTQ = 16384, CW_MOECNT = 16640, CW_MOECUR = 16704;

#define XB_TMO      128
#define XB_XCNT(j)  (256  + 64 * (j))
#define XB_XSUB(j)  (1280 + 64 * (j))
#define XB_XGEN(j)  (2304 + 64 * (j))
#define XB_TOP      3328
#define XB_TOPGEN   3392
#define XCD_BAR_WORDS 3456
#define XB_SPIN_CAP (1u << 22)
__device__ __forceinline__ unsigned xb_ld(unsigned* p)              { return __hip_atomic_load(p, __ATOMIC_RELAXED, __HIP_MEMORY_SCOPE_AGENT); }
__device__ __forceinline__ unsigned xb_add(unsigned* p, unsigned v) { return __hip_atomic_fetch_add(p, v, __ATOMIC_RELAXED, __HIP_MEMORY_SCOPE_AGENT); }
__device__ __forceinline__ unsigned xb_xcc_id() { return (unsigned)__builtin_amdgcn_s_getreg((3 << 11) | 20) & 0xFu; }
#define XB_SPIN(cond, bar) do { unsigned _sp = 0; while (cond) { __builtin_amdgcn_s_sleep(1); \
    if ((++_sp & 255u) == 0u) { if (xb_ld(&(bar)[XB_TMO])) break; if (_sp > XB_SPIN_CAP) { atomicAdd(&(bar)[XB_TMO], 1u); break; } } } } while (0)
struct XcdBarrier { unsigned* bar; unsigned x; volatile LAS unsigned* st; };
__device__ __forceinline__ XcdBarrier xcd_barrier_post(unsigned* bar, volatile LAS unsigned* st) {
    XcdBarrier b; b.bar = bar; b.x = xb_xcc_id(); b.st = st;
    if (threadIdx.x == 0) (void)xb_add(&bar[XB_XCNT(b.x)], 1u);
    return b;
}
__device__ __forceinline__ void xcd_barrier_complete(unsigned* bar, unsigned x, unsigned& nloc, unsigned& nx) {
    const unsigned G = gridDim.x * gridDim.y * gridDim.z;
    unsigned sum, cnt, mine, sp = 0u;
    for (;;) {
        sum = 0u; cnt = 0u; mine = 0u;
#pragma nounroll
        for (unsigned j = 0; j < 16; ++j) { const unsigned c = xb_ld(&bar[XB_XCNT(j)]); sum += c; cnt += (c > 0u) ? 1u : 0u; mine = (j == x) ? c : mine; }
        if (sum == G) break;
        __builtin_amdgcn_s_sleep(1);
        if ((++sp & 255u) == 0u) { if (xb_ld(&bar[XB_TMO])) break; if (sp > XB_SPIN_CAP) { atomicAdd(&bar[XB_TMO], 1u); break; } }
    }
    nloc = mine > 0u ? mine : 1u; nx = cnt > 0u ? cnt : 1u;
}
__device__ __forceinline__ void xcd_barrier_setup(const XcdBarrier& b) {
    if (threadIdx.x == 0) { unsigned nloc, nx; xcd_barrier_complete(b.bar, b.x, nloc, nx); b.st[0] = nloc; b.st[1] = nx; }
    __syncthreads();
}
__device__ __forceinline__ void xcd_barrier(const XcdBarrier& b) {
    asm volatile("s_waitcnt vmcnt(0)" ::: "memory");
    __syncthreads();
    if (opaque_tid() == 0) {
        unsigned* bar = b.bar;
        __builtin_amdgcn_s_waitcnt(0);
        const unsigned nloc = b.st[0], nx = b.st[1];
        const unsigned old = xb_add(&bar[XB_XSUB(b.x)], 1u);
        const unsigned gen = old / nloc;
        if (old + 1u == (gen + 1u) * nloc) {
            __builtin_amdgcn_fence(__ATOMIC_RELEASE, "agent");
            asm volatile("s_waitcnt vmcnt(0)" ::: "memory");
            const unsigned og = xb_add(&bar[XB_TOP], 1u);
            const unsigned tg = og / nx;
            if (og + 1u == (tg + 1u) * nx) xb_add(&bar[XB_TOPGEN], 1u);
            else XB_SPIN(xb_ld(&bar[XB_TOPGEN]) == tg, bar);
            __builtin_amdgcn_fence(__ATOMIC_ACQUIRE, "agent");
            xb_add(&bar[XB_XGEN(b.x)], 1u);
            asm volatile("s_waitcnt vmcnt(0)" ::: "memory");
        } else {
            XB_SPIN(xb_ld(&bar[XB_XGEN(b.x)]) == gen, bar);
            __builtin_amdgcn_fence(__ATOMIC_ACQUIRE, "agent");
            asm volatile("s_waitcnt vmcnt(0)" ::: "memory");
        }
    }
    __syncthreads();
}

struct Args { const void* in[35]; float* out; unsigned char* ws; int ph_lo, ph_hi; };
struct PTab { volatile LAS unsigned long long* t; __device__ __forceinline__ const void* operator[](int i) const { const unsigned long long v = t[i];
    const unsigned lo_ = __builtin_amdgcn_readfirstlane((unsigned)v), hi_ = __builtin_amdgcn_readfirstlane((unsigned)(v >> 32)); return (const void*)(GAS const char*)(((unsigned long long)hi_ << 32) | lo_); } };
struct ArgsD { PTab in; unsigned char* ws; };
enum { I_X = 0, I_MEM, I_POS, I_WIN, I_WQUP, I_WKVUP, I_QNG, I_KVNG, I_DLAM, I_SUBLN, I_LRE, I_LIM, I_BRE, I_BIM, I_CRE, I_CIM, I_SSMD, I_LOGDT, I_GLUW, I_WBR, I_WOUT, I_LNMG, I_LNMB,
       I_WXQ, I_WXKV, I_WXO, I_LNXG, I_LNXB, I_FGU, I_FDN, I_ROUTER, I_MGU, I_MDN, I_LNFG, I_LNFB };
constexpr int NPL = 16, NPHASE = 1 + DEPTH * NPL;
constexpr int LDS_BYTES = 147456;
constexpr int LDS_MISC = 131072 + 8192;

__device__ __forceinline__ float lam_init_of(int l) { return l == 0 ? 0.2f : 0.35550906759f; }

struct Mat { const float* src; bf16_t* dst; int K, N, kind; const float* ksc; int kmod; float kmul; int fp8; };
__device__ __forceinline__ int map_row(int kind, int n, int N) {
    if (kind == 0) return n;
    if (kind == 1) {
        if (n < 2048) { const int hc = n & 63; if (hc < 16) return (n - hc) + (hc < 8 ? 2 * hc : 2 * (hc - 8) + 1); return n; }
        if (n < 3840) return n;
        if (n < 3904) { const int hc = n - 3840; return 3840 + (hc < 32 ? 2 * hc : 2 * (hc - 32) + 1); }
        return n + 192;
    }
    if (kind == 2) { const int h = n / 192; int hc = n - h * 192; if (hc >= 128) { const int r = hc - 128; hc = 128 + (r < 32 ? 2 * r : 2 * (r - 32) + 1); } return h * 192 + hc; }
    const int half = N >> 1;
    if (n < half) return (n >> 7) * 256 + (n & 127);
    const int mm = n - half; return (mm >> 7) * 256 + 128 + (mm & 127);
}
__device__ __forceinline__ Mat get_mat(const ArgsD& a, int id) {
    Mat m; m.ksc = nullptr; m.kmod = 1; m.kmul = 1.f; m.kind = 0; m.fp8 = 0;
    unsigned char* ws = a.ws;
    if (id < 22) { const int l = id / 11, k = id % 11; unsigned char* lw = ws + WS_W + (size_t)l * LW_BYTES;
        switch (k) {
        case 0: m.src = (const float*)a.in[I_WIN] + (size_t)l * D * NIN_SRC; m.dst = (bf16_t*)(lw + LW_IN); m.K = D; m.N = NIN_SRC; m.kind = 1; break;
        case 1: m.src = (const float*)a.in[I_WQUP] + (size_t)l * 512 * 1536; m.dst = (bf16_t*)(lw + LW_QUP); m.K = 512; m.N = 1536; m.kind = 2; m.ksc = (const float*)a.in[I_QNG] + l * 512; m.kmod = 512; break;
        case 2: m.src = (const float*)a.in[I_WKVUP] + (size_t)l * 256 * 2048; m.dst = (bf16_t*)(lw + LW_KVUP); m.K = 256; m.N = 2048; m.ksc = (const float*)a.in[I_KVNG] + l * 256; m.kmod = 256; break;
        case 3: m.src = (const float*)a.in[I_GLUW] + (size_t)l * 1024 * 2048; m.dst = (bf16_t*)(lw + LW_GLU); m.K = 1024; m.N = 2048; m.kind = 3; break;
        case 4: m.src = (const float*)a.in[I_WBR] + (size_t)(l * 3 + 0) * 1024 * 2048; m.dst = (bf16_t*)(lw + LW_BR); m.K = 1024; m.N = 2048; m.ksc = (const float*)a.in[I_SUBLN] + l * 128; m.kmod = 128; m.kmul = 1.f - lam_init_of(l); break;
        case 5: m.src = (const float*)a.in[I_WBR] + (size_t)(l * 3 + 1) * 1024 * 2048; m.dst = (bf16_t*)(lw + LW_BR + 4 * MiB); m.K = 1024; m.N = 2048; break;
        case 6: m.src = (const float*)a.in[I_WBR] + (size_t)(l * 3 + 2) * 1024 * 2048; m.dst = (bf16_t*)(lw + LW_BR + 8 * MiB); m.K = 1024; m.N = 2048; break;
        case 7: m.src = (const float*)a.in[I_WOUT] + (size_t)l * 2048 * 2048; m.dst = (bf16_t*)(lw + LW_OUT); m.K = 2048; m.N = 2048; break;
        case 8: m.src = (const float*)a.in[I_WXQ] + (size_t)l * 2048 * 512; m.dst = (bf16_t*)(lw + LW_XQ); m.K = 2048; m.N = 512; break;
        case 9: m.src = (const float*)a.in[I_WXKV] + (size_t)l * 2048 * 1024; m.dst = (bf16_t*)(lw + LW_XKV); m.K = 2048; m.N = 1024; break;
        default: m.src = (const float*)a.in[I_WXO] + (size_t)l * 512 * 2048; m.dst = (bf16_t*)(lw + LW_XO); m.K = 512; m.N = 2048; break;
        }
    } else if (id == 22) { m.src = (const float*)a.in[I_FGU]; m.dst = (bf16_t*)(ws + WS_FFN); m.K = D; m.N = 2 * DFF; m.kind = 3; }
    else if (id == 23) { m.src = (const float*)a.in[I_FDN]; m.dst = (bf16_t*)(ws + WS_FFN + 44 * MiB); m.K = DFF; m.N = D; }
    else { const int e = (id - 24) >> 1;
        m.fp8 = 1;
        if (((id - 24) & 1) == 0) { m.src = (const float*)a.in[I_MGU] + (size_t)e * D * 2 * DFF; m.dst = (bf16_t*)(ws + WS_MOE + (size_t)e * 66 * MiB); m.K = D; m.N = 2 * DFF; m.kind = 3; m.kmul = 64.f; }
        else { m.src = (const float*)a.in[I_MDN] + (size_t)e * DFF * D; m.dst = (bf16_t*)(ws + WS_MOE + (size_t)e * 66 * MiB + 44 * MiB); m.K = DFF; m.N = D; m.kmul = 256.f; }
    }
    return m;
}
constexpr int NMAT = 40;
__device__ __forceinline__ void cvt_item(const Mat& mt, LAS float* scr, int item, int lane) {
    const int nblk = mt.N / 64, kb = item / nblk, nb = item - kb * nblk, k0 = 64 * kb, n0 = 64 * nb;
    const bool g8 = mt.kind == 1 && n0 >= 3072;
    const bool f8 = mt.fp8 || g8; const float kmul = g8 ? 64.f : mt.kmul;
    const int lr = lane >> 4, lc = (lane & 15) * 4;
    f32x4 v[16];
#pragma unroll
    for (int i = 0; i < 16; ++i) v[i] = *(const f32x4*)(mt.src + (size_t)(k0 + 4 * i + lr) * mt.N + n0 + lc);
    if (mt.ksc) {
#pragma unroll
        for (int i = 0; i < 16; ++i) v[i] = v[i] * (mt.ksc[(k0 + 4 * i + lr) % mt.kmod] * mt.kmul); }
    else if (f8) {
#pragma unroll
        for (int i = 0; i < 16; ++i) v[i] = v[i] * kmul; }
#pragma unroll
    for (int i = 0; i < 16; ++i) { LAS float* p = scr + (4 * i + lr) * 65 + lc; p[0] = v[i][0]; p[1] = v[i][1]; p[2] = v[i][2]; p[3] = v[i][3]; }
    LDS_WAIT(); asm volatile("" ::: "memory");
    const int c = lane & 7;
#pragma unroll
    for (int j = 0; j < 8; ++j) { const int n = (lane >> 3) + 8 * j; const LAS float* s = scr + (8 * c) * 65 + n;
        if (f8) { const u32x2 o = pack8_fp8((f32x4){s[0 * 65], s[1 * 65], s[2 * 65], s[3 * 65]}, (f32x4){s[4 * 65], s[5 * 65], s[6 * 65], s[7 * 65]}); const int r_ = map_row(mt.kind, n0 + n, mt.N);
            unsigned char* d8 = g8 ? (unsigned char*)mt.dst + (size_t)NIN_BF * mt.K * 2 + (size_t)(r_ - NIN_BF) * mt.K : (unsigned char*)mt.dst + (size_t)r_ * mt.K;
            *(u32x2*)(d8 + k0 + 8 * c) = o; }
        else { u32x4 o; o.x = cvt_pk_bf16(s[0 * 65], s[1 * 65]); o.y = cvt_pk_bf16(s[2 * 65], s[3 * 65]); o.z = cvt_pk_bf16(s[4 * 65], s[5 * 65]); o.w = cvt_pk_bf16(s[6 * 65], s[7 * 65]);
            *(u32x4*)(mt.dst + (size_t)map_row(mt.kind, n0 + n, mt.N) * mt.K + k0 + 8 * c) = o; } }
    LDS_WAIT(); asm volatile("" ::: "memory");
}
__device__ __forceinline__ void cvt_tile_wg(const Mat& mt, LAS float* scr, int tile, int tid) {
    const int nblk = mt.N / 256, kb = tile / nblk, nb = tile - kb * nblk, k0 = 64 * kb, n0 = 256 * nb;
    const int lane = tid & 63, w = tid >> 6;
    f32x4 v[8];
#pragma unroll
    for (int i = 0; i < 8; ++i) v[i] = *(const f32x4*)(mt.src + (size_t)(k0 + 8 * w + i) * mt.N + n0 + lane * 4);
    if (mt.ksc) {
#pragma unroll
        for (int i = 0; i < 8; ++i) v[i] = v[i] * (mt.ksc[(k0 + 8 * w + i) % mt.kmod] * mt.kmul); }
    else if (mt.fp8) {
#pragma unroll
        for (int i = 0; i < 8; ++i) v[i] = v[i] * mt.kmul; }
#pragma unroll
    for (int i = 0; i < 8; ++i) { LAS float* p = scr + (8 * w + i) * 257 + lane * 4; p[0] = v[i][0]; p[1] = v[i][1]; p[2] = v[i][2]; p[3] = v[i][3]; }
    __syncthreads();
    const int c = tid & 7;
#pragma unroll
    for (int j = 0; j < 4; ++j) { const int n = (tid >> 3) + 64 * j; const LAS float* s = scr + (8 * c) * 257 + n; const int r_ = map_row(mt.kind, n0 + n, mt.N);
        if (mt.fp8) *(u32x2*)((unsigned char*)mt.dst + (size_t)r_ * mt.K + k0 + 8 * c) = pack8_fp8((f32x4){s[0 * 257], s[1 * 257], s[2 * 257], s[3 * 257]}, (f32x4){s[4 * 257], s[5 * 257], s[6 * 257], s[7 * 257]});
        else { u32x4 o; o.x = cvt_pk_bf16(s[0 * 257], s[1 * 257]); o.y = cvt_pk_bf16(s[2 * 257], s[3 * 257]); o.z = cvt_pk_bf16(s[4 * 257], s[5 * 257]); o.w = cvt_pk_bf16(s[6 * 257], s[7 * 257]);
            *(u32x4*)(mt.dst + (size_t)r_ * mt.K + k0 + 8 * c) = o; } }
    __syncthreads();
}
__device__ __forceinline__ void ssm_build(const ArgsD& a, int l, int g, LAS unsigned char* lds) {
    LAS float* Ap = (LAS float*)lds;
    LAS float* Bb = Ap + 33 * 64 * 2;
    LAS float* Cc = Bb + 64 * 16 * 2;
    LAS float* Mk = Cc + 16 * 64 * 2;
    const int tid = opaque_tid();
    const float* lre = (const float*)a.in[I_LRE] + (l * 64 + g) * 64; const float* lim = (const float*)a.in[I_LIM] + (l * 64 + g) * 64;
    const float* bre = (const float*)a.in[I_BRE] + (size_t)(l * 64 + g) * 1024; const float* bim = (const float*)a.in[I_BIM] + (size_t)(l * 64 + g) * 1024;
    const float* cre = (const float*)a.in[I_CRE] + (size_t)(l * 64 + g) * 1024; const float* cim = (const float*)a.in[I_CIM] + (size_t)(l * 64 + g) * 1024;
    const double dt = exp((double)((const float*)a.in[I_LOGDT])[l * 64 + g]);
    for (int idx = tid; idx < 33 * 64; idx += 512) { const int n = idx & 63, k = idx >> 6; const double re = lre[n], im = lim[n];
        const double mag = exp(re * dt * k), ang = im * dt * k; Ap[idx * 2] = (float)(mag * cos(ang)); Ap[idx * 2 + 1] = (float)(mag * sin(ang)); }
    if (tid < 64) { float* a32 = (float*)(a.ws + WS_A32) + (size_t)((l * 64 + g) * 64 + tid) * 2; const double re = lre[tid], im = lim[tid]; const double mag = exp(32.0 * re * dt), ang = 32.0 * im * dt;
        a32[0] = (float)(mag * cos(ang)); a32[1] = (float)(mag * sin(ang)); }
    for (int idx = tid; idx < 1024; idx += 512) { const int n = idx >> 4; const double re = lre[n], im = lim[n]; const double mag = exp(re * dt), ang = im * dt;
        const double lr = mag * cos(ang) - 1.0, li = mag * sin(ang), den = re * re + im * im;
        const double fr_ = (lr * re + li * im) / den, fi_ = (li * re - lr * im) / den; const double br = bre[idx], bi = bim[idx];
        Bb[idx * 2] = (float)(fr_ * br - fi_ * bi); Bb[idx * 2 + 1] = (float)(fr_ * bi + fi_ * br);
        Cc[idx * 2] = cre[idx]; Cc[idx * 2 + 1] = cim[idx]; }
    __syncthreads();
    for (int idx = tid; idx < 32 * 256; idx += 512) { const int k = idx >> 8, p = (idx >> 4) & 15, q = idx & 15; float s = 0.f;
        for (int n = 0; n < 64; ++n) { const float ar = Ap[(k * 64 + n) * 2], ai = Ap[(k * 64 + n) * 2 + 1], br = Bb[(n * 16 + q) * 2], bi = Bb[(n * 16 + q) * 2 + 1];
            const float tr = ar * br - ai * bi, ti = ar * bi + ai * br; s += Cc[(p * 64 + n) * 2] * tr - Cc[(p * 64 + n) * 2 + 1] * ti; }
        Mk[idx] = s; }
    __syncthreads();
    unsigned char* lw = a.ws + WS_W + (size_t)l * LW_BYTES;
    bf16_t* T = (bf16_t*)(lw + LW_TEXT) + (size_t)g * 512 * SSM_KX; bf16_t* W = (bf16_t*)(lw + LW_WSL) + (size_t)g * 256 * 512;
    { const int R = tid, i = R >> 4, p = R & 15; bf16_t* row = T + (size_t)R * SSM_KX;
        for (int ch = 0; ch < 64; ++ch) { const int j = ch >> 1, q0 = (ch & 1) * 8; u32x4 w = {0u, 0u, 0u, 0u};
            if (j <= i) { const LAS float* mp = Mk + ((i - j) * 16 + p) * 16 + q0; w.x = cvt_pk_bf16(mp[0], mp[1]); w.y = cvt_pk_bf16(mp[2], mp[3]); w.z = cvt_pk_bf16(mp[4], mp[5]); w.w = cvt_pk_bf16(mp[6], mp[7]); }
            *(u32x4*)(row + ch * 8) = w; }
        for (int ch = 0; ch < 16; ++ch) { float v[8];
#pragma unroll
            for (int e = 0; e < 4; ++e) { const int n = ch * 4 + e; const float cr = Cc[(p * 64 + n) * 2], ci = Cc[(p * 64 + n) * 2 + 1], ar = Ap[((i + 1) * 64 + n) * 2], ai = Ap[((i + 1) * 64 + n) * 2 + 1];
                v[2 * e] = cr * ar - ci * ai; v[2 * e + 1] = -(cr * ai + ci * ar); }
            u32x4 w; w.x = cvt_pk_bf16(v[0], v[1]); w.y = cvt_pk_bf16(v[2], v[3]); w.z = cvt_pk_bf16(v[4], v[5]); w.w = cvt_pk_bf16(v[6], v[7]);
            *(u32x4*)(row + 512 + ch * 8) = w; } }
    if (tid < 256) { const int R = tid; bf16_t* row = W + (size_t)R * 512;
        for (int ch = 0; ch < 64; ++ch) { u32x4 w = {0u, 0u, 0u, 0u};
            if (R < 128) { const int n = R >> 1, im = R & 1, j = ch >> 1, q0 = (ch & 1) * 8; float v[8]; const float ar = Ap[((31 - j) * 64 + n) * 2], ai = Ap[((31 - j) * 64 + n) * 2 + 1];
#pragma unroll
                for (int e = 0; e < 8; ++e) { const float br = Bb[(n * 16 + q0 + e) * 2], bi = Bb[(n * 16 + q0 + e) * 2 + 1]; v[e] = im ? (ar * bi + ai * br) : (ar * br - ai * bi); }
                w.x = cvt_pk_bf16(v[0], v[1]); w.y = cvt_pk_bf16(v[2], v[3]); w.z = cvt_pk_bf16(v[4], v[5]); w.w = cvt_pk_bf16(v[6], v[7]); }
            *(u32x4*)(row + ch * 8) = w; } }
    __syncthreads();
}

struct LnArgs { bf16_t* X; float* outf; unsigned char* outq; const float* g; const float* b;
                const float* og; const int* slot; int* r_e; float* r_w; unsigned* cnt; };
template <int MODE>
__device__ __forceinline__ void ln_phase(const LnArgs& A, LAS unsigned char* lds, int G) {
    const int tid = opaque_tid(), lane = tid & 63, wave = __builtin_amdgcn_readfirstlane(tid >> 6);
    const int gw = blockIdx.x * 8 + wave, NGW = G * 8;
    f32x4 gv[8], bv[8];
    if (MODE != 1) {
#pragma unroll
        for (int j = 0; j < 8; ++j) { gv[j] = *(const f32x4*)(A.g + lane * 8 + 512 * (j >> 1) + 4 * (j & 1)); bv[j] = *(const f32x4*)(A.b + lane * 8 + 512 * (j >> 1) + 4 * (j & 1)); } }
    for (int row = gw; row < M; row += NGW) {
        bf16_t* xr = A.X + (size_t)row * D + lane * 8;
        f32x4 v[8]; float s = 0.f;
#pragma unroll
        for (int j = 0; j < 4; ++j) { const u32x4 w = *(const u32x4*)(xr + 512 * j); v[2 * j] = (f32x4){bf_lo(w.x), bf_hi(w.x), bf_lo(w.y), bf_hi(w.y)}; v[2 * j + 1] = (f32x4){bf_lo(w.z), bf_hi(w.z), bf_lo(w.w), bf_hi(w.w)}; }
        if (MODE == 2) { const int s0 = A.slot[row * 2], s1 = A.slot[row * 2 + 1]; const float* o0 = A.og + (size_t)s0 * D + lane * 8; const float* o1 = A.og + (size_t)s1 * D + lane * 8;
#pragma unroll
            for (int j = 0; j < 8; ++j) { const int e = 512 * (j >> 1) + 4 * (j & 1); v[j] = v[j] * ALPHA + *(const f32x4*)(o0 + e) + *(const f32x4*)(o1 + e); } }
#pragma unroll
        for (int j = 0; j < 8; ++j) s += (v[j][0] + v[j][1]) + (v[j][2] + v[j][3]);
        const float mean = wave_sum(s, lane) * (1.f / D); float s2 = 0.f;
#pragma unroll
        for (int j = 0; j < 8; ++j) { v[j] = v[j] - mean; s2 += (v[j][0] * v[j][0] + v[j][1] * v[j][1]) + (v[j][2] * v[j][2] + v[j][3] * v[j][3]); }
        const float rstd = 1.f / sqrtf(wave_sum(s2, lane) * (1.f / D) + LN_EPS);
#pragma unroll
        for (int j = 0; j < 8; ++j) { if (MODE == 1) { gv[j] = *(const f32x4*)(A.g + lane * 8 + 512 * (j >> 1) + 4 * (j & 1)); bv[j] = *(const f32x4*)(A.b + lane * 8 + 512 * (j >> 1) + 4 * (j & 1)); }
            v[j] = v[j] * rstd * gv[j] + bv[j]; }
        if (A.outf) { float* of = A.outf + (size_t)row * D + lane * 8;
#pragma unroll
            for (int j = 0; j < 8; ++j) *(f32x4*)(of + 512 * (j >> 1) + 4 * (j & 1)) = v[j]; }
        else {
#pragma unroll
            for (int j = 0; j < 4; ++j) *(u32x4*)(xr + 512 * j) = pack8(v[2 * j], v[2 * j + 1]); }
        if (A.outq) { unsigned char* oq = A.outq + (size_t)row * D + lane * 8;
#pragma unroll
            for (int j = 0; j < 4; ++j) *(u32x2*)(oq + 512 * j) = pack8_fp8(v[2 * j], v[2 * j + 1]); }
        if (MODE == 1) {
            const LAS float* wr_ = (const LAS float*)lds;
            int i0 = 0, i1 = 0; float v0 = -__builtin_inff(), v1 = -__builtin_inff();
#pragma unroll 1
            for (int e = 0; e < 8; ++e) { float acc = 0.f;
#pragma unroll
                for (int j = 0; j < 8; ++j) { const f32x4 w = *(const LAS f32x4*)(wr_ + e * D + lane * 8 + 512 * (j >> 1) + 4 * (j & 1)); acc += (v[j][0] * w[0] + v[j][1] * w[1]) + (v[j][2] * w[2] + v[j][3] * w[3]); }
                const float sg = wave_sum(acc, lane);
                if (sg > v0) { v1 = v0; i1 = i0; v0 = sg; i0 = e; } else if (sg > v1) { v1 = sg; i1 = e; } }
            const float w0 = 1.f / (1.f + expf(v1 - v0)), w1 = 1.f - w0;
            if (lane == 0) { A.r_e[row * 2] = i0; A.r_e[row * 2 + 1] = i1; A.r_w[row * 2] = w0; A.r_w[row * 2 + 1] = w1;
                __hip_atomic_fetch_add(A.cnt + i0, 1u, RLX_AGENT); __hip_atomic_fetch_add(A.cnt + i1, 1u, RLX_AGENT); }
        }
    }
}
__device__ __forceinline__ void moe_offsets(const unsigned* cnt, int (&off)[9]) {
    int acc = 0;
#pragma unroll
    for (int e = 0; e < 8; ++e) { off[e] = acc; const int c = (int)__hip_atomic_load(cnt + e, RLX_AGENT); acc += ((c + 255) >> 8) << 8; }
    off[8] = acc;
}

struct AttPtrs { const bf16_t *QD, *KD, *VD, *QM, *KM, *VM; bf16_t *BR0, *BR1; };
__device__ __forceinline__ void mla_unit(const AttPtrs& P, int h, int qb, char* lds) {
    const int tid = opaque_tid(), wid = __builtin_amdgcn_readfirstlane(tid >> 6), lane = tid & 63, r32 = lane & 31, hi = lane >> 5;
    const int q0 = qb * 256 + wid * 32; f32x16 o[4]; float l;
    att::attn_core_pp<192, 12, true, false>(P.QM + (size_t)(q0 + r32) * 1536 + h * 192 + hi * 8, P.KM + h * 192, 1536, P.VM + h * 128, 1024, 4 * (qb + 1), q0 + r32, q0, 0, lds, o, l);
    float* ws = (float*)(lds + 3 * att::SHM_V + 3 * 64 * 384) + wid * 64;
    att::normalize_o(o, l, ws, r32, hi);
    att::store_o_bf16(o, P.BR1 + (size_t)q0 * 1024 + h * 128, 1024, r32, hi);
    __syncthreads();
}
__device__ __forceinline__ void diff_unit(const AttPtrs& P, int h, int qb, float lam, char* lds) {
    const int tid = opaque_tid(), wid = __builtin_amdgcn_readfirstlane(tid >> 6), lane = tid & 63, r32 = lane & 31, hi = lane >> 5;
    const int mp = wid >> 2, w4 = wid & 3, q0 = qb * 128 + w4 * 32; f32x16 o[4]; float l;
    att::attn_core_pp<128, 4, true, true>(P.QD + (size_t)(q0 + r32) * 1024 + h * 128 + mp * 64 + hi * 8, P.KD + h * 128, 1024, P.VD + h * 128, 1024, 2 * (qb + 1), q0 + r32, q0, mp * 8, lds, o, l);
    float* ws = (float*)(lds + 3 * att::SHM_V + 3 * 64 * 256) + wid * 64;
    att::normalize_o(o, l, ws, r32, hi);
    __syncthreads();
    float* xch = (float*)lds + w4 * 4096 + lane;
    if (mp == 1) {
#pragma unroll
        for (int d0 = 0; d0 < 4; ++d0)
#pragma unroll
            for (int r = 0; r < 16; ++r) xch[(d0 * 16 + r) * 64] = o[d0][r];
    }
    __syncthreads();
    if (mp == 0) {
        float ss[16];
#pragma unroll
        for (int r = 0; r < 16; ++r) { float s = 0.f;
#pragma unroll
            for (int d0 = 0; d0 < 4; ++d0) { const float dv = o[d0][r] - lam * xch[(d0 * 16 + r) * 64]; o[d0][r] = dv; s += dv * dv; }
            ss[r] = s; }
#pragma unroll
        for (int r = 0; r < 16; ++r) { float s = ss[r];
#pragma unroll
            for (int off = 1; off < 32; off <<= 1) s += shflx(s, off, lane);
            const float rs = __builtin_amdgcn_rsqf(s * (1.f / 128.f) + RMS_EPS);
#pragma unroll
            for (int d0 = 0; d0 < 4; ++d0) o[d0][r] *= rs; }
        att::store_o_bf16(o, P.BR0 + (size_t)q0 * 1024 + h * 128, 1024, r32, hi);
    }
    __syncthreads();
}
__device__ __forceinline__ void cross_unit(const bf16_t* XQ, const bf16_t* XKV, bf16_t* XO, int h, int qb, char* lds) {
    const int tid = opaque_tid(), wid = __builtin_amdgcn_readfirstlane(tid >> 6), lane = tid & 63, r32 = lane & 31, hi = lane >> 5;
    const int q0 = qb * 256 + wid * 32; f32x16 o[4]; float l;
    att::attn_core<128, 8, false, true>(XQ + (size_t)(q0 + r32) * 512 + h * 128 + hi * 8, XKV + h * 128, 1024, XKV + 512 + h * 128, 1024, 4, 0, 0, 0, lds, o, l);
    float* ws = (float*)(lds + 2 * att::SHM_V + 2 * 64 * 256) + wid * 64;
    att::normalize_o(o, l, ws, r32, hi);
    att::store_o_bf16(o, XO + (size_t)q0 * 512 + h * 128, 512, r32, hi);
    __syncthreads();
}

__global__ void __launch_bounds__(512, 2) fwd_kernel(Args args) {
    extern __shared__ __attribute__((aligned(16))) unsigned char lds_raw[];
    LAS unsigned char* lds = (LAS unsigned char*)lds_raw;
    const int tid = threadIdx.x, lane = tid & 63, wave = __builtin_amdgcn_readfirstlane(tid >> 6);
    const int G = gridDim.x, bx = blockIdx.x;
    unsigned char* ws = (unsigned char*)(GAS unsigned char*)(unsigned long long)args.ws;
    unsigned* ctl = (unsigned*)(ws + WS_CTL);
    volatile LAS unsigned* MISC = (volatile LAS unsigned*)(lds + LDS_MISC);
    if (tid < 32) MISC[tid] = 0u;
    if (lane == 0) ((volatile LAS int*)LDS_WTAB)[__builtin_amdgcn_s_getreg(0x2804)] = wave;
    { volatile LAS unsigned long long* pt = (volatile LAS unsigned long long*)(lds + LDS_MISC + 256); if (tid < 35) pt[tid] = (unsigned long long)args.in[tid]; if (tid == 35) pt[35] = (unsigned long long)args.out; }
    __syncthreads();
    ArgsD ad; ad.in.t = (volatile LAS unsigned long long*)(lds + LDS_MISC + 256); ad.ws = ws;
    const int lo = args.ph_lo, hi = args.ph_hi;
    XcdBarrier bar; bar.bar = ctl + CW_BAR; bar.x = 0; bar.st = nullptr;
    if (hi - lo > 1) { bar = xcd_barrier_post(ctl + CW_BAR, MISC + 8); xcd_barrier_setup(bar); }
#ifndef PH_SEL
#define PH_SEL 0xFFFFFFFFu
#endif
#define INR(k) (lo <= (k) && (k) < hi)
#define IN0() (((PH_SEL) & 1u) && INR(0))
#define INL(j) ((((PH_SEL) >> ((j) + 1)) & 1u) && INR(pb + (j)))
#define SEAM(k) do { if (INR(k) && INR((k) + 1)) xcd_barrier(bar); } while (0)
    const int gw = bx * 8 + wave, NGW = G * 8;
    const int gtid = bx * 512 + tid, NGT = G * 512;

    if (IN0()) {
      {
        { int start = bx;
            for (int id = 0; id < NMAT; ++id) { const Mat mt = get_mat(ad, id); if (mt.kind == 1) continue; const int nit = (mt.K / 64) * (mt.N / 256);
                int it = start; for (; it < nit; it += G) cvt_tile_wg(mt, (LAS float*)lds, it, tid);
                start = it - nit; } }
        { LAS float* scr = (LAS float*)(lds + wave * 16640); int start = gw;
            for (int id = 0; id < 22; id += 11) { const Mat mt = get_mat(ad, id); const int nit = (mt.K / 64) * (mt.N / 64);
                int it = start; for (; it < nit; it += NGW) cvt_item(mt, scr, it, lane);
                start = it - nit; } }
        for (int l = 0; l < DEPTH; ++l) { u32x4* p = (u32x4*)((unsigned char*)(ws + WS_W + (size_t)l * LW_BYTES + LW_IN) + (size_t)NIN_BF * D * 2 + (size_t)(3904 - NIN_BF) * D);
            for (int i = gtid; i < 192 * D / 16; i += NGT) p[i] = (u32x4){0u, 0u, 0u, 0u}; }
        { const float* x = (const float*)ad.in[I_X]; bf16_t* xn = (bf16_t*)(ws + WS_XN);
            unsigned char* x8 = ws + WS_XN8;
            for (size_t i = gtid; i < (size_t)M * D / 8; i += NGT) { const f32x4 a = *(const f32x4*)(x + i * 8), b = *(const f32x4*)(x + i * 8 + 4); *(u32x4*)(xn + i * 8) = pack8(a, b); *(u32x2*)(x8 + i * 8) = pack8_fp8(a, b); }
            const float* mem = (const float*)ad.in[I_MEM]; bf16_t* mb = (bf16_t*)(ws + WS_MEMB);
            for (int i = gtid; i < MEM_LEN * D / 8; i += NGT) { const f32x4 a = *(const f32x4*)(mem + i * 8), b = *(const f32x4*)(mem + i * 8 + 4); *(u32x4*)(mb + i * 8) = pack8(a, b); } }
        { const int* pos = (const int*)ad.in[I_POS]; float* td = (float*)(ws + WS_TABD); float* tm = (float*)(ws + WS_TABM);
            for (int i = gtid; i < M * 40; i += NGT) { const int t = i / 40, k = i - t * 40; const double p = (double)pos[t];
                const double inv = (k < 8) ? exp(-(double)k * (13.122363377404328 / 8.0)) : exp(-(double)(k - 8) * (13.122363377404328 / 32.0));
                const double ang = p * inv; const float c = (float)cos(ang), s = (float)sin(ang);
                if (k < 8) { td[(t * 8 + k) * 2] = c; td[(t * 8 + k) * 2 + 1] = s; } else { tm[(t * 32 + k - 8) * 2] = c; tm[(t * 32 + k - 8) * 2 + 1] = s; } } }
        if (bx == 0 && tid < 192) { int* ord = (int*)(ws + WS_ORDER); const int mine = tid < 64 ? 160 * (tid + 1) : 48 * (tid - 64 + 1); int rank = 0;
            for (int c = 0; c < 192; ++c) { const int cc = c < 64 ? 160 * (c + 1) : 48 * (c - 64 + 1); rank += (cc > mine || (cc == mine && c < tid)) ? 1 : 0; }
            const int code = tid < 64 ? ((1 << 16) | (tid << 8)) : ((tid - 64) << 8);
            for (int h = 0; h < 8; ++h) ord[rank * 8 + h] = code | h; }
        __syncthreads();
        for (int uidx = bx; uidx < DEPTH * 64; uidx += G) ssm_build(ad, uidx >> 6, uidx & 63, lds);
        __syncthreads();
      }
    }
    SEAM(0);

    unsigned char* const ws_k = ws; const int bx_k = bx;
    for (int l = 0; l < DEPTH; ++l) {
        const int pb = 1 + l * NPL;
        if (!(lo < pb + NPL && pb < hi)) continue;
        int bx = bx_k; asm volatile("" : "+s"(bx));
        unsigned long long ws_i = (unsigned long long)ws_k; asm volatile("" : "+s"(ws_i)); unsigned char* ws = (unsigned char*)(GAS unsigned char*)ws_i;
#define PH_TID const int tid = opaque_tid(), lane = tid & 63, wave = __builtin_amdgcn_readfirstlane(tid >> 6); const int gw = bx * 8 + wave, NGW = G * 8; (void)lane; (void)wave; (void)gw; (void)NGW
#define lw (ws + WS_W + (size_t)l * LW_BYTES)
#define ssq_q ((float*)(ws + WS_PSQ))
#define ssq_kv (ssq_q + (size_t)8 * M)
#define XS ((float*)(ws + WS_XS))
#define XN ((bf16_t*)(ws + WS_XN))
#define tabd ((const float*)(ws + WS_TABD))
#define tabm ((const float*)(ws + WS_TABM))
#define QD ((bf16_t*)(ws + WS_QD))
#define KD ((bf16_t*)(ws + WS_KD))
#define VD ((bf16_t*)(ws + WS_VD))
#define MQ ((bf16_t*)(ws + WS_MQ))
#define MKV ((bf16_t*)(ws + WS_MKV))
#define KM ((bf16_t*)(ws + WS_KM))
#define VM ((bf16_t*)(ws + WS_VM))
#define QM ((bf16_t*)(ws + WS_QM))
#define SU ((bf16_t*)(ws + WS_SU))
#define GATES ((bf16_t*)(ws + WS_GATES))
#define SLOC ((float*)(ws + WS_SLOC))
#define YG ((bf16_t*)(ws + WS_YG))
#define BR ((bf16_t*)(ws + WS_BR))
#define TMP ((float*)(ws + WS_TMP))
#define MG ((bf16_t*)(ws + WS_MG))
#define XQ ((bf16_t*)(ws + WS_XQ))
#define XO ((bf16_t*)(ws + WS_XO))
#define XKV ((bf16_t*)(ws + WS_XKV) + (size_t)l * 256 * 1024)
#define r_e ((int*)(ws + WS_ROUTE))
#define r_w ((float*)(ws + WS_ROUTE + 128 * 1024))
#define slot ((int*)(ws + WS_ROUTE + 256 * 1024))
#define wslot ((float*)(ws + WS_ROUTE + 384 * 1024))
        if (INL(0)) {
#if !defined(SUBSEL) || (SUBSEL & 1)
            { pg8::Gemm g{XN, (const bf16_t*)(lw + LW_IN), (D) * 2, (D) * 2, (D) * 2, 0}; SchedPlain S; S.init(M / 256, NIN_BF / 256, D, D, G, bx);
              EpiInProj E{QD, KD, VD, MQ, MKV, KM, SU, GATES, ssq_q, ssq_kv, tabd, tabm, 0};
              pg8::gemm_phase(lds, g, S, E); }
            { pg8::Gemm g{ws + WS_XN8, lw + LW_IN + (size_t)NIN_BF * D * 2, D, D, D, 0}; SchedPlain S; S.T.init(M / 256, NIN_G8 / 256); S.G = G; S.c = bx; S.tA = (size_t)256 * D; S.tB = S.tA;
              EpiInProj E{QD, KD, VD, MQ, MKV, KM, SU, GATES, ssq_q, ssq_kv, tabd, tabm, 12};
              pg8::gemm_phase_t<true, 0x7C7C7C7C>(lds, g, S, E); }
#endif
#if !defined(SUBSEL) || (SUBSEL & 2)
            { pg8::Gemm g{(const bf16_t*)(ws + WS_MEMB), (const bf16_t*)(lw + LW_XKV), (D) * 2, (D) * 2, (D) * 2, 0}; SchedPlain S; S.init(1, 4, D, D, G, (bx + 128) % G);
              EpiBf16 E{XKV, 1024, 1.f};
              pg8::gemm_phase(lds, g, S, E); }
#endif
        }
        SEAM(pb + 0);
        if (INL(1)) {
#if !defined(SUBSEL) || (SUBSEL & 1)
            { pg8::Gemm g{MQ, (const bf16_t*)(lw + LW_QUP), (512) * 2, (512) * 2, (512) * 2, 0}; SchedPlain S; S.init(M / 256, 6, 512, 512, G, bx);
              EpiQup E{QM, ssq_q, tabm}; pg8::gemm_phase(lds, g, S, E); }
#endif
#if !defined(SUBSEL) || (SUBSEL & 2)
            { pg8::Gemm g{MKV, (const bf16_t*)(lw + LW_KVUP), (256) * 2, (256) * 2, (256) * 2, 0}; SchedPlain S; S.init(M / 256, 8, 256, 256, G, (bx + 128) % G);
              EpiKVup E{KM, VM, ssq_kv}; pg8::gemm_phase(lds, g, S, E); }
#endif
#if !defined(SUBSEL) || (SUBSEL & 4)
            { pg8::Gemm g{SU, (const bf16_t*)(lw + LW_WSL), (SSM_KX) * 2, (512) * 2, (512) * 2, 0}; SchedBatch S{2, 1, 64, G, (bx + 128) % G  , (size_t)256 * SSM_KX * 2, (size_t)256 * 512 * 2, (size_t)SSM_NCH * SSM_KX * 2, (size_t)256 * 512 * 2};
              EpiSloc E{SLOC}; pg8::gemm_phase(lds, g, S, E); }
#endif
        }
        SEAM(pb + 1);
        if (INL(2)) {
            PH_TID;
            if (bx < 64) { const int g = bx, n = lane, w = wave;
                const float* a32 = (const float*)(ws + WS_A32) + (size_t)((l * 64 + g) * 64 + n) * 2; const float ar = a32[0], ai = a32[1];
                const float* __restrict__ lp = SLOC + ((size_t)g * SSM_NCH + 64 * w) * 128 + 2 * n; bf16_t* __restrict__ sp = SU + ((size_t)g * SSM_NCH + 64 * w) * SSM_KX + 512 + 2 * n;
                float br[64], bi[64]; float sr = 0.f, si = 0.f;
#pragma unroll
                for (int c0 = 0; c0 < 64; c0 += 32) { f32x2 lv[32];
#pragma unroll
                    for (int k = 0; k < 32; ++k) lv[k] = *(const f32x2*)(lp + (size_t)(c0 + k) * 128);
#pragma unroll
                    for (int k = 0; k < 32; ++k) { br[c0 + k] = sr; bi[c0 + k] = si; const float nr = ar * sr - ai * si + lv[k][0], ni = ar * si + ai * sr + lv[k][1]; sr = nr; si = ni; } }
                LAS float* ex = (LAS float*)lds;
                ex[(w * 64 + n) * 2] = sr; ex[(w * 64 + n) * 2 + 1] = si;
                float pr = ar, pi = ai;
#pragma unroll
                for (int q = 0; q < 6; ++q) { const float tr = pr * pr - pi * pi, ti = 2.f * pr * pi; pr = tr; pi = ti; }
                __syncthreads();
                float cr = 0.f, ci = 0.f;
                for (int uu = 0; uu < w; ++uu) { const float er = ex[(uu * 64 + n) * 2], ei = ex[(uu * 64 + n) * 2 + 1]; const float tr = pr * cr - pi * ci + er, ti = pr * ci + pi * cr + ei; cr = tr; ci = ti; }
#pragma unroll
                for (int k = 0; k < 64; ++k) { *(unsigned*)(sp + (size_t)k * SSM_KX) = cvt_pk_bf16(br[k] + cr, bi[k] + ci);
                    const float tr = ar * cr - ai * ci, ti = ar * ci + ai * cr; cr = tr; ci = ti; } }
        }
        SEAM(pb + 2);
        if (INL(3)) {
#if !defined(SUBSEL) || (SUBSEL & 1)
            { pg8::Gemm g{SU, (const bf16_t*)(lw + LW_TEXT), (SSM_KX) * 2, (SSM_KX) * 2, (SSM_KX) * 2, 0}; SchedBatch S{2, 2, 64, G, bx, (size_t)256 * SSM_KX * 2, (size_t)256 * SSM_KX * 2, (size_t)SSM_NCH * SSM_KX * 2, (size_t)512 * SSM_KX * 2};
              EpiSsmY E{YG, SU, (const float*)ad.in[I_SSMD] + l * 1024}; pg8::gemm_phase(lds, g, S, E); }
#endif
            PH_TID;
            const float* dl = (const float*)ad.in[I_DLAM] + l * 256;
            const float lam = expf(wave_sum(dl[lane] * dl[64 + lane], lane)) - expf(wave_sum(dl[128 + lane] * dl[192 + lane], lane)) + lam_init_of(l);
            const AttPtrs P{QD, KD, VD, QM, KM, VM, BR, BR + (size_t)M * 1024};
            const int* ord = (const int*)(ws + WS_ORDER);
            __syncthreads();
            for (;;) {
                if (tid == 0) MISC[0] = __hip_atomic_fetch_add(ctl + CW_ATTQ + 64 * l, 1u, RLX_AGENT);
                __syncthreads();
                const unsigned it = MISC[0];
                __syncthreads();
                if (it >= 1536u) break;
                const int code = ord[it], h = code & 255, qb = (code >> 8) & 255;
#if !defined(SUBSEL) || (SUBSEL & 2)
                if (code >> 16) mla_unit(P, h, qb, (char*)lds_raw);
#endif
#if !defined(SUBSEL) || (SUBSEL & 4)
                if (!(code >> 16)) diff_unit(P, h, qb, lam, (char*)lds_raw);
#endif
            }
        }
        SEAM(pb + 3);
        if (INL(4)) {
            pg8::Gemm g{YG, (const bf16_t*)(lw + LW_GLU), (1024) * 2, (1024) * 2, (1024) * 2, 0}; SchedPlain S; S.init(M / 256, 8, 1024, 1024, G, bx);
            EpiGated<0> E{BR + (size_t)2 * M * 1024, 1024}; pg8::gemm_phase(lds, g, S, E);
        }
        SEAM(pb + 4);
        if (INL(5)) {
            pg8::Gemm g{BR, (const bf16_t*)(lw + LW_BR), (1024) * 2, (1024) * 2, (1024) * 2, 0}; SchedBranch S; S.T.init(M / 256, 8); S.G = G; S.c = bx; S.tA = (size_t)256 * 1024 * 2; S.tB = S.tA; S.zA = (size_t)M * 1024 * 2; S.zB = (size_t)2048 * 1024 * 2;
            EpiBranch E{GATES, (bf16_t*)TMP, MG}; pg8::gemm_phase(lds, g, S, E);
        }
        SEAM(pb + 5);
        if (INL(6)) {
            pg8::Gemm g{MG, (const bf16_t*)(lw + LW_OUT), (D) * 2, (D) * 2, (D) * 2, 0}; SchedPlain S; S.init(M / 256, 8, D, D, G, bx);
            EpiResid E{XN}; pg8::gemm_phase(lds, g, S, E);
        }
        SEAM(pb + 6);
        if (INL(7)) { const LnArgs A{XN, nullptr, nullptr, (const float*)ad.in[I_LNMG] + l * D, (const float*)ad.in[I_LNMB] + l * D, nullptr, nullptr, nullptr, nullptr, nullptr}; ln_phase<0>(A, lds, G); }
        SEAM(pb + 7);
        if (INL(8)) {
            pg8::Gemm g{XN, (const bf16_t*)(lw + LW_XQ), (D) * 2, (D) * 2, (D) * 2, 0}; SchedPlain S; S.T.init(M / 128, 2); S.G = G; S.c = bx; S.tA = (size_t)128 * D * 2; S.tB = (size_t)256 * D * 2;
            EpiBf16Half E{XQ, 512, C2_X}; pg8::gemm_phase(lds, g, S, E);
        }
        SEAM(pb + 8);
        if (INL(9)) { for (int uidx = bx; uidx < 256; uidx += G) cross_unit(XQ, XKV, XO, uidx & 3, uidx >> 2, (char*)lds_raw); }
        SEAM(pb + 9);
        if (INL(10)) {
            pg8::Gemm g{XO, (const bf16_t*)(lw + LW_XO), (512) * 2, (512) * 2, (512) * 2, 0}; SchedPlain S; S.init(M / 256, 8, 512, 512, G, bx);
            EpiResid E{XN}; pg8::gemm_phase(lds, g, S, E);
        }
        SEAM(pb + 10);
        if (INL(11)) {
            const LnArgs A{XN, nullptr, nullptr, (const float*)ad.in[I_LNXG] + l * D, (const float*)ad.in[I_LNXB] + l * D, nullptr, nullptr, r_e, r_w, ctl + CW_MOECNT};
            if (l == 0) ln_phase<0>(A, lds, G);
            else { PH_TID; const float* rw = (const float*)ad.in[I_ROUTER]; LAS float* wl = (LAS float*)lds;
                for (int i = tid; i < D * 8; i += 512) wl[(i & 7) * D + (i >> 3)] = rw[i];
                __syncthreads(); ln_phase<1>(A, lds, G); __syncthreads(); }
        }
        SEAM(pb + 11);
        if (l == 1) {
            if (INL(12)) { PH_TID; int off[9]; moe_offsets(ctl + CW_MOECNT, off); bf16_t* XG = (bf16_t*)(ws + WS_XG);
                for (int row = gw; row < M; row += NGW) { int s0 = 0, s1 = 0;
                    if (lane == 0) { const int e0 = r_e[row * 2], e1 = r_e[row * 2 + 1];
                        s0 = off[e0] + (int)__hip_atomic_fetch_add(ctl + CW_MOECUR + e0, 1u, RLX_AGENT); s1 = off[e1] + (int)__hip_atomic_fetch_add(ctl + CW_MOECUR + e1, 1u, RLX_AGENT);
                        slot[row * 2] = s0; slot[row * 2 + 1] = s1; wslot[s0] = r_w[row * 2]; wslot[s1] = r_w[row * 2 + 1]; }
                    s0 = __builtin_amdgcn_readfirstlane(s0); s1 = __builtin_amdgcn_readfirstlane(s1);
                    const u32x4* src = (const u32x4*)(XN + (size_t)row * D) + lane; u32x2* d0 = (u32x2*)((unsigned char*)XG + (size_t)s0 * D) + lane; u32x2* d1 = (u32x2*)((unsigned char*)XG + (size_t)s1 * D) + lane;
#pragma unroll
                    for (int j = 0; j < 4; ++j) { const u32x4 v = src[64 * j];
                        const u32x2 q = pack8_fp8((f32x4){bf_lo(v.x), bf_hi(v.x), bf_lo(v.y), bf_hi(v.y)}, (f32x4){bf_lo(v.z), bf_hi(v.z), bf_lo(v.w), bf_hi(v.w)}); d0[64 * j] = q; d1[64 * j] = q; } } }
            SEAM(pb + 12);
        }
        if (INL(13)) {
            if (l == 0) { pg8::Gemm g{XN, (const bf16_t*)(ws + WS_FFN), (D) * 2, (D) * 2, (D) * 2, 0}; SchedPlain S; S.init(M / 256, 44, D, D, G, bx);
                EpiGated<1> E{(bf16_t*)(ws + WS_HG), DFF}; pg8::gemm_phase(lds, g, S, E); }
            else { int off[9]; moe_offsets(ctl + CW_MOECNT, off);
                pg8::Gemm g{ws + WS_XG, ws + WS_MOE, D, D, D, 0x7C7C7C7C}; SchedMoe S; S.T.init(off[8] >> 8, 44); S.G = G; S.c = bx; S.tA = (size_t)256 * D; S.tB = S.tA; S.zB = 66 * MiB;
#pragma unroll
                for (int k = 0; k < 7; ++k) S.off[k] = off[k + 1];
                EpiSwigluF8 E{ws + WS_HG, DFF}; pg8::gemm_phase_t<true, 0x7C7C7C7C>(lds, g, S, E); }
        }
        SEAM(pb + 13);
        if (INL(14)) {
            if (l == 0) { pg8::Gemm g{(const bf16_t*)(ws + WS_HG), (const bf16_t*)(ws + WS_FFN + 44 * MiB), (DFF) * 2, (DFF) * 2, (DFF) * 2, 0}; SchedPlain S; S.init(M / 256, 8, DFF, DFF, G, bx);
                EpiResid E{XN}; pg8::gemm_phase(lds, g, S, E); }
            else { int off[9]; moe_offsets(ctl + CW_MOECNT, off);
                pg8::Gemm g{ws + WS_HG, ws + WS_MOE + 44 * MiB, DFF, DFF, DFF, 0x7B7B7B7B}; SchedMoe S; S.T.init(off[8] >> 8, 8); S.G = G; S.c = bx; S.tA = (size_t)256 * DFF; S.tB = S.tA; S.zB = 66 * MiB;
#pragma unroll
                for (int k = 0; k < 7; ++k) S.off[k] = off[k + 1];
                EpiMoeDown E{(float*)(ws + WS_OG), wslot}; pg8::gemm_phase_t<true, 0x7B7B7B7B>(lds, g, S, E); }
        }
        SEAM(pb + 14);
        if (INL(15)) {
            const LnArgs A{XN, (l == DEPTH - 1) ? (float*)ad.in[35] : nullptr, (l == DEPTH - 1) ? nullptr : ws + WS_XN8, (const float*)ad.in[I_LNFG] + l * D, (const float*)ad.in[I_LNFB] + l * D, (const float*)(ws + WS_OG), slot, nullptr, nullptr, nullptr};
            if (l == 0) ln_phase<0>(A, lds, G); else ln_phase<2>(A, lds, G);
        }
        SEAM(pb + 15);
    }
#undef INR
#undef IN0
#undef INL
#undef SEAM
}

extern "C" void kernel_launch(void* const* d_in, const int* in_sizes, int n_in, void* d_out, int out_size, void* d_ws, size_t ws_size, hipStream_t stream) {
    static int grid = 0;
    if (grid == 0) {
        if (n_in != 35 || out_size != M * D || ws_size < WS_END) { fprintf(stderr, "kernel_launch: shape/workspace mismatch: n_in %d out %d ws %zu (need %zu)\n", n_in, out_size, ws_size, (size_t)WS_END); grid = -1; return; }
        int dev = 0, cus = 0, per_cu = 0;
        if (hipGetDevice(&dev) != hipSuccess || hipDeviceGetAttribute(&cus, hipDeviceAttributeMultiprocessorCount, dev) != hipSuccess) { grid = -1; return; }
        if (hipFuncSetAttribute((const void*)fwd_kernel, hipFuncAttributeMaxDynamicSharedMemorySize, LDS_BYTES) != hipSuccess) { fprintf(stderr, "kernel_launch: hipFuncSetAttribute failed\n"); grid = -1; return; }
        if (hipOccupancyMaxActiveBlocksPerMultiprocessor(&per_cu, (const void*)fwd_kernel, 512, LDS_BYTES) != hipSuccess || per_cu < 1) { fprintf(stderr, "kernel_launch: occupancy query says %d\n", per_cu); }
        (void)hipGetLastError();
        grid = cus;
    }
    if (grid < 0) return;
    if (hipMemsetAsync((char*)d_ws + WS_CTL, 0, CTL_ZERO_BYTES, stream) != hipSuccess) return;
    Args a{};
    for (int i = 0; i < 35; ++i) a.in[i] = d_in[i];
    a.out = (float*)d_out; a.ws = (unsigned char*)d_ws;
#if MK_MULTI
    for (int p = 0; p < NPHASE; ++p) { if (p == 1 + 12) continue; a.ph_lo = p; a.ph_hi = p + 1; hipLaunchKernelGGL(fwd_kernel, dim3(grid), dim3(512), LDS_BYTES, stream, a); }
#else
    a.ph_lo = 0; a.ph_hi = NPHASE;
    hipLaunchKernelGGL(fwd_kernel, dim3(grid), dim3(512), LDS_BYTES, stream, a);
#endif
    const hipError_t le = hipPeekAtLastError();
    if (le != hipSuccess) fprintf(stderr, "kernel_launch: launch failed: %s\n", hipGetErrorName(le));
}
```

```cpp
#include <hip/hip_runtime.h>
#include <cstdio>
#include <cstdint>
#include <cmath>

#ifndef MK_MULTI
#define MK_MULTI 0
#endif
#ifndef MK_DBG
#define MK_DBG 0
#endif

#define GAS __attribute__((address_space(1)))
#define LAS __attribute__((address_space(3)))
typedef unsigned short bf16_t;
typedef short bf16x8 __attribute__((ext_vector_type(8)));
typedef short s16x4 __attribute__((ext_vector_type(4)));
typedef float f32x2 __attribute__((ext_vector_type(2)));
typedef float f32x4 __attribute__((ext_vector_type(4)));
typedef float f32x16 __attribute__((ext_vector_type(16)));
typedef unsigned u32x2 __attribute__((ext_vector_type(2)));
typedef unsigned u32x4 __attribute__((ext_vector_type(4)));
typedef GAS unsigned gu32;
#define RLX_AGENT __ATOMIC_RELAXED, __HIP_MEMORY_SCOPE_AGENT
#define LDS_WAIT() asm volatile("s_waitcnt lgkmcnt(0)" ::: "memory")
#define VM_WAIT() asm volatile("s_waitcnt vmcnt(0)" ::: "memory")
#define SBAR() __builtin_amdgcn_sched_barrier(0)

constexpr int M = 16384, D = 2048, DEPTH = 2, MEM_LEN = 256;
constexpr int NIN = 11264, NIN_BF = 3072  , NIN_G8 = 8192  ;
constexpr int NIN_SRC = 11072;
constexpr int DFF = 5632, NEXP = 8;
constexpr int SSM_L = 32, SSM_NCH = M / SSM_L  , SSM_KX = 640  ;
constexpr float LN_EPS = 1e-5f, RMS_EPS = 1e-6f;
constexpr float ALPHA = 1.4142135623730951f;
constexpr float LOG2E = 1.4426950408889634f;
constexpr float C2_DIFF = 0.125f * LOG2E;
constexpr float C2_MLA = 0.07216878364870323f * LOG2E;
constexpr float C2_X = 0.08838834764831845f * LOG2E;
constexpr int MOE_MAXROWS = 34816;

typedef __bf16 bf16x2_t __attribute__((ext_vector_type(2)));
__device__ __forceinline__ unsigned cvt_pk_bf16(float lo, float hi) { const f32x2 v = {lo, hi}; const bf16x2_t b = __builtin_convertvector(v, bf16x2_t); return __builtin_bit_cast(unsigned, b); }
__device__ __forceinline__ float bf_lo(unsigned w) { return __uint_as_float(w << 16); }
__device__ __forceinline__ float bf_hi(unsigned w) { return __uint_as_float(w & 0xffff0000u); }
__device__ __forceinline__ u32x4 pack8(f32x4 a, f32x4 b) { u32x4 w; w.x = cvt_pk_bf16(a[0], a[1]); w.y = cvt_pk_bf16(a[2], a[3]); w.z = cvt_pk_bf16(b[0], b[1]); w.w = cvt_pk_bf16(b[2], b[3]); return w; }
__device__ __forceinline__ u32x2 pack8_fp8(f32x4 a, f32x4 b) { int w0 = 0, w1 = 0;
    w0 = __builtin_amdgcn_cvt_pk_fp8_f32(a[0], a[1], w0, false); w0 = __builtin_amdgcn_cvt_pk_fp8_f32(a[2], a[3], w0, true);
    w1 = __builtin_amdgcn_cvt_pk_fp8_f32(b[0], b[1], w1, false); w1 = __builtin_amdgcn_cvt_pk_fp8_f32(b[2], b[3], w1, true);
    u32x2 r; r.x = (unsigned)w0; r.y = (unsigned)w1; return r; }
__device__ __forceinline__ float fast_sigmoid(float x) { return __builtin_amdgcn_rcpf(1.f + __builtin_amdgcn_exp2f(-x * LOG2E)); }
constexpr int LDS_WTAB = 131072 + 8192 + 1024;
__device__ __forceinline__ int opaque_tid() {
    const unsigned hw = __builtin_amdgcn_s_getreg(0x2804);
    const int wave = __builtin_amdgcn_readfirstlane(((volatile LAS int*)LDS_WTAB)[hw]);
    int lane; asm volatile("v_mbcnt_lo_u32_b32 %0, -1, 0\n\tv_mbcnt_hi_u32_b32 %0, -1, %0" : "=v"(lane));
    return wave * 64 + lane;
}
__device__ __forceinline__ float shflx(float v, int off, int lane) { return __int_as_float(__builtin_amdgcn_ds_bpermute((lane ^ off) << 2, __float_as_int(v))); }
__device__ __forceinline__ float wave_sum(float v, int lane) {
#pragma unroll
    for (int o = 1; o < 64; o <<= 1) v += shflx(v, o, lane);
    return v;
}

namespace pg8 {
constexpr int BM = 256, BK = 64, HALF = 128, HTB = HALF * BK * 2, STAGE_BYTES = 8 * HTB, NXCD = 8, WGM = 8;
__host__ __device__ __forceinline__ int lds_byte(int r, int c) { const int st = (r >> 4) * 2 + (c >> 5), rr = r & 15, cc = c & 31, ob = rr * 64 + cc * 2; return st * 1024 + (ob ^ (((ob >> 9) & 1) << 5)); }
__host__ __device__ __forceinline__ void stage_rc(int b, int& R, int& C) { const int st = b / 1024, sb = b % 1024, swz = sb ^ (((sb >> 9) & 1) << 5); R = (st >> 1) * 16 + swz / 64; C = (st & 1) * 32 + (swz % 64) / 2; }
__host__ __device__ __forceinline__ int perm32(int rho) { const int n = rho >> 4, i = rho & 15; return 8 * (i >> 2) + 4 * n + (i & 3); }

__device__ __forceinline__ size_t uni64(size_t v) { const unsigned lo_ = __builtin_amdgcn_readfirstlane((unsigned)v), hi_ = __builtin_amdgcn_readfirstlane((unsigned)(v >> 32)); return ((size_t)hi_ << 32) | lo_; }
struct Unit { int pm, pn, z; size_t offA, offB; };
struct Gemm { const void* A; const void* Bt; int ldaB, ldbB, KB; int wscale; };
typedef int v8i __attribute__((ext_vector_type(8)));
typedef int v4i __attribute__((ext_vector_type(4)));

struct TileOrder {
    int nM, nN, nwg;
    __device__ __forceinline__ void init(int nM_, int nN_) { nM = nM_; nN = nN_; nwg = nM * nN; }
    __device__ __forceinline__ bool map(long L, int& pm, int& pn) const {
        if (L >= nwg) return false;
        int wgid = (int)L; { const int q = nwg / NXCD, r = nwg % NXCD, xcd = wgid % NXCD, off = wgid / NXCD; wgid = (xcd < r ? xcd * (q + 1) : r * (q + 1) + (xcd - r) * q) + off; }
        const int nig = WGM * nN, gid = wgid / nig, fm = gid * WGM, gsz = (nM - fm) < WGM ? (nM - fm) : WGM;
        pm = __builtin_amdgcn_readfirstlane(fm + ((wgid % nig) % gsz)); pn = __builtin_amdgcn_readfirstlane((wgid % nig) / gsz); return true;
    }
};

template <bool FP8, int WSC, class Epi, class Sched>
__device__ __forceinline__ void gemm_phase_t(LAS unsigned char* lds, const Gemm g, const Sched& S, const Epi& E) {
    const int tid = opaque_tid(), wid = __builtin_amdgcn_readfirstlane(tid >> 6), lane = tid & 63, wr = wid >> 2, wc = wid & 3, fr = lane & 15, fq = lane >> 4;
    const int nt = g.KB / (BK * 2);
    unsigned voffA[2], voffB[2];
#pragma unroll
    for (int i = 0; i < 2; ++i) { int R, C; stage_rc(tid * 16 + i * 8192, R, C); const int Rb = (R & ~31) + perm32(R & 31);
        voffA[i] = (unsigned)(R * g.ldaB + C * 2); voffB[i] = (unsigned)(Rb * g.ldbB + C * 2); }
    const size_t kstep = (size_t)(BK * 2);
    const size_t hstepA = (size_t)HALF * g.ldaB, hstepB = (size_t)HALF * g.ldbB;
    const unsigned ldsw = (unsigned)wid * 1024u;
    const unsigned lds_u = __builtin_amdgcn_readfirstlane((unsigned)(uintptr_t)lds + ldsw);
    const int aoff = lds_byte(wr * 64 + fr, fq * 8), boff = lds_byte(wc * 32 + fr, fq * 8);
#define PG8_SA(b, h) (((b) * 2 + (h)) * HTB)
#define PG8_SB(b, h) ((4 + (b) * 2 + (h)) * HTB)
#define PG8_STAGE(bufoff, gbase, voff) do { _Pragma("unroll") for (int _i = 0; _i < 2; ++_i) \
        { unsigned _keep; asm volatile("s_mov_b32 %0, m0\n\ts_mov_b32 m0, %1\n\ts_nop 0\n\tglobal_load_lds_dwordx4 %2, %3\n\ts_mov_b32 m0, %0" : "=&s"(_keep) : "s"(lds_u + (unsigned)((bufoff) + _i * 8192)), "v"((voff)[_i]), "s"(gbase) : "memory"); } } while (0)
#define PG8_LD32(p) __builtin_shufflevector(*(const LAS v4i*)(p), *(const LAS v4i*)((p) + 1024), 0, 1, 2, 3, 4, 5, 6, 7)
#define PG8_LDA(dst, b, h) do { _Pragma("unroll") for (int m = 0; m < 4; ++m) dst[m] = PG8_LD32(lds + PG8_SA(b, h) + aoff + m * 2048); } while (0)
#define PG8_LDB(dst, b, h) do { _Pragma("unroll") for (int n = 0; n < 2; ++n) dst[n] = PG8_LD32(lds + PG8_SB(b, h) + boff + n * 2048); } while (0)
#define PG8_H0(x) __builtin_bit_cast(bf16x8, __builtin_shufflevector((x), (x), 0, 1, 2, 3))
#define PG8_H1(x) __builtin_bit_cast(bf16x8, __builtin_shufflevector((x), (x), 4, 5, 6, 7))
#define PG8_MMA(ai, bj, At, Bt) do { __builtin_amdgcn_s_setprio(1); _Pragma("unroll") for (int m = 0; m < 4; ++m) _Pragma("unroll") for (int n = 0; n < 2; ++n) { \
        if constexpr (FP8) asm volatile("v_mfma_scale_f32_16x16x128_f8f6f4 %0, %1, %2, %0, %3, %3 op_sel_hi:[0,0,0]" : "+v"(acc[ai][bj][m][n]) : "v"(Bt[n]), "v"(At[m]), "v"(wsc_v));     \
        else { acc[ai][bj][m][n] = __builtin_amdgcn_mfma_f32_16x16x32_bf16(PG8_H0(Bt[n]), PG8_H0(At[m]), acc[ai][bj][m][n], 0, 0, 0); acc[ai][bj][m][n] = __builtin_amdgcn_mfma_f32_16x16x32_bf16(PG8_H1(Bt[n]), PG8_H1(At[m]), acc[ai][bj][m][n], 0, 0, 0); } } \
        __builtin_amdgcn_s_setprio(0); } while (0)
#define PG8_WAIT_V(n) asm volatile("s_waitcnt vmcnt(" #n ")" ::: "memory")
#define PG8_WAIT_L(n) asm volatile("s_waitcnt lgkmcnt(" #n ")" ::: "memory")
#define PG8_BAR __builtin_amdgcn_s_barrier()
#define PG8_SCHED __builtin_amdgcn_sched_barrier(0)
    Unit cur, nxt; int ui = 0;
    if (!S.next(0, cur)) return;
    f32x4 acc[2][2][4][2];
#pragma unroll
    for (int a = 0; a < 2; ++a)
#pragma unroll
        for (int b = 0; b < 2; ++b)
#pragma unroll
            for (int m = 0; m < 4; ++m)
#pragma unroll
                for (int n = 0; n < 2; ++n) acc[a][b][m][n] = (f32x4){0.f, 0.f, 0.f, 0.f};
    v8i At[4], B0[2], B1[2]; const int wsc_v = WSC; (void)wsc_v;
    const char* cA = (const char*)g.A + uni64(cur.offA); const char* cB = (const char*)g.Bt + uni64(cur.offB);
    PG8_STAGE(PG8_SB(0, 0), cB, voffB); PG8_STAGE(PG8_SB(0, 1), cB + hstepB, voffB); PG8_STAGE(PG8_SA(0, 0), cA, voffA); PG8_STAGE(PG8_SA(0, 1), cA + hstepA, voffA);
    if (wr == 1) PG8_BAR;
    PG8_WAIT_V(2); PG8_BAR;
    PG8_STAGE(PG8_SB(1, 0), cB + kstep, voffB); PG8_STAGE(PG8_SA(1, 0), cA + kstep, voffA); PG8_STAGE(PG8_SB(1, 1), cB + hstepB + kstep, voffB);
    PG8_WAIT_V(6); PG8_BAR;
    for (;;) {
        const bool has_next = S.next(ui + 1, nxt);
        const char* nA = has_next ? (const char*)g.A + uni64(nxt.offA) : cA; const char* nB = has_next ? (const char*)g.Bt + uni64(nxt.offB) : cB;
        for (int t = 0; t < nt; t += 2) {
            const bool last = (t == nt - 2);
            const char* a1 = cA + (size_t)(t + 1) * kstep;
            const char* a2 = last ? nA : cA + (size_t)(t + 2) * kstep; const char* b2 = last ? nB : cB + (size_t)(t + 2) * kstep;
            const char* a3 = a2 + kstep; const char* b3 = b2 + kstep;
            PG8_LDB(B0, 0, 0); PG8_LDB(B1, 0, 1); PG8_SCHED; PG8_LDA(At, 0, 0); PG8_STAGE(PG8_SA(1, 1), a1 + hstepA, voffA);
            PG8_WAIT_V(8); PG8_WAIT_L(0); PG8_BAR; PG8_MMA(0, 0, At, B0); PG8_MMA(0, 1, At, B1); PG8_BAR; PG8_SCHED;
            PG8_LDA(At, 0, 1); PG8_STAGE(PG8_SB(0, 0), b2, voffB); PG8_STAGE(PG8_SB(0, 1), b2 + hstepB, voffB); PG8_STAGE(PG8_SA(0, 0), a2, voffA);
            PG8_WAIT_V(8); PG8_WAIT_L(0); PG8_BAR; PG8_MMA(1, 0, At, B0); PG8_MMA(1, 1, At, B1); PG8_BAR; PG8_SCHED;
            PG8_LDB(B0, 1, 0); PG8_LDB(B1, 1, 1); PG8_SCHED; PG8_LDA(At, 1, 0); PG8_STAGE(PG8_SA(0, 1), a2 + hstepA, voffA);
            PG8_WAIT_V(8); PG8_WAIT_L(0); PG8_BAR; PG8_MMA(0, 0, At, B0); PG8_MMA(0, 1, At, B1); PG8_BAR; PG8_SCHED;
            PG8_LDA(At, 1, 1); PG8_STAGE(PG8_SB(1, 0), b3, voffB); PG8_STAGE(PG8_SB(1, 1), b3 + hstepB, voffB); PG8_STAGE(PG8_SA(1, 0), a3, voffA);
            PG8_WAIT_V(8); PG8_WAIT_L(0); PG8_BAR; PG8_MMA(1, 0, At, B0); PG8_MMA(1, 1, At, B1); PG8_BAR; PG8_SCHED;
        }
        if (wr == 0) PG8_BAR;
        if constexpr (FP8) asm volatile("s_nop 15\n\ts_nop 15" ::: "memory");
        E(acc, cur, wr, wc, fr, fq);
        if (!has_next) break;
#pragma unroll
        for (int a = 0; a < 2; ++a)
#pragma unroll
            for (int b = 0; b < 2; ++b)
#pragma unroll
                for (int m = 0; m < 4; ++m)
#pragma unroll
                    for (int n = 0; n < 2; ++n) acc[a][b][m][n] = (f32x4){0.f, 0.f, 0.f, 0.f};
        cur = nxt; cA = nA; cB = nB; ++ui;
        if (wr == 1) PG8_BAR;
    }
    PG8_WAIT_V(0);
    PG8_BAR;
#undef PG8_SA
#undef PG8_SB
#undef PG8_STAGE
#undef PG8_LDA
#undef PG8_LDB
#undef PG8_MMA
#undef PG8_H0
#undef PG8_H1
#undef PG8_LD32
#undef PG8_WAIT_V
#undef PG8_WAIT_L
#undef PG8_BAR
#undef PG8_SCHED
}
template <class Epi, class Sched> __device__ __forceinline__ void gemm_phase(LAS unsigned char* lds, const Gemm g, const Sched& S, const Epi& E) { gemm_phase_t<false, 0>(lds, g, S, E); }
}

struct SchedPlain {
    pg8::TileOrder T; int G, c; size_t tA, tB;
    __device__ __forceinline__ void init(int nM, int nN, int lda, int ldb, int G_, int c_) { T.init(nM, nN); G = G_; c = c_; tA = (size_t)256 * lda * 2; tB = (size_t)256 * ldb * 2; }
    __device__ __forceinline__ bool next(int i, pg8::Unit& u) const { if (!T.map((long)i * G + c, u.pm, u.pn)) return false; u.z = 0; u.offA = u.pm * tA; u.offB = u.pn * tB; return true; }
};
struct SchedBatch {
    int nM, nN, nZ, G, c; size_t tA, tB, zA, zB;
    __device__ __forceinline__ bool next(int i, pg8::Unit& u) const {
        const long L = (long)i * G + c; const int per = nM * nN; if (L >= (long)per * nZ) return false;
        const int z = __builtin_amdgcn_readfirstlane((int)(L / per)), r = __builtin_amdgcn_readfirstlane((int)(L % per)); u.z = z; u.pm = __builtin_amdgcn_readfirstlane(r / nN); u.pn = __builtin_amdgcn_readfirstlane(r % nN); u.offA = z * zA + u.pm * tA; u.offB = z * zB + u.pn * tB; return true; }
};
struct SchedBranch {
    pg8::TileOrder T; int G, c; size_t tA, tB, zA, zB;
    __device__ __forceinline__ bool next(int i, pg8::Unit& u) const { const int t = i / 3, z = i - 3 * t; if (!T.map((long)t * G + c, u.pm, u.pn)) return false; u.z = z; u.offA = z * zA + u.pm * tA; u.offB = z * zB + u.pn * tB; return true; }
};
struct SchedMoe {
    pg8::TileOrder T; int G, c; size_t tA, tB, zB; int off[7];
    __device__ __forceinline__ bool next(int i, pg8::Unit& u) const {
        if (!T.map((long)i * G + c, u.pm, u.pn)) return false; const int r0 = u.pm * 256; int e = 0;
#pragma unroll
        for (int k = 0; k < 7; ++k) e += (r0 >= off[k]) ? 1 : 0;
        e = __builtin_amdgcn_readfirstlane(e); u.z = e; u.offA = u.pm * tA; u.offB = e * zB + u.pn * tB; return true; }
};

#define EPI_ARGS const f32x4 (&acc)[2][2][4][2], const pg8::Unit& u, int wr, int wc, int fr, int fq
#define EPI_ROW(ai, m) (u.pm * 256 + (ai) * 128 + wr * 64 + (m) * 16 + fr)
#define EPI_CB(bj) ((bj) * 128 + wc * 32 + fq * 8)
#define FOR_AI_M _Pragma("unroll") for (int ai = 0; ai < 2; ++ai) _Pragma("unroll") for (int m = 0; m < 4; ++m)
#define FOR_BJ _Pragma("unroll") for (int bj = 0; bj < 2; ++bj)

__device__ __forceinline__ void rope4(f32x4& v0, f32x4& v1, const f32x4 t0, const f32x4 t1) {
    const float a0 = v0[0] * t0[0] - v0[1] * t0[1], b0 = v0[1] * t0[0] + v0[0] * t0[1];
    const float a1 = v0[2] * t0[2] - v0[3] * t0[3], b1 = v0[3] * t0[2] + v0[2] * t0[3];
    const float a2 = v1[0] * t1[0] - v1[1] * t1[1], b2 = v1[1] * t1[0] + v1[0] * t1[1];
    const float a3 = v1[2] * t1[2] - v1[3] * t1[3], b3 = v1[3] * t1[2] + v1[2] * t1[3];
    v0 = (f32x4){a0, b0, a1, b1}; v1 = (f32x4){a2, b2, a3, b3};
}

struct EpiInProj {
    bf16_t *QD, *KD, *VD, *MQ, *MKV, *KM, *SU, *GATES; float *ssq_q, *ssq_kv; const float* tabd; const float* tabm;
    int pn_add;
    __device__ __forceinline__ void operator()(EPI_ARGS) const {
        const int pn = u.pn + pn_add;
        if (pn < 8) {
            bf16_t* O = pn < 4 ? QD : KD; const float sc = pn < 4 ? C2_DIFF : 1.f; const int colt = (pn & 3) * 256;
            const bool rp = ((wc & 1) == 0) && fq < 2;
#pragma unroll
            for (int ai = 0; ai < 2; ++ai) { f32x4 tt[4][2];
#pragma unroll
                for (int m = 0; m < 4; ++m) { tt[m][0] = (f32x4){1.f, 0.f, 1.f, 0.f}; tt[m][1] = (f32x4){1.f, 0.f, 1.f, 0.f};
                    if (rp) { const f32x4* tp = (const f32x4*)(tabd + (size_t)EPI_ROW(ai, m) * 16 + fq * 8); tt[m][0] = tp[0]; tt[m][1] = tp[1]; } }
#pragma unroll
                for (int m = 0; m < 4; ++m) { const int row = EPI_ROW(ai, m);
                    FOR_BJ { f32x4 v0 = acc[ai][bj][m][0], v1 = acc[ai][bj][m][1]; rope4(v0, v1, tt[m][0], tt[m][1]); v0 = v0 * sc; v1 = v1 * sc;
                        *(u32x4*)(O + (size_t)row * 1024 + colt + EPI_CB(bj)) = pack8(v0, v1); } } }
        } else if (pn < 12) {
            const int colt = (pn - 8) * 256;
            FOR_AI_M { const int row = EPI_ROW(ai, m); FOR_BJ { *(u32x4*)(VD + (size_t)row * 1024 + colt + EPI_CB(bj)) = pack8(acc[ai][bj][m][0], acc[ai][bj][m][1]); } }
        } else if (pn < 15) {
            bf16_t* O = pn < 14 ? MQ : MKV; const int ld = pn < 14 ? 512 : 256, colt = pn < 14 ? (pn - 12) * 256 : 0; float* ssq = pn < 14 ? ssq_q + (pn - 12) * 4 + wc : ssq_kv + wc; const int ns = pn < 14 ? 8 : 4;
            FOR_AI_M { const int row = EPI_ROW(ai, m); float s = 0.f;
                FOR_BJ { const f32x4 v0 = acc[ai][bj][m][0], v1 = acc[ai][bj][m][1]; s += (v0[0] * v0[0] + v0[1] * v0[1]) + (v0[2] * v0[2] + v0[3] * v0[3]) + (v1[0] * v1[0] + v1[1] * v1[1]) + (v1[2] * v1[2] + v1[3] * v1[3]);
                    *(u32x4*)(O + (size_t)row * ld + colt + EPI_CB(bj)) = pack8(v0, v1); }
                s += shflx(s, 16, fq * 16 + fr); s += shflx(s, 32, fq * 16 + fr);
                if (fq == 0) ssq[(size_t)row * ns] = s; }
        } else if (pn == 15) {
            if (wc < 2) {
                FOR_AI_M { const int row = EPI_ROW(ai, m); const f32x4* tp = (const f32x4*)(tabm + (size_t)row * 64 + (wc * 16 + fq * 4) * 2);
                    f32x4 v0 = acc[ai][0][m][0], v1 = acc[ai][0][m][1]; rope4(v0, v1, tp[0], tp[1]); const u32x4 w = pack8(v0, v1);
#pragma unroll
                    for (int h = 0; h < 8; ++h) *(u32x4*)(KM + (size_t)row * 1536 + h * 192 + 128 + wc * 32 + fq * 8) = w; }
            }
        } else if (pn < 20) {
            FOR_AI_M { const int row = EPI_ROW(ai, m); const int c = row >> 5, j = row & 31;
                FOR_BJ { const int ch = (pn - 16) * 256 + EPI_CB(bj), g = ch >> 4, q = ch & 15;
                    *(u32x4*)(SU + ((size_t)(g * SSM_NCH + c) * SSM_KX + j * 16 + q)) = pack8(acc[ai][bj][m][0], acc[ai][bj][m][1]); } }
        } else {
            const int colt = (pn - 20) * 256;
            FOR_AI_M { const int row = EPI_ROW(ai, m);
                FOR_BJ { f32x4 v0 = acc[ai][bj][m][0], v1 = acc[ai][bj][m][1];
#pragma unroll
                    for (int e = 0; e < 4; ++e) { v0[e] = fast_sigmoid(v0[e]); v1[e] = fast_sigmoid(v1[e]); }
                    *(u32x4*)(GATES + (size_t)row * 6144 + colt + EPI_CB(bj)) = pack8(v0, v1); } }
        }
    }
};
struct EpiQup {
    bf16_t* QM; const float* ssq; const float* tabm;
    __device__ __forceinline__ void operator()(EPI_ARGS) const {
#pragma unroll
        for (int ai = 0; ai < 2; ++ai) { f32x4 sq[4][2];
#pragma unroll
            for (int m = 0; m < 4; ++m) { const int row = EPI_ROW(ai, m); sq[m][0] = *(const f32x4*)(ssq + (size_t)row * 8); sq[m][1] = *(const f32x4*)(ssq + (size_t)row * 8 + 4); }
#pragma unroll
            for (int m = 0; m < 4; ++m) { const int row = EPI_ROW(ai, m); const f32x4 s0 = sq[m][0], s1 = sq[m][1];
                const float rq = __builtin_amdgcn_rsqf((((s0[0] + s0[1]) + (s0[2] + s0[3])) + ((s1[0] + s1[1]) + (s1[2] + s1[3]))) * (1.f / 512.f) + RMS_EPS) * C2_MLA;
                FOR_BJ { const int col = u.pn * 256 + EPI_CB(bj), h = col / 192, hc = col - h * 192; f32x4 v0 = acc[ai][bj][m][0], v1 = acc[ai][bj][m][1];
                    if (hc >= 128) { const f32x4* tp = (const f32x4*)(tabm + (size_t)row * 64 + (hc - 128)); rope4(v0, v1, tp[0], tp[1]); }
                    v0 = v0 * rq; v1 = v1 * rq; *(u32x4*)(QM + (size_t)row * 1536 + col) = pack8(v0, v1); } } }
    }
};
struct EpiKVup {
    bf16_t *KM, *VM; const float* ssq;
    __device__ __forceinline__ void operator()(EPI_ARGS) const {
#pragma unroll
        for (int ai = 0; ai < 2; ++ai) { float rk[4];
#pragma unroll
            for (int m = 0; m < 4; ++m) { const f32x4 s0 = *(const f32x4*)(ssq + (size_t)EPI_ROW(ai, m) * 4); rk[m] = ((s0[0] + s0[1]) + (s0[2] + s0[3])); }
#pragma unroll
            for (int m = 0; m < 4; ++m) { const int row = EPI_ROW(ai, m); const float r = __builtin_amdgcn_rsqf(rk[m] * (1.f / 256.f) + RMS_EPS); const int c = wc * 32 + fq * 8;
                *(u32x4*)(KM + (size_t)row * 1536 + u.pn * 192 + c) = pack8(acc[ai][0][m][0] * r, acc[ai][0][m][1] * r);
                *(u32x4*)(VM + (size_t)row * 1024 + u.pn * 128 + c) = pack8(acc[ai][1][m][0] * r, acc[ai][1][m][1] * r); } }
    }
};
struct EpiSloc {
    float* SLOC;
    __device__ __forceinline__ void operator()(EPI_ARGS) const {
        FOR_AI_M { const int c = EPI_ROW(ai, m); float* o = SLOC + ((size_t)(u.z * SSM_NCH + c) * 128 + wc * 32 + fq * 8);
            *(f32x4*)o = acc[ai][0][m][0]; *(f32x4*)(o + 4) = acc[ai][0][m][1]; }
    }
};
__device__ __forceinline__ float gelu_tanh(float x) { const float t = 1.5957691216057308f * (x + 0.044715f * x * x * x); return x * fast_sigmoid(t); }
struct EpiSsmY {
    bf16_t* YG; const bf16_t* SU; const float* dskip;
    __device__ __forceinline__ void operator()(EPI_ARGS) const {
        const int g = u.z; f32x4 d0[2], d1[2];
        FOR_BJ { const int col = u.pn * 256 + EPI_CB(bj), ch = g * 16 + (col & 15); d0[bj] = *(const f32x4*)(dskip + ch); d1[bj] = *(const f32x4*)(dskip + ch + 4); }
#pragma unroll
        for (int ai = 0; ai < 2; ++ai) { u32x4 uu[4][2];
#pragma unroll
            for (int m = 0; m < 4; ++m) { const int c = EPI_ROW(ai, m);
                FOR_BJ { const int col = u.pn * 256 + EPI_CB(bj), i = col >> 4, p0 = col & 15; uu[m][bj] = *(const u32x4*)(SU + ((size_t)(g * SSM_NCH + c) * SSM_KX + i * 16 + p0)); } }
#pragma unroll
            for (int m = 0; m < 4; ++m) { const int c = EPI_ROW(ai, m);
                FOR_BJ { const int col = u.pn * 256 + EPI_CB(bj), i = col >> 4, p0 = col & 15, t = c * SSM_L + i, ch = g * 16 + p0; const u32x4 w = uu[m][bj];
                    f32x4 v0 = acc[ai][bj][m][0], v1 = acc[ai][bj][m][1];
                    v0[0] += d0[bj][0] * bf_lo(w.x); v0[1] += d0[bj][1] * bf_hi(w.x); v0[2] += d0[bj][2] * bf_lo(w.y); v0[3] += d0[bj][3] * bf_hi(w.y);
                    v1[0] += d1[bj][0] * bf_lo(w.z); v1[1] += d1[bj][1] * bf_hi(w.z); v1[2] += d1[bj][2] * bf_lo(w.w); v1[3] += d1[bj][3] * bf_hi(w.w);
#pragma unroll
                    for (int e = 0; e < 4; ++e) { v0[e] = gelu_tanh(v0[e]); v1[e] = gelu_tanh(v1[e]); }
                    *(u32x4*)(YG + (size_t)t * 1024 + ch) = pack8(v0, v1); } } }
    }
};
template <int ACT  > struct EpiGated {
    bf16_t* O; int ldo;
    __device__ __forceinline__ void operator()(EPI_ARGS) const {
        FOR_AI_M { const int row = EPI_ROW(ai, m); f32x4 r[2];
#pragma unroll
            for (int n = 0; n < 2; ++n)
#pragma unroll
                for (int e = 0; e < 4; ++e) { const float a = acc[ai][0][m][n][e], b = acc[ai][1][m][n][e]; r[n][e] = ACT == 0 ? a * fast_sigmoid(b) : a * fast_sigmoid(a) * b; }
            *(u32x4*)(O + (size_t)row * ldo + u.pn * 128 + wc * 32 + fq * 8) = pack8(r[0], r[1]); }
    }
};
struct EpiSwigluF8 {
    unsigned char* O; int ldo;
    __device__ __forceinline__ void operator()(EPI_ARGS) const {
        FOR_AI_M { const int row = EPI_ROW(ai, m); f32x4 r[2];
#pragma unroll
            for (int n = 0; n < 2; ++n)
#pragma unroll
                for (int e = 0; e < 4; ++e) { const float a = acc[ai][0][m][n][e], b = acc[ai][1][m][n][e]; r[n][e] = a * fast_sigmoid(a) * b; }
            *(u32x2*)(O + (size_t)row * ldo + u.pn * 128 + wc * 32 + fq * 8) = pack8_fp8(r[0], r[1]); }
    }
};
struct EpiGatesF8 {
    bf16_t* GATES;
    __device__ __forceinline__ void operator()(EPI_ARGS) const {
        FOR_AI_M { const int row = EPI_ROW(ai, m);
            FOR_BJ { f32x4 v0 = acc[ai][bj][m][0], v1 = acc[ai][bj][m][1];
#pragma unroll
                for (int e = 0; e < 4; ++e) { v0[e] = fast_sigmoid(v0[e]); v1[e] = fast_sigmoid(v1[e]); }
                *(u32x4*)(GATES + (size_t)row * 6144 + u.pn * 256 + EPI_CB(bj)) = pack8(v0, v1); } }
    }
};
struct EpiBranch {
    const bf16_t* GATES; bf16_t* P; bf16_t* MG;
    __device__ __forceinline__ void operator()(EPI_ARGS) const {
        const int z = u.z;
#pragma unroll
        for (int ai = 0; ai < 2; ++ai)
#pragma unroll
            for (int mh = 0; mh < 2; ++mh) { u32x4 gg[2][2], pa[2][2], pb[2][2];
#pragma unroll
                for (int mm = 0; mm < 2; ++mm) { const int row = EPI_ROW(ai, mh * 2 + mm);
                    FOR_BJ { const int col = u.pn * 256 + EPI_CB(bj); gg[mm][bj] = *(const u32x4*)(GATES + (size_t)row * 6144 + z * 2048 + col);
                        if (z == 2) { const size_t o = (size_t)row * 2048 + col; pa[mm][bj] = *(const u32x4*)(P + o); pb[mm][bj] = *(const u32x4*)(P + (size_t)M * 2048 + o); } } }
#pragma unroll
                for (int mm = 0; mm < 2; ++mm) { const int m = mh * 2 + mm, row = EPI_ROW(ai, m);
                    FOR_BJ { const int col = u.pn * 256 + EPI_CB(bj); const u32x4 g = gg[mm][bj];
                        f32x4 v0 = acc[ai][bj][m][0], v1 = acc[ai][bj][m][1];
                        v0[0] *= bf_lo(g.x); v0[1] *= bf_hi(g.x); v0[2] *= bf_lo(g.y); v0[3] *= bf_hi(g.y);
                        v1[0] *= bf_lo(g.z); v1[1] *= bf_hi(g.z); v1[2] *= bf_lo(g.w); v1[3] *= bf_hi(g.w);
                        const size_t o = (size_t)row * 2048 + col;
                        if (z < 2) *(u32x4*)(P + (size_t)z * M * 2048 + o) = pack8(v0, v1);
                        else { const u32x4 a = pa[mm][bj], b = pb[mm][bj];
                            v0[0] += bf_lo(a.x) + bf_lo(b.x); v0[1] += bf_hi(a.x) + bf_hi(b.x); v0[2] += bf_lo(a.y) + bf_lo(b.y); v0[3] += bf_hi(a.y) + bf_hi(b.y);
                            v1[0] += bf_lo(a.z) + bf_lo(b.z); v1[1] += bf_hi(a.z) + bf_hi(b.z); v1[2] += bf_lo(a.w) + bf_lo(b.w); v1[3] += bf_hi(a.w) + bf_hi(b.w);
                            *(u32x4*)(MG + o) = pack8(v0, v1); } } } }
    }
};
struct EpiResid {
    bf16_t* X;
    __device__ __forceinline__ void operator()(EPI_ARGS) const {
#pragma unroll
        for (int ai = 0; ai < 2; ++ai) { u32x4 r[4][2];
#pragma unroll
            for (int m = 0; m < 4; ++m) { const int row = EPI_ROW(ai, m);
                FOR_BJ { r[m][bj] = *(const u32x4*)(X + (size_t)row * 2048 + u.pn * 256 + EPI_CB(bj)); } }
#pragma unroll
            for (int m = 0; m < 4; ++m) { const int row = EPI_ROW(ai, m);
                FOR_BJ { const u32x4 w = r[m][bj]; f32x4 v0 = acc[ai][bj][m][0], v1 = acc[ai][bj][m][1];
                    v0[0] += ALPHA * bf_lo(w.x); v0[1] += ALPHA * bf_hi(w.x); v0[2] += ALPHA * bf_lo(w.y); v0[3] += ALPHA * bf_hi(w.y);
                    v1[0] += ALPHA * bf_lo(w.z); v1[1] += ALPHA * bf_hi(w.z); v1[2] += ALPHA * bf_lo(w.w); v1[3] += ALPHA * bf_hi(w.w);
                    *(u32x4*)(X + (size_t)row * 2048 + u.pn * 256 + EPI_CB(bj)) = pack8(v0, v1); } } }
    }
};
struct EpiBf16 {
    bf16_t* O; int ldo; float scale;
    __device__ __forceinline__ void operator()(EPI_ARGS) const {
        FOR_AI_M { const int row = EPI_ROW(ai, m); FOR_BJ { *(u32x4*)(O + (size_t)row * ldo + u.pn * 256 + EPI_CB(bj)) = pack8(acc[ai][bj][m][0] * scale, acc[ai][bj][m][1] * scale); } }
    }
};
struct EpiBf16Half {
    bf16_t* O; int ldo; float scale;
    __device__ __forceinline__ void operator()(EPI_ARGS) const {
#pragma unroll
        for (int m = 0; m < 4; ++m) { const int row = u.pm * 128 + wr * 64 + m * 16 + fr;
            FOR_BJ { *(u32x4*)(O + (size_t)row * ldo + u.pn * 256 + EPI_CB(bj)) = pack8(acc[0][bj][m][0] * scale, acc[0][bj][m][1] * scale); } }
    }
};
struct EpiMoeDown {
    float* OG; const float* wslot;
    __device__ __forceinline__ void operator()(EPI_ARGS) const {
        float w[2][4];
        FOR_AI_M w[ai][m] = wslot[EPI_ROW(ai, m)];
        FOR_AI_M { const int row = EPI_ROW(ai, m);
            FOR_BJ { float* o = OG + (size_t)row * 2048 + u.pn * 256 + EPI_CB(bj); *(f32x4*)o = acc[ai][bj][m][0] * w[ai][m]; *(f32x4*)(o + 4) = acc[ai][bj][m][1] * w[ai][m]; } }
    }
};

namespace att {
constexpr int KVBLK = 64, SHM_V = KVBLK * 128 * 2;
constexpr float THRL = 8.f;
__device__ __forceinline__ int crow(int r, int hi) { return (r & 3) + 8 * (r >> 2) + 4 * hi; }
template <int PITCH> __device__ __forceinline__ int kfl(int row) { return (PITCH % 256 == 128) ? ((row >> 1) & 7) : (row & 15); }
template <int PITCH> __device__ __forceinline__ int kswz(int row, int colB) { return row * PITCH + (colB ^ (kfl<PITCH>(row) << 4)); }
__device__ __forceinline__ int v_st(int k, int c) { const int kk = (k & ~0xC) | ((k & 4) << 1) | ((k & 8) >> 1); return ((kk >> 3) * 4 + (c >> 5)) * 512 + ((kk & 7) * 32 + (c & 31)) * 2; }
__device__ __forceinline__ int v_rd_base(int lane) { return ((lane & 3) << 3) | (((lane >> 2) & 3) << 6) | (((lane >> 4) & 1) << 5) | (((lane >> 5) & 1) << 8); }
constexpr int v_rd_off(int d0, int ks, int half) { return d0 * 512 + ks * 4096 + half * 2048; }

__device__ __forceinline__ void mask_tile(f32x16& p0, f32x16& p1, int dq) {
    const float NEG = -__builtin_inff();
#pragma unroll
    for (int r = 0; r < 16; ++r) { const int c = (r & 3) + 8 * (r >> 2); if (dq - c < 0) p0[r] = NEG; if (dq - c - 32 < 0) p1[r] = NEG; }
}
__device__ __forceinline__ void partialSM(f32x16& p0, f32x16& p1, float& m_reg, float& alpha) {
    float pmax = p0[0];
#pragma unroll
    for (int r = 1; r < 16; ++r) pmax = fmaxf(pmax, p0[r]);
#pragma unroll
    for (int r = 0; r < 16; ++r) pmax = fmaxf(pmax, p1[r]);
    { auto rr = __builtin_amdgcn_permlane32_swap(__float_as_uint(pmax), __float_as_uint(pmax), false, false); pmax = fmaxf(__uint_as_float(rr[0]), __uint_as_float(rr[1])); }
    float mn;
    if (__builtin_expect(__all(pmax - m_reg <= THRL), 1)) { mn = m_reg; alpha = 1.f; }
    else { mn = fmaxf(m_reg, pmax); alpha = __builtin_amdgcn_exp2f(m_reg - mn); m_reg = mn; }
#pragma unroll
    for (int r = 0; r < 16; ++r) { p0[r] -= mn; p1[r] -= mn; }
#pragma unroll
    for (int r = 0; r < 16; ++r) p0[r] = __builtin_amdgcn_exp2f(p0[r]);
}
__device__ __forceinline__ void finishSM(f32x16& p0, f32x16& p1, float alpha, float& l_reg, bf16x8& pa0, bf16x8& pa1, bf16x8& pa2, bf16x8& pa3) {
#pragma unroll
    for (int r = 0; r < 16; ++r) p1[r] = __builtin_amdgcn_exp2f(p1[r]);
    float ps = 0;
#pragma unroll
    for (int r = 0; r < 16; ++r) ps += p0[r];
#pragma unroll
    for (int r = 0; r < 16; ++r) ps += p1[r];
    { auto rr = __builtin_amdgcn_permlane32_swap(__float_as_uint(ps), __float_as_uint(ps), false, false); ps = __uint_as_float(rr[0]) + __uint_as_float(rr[1]); }
    l_reg = l_reg * alpha + ps;
#define PK4(P, B_, OUT) do { unsigned a0 = cvt_pk_bf16(P[B_+0], P[B_+1]), a1 = cvt_pk_bf16(P[B_+2], P[B_+3]); unsigned b0 = cvt_pk_bf16(P[B_+4], P[B_+5]), b1 = cvt_pk_bf16(P[B_+6], P[B_+7]); \
        auto r0 = __builtin_amdgcn_permlane32_swap(a0, b0, false, false); auto r1 = __builtin_amdgcn_permlane32_swap(a1, b1, false, false); \
        u32x4 w = {r0[0], r1[0], r0[1], r1[1]}; OUT = *reinterpret_cast<bf16x8*>(&w); } while (0)
    PK4(p0, 0, pa0); PK4(p0, 8, pa1); PK4(p1, 0, pa2); PK4(p1, 8, pa3);
#undef PK4
}
template <int PITCH, int ND0>
__device__ __forceinline__ void qkt(f32x16& p0, f32x16& p1, const char* Kb, int r32, int hi, int kch0, const bf16x8* qr) {
    p0 = f32x16{}; p1 = f32x16{};
    const char* kb[4];
#pragma unroll
    for (int dd = 0; dd < 4; ++dd) kb[dd] = Kb + kswz<PITCH>(r32, (kch0 + dd * 2 + hi) * 16);
#pragma unroll
    for (int d0 = 0; d0 < ND0; ++d0) { const char* a = (PITCH % 256 == 0) ? Kb + kswz<PITCH>(r32, (kch0 + d0 * 2 + hi) * 16) : kb[d0 & 3] + (d0 >> 2) * 128;
        const bf16x8 b0 = *reinterpret_cast<const bf16x8*>(a);
        const bf16x8 b1 = *reinterpret_cast<const bf16x8*>(a + 32 * PITCH);
        p0 = __builtin_amdgcn_mfma_f32_32x32x16_bf16(b0, qr[d0], p0, 0, 0, 0);
        p1 = __builtin_amdgcn_mfma_f32_32x32x16_bf16(b1, qr[d0], p1, 0, 0, 0); }
}
__device__ __forceinline__ void pv_tile(f32x16* o, int vb0, bf16x8 pa0, bf16x8 pa1, bf16x8 pa2, bf16x8 pa3) {
    s16x4 va[8], vb[8];
#define TRRD(dst, off) asm volatile("ds_read_b64_tr_b16 %0, %1 offset:%2" : "=&v"(dst) : "v"(vb0), "i"(off) : "memory")
#define PV_RD(v, d0) do { constexpr int b_ = v_rd_off(d0, 0, 0); TRRD(v[0], b_); TRRD(v[1], b_ + 2048); TRRD(v[2], b_ + 4096); TRRD(v[3], b_ + 6144); TRRD(v[4], b_ + 8192); TRRD(v[5], b_ + 10240); TRRD(v[6], b_ + 12288); TRRD(v[7], b_ + 14336); } while (0)
#define PV_MM(v, d0) do { \
        o[d0] = __builtin_amdgcn_mfma_f32_32x32x16_bf16(pa0, (bf16x8){v[0][0], v[0][1], v[0][2], v[0][3], v[1][0], v[1][1], v[1][2], v[1][3]}, o[d0], 0, 0, 0); \
        o[d0] = __builtin_amdgcn_mfma_f32_32x32x16_bf16(pa1, (bf16x8){v[2][0], v[2][1], v[2][2], v[2][3], v[3][0], v[3][1], v[3][2], v[3][3]}, o[d0], 0, 0, 0); \
        o[d0] = __builtin_amdgcn_mfma_f32_32x32x16_bf16(pa2, (bf16x8){v[4][0], v[4][1], v[4][2], v[4][3], v[5][0], v[5][1], v[5][2], v[5][3]}, o[d0], 0, 0, 0); \
        o[d0] = __builtin_amdgcn_mfma_f32_32x32x16_bf16(pa3, (bf16x8){v[6][0], v[6][1], v[6][2], v[6][3], v[7][0], v[7][1], v[7][2], v[7][3]}, o[d0], 0, 0, 0); } while (0)
#define PV_W8(v) asm volatile("s_waitcnt lgkmcnt(8)" : "+v"(v[0]), "+v"(v[1]), "+v"(v[2]), "+v"(v[3]), "+v"(v[4]), "+v"(v[5]), "+v"(v[6]), "+v"(v[7]) :: "memory")
#define PV_W0(v) asm volatile("s_waitcnt lgkmcnt(0)" : "+v"(v[0]), "+v"(v[1]), "+v"(v[2]), "+v"(v[3]), "+v"(v[4]), "+v"(v[5]), "+v"(v[6]), "+v"(v[7]) :: "memory")
    PV_RD(va, 0); PV_RD(vb, 1); PV_W8(va); SBAR(); PV_MM(va, 0);
    PV_RD(va, 2); PV_W8(vb); SBAR(); PV_MM(vb, 1);
    PV_RD(vb, 3); PV_W8(va); SBAR(); PV_MM(va, 2);
    PV_W0(vb); SBAR(); PV_MM(vb, 3);
#undef PV_W0
#undef PV_W8
#undef PV_MM
#undef PV_RD
#undef TRRD
}

template <int KT, int ND0, bool CAUSAL, bool PIPE>
__device__ __forceinline__ void attn_core(const bf16_t* Qlane, const bf16_t* __restrict__ Kh, int ldk, const bf16_t* __restrict__ Vh, int ldv, int NT, int qpos, int qlo, int kch0,
                                          char* lds, f32x16 (&o)[4], float& l_reg) {
    constexpr int PITCH = KT * 2, SHM_K = KVBLK * PITCH, NKL = KT / 64, CPR = KT / 8;
    const int tid = opaque_tid(), wid = __builtin_amdgcn_readfirstlane(tid >> 6), lane = tid & 63, r32 = lane & 31, hi = lane >> 5;
    char* V_lds = lds; char* K_lds = lds + 2 * SHM_V;
    float* ws = (float*)(lds + 2 * SHM_V + 2 * SHM_K) + wid * 64; float* al_l = ws + 32;
    float m_reg = -1e30f; l_reg = 0.f;
#pragma unroll
    for (int d = 0; d < 4; ++d) o[d] = f32x16{};
    bf16x8 qr[ND0];
#pragma unroll
    for (int d0 = 0; d0 < ND0; ++d0) qr[d0] = *reinterpret_cast<const bf16x8*>(Qlane + d0 * 16);
    const int sr = tid >> 4, sc = (tid & 15) * 8, vst0 = v_st(sr, sc), vst1 = v_st(32 + sr, sc);
    const int vb0 = (int)(uintptr_t)V_lds + v_rd_base(lane);
    int krow[NKL], kcc[NKL];
#pragma unroll
    for (int i = 0; i < NKL; ++i) { const int cid = tid + 512 * i; krow[i] = cid / CPR; kcc[i] = cid - krow[i] * CPR; }
    bf16x8 st_v0, st_v1, st_k[NKL];
#define SLOAD(k0) do { st_v0 = *reinterpret_cast<const bf16x8*>(Vh + (size_t)((k0) + sr) * ldv + sc); st_v1 = *reinterpret_cast<const bf16x8*>(Vh + (size_t)((k0) + 32 + sr) * ldv + sc); \
        _Pragma("unroll") for (int i_ = 0; i_ < NKL; ++i_) st_k[i_] = *reinterpret_cast<const bf16x8*>(Kh + (size_t)((k0) + krow[i_]) * ldk + kcc[i_] * 8); } while (0)
#define SWRITE(b) do { *(bf16x8*)(V_lds + (b) * SHM_V + vst0) = st_v0; *(bf16x8*)(V_lds + (b) * SHM_V + vst1) = st_v1; \
        _Pragma("unroll") for (int i_ = 0; i_ < NKL; ++i_) *(bf16x8*)(K_lds + (b) * SHM_K + kswz<PITCH>(krow[i_], kcc[i_] * 16)) = st_k[i_]; } while (0)
#define RESC(a) do { if (__any((a) < 1.f)) { if (hi == 0) al_l[r32] = (a); asm volatile("s_waitcnt lgkmcnt(0)" ::: "memory"); \
        _Pragma("unroll") for (int d_ = 0; d_ < 4; ++d_) _Pragma("unroll") for (int r = 0; r < 16; ++r) o[d_][r] *= al_l[crow(r, hi)]; } } while (0)
#define MASKT(P0_, P1_, t) do { if (CAUSAL) { const int kb_ = (t) * KVBLK; if (kb_ + KVBLK - 1 > qlo) mask_tile(P0_, P1_, qpos - kb_ - 4 * hi); } } while (0)
    if constexpr (PIPE) {
    f32x16 pA0, pA1, pB0, pB1; float alA, alB; bf16x8 pa0, pa1, pa2, pa3;
    SLOAD(0); VM_WAIT(); SWRITE(0); __syncthreads();
    qkt<PITCH, ND0>(pA0, pA1, K_lds, r32, hi, kch0, qr); MASKT(pA0, pA1, 0); partialSM(pA0, pA1, m_reg, alA);
    SLOAD(KVBLK); VM_WAIT(); SWRITE(1); __syncthreads();
    for (int j = 1; j + 1 < NT; j += 2) {
        SBAR(); qkt<PITCH, ND0>(pB0, pB1, K_lds + SHM_K, r32, hi, kch0, qr);
        finishSM(pA0, pA1, alA, l_reg, pa0, pa1, pa2, pa3); SBAR();
        SLOAD((j + 1) * KVBLK); SBAR();
        pv_tile(o, vb0, pa0, pa1, pa2, pa3); MASKT(pB0, pB1, j); partialSM(pB0, pB1, m_reg, alB);
        __syncthreads(); VM_WAIT(); SWRITE(0);
        RESC(alB); __syncthreads();
        SBAR(); qkt<PITCH, ND0>(pA0, pA1, K_lds, r32, hi, kch0, qr);
        finishSM(pB0, pB1, alB, l_reg, pa0, pa1, pa2, pa3); SBAR();
        SLOAD((j + 2) * KVBLK); SBAR();
        pv_tile(o, vb0 + SHM_V, pa0, pa1, pa2, pa3); MASKT(pA0, pA1, j + 1); partialSM(pA0, pA1, m_reg, alA);
        __syncthreads(); VM_WAIT(); SWRITE(1);
        RESC(alA); __syncthreads();
    }
    SBAR(); qkt<PITCH, ND0>(pB0, pB1, K_lds + SHM_K, r32, hi, kch0, qr);
    finishSM(pA0, pA1, alA, l_reg, pa0, pa1, pa2, pa3); SBAR();
    pv_tile(o, vb0, pa0, pa1, pa2, pa3); MASKT(pB0, pB1, NT - 1); partialSM(pB0, pB1, m_reg, alB);
    RESC(alB);
    finishSM(pB0, pB1, alB, l_reg, pa0, pa1, pa2, pa3); SBAR();
    pv_tile(o, vb0 + SHM_V, pa0, pa1, pa2, pa3);
    } else {
    f32x16 p0, p1; float al; bf16x8 pa0, pa1, pa2, pa3;
    SLOAD(0); VM_WAIT(); SWRITE(0); __syncthreads();
    for (int t = 0; t < NT; t += 2) {
        SBAR(); SLOAD((t + 1) * KVBLK); SBAR();
        qkt<PITCH, ND0>(p0, p1, K_lds, r32, hi, kch0, qr); MASKT(p0, p1, t); partialSM(p0, p1, m_reg, al); RESC(al);
        finishSM(p0, p1, al, l_reg, pa0, pa1, pa2, pa3); SBAR();
        pv_tile(o, vb0, pa0, pa1, pa2, pa3);
        VM_WAIT(); SWRITE(1); __syncthreads();
        SBAR(); if (t + 2 < NT) SLOAD((t + 2) * KVBLK); SBAR();
        qkt<PITCH, ND0>(p0, p1, K_lds + SHM_K, r32, hi, kch0, qr); MASKT(p0, p1, t + 1); partialSM(p0, p1, m_reg, al); RESC(al);
        finishSM(p0, p1, al, l_reg, pa0, pa1, pa2, pa3); SBAR();
        pv_tile(o, vb0 + SHM_V, pa0, pa1, pa2, pa3);
        if (t + 2 < NT) { VM_WAIT(); SWRITE(0); } __syncthreads();
    }
    }
#undef SLOAD
#undef SWRITE
#undef RESC
#undef MASKT
}

template <bool NEGM = true>
__device__ __forceinline__ void partialSM_rel(f32x16& p0, f32x16& p1, float& m_reg, f32x16& negm, float& alpha, bool first) {
    float pmax = p0[0];
#pragma unroll
    for (int r = 1; r < 16; ++r) pmax = fmaxf(pmax, p0[r]);
#pragma unroll
    for (int r = 0; r < 16; ++r) pmax = fmaxf(pmax, p1[r]);
    { auto rr = __builtin_amdgcn_permlane32_swap(__float_as_uint(pmax), __float_as_uint(pmax), false, false); pmax = fmaxf(__uint_as_float(rr[0]), __uint_as_float(rr[1])); }
    if (__builtin_expect(!first && __all(pmax <= THRL), 1)) { alpha = 1.f; }
    else { const float dl = first ? pmax : fmaxf(pmax, 0.f); alpha = first ? 1.f : __builtin_amdgcn_exp2f(-dl); m_reg += dl;
#pragma unroll
        for (int r = 0; r < 16; ++r) { p0[r] -= dl; p1[r] -= dl; }
        if constexpr (NEGM) {
#pragma unroll
            for (int r = 0; r < 16; ++r) negm[r] = -m_reg; } }
#pragma unroll
    for (int r = 0; r < 16; ++r) p0[r] = __builtin_amdgcn_exp2f(p0[r]);
}
template <int PITCH, int ND0>
__device__ __forceinline__ void qkt_rel(f32x16& p0, f32x16& p1, const char* Kb, int r32, int hi, int kch0, const bf16x8* qr, const f32x16& negm) {
    const char* kb[4];
#pragma unroll
    for (int dd = 0; dd < 4; ++dd) kb[dd] = Kb + kswz<PITCH>(r32, (kch0 + dd * 2 + hi) * 16);
#pragma unroll
    for (int d0 = 0; d0 < ND0; ++d0) { const char* a = (PITCH % 256 == 0) ? Kb + kswz<PITCH>(r32, (kch0 + d0 * 2 + hi) * 16) : kb[d0 & 3] + (d0 >> 2) * 128;
        const bf16x8 b0 = *reinterpret_cast<const bf16x8*>(a);
        const bf16x8 b1 = *reinterpret_cast<const bf16x8*>(a + 32 * PITCH);
        p0 = __builtin_amdgcn_mfma_f32_32x32x16_bf16(b0, qr[d0], d0 == 0 ? negm : p0, 0, 0, 0);
        p1 = __builtin_amdgcn_mfma_f32_32x32x16_bf16(b1, qr[d0], d0 == 0 ? negm : p1, 0, 0, 0); }
}

template <int PITCH, int ND0, int PF>
__device__ __forceinline__ void qkt_rel_pf(f32x16& p0, f32x16& p1, const char* Kb, int r32, int hi, int kch0, const bf16x8* qr, const f32x16& negm_) {
    static_assert(PITCH % 256 == 128 || ND0 <= 4, "the +128 B immediate offsets need the 3-bit swizzle");
    f32x16 negm = negm_;
    int kb[4];
#pragma unroll
    for (int dd = 0; dd < 4; ++dd) kb[dd] = (int)(uintptr_t)Kb + kswz<PITCH>(r32, (kch0 + dd * 2 + hi) * 16);
    bf16x8 f[PF + 1][2];
#define KRD(d) do { asm volatile("ds_read_b128 %0, %1 offset:%2" : "=v"(f[(d) % (PF + 1)][0]) : "v"(kb[(d) & 3]), "i"(((d) >> 2) * 128)); \
                    asm volatile("ds_read_b128 %0, %1 offset:%2" : "=v"(f[(d) % (PF + 1)][1]) : "v"(kb[(d) & 3]), "i"(((d) >> 2) * 128 + 32 * PITCH)); } while (0)
#pragma unroll
    for (int d = 0; d < PF && d < ND0; ++d) KRD(d);
#pragma unroll
    for (int d0 = 0; d0 < ND0; ++d0) {
        if (d0 + PF < ND0) KRD(d0 + PF);
        const int ahead = (d0 + PF < ND0 ? PF : ND0 - 1 - d0) * 2;
        if (ahead >= 4) asm volatile("s_waitcnt lgkmcnt(4)" : "+v"(f[d0 % (PF + 1)][0]), "+v"(f[d0 % (PF + 1)][1]));
        else if (ahead == 2) asm volatile("s_waitcnt lgkmcnt(2)" : "+v"(f[d0 % (PF + 1)][0]), "+v"(f[d0 % (PF + 1)][1]));
        else asm volatile("s_waitcnt lgkmcnt(0)" : "+v"(f[d0 % (PF + 1)][0]), "+v"(f[d0 % (PF + 1)][1]));
        p0 = __builtin_amdgcn_mfma_f32_32x32x16_bf16(f[d0 % (PF + 1)][0], qr[d0], d0 == 0 ? negm : p0, 0, 0, 0);
        p1 = __builtin_amdgcn_mfma_f32_32x32x16_bf16(f[d0 % (PF + 1)][1], qr[d0], d0 == 0 ? negm : p1, 0, 0, 0);
    }
#undef KRD
}

template <int PITCH, int ND0>
__device__ __forceinline__ void pv_qk(f32x16* o, int vb0, bf16x8 pa0, bf16x8 pa1, bf16x8 pa2, bf16x8 pa3,
                                      f32x16& p0, f32x16& p1, const char* Kb, int r32, int hi, int kch0, const bf16x8* qr, const f32x16& negm_) {
    constexpr int PF = 2;
    static_assert(PITCH % 256 == 128 || ND0 <= 4, "the +128 B immediate offsets need the 3-bit swizzle");
    f32x16 negm = negm_;
    s16x4 va[8], vb[8];
    int kb[4];
#pragma unroll
    for (int dd = 0; dd < 4; ++dd) kb[dd] = (int)(uintptr_t)Kb + kswz<PITCH>(r32, (kch0 + dd * 2 + hi) * 16);
    bf16x8 f[PF + 1][2];
#define TRRD(dst, off) asm volatile("ds_read_b64_tr_b16 %0, %1 offset:%2" : "=&v"(dst) : "v"(vb0), "i"(off) : "memory")
#define PV_RD(v, d0) do { constexpr int b_ = v_rd_off(d0, 0, 0); TRRD(v[0], b_); TRRD(v[1], b_ + 2048); TRRD(v[2], b_ + 4096); TRRD(v[3], b_ + 6144); TRRD(v[4], b_ + 8192); TRRD(v[5], b_ + 10240); TRRD(v[6], b_ + 12288); TRRD(v[7], b_ + 14336); } while (0)
#define PV_MM(v, d0) do { \
        o[d0] = __builtin_amdgcn_mfma_f32_32x32x16_bf16(pa0, (bf16x8){v[0][0], v[0][1], v[0][2], v[0][3], v[1][0], v[1][1], v[1][2], v[1][3]}, o[d0], 0, 0, 0); \
        o[d0] = __builtin_amdgcn_mfma_f32_32x32x16_bf16(pa1, (bf16x8){v[2][0], v[2][1], v[2][2], v[2][3], v[3][0], v[3][1], v[3][2], v[3][3]}, o[d0], 0, 0, 0); \
        o[d0] = __builtin_amdgcn_mfma_f32_32x32x16_bf16(pa2, (bf16x8){v[4][0], v[4][1], v[4][2], v[4][3], v[5][0], v[5][1], v[5][2], v[5][3]}, o[d0], 0, 0, 0); \
        o[d0] = __builtin_amdgcn_mfma_f32_32x32x16_bf16(pa3, (bf16x8){v[6][0], v[6][1], v[6][2], v[6][3], v[7][0], v[7][1], v[7][2], v[7][3]}, o[d0], 0, 0, 0); } while (0)
#define PV_WN(v, n) asm volatile("s_waitcnt lgkmcnt(%8)" : "+v"(v[0]), "+v"(v[1]), "+v"(v[2]), "+v"(v[3]), "+v"(v[4]), "+v"(v[5]), "+v"(v[6]), "+v"(v[7]) : "n"(n) : "memory")
#define KRD(d) do { asm volatile("ds_read_b128 %0, %1 offset:%2" : "=v"(f[(d) % (PF + 1)][0]) : "v"(kb[(d) & 3]), "i"(((d) >> 2) * 128) : "memory"); \
                    asm volatile("ds_read_b128 %0, %1 offset:%2" : "=v"(f[(d) % (PF + 1)][1]) : "v"(kb[(d) & 3]), "i"(((d) >> 2) * 128 + 32 * PITCH) : "memory"); } while (0)
#define PV_RDK(v, ks) do { TRRD(v[0], v_rd_off(0, ks, 0)); TRRD(v[1], v_rd_off(0, ks, 1)); TRRD(v[2], v_rd_off(1, ks, 0)); TRRD(v[3], v_rd_off(1, ks, 1)); \
                            TRRD(v[4], v_rd_off(2, ks, 0)); TRRD(v[5], v_rd_off(2, ks, 1)); TRRD(v[6], v_rd_off(3, ks, 0)); TRRD(v[7], v_rd_off(3, ks, 1)); } while (0)
#define PV_MMK(v, pa) do { \
        o[0] = __builtin_amdgcn_mfma_f32_32x32x16_bf16(pa, (bf16x8){v[0][0], v[0][1], v[0][2], v[0][3], v[1][0], v[1][1], v[1][2], v[1][3]}, o[0], 0, 0, 0); \
        o[1] = __builtin_amdgcn_mfma_f32_32x32x16_bf16(pa, (bf16x8){v[2][0], v[2][1], v[2][2], v[2][3], v[3][0], v[3][1], v[3][2], v[3][3]}, o[1], 0, 0, 0); \
        o[2] = __builtin_amdgcn_mfma_f32_32x32x16_bf16(pa, (bf16x8){v[4][0], v[4][1], v[4][2], v[4][3], v[5][0], v[5][1], v[5][2], v[5][3]}, o[2], 0, 0, 0); \
        o[3] = __builtin_amdgcn_mfma_f32_32x32x16_bf16(pa, (bf16x8){v[6][0], v[6][1], v[6][2], v[6][3], v[7][0], v[7][1], v[7][2], v[7][3]}, o[3], 0, 0, 0); } while (0)
    PV_RDK(va, 0); PV_RDK(vb, 1); PV_WN(va, 8); SBAR(); PV_MMK(va, pa0);
    PV_RDK(va, 2); PV_WN(vb, 8); SBAR(); PV_MMK(vb, pa1);
    PV_RDK(vb, 3); PV_WN(va, 8); SBAR(); PV_MMK(va, pa2);
    KRD(0); KRD(1);
    PV_WN(vb, 4); SBAR(); PV_MMK(vb, pa3);
#undef PV_MMK
#undef PV_RDK
    SBAR();
#pragma unroll
    for (int d0 = 0; d0 < ND0; ++d0) {
        if (d0 + PF < ND0) KRD(d0 + PF);
        const int ahead = (d0 + PF < ND0 ? PF : ND0 - 1 - d0) * 2;
        if (ahead >= 4) asm volatile("s_waitcnt lgkmcnt(4)" : "+v"(f[d0 % (PF + 1)][0]), "+v"(f[d0 % (PF + 1)][1]) :: "memory");
        else if (ahead == 2) asm volatile("s_waitcnt lgkmcnt(2)" : "+v"(f[d0 % (PF + 1)][0]), "+v"(f[d0 % (PF + 1)][1]) :: "memory");
        else asm volatile("s_waitcnt lgkmcnt(0)" : "+v"(f[d0 % (PF + 1)][0]), "+v"(f[d0 % (PF + 1)][1]) :: "memory");
        p0 = __builtin_amdgcn_mfma_f32_32x32x16_bf16(f[d0 % (PF + 1)][0], qr[d0], d0 == 0 ? negm : p0, 0, 0, 0);
        p1 = __builtin_amdgcn_mfma_f32_32x32x16_bf16(f[d0 % (PF + 1)][1], qr[d0], d0 == 0 ? negm : p1, 0, 0, 0);
    }
#undef KRD
#undef PV_WN
#undef PV_MM
#undef PV_RD
#undef TRRD
}

__device__ __forceinline__ void glds16(unsigned lds_addr, const void* sbase, unsigned voff) {
    unsigned keep;
    asm volatile("s_mov_b32 %0, m0\n\ts_mov_b32 m0, %1\n\ts_nop 0\n\tglobal_load_lds_dwordx4 %2, %3\n\ts_mov_b32 m0, %0" : "=&s"(keep) : "s"(lds_addr), "v"(voff), "s"(sbase) : "memory");
}
template <int KT, int ND0, bool CAUSAL>
__device__ __forceinline__ void attn_core_ring(const bf16_t* Qlane, const bf16_t* __restrict__ Kh, int ldk, const bf16_t* __restrict__ Vh, int ldv, int NT, int qpos, int qlo, int kch0,
                                               char* lds, f32x16 (&o)[4], float& l_reg) {
    constexpr int PITCH = KT * 2, SHM_K = KVBLK * PITCH, NKP = SHM_K / 8192, NVP = SHM_V / 8192;
    const int tid = opaque_tid(), wid = __builtin_amdgcn_readfirstlane(tid >> 6), lane = tid & 63, r32 = lane & 31, hi = lane >> 5;
    char* V_lds = lds; char* K_lds = lds + 3 * SHM_V;
    float* ws = (float*)(lds + 3 * SHM_V + 3 * SHM_K) + wid * 64; float* al_l = ws + 32;
    float m_reg = 0.f; l_reg = 0.f; f32x16 negm = f32x16{};
#pragma unroll
    for (int d = 0; d < 4; ++d) o[d] = f32x16{};
    bf16x8 qr[ND0];
#pragma unroll
    for (int d0 = 0; d0 < ND0; ++d0) qr[d0] = *reinterpret_cast<const bf16x8*>(Qlane + d0 * 16);
    const int vb0 = (int)(uintptr_t)V_lds + v_rd_base(lane);
    unsigned koff[NKP], voff[NVP];
#pragma unroll
    for (int i = 0; i < NKP; ++i) { const int a = (wid * NKP + i) * 1024 + lane * 16, row = a / PITCH, cpos = (a - row * PITCH) >> 4, f = kfl<PITCH>(row);
        const int chunk = cpos ^ f; koff[i] = (unsigned)(row * ldk * 2 + chunk * 16); }
#pragma unroll
    for (int i = 0; i < NVP; ++i) { const int a = (wid * NVP + i) * 1024 + lane * 16, sub = a >> 9, rem = a & 511, kk = (sub >> 2) * 8 + (rem >> 6), c = (sub & 3) * 32 + ((rem & 63) >> 1);
        const int k = (kk & ~0xC) | ((kk & 4) << 1) | ((kk & 8) >> 1); voff[i] = (unsigned)(k * ldv * 2 + c * 2); }
    const unsigned ldsK = (unsigned)(uintptr_t)K_lds + (unsigned)(wid * NKP) * 1024u, ldsV = (unsigned)(uintptr_t)V_lds + (unsigned)(wid * NVP) * 1024u;
#define DMA_TILE(t, slot) do { const char* kb_ = (const char*)Kh + (size_t)(t) * KVBLK * ldk * 2; const char* vb_ = (const char*)Vh + (size_t)(t) * KVBLK * ldv * 2; \
        _Pragma("unroll") for (int i_ = 0; i_ < NKP; ++i_) glds16(ldsK + (slot) * SHM_K + i_ * 1024, kb_, koff[i_]); \
        _Pragma("unroll") for (int i_ = 0; i_ < NVP; ++i_) glds16(ldsV + (slot) * SHM_V + i_ * 1024, vb_, voff[i_]); } while (0)
#define RING_SYNC(more) do { if (more) asm volatile("s_waitcnt vmcnt(%0)" :: "n"(NKP + NVP) : "memory"); else asm volatile("s_waitcnt vmcnt(0)" ::: "memory"); \
        asm volatile("s_waitcnt lgkmcnt(0)" ::: "memory"); __builtin_amdgcn_s_barrier(); asm volatile("" ::: "memory"); } while (0)
#define RESC(a) do { if (__any((a) < 1.f)) { if (hi == 0) al_l[r32] = (a); asm volatile("s_waitcnt lgkmcnt(0)" ::: "memory"); \
        _Pragma("unroll") for (int d_ = 0; d_ < 4; ++d_) _Pragma("unroll") for (int r = 0; r < 16; ++r) o[d_][r] *= al_l[crow(r, hi)]; } } while (0)
#define MASKT(P0_, P1_, t) do { if (CAUSAL) { const int kb_ = (t) * KVBLK; if (kb_ + KVBLK - 1 > qlo) mask_tile(P0_, P1_, qpos - kb_ - 4 * hi); } } while (0)
    f32x16 p0, p1; float al; bf16x8 pa0, pa1, pa2, pa3;
    asm volatile("s_waitcnt vmcnt(0)" ::: "memory");
#pragma unroll
    for (int d0 = 0; d0 < ND0; ++d0) asm volatile("" : "+v"(qr[d0]));
    DMA_TILE(0, 0); if (NT > 1) DMA_TILE(1, 1);
    RING_SYNC(NT > 1);
    int slot = 0;
    for (int t = 0; t < NT; ++t) {
        const int s2 = slot == 0 ? 2 : slot - 1;
        SBAR(); if (t + 2 < NT) DMA_TILE(t + 2, s2); SBAR();
        qkt_rel_pf<PITCH, ND0, 2>(p0, p1, K_lds + slot * SHM_K, r32, hi, kch0, qr, negm); MASKT(p0, p1, t); partialSM_rel(p0, p1, m_reg, negm, al, t == 0); RESC(al);
        finishSM(p0, p1, al, l_reg, pa0, pa1, pa2, pa3); SBAR();
        pv_tile(o, vb0 + slot * SHM_V, pa0, pa1, pa2, pa3);
        RING_SYNC(t + 2 < NT);
        slot = slot == 2 ? 0 : slot + 1;
    }
#undef DMA_TILE
#undef RING_SYNC
#undef RESC
#undef MASKT
}
template <int KT, int ND0, bool CAUSAL, bool NEGM>
__device__ __forceinline__ void attn_core_pp(const bf16_t* Qlane, const bf16_t* __restrict__ Kh, int ldk, const bf16_t* __restrict__ Vh, int ldv, int NT, int qpos, int qlo, int kch0,
                                             char* lds, f32x16 (&o)[4], float& l_reg) {
    constexpr int PITCH = KT * 2, SHM_K = KVBLK * PITCH, NKP = SHM_K / 8192, NVP = SHM_V / 8192;
    const int tid = opaque_tid(), wid = __builtin_amdgcn_readfirstlane(tid >> 6), lane = tid & 63, r32 = lane & 31, hi = lane >> 5;
    const bool grpB = wid >= 4;
    char* V_lds = lds; char* K_lds = lds + 3 * SHM_V;
    float* ws = (float*)(lds + 3 * SHM_V + 3 * SHM_K) + wid * 64; float* al_l = ws + 32;
    float m_reg = 0.f; l_reg = 0.f; f32x16 negm = f32x16{};
#pragma unroll
    for (int d = 0; d < 4; ++d) o[d] = f32x16{};
    bf16x8 qr[ND0];
#pragma unroll
    for (int d0 = 0; d0 < ND0; ++d0) qr[d0] = *reinterpret_cast<const bf16x8*>(Qlane + d0 * 16);
    const int vb0 = (int)(uintptr_t)V_lds + v_rd_base(lane);
    unsigned koff[NKP], voff[NVP];
#pragma unroll
    for (int i = 0; i < NKP; ++i) { const int a = (wid * NKP + i) * 1024 + lane * 16, row = a / PITCH, cpos = (a - row * PITCH) >> 4, f = kfl<PITCH>(row);
        const int chunk = cpos ^ f; koff[i] = (unsigned)(row * ldk * 2 + chunk * 16); }
#pragma unroll
    for (int i = 0; i < NVP; ++i) { const int a = (wid * NVP + i) * 1024 + lane * 16, sub = a >> 9, rem = a & 511, kk = (sub >> 2) * 8 + (rem >> 6), c = (sub & 3) * 32 + ((rem & 63) >> 1);
        const int k = (kk & ~0xC) | ((kk & 4) << 1) | ((kk & 8) >> 1); voff[i] = (unsigned)(k * ldv * 2 + c * 2); }
    const unsigned ldsK = (unsigned)(uintptr_t)K_lds + (unsigned)(wid * NKP) * 1024u, ldsV = (unsigned)(uintptr_t)V_lds + (unsigned)(wid * NVP) * 1024u;
#define DMA_K(t, slot) do { const char* kb_ = (const char*)Kh + (size_t)(t) * KVBLK * ldk * 2; _Pragma("unroll") for (int i_ = 0; i_ < NKP; ++i_) glds16(ldsK + (slot) * SHM_K + i_ * 1024, kb_, koff[i_]); } while (0)
#define DMA_V(t, slot) do { const char* vb_ = (const char*)Vh + (size_t)(t) * KVBLK * ldv * 2; _Pragma("unroll") for (int i_ = 0; i_ < NVP; ++i_) glds16(ldsV + (slot) * SHM_V + i_ * 1024, vb_, voff[i_]); } while (0)
#define ISSUE(u, ksl, vsl) do { if ((u) < NT) DMA_K(u, ksl); if ((u) - 1 < NT) DMA_V((u) - 1, vsl); } while (0)
#define PAIR_WAIT(t) do { if ((t) + 2 < NT) asm volatile("s_waitcnt vmcnt(%0)" :: "n"(NKP + NVP) : "memory"); else if ((t) + 2 == NT) asm volatile("s_waitcnt vmcnt(%0)" :: "n"(NVP) : "memory"); \
        else asm volatile("s_waitcnt vmcnt(0)" ::: "memory"); } while (0)
#define BAR() do { SBAR(); asm volatile("s_waitcnt lgkmcnt(0)" ::: "memory"); __builtin_amdgcn_s_barrier(); asm volatile("" ::: "memory"); SBAR(); } while (0)
#define RESC(a) do { if (__any((a) < 1.f)) { if (hi == 0) al_l[r32] = (a); asm volatile("s_waitcnt lgkmcnt(0)" ::: "memory"); \
        _Pragma("unroll") for (int d_ = 0; d_ < 4; ++d_) _Pragma("unroll") for (int r = 0; r < 16; ++r) o[d_][r] *= al_l[crow(r, hi)]; } } while (0)
#define MASKT(P0_, P1_, t) do { if (CAUSAL) { const int kb_ = (t) * KVBLK; if (kb_ + KVBLK - 1 > qlo) mask_tile(P0_, P1_, qpos - kb_ - 4 * hi); } } while (0)
    f32x16 p0, p1; float al; bf16x8 pa0, pa1, pa2, pa3;
    asm volatile("s_waitcnt vmcnt(0)" ::: "memory");
#pragma unroll
    for (int d0 = 0; d0 < ND0; ++d0) asm volatile("" : "+v"(qr[d0]));
    DMA_K(0, 0);
    if (NT > 1) DMA_K(1, 1);
    DMA_V(0, 0);
    if (NT > 1) asm volatile("s_waitcnt vmcnt(%0)" :: "n"(NKP + NVP) : "memory"); else asm volatile("s_waitcnt vmcnt(%0)" :: "n"(NVP) : "memory");
    BAR();
    if (grpB) { ISSUE(2, 2, 1); BAR(); }
#define QK_(ksl) do { if constexpr (NEGM) qkt_rel_pf<PITCH, ND0, 2>(p0, p1, K_lds + (ksl) * SHM_K, r32, hi, kch0, qr, negm); \
        else { f32x16 c_; const float nm_ = -m_reg; _Pragma("unroll") for (int r = 0; r < 16; ++r) c_[r] = nm_; qkt_rel_pf<PITCH, ND0, 2>(p0, p1, K_lds + (ksl) * SHM_K, r32, hi, kch0, qr, c_); } } while (0)
#define Y_(t_, first_) do { MASKT(p0, p1, t_); partialSM_rel<NEGM>(p0, p1, m_reg, negm, al, first_); RESC(al); finishSM(p0, p1, al, l_reg, pa0, pa1, pa2, pa3); } while (0)
    QK_(0);
    if (grpB) PAIR_WAIT(0);
    BAR();
    if (grpB) ISSUE(3, 0, 2); else ISSUE(2, 2, 1);
    SBAR();
    Y_(0, true);
    if (!grpB) PAIR_WAIT(0);
    BAR();
    int ks = 1;
    for (int t = 1; t < NT; ++t) {
        const int kp = ks == 0 ? 2 : ks - 1, kn = ks == 2 ? 0 : ks + 1;
        if constexpr (NEGM) pv_qk<PITCH, ND0>(o, vb0 + kp * SHM_V, pa0, pa1, pa2, pa3, p0, p1, K_lds + ks * SHM_K, r32, hi, kch0, qr, negm);
        else { f32x16 c_; const float nm_ = -m_reg; _Pragma("unroll") for (int r = 0; r < 16; ++r) c_[r] = nm_; pv_qk<PITCH, ND0>(o, vb0 + kp * SHM_V, pa0, pa1, pa2, pa3, p0, p1, K_lds + ks * SHM_K, r32, hi, kch0, qr, c_); }
#ifdef PROBE_XMFMA
        if constexpr (ND0 == 4) { f32x16 dz_ = f32x16{}; _Pragma("unroll") for (int i_ = 0; i_ < PROBE_XMFMA; ++i_) asm volatile("v_mfma_f32_32x32x16_bf16 %0, %1, %2, %0" : "+v"(dz_) : "v"(qr[0]), "v"(qr[1])); asm volatile("s_nop 15\n\ts_nop 15" :: "v"(dz_)); }
#endif
        if (grpB) PAIR_WAIT(t);
        BAR();
        if (grpB) ISSUE(t + 3, ks, kp); else ISSUE(t + 2, kp, kn);
        SBAR();
        Y_(t, false);
#ifdef PROBE_YEXP
        if constexpr (ND0 == 4) { float dm_ = al; _Pragma("unroll") for (int i_ = 0; i_ < PROBE_YEXP; ++i_) asm volatile("v_exp_f32 %0, %1" : "=v"(dm_) : "v"(al)); asm volatile("" :: "v"(dm_)); }
#endif

        if (!grpB) PAIR_WAIT(t);
        BAR();
        ks = kn;
    }
    pv_tile(o, vb0 + (ks == 0 ? 2 : ks - 1) * SHM_V, pa0, pa1, pa2, pa3);
    BAR();
#undef QK_
#undef Y_
    if (!grpB) BAR();
#undef DMA_K
#undef DMA_V
#undef ISSUE
#undef PAIR_WAIT
#undef BAR
#undef RESC
#undef MASKT
}
__device__ __forceinline__ void normalize_o(f32x16 (&o)[4], float l_reg, float* ws, int r32, int hi) {
    if (hi == 0) ws[r32] = l_reg; asm volatile("s_waitcnt lgkmcnt(0)" ::: "memory");
#pragma unroll
    for (int r = 0; r < 16; ++r) { const float rl = __builtin_amdgcn_rcpf(ws[crow(r, hi)]);
#pragma unroll
        for (int d0 = 0; d0 < 4; ++d0) o[d0][r] *= rl; }
}
__device__ __forceinline__ void store_o_bf16(const f32x16 (&o)[4], bf16_t* Ow, int ldo, int r32, int hi) {
#pragma unroll
    for (int r = 0; r < 16; ++r) { const int orow = crow(r, hi);
#pragma unroll
        for (int d0 = 0; d0 < 4; ++d0) { const float v = o[d0][r]; const float vn = shflx(v, 1, hi * 32 + r32);
            if ((r32 & 1) == 0) *(unsigned*)(Ow + (size_t)orow * ldo + d0 * 32 + r32) = cvt_pk_bf16(v, vn); } }
}
}

constexpr size_t MiB = 1u << 20;
constexpr size_t WS_CTL = 0, CTL_ZERO_BYTES = 4 * MiB;
constexpr size_t WS_SSQ = 1 * MiB;
constexpr size_t WS_W = 4 * MiB, LW_BYTES = 269 * MiB / 2;
constexpr size_t LW_IN = 0, LW_QUP = 44 * MiB, LW_KVUP = LW_QUP + 3 * MiB / 2, LW_GLU = LW_KVUP + 1 * MiB, LW_BR = LW_GLU + 4 * MiB, LW_OUT = LW_BR + 12 * MiB,
                 LW_XQ = LW_OUT + 8 * MiB, LW_XKV = LW_XQ + 2 * MiB, LW_XO = LW_XKV + 4 * MiB, LW_TEXT = LW_XO + 2 * MiB, LW_WSL = LW_TEXT + 40 * MiB;
static_assert(LW_WSL + 16 * MiB == LW_BYTES, "layer weight block");
constexpr size_t WS_FFN = WS_W + 2 * LW_BYTES;
constexpr size_t WS_MOE = WS_FFN + 66 * MiB;
constexpr size_t WS_XS = WS_MOE + 8 * 66 * MiB + 1 * MiB;
static_assert(WS_XS == 868 * MiB, "map");
constexpr size_t WS_XN = WS_XS + 128 * MiB;
constexpr size_t WS_TABD = WS_XN + 64 * MiB, WS_TABM = WS_TABD + 1 * MiB, WS_XKV = WS_TABM + 4 * MiB, WS_MEMB = WS_XKV + 1 * MiB, WS_ROUTE = WS_MEMB + 1 * MiB, WS_ORDER = WS_ROUTE + 1 * MiB;
constexpr size_t WS_A32 = WS_ORDER + 64 * 1024;
constexpr size_t WS_PSQ = WS_ORDER + 1 * MiB;
constexpr size_t WS_MIX = WS_TABD + 12 * MiB;
static_assert(WS_MIX == 1072 * MiB, "map");
constexpr size_t WS_QD = WS_MIX, WS_KD = WS_QD + 32 * MiB, WS_VD = WS_KD + 32 * MiB, WS_MQ = WS_VD + 32 * MiB, WS_MKV = WS_MQ + 16 * MiB, WS_KM = WS_MKV + 8 * MiB, WS_VM = WS_KM + 48 * MiB,
                 WS_QM = WS_VM + 32 * MiB, WS_SU = WS_QM + 48 * MiB, WS_GATES = WS_SU + 40 * MiB, WS_SLOC = WS_GATES + 192 * MiB, WS_YG = WS_SLOC + 16 * MiB, WS_BR = WS_YG + 32 * MiB,
                 WS_TMP = WS_BR + 96 * MiB, WS_MG = WS_TMP + 128 * MiB, WS_XQ = WS_MG + 64 * MiB, WS_XO = WS_XQ + 16 * MiB, WS_XN8 = WS_XO + 16 * MiB  , WS_END = WS_XN8 + 32 * MiB;
static_assert(WS_END == 1952 * MiB, "map");
constexpr size_t WS_XG = WS_MIX, WS_HG = WS_XG + 136 * MiB, WS_OG = WS_HG + 374 * MiB;
static_assert(WS_OG + 272 * MiB <= WS_XQ, "ffn overlay");
constexpr int CW_TMO = 0, CW_DBG = 2, CW_BAR = 4096, CW_ATTQ = 16384, CW_MOECNT = 16640, CW_MOECUR = 16704;

#define XB_TMO      128
#define XB_XCNT(j)  (256  + 64 * (j))
#define XB_XSUB(j)  (1280 + 64 * (j))
#define XB_XGEN(j)  (2304 + 64 * (j))
#define XB_TOP      3328
#define XB_TOPGEN   3392
#define XCD_BAR_WORDS 3456
#define XB_SPIN_CAP (1u << 22)
__device__ __forceinline__ unsigned xb_ld(unsigned* p)              { return __hip_atomic_load(p, __ATOMIC_RELAXED, __HIP_MEMORY_SCOPE_AGENT); }
__device__ __forceinline__ unsigned xb_add(unsigned* p, unsigned v) { return __hip_atomic_fetch_add(p, v, __ATOMIC_RELAXED, __HIP_MEMORY_SCOPE_AGENT); }
__device__ __forceinline__ unsigned xb_xcc_id() { return (unsigned)__builtin_amdgcn_s_getreg((3 << 11) | 20) & 0xFu; }
#define XB_SPIN(cond, bar) do { unsigned _sp = 0; while (cond) { __builtin_amdgcn_s_sleep(1); \
    if ((++_sp & 255u) == 0u) { if (xb_ld(&(bar)[XB_TMO])) break; if (_sp > XB_SPIN_CAP) { atomicAdd(&(bar)[XB_TMO], 1u); break; } } } } while (0)
struct XcdBarrier { unsigned* bar; unsigned x; volatile LAS unsigned* st; };
__device__ __forceinline__ XcdBarrier xcd_barrier_post(unsigned* bar, volatile LAS unsigned* st) {
    XcdBarrier b; b.bar = bar; b.x = xb_xcc_id(); b.st = st;
    if (threadIdx.x == 0) (void)xb_add(&bar[XB_XCNT(b.x)], 1u);
    return b;
}
__device__ __forceinline__ void xcd_barrier_complete(unsigned* bar, unsigned x, unsigned& nloc, unsigned& nx) {
    const unsigned G = gridDim.x * gridDim.y * gridDim.z;
    unsigned sum, cnt, mine, sp = 0u;
    for (;;) {
        sum = 0u; cnt = 0u; mine = 0u;
#pragma nounroll
        for (unsigned j = 0; j < 16; ++j) { const unsigned c = xb_ld(&bar[XB_XCNT(j)]); sum += c; cnt += (c > 0u) ? 1u : 0u; mine = (j == x) ? c : mine; }
        if (sum == G) break;
        __builtin_amdgcn_s_sleep(1);
        if ((++sp & 255u) == 0u) { if (xb_ld(&bar[XB_TMO])) break; if (sp > XB_SPIN_CAP) { atomicAdd(&bar[XB_TMO], 1u); break; } }
    }
    nloc = mine > 0u ? mine : 1u; nx = cnt > 0u ? cnt : 1u;
}
__device__ __forceinline__ void xcd_barrier_setup(const XcdBarrier& b) {
    if (threadIdx.x == 0) { unsigned nloc, nx; xcd_barrier_complete(b.bar, b.x, nloc, nx); b.st[0] = nloc; b.st[1] = nx; }
    __syncthreads();
}
__device__ __forceinline__ void xcd_barrier(const XcdBarrier& b) {
    asm volatile("s_waitcnt vmcnt(0)" ::: "memory");
    __syncthreads();
    if (opaque_tid() == 0) {
        unsigned* bar = b.bar;
        __builtin_amdgcn_s_waitcnt(0);
        const unsigned nloc = b.st[0], nx = b.st[1];
        const unsigned old = xb_add(&bar[XB_XSUB(b.x)], 1u);
        const unsigned gen = old / nloc;
        if (old + 1u == (gen + 1u) * nloc) {
            __builtin_amdgcn_fence(__ATOMIC_RELEASE, "agent");
            asm volatile("s_waitcnt vmcnt(0)" ::: "memory");
            const unsigned og = xb_add(&bar[XB_TOP], 1u);
            const unsigned tg = og / nx;
            if (og + 1u == (tg + 1u) * nx) xb_add(&bar[XB_TOPGEN], 1u);
            else XB_SPIN(xb_ld(&bar[XB_TOPGEN]) == tg, bar);
            __builtin_amdgcn_fence(__ATOMIC_ACQUIRE, "agent");
            xb_add(&bar[XB_XGEN(b.x)], 1u);
            asm volatile("s_waitcnt vmcnt(0)" ::: "memory");
        } else {
            XB_SPIN(xb_ld(&bar[XB_XGEN(b.x)]) == gen, bar);
            __builtin_amdgcn_fence(__ATOMIC_ACQUIRE, "agent");
            asm volatile("s_waitcnt vmcnt(0)" ::: "memory");
        }
    }
    __syncthreads();
}

struct Args { const void* in[35]; float* out; unsigned char* ws; int ph_lo, ph_hi; };
struct PTab { volatile LAS unsigned long long* t; __device__ __forceinline__ const void* operator[](int i) const { const unsigned long long v = t[i];
    const unsigned lo_ = __builtin_amdgcn_readfirstlane((unsigned)v), hi_ = __builtin_amdgcn_readfirstlane((unsigned)(v >> 32)); return (const void*)(GAS const char*)(((unsigned long long)hi_ << 32) | lo_); } };
struct ArgsD { PTab in; unsigned char* ws; };
enum { I_X = 0, I_MEM, I_POS, I_WIN, I_WQUP, I_WKVUP, I_QNG, I_KVNG, I_DLAM, I_SUBLN, I_LRE, I_LIM, I_BRE, I_BIM, I_CRE, I_CIM, I_SSMD, I_LOGDT, I_GLUW, I_WBR, I_WOUT, I_LNMG, I_LNMB,
       I_WXQ, I_WXKV, I_WXO, I_LNXG, I_LNXB, I_FGU, I_FDN, I_ROUTER, I_MGU, I_MDN, I_LNFG, I_LNFB };
constexpr int NPL = 16, NPHASE = 1 + DEPTH * NPL;
constexpr int LDS_BYTES = 147456;
constexpr int LDS_MISC = 131072 + 8192;

__device__ __forceinline__ float lam_init_of(int l) { return l == 0 ? 0.2f : 0.35550906759f; }

struct Mat { const float* src; bf16_t* dst; int K, N, kind; const float* ksc; int kmod; float kmul; int fp8; };
__device__ __forceinline__ int map_row(int kind, int n, int N) {
    if (kind == 0) return n;
    if (kind == 1) {
        if (n < 2048) { const int hc = n & 63; if (hc < 16) return (n - hc) + (hc < 8 ? 2 * hc : 2 * (hc - 8) + 1); return n; }
        if (n < 3840) return n;
        if (n < 3904) { const int hc = n - 3840; return 3840 + (hc < 32 ? 2 * hc : 2 * (hc - 32) + 1); }
        return n + 192;
    }
    if (kind == 2) { const int h = n / 192; int hc = n - h * 192; if (hc >= 128) { const int r = hc - 128; hc = 128 + (r < 32 ? 2 * r : 2 * (r - 32) + 1); } return h * 192 + hc; }
    const int half = N >> 1;
    if (n < half) return (n >> 7) * 256 + (n & 127);
    const int mm = n - half; return (mm >> 7) * 256 + 128 + (mm & 127);
}
__device__ __forceinline__ Mat get_mat(const ArgsD& a, int id) {
    Mat m; m.ksc = nullptr; m.kmod = 1; m.kmul = 1.f; m.kind = 0; m.fp8 = 0;
    unsigned char* ws = a.ws;
    if (id < 22) { const int l = id / 11, k = id % 11; unsigned char* lw = ws + WS_W + (size_t)l * LW_BYTES;
        switch (k) {
        case 0: m.src = (const float*)a.in[I_WIN] + (size_t)l * D * NIN_SRC; m.dst = (bf16_t*)(lw + LW_IN); m.K = D; m.N = NIN_SRC; m.kind = 1; break;
        case 1: m.src = (const float*)a.in[I_WQUP] + (size_t)l * 512 * 1536; m.dst = (bf16_t*)(lw + LW_QUP); m.K = 512; m.N = 1536; m.kind = 2; m.ksc = (const float*)a.in[I_QNG] + l * 512; m.kmod = 512; break;
        case 2: m.src = (const float*)a.in[I_WKVUP] + (size_t)l * 256 * 2048; m.dst = (bf16_t*)(lw + LW_KVUP); m.K = 256; m.N = 2048; m.ksc = (const float*)a.in[I_KVNG] + l * 256; m.kmod = 256; break;
        case 3: m.src = (const float*)a.in[I_GLUW] + (size_t)l * 1024 * 2048; m.dst = (bf16_t*)(lw + LW_GLU); m.K = 1024; m.N = 2048; m.kind = 3; break;
        case 4: m.src = (const float*)a.in[I_WBR] + (size_t)(l * 3 + 0) * 1024 * 2048; m.dst = (bf16_t*)(lw + LW_BR); m.K = 1024; m.N = 2048; m.ksc = (const float*)a.in[I_SUBLN] + l * 128; m.kmod = 128; m.kmul = 1.f - lam_init_of(l); break;
        case 5: m.src = (const float*)a.in[I_WBR] + (size_t)(l * 3 + 1) * 1024 * 2048; m.dst = (bf16_t*)(lw + LW_BR + 4 * MiB); m.K = 1024; m.N = 2048; break;
        case 6: m.src = (const float*)a.in[I_WBR] + (size_t)(l * 3 + 2) * 1024 * 2048; m.dst = (bf16_t*)(lw + LW_BR + 8 * MiB); m.K = 1024; m.N = 2048; break;
        case 7: m.src = (const float*)a.in[I_WOUT] + (size_t)l * 2048 * 2048; m.dst = (bf16_t*)(lw + LW_OUT); m.K = 2048; m.N = 2048; break;
        case 8: m.src = (const float*)a.in[I_WXQ] + (size_t)l * 2048 * 512; m.dst = (bf16_t*)(lw + LW_XQ); m.K = 2048; m.N = 512; break;
        case 9: m.src = (const float*)a.in[I_WXKV] + (size_t)l * 2048 * 1024; m.dst = (bf16_t*)(lw + LW_XKV); m.K = 2048; m.N = 1024; break;
        default: m.src = (const float*)a.in[I_WXO] + (size_t)l * 512 * 2048; m.dst = (bf16_t*)(lw + LW_XO); m.K = 512; m.N = 2048; break;
        }
    } else if (id == 22) { m.src = (const float*)a.in[I_FGU]; m.dst = (bf16_t*)(ws + WS_FFN); m.K = D; m.N = 2 * DFF; m.kind = 3; }
    else if (id == 23) { m.src = (const float*)a.in[I_FDN]; m.dst = (bf16_t*)(ws + WS_FFN + 44 * MiB); m.K = DFF; m.N = D; }
    else { const int e = (id - 24) >> 1;
        m.fp8 = 1;
        if (((id - 24) & 1) == 0) { m.src = (const float*)a.in[I_MGU] + (size_t)e * D * 2 * DFF; m.dst = (bf16_t*)(ws + WS_MOE + (size_t)e * 66 * MiB); m.K = D; m.N = 2 * DFF; m.kind = 3; m.kmul = 64.f; }
        else { m.src = (const float*)a.in[I_MDN] + (size_t)e * DFF * D; m.dst = (bf16_t*)(ws + WS_MOE + (size_t)e * 66 * MiB + 44 * MiB); m.K = DFF; m.N = D; m.kmul = 256.f; }
    }
    return m;
}
constexpr int NMAT = 40;
__device__ __forceinline__ void cvt_item(const Mat& mt, LAS float* scr, int item, int lane) {
    const int nblk = mt.N / 64, kb = item / nblk, nb = item - kb * nblk, k0 = 64 * kb, n0 = 64 * nb;
    const bool g8 = mt.kind == 1 && n0 >= 3072;
    const bool f8 = mt.fp8 || g8; const float kmul = g8 ? 64.f : mt.kmul;
    const int lr = lane >> 4, lc = (lane & 15) * 4;
    f32x4 v[16];
#pragma unroll
    for (int i = 0; i < 16; ++i) v[i] = *(const f32x4*)(mt.src + (size_t)(k0 + 4 * i + lr) * mt.N + n0 + lc);
    if (mt.ksc) {
#pragma unroll
        for (int i = 0; i < 16; ++i) v[i] = v[i] * (mt.ksc[(k0 + 4 * i + lr) % mt.kmod] * mt.kmul); }
    else if (f8) {
#pragma unroll
        for (int i = 0; i < 16; ++i) v[i] = v[i] * kmul; }
#pragma unroll
    for (int i = 0; i < 16; ++i) { LAS float* p = scr + (4 * i + lr) * 65 + lc; p[0] = v[i][0]; p[1] = v[i][1]; p[2] = v[i][2]; p[3] = v[i][3]; }
    LDS_WAIT(); asm volatile("" ::: "memory");
    const int c = lane & 7;
#pragma unroll
    for (int j = 0; j < 8; ++j) { const int n = (lane >> 3) + 8 * j; const LAS float* s = scr + (8 * c) * 65 + n;
        if (f8) { const u32x2 o = pack8_fp8((f32x4){s[0 * 65], s[1 * 65], s[2 * 65], s[3 * 65]}, (f32x4){s[4 * 65], s[5 * 65], s[6 * 65], s[7 * 65]}); const int r_ = map_row(mt.kind, n0 + n, mt.N);
            unsigned char* d8 = g8 ? (unsigned char*)mt.dst + (size_t)NIN_BF * mt.K * 2 + (size_t)(r_ - NIN_BF) * mt.K : (unsigned char*)mt.dst + (size_t)r_ * mt.K;
            *(u32x2*)(d8 + k0 + 8 * c) = o; }
        else { u32x4 o; o.x = cvt_pk_bf16(s[0 * 65], s[1 * 65]); o.y = cvt_pk_bf16(s[2 * 65], s[3 * 65]); o.z = cvt_pk_bf16(s[4 * 65], s[5 * 65]); o.w = cvt_pk_bf16(s[6 * 65], s[7 * 65]);
            *(u32x4*)(mt.dst + (size_t)map_row(mt.kind, n0 + n, mt.N) * mt.K + k0 + 8 * c) = o; } }
    LDS_WAIT(); asm volatile("" ::: "memory");
}
__device__ __forceinline__ void cvt_tile_wg(const Mat& mt, LAS float* scr, int tile, int tid) {
    const int nblk = mt.N / 256, kb = tile / nblk, nb = tile - kb * nblk, k0 = 64 * kb, n0 = 256 * nb;
    const int lane = tid & 63, w = tid >> 6;
    f32x4 v[8];
#pragma unroll
    for (int i = 0; i < 8; ++i) v[i] = *(const f32x4*)(mt.src + (size_t)(k0 + 8 * w + i) * mt.N + n0 + lane * 4);
    if (mt.ksc) {
#pragma unroll
        for (int i = 0; i < 8; ++i) v[i] = v[i] * (mt.ksc[(k0 + 8 * w + i) % mt.kmod] * mt.kmul); }
    else if (mt.fp8) {
#pragma unroll
        for (int i = 0; i < 8; ++i) v[i] = v[i] * mt.kmul; }
#pragma unroll
    for (int i = 0; i < 8; ++i) { LAS float* p = scr + (8 * w + i) * 257 + lane * 4; p[0] = v[i][0]; p[1] = v[i][1]; p[2] = v[i][2]; p[3] = v[i][3]; }
    __syncthreads();
    const int c = tid & 7;
#pragma unroll
    for (int j = 0; j < 4; ++j) { const int n = (tid >> 3) + 64 * j; const LAS float* s = scr + (8 * c) * 257 + n; const int r_ = map_row(mt.kind, n0 + n, mt.N);
        if (mt.fp8) *(u32x2*)((unsigned char*)mt.dst + (size_t)r_ * mt.K + k0 + 8 * c) = pack8_fp8((f32x4){s[0 * 257], s[1 * 257], s[2 * 257], s[3 * 257]}, (f32x4){s[4 * 257], s[5 * 257], s[6 * 257], s[7 * 257]});
        else { u32x4 o; o.x = cvt_pk_bf16(s[0 * 257], s[1 * 257]); o.y = cvt_pk_bf16(s[2 * 257], s[3 * 257]); o.z = cvt_pk_bf16(s[4 * 257], s[5 * 257]); o.w = cvt_pk_bf16(s[6 * 257], s[7 * 257]);
            *(u32x4*)(mt.dst + (size_t)r_ * mt.K + k0 + 8 * c) = o; } }
    __syncthreads();
}
__device__ __forceinline__ void ssm_build(const ArgsD& a, int l, int g, LAS unsigned char* lds) {
    LAS float* Ap = (LAS float*)lds;
    LAS float* Bb = Ap + 33 * 64 * 2;
    LAS float* Cc = Bb + 64 * 16 * 2;
    LAS float* Mk = Cc + 16 * 64 * 2;
    const int tid = opaque_tid();
    const float* lre = (const float*)a.in[I_LRE] + (l * 64 + g) * 64; const float* lim = (const float*)a.in[I_LIM] + (l * 64 + g) * 64;
    const float* bre = (const float*)a.in[I_BRE] + (size_t)(l * 64 + g) * 1024; const float* bim = (const float*)a.in[I_BIM] + (size_t)(l * 64 + g) * 1024;
    const float* cre = (const float*)a.in[I_CRE] + (size_t)(l * 64 + g) * 1024; const float* cim = (const float*)a.in[I_CIM] + (size_t)(l * 64 + g) * 1024;
    const double dt = exp((double)((const float*)a.in[I_LOGDT])[l * 64 + g]);
    for (int idx = tid; idx < 33 * 64; idx += 512) { const int n = idx & 63, k = idx >> 6; const double re = lre[n], im = lim[n];
        const double mag = exp(re * dt * k), ang = im * dt * k; Ap[idx * 2] = (float)(mag * cos(ang)); Ap[idx * 2 + 1] = (float)(mag * sin(ang)); }
    if (tid < 64) { float* a32 = (float*)(a.ws + WS_A32) + (size_t)((l * 64 + g) * 64 + tid) * 2; const double re = lre[tid], im = lim[tid]; const double mag = exp(32.0 * re * dt), ang = 32.0 * im * dt;
        a32[0] = (float)(mag * cos(ang)); a32[1] = (float)(mag * sin(ang)); }
    for (int idx = tid; idx < 1024; idx += 512) { const int n = idx >> 4; const double re = lre[n], im = lim[n]; const double mag = exp(re * dt), ang = im * dt;
        const double lr = mag * cos(ang) - 1.0, li = mag * sin(ang), den = re * re + im * im;
        const double fr_ = (lr * re + li * im) / den, fi_ = (li * re - lr * im) / den; const double br = bre[idx], bi = bim[idx];
        Bb[idx * 2] = (float)(fr_ * br - fi_ * bi); Bb[idx * 2 + 1] = (float)(fr_ * bi + fi_ * br);
        Cc[idx * 2] = cre[idx]; Cc[idx * 2 + 1] = cim[idx]; }
    __syncthreads();
    for (int idx = tid; idx < 32 * 256; idx += 512) { const int k = idx >> 8, p = (idx >> 4) & 15, q = idx & 15; float s = 0.f;
        for (int n = 0; n < 64; ++n) { const float ar = Ap[(k * 64 + n) * 2], ai = Ap[(k * 64 + n) * 2 + 1], br = Bb[(n * 16 + q) * 2], bi = Bb[(n * 16 + q) * 2 + 1];
            const float tr = ar * br - ai * bi, ti = ar * bi + ai * br; s += Cc[(p * 64 + n) * 2] * tr - Cc[(p * 64 + n) * 2 + 1] * ti; }
        Mk[idx] = s; }
    __syncthreads();
    unsigned char* lw = a.ws + WS_W + (size_t)l * LW_BYTES;
    bf16_t* T = (bf16_t*)(lw + LW_TEXT) + (size_t)g * 512 * SSM_KX; bf16_t* W = (bf16_t*)(lw + LW_WSL) + (size_t)g * 256 * 512;
    { const int R = tid, i = R >> 4, p = R & 15; bf16_t* row = T + (size_t)R * SSM_KX;
        for (int ch = 0; ch < 64; ++ch) { const int j = ch >> 1, q0 = (ch & 1) * 8; u32x4 w = {0u, 0u, 0u, 0u};
            if (j <= i) { const LAS float* mp = Mk + ((i - j) * 16 + p) * 16 + q0; w.x = cvt_pk_bf16(mp[0], mp[1]); w.y = cvt_pk_bf16(mp[2], mp[3]); w.z = cvt_pk_bf16(mp[4], mp[5]); w.w = cvt_pk_bf16(mp[6], mp[7]); }
            *(u32x4*)(row + ch * 8) = w; }
        for (int ch = 0; ch < 16; ++ch) { float v[8];
#pragma unroll
            for (int e = 0; e < 4; ++e) { const int n = ch * 4 + e; const float cr = Cc[(p * 64 + n) * 2], ci = Cc[(p * 64 + n) * 2 + 1], ar = Ap[((i + 1) * 64 + n) * 2], ai = Ap[((i + 1) * 64 + n) * 2 + 1];
                v[2 * e] = cr * ar - ci * ai; v[2 * e + 1] = -(cr * ai + ci * ar); }
            u32x4 w; w.x = cvt_pk_bf16(v[0], v[1]); w.y = cvt_pk_bf16(v[2], v[3]); w.z = cvt_pk_bf16(v[4], v[5]); w.w = cvt_pk_bf16(v[6], v[7]);
            *(u32x4*)(row + 512 + ch * 8) = w; } }
    if (tid < 256) { const int R = tid; bf16_t* row = W + (size_t)R * 512;
        for (int ch = 0; ch < 64; ++ch) { u32x4 w = {0u, 0u, 0u, 0u};
            if (R < 128) { const int n = R >> 1, im = R & 1, j = ch >> 1, q0 = (ch & 1) * 8; float v[8]; const float ar = Ap[((31 - j) * 64 + n) * 2], ai = Ap[((31 - j) * 64 + n) * 2 + 1];
#pragma unroll
                for (int e = 0; e < 8; ++e) { const float br = Bb[(n * 16 + q0 + e) * 2], bi = Bb[(n * 16 + q0 + e) * 2 + 1]; v[e] = im ? (ar * bi + ai * br) : (ar * br - ai * bi); }
                w.x = cvt_pk_bf16(v[0], v[1]); w.y = cvt_pk_bf16(v[2], v[3]); w.z = cvt_pk_bf16(v[4], v[5]); w.w = cvt_pk_bf16(v[6], v[7]); }
            *(u32x4*)(row + ch * 8) = w; } }
    __syncthreads();
}

struct LnArgs { bf16_t* X; float* outf; unsigned char* outq; const float* g; const float* b;
                const float* og; const int* slot; int* r_e; float* r_w; unsigned* cnt; };
template <int MODE>
__device__ __forceinline__ void ln_phase(const LnArgs& A, LAS unsigned char* lds, int G) {
    const int tid = opaque_tid(), lane = tid & 63, wave = __builtin_amdgcn_readfirstlane(tid >> 6);
    const int gw = blockIdx.x * 8 + wave, NGW = G * 8;
    f32x4 gv[8], bv[8];
    if (MODE != 1) {
#pragma unroll
        for (int j = 0; j < 8; ++j) { gv[j] = *(const f32x4*)(A.g + lane * 8 + 512 * (j >> 1) + 4 * (j & 1)); bv[j] = *(const f32x4*)(A.b + lane * 8 + 512 * (j >> 1) + 4 * (j & 1)); } }
    for (int row = gw; row < M; row += NGW) {
        bf16_t* xr = A.X + (size_t)row * D + lane * 8;
        f32x4 v[8]; float s = 0.f;
#pragma unroll
        for (int j = 0; j < 4; ++j) { const u32x4 w = *(const u32x4*)(xr + 512 * j); v[2 * j] = (f32x4){bf_lo(w.x), bf_hi(w.x), bf_lo(w.y), bf_hi(w.y)}; v[2 * j + 1] = (f32x4){bf_lo(w.z), bf_hi(w.z), bf_lo(w.w), bf_hi(w.w)}; }
        if (MODE == 2) { const int s0 = A.slot[row * 2], s1 = A.slot[row * 2 + 1]; const float* o0 = A.og + (size_t)s0 * D + lane * 8; const float* o1 = A.og + (size_t)s1 * D + lane * 8;
#pragma unroll
            for (int j = 0; j < 8; ++j) { const int e = 512 * (j >> 1) + 4 * (j & 1); v[j] = v[j] * ALPHA + *(const f32x4*)(o0 + e) + *(const f32x4*)(o1 + e); } }
#pragma unroll
        for (int j = 0; j < 8; ++j) s += (v[j][0] + v[j][1]) + (v[j][2] + v[j][3]);
        const float mean = wave_sum(s, lane) * (1.f / D); float s2 = 0.f;
#pragma unroll
        for (int j = 0; j < 8; ++j) { v[j] = v[j] - mean; s2 += (v[j][0] * v[j][0] + v[j][1] * v[j][1]) + (v[j][2] * v[j][2] + v[j][3] * v[j][3]); }
        const float rstd = 1.f / sqrtf(wave_sum(s2, lane) * (1.f / D) + LN_EPS);
#pragma unroll
        for (int j = 0; j < 8; ++j) { if (MODE == 1) { gv[j] = *(const f32x4*)(A.g + lane * 8 + 512 * (j >> 1) + 4 * (j & 1)); bv[j] = *(const f32x4*)(A.b + lane * 8 + 512 * (j >> 1) + 4 * (j & 1)); }
            v[j] = v[j] * rstd * gv[j] + bv[j]; }
        if (A.outf) { float* of = A.outf + (size_t)row * D + lane * 8;
#pragma unroll
            for (int j = 0; j < 8; ++j) *(f32x4*)(of + 512 * (j >> 1) + 4 * (j & 1)) = v[j]; }
        else {
#pragma unroll
            for (int j = 0; j < 4; ++j) *(u32x4*)(xr + 512 * j) = pack8(v[2 * j], v[2 * j + 1]); }
        if (A.outq) { unsigned char* oq = A.outq + (size_t)row * D + lane * 8;
#pragma unroll
            for (int j = 0; j < 4; ++j) *(u32x2*)(oq + 512 * j) = pack8_fp8(v[2 * j], v[2 * j + 1]); }
        if (MODE == 1) {
            const LAS float* wr_ = (const LAS float*)lds;
            int i0 = 0, i1 = 0; float v0 = -__builtin_inff(), v1 = -__builtin_inff();
#pragma unroll 1
            for (int e = 0; e < 8; ++e) { float acc = 0.f;
#pragma unroll
                for (int j = 0; j < 8; ++j) { const f32x4 w = *(const LAS f32x4*)(wr_ + e * D + lane * 8 + 512 * (j >> 1) + 4 * (j & 1)); acc += (v[j][0] * w[0] + v[j][1] * w[1]) + (v[j][2] * w[2] + v[j][3] * w[3]); }
                const float sg = wave_sum(acc, lane);
                if (sg > v0) { v1 = v0; i1 = i0; v0 = sg; i0 = e; } else if (sg > v1) { v1 = sg; i1 = e; } }
            const float w0 = 1.f / (1.f + expf(v1 - v0)), w1 = 1.f - w0;
            if (lane == 0) { A.r_e[row * 2] = i0; A.r_e[row * 2 + 1] = i1; A.r_w[row * 2] = w0; A.r_w[row * 2 + 1] = w1;
                __hip_atomic_fetch_add(A.cnt + i0, 1u, RLX_AGENT); __hip_atomic_fetch_add(A.cnt + i1, 1u, RLX_AGENT); }
        }
    }
}
__device__ __forceinline__ void moe_offsets(const unsigned* cnt, int (&off)[9]) {
    int acc = 0;
#pragma unroll
    for (int e = 0; e < 8; ++e) { off[e] = acc; const int c = (int)__hip_atomic_load(cnt + e, RLX_AGENT); acc += ((c + 255) >> 8) << 8; }
    off[8] = acc;
}

struct AttPtrs { const bf16_t *QD, *KD, *VD, *QM, *KM, *VM; bf16_t *BR0, *BR1; };
__device__ __forceinline__ void mla_unit(const AttPtrs& P, int h, int qb, char* lds) {
    const int tid = opaque_tid(), wid = __builtin_amdgcn_readfirstlane(tid >> 6), lane = tid & 63, r32 = lane & 31, hi = lane >> 5;
    const int q0 = qb * 256 + wid * 32; f32x16 o[4]; float l;
    att::attn_core_pp<192, 12, true, false>(P.QM + (size_t)(q0 + r32) * 1536 + h * 192 + hi * 8, P.KM + h * 192, 1536, P.VM + h * 128, 1024, 4 * (qb + 1), q0 + r32, q0, 0, lds, o, l);
    float* ws = (float*)(lds + 3 * att::SHM_V + 3 * 64 * 384) + wid * 64;
    att::normalize_o(o, l, ws, r32, hi);
    att::store_o_bf16(o, P.BR1 + (size_t)q0 * 1024 + h * 128, 1024, r32, hi);
    __syncthreads();
}
__device__ __forceinline__ void diff_unit(const AttPtrs& P, int h, int qb, float lam, char* lds) {
    const int tid = opaque_tid(), wid = __builtin_amdgcn_readfirstlane(tid >> 6), lane = tid & 63, r32 = lane & 31, hi = lane >> 5;
    const int mp = wid >> 2, w4 = wid & 3, q0 = qb * 128 + w4 * 32; f32x16 o[4]; float l;
    att::attn_core_pp<128, 4, true, true>(P.QD + (size_t)(q0 + r32) * 1024 + h * 128 + mp * 64 + hi * 8, P.KD + h * 128, 1024, P.VD + h * 128, 1024, 2 * (qb + 1), q0 + r32, q0, mp * 8, lds, o, l);
    float* ws = (float*)(lds + 3 * att::SHM_V + 3 * 64 * 256) + wid * 64;
    att::normalize_o(o, l, ws, r32, hi);
    __syncthreads();
    float* xch = (float*)lds + w4 * 4096 + lane;
    if (mp == 1) {
#pragma unroll
        for (int d0 = 0; d0 < 4; ++d0)
#pragma unroll
            for (int r = 0; r < 16; ++r) xch[(d0 * 16 + r) * 64] = o[d0][r];
    }
    __syncthreads();
    if (mp == 0) {
        float ss[16];
#pragma unroll
        for (int r = 0; r < 16; ++r) { float s = 0.f;
#pragma unroll
            for (int d0 = 0; d0 < 4; ++d0) { const float dv = o[d0][r] - lam * xch[(d0 * 16 + r) * 64]; o[d0][r] = dv; s += dv * dv; }
            ss[r] = s; }
#pragma unroll
        for (int r = 0; r < 16; ++r) { float s = ss[r];
#pragma unroll
            for (int off = 1; off < 32; off <<= 1) s += shflx(s, off, lane);
            const float rs = __builtin_amdgcn_rsqf(s * (1.f / 128.f) + RMS_EPS);
#pragma unroll
            for (int d0 = 0; d0 < 4; ++d0) o[d0][r] *= rs; }
        att::store_o_bf16(o, P.BR0 + (size_t)q0 * 1024 + h * 128, 1024, r32, hi);
    }
    __syncthreads();
}
__device__ __forceinline__ void cross_unit(const bf16_t* XQ, const bf16_t* XKV, bf16_t* XO, int h, int qb, char* lds) {
    const int tid = opaque_tid(), wid = __builtin_amdgcn_readfirstlane(tid >> 6), lane = tid & 63, r32 = lane & 31, hi = lane >> 5;
    const int q0 = qb * 256 + wid * 32; f32x16 o[4]; float l;
    att::attn_core<128, 8, false, true>(XQ + (size_t)(q0 + r32) * 512 + h * 128 + hi * 8, XKV + h * 128, 1024, XKV + 512 + h * 128, 1024, 4, 0, 0, 0, lds, o, l);
    float* ws = (float*)(lds + 2 * att::SHM_V + 2 * 64 * 256) + wid * 64;
    att::normalize_o(o, l, ws, r32, hi);
    att::store_o_bf16(o, XO + (size_t)q0 * 512 + h * 128, 512, r32, hi);
    __syncthreads();
}

__global__ void __launch_bounds__(512, 2) fwd_kernel(Args args) {
    extern __shared__ __attribute__((aligned(16))) unsigned char lds_raw[];
    LAS unsigned char* lds = (LAS unsigned char*)lds_raw;
    const int tid = threadIdx.x, lane = tid & 63, wave = __builtin_amdgcn_readfirstlane(tid >> 6);
    const int G = gridDim.x, bx = blockIdx.x;
    unsigned char* ws = (unsigned char*)(GAS unsigned char*)(unsigned long long)args.ws;
    unsigned* ctl = (unsigned*)(ws + WS_CTL);
    volatile LAS unsigned* MISC = (volatile LAS unsigned*)(lds + LDS_MISC);
    if (tid < 32) MISC[tid] = 0u;
    if (lane == 0) ((volatile LAS int*)LDS_WTAB)[__builtin_amdgcn_s_getreg(0x2804)] = wave;
    { volatile LAS unsigned long long* pt = (volatile LAS unsigned long long*)(lds + LDS_MISC + 256); if (tid < 35) pt[tid] = (unsigned long long)args.in[tid]; if (tid == 35) pt[35] = (unsigned long long)args.out; }
    __syncthreads();
    ArgsD ad; ad.in.t = (volatile LAS unsigned long long*)(lds + LDS_MISC + 256); ad.ws = ws;
    const int lo = args.ph_lo, hi = args.ph_hi;
    XcdBarrier bar; bar.bar = ctl + CW_BAR; bar.x = 0; bar.st = nullptr;
    if (hi - lo > 1) { bar = xcd_barrier_post(ctl + CW_BAR, MISC + 8); xcd_barrier_setup(bar); }
#ifndef PH_SEL
#define PH_SEL 0xFFFFFFFFu
#endif
#define INR(k) (lo <= (k) && (k) < hi)
#define IN0() (((PH_SEL) & 1u) && INR(0))
#define INL(j) ((((PH_SEL) >> ((j) + 1)) & 1u) && INR(pb + (j)))
#define SEAM(k) do { if (INR(k) && INR((k) + 1)) xcd_barrier(bar); } while (0)
    const int gw = bx * 8 + wave, NGW = G * 8;
    const int gtid = bx * 512 + tid, NGT = G * 512;

    if (IN0()) {
      {
        { int start = bx;
            for (int id = 0; id < NMAT; ++id) { const Mat mt = get_mat(ad, id); if (mt.kind == 1) continue; const int nit = (mt.K / 64) * (mt.N / 256);
                int it = start; for (; it < nit; it += G) cvt_tile_wg(mt, (LAS float*)lds, it, tid);
                start = it - nit; } }
        { LAS float* scr = (LAS float*)(lds + wave * 16640); int start = gw;
            for (int id = 0; id < 22; id += 11) { const Mat mt = get_mat(ad, id); const int nit = (mt.K / 64) * (mt.N / 64);
                int it = start; for (; it < nit; it += NGW) cvt_item(mt, scr, it, lane);
                start = it - nit; } }
        for (int l = 0; l < DEPTH; ++l) { u32x4* p = (u32x4*)((unsigned char*)(ws + WS_W + (size_t)l * LW_BYTES + LW_IN) + (size_t)NIN_BF * D * 2 + (size_t)(3904 - NIN_BF) * D);
            for (int i = gtid; i < 192 * D / 16; i += NGT) p[i] = (u32x4){0u, 0u, 0u, 0u}; }
        { const float* x = (const float*)ad.in[I_X]; bf16_t* xn = (bf16_t*)(ws + WS_XN);
            unsigned char* x8 = ws + WS_XN8;
            for (size_t i = gtid; i < (size_t)M * D / 8; i += NGT) { const f32x4 a = *(const f32x4*)(x + i * 8), b = *(const f32x4*)(x + i * 8 + 4); *(u32x4*)(xn + i * 8) = pack8(a, b); *(u32x2*)(x8 + i * 8) = pack8_fp8(a, b); }
            const float* mem = (const float*)ad.in[I_MEM]; bf16_t* mb = (bf16_t*)(ws + WS_MEMB);
            for (int i = gtid; i < MEM_LEN * D / 8; i += NGT) { const f32x4 a = *(const f32x4*)(mem + i * 8), b = *(const f32x4*)(mem + i * 8 + 4); *(u32x4*)(mb + i * 8) = pack8(a, b); } }
        { const int* pos = (const int*)ad.in[I_POS]; float* td = (float*)(ws + WS_TABD); float* tm = (float*)(ws + WS_TABM);
            for (int i = gtid; i < M * 40; i += NGT) { const int t = i / 40, k = i - t * 40; const double p = (double)pos[t];
                const double inv = (k < 8) ? exp(-(double)k * (13.122363377404328 / 8.0)) : exp(-(double)(k - 8) * (13.122363377404328 / 32.0));
                const double ang = p * inv; const float c = (float)cos(ang), s = (float)sin(ang);
                if (k < 8) { td[(t * 8 + k) * 2] = c; td[(t * 8 + k) * 2 + 1] = s; } else { tm[(t * 32 + k - 8) * 2] = c; tm[(t * 32 + k - 8) * 2 + 1] = s; } } }
        if (bx == 0 && tid < 192) { int* ord = (int*)(ws + WS_ORDER); const int mine = tid < 64 ? 160 * (tid + 1) : 48 * (tid - 64 + 1); int rank = 0;
            for (int c = 0; c < 192; ++c) { const int cc = c < 64 ? 160 * (c + 1) : 48 * (c - 64 + 1); rank += (cc > mine || (cc == mine && c < tid)) ? 1 : 0; }
            const int code = tid < 64 ? ((1 << 16) | (tid << 8)) : ((tid - 64) << 8);
            for (int h = 0; h < 8; ++h) ord[rank * 8 + h] = code | h; }
        __syncthreads();
        for (int uidx = bx; uidx < DEPTH * 64; uidx += G) ssm_build(ad, uidx >> 6, uidx & 63, lds);
        __syncthreads();
      }
    }
    SEAM(0);

    unsigned char* const ws_k = ws; const int bx_k = bx;
    for (int l = 0; l < DEPTH; ++l) {
        const int pb = 1 + l * NPL;
        if (!(lo < pb + NPL && pb < hi)) continue;
        int bx = bx_k; asm volatile("" : "+s"(bx));
        unsigned long long ws_i = (unsigned long long)ws_k; asm volatile("" : "+s"(ws_i)); unsigned char* ws = (unsigned char*)(GAS unsigned char*)ws_i;
#define PH_TID const int tid = opaque_tid(), lane = tid & 63, wave = __builtin_amdgcn_readfirstlane(tid >> 6); const int gw = bx * 8 + wave, NGW = G * 8; (void)lane; (void)wave; (void)gw; (void)NGW
#define lw (ws + WS_W + (size_t)l * LW_BYTES)
#define ssq_q ((float*)(ws + WS_PSQ))
#define ssq_kv (ssq_q + (size_t)8 * M)
#define XS ((float*)(ws + WS_XS))
#define XN ((bf16_t*)(ws + WS_XN))
#define tabd ((const float*)(ws + WS_TABD))
#define tabm ((const float*)(ws + WS_TABM))
#define QD ((bf16_t*)(ws + WS_QD))
#define KD ((bf16_t*)(ws + WS_KD))
#define VD ((bf16_t*)(ws + WS_VD))
#define MQ ((bf16_t*)(ws + WS_MQ))
#define MKV ((bf16_t*)(ws + WS_MKV))
#define KM ((bf16_t*)(ws + WS_KM))
#define VM ((bf16_t*)(ws + WS_VM))
#define QM ((bf16_t*)(ws + WS_QM))
#define SU ((bf16_t*)(ws + WS_SU))
#define GATES ((bf16_t*)(ws + WS_GATES))
#define SLOC ((float*)(ws + WS_SLOC))
#define YG ((bf16_t*)(ws + WS_YG))
#define BR ((bf16_t*)(ws + WS_BR))
#define TMP ((float*)(ws + WS_TMP))
#define MG ((bf16_t*)(ws + WS_MG))
#define XQ ((bf16_t*)(ws + WS_XQ))
#define XO ((bf16_t*)(ws + WS_XO))
#define XKV ((bf16_t*)(ws + WS_XKV) + (size_t)l * 256 * 1024)
#define r_e ((int*)(ws + WS_ROUTE))
#define r_w ((float*)(ws + WS_ROUTE + 128 * 1024))
#define slot ((int*)(ws + WS_ROUTE + 256 * 1024))
#define wslot ((float*)(ws + WS_ROUTE + 384 * 1024))
        if (INL(0)) {
#if !defined(SUBSEL) || (SUBSEL & 1)
            { pg8::Gemm g{XN, (const bf16_t*)(lw + LW_IN), (D) * 2, (D) * 2, (D) * 2, 0}; SchedPlain S; S.init(M / 256, NIN_BF / 256, D, D, G, bx);
              EpiInProj E{QD, KD, VD, MQ, MKV, KM, SU, GATES, ssq_q, ssq_kv, tabd, tabm, 0};
              pg8::gemm_phase(lds, g, S, E); }
            { pg8::Gemm g{ws + WS_XN8, lw + LW_IN + (size_t)NIN_BF * D * 2, D, D, D, 0}; SchedPlain S; S.T.init(M / 256, NIN_G8 / 256); S.G = G; S.c = bx; S.tA = (size_t)256 * D; S.tB = S.tA;
              EpiInProj E{QD, KD, VD, MQ, MKV, KM, SU, GATES, ssq_q, ssq_kv, tabd, tabm, 12};
              pg8::gemm_phase_t<true, 0x7C7C7C7C>(lds, g, S, E); }
#endif
#if !defined(SUBSEL) || (SUBSEL & 2)
            { pg8::Gemm g{(const bf16_t*)(ws + WS_MEMB), (const bf16_t*)(lw + LW_XKV), (D) * 2, (D) * 2, (D) * 2, 0}; SchedPlain S; S.init(1, 4, D, D, G, (bx + 128) % G);
              EpiBf16 E{XKV, 1024, 1.f};
              pg8::gemm_phase(lds, g, S, E); }
#endif
        }
        SEAM(pb + 0);
        if (INL(1)) {
#if !defined(SUBSEL) || (SUBSEL & 1)
            { pg8::Gemm g{MQ, (const bf16_t*)(lw + LW_QUP), (512) * 2, (512) * 2, (512) * 2, 0}; SchedPlain S; S.init(M / 256, 6, 512, 512, G, bx);
              EpiQup E{QM, ssq_q, tabm}; pg8::gemm_phase(lds, g, S, E); }
#endif
#if !defined(SUBSEL) || (SUBSEL & 2)
            { pg8::Gemm g{MKV, (const bf16_t*)(lw + LW_KVUP), (256) * 2, (256) * 2, (256) * 2, 0}; SchedPlain S; S.init(M / 256, 8, 256, 256, G, (bx + 128) % G);
              EpiKVup E{KM, VM, ssq_kv}; pg8::gemm_phase(lds, g, S, E); }
#endif
#if !defined(SUBSEL) || (SUBSEL & 4)
            { pg8::Gemm g{SU, (const bf16_t*)(lw + LW_WSL), (SSM_KX) * 2, (512) * 2, (512) * 2, 0}; SchedBatch S{2, 1, 64, G, (bx + 128) % G  , (size_t)256 * SSM_KX * 2, (size_t)256 * 512 * 2, (size_t)SSM_NCH * SSM_KX * 2, (size_t)256 * 512 * 2};
              EpiSloc E{SLOC}; pg8::gemm_phase(lds, g, S, E); }
#endif
        }
        SEAM(pb + 1);
        if (INL(2)) {
            PH_TID;
            if (bx < 64) { const int g = bx, n = lane, w = wave;
                const float* a32 = (const float*)(ws + WS_A32) + (size_t)((l * 64 + g) * 64 + n) * 2; const float ar = a32[0], ai = a32[1];
                const float* __restrict__ lp = SLOC + ((size_t)g * SSM_NCH + 64 * w) * 128 + 2 * n; bf16_t* __restrict__ sp = SU + ((size_t)g * SSM_NCH + 64 * w) * SSM_KX + 512 + 2 * n;
                float br[64], bi[64]; float sr = 0.f, si = 0.f;
#pragma unroll
                for (int c0 = 0; c0 < 64; c0 += 32) { f32x2 lv[32];
#pragma unroll
                    for (int k = 0; k < 32; ++k) lv[k] = *(const f32x2*)(lp + (size_t)(c0 + k) * 128);
#pragma unroll
                    for (int k = 0; k < 32; ++k) { br[c0 + k] = sr; bi[c0 + k] = si; const float nr = ar * sr - ai * si + lv[k][0], ni = ar * si + ai * sr + lv[k][1]; sr = nr; si = ni; } }
                LAS float* ex = (LAS float*)lds;
                ex[(w * 64 + n) * 2] = sr; ex[(w * 64 + n) * 2 + 1] = si;
                float pr = ar, pi = ai;
#pragma unroll
                for (int q = 0; q < 6; ++q) { const float tr = pr * pr - pi * pi, ti = 2.f * pr * pi; pr = tr; pi = ti; }
                __syncthreads();
                float cr = 0.f, ci = 0.f;
                for (int uu = 0; uu < w; ++uu) { const float er = ex[(uu * 64 + n) * 2], ei = ex[(uu * 64 + n) * 2 + 1]; const float tr = pr * cr - pi * ci + er, ti = pr * ci + pi * cr + ei; cr = tr; ci = ti; }
#pragma unroll
                for (int k = 0; k < 64; ++k) { *(unsigned*)(sp + (size_t)k * SSM_KX) = cvt_pk_bf16(br[k] + cr, bi[k] + ci);
                    const float tr = ar * cr - ai * ci, ti = ar * ci + ai * cr; cr = tr; ci = ti; } }
        }
        SEAM(pb + 2);
        if (INL(3)) {
#if !defined(SUBSEL) || (SUBSEL & 1)
            { pg8::Gemm g{SU, (const bf16_t*)(lw + LW_TEXT), (SSM_KX) * 2, (SSM_KX) * 2, (SSM_KX) * 2, 0}; SchedBatch S{2, 2, 64, G, bx, (size_t)256 * SSM_KX * 2, (size_t)256 * SSM_KX * 2, (size_t)SSM_NCH * SSM_KX * 2, (size_t)512 * SSM_KX * 2};
              EpiSsmY E{YG, SU, (const float*)ad.in[I_SSMD] + l * 1024}; pg8::gemm_phase(lds, g, S, E); }
#endif
            PH_TID;
            const float* dl = (const float*)ad.in[I_DLAM] + l * 256;
            const float lam = expf(wave_sum(dl[lane] * dl[64 + lane], lane)) - expf(wave_sum(dl[128 + lane] * dl[192 + lane], lane)) + lam_init_of(l);
            const AttPtrs P{QD, KD, VD, QM, KM, VM, BR, BR + (size_t)M * 1024};
            const int* ord = (const int*)(ws + WS_ORDER);
            __syncthreads();
#ifndef PROBE_ATT
#define PROBE_ATT 0
#endif
            const unsigned myx = xb_xcc_id() & 7u;
#pragma nounroll
            for (int rep = 0; rep < (PROBE_ATT ? 2 : 1); ++rep)
#pragma nounroll
            for (int sq = 0; sq < 8; ++sq) { const int q = (int)((myx + sq) & 7u);
            for (;;) {
                if (tid == 0) MISC[0] = __hip_atomic_fetch_add(ctl + CW_ATTQ + 64 * l + 32 * rep + q, 1u, RLX_AGENT);
                __syncthreads();
                const unsigned it = MISC[0];
                __syncthreads();
                if (it >= 192u) break;
                const int code = ord[it * 8 + q], h = code & 255, qb = (code >> 8) & 255;
                if ((code >> 16) && (rep == 0 || (PROBE_ATT & 1))) mla_unit(P, h, qb, (char*)lds_raw);
                if (!(code >> 16) && (rep == 0 || (PROBE_ATT & 2))) diff_unit(P, h, qb, lam, (char*)lds_raw);
            } }
        }
        SEAM(pb + 3);
        if (INL(4)) {
            pg8::Gemm g{YG, (const bf16_t*)(lw + LW_GLU), (1024) * 2, (1024) * 2, (1024) * 2, 0}; SchedPlain S; S.init(M / 256, 8, 1024, 1024, G, bx);
            EpiGated<0> E{BR + (size_t)2 * M * 1024, 1024}; pg8::gemm_phase(lds, g, S, E);
        }
        SEAM(pb + 4);
        if (INL(5)) {
            pg8::Gemm g{BR, (const bf16_t*)(lw + LW_BR), (1024) * 2, (1024) * 2, (1024) * 2, 0}; SchedBranch S; S.T.init(M / 256, 8); S.G = G; S.c = bx; S.tA = (size_t)256 * 1024 * 2; S.tB = S.tA; S.zA = (size_t)M * 1024 * 2; S.zB = (size_t)2048 * 1024 * 2;
            EpiBranch E{GATES, (bf16_t*)TMP, MG}; pg8::gemm_phase(lds, g, S, E);
        }
        SEAM(pb + 5);
        if (INL(6)) {
            pg8::Gemm g{MG, (const bf16_t*)(lw + LW_OUT), (D) * 2, (D) * 2, (D) * 2, 0}; SchedPlain S; S.init(M / 256, 8, D, D, G, bx);
            EpiResid E{XN}; pg8::gemm_phase(lds, g, S, E);
        }
        SEAM(pb + 6);
        if (INL(7)) { const LnArgs A{XN, nullptr, nullptr, (const float*)ad.in[I_LNMG] + l * D, (const float*)ad.in[I_LNMB] + l * D, nullptr, nullptr, nullptr, nullptr, nullptr}; ln_phase<0>(A, lds, G); }
        SEAM(pb + 7);
        if (INL(8)) {
            pg8::Gemm g{XN, (const bf16_t*)(lw + LW_XQ), (D) * 2, (D) * 2, (D) * 2, 0}; SchedPlain S; S.T.init(M / 128, 2); S.G = G; S.c = bx; S.tA = (size_t)128 * D * 2; S.tB = (size_t)256 * D * 2;
            EpiBf16Half E{XQ, 512, C2_X}; pg8::gemm_phase(lds, g, S, E);
        }
        SEAM(pb + 8);
        if (INL(9)) { for (int uidx = bx; uidx < 256; uidx += G) cross_unit(XQ, XKV, XO, uidx & 3, uidx >> 2, (char*)lds_raw); }
        SEAM(pb + 9);
        if (INL(10)) {
            pg8::Gemm g{XO, (const bf16_t*)(lw + LW_XO), (512) * 2, (512) * 2, (512) * 2, 0}; SchedPlain S; S.init(M / 256, 8, 512, 512, G, bx);
            EpiResid E{XN}; pg8::gemm_phase(lds, g, S, E);
        }
        SEAM(pb + 10);
        if (INL(11)) {
            const LnArgs A{XN, nullptr, nullptr, (const float*)ad.in[I_LNXG] + l * D, (const float*)ad.in[I_LNXB] + l * D, nullptr, nullptr, r_e, r_w, ctl + CW_MOECNT};
            if (l == 0) ln_phase<0>(A, lds, G);
            else { PH_TID; const float* rw = (const float*)ad.in[I_ROUTER]; LAS float* wl = (LAS float*)lds;
                for (int i = tid; i < D * 8; i += 512) wl[(i & 7) * D + (i >> 3)] = rw[i];
                __syncthreads(); ln_phase<1>(A, lds, G); __syncthreads(); }
        }
        SEAM(pb + 11);
        if (l == 1) {
            if (INL(12)) { PH_TID; int off[9]; moe_offsets(ctl + CW_MOECNT, off); bf16_t* XG = (bf16_t*)(ws + WS_XG);
                for (int row = gw; row < M; row += NGW) { int s0 = 0, s1 = 0;
                    if (lane == 0) { const int e0 = r_e[row * 2], e1 = r_e[row * 2 + 1];
                        s0 = off[e0] + (int)__hip_atomic_fetch_add(ctl + CW_MOECUR + e0, 1u, RLX_AGENT); s1 = off[e1] + (int)__hip_atomic_fetch_add(ctl + CW_MOECUR + e1, 1u, RLX_AGENT);
                        slot[row * 2] = s0; slot[row * 2 + 1] = s1; wslot[s0] = r_w[row * 2]; wslot[s1] = r_w[row * 2 + 1]; }
                    s0 = __builtin_amdgcn_readfirstlane(s0); s1 = __builtin_amdgcn_readfirstlane(s1);
                    const u32x4* src = (const u32x4*)(XN + (size_t)row * D) + lane; u32x2* d0 = (u32x2*)((unsigned char*)XG + (size_t)s0 * D) + lane; u32x2* d1 = (u32x2*)((unsigned char*)XG + (size_t)s1 * D) + lane;
#pragma unroll
                    for (int j = 0; j < 4; ++j) { const u32x4 v = src[64 * j];
                        const u32x2 q = pack8_fp8((f32x4){bf_lo(v.x), bf_hi(v.x), bf_lo(v.y), bf_hi(v.y)}, (f32x4){bf_lo(v.z), bf_hi(v.z), bf_lo(v.w), bf_hi(v.w)}); d0[64 * j] = q; d1[64 * j] = q; } } }
            SEAM(pb + 12);
        }
        if (INL(13)) {
            if (l == 0) { pg8::Gemm g{XN, (const bf16_t*)(ws + WS_FFN), (D) * 2, (D) * 2, (D) * 2, 0}; SchedPlain S; S.init(M / 256, 44, D, D, G, bx);
                EpiGated<1> E{(bf16_t*)(ws + WS_HG), DFF}; pg8::gemm_phase(lds, g, S, E); }
            else { int off[9]; moe_offsets(ctl + CW_MOECNT, off);
                pg8::Gemm g{ws + WS_XG, ws + WS_MOE, D, D, D, 0x7C7C7C7C}; SchedMoe S; S.T.init(off[8] >> 8, 44); S.G = G; S.c = bx; S.tA = (size_t)256 * D; S.tB = S.tA; S.zB = 66 * MiB;
#pragma unroll
                for (int k = 0; k < 7; ++k) S.off[k] = off[k + 1];
                EpiSwigluF8 E{ws + WS_HG, DFF}; pg8::gemm_phase_t<true, 0x7C7C7C7C>(lds, g, S, E); }
        }
        SEAM(pb + 13);
        if (INL(14)) {
            if (l == 0) { pg8::Gemm g{(const bf16_t*)(ws + WS_HG), (const bf16_t*)(ws + WS_FFN + 44 * MiB), (DFF) * 2, (DFF) * 2, (DFF) * 2, 0}; SchedPlain S; S.init(M / 256, 8, DFF, DFF, G, bx);
                EpiResid E{XN}; pg8::gemm_phase(lds, g, S, E); }
            else { int off[9]; moe_offsets(ctl + CW_MOECNT, off);
                pg8::Gemm g{ws + WS_HG, ws + WS_MOE + 44 * MiB, DFF, DFF, DFF, 0x7B7B7B7B}; SchedMoe S; S.T.init(off[8] >> 8, 8); S.G = G; S.c = bx; S.tA = (size_t)256 * DFF; S.tB = S.tA; S.zB = 66 * MiB;
#pragma unroll
                for (int k = 0; k < 7; ++k) S.off[k] = off[k + 1];
                EpiMoeDown E{(float*)(ws + WS_OG), wslot}; pg8::gemm_phase_t<true, 0x7B7B7B7B>(lds, g, S, E); }
        }
        SEAM(pb + 14);
        if (INL(15)) {
            const LnArgs A{XN, (l == DEPTH - 1) ? (float*)ad.in[35] : nullptr, (l == DEPTH - 1) ? nullptr : ws + WS_XN8, (const float*)ad.in[I_LNFG] + l * D, (const float*)ad.in[I_LNFB] + l * D, (const float*)(ws + WS_OG), slot, nullptr, nullptr, nullptr};
            if (l == 0) ln_phase<0>(A, lds, G); else ln_phase<2>(A, lds, G);
        }
        SEAM(pb + 15);
    }
#undef INR
#undef IN0
#undef INL
#undef SEAM
}

extern "C" void kernel_launch(void* const* d_in, const int* in_sizes, int n_in, void* d_out, int out_size, void* d_ws, size_t ws_size, hipStream_t stream) {
    static int grid = 0;
    if (grid == 0) {
        if (n_in != 35 || out_size != M * D || ws_size < WS_END) { fprintf(stderr, "kernel_launch: shape/workspace mismatch: n_in %d out %d ws %zu (need %zu)\n", n_in, out_size, ws_size, (size_t)WS_END); grid = -1; return; }
        int dev = 0, cus = 0, per_cu = 0;
        if (hipGetDevice(&dev) != hipSuccess || hipDeviceGetAttribute(&cus, hipDeviceAttributeMultiprocessorCount, dev) != hipSuccess) { grid = -1; return; }
        if (hipFuncSetAttribute((const void*)fwd_kernel, hipFuncAttributeMaxDynamicSharedMemorySize, LDS_BYTES) != hipSuccess) { fprintf(stderr, "kernel_launch: hipFuncSetAttribute failed\n"); grid = -1; return; }
        if (hipOccupancyMaxActiveBlocksPerMultiprocessor(&per_cu, (const void*)fwd_kernel, 512, LDS_BYTES) != hipSuccess || per_cu < 1) { fprintf(stderr, "kernel_launch: occupancy query says %d\n", per_cu); }
        (void)hipGetLastError();
        grid = cus;
    }
    if (grid < 0) return;
    if (hipMemsetAsync((char*)d_ws + WS_CTL, 0, CTL_ZERO_BYTES, stream) != hipSuccess) return;
    Args a{};
    for (int i = 0; i < 35; ++i) a.in[i] = d_in[i];
    a.out = (float*)d_out; a.ws = (unsigned char*)d_ws;
#if MK_MULTI
    for (int p = 0; p < NPHASE; ++p) { if (p == 1 + 12) continue; a.ph_lo = p; a.ph_hi = p + 1; hipLaunchKernelGGL(fwd_kernel, dim3(grid), dim3(512), LDS_BYTES, stream, a); }
#else
    a.ph_lo = 0; a.ph_hi = NPHASE;
    hipLaunchKernelGGL(fwd_kernel, dim3(grid), dim3(512), LDS_BYTES, stream, a);
#endif
    const hipError_t le = hipPeekAtLastError();
    if (le != hipSuccess) fprintf(stderr, "kernel_launch: launch failed: %s\n", hipGetErrorName(le));
}
```

```cpp
#include <hip/hip_runtime.h>
#include <cstdio>
#include <cstdint>
#include <cmath>

#ifndef MK_MULTI
#define MK_MULTI 0
#endif
#ifndef MK_DBG
#define MK_DBG 0
#endif

#define GAS __attribute__((address_space(1)))
#define LAS __attribute__((address_space(3)))
typedef unsigned short bf16_t;
typedef short bf16x8 __attribute__((ext_vector_type(8)));
typedef short s16x4 __attribute__((ext_vector_type(4)));
typedef float f32x2 __attribute__((ext_vector_type(2)));
typedef float f32x4 __attribute__((ext_vector_type(4)));
typedef float f32x16 __attribute__((ext_vector_type(16)));
typedef unsigned u32x2 __attribute__((ext_vector_type(2)));
typedef unsigned u32x4 __attribute__((ext_vector_type(4)));
typedef GAS unsigned gu32;
#define RLX_AGENT __ATOMIC_RELAXED, __HIP_MEMORY_SCOPE_AGENT
#define LDS_WAIT() asm volatile("s_waitcnt lgkmcnt(0)" ::: "memory")
#define VM_WAIT() asm volatile("s_waitcnt vmcnt(0)" ::: "memory")
#define SBAR() __builtin_amdgcn_sched_barrier(0)

constexpr int M = 16384, D = 2048, DEPTH = 2, MEM_LEN = 256;
constexpr int NIN = 11264, NIN_BF = 3072  , NIN_G8 = 8192  ;
constexpr int NIN_SRC = 11072;
constexpr int DFF = 5632, NEXP = 8;
constexpr int SSM_L = 32, SSM_NCH = M / SSM_L  , SSM_KX = 640  ;
constexpr float LN_EPS = 1e-5f, RMS_EPS = 1e-6f;
constexpr float ALPHA = 1.4142135623730951f;
constexpr float LOG2E = 1.4426950408889634f;
constexpr float C2_DIFF = 0.125f * LOG2E;
constexpr float C2_MLA = 0.07216878364870323f * LOG2E;
constexpr float C2_X = 0.08838834764831845f * LOG2E;
constexpr int MOE_MAXROWS = 34816;

typedef __bf16 bf16x2_t __attribute__((ext_vector_type(2)));
__device__ __forceinline__ unsigned cvt_pk_bf16(float lo, float hi) { const f32x2 v = {lo, hi}; const bf16x2_t b = __builtin_convertvector(v, bf16x2_t); return __builtin_bit_cast(unsigned, b); }
__device__ __forceinline__ float bf_lo(unsigned w) { return __uint_as_float(w << 16); }
__device__ __forceinline__ float bf_hi(unsigned w) { return __uint_as_float(w & 0xffff0000u); }
__device__ __forceinline__ u32x4 pack8(f32x4 a, f32x4 b) { u32x4 w; w.x = cvt_pk_bf16(a[0], a[1]); w.y = cvt_pk_bf16(a[2], a[3]); w.z = cvt_pk_bf16(b[0], b[1]); w.w = cvt_pk_bf16(b[2], b[3]); return w; }
__device__ __forceinline__ u32x2 pack8_fp8(f32x4 a, f32x4 b) { int w0 = 0, w1 = 0;
    w0 = __builtin_amdgcn_cvt_pk_fp8_f32(a[0], a[1], w0, false); w0 = __builtin_amdgcn_cvt_pk_fp8_f32(a[2], a[3], w0, true);
    w1 = __builtin_amdgcn_cvt_pk_fp8_f32(b[0], b[1], w1, false); w1 = __builtin_amdgcn_cvt_pk_fp8_f32(b[2], b[3], w1, true);
    u32x2 r; r.x = (unsigned)w0; r.y = (unsigned)w1; return r; }
__device__ __forceinline__ float fast_sigmoid(float x) { return __builtin_amdgcn_rcpf(1.f + __builtin_amdgcn_exp2f(-x * LOG2E)); }
constexpr int LDS_WTAB = 131072 + 8192 + 1024;
__device__ __forceinline__ int opaque_tid() {
    const unsigned hw = __builtin_amdgcn_s_getreg(0x2804);
    const int wave = __builtin_amdgcn_readfirstlane(((volatile LAS int*)LDS_WTAB)[hw]);
    int lane; asm volatile("v_mbcnt_lo_u32_b32 %0, -1, 0\n\tv_mbcnt_hi_u32_b32 %0, -1, %0" : "=v"(lane));
    return wave * 64 + lane;
}
__device__ __forceinline__ float shflx(float v, int off, int lane) { return __int_as_float(__builtin_amdgcn_ds_bpermute((lane ^ off) << 2, __float_as_int(v))); }
__device__ __forceinline__ float wave_sum(float v, int lane) {
#pragma unroll
    for (int o = 1; o < 64; o <<= 1) v += shflx(v, o, lane);
    return v;
}

namespace pg8 {
constexpr int BM = 256, BK = 64, HALF = 128, HTB = HALF * BK * 2, STAGE_BYTES = 8 * HTB, NXCD = 8, WGM = 8;
__host__ __device__ __forceinline__ int lds_byte(int r, int c) { const int st = (r >> 4) * 2 + (c >> 5), rr = r & 15, cc = c & 31, ob = rr * 64 + cc * 2; return st * 1024 + (ob ^ (((ob >> 9) & 1) << 5)); }
__host__ __device__ __forceinline__ void stage_rc(int b, int& R, int& C) { const int st = b / 1024, sb = b % 1024, swz = sb ^ (((sb >> 9) & 1) << 5); R = (st >> 1) * 16 + swz / 64; C = (st & 1) * 32 + (swz % 64) / 2; }
__host__ __device__ __forceinline__ int perm32(int rho) { const int n = rho >> 4, i = rho & 15; return 8 * (i >> 2) + 4 * n + (i & 3); }

__device__ __forceinline__ size_t uni64(size_t v) { const unsigned lo_ = __builtin_amdgcn_readfirstlane((unsigned)v), hi_ = __builtin_amdgcn_readfirstlane((unsigned)(v >> 32)); return ((size_t)hi_ << 32) | lo_; }
struct Unit { int pm, pn, z; size_t offA, offB; };
struct Gemm { const void* A; const void* Bt; int ldaB, ldbB, KB; int wscale; };
typedef int v8i __attribute__((ext_vector_type(8)));
typedef int v4i __attribute__((ext_vector_type(4)));

struct TileOrder {
    int nM, nN, nwg;
    __device__ __forceinline__ void init(int nM_, int nN_) { nM = nM_; nN = nN_; nwg = nM * nN; }
    __device__ __forceinline__ bool map(long L, int& pm, int& pn) const {
        if (L >= nwg) return false;
        int wgid = (int)L; { const int q = nwg / NXCD, r = nwg % NXCD, xcd = wgid % NXCD, off = wgid / NXCD; wgid = (xcd < r ? xcd * (q + 1) : r * (q + 1) + (xcd - r) * q) + off; }
        const int nig = WGM * nN, gid = wgid / nig, fm = gid * WGM, gsz = (nM - fm) < WGM ? (nM - fm) : WGM;
        pm = __builtin_amdgcn_readfirstlane(fm + ((wgid % nig) % gsz)); pn = __builtin_amdgcn_readfirstlane((wgid % nig) / gsz); return true;
    }
};

template <bool FP8, int WSC, class Epi, class Sched>
__device__ __forceinline__ void gemm_phase_t(LAS unsigned char* lds, const Gemm g, const Sched& S, const Epi& E) {
    const int tid = opaque_tid(), wid = __builtin_amdgcn_readfirstlane(tid >> 6), lane = tid & 63, wr = wid >> 2, wc = wid & 3, fr = lane & 15, fq = lane >> 4;
    const int nt = g.KB / (BK * 2);
    unsigned voffA[2], voffB[2];
#pragma unroll
    for (int i = 0; i < 2; ++i) { int R, C; stage_rc(tid * 16 + i * 8192, R, C); const int Rb = (R & ~31) + perm32(R & 31);
        voffA[i] = (unsigned)(R * g.ldaB + C * 2); voffB[i] = (unsigned)(Rb * g.ldbB + C * 2); }
    const size_t kstep = (size_t)(BK * 2);
    const size_t hstepA = (size_t)HALF * g.ldaB, hstepB = (size_t)HALF * g.ldbB;
    const unsigned ldsw = (unsigned)wid * 1024u;
    const unsigned lds_u = __builtin_amdgcn_readfirstlane((unsigned)(uintptr_t)lds + ldsw);
    const int aoff = lds_byte(wr * 64 + fr, fq * 8), boff = lds_byte(wc * 32 + fr, fq * 8);
#define PG8_SA(b, h) (((b) * 2 + (h)) * HTB)
#define PG8_SB(b, h) ((4 + (b) * 2 + (h)) * HTB)
#define PG8_STAGE(bufoff, gbase, voff) do { _Pragma("unroll") for (int _i = 0; _i < 2; ++_i) \
        { unsigned _keep; asm volatile("s_mov_b32 %0, m0\n\ts_mov_b32 m0, %1\n\ts_nop 0\n\tglobal_load_lds_dwordx4 %2, %3\n\ts_mov_b32 m0, %0" : "=&s"(_keep) : "s"(lds_u + (unsigned)((bufoff) + _i * 8192)), "v"((voff)[_i]), "s"(gbase) : "memory"); } } while (0)
#define PG8_LD32(p) __builtin_shufflevector(*(const LAS v4i*)(p), *(const LAS v4i*)((p) + 1024), 0, 1, 2, 3, 4, 5, 6, 7)
#define PG8_LDA(dst, b, h) do { _Pragma("unroll") for (int m = 0; m < 4; ++m) dst[m] = PG8_LD32(lds + PG8_SA(b, h) + aoff + m * 2048); } while (0)
#define PG8_LDB(dst, b, h) do { _Pragma("unroll") for (int n = 0; n < 2; ++n) dst[n] = PG8_LD32(lds + PG8_SB(b, h) + boff + n * 2048); } while (0)
#define PG8_H0(x) __builtin_bit_cast(bf16x8, __builtin_shufflevector((x), (x), 0, 1, 2, 3))
#define PG8_H1(x) __builtin_bit_cast(bf16x8, __builtin_shufflevector((x), (x), 4, 5, 6, 7))
#define PG8_MMA(ai, bj, At, Bt) do { __builtin_amdgcn_s_setprio(1); _Pragma("unroll") for (int m = 0; m < 4; ++m) _Pragma("unroll") for (int n = 0; n < 2; ++n) { \
        if constexpr (FP8) asm volatile("v_mfma_scale_f32_16x16x128_f8f6f4 %0, %1, %2, %0, %3, %3 op_sel_hi:[0,0,0]" : "+v"(acc[ai][bj][m][n]) : "v"(Bt[n]), "v"(At[m]), "v"(wsc_v));     \
        else { acc[ai][bj][m][n] = __builtin_amdgcn_mfma_f32_16x16x32_bf16(PG8_H0(Bt[n]), PG8_H0(At[m]), acc[ai][bj][m][n], 0, 0, 0); acc[ai][bj][m][n] = __builtin_amdgcn_mfma_f32_16x16x32_bf16(PG8_H1(Bt[n]), PG8_H1(At[m]), acc[ai][bj][m][n], 0, 0, 0); } } \
        __builtin_amdgcn_s_setprio(0); } while (0)
#define PG8_WAIT_V(n) asm volatile("s_waitcnt vmcnt(" #n ")" ::: "memory")
#define PG8_WAIT_L(n) asm volatile("s_waitcnt lgkmcnt(" #n ")" ::: "memory")
#define PG8_BAR __builtin_amdgcn_s_barrier()
#define PG8_SCHED __builtin_amdgcn_sched_barrier(0)
    Unit cur, nxt; int ui = 0;
    if (!S.next(0, cur)) return;
    f32x4 acc[2][2][4][2];
#pragma unroll
    for (int a = 0; a < 2; ++a)
#pragma unroll
        for (int b = 0; b < 2; ++b)
#pragma unroll
            for (int m = 0; m < 4; ++m)
#pragma unroll
                for (int n = 0; n < 2; ++n) acc[a][b][m][n] = (f32x4){0.f, 0.f, 0.f, 0.f};
    v8i At[4], B0[2], B1[2]; const int wsc_v = WSC; (void)wsc_v;
    const char* cA = (const char*)g.A + uni64(cur.offA); const char* cB = (const char*)g.Bt + uni64(cur.offB);
    PG8_STAGE(PG8_SB(0, 0), cB, voffB); PG8_STAGE(PG8_SB(0, 1), cB + hstepB, voffB); PG8_STAGE(PG8_SA(0, 0), cA, voffA); PG8_STAGE(PG8_SA(0, 1), cA + hstepA, voffA);
    if (wr == 1) PG8_BAR;
    PG8_WAIT_V(2); PG8_BAR;
    PG8_STAGE(PG8_SB(1, 0), cB + kstep, voffB); PG8_STAGE(PG8_SA(1, 0), cA + kstep, voffA); PG8_STAGE(PG8_SB(1, 1), cB + hstepB + kstep, voffB);
    PG8_WAIT_V(6); PG8_BAR;
    for (;;) {
        const bool has_next = S.next(ui + 1, nxt);
        const char* nA = has_next ? (const char*)g.A + uni64(nxt.offA) : cA; const char* nB = has_next ? (const char*)g.Bt + uni64(nxt.offB) : cB;
        for (int t = 0; t < nt; t += 2) {
            const bool last = (t == nt - 2);
            const char* a1 = cA + (size_t)(t + 1) * kstep;
            const char* a2 = last ? nA : cA + (size_t)(t + 2) * kstep; const char* b2 = last ? nB : cB + (size_t)(t + 2) * kstep;
            const char* a3 = a2 + kstep; const char* b3 = b2 + kstep;
            PG8_LDB(B0, 0, 0); PG8_LDB(B1, 0, 1); PG8_SCHED; PG8_LDA(At, 0, 0); PG8_STAGE(PG8_SA(1, 1), a1 + hstepA, voffA);
            PG8_WAIT_V(8); PG8_WAIT_L(0); PG8_BAR; PG8_MMA(0, 0, At, B0); PG8_MMA(0, 1, At, B1); PG8_BAR; PG8_SCHED;
            PG8_LDA(At, 0, 1); PG8_STAGE(PG8_SB(0, 0), b2, voffB); PG8_STAGE(PG8_SB(0, 1), b2 + hstepB, voffB); PG8_STAGE(PG8_SA(0, 0), a2, voffA);
            PG8_WAIT_V(8); PG8_WAIT_L(0); PG8_BAR; PG8_MMA(1, 0, At, B0); PG8_MMA(1, 1, At, B1); PG8_BAR; PG8_SCHED;
            PG8_LDB(B0, 1, 0); PG8_LDB(B1, 1, 1); PG8_SCHED; PG8_LDA(At, 1, 0); PG8_STAGE(PG8_SA(0, 1), a2 + hstepA, voffA);
            PG8_WAIT_V(8); PG8_WAIT_L(0); PG8_BAR; PG8_MMA(0, 0, At, B0); PG8_MMA(0, 1, At, B1); PG8_BAR; PG8_SCHED;
            PG8_LDA(At, 1, 1); PG8_STAGE(PG8_SB(1, 0), b3, voffB); PG8_STAGE(PG8_SB(1, 1), b3 + hstepB, voffB); PG8_STAGE(PG8_SA(1, 0), a3, voffA);
            PG8_WAIT_V(8); PG8_WAIT_L(0); PG8_BAR; PG8_MMA(1, 0, At, B0); PG8_MMA(1, 1, At, B1); PG8_BAR; PG8_SCHED;
        }
        if (wr == 0) PG8_BAR;
        if constexpr (FP8) asm volatile("s_nop 15\n\ts_nop 15" ::: "memory");
        E(acc, cur, wr, wc, fr, fq);
        if (!has_next) break;
#pragma unroll
        for (int a = 0; a < 2; ++a)
#pragma unroll
            for (int b = 0; b < 2; ++b)
#pragma unroll
                for (int m = 0; m < 4; ++m)
#pragma unroll
                    for (int n = 0; n < 2; ++n) acc[a][b][m][n] = (f32x4){0.f, 0.f, 0.f, 0.f};
        cur = nxt; cA = nA; cB = nB; ++ui;
        if (wr == 1) PG8_BAR;
    }
    PG8_WAIT_V(0);
    PG8_BAR;
#undef PG8_SA
#undef PG8_SB
#undef PG8_STAGE
#undef PG8_LDA
#undef PG8_LDB
#undef PG8_MMA
#undef PG8_H0
#undef PG8_H1
#undef PG8_LD32
#undef PG8_WAIT_V
#undef PG8_WAIT_L
#undef PG8_BAR
#undef PG8_SCHED
}
template <class Epi, class Sched> __device__ __forceinline__ void gemm_phase(LAS unsigned char* lds, const Gemm g, const Sched& S, const Epi& E) { gemm_phase_t<false, 0>(lds, g, S, E); }
}

struct SchedPlain {
    pg8::TileOrder T; int G, c; size_t tA, tB;
    __device__ __forceinline__ void init(int nM, int nN, int lda, int ldb, int G_, int c_) { T.init(nM, nN); G = G_; c = c_; tA = (size_t)256 * lda * 2; tB = (size_t)256 * ldb * 2; }
    __device__ __forceinline__ bool next(int i, pg8::Unit& u) const { if (!T.map((long)i * G + c, u.pm, u.pn)) return false; u.z = 0; u.offA = u.pm * tA; u.offB = u.pn * tB; return true; }
};
struct SchedBatch {
    int nM, nN, nZ, G, c; size_t tA, tB, zA, zB;
    __device__ __forceinline__ bool next(int i, pg8::Unit& u) const {
        const long L = (long)i * G + c; const int per = nM * nN; if (L >= (long)per * nZ) return false;
        const int z = __builtin_amdgcn_readfirstlane((int)(L / per)), r = __builtin_amdgcn_readfirstlane((int)(L % per)); u.z = z; u.pm = __builtin_amdgcn_readfirstlane(r / nN); u.pn = __builtin_amdgcn_readfirstlane(r % nN); u.offA = z * zA + u.pm * tA; u.offB = z * zB + u.pn * tB; return true; }
};
struct SchedBranch {
    pg8::TileOrder T; int G, c; size_t tA, tB, zA, zB;
    __device__ __forceinline__ bool next(int i, pg8::Unit& u) const { const int t = i / 3, z = i - 3 * t; if (!T.map((long)t * G + c, u.pm, u.pn)) return false; u.z = z; u.offA = z * zA + u.pm * tA; u.offB = z * zB + u.pn * tB; return true; }
};
struct SchedMoe {
    pg8::TileOrder T; int G, c; size_t tA, tB, zB; int off[7];
    __device__ __forceinline__ bool next(int i, pg8::Unit& u) const {
        if (!T.map((long)i * G + c, u.pm, u.pn)) return false; const int r0 = u.pm * 256; int e = 0;
#pragma unroll
        for (int k = 0; k < 7; ++k) e += (r0 >= off[k]) ? 1 : 0;
        e = __builtin_amdgcn_readfirstlane(e); u.z = e; u.offA = u.pm * tA; u.offB = e * zB + u.pn * tB; return true; }
};

#define EPI_ARGS const f32x4 (&acc)[2][2][4][2], const pg8::Unit& u, int wr, int wc, int fr, int fq
#define EPI_ROW(ai, m) (u.pm * 256 + (ai) * 128 + wr * 64 + (m) * 16 + fr)
#define EPI_CB(bj) ((bj) * 128 + wc * 32 + fq * 8)
#define FOR_AI_M _Pragma("unroll") for (int ai = 0; ai < 2; ++ai) _Pragma("unroll") for (int m = 0; m < 4; ++m)
#define FOR_BJ _Pragma("unroll") for (int bj = 0; bj < 2; ++bj)

__device__ __forceinline__ void rope4(f32x4& v0, f32x4& v1, const f32x4 t0, const f32x4 t1) {
    const float a0 = v0[0] * t0[0] - v0[1] * t0[1], b0 = v0[1] * t0[0] + v0[0] * t0[1];
    const float a1 = v0[2] * t0[2] - v0[3] * t0[3], b1 = v0[3] * t0[2] + v0[2] * t0[3];
    const float a2 = v1[0] * t1[0] - v1[1] * t1[1], b2 = v1[1] * t1[0] + v1[0] * t1[1];
    const float a3 = v1[2] * t1[2] - v1[3] * t1[3], b3 = v1[3] * t1[2] + v1[2] * t1[3];
    v0 = (f32x4){a0, b0, a1, b1}; v1 = (f32x4){a2, b2, a3, b3};
}

struct EpiInProj {
    bf16_t *QD, *KD, *VD, *MQ, *MKV, *KM, *SU, *GATES; float *ssq_q, *ssq_kv; const float* tabd; const float* tabm;
    int pn_add;
    __device__ __forceinline__ void operator()(EPI_ARGS) const {
        const int pn = u.pn + pn_add;
        if (pn < 8) {
            bf16_t* O = pn < 4 ? QD : KD; const float sc = pn < 4 ? C2_DIFF : 1.f; const int colt = (pn & 3) * 256;
            const bool rp = ((wc & 1) == 0) && fq < 2;
#pragma unroll
            for (int ai = 0; ai < 2; ++ai) { f32x4 tt[4][2];
#pragma unroll
                for (int m = 0; m < 4; ++m) { tt[m][0] = (f32x4){1.f, 0.f, 1.f, 0.f}; tt[m][1] = (f32x4){1.f, 0.f, 1.f, 0.f};
                    if (rp) { const f32x4* tp = (const f32x4*)(tabd + (size_t)EPI_ROW(ai, m) * 16 + fq * 8); tt[m][0] = tp[0]; tt[m][1] = tp[1]; } }
#pragma unroll
                for (int m = 0; m < 4; ++m) { const int row = EPI_ROW(ai, m);
                    FOR_BJ { f32x4 v0 = acc[ai][bj][m][0], v1 = acc[ai][bj][m][1]; rope4(v0, v1, tt[m][0], tt[m][1]); v0 = v0 * sc; v1 = v1 * sc;
                        *(u32x4*)(O + (size_t)row * 1024 + colt + EPI_CB(bj)) = pack8(v0, v1); } } }
        } else if (pn < 12) {
            const int colt = (pn - 8) * 256;
            FOR_AI_M { const int row = EPI_ROW(ai, m); FOR_BJ { *(u32x4*)(VD + (size_t)row * 1024 + colt + EPI_CB(bj)) = pack8(acc[ai][bj][m][0], acc[ai][bj][m][1]); } }
        } else if (pn < 15) {
            bf16_t* O = pn < 14 ? MQ : MKV; const int ld = pn < 14 ? 512 : 256, colt = pn < 14 ? (pn - 12) * 256 : 0; float* ssq = pn < 14 ? ssq_q + (pn - 12) * 4 + wc : ssq_kv + wc; const int ns = pn < 14 ? 8 : 4;
            FOR_AI_M { const int row = EPI_ROW(ai, m); float s = 0.f;
                FOR_BJ { const f32x4 v0 = acc[ai][bj][m][0], v1 = acc[ai][bj][m][1]; s += (v0[0] * v0[0] + v0[1] * v0[1]) + (v0[2] * v0[2] + v0[3] * v0[3]) + (v1[0] * v1[0] + v1[1] * v1[1]) + (v1[2] * v1[2] + v1[3] * v1[3]);
                    *(u32x4*)(O + (size_t)row * ld + colt + EPI_CB(bj)) = pack8(v0, v1); }
                s += shflx(s, 16, fq * 16 + fr); s += shflx(s, 32, fq * 16 + fr);
                if (fq == 0) ssq[(size_t)row * ns] = s; }
        } else if (pn == 15) {
            if (wc < 2) {
                FOR_AI_M { const int row = EPI_ROW(ai, m); const f32x4* tp = (const f32x4*)(tabm + (size_t)row * 64 + (wc * 16 + fq * 4) * 2);
                    f32x4 v0 = acc[ai][0][m][0], v1 = acc[ai][0][m][1]; rope4(v0, v1, tp[0], tp[1]); const u32x4 w = pack8(v0, v1);
#pragma unroll
                    for (int h = 0; h < 8; ++h) *(u32x4*)(KM + (size_t)row * 1536 + h * 192 + 128 + wc * 32 + fq * 8) = w; }
            }
        } else if (pn < 20) {
            FOR_AI_M { const int row = EPI_ROW(ai, m); const int c = row >> 5, j = row & 31;
                FOR_BJ { const int ch = (pn - 16) * 256 + EPI_CB(bj), g = ch >> 4, q = ch & 15;
                    *(u32x4*)(SU + ((size_t)(g * SSM_NCH + c) * SSM_KX + j * 16 + q)) = pack8(acc[ai][bj][m][0], acc[ai][bj][m][1]); } }
        } else {
            const int colt = (pn - 20) * 256;
            FOR_AI_M { const int row = EPI_ROW(ai, m);
                FOR_BJ { f32x4 v0 = acc[ai][bj][m][0], v1 = acc[ai][bj][m][1];
#pragma unroll
                    for (int e = 0; e < 4; ++e) { v0[e] = fast_sigmoid(v0[e]); v1[e] = fast_sigmoid(v1[e]); }
                    *(u32x4*)(GATES + (size_t)row * 6144 + colt + EPI_CB(bj)) = pack8(v0, v1); } }
        }
    }
};
struct EpiQup {
    bf16_t* QM; const float* ssq; const float* tabm;
    __device__ __forceinline__ void operator()(EPI_ARGS) const {
#pragma unroll
        for (int ai = 0; ai < 2; ++ai) { f32x4 sq[4][2];
#pragma unroll
            for (int m = 0; m < 4; ++m) { const int row = EPI_ROW(ai, m); sq[m][0] = *(const f32x4*)(ssq + (size_t)row * 8); sq[m][1] = *(const f32x4*)(ssq + (size_t)row * 8 + 4); }
#pragma unroll
            for (int m = 0; m < 4; ++m) { const int row = EPI_ROW(ai, m); const f32x4 s0 = sq[m][0], s1 = sq[m][1];
                const float rq = __builtin_amdgcn_rsqf((((s0[0] + s0[1]) + (s0[2] + s0[3])) + ((s1[0] + s1[1]) + (s1[2] + s1[3]))) * (1.f / 512.f) + RMS_EPS) * C2_MLA;
                FOR_BJ { const int col = u.pn * 256 + EPI_CB(bj), h = col / 192, hc = col - h * 192; f32x4 v0 = acc[ai][bj][m][0], v1 = acc[ai][bj][m][1];
                    if (hc >= 128) { const f32x4* tp = (const f32x4*)(tabm + (size_t)row * 64 + (hc - 128)); rope4(v0, v1, tp[0], tp[1]); }
                    v0 = v0 * rq; v1 = v1 * rq; *(u32x4*)(QM + (size_t)row * 1536 + col) = pack8(v0, v1); } } }
    }
};
struct EpiKVup {
    bf16_t *KM, *VM; const float* ssq;
    __device__ __forceinline__ void operator()(EPI_ARGS) const {
#pragma unroll
        for (int ai = 0; ai < 2; ++ai) { float rk[4];
#pragma unroll
            for (int m = 0; m < 4; ++m) { const f32x4 s0 = *(const f32x4*)(ssq + (size_t)EPI_ROW(ai, m) * 4); rk[m] = ((s0[0] + s0[1]) + (s0[2] + s0[3])); }
#pragma unroll
            for (int m = 0; m < 4; ++m) { const int row = EPI_ROW(ai, m); const float r = __builtin_amdgcn_rsqf(rk[m] * (1.f / 256.f) + RMS_EPS); const int c = wc * 32 + fq * 8;
                *(u32x4*)(KM + (size_t)row * 1536 + u.pn * 192 + c) = pack8(acc[ai][0][m][0] * r, acc[ai][0][m][1] * r);
                *(u32x4*)(VM + (size_t)row * 1024 + u.pn * 128 + c) = pack8(acc[ai][1][m][0] * r, acc[ai][1][m][1] * r); } }
    }
};
struct EpiSloc {
    float* SLOC;
    __device__ __forceinline__ void operator()(EPI_ARGS) const {
        FOR_AI_M { const int c = EPI_ROW(ai, m); float* o = SLOC + ((size_t)(u.z * SSM_NCH + c) * 128 + wc * 32 + fq * 8);
            *(f32x4*)o = acc[ai][0][m][0]; *(f32x4*)(o + 4) = acc[ai][0][m][1]; }
    }
};
__device__ __forceinline__ float gelu_tanh(float x) { const float t = 1.5957691216057308f * (x + 0.044715f * x * x * x); return x * fast_sigmoid(t); }
struct EpiSsmY {
    bf16_t* YG; const bf16_t* SU; const float* dskip;
    __device__ __forceinline__ void operator()(EPI_ARGS) const {
        const int g = u.z; f32x4 d0[2], d1[2];
        FOR_BJ { const int col = u.pn * 256 + EPI_CB(bj), ch = g * 16 + (col & 15); d0[bj] = *(const f32x4*)(dskip + ch); d1[bj] = *(const f32x4*)(dskip + ch + 4); }
#pragma unroll
        for (int ai = 0; ai < 2; ++ai) { u32x4 uu[4][2];
#pragma unroll
            for (int m = 0; m < 4; ++m) { const int c = EPI_ROW(ai, m);
                FOR_BJ { const int col = u.pn * 256 + EPI_CB(bj), i = col >> 4, p0 = col & 15; uu[m][bj] = *(const u32x4*)(SU + ((size_t)(g * SSM_NCH + c) * SSM_KX + i * 16 + p0)); } }
#pragma unroll
            for (int m = 0; m < 4; ++m) { const int c = EPI_ROW(ai, m);
                FOR_BJ { const int col = u.pn * 256 + EPI_CB(bj), i = col >> 4, p0 = col & 15, t = c * SSM_L + i, ch = g * 16 + p0; const u32x4 w = uu[m][bj];
                    f32x4 v0 = acc[ai][bj][m][0], v1 = acc[ai][bj][m][1];
                    v0[0] += d0[bj][0] * bf_lo(w.x); v0[1] += d0[bj][1] * bf_hi(w.x); v0[2] += d0[bj][2] * bf_lo(w.y); v0[3] += d0[bj][3] * bf_hi(w.y);
                    v1[0] += d1[bj][0] * bf_lo(w.z); v1[1] += d1[bj][1] * bf_hi(w.z); v1[2] += d1[bj][2] * bf_lo(w.w); v1[3] += d1[bj][3] * bf_hi(w.w);
#pragma unroll
                    for (int e = 0; e < 4; ++e) { v0[e] = gelu_tanh(v0[e]); v1[e] = gelu_tanh(v1[e]); }
                    *(u32x4*)(YG + (size_t)t * 1024 + ch) = pack8(v0, v1); } } }
    }
};
template <int ACT  > struct EpiGated {
    bf16_t* O; int ldo;
    __device__ __forceinline__ void operator()(EPI_ARGS) const {
        FOR_AI_M { const int row = EPI_ROW(ai, m); f32x4 r[2];
#pragma unroll
            for (int n = 0; n < 2; ++n)
#pragma unroll
                for (int e = 0; e < 4; ++e) { const float a = acc[ai][0][m][n][e], b = acc[ai][1][m][n][e]; r[n][e] = ACT == 0 ? a * fast_sigmoid(b) : a * fast_sigmoid(a) * b; }
            *(u32x4*)(O + (size_t)row * ldo + u.pn * 128 + wc * 32 + fq * 8) = pack8(r[0], r[1]); }
    }
};
struct EpiSwigluF8 {
    unsigned char* O; int ldo;
    __device__ __forceinline__ void operator()(EPI_ARGS) const {
        FOR_AI_M { const int row = EPI_ROW(ai, m); f32x4 r[2];
#pragma unroll
            for (int n = 0; n < 2; ++n)
#pragma unroll
                for (int e = 0; e < 4; ++e) { const float a = acc[ai][0][m][n][e], b = acc[ai][1][m][n][e]; r[n][e] = a * fast_sigmoid(a) * b; }
            *(u32x2*)(O + (size_t)row * ldo + u.pn * 128 + wc * 32 + fq * 8) = pack8_fp8(r[0], r[1]); }
    }
};
struct EpiGatesF8 {
    bf16_t* GATES;
    __device__ __forceinline__ void operator()(EPI_ARGS) const {
        FOR_AI_M { const int row = EPI_ROW(ai, m);
            FOR_BJ { f32x4 v0 = acc[ai][bj][m][0], v1 = acc[ai][bj][m][1];
#pragma unroll
                for (int e = 0; e < 4; ++e) { v0[e] = fast_sigmoid(v0[e]); v1[e] = fast_sigmoid(v1[e]); }
                *(u32x4*)(GATES + (size_t)row * 6144 + u.pn * 256 + EPI_CB(bj)) = pack8(v0, v1); } }
    }
};
struct EpiBranch {
    const bf16_t* GATES; bf16_t* P; bf16_t* MG;
    __device__ __forceinline__ void operator()(EPI_ARGS) const {
        const int z = u.z;
#pragma unroll
        for (int ai = 0; ai < 2; ++ai)
#pragma unroll
            for (int mh = 0; mh < 2; ++mh) { u32x4 gg[2][2], pa[2][2], pb[2][2];
#pragma unroll
                for (int mm = 0; mm < 2; ++mm) { const int row = EPI_ROW(ai, mh * 2 + mm);
                    FOR_BJ { const int col = u.pn * 256 + EPI_CB(bj); gg[mm][bj] = *(const u32x4*)(GATES + (size_t)row * 6144 + z * 2048 + col);
                        if (z == 2) { const size_t o = (size_t)row * 2048 + col; pa[mm][bj] = *(const u32x4*)(P + o); pb[mm][bj] = *(const u32x4*)(P + (size_t)M * 2048 + o); } } }
#pragma unroll
                for (int mm = 0; mm < 2; ++mm) { const int m = mh * 2 + mm, row = EPI_ROW(ai, m);
                    FOR_BJ { const int col = u.pn * 256 + EPI_CB(bj); const u32x4 g = gg[mm][bj];
                        f32x4 v0 = acc[ai][bj][m][0], v1 = acc[ai][bj][m][1];
                        v0[0] *= bf_lo(g.x); v0[1] *= bf_hi(g.x); v0[2] *= bf_lo(g.y); v0[3] *= bf_hi(g.y);
                        v1[0] *= bf_lo(g.z); v1[1] *= bf_hi(g.z); v1[2] *= bf_lo(g.w); v1[3] *= bf_hi(g.w);
                        const size_t o = (size_t)row * 2048 + col;
                        if (z < 2) *(u32x4*)(P + (size_t)z * M * 2048 + o) = pack8(v0, v1);
                        else { const u32x4 a = pa[mm][bj], b = pb[mm][bj];
                            v0[0] += bf_lo(a.x) + bf_lo(b.x); v0[1] += bf_hi(a.x) + bf_hi(b.x); v0[2] += bf_lo(a.y) + bf_lo(b.y); v0[3] += bf_hi(a.y) + bf_hi(b.y);
                            v1[0] += bf_lo(a.z) + bf_lo(b.z); v1[1] += bf_hi(a.z) + bf_hi(b.z); v1[2] += bf_lo(a.w) + bf_lo(b.w); v1[3] += bf_hi(a.w) + bf_hi(b.w);
                            *(u32x4*)(MG + o) = pack8(v0, v1); } } } }
    }
};
struct EpiResid {
    bf16_t* X;
    __device__ __forceinline__ void operator()(EPI_ARGS) const {
#pragma unroll
        for (int ai = 0; ai < 2; ++ai) { u32x4 r[4][2];
#pragma unroll
            for (int m = 0; m < 4; ++m) { const int row = EPI_ROW(ai, m);
                FOR_BJ { r[m][bj] = *(const u32x4*)(X + (size_t)row * 2048 + u.pn * 256 + EPI_CB(bj)); } }
#pragma unroll
            for (int m = 0; m < 4; ++m) { const int row = EPI_ROW(ai, m);
                FOR_BJ { const u32x4 w = r[m][bj]; f32x4 v0 = acc[ai][bj][m][0], v1 = acc[ai][bj][m][1];
                    v0[0] += ALPHA * bf_lo(w.x); v0[1] += ALPHA * bf_hi(w.x); v0[2] += ALPHA * bf_lo(w.y); v0[3] += ALPHA * bf_hi(w.y);
                    v1[0] += ALPHA * bf_lo(w.z); v1[1] += ALPHA * bf_hi(w.z); v1[2] += ALPHA * bf_lo(w.w); v1[3] += ALPHA * bf_hi(w.w);
                    *(u32x4*)(X + (size_t)row * 2048 + u.pn * 256 + EPI_CB(bj)) = pack8(v0, v1); } } }
    }
};
struct EpiBf16 {
    bf16_t* O; int ldo; float scale;
    __device__ __forceinline__ void operator()(EPI_ARGS) const {
        FOR_AI_M { const int row = EPI_ROW(ai, m); FOR_BJ { *(u32x4*)(O + (size_t)row * ldo + u.pn * 256 + EPI_CB(bj)) = pack8(acc[ai][bj][m][0] * scale, acc[ai][bj][m][1] * scale); } }
    }
};
struct EpiBf16Half {
    bf16_t* O; int ldo; float scale;
    __device__ __forceinline__ void operator()(EPI_ARGS) const {
#pragma unroll
        for (int m = 0; m < 4; ++m) { const int row = u.pm * 128 + wr * 64 + m * 16 + fr;
            FOR_BJ { *(u32x4*)(O + (size_t)row * ldo + u.pn * 256 + EPI_CB(bj)) = pack8(acc[0][bj][m][0] * scale, acc[0][bj][m][1] * scale); } }
    }
};
struct EpiMoeDown {
    float* OG; const float* wslot;
    __device__ __forceinline__ void operator()(EPI_ARGS) const {
        float w[2][4];
        FOR_AI_M w[ai][m] = wslot[EPI_ROW(ai, m)];
        FOR_AI_M { const int row = EPI_ROW(ai, m);
            FOR_BJ { float* o = OG + (size_t)row * 2048 + u.pn * 256 + EPI_CB(bj); *(f32x4*)o = acc[ai][bj][m][0] * w[ai][m]; *(f32x4*)(o + 4) = acc[ai][bj][m][1] * w[ai][m]; } }
    }
};

namespace att {
constexpr int KVBLK = 64, SHM_V = KVBLK * 128 * 2;
constexpr float THRL = 8.f;
__device__ __forceinline__ int crow(int r, int hi) { return (r & 3) + 8 * (r >> 2) + 4 * hi; }
template <int PITCH> __device__ __forceinline__ int kfl(int row) { return (PITCH % 256 == 128) ? ((row >> 1) & 7) : (row & 15); }
template <int PITCH> __device__ __forceinline__ int kswz(int row, int colB) { return row * PITCH + (colB ^ (kfl<PITCH>(row) << 4)); }
__device__ __forceinline__ int v_st(int k, int c) { const int kk = k; return ((kk >> 3) * 4 + (c >> 5)) * 512 + ((kk & 7) * 32 + (c & 31)) * 2; }
__device__ __forceinline__ int v_rd_base(int lane) { return ((lane & 3) << 3) | (((lane >> 2) & 3) << 6) | (((lane >> 4) & 1) << 5) | (((lane >> 5) & 1) << 8); }
constexpr int v_rd_off(int d0, int ks, int half) { return d0 * 512 + ks * 4096 + half * 2048; }

__device__ __forceinline__ void mask_tile(f32x16& p0, f32x16& p1, int dq) {
    const float NEG = -__builtin_inff();
#pragma unroll
    for (int r = 0; r < 16; ++r) { const int c = (r & 3) + 8 * (r >> 2); if (dq - c < 0) p0[r] = NEG; if (dq - c - 32 < 0) p1[r] = NEG; }
}
__device__ __forceinline__ void partialSM(f32x16& p0, f32x16& p1, float& m_reg, float& alpha) {
    float pmax = p0[0];
#pragma unroll
    for (int r = 1; r < 16; ++r) pmax = fmaxf(pmax, p0[r]);
#pragma unroll
    for (int r = 0; r < 16; ++r) pmax = fmaxf(pmax, p1[r]);
    { auto rr = __builtin_amdgcn_permlane32_swap(__float_as_uint(pmax), __float_as_uint(pmax), false, false); pmax = fmaxf(__uint_as_float(rr[0]), __uint_as_float(rr[1])); }
    float mn;
    if (__builtin_expect(__all(pmax - m_reg <= THRL), 1)) { mn = m_reg; alpha = 1.f; }
    else { mn = fmaxf(m_reg, pmax); alpha = __builtin_amdgcn_exp2f(m_reg - mn); m_reg = mn; }
#pragma unroll
    for (int r = 0; r < 16; ++r) { p0[r] -= mn; p1[r] -= mn; }
#pragma unroll
    for (int r = 0; r < 16; ++r) p0[r] = __builtin_amdgcn_exp2f(p0[r]);
}
__device__ __forceinline__ void finishSM(f32x16& p0, f32x16& p1, float alpha, float& l_reg, bf16x8& pa0, bf16x8& pa1, bf16x8& pa2, bf16x8& pa3) {
#pragma unroll
    for (int r = 0; r < 16; ++r) p1[r] = __builtin_amdgcn_exp2f(p1[r]);
    float ps = 0;
#pragma unroll
    for (int r = 0; r < 16; ++r) ps += p0[r];
#pragma unroll
    for (int r = 0; r < 16; ++r) ps += p1[r];
    { auto rr = __builtin_amdgcn_permlane32_swap(__float_as_uint(ps), __float_as_uint(ps), false, false); ps = __uint_as_float(rr[0]) + __uint_as_float(rr[1]); }
    l_reg = l_reg * alpha + ps;
#define PK4(P, B_, OUT) do { unsigned a0 = cvt_pk_bf16(P[B_+0], P[B_+1]), a1 = cvt_pk_bf16(P[B_+2], P[B_+3]); unsigned b0 = cvt_pk_bf16(P[B_+4], P[B_+5]), b1 = cvt_pk_bf16(P[B_+6], P[B_+7]); \
        u32x4 w = {a0, a1, b0, b1}; OUT = *reinterpret_cast<bf16x8*>(&w); } while (0)
    PK4(p0, 0, pa0); PK4(p0, 8, pa1); PK4(p1, 0, pa2); PK4(p1, 8, pa3);
#undef PK4
}
template <int PITCH, int ND0>
__device__ __forceinline__ void qkt(f32x16& p0, f32x16& p1, const char* Kb, int r32, int hi, int kch0, const bf16x8* qr) {
    p0 = f32x16{}; p1 = f32x16{};
    const char* kb[4];
#pragma unroll
    for (int dd = 0; dd < 4; ++dd) kb[dd] = Kb + kswz<PITCH>(r32, (kch0 + dd * 2 + hi) * 16);
#pragma unroll
    for (int d0 = 0; d0 < ND0; ++d0) { const char* a = (PITCH % 256 == 0) ? Kb + kswz<PITCH>(r32, (kch0 + d0 * 2 + hi) * 16) : kb[d0 & 3] + (d0 >> 2) * 128;
        const bf16x8 b0 = *reinterpret_cast<const bf16x8*>(a);
        const bf16x8 b1 = *reinterpret_cast<const bf16x8*>(a + 32 * PITCH);
        p0 = __builtin_amdgcn_mfma_f32_32x32x16_bf16(b0, qr[d0], p0, 0, 0, 0);
        p1 = __builtin_amdgcn_mfma_f32_32x32x16_bf16(b1, qr[d0], p1, 0, 0, 0); }
}
__device__ __forceinline__ void pv_tile(f32x16* o, int vb0, bf16x8 pa0, bf16x8 pa1, bf16x8 pa2, bf16x8 pa3) {
    s16x4 va[8], vb[8];
#define TRRD(dst, off) asm volatile("ds_read_b64_tr_b16 %0, %1 offset:%2" : "=&v"(dst) : "v"(vb0), "i"(off) : "memory")
#define PV_RD(v, d0) do { constexpr int b_ = v_rd_off(d0, 0, 0); TRRD(v[0], b_); TRRD(v[1], b_ + 2048); TRRD(v[2], b_ + 4096); TRRD(v[3], b_ + 6144); TRRD(v[4], b_ + 8192); TRRD(v[5], b_ + 10240); TRRD(v[6], b_ + 12288); TRRD(v[7], b_ + 14336); } while (0)
#define PV_MM(v, d0) do { \
        o[d0] = __builtin_amdgcn_mfma_f32_32x32x16_bf16(pa0, (bf16x8){v[0][0], v[0][1], v[0][2], v[0][3], v[1][0], v[1][1], v[1][2], v[1][3]}, o[d0], 0, 0, 0); \
        o[d0] = __builtin_amdgcn_mfma_f32_32x32x16_bf16(pa1, (bf16x8){v[2][0], v[2][1], v[2][2], v[2][3], v[3][0], v[3][1], v[3][2], v[3][3]}, o[d0], 0, 0, 0); \
        o[d0] = __builtin_amdgcn_mfma_f32_32x32x16_bf16(pa2, (bf16x8){v[4][0], v[4][1], v[4][2], v[4][3], v[5][0], v[5][1], v[5][2], v[5][3]}, o[d0], 0, 0, 0); \
        o[d0] = __builtin_amdgcn_mfma_f32_32x32x16_bf16(pa3, (bf16x8){v[6][0], v[6][1], v[6][2], v[6][3], v[7][0], v[7][1], v[7][2], v[7][3]}, o[d0], 0, 0, 0); } while (0)
#define PV_W8(v) asm volatile("s_waitcnt lgkmcnt(8)" : "+v"(v[0]), "+v"(v[1]), "+v"(v[2]), "+v"(v[3]), "+v"(v[4]), "+v"(v[5]), "+v"(v[6]), "+v"(v[7]) :: "memory")
#define PV_W0(v) asm volatile("s_waitcnt lgkmcnt(0)" : "+v"(v[0]), "+v"(v[1]), "+v"(v[2]), "+v"(v[3]), "+v"(v[4]), "+v"(v[5]), "+v"(v[6]), "+v"(v[7]) :: "memory")
    PV_RD(va, 0); PV_RD(vb, 1); PV_W8(va); SBAR(); PV_MM(va, 0);
    PV_RD(va, 2); PV_W8(vb); SBAR(); PV_MM(vb, 1);
    PV_RD(vb, 3); PV_W8(va); SBAR(); PV_MM(va, 2);
    PV_W0(vb); SBAR(); PV_MM(vb, 3);
#undef PV_W0
#undef PV_W8
#undef PV_MM
#undef PV_RD
#undef TRRD
}

template <int KT, int ND0, bool CAUSAL, bool PIPE>
__device__ __forceinline__ void attn_core(const bf16_t* Qlane, const bf16_t* __restrict__ Kh, int ldk, const bf16_t* __restrict__ Vh, int ldv, int NT, int qpos, int qlo, int kch0,
                                          char* lds, f32x16 (&o)[4], float& l_reg) {
    constexpr int PITCH = KT * 2, SHM_K = KVBLK * PITCH, NKL = KT / 64, CPR = KT / 8;
    const int tid = opaque_tid(), wid = __builtin_amdgcn_readfirstlane(tid >> 6), lane = tid & 63, r32 = lane & 31, hi = lane >> 5;
    char* V_lds = lds; char* K_lds = lds + 2 * SHM_V;
    float* ws = (float*)(lds + 2 * SHM_V + 2 * SHM_K) + wid * 64; float* al_l = ws + 32;
    float m_reg = -1e30f; l_reg = 0.f;
#pragma unroll
    for (int d = 0; d < 4; ++d) o[d] = f32x16{};
    bf16x8 qr[ND0];
#pragma unroll
    for (int d0 = 0; d0 < ND0; ++d0) qr[d0] = *reinterpret_cast<const bf16x8*>(Qlane + d0 * 16);
    const int sr = tid >> 4, sc = (tid & 15) * 8, vst0 = v_st(sr, sc), vst1 = v_st(32 + sr, sc);
    const int vb0 = (int)(uintptr_t)V_lds + v_rd_base(lane);
    int krow[NKL], kcc[NKL];
#pragma unroll
    for (int i = 0; i < NKL; ++i) { const int cid = tid + 512 * i; krow[i] = cid / CPR; kcc[i] = cid - krow[i] * CPR; }
    bf16x8 st_v0, st_v1, st_k[NKL];
#define SLOAD(k0) do { st_v0 = *reinterpret_cast<const bf16x8*>(Vh + (size_t)((k0) + sr) * ldv + sc); st_v1 = *reinterpret_cast<const bf16x8*>(Vh + (size_t)((k0) + 32 + sr) * ldv + sc); \
        _Pragma("unroll") for (int i_ = 0; i_ < NKL; ++i_) st_k[i_] = *reinterpret_cast<const bf16x8*>(Kh + (size_t)((k0) + krow[i_]) * ldk + kcc[i_] * 8); } while (0)
#define SWRITE(b) do { *(bf16x8*)(V_lds + (b) * SHM_V + vst0) = st_v0; *(bf16x8*)(V_lds + (b) * SHM_V + vst1) = st_v1; \
        _Pragma("unroll") for (int i_ = 0; i_ < NKL; ++i_) *(bf16x8*)(K_lds + (b) * SHM_K + kswz<PITCH>(krow[i_], kcc[i_] * 16)) = st_k[i_]; } while (0)
#define RESC(a) do { if (__any((a) < 1.f)) { if (hi == 0) al_l[r32] = (a); asm volatile("s_waitcnt lgkmcnt(0)" ::: "memory"); \
        _Pragma("unroll") for (int d_ = 0; d_ < 4; ++d_) _Pragma("unroll") for (int r = 0; r < 16; ++r) o[d_][r] *= al_l[crow(r, hi)]; } } while (0)
#define MASKT(P0_, P1_, t) do { if (CAUSAL) { const int kb_ = (t) * KVBLK; if (kb_ + KVBLK - 1 > qlo) mask_tile(P0_, P1_, qpos - kb_ - 4 * hi); } } while (0)
    if constexpr (PIPE) {
    f32x16 pA0, pA1, pB0, pB1; float alA, alB; bf16x8 pa0, pa1, pa2, pa3;
    SLOAD(0); VM_WAIT(); SWRITE(0); __syncthreads();
    qkt<PITCH, ND0>(pA0, pA1, K_lds, r32, hi, kch0, qr); MASKT(pA0, pA1, 0); partialSM(pA0, pA1, m_reg, alA);
    SLOAD(KVBLK); VM_WAIT(); SWRITE(1); __syncthreads();
    for (int j = 1; j + 1 < NT; j += 2) {
        SBAR(); qkt<PITCH, ND0>(pB0, pB1, K_lds + SHM_K, r32, hi, kch0, qr);
        finishSM(pA0, pA1, alA, l_reg, pa0, pa1, pa2, pa3); SBAR();
        SLOAD((j + 1) * KVBLK); SBAR();
        pv_tile(o, vb0, pa0, pa1, pa2, pa3); MASKT(pB0, pB1, j); partialSM(pB0, pB1, m_reg, alB);
        __syncthreads(); VM_WAIT(); SWRITE(0);
        RESC(alB); __syncthreads();
        SBAR(); qkt<PITCH, ND0>(pA0, pA1, K_lds, r32, hi, kch0, qr);
        finishSM(pB0, pB1, alB, l_reg, pa0, pa1, pa2, pa3); SBAR();
        SLOAD((j + 2) * KVBLK); SBAR();
        pv_tile(o, vb0 + SHM_V, pa0, pa1, pa2, pa3); MASKT(pA0, pA1, j + 1); partialSM(pA0, pA1, m_reg, alA);
        __syncthreads(); VM_WAIT(); SWRITE(1);
        RESC(alA); __syncthreads();
    }
    SBAR(); qkt<PITCH, ND0>(pB0, pB1, K_lds + SHM_K, r32, hi, kch0, qr);
    finishSM(pA0, pA1, alA, l_reg, pa0, pa1, pa2, pa3); SBAR();
    pv_tile(o, vb0, pa0, pa1, pa2, pa3); MASKT(pB0, pB1, NT - 1); partialSM(pB0, pB1, m_reg, alB);
    RESC(alB);
    finishSM(pB0, pB1, alB, l_reg, pa0, pa1, pa2, pa3); SBAR();
    pv_tile(o, vb0 + SHM_V, pa0, pa1, pa2, pa3);
    } else {
    f32x16 p0, p1; float al; bf16x8 pa0, pa1, pa2, pa3;
    SLOAD(0); VM_WAIT(); SWRITE(0); __syncthreads();
    for (int t = 0; t < NT; t += 2) {
        SBAR(); SLOAD((t + 1) * KVBLK); SBAR();
        qkt<PITCH, ND0>(p0, p1, K_lds, r32, hi, kch0, qr); MASKT(p0, p1, t); partialSM(p0, p1, m_reg, al); RESC(al);
        finishSM(p0, p1, al, l_reg, pa0, pa1, pa2, pa3); SBAR();
        pv_tile(o, vb0, pa0, pa1, pa2, pa3);
        VM_WAIT(); SWRITE(1); __syncthreads();
        SBAR(); if (t + 2 < NT) SLOAD((t + 2) * KVBLK); SBAR();
        qkt<PITCH, ND0>(p0, p1, K_lds + SHM_K, r32, hi, kch0, qr); MASKT(p0, p1, t + 1); partialSM(p0, p1, m_reg, al); RESC(al);
        finishSM(p0, p1, al, l_reg, pa0, pa1, pa2, pa3); SBAR();
        pv_tile(o, vb0 + SHM_V, pa0, pa1, pa2, pa3);
        if (t + 2 < NT) { VM_WAIT(); SWRITE(0); } __syncthreads();
    }
    }
#undef SLOAD
#undef SWRITE
#undef RESC
#undef MASKT
}

template <bool NEGM = true>
__device__ __forceinline__ void partialSM_rel(f32x16& p0, f32x16& p1, float& m_reg, f32x16& negm, float& alpha, bool first) {
    float pmax = p0[0];
#pragma unroll
    for (int r = 1; r < 16; ++r) pmax = fmaxf(pmax, p0[r]);
#pragma unroll
    for (int r = 0; r < 16; ++r) pmax = fmaxf(pmax, p1[r]);
    { auto rr = __builtin_amdgcn_permlane32_swap(__float_as_uint(pmax), __float_as_uint(pmax), false, false); pmax = fmaxf(__uint_as_float(rr[0]), __uint_as_float(rr[1])); }
    if (__builtin_expect(!first && __all(pmax <= THRL), 1)) { alpha = 1.f; }
    else { const float dl = first ? pmax : fmaxf(pmax, 0.f); alpha = first ? 1.f : __builtin_amdgcn_exp2f(-dl); m_reg += dl;
#pragma unroll
        for (int r = 0; r < 16; ++r) { p0[r] -= dl; p1[r] -= dl; }
        if constexpr (NEGM) {
#pragma unroll
            for (int r = 0; r < 16; ++r) negm[r] = -m_reg; } }
#pragma unroll
    for (int r = 0; r < 16; ++r) p0[r] = __builtin_amdgcn_exp2f(p0[r]);
}
template <int PITCH, int ND0>
__device__ __forceinline__ void qkt_rel(f32x16& p0, f32x16& p1, const char* Kb, int r32, int hi, int kch0, const bf16x8* qr, const f32x16& negm) {
    const char* kb[4];
#pragma unroll
    for (int dd = 0; dd < 4; ++dd) kb[dd] = Kb + kswz<PITCH>(r32, (kch0 + dd * 2 + hi) * 16);
#pragma unroll
    for (int d0 = 0; d0 < ND0; ++d0) { const char* a = (PITCH % 256 == 0) ? Kb + kswz<PITCH>(r32, (kch0 + d0 * 2 + hi) * 16) : kb[d0 & 3] + (d0 >> 2) * 128;
        const bf16x8 b0 = *reinterpret_cast<const bf16x8*>(a);
        const bf16x8 b1 = *reinterpret_cast<const bf16x8*>(a + 32 * PITCH);
        p0 = __builtin_amdgcn_mfma_f32_32x32x16_bf16(b0, qr[d0], d0 == 0 ? negm : p0, 0, 0, 0);
        p1 = __builtin_amdgcn_mfma_f32_32x32x16_bf16(b1, qr[d0], d0 == 0 ? negm : p1, 0, 0, 0); }
}

template <int PITCH, int ND0, int PF>
__device__ __forceinline__ void qkt_rel_pf(f32x16& p0, f32x16& p1, const char* Kb, int r32, int hi, int kch0, const bf16x8* qr, const f32x16& negm_) {
    static_assert(PITCH % 256 == 128 || ND0 <= 4, "the +128 B immediate offsets need the 3-bit swizzle");
    f32x16 negm = negm_;
    int kb[4];
#pragma unroll
    for (int dd = 0; dd < 4; ++dd) kb[dd] = (int)(uintptr_t)Kb + kswz<PITCH>(r32, (kch0 + dd * 2 + hi) * 16);
    bf16x8 f[PF + 1][2];
#define KRD(d) do { asm volatile("ds_read_b128 %0, %1 offset:%2" : "=v"(f[(d) % (PF + 1)][0]) : "v"(kb[(d) & 3]), "i"(((d) >> 2) * 128)); \
                    asm volatile("ds_read_b128 %0, %1 offset:%2" : "=v"(f[(d) % (PF + 1)][1]) : "v"(kb[(d) & 3]), "i"(((d) >> 2) * 128 + 32 * PITCH)); } while (0)
#pragma unroll
    for (int d = 0; d < PF && d < ND0; ++d) KRD(d);
#pragma unroll
    for (int d0 = 0; d0 < ND0; ++d0) {
        if (d0 + PF < ND0) KRD(d0 + PF);
        const int ahead = (d0 + PF < ND0 ? PF : ND0 - 1 - d0) * 2;
        if (ahead >= 4) asm volatile("s_waitcnt lgkmcnt(4)" : "+v"(f[d0 % (PF + 1)][0]), "+v"(f[d0 % (PF + 1)][1]));
        else if (ahead == 2) asm volatile("s_waitcnt lgkmcnt(2)" : "+v"(f[d0 % (PF + 1)][0]), "+v"(f[d0 % (PF + 1)][1]));
        else asm volatile("s_waitcnt lgkmcnt(0)" : "+v"(f[d0 % (PF + 1)][0]), "+v"(f[d0 % (PF + 1)][1]));
        p0 = __builtin_amdgcn_mfma_f32_32x32x16_bf16(f[d0 % (PF + 1)][0], qr[d0], d0 == 0 ? negm : p0, 0, 0, 0);
        p1 = __builtin_amdgcn_mfma_f32_32x32x16_bf16(f[d0 % (PF + 1)][1], qr[d0], d0 == 0 ? negm : p1, 0, 0, 0);
    }
#undef KRD
}

template <int PITCH, int ND0>
__device__ __forceinline__ void pv_qk(f32x16* o, int vb0, bf16x8 pa0, bf16x8 pa1, bf16x8 pa2, bf16x8 pa3,
                                      f32x16& p0, f32x16& p1, const char* Kb, int r32, int hi, int kch0, const bf16x8* qr, const f32x16& negm_) {
    constexpr int PF = 2;
    static_assert(PITCH % 256 == 128 || ND0 <= 4, "the +128 B immediate offsets need the 3-bit swizzle");
    f32x16 negm = negm_;
    s16x4 va[8], vb[8];
    int kb[4];
#pragma unroll
    for (int dd = 0; dd < 4; ++dd) kb[dd] = (int)(uintptr_t)Kb + kswz<PITCH>(r32, (kch0 + dd * 2 + hi) * 16);
    bf16x8 f[PF + 1][2];
#define TRRD(dst, off) asm volatile("ds_read_b64_tr_b16 %0, %1 offset:%2" : "=&v"(dst) : "v"(vb0), "i"(off) : "memory")
#define PV_RD(v, d0) do { constexpr int b_ = v_rd_off(d0, 0, 0); TRRD(v[0], b_); TRRD(v[1], b_ + 2048); TRRD(v[2], b_ + 4096); TRRD(v[3], b_ + 6144); TRRD(v[4], b_ + 8192); TRRD(v[5], b_ + 10240); TRRD(v[6], b_ + 12288); TRRD(v[7], b_ + 14336); } while (0)
#define PV_MM(v, d0) do { \
        o[d0] = __builtin_amdgcn_mfma_f32_32x32x16_bf16(pa0, (bf16x8){v[0][0], v[0][1], v[0][2], v[0][3], v[1][0], v[1][1], v[1][2], v[1][3]}, o[d0], 0, 0, 0); \
        o[d0] = __builtin_amdgcn_mfma_f32_32x32x16_bf16(pa1, (bf16x8){v[2][0], v[2][1], v[2][2], v[2][3], v[3][0], v[3][1], v[3][2], v[3][3]}, o[d0], 0, 0, 0); \
        o[d0] = __builtin_amdgcn_mfma_f32_32x32x16_bf16(pa2, (bf16x8){v[4][0], v[4][1], v[4][2], v[4][3], v[5][0], v[5][1], v[5][2], v[5][3]}, o[d0], 0, 0, 0); \
        o[d0] = __builtin_amdgcn_mfma_f32_32x32x16_bf16(pa3, (bf16x8){v[6][0], v[6][1], v[6][2], v[6][3], v[7][0], v[7][1], v[7][2], v[7][3]}, o[d0], 0, 0, 0); } while (0)
#define PV_WN(v, n) asm volatile("s_waitcnt lgkmcnt(%8)" : "+v"(v[0]), "+v"(v[1]), "+v"(v[2]), "+v"(v[3]), "+v"(v[4]), "+v"(v[5]), "+v"(v[6]), "+v"(v[7]) : "n"(n) : "memory")
#define KRD(d) do { asm volatile("ds_read_b128 %0, %1 offset:%2" : "=v"(f[(d) % (PF + 1)][0]) : "v"(kb[(d) & 3]), "i"(((d) >> 2) * 128) : "memory"); \
                    asm volatile("ds_read_b128 %0, %1 offset:%2" : "=v"(f[(d) % (PF + 1)][1]) : "v"(kb[(d) & 3]), "i"(((d) >> 2) * 128 + 32 * PITCH) : "memory"); } while (0)
#define PV_RDK(v, ks) do { TRRD(v[0], v_rd_off(0, ks, 0)); TRRD(v[1], v_rd_off(0, ks, 1)); TRRD(v[2], v_rd_off(1, ks, 0)); TRRD(v[3], v_rd_off(1, ks, 1)); \
                            TRRD(v[4], v_rd_off(2, ks, 0)); TRRD(v[5], v_rd_off(2, ks, 1)); TRRD(v[6], v_rd_off(3, ks, 0)); TRRD(v[7], v_rd_off(3, ks, 1)); } while (0)
#define PV_MMK(v, pa) do { \
        o[0] = __builtin_amdgcn_mfma_f32_32x32x16_bf16(pa, (bf16x8){v[0][0], v[0][1], v[0][2], v[0][3], v[1][0], v[1][1], v[1][2], v[1][3]}, o[0], 0, 0, 0); \
        o[1] = __builtin_amdgcn_mfma_f32_32x32x16_bf16(pa, (bf16x8){v[2][0], v[2][1], v[2][2], v[2][3], v[3][0], v[3][1], v[3][2], v[3][3]}, o[1], 0, 0, 0); \
        o[2] = __builtin_amdgcn_mfma_f32_32x32x16_bf16(pa, (bf16x8){v[4][0], v[4][1], v[4][2], v[4][3], v[5][0], v[5][1], v[5][2], v[5][3]}, o[2], 0, 0, 0); \
        o[3] = __builtin_amdgcn_mfma_f32_32x32x16_bf16(pa, (bf16x8){v[6][0], v[6][1], v[6][2], v[6][3], v[7][0], v[7][1], v[7][2], v[7][3]}, o[3], 0, 0, 0); } while (0)
    PV_RDK(va, 0); PV_RDK(vb, 1); PV_WN(va, 8); SBAR(); PV_MMK(va, pa0);
    PV_RDK(va, 2); PV_WN(vb, 8); SBAR(); PV_MMK(vb, pa1);
    PV_RDK(vb, 3); PV_WN(va, 8); SBAR(); PV_MMK(va, pa2);
    KRD(0); KRD(1);
    PV_WN(vb, 4); SBAR(); PV_MMK(vb, pa3);
#undef PV_MMK
#undef PV_RDK
    SBAR();
#pragma unroll
    for (int d0 = 0; d0 < ND0; ++d0) {
        if (d0 + PF < ND0) KRD(d0 + PF);
        const int ahead = (d0 + PF < ND0 ? PF : ND0 - 1 - d0) * 2;
        if (ahead >= 4) asm volatile("s_waitcnt lgkmcnt(4)" : "+v"(f[d0 % (PF + 1)][0]), "+v"(f[d0 % (PF + 1)][1]) :: "memory");
        else if (ahead == 2) asm volatile("s_waitcnt lgkmcnt(2)" : "+v"(f[d0 % (PF + 1)][0]), "+v"(f[d0 % (PF + 1)][1]) :: "memory");
        else asm volatile("s_waitcnt lgkmcnt(0)" : "+v"(f[d0 % (PF + 1)][0]), "+v"(f[d0 % (PF + 1)][1]) :: "memory");
        p0 = __builtin_amdgcn_mfma_f32_32x32x16_bf16(f[d0 % (PF + 1)][0], qr[d0], d0 == 0 ? negm : p0, 0, 0, 0);
        p1 = __builtin_amdgcn_mfma_f32_32x32x16_bf16(f[d0 % (PF + 1)][1], qr[d0], d0 == 0 ? negm : p1, 0, 0, 0);
    }
#undef KRD
#undef PV_WN
#undef PV_MM
#undef PV_RD
#undef TRRD
}

__device__ __forceinline__ void glds16(unsigned lds_addr, const void* sbase, unsigned voff) {
    unsigned keep;
    asm volatile("s_mov_b32 %0, m0\n\ts_mov_b32 m0, %1\n\ts_nop 0\n\tglobal_load_lds_dwordx4 %2, %3\n\ts_mov_b32 m0, %0" : "=&s"(keep) : "s"(lds_addr), "v"(voff), "s"(sbase) : "memory");
}
template <int KT, int ND0, bool CAUSAL>
__device__ __forceinline__ void attn_core_ring(const bf16_t* Qlane, const bf16_t* __restrict__ Kh, int ldk, const bf16_t* __restrict__ Vh, int ldv, int NT, int qpos, int qlo, int kch0,
                                               char* lds, f32x16 (&o)[4], float& l_reg) {
    constexpr int PITCH = KT * 2, SHM_K = KVBLK * PITCH, NKP = SHM_K / 8192, NVP = SHM_V / 8192;
    const int tid = opaque_tid(), wid = __builtin_amdgcn_readfirstlane(tid >> 6), lane = tid & 63, r32 = lane & 31, hi = lane >> 5;
    char* V_lds = lds; char* K_lds = lds + 3 * SHM_V;
    float* ws = (float*)(lds + 3 * SHM_V + 3 * SHM_K) + wid * 64; float* al_l = ws + 32;
    float m_reg = 0.f; l_reg = 0.f; f32x16 negm = f32x16{};
#pragma unroll
    for (int d = 0; d < 4; ++d) o[d] = f32x16{};
    bf16x8 qr[ND0];
#pragma unroll
    for (int d0 = 0; d0 < ND0; ++d0) qr[d0] = *reinterpret_cast<const bf16x8*>(Qlane + d0 * 16);
    const int vb0 = (int)(uintptr_t)V_lds + v_rd_base(lane);
    unsigned koff[NKP], voff[NVP];
#pragma unroll
    for (int i = 0; i < NKP; ++i) { const int a = (wid * NKP + i) * 1024 + lane * 16, row = a / PITCH, cpos = (a - row * PITCH) >> 4, f = kfl<PITCH>(row);
        const int chunk = cpos ^ f; koff[i] = (unsigned)(row * ldk * 2 + chunk * 16); }
#pragma unroll
    for (int i = 0; i < NVP; ++i) { const int a = (wid * NVP + i) * 1024 + lane * 16, sub = a >> 9, rem = a & 511, kk = (sub >> 2) * 8 + (rem >> 6), c = (sub & 3) * 32 + ((rem & 63) >> 1);
        const int k = kk; voff[i] = (unsigned)(k * ldv * 2 + c * 2); }
    const unsigned ldsK = (unsigned)(uintptr_t)K_lds + (unsigned)(wid * NKP) * 1024u, ldsV = (unsigned)(uintptr_t)V_lds + (unsigned)(wid * NVP) * 1024u;
#define DMA_TILE(t, slot) do { const char* kb_ = (const char*)Kh + (size_t)(t) * KVBLK * ldk * 2; const char* vb_ = (const char*)Vh + (size_t)(t) * KVBLK * ldv * 2; \
        _Pragma("unroll") for (int i_ = 0; i_ < NKP; ++i_) glds16(ldsK + (slot) * SHM_K + i_ * 1024, kb_, koff[i_]); \
        _Pragma("unroll") for (int i_ = 0; i_ < NVP; ++i_) glds16(ldsV + (slot) * SHM_V + i_ * 1024, vb_, voff[i_]); } while (0)
#define RING_SYNC(more) do { if (more) asm volatile("s_waitcnt vmcnt(%0)" :: "n"(NKP + NVP) : "memory"); else asm volatile("s_waitcnt vmcnt(0)" ::: "memory"); \
        asm volatile("s_waitcnt lgkmcnt(0)" ::: "memory"); __builtin_amdgcn_s_barrier(); asm volatile("" ::: "memory"); } while (0)
#define RESC(a) do { if (__any((a) < 1.f)) { if (hi == 0) al_l[r32] = (a); asm volatile("s_waitcnt lgkmcnt(0)" ::: "memory"); \
        _Pragma("unroll") for (int d_ = 0; d_ < 4; ++d_) _Pragma("unroll") for (int r = 0; r < 16; ++r) o[d_][r] *= al_l[crow(r, hi)]; } } while (0)
#define MASKT(P0_, P1_, t) do { if (CAUSAL) { const int kb_ = (t) * KVBLK; if (kb_ + KVBLK - 1 > qlo) mask_tile(P0_, P1_, qpos - kb_ - 4 * hi); } } while (0)
    f32x16 p0, p1; float al; bf16x8 pa0, pa1, pa2, pa3;
    asm volatile("s_waitcnt vmcnt(0)" ::: "memory");
#pragma unroll
    for (int d0 = 0; d0 < ND0; ++d0) asm volatile("" : "+v"(qr[d0]));
    DMA_TILE(0, 0); if (NT > 1) DMA_TILE(1, 1);
    RING_SYNC(NT > 1);
    int slot = 0;
    for (int t = 0; t < NT; ++t) {
        const int s2 = slot == 0 ? 2 : slot - 1;
        SBAR(); if (t + 2 < NT) DMA_TILE(t + 2, s2); SBAR();
        qkt_rel_pf<PITCH, ND0, 2>(p0, p1, K_lds + slot * SHM_K, r32, hi, kch0, qr, negm); MASKT(p0, p1, t); partialSM_rel(p0, p1, m_reg, negm, al, t == 0); RESC(al);
        finishSM(p0, p1, al, l_reg, pa0, pa1, pa2, pa3); SBAR();
        pv_tile(o, vb0 + slot * SHM_V, pa0, pa1, pa2, pa3);
        RING_SYNC(t + 2 < NT);
        slot = slot == 2 ? 0 : slot + 1;
    }
#undef DMA_TILE
#undef RING_SYNC
#undef RESC
#undef MASKT
}
template <int KT, int ND0, bool CAUSAL, bool NEGM>
__device__ __forceinline__ void attn_core_pp(const bf16_t* Qlane, const bf16_t* __restrict__ Kh, int ldk, const bf16_t* __restrict__ Vh, int ldv, int NT, int qpos, int qlo, int kch0,
                                             char* lds, f32x16 (&o)[4], float& l_reg) {
    constexpr int PITCH = KT * 2, SHM_K = KVBLK * PITCH, NKP = SHM_K / 8192, NVP = SHM_V / 8192;
    const int tid = opaque_tid(), wid = __builtin_amdgcn_readfirstlane(tid >> 6), lane = tid & 63, r32 = lane & 31, hi = lane >> 5;
    const bool grpB = wid >= 4;
    char* V_lds = lds; char* K_lds = lds + 3 * SHM_V;
    float* ws = (float*)(lds + 3 * SHM_V + 3 * SHM_K) + wid * 64; float* al_l = ws + 32;
    float m_reg = 0.f; l_reg = 0.f; f32x16 negm = f32x16{};
#pragma unroll
    for (int d = 0; d < 4; ++d) o[d] = f32x16{};
    bf16x8 qr[ND0];
#pragma unroll
    for (int d0 = 0; d0 < ND0; ++d0) qr[d0] = *reinterpret_cast<const bf16x8*>(Qlane + d0 * 16);
    const int vb0 = (int)(uintptr_t)V_lds + v_rd_base(lane);
    unsigned koff[NKP], voff[NVP];
#pragma unroll
    for (int i = 0; i < NKP; ++i) { const int a = (wid * NKP + i) * 1024 + lane * 16, row = a / PITCH, cpos = (a - row * PITCH) >> 4, f = kfl<PITCH>(row);
        const int chunk = cpos ^ f; koff[i] = (unsigned)(row * ldk * 2 + chunk * 16); }
#pragma unroll
    for (int i = 0; i < NVP; ++i) { const int a = (wid * NVP + i) * 1024 + lane * 16, sub = a >> 9, rem = a & 511, kk = (sub >> 2) * 8 + (rem >> 6), c = (sub & 3) * 32 + ((rem & 63) >> 1);
        const int k = kk; voff[i] = (unsigned)(k * ldv * 2 + c * 2); }
    const unsigned ldsK = (unsigned)(uintptr_t)K_lds + (unsigned)(wid * NKP) * 1024u, ldsV = (unsigned)(uintptr_t)V_lds + (unsigned)(wid * NVP) * 1024u;
#define DMA_K(t, slot) do { const char* kb_ = (const char*)Kh + (size_t)(t) * KVBLK * ldk * 2; _Pragma("unroll") for (int i_ = 0; i_ < NKP; ++i_) glds16(ldsK + (slot) * SHM_K + i_ * 1024, kb_, koff[i_]); } while (0)
#define DMA_V(t, slot) do { const char* vb_ = (const char*)Vh + (size_t)(t) * KVBLK * ldv * 2; _Pragma("unroll") for (int i_ = 0; i_ < NVP; ++i_) glds16(ldsV + (slot) * SHM_V + i_ * 1024, vb_, voff[i_]); } while (0)
#define ISSUE(u, ksl, vsl) do { if ((u) < NT) DMA_K(u, ksl); if ((u) - 1 < NT) DMA_V((u) - 1, vsl); } while (0)
#define PAIR_WAIT(t) do { if ((t) + 2 < NT) asm volatile("s_waitcnt vmcnt(%0)" :: "n"(NKP + NVP) : "memory"); else if ((t) + 2 == NT) asm volatile("s_waitcnt vmcnt(%0)" :: "n"(NVP) : "memory"); \
        else asm volatile("s_waitcnt vmcnt(0)" ::: "memory"); } while (0)
#define BAR() do { SBAR(); asm volatile("s_waitcnt lgkmcnt(0)" ::: "memory"); __builtin_amdgcn_s_barrier(); asm volatile("" ::: "memory"); SBAR(); } while (0)
#define RESC(a) do { if (__any((a) < 1.f)) { if (hi == 0) al_l[r32] = (a); asm volatile("s_waitcnt lgkmcnt(0)" ::: "memory"); \
        _Pragma("unroll") for (int d_ = 0; d_ < 4; ++d_) _Pragma("unroll") for (int r = 0; r < 16; ++r) o[d_][r] *= al_l[crow(r, hi)]; } } while (0)
#define MASKT(P0_, P1_, t) do { if (CAUSAL) { const int kb_ = (t) * KVBLK; if (kb_ + KVBLK - 1 > qlo) mask_tile(P0_, P1_, qpos - kb_ - 4 * hi); } } while (0)
    f32x16 p0, p1; float al; bf16x8 pa0, pa1, pa2, pa3;
    asm volatile("s_waitcnt vmcnt(0)" ::: "memory");
#pragma unroll
    for (int d0 = 0; d0 < ND0; ++d0) asm volatile("" : "+v"(qr[d0]));
    DMA_K(0, 0);
    if (NT > 1) DMA_K(1, 1);
    DMA_V(0, 0);
    if (NT > 1) asm volatile("s_waitcnt vmcnt(%0)" :: "n"(NKP + NVP) : "memory"); else asm volatile("s_waitcnt vmcnt(%0)" :: "n"(NVP) : "memory");
    BAR();
    if (grpB) { ISSUE(2, 2, 1); BAR(); }
#define QK_(ksl) do { if constexpr (NEGM) qkt_rel_pf<PITCH, ND0, 2>(p0, p1, K_lds + (ksl) * SHM_K, r32, hi, kch0, qr, negm); \
        else { f32x16 c_; const float nm_ = -m_reg; _Pragma("unroll") for (int r = 0; r < 16; ++r) c_[r] = nm_; qkt_rel_pf<PITCH, ND0, 2>(p0, p1, K_lds + (ksl) * SHM_K, r32, hi, kch0, qr, c_); } } while (0)
#define Y_(t_, first_) do { MASKT(p0, p1, t_); partialSM_rel<NEGM>(p0, p1, m_reg, negm, al, first_); RESC(al); finishSM(p0, p1, al, l_reg, pa0, pa1, pa2, pa3); } while (0)
    QK_(0);
    if (grpB) PAIR_WAIT(0);
    BAR();
    if (grpB) ISSUE(3, 0, 2); else ISSUE(2, 2, 1);
    SBAR();
    Y_(0, true);
    if (!grpB) PAIR_WAIT(0);
    BAR();
    int ks = 1;
    for (int t = 1; t < NT; ++t) {
        const int kp = ks == 0 ? 2 : ks - 1, kn = ks == 2 ? 0 : ks + 1;
        if constexpr (NEGM) pv_qk<PITCH, ND0>(o, vb0 + kp * SHM_V, pa0, pa1, pa2, pa3, p0, p1, K_lds + ks * SHM_K, r32, hi, kch0, qr, negm);
        else { f32x16 c_; const float nm_ = -m_reg; _Pragma("unroll") for (int r = 0; r < 16; ++r) c_[r] = nm_; pv_qk<PITCH, ND0>(o, vb0 + kp * SHM_V, pa0, pa1, pa2, pa3, p0, p1, K_lds + ks * SHM_K, r32, hi, kch0, qr, c_); }
#ifdef PROBE_XMFMA
        if constexpr (ND0 == 4) { f32x16 dz_ = f32x16{}; _Pragma("unroll") for (int i_ = 0; i_ < PROBE_XMFMA; ++i_) asm volatile("v_mfma_f32_32x32x16_bf16 %0, %1, %2, %0" : "+v"(dz_) : "v"(qr[0]), "v"(qr[1])); asm volatile("s_nop 15\n\ts_nop 15" :: "v"(dz_)); }
#endif
        if (grpB) PAIR_WAIT(t);
        BAR();
        if (grpB) ISSUE(t + 3, ks, kp); else ISSUE(t + 2, kp, kn);
        SBAR();
        Y_(t, false);
#ifdef PROBE_YEXP
        if constexpr (ND0 == 4) { float dm_ = al; _Pragma("unroll") for (int i_ = 0; i_ < PROBE_YEXP; ++i_) asm volatile("v_exp_f32 %0, %1" : "=v"(dm_) : "v"(al)); asm volatile("" :: "v"(dm_)); }
#endif

        if (!grpB) PAIR_WAIT(t);
        BAR();
        ks = kn;
    }
    pv_tile(o, vb0 + (ks == 0 ? 2 : ks - 1) * SHM_V, pa0, pa1, pa2, pa3);
    BAR();
#undef QK_
#undef Y_
    if (!grpB) BAR();
#undef DMA_K
#undef DMA_V
#undef ISSUE
#undef PAIR_WAIT
#undef BAR
#undef RESC
#undef MASKT
}
__device__ __forceinline__ void normalize_o(f32x16 (&o)[4], float l_reg, float* ws, int r32, int hi) {
    if (hi == 0) ws[r32] = l_reg; asm volatile("s_waitcnt lgkmcnt(0)" ::: "memory");
#pragma unroll
    for (int r = 0; r < 16; ++r) { const float rl = __builtin_amdgcn_rcpf(ws[crow(r, hi)]);
#pragma unroll
        for (int d0 = 0; d0 < 4; ++d0) o[d0][r] *= rl; }
}
__device__ __forceinline__ void store_o_bf16(const f32x16 (&o)[4], bf16_t* Ow, int ldo, int r32, int hi) {
#pragma unroll
    for (int r = 0; r < 16; ++r) { const int orow = crow(r, hi);
#pragma unroll
        for (int d0 = 0; d0 < 4; ++d0) { const float v = o[d0][r]; const float vn = shflx(v, 1, hi * 32 + r32);
            if ((r32 & 1) == 0) *(unsigned*)(Ow + (size_t)orow * ldo + d0 * 32 + r32) = cvt_pk_bf16(v, vn); } }
}
}

constexpr size_t MiB = 1u << 20;
constexpr size_t WS_CTL = 0, CTL_ZERO_BYTES = 4 * MiB;
constexpr size_t WS_SSQ = 1 * MiB;
constexpr size_t WS_W = 4 * MiB, LW_BYTES = 269 * MiB / 2;
constexpr size_t LW_IN = 0, LW_QUP = 44 * MiB, LW_KVUP = LW_QUP + 3 * MiB / 2, LW_GLU = LW_KVUP + 1 * MiB, LW_BR = LW_GLU + 4 * MiB, LW_OUT = LW_BR + 12 * MiB,
                 LW_XQ = LW_OUT + 8 * MiB, LW_XKV = LW_XQ + 2 * MiB, LW_XO = LW_XKV + 4 * MiB, LW_TEXT = LW_XO + 2 * MiB, LW_WSL = LW_TEXT + 40 * MiB;
static_assert(LW_WSL + 16 * MiB == LW_BYTES, "layer weight block");
constexpr size_t WS_FFN = WS_W + 2 * LW_BYTES;
constexpr size_t WS_MOE = WS_FFN + 66 * MiB;
constexpr size_t WS_XS = WS_MOE + 8 * 66 * MiB + 1 * MiB;
static_assert(WS_XS == 868 * MiB, "map");
constexpr size_t WS_XN = WS_XS + 128 * MiB;
constexpr size_t WS_TABD = WS_XN + 64 * MiB, WS_TABM = WS_TABD + 1 * MiB, WS_XKV = WS_TABM + 4 * MiB, WS_MEMB = WS_XKV + 1 * MiB, WS_ROUTE = WS_MEMB + 1 * MiB, WS_ORDER = WS_ROUTE + 1 * MiB;
constexpr size_t WS_A32 = WS_ORDER + 64 * 1024;
constexpr size_t WS_PSQ = WS_ORDER + 1 * MiB;
constexpr size_t WS_MIX = WS_TABD + 12 * MiB;
static_assert(WS_MIX == 1072 * MiB, "map");
constexpr size_t WS_QD = WS_MIX, WS_KD = WS_QD + 32 * MiB, WS_VD = WS_KD + 32 * MiB, WS_MQ = WS_VD + 32 * MiB, WS_MKV = WS_MQ + 16 * MiB, WS_KM = WS_MKV + 8 * MiB, WS_VM = WS_KM + 48 * MiB,
                 WS_QM = WS_VM + 32 * MiB, WS_SU = WS_QM + 48 * MiB, WS_GATES = WS_SU + 40 * MiB, WS_SLOC = WS_GATES + 192 * MiB, WS_YG = WS_SLOC + 16 * MiB, WS_BR = WS_YG + 32 * MiB,
                 WS_TMP = WS_BR + 96 * MiB, WS_MG = WS_TMP + 128 * MiB, WS_XQ = WS_MG + 64 * MiB, WS_XO = WS_XQ + 16 * MiB, WS_XN8 = WS_XO + 16 * MiB  , WS_END = WS_XN8 + 32 * MiB;
static_assert(WS_END == 1952 * MiB, "map");
constexpr size_t WS_XG = WS_MIX, WS_HG = WS_XG + 136 * MiB, WS_OG = WS_HG + 374 * MiB;
static_assert(WS_OG + 272 * MiB <= WS_XQ, "ffn overlay");
constexpr int CW_TMO = 0, CW_DBG = 2, CW_BAR = 4096, CW_ATTQ = 16384, CW_MOECNT = 16640, CW_MOECUR = 16704;

#define XB_TMO      128
#define XB_XCNT(j)  (256  + 64 * (j))
#define XB_XSUB(j)  (1280 + 64 * (j))
#define XB_XGEN(j)  (2304 + 64 * (j))
#define XB_TOP      3328
#define XB_TOPGEN   3392
#define XCD_BAR_WORDS 3456
#define XB_SPIN_CAP (1u << 22)
__device__ __forceinline__ unsigned xb_ld(unsigned* p)              { return __hip_atomic_load(p, __ATOMIC_RELAXED, __HIP_MEMORY_SCOPE_AGENT); }
__device__ __forceinline__ unsigned xb_add(unsigned* p, unsigned v) { return __hip_atomic_fetch_add(p, v, __ATOMIC_RELAXED, __HIP_MEMORY_SCOPE_AGENT); }
__device__ __forceinline__ unsigned xb_xcc_id() { return (unsigned)__builtin_amdgcn_s_getreg((3 << 11) | 20) & 0xFu; }
#define XB_SPIN(cond, bar) do { unsigned _sp = 0; while (cond) { __builtin_amdgcn_s_sleep(1); \
    if ((++_sp & 255u) == 0u) { if (xb_ld(&(bar)[XB_TMO])) break; if (_sp > XB_SPIN_CAP) { atomicAdd(&(bar)[XB_TMO], 1u); break; } } } } while (0)
struct XcdBarrier { unsigned* bar; unsigned x; volatile LAS unsigned* st; };
__device__ __forceinline__ XcdBarrier xcd_barrier_post(unsigned* bar, volatile LAS unsigned* st) {
    XcdBarrier b; b.bar = bar; b.x = xb_xcc_id(); b.st = st;
    if (threadIdx.x == 0) (void)xb_add(&bar[XB_XCNT(b.x)], 1u);
    return b;
}
__device__ __forceinline__ void xcd_barrier_complete(unsigned* bar, unsigned x, unsigned& nloc, unsigned& nx) {
    const unsigned G = gridDim.x * gridDim.y * gridDim.z;
    unsigned sum, cnt, mine, sp = 0u;
    for (;;) {
        sum = 0u; cnt = 0u; mine = 0u;
#pragma nounroll
        for (unsigned j = 0; j < 16; ++j) { const unsigned c = xb_ld(&bar[XB_XCNT(j)]); sum += c; cnt += (c > 0u) ? 1u : 0u; mine = (j == x) ? c : mine; }
        if (sum == G) break;
        __builtin_amdgcn_s_sleep(1);
        if ((++sp & 255u) == 0u) { if (xb_ld(&bar[XB_TMO])) break; if (sp > XB_SPIN_CAP) { atomicAdd(&bar[XB_TMO], 1u); break; } }
    }
    nloc = mine > 0u ? mine : 1u; nx = cnt > 0u ? cnt : 1u;
}
__device__ __forceinline__ void xcd_barrier_setup(const XcdBarrier& b) {
    if (threadIdx.x == 0) { unsigned nloc, nx; xcd_barrier_complete(b.bar, b.x, nloc, nx); b.st[0] = nloc; b.st[1] = nx; }
    __syncthreads();
}
__device__ __forceinline__ void xcd_barrier(const XcdBarrier& b) {
    asm volatile("s_waitcnt vmcnt(0)" ::: "memory");
    __syncthreads();
    if (opaque_tid() == 0) {
        unsigned* bar = b.bar;
        __builtin_amdgcn_s_waitcnt(0);
        const unsigned nloc = b.st[0], nx = b.st[1];
        const unsigned old = xb_add(&bar[XB_XSUB(b.x)], 1u);
        const unsigned gen = old / nloc;
        if (old + 1u == (gen + 1u) * nloc) {
            __builtin_amdgcn_fence(__ATOMIC_RELEASE, "agent");
            asm volatile("s_waitcnt vmcnt(0)" ::: "memory");
            const unsigned og = xb_add(&bar[XB_TOP], 1u);
            const unsigned tg = og / nx;
            if (og + 1u == (tg + 1u) * nx) xb_add(&bar[XB_TOPGEN], 1u);
            else XB_SPIN(xb_ld(&bar[XB_TOPGEN]) == tg, bar);
            __builtin_amdgcn_fence(__ATOMIC_ACQUIRE, "agent");
            xb_add(&bar[XB_XGEN(b.x)], 1u);
            asm volatile("s_waitcnt vmcnt(0)" ::: "memory");
        } else {
            XB_SPIN(xb_ld(&bar[XB_XGEN(b.x)]) == gen, bar);
            __builtin_amdgcn_fence(__ATOMIC_ACQUIRE, "agent");
            asm volatile("s_waitcnt vmcnt(0)" ::: "memory");
        }
    }
    __syncthreads();
}

struct Args { const void* in[35]; float* out; unsigned char* ws; int ph_lo, ph_hi; };
struct PTab { volatile LAS unsigned long long* t; __device__ __forceinline__ const void* operator[](int i) const { const unsigned long long v = t[i];
    const unsigned lo_ = __builtin_amdgcn_readfirstlane((unsigned)v), hi_ = __builtin_amdgcn_readfirstlane((unsigned)(v >> 32)); return (const void*)(GAS const char*)(((unsigned long long)hi_ << 32) | lo_); } };
struct ArgsD { PTab in; unsigned char* ws; };
enum { I_X = 0, I_MEM, I_POS, I_WIN, I_WQUP, I_WKVUP, I_QNG, I_KVNG, I_DLAM, I_SUBLN, I_LRE, I_LIM, I_BRE, I_BIM, I_CRE, I_CIM, I_SSMD, I_LOGDT, I_GLUW, I_WBR, I_WOUT, I_LNMG, I_LNMB,
       I_WXQ, I_WXKV, I_WXO, I_LNXG, I_LNXB, I_FGU, I_FDN, I_ROUTER, I_MGU, I_MDN, I_LNFG, I_LNFB };
constexpr int NPL = 16, NPHASE = 1 + DEPTH * NPL;
constexpr int LDS_BYTES = 147456;
constexpr int LDS_MISC = 131072 + 8192;

__device__ __forceinline__ float lam_init_of(int l) { return l == 0 ? 0.2f : 0.35550906759f; }

struct Mat { const float* src; bf16_t* dst; int K, N, kind; const float* ksc; int kmod; float kmul; int fp8; };
__device__ __forceinline__ int map_row(int kind, int n, int N) {
    if (kind == 0) return n;
    if (kind == 1) {
        if (n < 2048) { const int hc = n & 63; if (hc < 16) return (n - hc) + (hc < 8 ? 2 * hc : 2 * (hc - 8) + 1); return n; }
        if (n < 3840) return n;
        if (n < 3904) { const int hc = n - 3840; return 3840 + (hc < 32 ? 2 * hc : 2 * (hc - 32) + 1); }
        return n + 192;
    }
    if (kind == 2) { const int h = n / 192; int hc = n - h * 192; if (hc >= 128) { const int r = hc - 128; hc = 128 + (r < 32 ? 2 * r : 2 * (r - 32) + 1); } return h * 192 + hc; }
    const int half = N >> 1;
    if (n < half) return (n >> 7) * 256 + (n & 127);
    const int mm = n - half; return (mm >> 7) * 256 + 128 + (mm & 127);
}
__device__ __forceinline__ Mat get_mat(const ArgsD& a, int id) {
    Mat m; m.ksc = nullptr; m.kmod = 1; m.kmul = 1.f; m.kind = 0; m.fp8 = 0;
    unsigned char* ws = a.ws;
    if (id < 22) { const int l = id / 11, k = id % 11; unsigned char* lw = ws + WS_W + (size_t)l * LW_BYTES;
        switch (k) {
        case 0: m.src = (const float*)a.in[I_WIN] + (size_t)l * D * NIN_SRC; m.dst = (bf16_t*)(lw + LW_IN); m.K = D; m.N = NIN_SRC; m.kind = 1; break;
        case 1: m.src = (const float*)a.in[I_WQUP] + (size_t)l * 512 * 1536; m.dst = (bf16_t*)(lw + LW_QUP); m.K = 512; m.N = 1536; m.kind = 2; m.ksc = (const float*)a.in[I_QNG] + l * 512; m.kmod = 512; break;
        case 2: m.src = (const float*)a.in[I_WKVUP] + (size_t)l * 256 * 2048; m.dst = (bf16_t*)(lw + LW_KVUP); m.K = 256; m.N = 2048; m.ksc = (const float*)a.in[I_KVNG] + l * 256; m.kmod = 256; break;
        case 3: m.src = (const float*)a.in[I_GLUW] + (size_t)l * 1024 * 2048; m.dst = (bf16_t*)(lw + LW_GLU); m.K = 1024; m.N = 2048; m.kind = 3; break;
        case 4: m.src = (const float*)a.in[I_WBR] + (size_t)(l * 3 + 0) * 1024 * 2048; m.dst = (bf16_t*)(lw + LW_BR); m.K = 1024; m.N = 2048; m.ksc = (const float*)a.in[I_SUBLN] + l * 128; m.kmod = 128; m.kmul = 1.f - lam_init_of(l); break;
        case 5: m.src = (const float*)a.in[I_WBR] + (size_t)(l * 3 + 1) * 1024 * 2048; m.dst = (bf16_t*)(lw + LW_BR + 4 * MiB); m.K = 1024; m.N = 2048; break;
        case 6: m.src = (const float*)a.in[I_WBR] + (size_t)(l * 3 + 2) * 1024 * 2048; m.dst = (bf16_t*)(lw + LW_BR + 8 * MiB); m.K = 1024; m.N = 2048; break;
        case 7: m.src = (const float*)a.in[I_WOUT] + (size_t)l * 2048 * 2048; m.dst = (bf16_t*)(lw + LW_OUT); m.K = 2048; m.N = 2048; break;
        case 8: m.src = (const float*)a.in[I_WXQ] + (size_t)l * 2048 * 512; m.dst = (bf16_t*)(lw + LW_XQ); m.K = 2048; m.N = 512; break;
        case 9: m.src = (const float*)a.in[I_WXKV] + (size_t)l * 2048 * 1024; m.dst = (bf16_t*)(lw + LW_XKV); m.K = 2048; m.N = 1024; break;
        default: m.src = (const float*)a.in[I_WXO] + (size_t)l * 512 * 2048; m.dst = (bf16_t*)(lw + LW_XO); m.K = 512; m.N = 2048; break;
        }
    } else if (id == 22) { m.src = (const float*)a.in[I_FGU]; m.dst = (bf16_t*)(ws + WS_FFN); m.K = D; m.N = 2 * DFF; m.kind = 3; }
    else if (id == 23) { m.src = (const float*)a.in[I_FDN]; m.dst = (bf16_t*)(ws + WS_FFN + 44 * MiB); m.K = DFF; m.N = D; }
    else { const int e = (id - 24) >> 1;
        m.fp8 = 1;
        if (((id - 24) & 1) == 0) { m.src = (const float*)a.in[I_MGU] + (size_t)e * D * 2 * DFF; m.dst = (bf16_t*)(ws + WS_MOE + (size_t)e * 66 * MiB); m.K = D; m.N = 2 * DFF; m.kind = 3; m.kmul = 64.f; }
        else { m.src = (const float*)a.in[I_MDN] + (size_t)e * DFF * D; m.dst = (bf16_t*)(ws + WS_MOE + (size_t)e * 66 * MiB + 44 * MiB); m.K = DFF; m.N = D; m.kmul = 256.f; }
    }
    return m;
}
constexpr int NMAT = 40;
__device__ __forceinline__ void cvt_item(const Mat& mt, LAS float* scr, int item, int lane) {
    const int nblk = mt.N / 64, kb = item / nblk, nb = item - kb * nblk, k0 = 64 * kb, n0 = 64 * nb;
    const bool g8 = mt.kind == 1 && n0 >= 3072;
    const bool f8 = mt.fp8 || g8; const float kmul = g8 ? 64.f : mt.kmul;
    const int lr = lane >> 4, lc = (lane & 15) * 4;
    f32x4 v[16];
#pragma unroll
    for (int i = 0; i < 16; ++i) v[i] = *(const f32x4*)(mt.src + (size_t)(k0 + 4 * i + lr) * mt.N + n0 + lc);
    if (mt.ksc) {
#pragma unroll
        for (int i = 0; i < 16; ++i) v[i] = v[i] * (mt.ksc[(k0 + 4 * i + lr) % mt.kmod] * mt.kmul); }
    else if (f8) {
#pragma unroll
        for (int i = 0; i < 16; ++i) v[i] = v[i] * kmul; }
#pragma unroll
    for (int i = 0; i < 16; ++i) { LAS float* p = scr + (4 * i + lr) * 65 + lc; p[0] = v[i][0]; p[1] = v[i][1]; p[2] = v[i][2]; p[3] = v[i][3]; }
    LDS_WAIT(); asm volatile("" ::: "memory");
    const int c = lane & 7;
#pragma unroll
    for (int j = 0; j < 8; ++j) { const int n = (lane >> 3) + 8 * j; const LAS float* s = scr + (8 * c) * 65 + n;
        if (f8) { const u32x2 o = pack8_fp8((f32x4){s[0 * 65], s[1 * 65], s[2 * 65], s[3 * 65]}, (f32x4){s[4 * 65], s[5 * 65], s[6 * 65], s[7 * 65]}); const int r_ = map_row(mt.kind, n0 + n, mt.N);
            unsigned char* d8 = g8 ? (unsigned char*)mt.dst + (size_t)NIN_BF * mt.K * 2 + (size_t)(r_ - NIN_BF) * mt.K : (unsigned char*)mt.dst + (size_t)r_ * mt.K;
            *(u32x2*)(d8 + k0 + 8 * c) = o; }
        else { u32x4 o; o.x = cvt_pk_bf16(s[0 * 65], s[1 * 65]); o.y = cvt_pk_bf16(s[2 * 65], s[3 * 65]); o.z = cvt_pk_bf16(s[4 * 65], s[5 * 65]); o.w = cvt_pk_bf16(s[6 * 65], s[7 * 65]);
            *(u32x4*)(mt.dst + (size_t)map_row(mt.kind, n0 + n, mt.N) * mt.K + k0 + 8 * c) = o; } }
    LDS_WAIT(); asm volatile("" ::: "memory");
}
__device__ __forceinline__ void cvt_tile_wg(const Mat& mt, LAS float* scr, int tile, int tid) {
    const int nblk = mt.N / 256, kb = tile / nblk, nb = tile - kb * nblk, k0 = 64 * kb, n0 = 256 * nb;
    const int lane = tid & 63, w = tid >> 6;
    f32x4 v[8];
#pragma unroll
    for (int i = 0; i < 8; ++i) v[i] = *(const f32x4*)(mt.src + (size_t)(k0 + 8 * w + i) * mt.N + n0 + lane * 4);
    if (mt.ksc) {
#pragma unroll
        for (int i = 0; i < 8; ++i) v[i] = v[i] * (mt.ksc[(k0 + 8 * w + i) % mt.kmod] * mt.kmul); }
    else if (mt.fp8) {
#pragma unroll
        for (int i = 0; i < 8; ++i) v[i] = v[i] * mt.kmul; }
#pragma unroll
    for (int i = 0; i < 8; ++i) { LAS float* p = scr + (8 * w + i) * 257 + lane * 4; p[0] = v[i][0]; p[1] = v[i][1]; p[2] = v[i][2]; p[3] = v[i][3]; }
    __syncthreads();
    const int c = tid & 7;
#pragma unroll
    for (int j = 0; j < 4; ++j) { const int n = (tid >> 3) + 64 * j; const LAS float* s = scr + (8 * c) * 257 + n; const int r_ = map_row(mt.kind, n0 + n, mt.N);
        if (mt.fp8) *(u32x2*)((unsigned char*)mt.dst + (size_t)r_ * mt.K + k0 + 8 * c) = pack8_fp8((f32x4){s[0 * 257], s[1 * 257], s[2 * 257], s[3 * 257]}, (f32x4){s[4 * 257], s[5 * 257], s[6 * 257], s[7 * 257]});
        else { u32x4 o; o.x = cvt_pk_bf16(s[0 * 257], s[1 * 257]); o.y = cvt_pk_bf16(s[2 * 257], s[3 * 257]); o.z = cvt_pk_bf16(s[4 * 257], s[5 * 257]); o.w = cvt_pk_bf16(s[6 * 257], s[7 * 257]);
            *(u32x4*)(mt.dst + (size_t)r_ * mt.K + k0 + 8 * c) = o; } }
    __syncthreads();
}
__device__ __forceinline__ void ssm_build(const ArgsD& a, int l, int g, int half, LAS unsigned char* lds) {
    LAS float* Ap = (LAS float*)lds;
    LAS float* Bb = Ap + 33 * 64 * 2;
    LAS float* Cc = Bb + 64 * 16 * 2;
    LAS float* Mk = Cc + 16 * 64 * 2;
    const int tid = opaque_tid();
    const float* lre = (const float*)a.in[I_LRE] + (l * 64 + g) * 64; const float* lim = (const float*)a.in[I_LIM] + (l * 64 + g) * 64;
    const float* bre = (const float*)a.in[I_BRE] + (size_t)(l * 64 + g) * 1024; const float* bim = (const float*)a.in[I_BIM] + (size_t)(l * 64 + g) * 1024;
    const float* cre = (const float*)a.in[I_CRE] + (size_t)(l * 64 + g) * 1024; const float* cim = (const float*)a.in[I_CIM] + (size_t)(l * 64 + g) * 1024;
    const double dt = exp((double)((const float*)a.in[I_LOGDT])[l * 64 + g]);
    for (int idx = tid; idx < 33 * 64; idx += 512) { const int n = idx & 63, k = idx >> 6; const double re = lre[n], im = lim[n];
        const double mag = exp(re * dt * k), ang = im * dt * k; Ap[idx * 2] = (float)(mag * cos(ang)); Ap[idx * 2 + 1] = (float)(mag * sin(ang)); }
    if (tid < 64) { float* a32 = (float*)(a.ws + WS_A32) + (size_t)((l * 64 + g) * 64 + tid) * 2; const double re = lre[tid], im = lim[tid]; const double mag = exp(32.0 * re * dt), ang = 32.0 * im * dt;
        a32[0] = (float)(mag * cos(ang)); a32[1] = (float)(mag * sin(ang)); }
    for (int idx = tid; idx < 1024; idx += 512) { const int n = idx >> 4; const double re = lre[n], im = lim[n]; const double mag = exp(re * dt), ang = im * dt;
        const double lr = mag * cos(ang) - 1.0, li = mag * sin(ang), den = re * re + im * im;
        const double fr_ = (lr * re + li * im) / den, fi_ = (li * re - lr * im) / den; const double br = bre[idx], bi = bim[idx];
        Bb[idx * 2] = (float)(fr_ * br - fi_ * bi); Bb[idx * 2 + 1] = (float)(fr_ * bi + fi_ * br);
        Cc[idx * 2] = cre[idx]; Cc[idx * 2 + 1] = cim[idx]; }
    __syncthreads();
    { const int k = tid >> 4, p = tid & 15; float acc[16];
#pragma unroll
        for (int q = 0; q < 16; ++q) acc[q] = 0.f;
        for (int n = 0; n < 64; ++n) { const float ar = Ap[(k * 64 + n) * 2], ai = Ap[(k * 64 + n) * 2 + 1], cr = Cc[(p * 64 + n) * 2], ci = Cc[(p * 64 + n) * 2 + 1];
            const float ur = cr * ar - ci * ai, ui = cr * ai + ci * ar; const LAS f32x4* bq = (const LAS f32x4*)(Bb + n * 32);
#pragma unroll
            for (int q4 = 0; q4 < 8; ++q4) { const f32x4 bv = bq[q4]; acc[2 * q4] += bv[0] * ur - bv[1] * ui; acc[2 * q4 + 1] += bv[2] * ur - bv[3] * ui; } }
#pragma unroll
        for (int q = 0; q < 16; ++q) Mk[tid * 16 + q] = acc[q]; }
    __syncthreads();
    unsigned char* lw = a.ws + WS_W + (size_t)l * LW_BYTES;
    bf16_t* T = (bf16_t*)(lw + LW_TEXT) + (size_t)g * 512 * SSM_KX; bf16_t* W = (bf16_t*)(lw + LW_WSL) + (size_t)g * 256 * 512;
    for (int it = 0; it < 40; ++it) { const int c = it * 512 + tid, Rl = c / 80, ch = c - Rl * 80, R = 256 * half + Rl, i = R >> 4, p = R & 15; u32x4 w = {0u, 0u, 0u, 0u};
        if (ch < 64) { const int j = ch >> 1, q0 = (ch & 1) * 8;
            if (j <= i) { const LAS float* mp = Mk + ((i - j) * 16 + p) * 16 + q0; w.x = cvt_pk_bf16(mp[0], mp[1]); w.y = cvt_pk_bf16(mp[2], mp[3]); w.z = cvt_pk_bf16(mp[4], mp[5]); w.w = cvt_pk_bf16(mp[6], mp[7]); } }
        else { const int cc = ch - 64; float v[8];
#pragma unroll
            for (int e = 0; e < 4; ++e) { const int n = cc * 4 + e; const float cr = Cc[(p * 64 + n) * 2], ci = Cc[(p * 64 + n) * 2 + 1], ar = Ap[((i + 1) * 64 + n) * 2], ai = Ap[((i + 1) * 64 + n) * 2 + 1];
                v[2 * e] = cr * ar - ci * ai; v[2 * e + 1] = -(cr * ai + ci * ar); }
            w.x = cvt_pk_bf16(v[0], v[1]); w.y = cvt_pk_bf16(v[2], v[3]); w.z = cvt_pk_bf16(v[4], v[5]); w.w = cvt_pk_bf16(v[6], v[7]); }
        *(u32x4*)(T + (size_t)R * SSM_KX + ch * 8) = w; }
    for (int it = 0; it < 16; ++it) { const int c = it * 512 + tid, R = 128 * half + (c >> 6), ch = c & 63; u32x4 w = {0u, 0u, 0u, 0u};
        if (R < 128) { const int n = R >> 1, im = R & 1, j = ch >> 1, q0 = (ch & 1) * 8; float v[8]; const float ar = Ap[((31 - j) * 64 + n) * 2], ai = Ap[((31 - j) * 64 + n) * 2 + 1];
#pragma unroll
            for (int e = 0; e < 8; ++e) { const float br = Bb[(n * 16 + q0 + e) * 2], bi = Bb[(n * 16 + q0 + e) * 2 + 1]; v[e] = im ? (ar * bi + ai * br) : (ar * br - ai * bi); }
            w.x = cvt_pk_bf16(v[0], v[1]); w.y = cvt_pk_bf16(v[2], v[3]); w.z = cvt_pk_bf16(v[4], v[5]); w.w = cvt_pk_bf16(v[6], v[7]); }
        *(u32x4*)(W + (size_t)R * 512 + ch * 8) = w; }
    __syncthreads();
}

struct LnArgs { bf16_t* X; float* outf; unsigned char* outq; const float* g; const float* b;
                const float* og; const int* slot; int* r_e; float* r_w; unsigned* cnt; };
template <int MODE>
__device__ __forceinline__ void ln_phase(const LnArgs& A, LAS unsigned char* lds, int G) {
    const int tid = opaque_tid(), lane = tid & 63, wave = __builtin_amdgcn_readfirstlane(tid >> 6);
    const int gw = blockIdx.x * 8 + wave, NGW = G * 8;
    f32x4 gv[8], bv[8];
    if (MODE != 1) {
#pragma unroll
        for (int j = 0; j < 8; ++j) { gv[j] = *(const f32x4*)(A.g + lane * 8 + 512 * (j >> 1) + 4 * (j & 1)); bv[j] = *(const f32x4*)(A.b + lane * 8 + 512 * (j >> 1) + 4 * (j & 1)); } }
    for (int row = gw; row < M; row += NGW) {
        bf16_t* xr = A.X + (size_t)row * D + lane * 8;
        f32x4 v[8]; float s = 0.f;
#pragma unroll
        for (int j = 0; j < 4; ++j) { const u32x4 w = *(const u32x4*)(xr + 512 * j); v[2 * j] = (f32x4){bf_lo(w.x), bf_hi(w.x), bf_lo(w.y), bf_hi(w.y)}; v[2 * j + 1] = (f32x4){bf_lo(w.z), bf_hi(w.z), bf_lo(w.w), bf_hi(w.w)}; }
        if (MODE == 2) { const int s0 = A.slot[row * 2], s1 = A.slot[row * 2 + 1]; const float* o0 = A.og + (size_t)s0 * D + lane * 8; const float* o1 = A.og + (size_t)s1 * D + lane * 8;
#pragma unroll
            for (int j = 0; j < 8; ++j) { const int e = 512 * (j >> 1) + 4 * (j & 1); v[j] = v[j] * ALPHA + *(const f32x4*)(o0 + e) + *(const f32x4*)(o1 + e); } }
#pragma unroll
        for (int j = 0; j < 8; ++j) s += (v[j][0] + v[j][1]) + (v[j][2] + v[j][3]);
        const float mean = wave_sum(s, lane) * (1.f / D); float s2 = 0.f;
#pragma unroll
        for (int j = 0; j < 8; ++j) { v[j] = v[j] - mean; s2 += (v[j][0] * v[j][0] + v[j][1] * v[j][1]) + (v[j][2] * v[j][2] + v[j][3] * v[j][3]); }
        const float rstd = 1.f / sqrtf(wave_sum(s2, lane) * (1.f / D) + LN_EPS);
#pragma unroll
        for (int j = 0; j < 8; ++j) { if (MODE == 1) { gv[j] = *(const f32x4*)(A.g + lane * 8 + 512 * (j >> 1) + 4 * (j & 1)); bv[j] = *(const f32x4*)(A.b + lane * 8 + 512 * (j >> 1) + 4 * (j & 1)); }
            v[j] = v[j] * rstd * gv[j] + bv[j]; }
        if (A.outf) { float* of = A.outf + (size_t)row * D + lane * 8;
#pragma unroll
            for (int j = 0; j < 8; ++j) *(f32x4*)(of + 512 * (j >> 1) + 4 * (j & 1)) = v[j]; }
        else {
#pragma unroll
            for (int j = 0; j < 4; ++j) *(u32x4*)(xr + 512 * j) = pack8(v[2 * j], v[2 * j + 1]); }
        if (A.outq) { unsigned char* oq = A.outq + (size_t)row * D + lane * 8;
#pragma unroll
            for (int j = 0; j < 4; ++j) *(u32x2*)(oq + 512 * j) = pack8_fp8(v[2 * j], v[2 * j + 1]); }
        if (MODE == 1) {
            const LAS float* wr_ = (const LAS float*)lds;
            int i0 = 0, i1 = 0; float v0 = -__builtin_inff(), v1 = -__builtin_inff();
#pragma unroll 1
            for (int e = 0; e < 8; ++e) { float acc = 0.f;
#pragma unroll
                for (int j = 0; j < 8; ++j) { const f32x4 w = *(const LAS f32x4*)(wr_ + e * D + lane * 8 + 512 * (j >> 1) + 4 * (j & 1)); acc += (v[j][0] * w[0] + v[j][1] * w[1]) + (v[j][2] * w[2] + v[j][3] * w[3]); }
                const float sg = wave_sum(acc, lane);
                if (sg > v0) { v1 = v0; i1 = i0; v0 = sg; i0 = e; } else if (sg > v1) { v1 = sg; i1 = e; } }
            const float w0 = 1.f / (1.f + expf(v1 - v0)), w1 = 1.f - w0;
            if (lane == 0) { A.r_e[row * 2] = i0; A.r_e[row * 2 + 1] = i1; A.r_w[row * 2] = w0; A.r_w[row * 2 + 1] = w1;
                __hip_atomic_fetch_add(A.cnt + i0, 1u, RLX_AGENT); __hip_atomic_fetch_add(A.cnt + i1, 1u, RLX_AGENT); }
        }
    }
}
__device__ __forceinline__ void moe_offsets(const unsigned* cnt, int (&off)[9]) {
    int acc = 0;
#pragma unroll
    for (int e = 0; e < 8; ++e) { off[e] = acc; const int c = (int)__hip_atomic_load(cnt + e, RLX_AGENT); acc += ((c + 255) >> 8) << 8; }
    off[8] = acc;
}

struct AttPtrs { const bf16_t *QD, *KD, *VD, *QM, *KM, *VM; bf16_t *BR0, *BR1; };
__device__ __forceinline__ void mla_unit(const AttPtrs& P, int h, int qb, char* lds) {
    const int tid = opaque_tid(), wid = __builtin_amdgcn_readfirstlane(tid >> 6), lane = tid & 63, r32 = lane & 31, hi = lane >> 5;
    const int q0 = qb * 256 + wid * 32; f32x16 o[4]; float l;
    att::attn_core_pp<192, 12, true, false>(P.QM + (size_t)(q0 + r32) * 1536 + h * 192 + hi * 8, P.KM + h * 192, 1536, P.VM + h * 128, 1024, 4 * (qb + 1), q0 + r32, q0, 0, lds, o, l);
    float* ws = (float*)(lds + 3 * att::SHM_V + 3 * 64 * 384) + wid * 64;
    att::normalize_o(o, l, ws, r32, hi);
    att::store_o_bf16(o, P.BR1 + (size_t)q0 * 1024 + h * 128, 1024, r32, hi);
    __syncthreads();
}
__device__ __forceinline__ void diff_unit(const AttPtrs& P, int h, int qb, float lam, char* lds) {
    const int tid = opaque_tid(), wid = __builtin_amdgcn_readfirstlane(tid >> 6), lane = tid & 63, r32 = lane & 31, hi = lane >> 5;
    const int mp = wid >> 2, w4 = wid & 3, q0 = qb * 128 + w4 * 32; f32x16 o[4]; float l;
    att::attn_core_pp<128, 4, true, true>(P.QD + (size_t)(q0 + r32) * 1024 + h * 128 + mp * 64 + hi * 8, P.KD + h * 128, 1024, P.VD + h * 128, 1024, 2 * (qb + 1), q0 + r32, q0, mp * 8, lds, o, l);
    float* ws = (float*)(lds + 3 * att::SHM_V + 3 * 64 * 256) + wid * 64;
    att::normalize_o(o, l, ws, r32, hi);
    __syncthreads();
    float* xch = (float*)lds + w4 * 4096 + lane;
    if (mp == 1) {
#pragma unroll
        for (int d0 = 0; d0 < 4; ++d0)
#pragma unroll
            for (int r = 0; r < 16; ++r) xch[(d0 * 16 + r) * 64] = o[d0][r];
    }
    __syncthreads();
    if (mp == 0) {
        float ss[16];
#pragma unroll
        for (int r = 0; r < 16; ++r) { float s = 0.f;
#pragma unroll
            for (int d0 = 0; d0 < 4; ++d0) { const float dv = o[d0][r] - lam * xch[(d0 * 16 + r) * 64]; o[d0][r] = dv; s += dv * dv; }
            ss[r] = s; }
#pragma unroll
        for (int r = 0; r < 16; ++r) { float s = ss[r];
#pragma unroll
            for (int off = 1; off < 32; off <<= 1) s += shflx(s, off, lane);
            const float rs = __builtin_amdgcn_rsqf(s * (1.f / 128.f) + RMS_EPS);
#pragma unroll
            for (int d0 = 0; d0 < 4; ++d0) o[d0][r] *= rs; }
        att::store_o_bf16(o, P.BR0 + (size_t)q0 * 1024 + h * 128, 1024, r32, hi);
    }
    __syncthreads();
}
__device__ __forceinline__ void cross_unit(const bf16_t* XQ, const bf16_t* XKV, bf16_t* XO, int h, int qb, char* lds) {
    const int tid = opaque_tid(), wid = __builtin_amdgcn_readfirstlane(tid >> 6), lane = tid & 63, r32 = lane & 31, hi = lane >> 5;
    const int q0 = qb * 256 + wid * 32; f32x16 o[4]; float l;
    att::attn_core<128, 8, false, true>(XQ + (size_t)(q0 + r32) * 512 + h * 128 + hi * 8, XKV + h * 128, 1024, XKV + 512 + h * 128, 1024, 4, 0, 0, 0, lds, o, l);
    float* ws = (float*)(lds + 2 * att::SHM_V + 2 * 64 * 256) + wid * 64;
    att::normalize_o(o, l, ws, r32, hi);
    att::store_o_bf16(o, XO + (size_t)q0 * 512 + h * 128, 512, r32, hi);
    __syncthreads();
}

__global__ void __launch_bounds__(512, 2) fwd_kernel(Args args) {
    extern __shared__ __attribute__((aligned(16))) unsigned char lds_raw[];
    LAS unsigned char* lds = (LAS unsigned char*)lds_raw;
    const int tid = threadIdx.x, lane = tid & 63, wave = __builtin_amdgcn_readfirstlane(tid >> 6);
    const int G = gridDim.x, bx = blockIdx.x;
    unsigned char* ws = (unsigned char*)(GAS unsigned char*)(unsigned long long)args.ws;
    unsigned* ctl = (unsigned*)(ws + WS_CTL);
    volatile LAS unsigned* MISC = (volatile LAS unsigned*)(lds + LDS_MISC);
    if (tid < 32) MISC[tid] = 0u;
    if (lane == 0) ((volatile LAS int*)LDS_WTAB)[__builtin_amdgcn_s_getreg(0x2804)] = wave;
    { volatile LAS unsigned long long* pt = (volatile LAS unsigned long long*)(lds + LDS_MISC + 256); if (tid < 35) pt[tid] = (unsigned long long)args.in[tid]; if (tid == 35) pt[35] = (unsigned long long)args.out; }
    __syncthreads();
    ArgsD ad; ad.in.t = (volatile LAS unsigned long long*)(lds + LDS_MISC + 256); ad.ws = ws;
    const int lo = args.ph_lo, hi = args.ph_hi;
    XcdBarrier bar; bar.bar = ctl + CW_BAR; bar.x = 0; bar.st = nullptr;
    if (hi - lo > 1) { bar = xcd_barrier_post(ctl + CW_BAR, MISC + 8); xcd_barrier_setup(bar); }
#ifndef PH_SEL
#define PH_SEL 0xFFFFFFFFu
#endif
#define INR(k) (lo <= (k) && (k) < hi)
#define IN0() (((PH_SEL) & 1u) && INR(0))
#define INL(j) ((((PH_SEL) >> ((j) + 1)) & 1u) && INR(pb + (j)))
#define SEAM(k) do { if (INR(k) && INR((k) + 1)) xcd_barrier(bar); } while (0)
    const int gw = bx * 8 + wave, NGW = G * 8;
    const int gtid = bx * 512 + tid, NGT = G * 512;

    if (IN0()) {
      {
        { int start = bx;
            for (int id = 0; id < NMAT; ++id) { const Mat mt = get_mat(ad, id); if (mt.kind == 1) continue; const int nit = (mt.K / 64) * (mt.N / 256);
                int it = start; for (; it < nit; it += G) cvt_tile_wg(mt, (LAS float*)lds, it, tid);
                start = it - nit; } }
        { LAS float* scr = (LAS float*)(lds + wave * 16640); int start = gw;
            for (int id = 0; id < 22; id += 11) { const Mat mt = get_mat(ad, id); const int nit = (mt.K / 64) * (mt.N / 64);
                int it = start; for (; it < nit; it += NGW) cvt_item(mt, scr, it, lane);
                start = it - nit; } }
        for (int l = 0; l < DEPTH; ++l) { u32x4* p = (u32x4*)((unsigned char*)(ws + WS_W + (size_t)l * LW_BYTES + LW_IN) + (size_t)NIN_BF * D * 2 + (size_t)(3904 - NIN_BF) * D);
            for (int i = gtid; i < 192 * D / 16; i += NGT) p[i] = (u32x4){0u, 0u, 0u, 0u}; }
        { const float* x = (const float*)ad.in[I_X]; bf16_t* xn = (bf16_t*)(ws + WS_XN);
            unsigned char* x8 = ws + WS_XN8;
            for (size_t i = gtid; i < (size_t)M * D / 8; i += NGT) { const f32x4 a = *(const f32x4*)(x + i * 8), b = *(const f32x4*)(x + i * 8 + 4); *(u32x4*)(xn + i * 8) = pack8(a, b); *(u32x2*)(x8 + i * 8) = pack8_fp8(a, b); }
            const float* mem = (const float*)ad.in[I_MEM]; bf16_t* mb = (bf16_t*)(ws + WS_MEMB);
            for (int i = gtid; i < MEM_LEN * D / 8; i += NGT) { const f32x4 a = *(const f32x4*)(mem + i * 8), b = *(const f32x4*)(mem + i * 8 + 4); *(u32x4*)(mb + i * 8) = pack8(a, b); } }
        { const int* pos = (const int*)ad.in[I_POS]; float* td = (float*)(ws + WS_TABD); float* tm = (float*)(ws + WS_TABM);
            for (int i = gtid; i < M * 40; i += NGT) { const int t = i / 40, k = i - t * 40; const double p = (double)pos[t];
                const double inv = (k < 8) ? exp(-(double)k * (13.122363377404328 / 8.0)) : exp(-(double)(k - 8) * (13.122363377404328 / 32.0));
                const double ang = p * inv; const float c = (float)cos(ang), s = (float)sin(ang);
                if (k < 8) { td[(t * 8 + k) * 2] = c; td[(t * 8 + k) * 2 + 1] = s; } else { tm[(t * 32 + k - 8) * 2] = c; tm[(t * 32 + k - 8) * 2 + 1] = s; } } }
        if (bx == 0 && tid < 192) { int* ord = (int*)(ws + WS_ORDER); const int mine = tid < 64 ? 160 * (tid + 1) : 48 * (tid - 64 + 1); int rank = 0;
            for (int c = 0; c < 192; ++c) { const int cc = c < 64 ? 160 * (c + 1) : 48 * (c - 64 + 1); rank += (cc > mine || (cc == mine && c < tid)) ? 1 : 0; }
            const int code = tid < 64 ? ((1 << 16) | (tid << 8)) : ((tid - 64) << 8);
            for (int h = 0; h < 8; ++h) ord[rank * 8 + h] = code | h; }
        __syncthreads();
#ifdef PROBE_SSMB
#pragma nounroll
        for (int rep_ = 0; rep_ < 2; ++rep_)
#endif
        for (int uidx = bx; uidx < DEPTH * 64 * 2; uidx += G) ssm_build(ad, uidx >> 7, (uidx >> 1) & 63, uidx & 1, lds);
        __syncthreads();
      }
    }
    SEAM(0);

    unsigned char* const ws_k = ws; const int bx_k = bx;
    for (int l = 0; l < DEPTH; ++l) {
        const int pb = 1 + l * NPL;
        if (!(lo < pb + NPL && pb < hi)) continue;
        int bx = bx_k; asm volatile("" : "+s"(bx));
        unsigned long long ws_i = (unsigned long long)ws_k; asm volatile("" : "+s"(ws_i)); unsigned char* ws = (unsigned char*)(GAS unsigned char*)ws_i;
#define PH_TID const int tid = opaque_tid(), lane = tid & 63, wave = __builtin_amdgcn_readfirstlane(tid >> 6); const int gw = bx * 8 + wave, NGW = G * 8; (void)lane; (void)wave; (void)gw; (void)NGW
#define lw (ws + WS_W + (size_t)l * LW_BYTES)
#define ssq_q ((float*)(ws + WS_PSQ))
#define ssq_kv (ssq_q + (size_t)8 * M)
#define XS ((float*)(ws + WS_XS))
#define XN ((bf16_t*)(ws + WS_XN))
#define tabd ((const float*)(ws + WS_TABD))
#define tabm ((const float*)(ws + WS_TABM))
#define QD ((bf16_t*)(ws + WS_QD))
#define KD ((bf16_t*)(ws + WS_KD))
#define VD ((bf16_t*)(ws + WS_VD))
#define MQ ((bf16_t*)(ws + WS_MQ))
#define MKV ((bf16_t*)(ws + WS_MKV))
#define KM ((bf16_t*)(ws + WS_KM))
#define VM ((bf16_t*)(ws + WS_VM))
#define QM ((bf16_t*)(ws + WS_QM))
#define SU ((bf16_t*)(ws + WS_SU))
#define GATES ((bf16_t*)(ws + WS_GATES))
#define SLOC ((float*)(ws + WS_SLOC))
#define YG ((bf16_t*)(ws + WS_YG))
#define BR ((bf16_t*)(ws + WS_BR))
#define TMP ((float*)(ws + WS_TMP))
#define MG ((bf16_t*)(ws + WS_MG))
#define XQ ((bf16_t*)(ws + WS_XQ))
#define XO ((bf16_t*)(ws + WS_XO))
#define XKV ((bf16_t*)(ws + WS_XKV) + (size_t)l * 256 * 1024)
#define r_e ((int*)(ws + WS_ROUTE))
#define r_w ((float*)(ws + WS_ROUTE + 128 * 1024))
#define slot ((int*)(ws + WS_ROUTE + 256 * 1024))
#define wslot ((float*)(ws + WS_ROUTE + 384 * 1024))
        if (INL(0)) {
#if !defined(SUBSEL) || (SUBSEL & 1)
            { pg8::Gemm g{XN, (const bf16_t*)(lw + LW_IN), (D) * 2, (D) * 2, (D) * 2, 0}; SchedPlain S; S.init(M / 256, NIN_BF / 256, D, D, G, bx);
              EpiInProj E{QD, KD, VD, MQ, MKV, KM, SU, GATES, ssq_q, ssq_kv, tabd, tabm, 0};
              pg8::gemm_phase(lds, g, S, E); }
            { pg8::Gemm g{ws + WS_XN8, lw + LW_IN + (size_t)NIN_BF * D * 2, D, D, D, 0}; SchedPlain S; S.T.init(M / 256, NIN_G8 / 256); S.G = G; S.c = bx; S.tA = (size_t)256 * D; S.tB = S.tA;
              EpiInProj E{QD, KD, VD, MQ, MKV, KM, SU, GATES, ssq_q, ssq_kv, tabd, tabm, 12};
              pg8::gemm_phase_t<true, 0x7C7C7C7C>(lds, g, S, E); }
#endif
#if !defined(SUBSEL) || (SUBSEL & 2)
            { pg8::Gemm g{(const bf16_t*)(ws + WS_MEMB), (const bf16_t*)(lw + LW_XKV), (D) * 2, (D) * 2, (D) * 2, 0}; SchedPlain S; S.init(1, 4, D, D, G, (bx + 128) % G);
              EpiBf16 E{XKV, 1024, 1.f};
              pg8::gemm_phase(lds, g, S, E); }
#endif
        }
        SEAM(pb + 0);
        if (INL(1)) {
#if !defined(SUBSEL) || (SUBSEL & 1)
            { pg8::Gemm g{MQ, (const bf16_t*)(lw + LW_QUP), (512) * 2, (512) * 2, (512) * 2, 0}; SchedPlain S; S.init(M / 256, 6, 512, 512, G, bx);
              EpiQup E{QM, ssq_q, tabm}; pg8::gemm_phase(lds, g, S, E); }
#endif
#if !defined(SUBSEL) || (SUBSEL & 2)
            { pg8::Gemm g{MKV, (const bf16_t*)(lw + LW_KVUP), (256) * 2, (256) * 2, (256) * 2, 0}; SchedPlain S; S.init(M / 256, 8, 256, 256, G, (bx + 128) % G);
              EpiKVup E{KM, VM, ssq_kv}; pg8::gemm_phase(lds, g, S, E); }
#endif
#if !defined(SUBSEL) || (SUBSEL & 4)
            { pg8::Gemm g{SU, (const bf16_t*)(lw + LW_WSL), (SSM_KX) * 2, (512) * 2, (512) * 2, 0}; SchedBatch S{2, 1, 64, G, (bx + 128) % G  , (size_t)256 * SSM_KX * 2, (size_t)256 * 512 * 2, (size_t)SSM_NCH * SSM_KX * 2, (size_t)256 * 512 * 2};
              EpiSloc E{SLOC}; pg8::gemm_phase(lds, g, S, E); }
#endif
        }
        SEAM(pb + 1);
        if (INL(2)) {
            PH_TID;
            if (bx < 64) { const int g = bx, n = lane, w = wave;
                const float* a32 = (const float*)(ws + WS_A32) + (size_t)((l * 64 + g) * 64 + n) * 2; const float ar = a32[0], ai = a32[1];
                const float* __restrict__ lp = SLOC + ((size_t)g * SSM_NCH + 64 * w) * 128 + 2 * n; bf16_t* __restrict__ sp = SU + ((size_t)g * SSM_NCH + 64 * w) * SSM_KX + 512 + 2 * n;
                float br[64], bi[64]; float sr = 0.f, si = 0.f;
#pragma unroll
                for (int c0 = 0; c0 < 64; c0 += 32) { f32x2 lv[32];
#pragma unroll
                    for (int k = 0; k < 32; ++k) lv[k] = *(const f32x2*)(lp + (size_t)(c0 + k) * 128);
#pragma unroll
                    for (int k = 0; k < 32; ++k) { br[c0 + k] = sr; bi[c0 + k] = si; const float nr = ar * sr - ai * si + lv[k][0], ni = ar * si + ai * sr + lv[k][1]; sr = nr; si = ni; } }
                LAS float* ex = (LAS float*)lds;
                ex[(w * 64 + n) * 2] = sr; ex[(w * 64 + n) * 2 + 1] = si;
                float pr = ar, pi = ai;
#pragma unroll
                for (int q = 0; q < 6; ++q) { const float tr = pr * pr - pi * pi, ti = 2.f * pr * pi; pr = tr; pi = ti; }
                __syncthreads();
                float cr = 0.f, ci = 0.f;
                for (int uu = 0; uu < w; ++uu) { const float er = ex[(uu * 64 + n) * 2], ei = ex[(uu * 64 + n) * 2 + 1]; const float tr = pr * cr - pi * ci + er, ti = pr * ci + pi * cr + ei; cr = tr; ci = ti; }
#pragma unroll
                for (int k = 0; k < 64; ++k) { *(unsigned*)(sp + (size_t)k * SSM_KX) = cvt_pk_bf16(br[k] + cr, bi[k] + ci);
                    const float tr = ar * cr - ai * ci, ti = ar * ci + ai * cr; cr = tr; ci = ti; } }
        }
        SEAM(pb + 2);
        if (INL(3)) {
#if !defined(SUBSEL) || (SUBSEL & 1)
            { pg8::Gemm g{SU, (const bf16_t*)(lw + LW_TEXT), (SSM_KX) * 2, (SSM_KX) * 2, (SSM_KX) * 2, 0}; SchedBatch S{2, 2, 64, G, bx, (size_t)256 * SSM_KX * 2, (size_t)256 * SSM_KX * 2, (size_t)SSM_NCH * SSM_KX * 2, (size_t)512 * SSM_KX * 2};
              EpiSsmY E{YG, SU, (const float*)ad.in[I_SSMD] + l * 1024}; pg8::gemm_phase(lds, g, S, E); }
#endif
            PH_TID;
            const float* dl = (const float*)ad.in[I_DLAM] + l * 256;
            const float lam = expf(wave_sum(dl[lane] * dl[64 + lane], lane)) - expf(wave_sum(dl[128 + lane] * dl[192 + lane], lane)) + lam_init_of(l);
            const AttPtrs P{QD, KD, VD, QM, KM, VM, BR, BR + (size_t)M * 1024};
            const int* ord = (const int*)(ws + WS_ORDER);
            __syncthreads();
#ifndef PROBE_ATT
#define PROBE_ATT 0
#endif
            const unsigned myx = xb_xcc_id() & 7u;
#pragma nounroll
            for (int rep = 0; rep < (PROBE_ATT ? 2 : 1); ++rep)
#pragma nounroll
            for (int sq = 0; sq < 8; ++sq) { const int q = (int)((myx + sq) & 7u);
            for (;;) {
                if (tid == 0) MISC[0] = __hip_atomic_fetch_add(ctl + CW_ATTQ + 64 * l + 32 * rep + q, 1u, RLX_AGENT);
                __syncthreads();
                const unsigned it = MISC[0];
                __syncthreads();
                if (it >= 192u) break;
                const int code = ord[it * 8 + q], h = code & 255, qb = (code >> 8) & 255;
                if ((code >> 16) && (rep == 0 || (PROBE_ATT & 1))) mla_unit(P, h, qb, (char*)lds_raw);
                if (!(code >> 16) && (rep == 0 || (PROBE_ATT & 2))) diff_unit(P, h, qb, lam, (char*)lds_raw);
            } }
        }
        SEAM(pb + 3);
        if (INL(4)) {
            pg8::Gemm g{YG, (const bf16_t*)(lw + LW_GLU), (1024) * 2, (1024) * 2, (1024) * 2, 0}; SchedPlain S; S.init(M / 256, 8, 1024, 1024, G, bx);
            EpiGated<0> E{BR + (size_t)2 * M * 1024, 1024}; pg8::gemm_phase(lds, g, S, E);
        }
        SEAM(pb + 4);
        if (INL(5)) {
            pg8::Gemm g{BR, (const bf16_t*)(lw + LW_BR), (1024) * 2, (1024) * 2, (1024) * 2, 0}; SchedBranch S; S.T.init(M / 256, 8); S.G = G; S.c = bx; S.tA = (size_t)256 * 1024 * 2; S.tB = S.tA; S.zA = (size_t)M * 1024 * 2; S.zB = (size_t)2048 * 1024 * 2;
            EpiBranch E{GATES, (bf16_t*)TMP, MG}; pg8::gemm_phase(lds, g, S, E);
        }
        SEAM(pb + 5);
        if (INL(6)) {
            pg8::Gemm g{MG, (const bf16_t*)(lw + LW_OUT), (D) * 2, (D) * 2, (D) * 2, 0}; SchedPlain S; S.init(M / 256, 8, D, D, G, bx);
            EpiResid E{XN}; pg8::gemm_phase(lds, g, S, E);
        }
        SEAM(pb + 6);
        if (INL(7)) { const LnArgs A{XN, nullptr, nullptr, (const float*)ad.in[I_LNMG] + l * D, (const float*)ad.in[I_LNMB] + l * D, nullptr, nullptr, nullptr, nullptr, nullptr}; ln_phase<0>(A, lds, G); }
        SEAM(pb + 7);
        if (INL(8)) {
            pg8::Gemm g{XN, (const bf16_t*)(lw + LW_XQ), (D) * 2, (D) * 2, (D) * 2, 0}; SchedPlain S; S.T.init(M / 128, 2); S.G = G; S.c = bx; S.tA = (size_t)128 * D * 2; S.tB = (size_t)256 * D * 2;
            EpiBf16Half E{XQ, 512, C2_X}; pg8::gemm_phase(lds, g, S, E);
        }
        SEAM(pb + 8);
        if (INL(9)) { for (int uidx = bx; uidx < 256; uidx += G) cross_unit(XQ, XKV, XO, uidx & 3, uidx >> 2, (char*)lds_raw); }
        SEAM(pb + 9);
        if (INL(10)) {
            pg8::Gemm g{XO, (const bf16_t*)(lw + LW_XO), (512) * 2, (512) * 2, (512) * 2, 0}; SchedPlain S; S.init(M / 256, 8, 512, 512, G, bx);
            EpiResid E{XN}; pg8::gemm_phase(lds, g, S, E);
        }
        SEAM(pb + 10);
        if (INL(11)) {
            const LnArgs A{XN, nullptr, nullptr, (const float*)ad.in[I_LNXG] + l * D, (const float*)ad.in[I_LNXB] + l * D, nullptr, nullptr, r_e, r_w, ctl + CW_MOECNT};
            if (l == 0) ln_phase<0>(A, lds, G);
            else { PH_TID; const float* rw = (const float*)ad.in[I_ROUTER]; LAS float* wl = (LAS float*)lds;
                for (int i = tid; i < D * 8; i += 512) wl[(i & 7) * D + (i >> 3)] = rw[i];
                __syncthreads(); ln_phase<1>(A, lds, G); __syncthreads(); }
        }
        SEAM(pb + 11);
        if (l == 1) {
            if (INL(12)) { PH_TID; int off[9]; moe_offsets(ctl + CW_MOECNT, off); bf16_t* XG = (bf16_t*)(ws + WS_XG);
                for (int row = gw; row < M; row += NGW) { int s0 = 0, s1 = 0;
                    if (lane == 0) { const int e0 = r_e[row * 2], e1 = r_e[row * 2 + 1];
                        s0 = off[e0] + (int)__hip_atomic_fetch_add(ctl + CW_MOECUR + e0, 1u, RLX_AGENT); s1 = off[e1] + (int)__hip_atomic_fetch_add(ctl + CW_MOECUR + e1, 1u, RLX_AGENT);
                        slot[row * 2] = s0; slot[row * 2 + 1] = s1; wslot[s0] = r_w[row * 2]; wslot[s1] = r_w[row * 2 + 1]; }
                    s0 = __builtin_amdgcn_readfirstlane(s0); s1 = __builtin_amdgcn_readfirstlane(s1);
                    const u32x4* src = (const u32x4*)(XN + (size_t)row * D) + lane; u32x2* d0 = (u32x2*)((unsigned char*)XG + (size_t)s0 * D) + lane; u32x2* d1 = (u32x2*)((unsigned char*)XG + (size_t)s1 * D) + lane;
#pragma unroll
                    for (int j = 0; j < 4; ++j) { const u32x4 v = src[64 * j];
                        const u32x2 q = pack8_fp8((f32x4){bf_lo(v.x), bf_hi(v.x), bf_lo(v.y), bf_hi(v.y)}, (f32x4){bf_lo(v.z), bf_hi(v.z), bf_lo(v.w), bf_hi(v.w)}); d0[64 * j] = q; d1[64 * j] = q; } } }
            SEAM(pb + 12);
        }
        if (INL(13)) {
            if (l == 0) { pg8::Gemm g{XN, (const bf16_t*)(ws + WS_FFN), (D) * 2, (D) * 2, (D) * 2, 0}; SchedPlain S; S.init(M / 256, 44, D, D, G, bx);
                EpiGated<1> E{(bf16_t*)(ws + WS_HG), DFF}; pg8::gemm_phase(lds, g, S, E); }
            else { int off[9]; moe_offsets(ctl + CW_MOECNT, off);
                pg8::Gemm g{ws + WS_XG, ws + WS_MOE, D, D, D, 0x7C7C7C7C}; SchedMoe S; S.T.init(off[8] >> 8, 44); S.G = G; S.c = bx; S.tA = (size_t)256 * D; S.tB = S.tA; S.zB = 66 * MiB;
#pragma unroll
                for (int k = 0; k < 7; ++k) S.off[k] = off[k + 1];
                EpiSwigluF8 E{ws + WS_HG, DFF}; pg8::gemm_phase_t<true, 0x7C7C7C7C>(lds, g, S, E); }
        }
        SEAM(pb + 13);
        if (INL(14)) {
            if (l == 0) { pg8::Gemm g{(const bf16_t*)(ws + WS_HG), (const bf16_t*)(ws + WS_FFN + 44 * MiB), (DFF) * 2, (DFF) * 2, (DFF) * 2, 0}; SchedPlain S; S.init(M / 256, 8, DFF, DFF, G, bx);
                EpiResid E{XN}; pg8::gemm_phase(lds, g, S, E); }
            else { int off[9]; moe_offsets(ctl + CW_MOECNT, off);
                pg8::Gemm g{ws + WS_HG, ws + WS_MOE + 44 * MiB, DFF, DFF, DFF, 0x7B7B7B7B}; SchedMoe S; S.T.init(off[8] >> 8, 8); S.G = G; S.c = bx; S.tA = (size_t)256 * DFF; S.tB = S.tA; S.zB = 66 * MiB;
#pragma unroll
                for (int k = 0; k < 7; ++k) S.off[k] = off[k + 1];
                EpiMoeDown E{(float*)(ws + WS_OG), wslot}; pg8::gemm_phase_t<true, 0x7B7B7B7B>(lds, g, S, E); }
        }
        SEAM(pb + 14);
        if (INL(15)) {
            const LnArgs A{XN, (l == DEPTH - 1) ? (float*)ad.in[35] : nullptr, (l == DEPTH - 1) ? nullptr : ws + WS_XN8, (const float*)ad.in[I_LNFG] + l * D, (const float*)ad.in[I_LNFB] + l * D, (const float*)(ws + WS_OG), slot, nullptr, nullptr, nullptr};
            if (l == 0) ln_phase<0>(A, lds, G); else ln_phase<2>(A, lds, G);
        }
        SEAM(pb + 15);
    }
#undef INR
#undef IN0
#undef INL
#undef SEAM
}

extern "C" void kernel_launch(void* const* d_in, const int* in_sizes, int n_in, void* d_out, int out_size, void* d_ws, size_t ws_size, hipStream_t stream) {
    static int grid = 0;
    if (grid == 0) {
        if (n_in != 35 || out_size != M * D || ws_size < WS_END) { fprintf(stderr, "kernel_launch: shape/workspace mismatch: n_in %d out %d ws %zu (need %zu)\n", n_in, out_size, ws_size, (size_t)WS_END); grid = -1; return; }
        int dev = 0, cus = 0, per_cu = 0;
        if (hipGetDevice(&dev) != hipSuccess || hipDeviceGetAttribute(&cus, hipDeviceAttributeMultiprocessorCount, dev) != hipSuccess) { grid = -1; return; }
        if (hipFuncSetAttribute((const void*)fwd_kernel, hipFuncAttributeMaxDynamicSharedMemorySize, LDS_BYTES) != hipSuccess) { fprintf(stderr, "kernel_launch: hipFuncSetAttribute failed\n"); grid = -1; return; }
        if (hipOccupancyMaxActiveBlocksPerMultiprocessor(&per_cu, (const void*)fwd_kernel, 512, LDS_BYTES) != hipSuccess || per_cu < 1) { fprintf(stderr, "kernel_launch: occupancy query says %d\n", per_cu); }
        (void)hipGetLastError();
        grid = cus;
    }
    if (grid < 0) return;
    if (hipMemsetAsync((char*)d_ws + WS_CTL, 0, CTL_ZERO_BYTES, stream) != hipSuccess) return;
    Args a{};
    for (int i = 0; i < 35; ++i) a.in[i] = d_in[i];
    a.out = (float*)d_out; a.ws = (unsigned char*)d_ws;
#if MK_MULTI
    for (int p = 0; p < NPHASE; ++p) { if (p == 1 + 12) continue; a.ph_lo = p; a.ph_hi = p + 1; hipLaunchKernelGGL(fwd_kernel, dim3(grid), dim3(512), LDS_BYTES, stream, a); }
#else
    a.ph_lo = 0; a.ph_hi = NPHASE;
    hipLaunchKernelGGL(fwd_kernel, dim3(grid), dim3(512), LDS_BYTES, stream, a);
#endif
    const hipError_t le = hipPeekAtLastError();
    if (le != hipSuccess) fprintf(stderr, "kernel_launch: launch failed: %s\n", hipGetErrorName(le));
}
```

```cpp
#include <hip/hip_runtime.h>
#include <cstdio>
#include <cstdint>
#include <cmath>

#ifndef MK_MULTI
#define MK_MULTI 0
#endif
#ifndef MK_DBG
#define MK_DBG 0
#endif

#define GAS __attribute__((address_space(1)))
#define LAS __attribute__((address_space(3)))
typedef unsigned short bf16_t;
typedef short bf16x8 __attribute__((ext_vector_type(8)));
typedef short s16x4 __attribute__((ext_vector_type(4)));
typedef float f32x2 __attribute__((ext_vector_type(2)));
typedef float f32x4 __attribute__((ext_vector_type(4)));
typedef float f32x16 __attribute__((ext_vector_type(16)));
typedef unsigned u32x2 __attribute__((ext_vector_type(2)));
typedef unsigned u32x4 __attribute__((ext_vector_type(4)));
typedef GAS unsigned gu32;
#define RLX_AGENT __ATOMIC_RELAXED, __HIP_MEMORY_SCOPE_AGENT
#define LDS_WAIT() asm volatile("s_waitcnt lgkmcnt(0)" ::: "memory")
#define VM_WAIT() asm volatile("s_waitcnt vmcnt(0)" ::: "memory")
#define SBAR() __builtin_amdgcn_sched_barrier(0)

constexpr int M = 16384, D = 2048, DEPTH = 2, MEM_LEN = 256;
constexpr int NIN = 11264, NIN_BF = 3072  , NIN_G8 = 8192  ;
constexpr int NIN_SRC = 11072;
constexpr int DFF = 5632, NEXP = 8;
constexpr int SSM_L = 32, SSM_NCH = M / SSM_L  , SSM_KX = 640  ;
constexpr float LN_EPS = 1e-5f, RMS_EPS = 1e-6f;
constexpr float ALPHA = 1.4142135623730951f;
constexpr float LOG2E = 1.4426950408889634f;
constexpr float C2_DIFF = 0.125f * LOG2E;
constexpr float C2_MLA = 0.07216878364870323f * LOG2E;
constexpr float C2_X = 0.08838834764831845f * LOG2E;
constexpr int MOE_MAXROWS = 34816;

typedef __bf16 bf16x2_t __attribute__((ext_vector_type(2)));
__device__ __forceinline__ unsigned cvt_pk_bf16(float lo, float hi) { const f32x2 v = {lo, hi}; const bf16x2_t b = __builtin_convertvector(v, bf16x2_t); return __builtin_bit_cast(unsigned, b); }
__device__ __forceinline__ float bf_lo(unsigned w) { return __uint_as_float(w << 16); }
__device__ __forceinline__ float bf_hi(unsigned w) { return __uint_as_float(w & 0xffff0000u); }
__device__ __forceinline__ u32x4 pack8(f32x4 a, f32x4 b) { u32x4 w; w.x = cvt_pk_bf16(a[0], a[1]); w.y = cvt_pk_bf16(a[2], a[3]); w.z = cvt_pk_bf16(b[0], b[1]); w.w = cvt_pk_bf16(b[2], b[3]); return w; }
__device__ __forceinline__ u32x2 pack8_fp8(f32x4 a, f32x4 b) { int w0 = 0, w1 = 0;
    w0 = __builtin_amdgcn_cvt_pk_fp8_f32(a[0], a[1], w0, false); w0 = __builtin_amdgcn_cvt_pk_fp8_f32(a[2], a[3], w0, true);
    w1 = __builtin_amdgcn_cvt_pk_fp8_f32(b[0], b[1], w1, false); w1 = __builtin_amdgcn_cvt_pk_fp8_f32(b[2], b[3], w1, true);
    u32x2 r; r.x = (unsigned)w0; r.y = (unsigned)w1; return r; }
__device__ __forceinline__ float fast_sigmoid(float x) { return __builtin_amdgcn_rcpf(1.f + __builtin_amdgcn_exp2f(-x * LOG2E)); }
constexpr int LDS_WTAB = 131072 + 8192 + 1024;
__device__ __forceinline__ int opaque_tid() {
    const unsigned hw = __builtin_amdgcn_s_getreg(0x2804);
    const int wave = __builtin_amdgcn_readfirstlane(((volatile LAS int*)LDS_WTAB)[hw]);
    int lane; asm volatile("v_mbcnt_lo_u32_b32 %0, -1, 0\n\tv_mbcnt_hi_u32_b32 %0, -1, %0" : "=v"(lane));
    return wave * 64 + lane;
}
__device__ __forceinline__ float shflx(float v, int off, int lane) { return __int_as_float(__builtin_amdgcn_ds_bpermute((lane ^ off) << 2, __float_as_int(v))); }
__device__ __forceinline__ float wave_sum(float v, int lane) {
#pragma unroll
    for (int o = 1; o < 64; o <<= 1) v += shflx(v, o, lane);
    return v;
}

namespace pg8 {
constexpr int BM = 256, BK = 64, HALF = 128, HTB = HALF * BK * 2, STAGE_BYTES = 8 * HTB, NXCD = 8, WGM = 8;
__host__ __device__ __forceinline__ int lds_byte(int r, int c) { const int st = (r >> 4) * 2 + (c >> 5), rr = r & 15, cc = c & 31, ob = rr * 64 + cc * 2; return st * 1024 + (ob ^ (((ob >> 9) & 1) << 5)); }
__host__ __device__ __forceinline__ void stage_rc(int b, int& R, int& C) { const int st = b / 1024, sb = b % 1024, swz = sb ^ (((sb >> 9) & 1) << 5); R = (st >> 1) * 16 + swz / 64; C = (st & 1) * 32 + (swz % 64) / 2; }
__host__ __device__ __forceinline__ int perm32(int rho) { const int n = rho >> 4, i = rho & 15; return 8 * (i >> 2) + 4 * n + (i & 3); }

__device__ __forceinline__ size_t uni64(size_t v) { const unsigned lo_ = __builtin_amdgcn_readfirstlane((unsigned)v), hi_ = __builtin_amdgcn_readfirstlane((unsigned)(v >> 32)); return ((size_t)hi_ << 32) | lo_; }
struct Unit { int pm, pn, z; size_t offA, offB; };
struct Gemm { const void* A; const void* Bt; int ldaB, ldbB, KB; int wscale; };
typedef int v8i __attribute__((ext_vector_type(8)));
typedef int v4i __attribute__((ext_vector_type(4)));

struct TileOrder {
    int nM, nN, nwg;
    __device__ __forceinline__ void init(int nM_, int nN_) { nM = nM_; nN = nN_; nwg = nM * nN; }
    __device__ __forceinline__ bool map(long L, int& pm, int& pn) const {
        if (L >= nwg) return false;
        int wgid = (int)L; { const int q = nwg / NXCD, r = nwg % NXCD, xcd = wgid % NXCD, off = wgid / NXCD; wgid = (xcd < r ? xcd * (q + 1) : r * (q + 1) + (xcd - r) * q) + off; }
        const int nig = WGM * nN, gid = wgid / nig, fm = gid * WGM, gsz = (nM - fm) < WGM ? (nM - fm) : WGM;
        pm = __builtin_amdgcn_readfirstlane(fm + ((wgid % nig) % gsz)); pn = __builtin_amdgcn_readfirstlane((wgid % nig) / gsz); return true;
    }
};

template <bool FP8, int WSC, class Epi, class Sched>
__device__ __forceinline__ void gemm_phase_t(LAS unsigned char* lds, const Gemm g, const Sched& S, const Epi& E) {
    const int tid = opaque_tid(), wid = __builtin_amdgcn_readfirstlane(tid >> 6), lane = tid & 63, wr = wid >> 2, wc = wid & 3, fr = lane & 15, fq = lane >> 4;
    const int nt = g.KB / (BK * 2);
    unsigned voffA[2], voffB[2];
#pragma unroll
    for (int i = 0; i < 2; ++i) { int R, C; stage_rc(tid * 16 + i * 8192, R, C); const int Rb = (R & ~31) + perm32(R & 31);
        voffA[i] = (unsigned)(R * g.ldaB + C * 2); voffB[i] = (unsigned)(Rb * g.ldbB + C * 2); }
    const size_t kstep = (size_t)(BK * 2);
    const size_t hstepA = (size_t)HALF * g.ldaB, hstepB = (size_t)HALF * g.ldbB;
    const unsigned ldsw = (unsigned)wid * 1024u;
    const unsigned lds_u = __builtin_amdgcn_readfirstlane((unsigned)(uintptr_t)lds + ldsw);
    const int aoff = lds_byte(wr * 64 + fr, fq * 8), boff = lds_byte(wc * 32 + fr, fq * 8);
#define PG8_SA(b, h) (((b) * 2 + (h)) * HTB)
#define PG8_SB(b, h) ((4 + (b) * 2 + (h)) * HTB)
#define PG8_STAGE(bufoff, gbase, voff) do { _Pragma("unroll") for (int _i = 0; _i < 2; ++_i) \
        { unsigned _keep; asm volatile("s_mov_b32 %0, m0\n\ts_mov_b32 m0, %1\n\ts_nop 0\n\tglobal_load_lds_dwordx4 %2, %3\n\ts_mov_b32 m0, %0" : "=&s"(_keep) : "s"(lds_u + (unsigned)((bufoff) + _i * 8192)), "v"((voff)[_i]), "s"(gbase) : "memory"); } } while (0)
#define PG8_LD32(p) __builtin_shufflevector(*(const LAS v4i*)(p), *(const LAS v4i*)((p) + 1024), 0, 1, 2, 3, 4, 5, 6, 7)
#define PG8_LDA(dst, b, h) do { _Pragma("unroll") for (int m = 0; m < 4; ++m) dst[m] = PG8_LD32(lds + PG8_SA(b, h) + aoff + m * 2048); } while (0)
#define PG8_LDB(dst, b, h) do { _Pragma("unroll") for (int n = 0; n < 2; ++n) dst[n] = PG8_LD32(lds + PG8_SB(b, h) + boff + n * 2048); } while (0)
#define PG8_H0(x) __builtin_bit_cast(bf16x8, __builtin_shufflevector((x), (x), 0, 1, 2, 3))
#define PG8_H1(x) __builtin_bit_cast(bf16x8, __builtin_shufflevector((x), (x), 4, 5, 6, 7))
#define PG8_MMA(ai, bj, At, Bt) do { __builtin_amdgcn_s_setprio(1); _Pragma("unroll") for (int m = 0; m < 4; ++m) _Pragma("unroll") for (int n = 0; n < 2; ++n) { \
        if constexpr (FP8) asm volatile("v_mfma_scale_f32_16x16x128_f8f6f4 %0, %1, %2, %0, %3, %3 op_sel_hi:[0,0,0]" : "+v"(acc[ai][bj][m][n]) : "v"(Bt[n]), "v"(At[m]), "v"(wsc_v));     \
        else { acc[ai][bj][m][n] = __builtin_amdgcn_mfma_f32_16x16x32_bf16(PG8_H0(Bt[n]), PG8_H0(At[m]), acc[ai][bj][m][n], 0, 0, 0); acc[ai][bj][m][n] = __builtin_amdgcn_mfma_f32_16x16x32_bf16(PG8_H1(Bt[n]), PG8_H1(At[m]), acc[ai][bj][m][n], 0, 0, 0); } } \
        __builtin_amdgcn_s_setprio(0); } while (0)
#define PG8_WAIT_V(n) asm volatile("s_waitcnt vmcnt(" #n ")" ::: "memory")
#define PG8_WAIT_L(n) asm volatile("s_waitcnt lgkmcnt(" #n ")" ::: "memory")
#define PG8_BAR __builtin_amdgcn_s_barrier()
#define PG8_SCHED __builtin_amdgcn_sched_barrier(0)
    Unit cur, nxt; int ui = 0;
    if (!S.next(0, cur)) return;
    f32x4 acc[2][2][4][2];
#pragma unroll
    for (int a = 0; a < 2; ++a)
#pragma unroll
        for (int b = 0; b < 2; ++b)
#pragma unroll
            for (int m = 0; m < 4; ++m)
#pragma unroll
                for (int n = 0; n < 2; ++n) acc[a][b][m][n] = (f32x4){0.f, 0.f, 0.f, 0.f};
    v8i At[4], B0[2], B1[2]; const int wsc_v = WSC; (void)wsc_v;
    const char* cA = (const char*)g.A + uni64(cur.offA); const char* cB = (const char*)g.Bt + uni64(cur.offB);
    PG8_STAGE(PG8_SB(0, 0), cB, voffB); PG8_STAGE(PG8_SB(0, 1), cB + hstepB, voffB); PG8_STAGE(PG8_SA(0, 0), cA, voffA); PG8_STAGE(PG8_SA(0, 1), cA + hstepA, voffA);
    if (wr == 1) PG8_BAR;
    PG8_WAIT_V(2); PG8_BAR;
    PG8_STAGE(PG8_SB(1, 0), cB + kstep, voffB); PG8_STAGE(PG8_SA(1, 0), cA + kstep, voffA); PG8_STAGE(PG8_SB(1, 1), cB + hstepB + kstep, voffB);
    PG8_WAIT_V(6); PG8_BAR;
    for (;;) {
        const bool has_next = S.next(ui + 1, nxt);
        const char* nA = has_next ? (const char*)g.A + uni64(nxt.offA) : cA; const char* nB = has_next ? (const char*)g.Bt + uni64(nxt.offB) : cB;
        for (int t = 0; t < nt; t += 2) {
            const bool last = (t == nt - 2);
            const char* a1 = cA + (size_t)(t + 1) * kstep;
            const char* a2 = last ? nA : cA + (size_t)(t + 2) * kstep; const char* b2 = last ? nB : cB + (size_t)(t + 2) * kstep;
            const char* a3 = a2 + kstep; const char* b3 = b2 + kstep;
            PG8_LDB(B0, 0, 0); PG8_LDB(B1, 0, 1); PG8_SCHED; PG8_LDA(At, 0, 0); PG8_STAGE(PG8_SA(1, 1), a1 + hstepA, voffA);
            PG8_WAIT_V(8); PG8_WAIT_L(0); PG8_BAR; PG8_MMA(0, 0, At, B0); PG8_MMA(0, 1, At, B1); PG8_BAR; PG8_SCHED;
            PG8_LDA(At, 0, 1); PG8_STAGE(PG8_SB(0, 0), b2, voffB); PG8_STAGE(PG8_SB(0, 1), b2 + hstepB, voffB); PG8_STAGE(PG8_SA(0, 0), a2, voffA);
            PG8_WAIT_V(8); PG8_WAIT_L(0); PG8_BAR; PG8_MMA(1, 0, At, B0); PG8_MMA(1, 1, At, B1); PG8_BAR; PG8_SCHED;
            PG8_LDB(B0, 1, 0); PG8_LDB(B1, 1, 1); PG8_SCHED; PG8_LDA(At, 1, 0); PG8_STAGE(PG8_SA(0, 1), a2 + hstepA, voffA);
            PG8_WAIT_V(8); PG8_WAIT_L(0); PG8_BAR; PG8_MMA(0, 0, At, B0); PG8_MMA(0, 1, At, B1); PG8_BAR; PG8_SCHED;
            PG8_LDA(At, 1, 1); PG8_STAGE(PG8_SB(1, 0), b3, voffB); PG8_STAGE(PG8_SB(1, 1), b3 + hstepB, voffB); PG8_STAGE(PG8_SA(1, 0), a3, voffA);
            PG8_WAIT_V(8); PG8_WAIT_L(0); PG8_BAR; PG8_MMA(1, 0, At, B0); PG8_MMA(1, 1, At, B1); PG8_BAR; PG8_SCHED;
        }
        if (wr == 0) PG8_BAR;
        if constexpr (FP8) asm volatile("s_nop 15\n\ts_nop 15" ::: "memory");
        E(acc, cur, wr, wc, fr, fq);
        if (!has_next) break;
#pragma unroll
        for (int a = 0; a < 2; ++a)
#pragma unroll
            for (int b = 0; b < 2; ++b)
#pragma unroll
                for (int m = 0; m < 4; ++m)
#pragma unroll
                    for (int n = 0; n < 2; ++n) acc[a][b][m][n] = (f32x4){0.f, 0.f, 0.f, 0.f};
        cur = nxt; cA = nA; cB = nB; ++ui;
        if (wr == 1) PG8_BAR;
    }
    PG8_WAIT_V(0);
    PG8_BAR;
#undef PG8_SA
#undef PG8_SB
#undef PG8_STAGE
#undef PG8_LDA
#undef PG8_LDB
#undef PG8_MMA
#undef PG8_H0
#undef PG8_H1
#undef PG8_LD32
#undef PG8_WAIT_V
#undef PG8_WAIT_L
#undef PG8_BAR
#undef PG8_SCHED
}
template <class Epi, class Sched> __device__ __forceinline__ void gemm_phase(LAS unsigned char* lds, const Gemm g, const Sched& S, const Epi& E) { gemm_phase_t<false, 0>(lds, g, S, E); }
}

struct SchedPlain {
    pg8::TileOrder T; int G, c; size_t tA, tB;
    __device__ __forceinline__ void init(int nM, int nN, int lda, int ldb, int G_, int c_) { T.init(nM, nN); G = G_; c = c_; tA = (size_t)256 * lda * 2; tB = (size_t)256 * ldb * 2; }
    __device__ __forceinline__ bool next(int i, pg8::Unit& u) const { if (!T.map((long)i * G + c, u.pm, u.pn)) return false; u.z = 0; u.offA = u.pm * tA; u.offB = u.pn * tB; return true; }
};
struct SchedBatch {
    int nM, nN, nZ, G, c; size_t tA, tB, zA, zB;
    __device__ __forceinline__ bool next(int i, pg8::Unit& u) const {
        const long L = (long)i * G + c; const int per = nM * nN; if (L >= (long)per * nZ) return false;
        const int z = __builtin_amdgcn_readfirstlane((int)(L / per)), r = __builtin_amdgcn_readfirstlane((int)(L % per)); u.z = z; u.pm = __builtin_amdgcn_readfirstlane(r / nN); u.pn = __builtin_amdgcn_readfirstlane(r % nN); u.offA = z * zA + u.pm * tA; u.offB = z * zB + u.pn * tB; return true; }
};
struct SchedBranch {
    pg8::TileOrder T; int G, c; size_t tA, tB, zA, zB;
    __device__ __forceinline__ bool next(int i, pg8::Unit& u) const { const int t = i / 3, z = i - 3 * t; if (!T.map((long)t * G + c, u.pm, u.pn)) return false; u.z = z; u.offA = z * zA + u.pm * tA; u.offB = z * zB + u.pn * tB; return true; }
};
struct SchedMoe {
    pg8::TileOrder T; int G, c; size_t tA, tB, zB; int off[7];
    __device__ __forceinline__ bool next(int i, pg8::Unit& u) const {
        if (!T.map((long)i * G + c, u.pm, u.pn)) return false; const int r0 = u.pm * 256; int e = 0;
#pragma unroll
        for (int k = 0; k < 7; ++k) e += (r0 >= off[k]) ? 1 : 0;
        e = __builtin_amdgcn_readfirstlane(e); u.z = e; u.offA = u.pm * tA; u.offB = e * zB + u.pn * tB; return true; }
};

#define EPI_ARGS const f32x4 (&acc)[2][2][4][2], const pg8::Unit& u, int wr, int wc, int fr, int fq
#define EPI_ROW(ai, m) (u.pm * 256 + (ai) * 128 + wr * 64 + (m) * 16 + fr)
#define EPI_CB(bj) ((bj) * 128 + wc * 32 + fq * 8)
#define FOR_AI_M _Pragma("unroll") for (int ai = 0; ai < 2; ++ai) _Pragma("unroll") for (int m = 0; m < 4; ++m)
#define FOR_BJ _Pragma("unroll") for (int bj = 0; bj < 2; ++bj)

__device__ __forceinline__ void rope4(f32x4& v0, f32x4& v1, const f32x4 t0, const f32x4 t1) {
    const float a0 = v0[0] * t0[0] - v0[1] * t0[1], b0 = v0[1] * t0[0] + v0[0] * t0[1];
    const float a1 = v0[2] * t0[2] - v0[3] * t0[3], b1 = v0[3] * t0[2] + v0[2] * t0[3];
    const float a2 = v1[0] * t1[0] - v1[1] * t1[1], b2 = v1[1] * t1[0] + v1[0] * t1[1];
    const float a3 = v1[2] * t1[2] - v1[3] * t1[3], b3 = v1[3] * t1[2] + v1[2] * t1[3];
    v0 = (f32x4){a0, b0, a1, b1}; v1 = (f32x4){a2, b2, a3, b3};
}

struct EpiInProj {
    bf16_t *QD, *KD, *VD, *MQ, *MKV, *KM, *SU, *GATES; float *ssq_q, *ssq_kv; const float* tabd; const float* tabm;
    int pn_add;
    __device__ __forceinline__ void operator()(EPI_ARGS) const {
        const int pn = u.pn + pn_add;
        if (pn < 8) {
            bf16_t* O = pn < 4 ? QD : KD; const float sc = pn < 4 ? C2_DIFF : 1.f; const int colt = (pn & 3) * 256;
            const bool rp = ((wc & 1) == 0) && fq < 2;
#pragma unroll
            for (int ai = 0; ai < 2; ++ai) { f32x4 tt[4][2];
#pragma unroll
                for (int m = 0; m < 4; ++m) { tt[m][0] = (f32x4){1.f, 0.f, 1.f, 0.f}; tt[m][1] = (f32x4){1.f, 0.f, 1.f, 0.f};
                    if (rp) { const f32x4* tp = (const f32x4*)(tabd + (size_t)EPI_ROW(ai, m) * 16 + fq * 8); tt[m][0] = tp[0]; tt[m][1] = tp[1]; } }
#pragma unroll
                for (int m = 0; m < 4; ++m) { const int row = EPI_ROW(ai, m);
                    FOR_BJ { f32x4 v0 = acc[ai][bj][m][0], v1 = acc[ai][bj][m][1]; rope4(v0, v1, tt[m][0], tt[m][1]); v0 = v0 * sc; v1 = v1 * sc;
                        *(u32x4*)(O + (size_t)row * 1024 + colt + EPI_CB(bj)) = pack8(v0, v1); } } }
        } else if (pn < 12) {
            const int colt = (pn - 8) * 256;
            FOR_AI_M { const int row = EPI_ROW(ai, m); FOR_BJ { *(u32x4*)(VD + (size_t)row * 1024 + colt + EPI_CB(bj)) = pack8(acc[ai][bj][m][0], acc[ai][bj][m][1]); } }
        } else if (pn < 15) {
            bf16_t* O = pn < 14 ? MQ : MKV; const int ld = pn < 14 ? 512 : 256, colt = pn < 14 ? (pn - 12) * 256 : 0; float* ssq = pn < 14 ? ssq_q + (pn - 12) * 4 + wc : ssq_kv + wc; const int ns = pn < 14 ? 8 : 4;
            FOR_AI_M { const int row = EPI_ROW(ai, m); float s = 0.f;
                FOR_BJ { const f32x4 v0 = acc[ai][bj][m][0], v1 = acc[ai][bj][m][1]; s += (v0[0] * v0[0] + v0[1] * v0[1]) + (v0[2] * v0[2] + v0[3] * v0[3]) + (v1[0] * v1[0] + v1[1] * v1[1]) + (v1[2] * v1[2] + v1[3] * v1[3]);
                    *(u32x4*)(O + (size_t)row * ld + colt + EPI_CB(bj)) = pack8(v0, v1); }
                s += shflx(s, 16, fq * 16 + fr); s += shflx(s, 32, fq * 16 + fr);
                if (fq == 0) ssq[(size_t)row * ns] = s; }
        } else if (pn == 15) {
            if (wc < 2) {
                FOR_AI_M { const int row = EPI_ROW(ai, m); const f32x4* tp = (const f32x4*)(tabm + (size_t)row * 64 + (wc * 16 + fq * 4) * 2);
                    f32x4 v0 = acc[ai][0][m][0], v1 = acc[ai][0][m][1]; rope4(v0, v1, tp[0], tp[1]); const u32x4 w = pack8(v0, v1);
#pragma unroll
                    for (int h = 0; h < 8; ++h) *(u32x4*)(KM + (size_t)row * 1536 + h * 192 + 128 + wc * 32 + fq * 8) = w; }
            }
        } else if (pn < 20) {
            FOR_AI_M { const int row = EPI_ROW(ai, m); const int c = row >> 5, j = row & 31;
                FOR_BJ { const int ch = (pn - 16) * 256 + EPI_CB(bj), g = ch >> 4, q = ch & 15;
                    *(u32x4*)(SU + ((size_t)(g * SSM_NCH + c) * SSM_KX + j * 16 + q)) = pack8(acc[ai][bj][m][0], acc[ai][bj][m][1]); } }
        } else {
            const int colt = (pn - 20) * 256;
            FOR_AI_M { const int row = EPI_ROW(ai, m);
                FOR_BJ { f32x4 v0 = acc[ai][bj][m][0], v1 = acc[ai][bj][m][1];
#pragma unroll
                    for (int e = 0; e < 4; ++e) { v0[e] = fast_sigmoid(v0[e]); v1[e] = fast_sigmoid(v1[e]); }
                    *(u32x4*)(GATES + (size_t)row * 6144 + colt + EPI_CB(bj)) = pack8(v0, v1); } }
        }
    }
};
struct EpiQup {
    bf16_t* QM; const float* ssq; const float* tabm;
    __device__ __forceinline__ void operator()(EPI_ARGS) const {
#pragma unroll
        for (int ai = 0; ai < 2; ++ai) { f32x4 sq[4][2];
#pragma unroll
            for (int m = 0; m < 4; ++m) { const int row = EPI_ROW(ai, m); sq[m][0] = *(const f32x4*)(ssq + (size_t)row * 8); sq[m][1] = *(const f32x4*)(ssq + (size_t)row * 8 + 4); }
#pragma unroll
            for (int m = 0; m < 4; ++m) { const int row = EPI_ROW(ai, m); const f32x4 s0 = sq[m][0], s1 = sq[m][1];
                const float rq = __builtin_amdgcn_rsqf((((s0[0] + s0[1]) + (s0[2] + s0[3])) + ((s1[0] + s1[1]) + (s1[2] + s1[3]))) * (1.f / 512.f) + RMS_EPS) * C2_MLA;
                FOR_BJ { const int col = u.pn * 256 + EPI_CB(bj), h = col / 192, hc = col - h * 192; f32x4 v0 = acc[ai][bj][m][0], v1 = acc[ai][bj][m][1];
                    if (hc >= 128) { const f32x4* tp = (const f32x4*)(tabm + (size_t)row * 64 + (hc - 128)); rope4(v0, v1, tp[0], tp[1]); }
                    v0 = v0 * rq; v1 = v1 * rq; *(u32x4*)(QM + (size_t)row * 1536 + col) = pack8(v0, v1); } } }
    }
};
struct EpiKVup {
    bf16_t *KM, *VM; const float* ssq;
    __device__ __forceinline__ void operator()(EPI_ARGS) const {
#pragma unroll
        for (int ai = 0; ai < 2; ++ai) { float rk[4];
#pragma unroll
            for (int m = 0; m < 4; ++m) { const f32x4 s0 = *(const f32x4*)(ssq + (size_t)EPI_ROW(ai, m) * 4); rk[m] = ((s0[0] + s0[1]) + (s0[2] + s0[3])); }
#pragma unroll
            for (int m = 0; m < 4; ++m) { const int row = EPI_ROW(ai, m); const float r = __builtin_amdgcn_rsqf(rk[m] * (1.f / 256.f) + RMS_EPS); const int c = wc * 32 + fq * 8;
                *(u32x4*)(KM + (size_t)row * 1536 + u.pn * 192 + c) = pack8(acc[ai][0][m][0] * r, acc[ai][0][m][1] * r);
                *(u32x4*)(VM + (size_t)row * 1024 + u.pn * 128 + c) = pack8(acc[ai][1][m][0] * r, acc[ai][1][m][1] * r); } }
    }
};
struct EpiSloc {
    float* SLOC;
    __device__ __forceinline__ void operator()(EPI_ARGS) const {
        FOR_AI_M { const int c = EPI_ROW(ai, m); float* o = SLOC + ((size_t)(u.z * SSM_NCH + c) * 128 + wc * 32 + fq * 8);
            *(f32x4*)o = acc[ai][0][m][0]; *(f32x4*)(o + 4) = acc[ai][0][m][1]; }
    }
};
__device__ __forceinline__ float gelu_tanh(float x) { const float t = 1.5957691216057308f * (x + 0.044715f * x * x * x); return x * fast_sigmoid(t); }
struct EpiSsmY {
    bf16_t* YG; const bf16_t* SU; const float* dskip;
    __device__ __forceinline__ void operator()(EPI_ARGS) const {
        const int g = u.z; f32x4 d0[2], d1[2];
        FOR_BJ { const int col = u.pn * 256 + EPI_CB(bj), ch = g * 16 + (col & 15); d0[bj] = *(const f32x4*)(dskip + ch); d1[bj] = *(const f32x4*)(dskip + ch + 4); }
#pragma unroll
        for (int ai = 0; ai < 2; ++ai) { u32x4 uu[4][2];
#pragma unroll
            for (int m = 0; m < 4; ++m) { const int c = EPI_ROW(ai, m);
                FOR_BJ { const int col = u.pn * 256 + EPI_CB(bj), i = col >> 4, p0 = col & 15; uu[m][bj] = *(const u32x4*)(SU + ((size_t)(g * SSM_NCH + c) * SSM_KX + i * 16 + p0)); } }
#pragma unroll
            for (int m = 0; m < 4; ++m) { const int c = EPI_ROW(ai, m);
                FOR_BJ { const int col = u.pn * 256 + EPI_CB(bj), i = col >> 4, p0 = col & 15, t = c * SSM_L + i, ch = g * 16 + p0; const u32x4 w = uu[m][bj];
                    f32x4 v0 = acc[ai][bj][m][0], v1 = acc[ai][bj][m][1];
                    v0[0] += d0[bj][0] * bf_lo(w.x); v0[1] += d0[bj][1] * bf_hi(w.x); v0[2] += d0[bj][2] * bf_lo(w.y); v0[3] += d0[bj][3] * bf_hi(w.y);
                    v1[0] += d1[bj][0] * bf_lo(w.z); v1[1] += d1[bj][1] * bf_hi(w.z); v1[2] += d1[bj][2] * bf_lo(w.w); v1[3] += d1[bj][3] * bf_hi(w.w);
#pragma unroll
                    for (int e = 0; e < 4; ++e) { v0[e] = gelu_tanh(v0[e]); v1[e] = gelu_tanh(v1[e]); }
                    *(u32x4*)(YG + (size_t)t * 1024 + ch) = pack8(v0, v1); } } }
    }
};
template <int ACT  > struct EpiGated {
    bf16_t* O; int ldo;
    __device__ __forceinline__ void operator()(EPI_ARGS) const {
        FOR_AI_M { const int row = EPI_ROW(ai, m); f32x4 r[2];
#pragma unroll
            for (int n = 0; n < 2; ++n)
#pragma unroll
                for (int e = 0; e < 4; ++e) { const float a = acc[ai][0][m][n][e], b = acc[ai][1][m][n][e]; r[n][e] = ACT == 0 ? a * fast_sigmoid(b) : a * fast_sigmoid(a) * b; }
            *(u32x4*)(O + (size_t)row * ldo + u.pn * 128 + wc * 32 + fq * 8) = pack8(r[0], r[1]); }
    }
};
struct EpiSwigluF8 {
    unsigned char* O; int ldo;
    __device__ __forceinline__ void operator()(EPI_ARGS) const {
        FOR_AI_M { const int row = EPI_ROW(ai, m); f32x4 r[2];
#pragma unroll
            for (int n = 0; n < 2; ++n)
#pragma unroll
                for (int e = 0; e < 4; ++e) { const float a = acc[ai][0][m][n][e], b = acc[ai][1][m][n][e]; r[n][e] = a * fast_sigmoid(a) * b; }
            *(u32x2*)(O + (size_t)row * ldo + u.pn * 128 + wc * 32 + fq * 8) = pack8_fp8(r[0], r[1]); }
    }
};
struct EpiGatesF8 {
    bf16_t* GATES;
    __device__ __forceinline__ void operator()(EPI_ARGS) const {
        FOR_AI_M { const int row = EPI_ROW(ai, m);
            FOR_BJ { f32x4 v0 = acc[ai][bj][m][0], v1 = acc[ai][bj][m][1];
#pragma unroll
                for (int e = 0; e < 4; ++e) { v0[e] = fast_sigmoid(v0[e]); v1[e] = fast_sigmoid(v1[e]); }
                *(u32x4*)(GATES + (size_t)row * 6144 + u.pn * 256 + EPI_CB(bj)) = pack8(v0, v1); } }
    }
};
struct EpiBranch {
    const bf16_t* GATES; bf16_t* P; bf16_t* MG;
    __device__ __forceinline__ void operator()(EPI_ARGS) const {
        const int z = u.z;
#pragma unroll
        for (int ai = 0; ai < 2; ++ai)
#pragma unroll
            for (int mh = 0; mh < 2; ++mh) { u32x4 gg[2][2], pa[2][2], pb[2][2];
#pragma unroll
                for (int mm = 0; mm < 2; ++mm) { const int row = EPI_ROW(ai, mh * 2 + mm);
                    FOR_BJ { const int col = u.pn * 256 + EPI_CB(bj); gg[mm][bj] = *(const u32x4*)(GATES + (size_t)row * 6144 + z * 2048 + col);
                        if (z == 2) { const size_t o = (size_t)row * 2048 + col; pa[mm][bj] = *(const u32x4*)(P + o); pb[mm][bj] = *(const u32x4*)(P + (size_t)M * 2048 + o); } } }
#pragma unroll
                for (int mm = 0; mm < 2; ++mm) { const int m = mh * 2 + mm, row = EPI_ROW(ai, m);
                    FOR_BJ { const int col = u.pn * 256 + EPI_CB(bj); const u32x4 g = gg[mm][bj];
                        f32x4 v0 = acc[ai][bj][m][0], v1 = acc[ai][bj][m][1];
                        v0[0] *= bf_lo(g.x); v0[1] *= bf_hi(g.x); v0[2] *= bf_lo(g.y); v0[3] *= bf_hi(g.y);
                        v1[0] *= bf_lo(g.z); v1[1] *= bf_hi(g.z); v1[2] *= bf_lo(g.w); v1[3] *= bf_hi(g.w);
                        const size_t o = (size_t)row * 2048 + col;
                        if (z < 2) *(u32x4*)(P + (size_t)z * M * 2048 + o) = pack8(v0, v1);
                        else { const u32x4 a = pa[mm][bj], b = pb[mm][bj];
                            v0[0] += bf_lo(a.x) + bf_lo(b.x); v0[1] += bf_hi(a.x) + bf_hi(b.x); v0[2] += bf_lo(a.y) + bf_lo(b.y); v0[3] += bf_hi(a.y) + bf_hi(b.y);
                            v1[0] += bf_lo(a.z) + bf_lo(b.z); v1[1] += bf_hi(a.z) + bf_hi(b.z); v1[2] += bf_lo(a.w) + bf_lo(b.w); v1[3] += bf_hi(a.w) + bf_hi(b.w);
                            *(u32x4*)(MG + o) = pack8(v0, v1); } } } }
    }
};
struct EpiResid {
    bf16_t* X;
    __device__ __forceinline__ void operator()(EPI_ARGS) const {
#pragma unroll
        for (int ai = 0; ai < 2; ++ai) { u32x4 r[4][2];
#pragma unroll
            for (int m = 0; m < 4; ++m) { const int row = EPI_ROW(ai, m);
                FOR_BJ { r[m][bj] = *(const u32x4*)(X + (size_t)row * 2048 + u.pn * 256 + EPI_CB(bj)); } }
#pragma unroll
            for (int m = 0; m < 4; ++m) { const int row = EPI_ROW(ai, m);
                FOR_BJ { const u32x4 w = r[m][bj]; f32x4 v0 = acc[ai][bj][m][0], v1 = acc[ai][bj][m][1];
                    v0[0] += ALPHA * bf_lo(w.x); v0[1] += ALPHA * bf_hi(w.x); v0[2] += ALPHA * bf_lo(w.y); v0[3] += ALPHA * bf_hi(w.y);
                    v1[0] += ALPHA * bf_lo(w.z); v1[1] += ALPHA * bf_hi(w.z); v1[2] += ALPHA * bf_lo(w.w); v1[3] += ALPHA * bf_hi(w.w);
                    *(u32x4*)(X + (size_t)row * 2048 + u.pn * 256 + EPI_CB(bj)) = pack8(v0, v1); } } }
    }
};
struct EpiBf16 {
    bf16_t* O; int ldo; float scale;
    __device__ __forceinline__ void operator()(EPI_ARGS) const {
        FOR_AI_M { const int row = EPI_ROW(ai, m); FOR_BJ { *(u32x4*)(O + (size_t)row * ldo + u.pn * 256 + EPI_CB(bj)) = pack8(acc[ai][bj][m][0] * scale, acc[ai][bj][m][1] * scale); } }
    }
};
struct EpiBf16Half {
    bf16_t* O; int ldo; float scale;
    __device__ __forceinline__ void operator()(EPI_ARGS) const {
#pragma unroll
        for (int m = 0; m < 4; ++m) { const int row = u.pm * 128 + wr * 64 + m * 16 + fr;
            FOR_BJ { *(u32x4*)(O + (size_t)row * ldo + u.pn * 256 + EPI_CB(bj)) = pack8(acc[0][bj][m][0] * scale, acc[0][bj][m][1] * scale); } }
    }
};
struct EpiMoeDown {
    float* OG; const float* wslot;
    __device__ __forceinline__ void operator()(EPI_ARGS) const {
        float w[2][4];
        FOR_AI_M w[ai][m] = wslot[EPI_ROW(ai, m)];
        FOR_AI_M { const int row = EPI_ROW(ai, m);
            FOR_BJ { float* o = OG + (size_t)row * 2048 + u.pn * 256 + EPI_CB(bj); *(f32x4*)o = acc[ai][bj][m][0] * w[ai][m]; *(f32x4*)(o + 4) = acc[ai][bj][m][1] * w[ai][m]; } }
    }
};

namespace att {
constexpr int KVBLK = 64, SHM_V = KVBLK * 128 * 2;
constexpr float THRL = 8.f;
__device__ __forceinline__ int crow(int r, int hi) { return (r & 3) + 8 * (r >> 2) + 4 * hi; }
template <int PITCH> __device__ __forceinline__ int kfl(int row) { return (PITCH % 256 == 128) ? ((row >> 1) & 7) : (row & 15); }
template <int PITCH> __device__ __forceinline__ int kswz(int row, int colB) { return row * PITCH + (colB ^ (kfl<PITCH>(row) << 4)); }
__device__ __forceinline__ int v_st(int k, int c) { const int kk = k; return ((kk >> 3) * 4 + (c >> 5)) * 512 + ((kk & 7) * 32 + (c & 31)) * 2; }
__device__ __forceinline__ int v_rd_base(int lane) { return ((lane & 3) << 3) | (((lane >> 2) & 3) << 6) | (((lane >> 4) & 1) << 5) | (((lane >> 5) & 1) << 8); }
constexpr int v_rd_off(int d0, int ks, int half) { return d0 * 512 + ks * 4096 + half * 2048; }

__device__ __forceinline__ void mask_tile(f32x16& p0, f32x16& p1, int dq) {
    const float NEG = -__builtin_inff();
#pragma unroll
    for (int r = 0; r < 16; ++r) { const int c = (r & 3) + 8 * (r >> 2); if (dq - c < 0) p0[r] = NEG; if (dq - c - 32 < 0) p1[r] = NEG; }
}
__device__ __forceinline__ void partialSM(f32x16& p0, f32x16& p1, float& m_reg, float& alpha) {
    float pmax = p0[0];
#pragma unroll
    for (int r = 1; r < 16; ++r) pmax = fmaxf(pmax, p0[r]);
#pragma unroll
    for (int r = 0; r < 16; ++r) pmax = fmaxf(pmax, p1[r]);
    { auto rr = __builtin_amdgcn_permlane32_swap(__float_as_uint(pmax), __float_as_uint(pmax), false, false); pmax = fmaxf(__uint_as_float(rr[0]), __uint_as_float(rr[1])); }
    float mn;
    if (__builtin_expect(__all(pmax - m_reg <= THRL), 1)) { mn = m_reg; alpha = 1.f; }
    else { mn = fmaxf(m_reg, pmax); alpha = __builtin_amdgcn_exp2f(m_reg - mn); m_reg = mn; }
#pragma unroll
    for (int r = 0; r < 16; ++r) { p0[r] -= mn; p1[r] -= mn; }
#pragma unroll
    for (int r = 0; r < 16; ++r) p0[r] = __builtin_amdgcn_exp2f(p0[r]);
}
__device__ __forceinline__ void finishSM(f32x16& p0, f32x16& p1, float alpha, float& l_reg, bf16x8& pa0, bf16x8& pa1, bf16x8& pa2, bf16x8& pa3) {
#pragma unroll
    for (int r = 0; r < 16; ++r) p1[r] = __builtin_amdgcn_exp2f(p1[r]);
    float ps = 0;
#pragma unroll
    for (int r = 0; r < 16; ++r) ps += p0[r];
#pragma unroll
    for (int r = 0; r < 16; ++r) ps += p1[r];
    { auto rr = __builtin_amdgcn_permlane32_swap(__float_as_uint(ps), __float_as_uint(ps), false, false); ps = __uint_as_float(rr[0]) + __uint_as_float(rr[1]); }
    l_reg = l_reg * alpha + ps;
#define PK4(P, B_, OUT) do { unsigned a0 = cvt_pk_bf16(P[B_+0], P[B_+1]), a1 = cvt_pk_bf16(P[B_+2], P[B_+3]); unsigned b0 = cvt_pk_bf16(P[B_+4], P[B_+5]), b1 = cvt_pk_bf16(P[B_+6], P[B_+7]); \
        u32x4 w = {a0, a1, b0, b1}; OUT = *reinterpret_cast<bf16x8*>(&w); } while (0)
    PK4(p0, 0, pa0); PK4(p0, 8, pa1); PK4(p1, 0, pa2); PK4(p1, 8, pa3);
#undef PK4
}
template <int PITCH, int ND0>
__device__ __forceinline__ void qkt(f32x16& p0, f32x16& p1, const char* Kb, int r32, int hi, int kch0, const bf16x8* qr) {
    p0 = f32x16{}; p1 = f32x16{};
    const char* kb[4];
#pragma unroll
    for (int dd = 0; dd < 4; ++dd) kb[dd] = Kb + kswz<PITCH>(r32, (kch0 + dd * 2 + hi) * 16);
#pragma unroll
    for (int d0 = 0; d0 < ND0; ++d0) { const char* a = (PITCH % 256 == 0) ? Kb + kswz<PITCH>(r32, (kch0 + d0 * 2 + hi) * 16) : kb[d0 & 3] + (d0 >> 2) * 128;
        const bf16x8 b0 = *reinterpret_cast<const bf16x8*>(a);
        const bf16x8 b1 = *reinterpret_cast<const bf16x8*>(a + 32 * PITCH);
        p0 = __builtin_amdgcn_mfma_f32_32x32x16_bf16(b0, qr[d0], p0, 0, 0, 0);
        p1 = __builtin_amdgcn_mfma_f32_32x32x16_bf16(b1, qr[d0], p1, 0, 0, 0); }
}
__device__ __forceinline__ void pv_tile(f32x16* o, int vb0, bf16x8 pa0, bf16x8 pa1, bf16x8 pa2, bf16x8 pa3) {
    s16x4 va[8], vb[8];
#define TRRD(dst, off) asm volatile("ds_read_b64_tr_b16 %0, %1 offset:%2" : "=&v"(dst) : "v"(vb0), "i"(off) : "memory")
#define PV_RD(v, d0) do { constexpr int b_ = v_rd_off(d0, 0, 0); TRRD(v[0], b_); TRRD(v[1], b_ + 2048); TRRD(v[2], b_ + 4096); TRRD(v[3], b_ + 6144); TRRD(v[4], b_ + 8192); TRRD(v[5], b_ + 10240); TRRD(v[6], b_ + 12288); TRRD(v[7], b_ + 14336); } while (0)
#define PV_MM(v, d0) do { \
        o[d0] = __builtin_amdgcn_mfma_f32_32x32x16_bf16(pa0, (bf16x8){v[0][0], v[0][1], v[0][2], v[0][3], v[1][0], v[1][1], v[1][2], v[1][3]}, o[d0], 0, 0, 0); \
        o[d0] = __builtin_amdgcn_mfma_f32_32x32x16_bf16(pa1, (bf16x8){v[2][0], v[2][1], v[2][2], v[2][3], v[3][0], v[3][1], v[3][2], v[3][3]}, o[d0], 0, 0, 0); \
        o[d0] = __builtin_amdgcn_mfma_f32_32x32x16_bf16(pa2, (bf16x8){v[4][0], v[4][1], v[4][2], v[4][3], v[5][0], v[5][1], v[5][2], v[5][3]}, o[d0], 0, 0, 0); \
        o[d0] = __builtin_amdgcn_mfma_f32_32x32x16_bf16(pa3, (bf16x8){v[6][0], v[6][1], v[6][2], v[6][3], v[7][0], v[7][1], v[7][2], v[7][3]}, o[d0], 0, 0, 0); } while (0)
#define PV_W8(v) asm volatile("s_waitcnt lgkmcnt(8)" : "+v"(v[0]), "+v"(v[1]), "+v"(v[2]), "+v"(v[3]), "+v"(v[4]), "+v"(v[5]), "+v"(v[6]), "+v"(v[7]) :: "memory")
#define PV_W0(v) asm volatile("s_waitcnt lgkmcnt(0)" : "+v"(v[0]), "+v"(v[1]), "+v"(v[2]), "+v"(v[3]), "+v"(v[4]), "+v"(v[5]), "+v"(v[6]), "+v"(v[7]) :: "memory")
    PV_RD(va, 0); PV_RD(vb, 1); PV_W8(va); SBAR(); PV_MM(va, 0);
    PV_RD(va, 2); PV_W8(vb); SBAR(); PV_MM(vb, 1);
    PV_RD(vb, 3); PV_W8(va); SBAR(); PV_MM(va, 2);
    PV_W0(vb); SBAR(); PV_MM(vb, 3);
#undef PV_W0
#undef PV_W8
#undef PV_MM
#undef PV_RD
#undef TRRD
}

template <int KT, int ND0, bool CAUSAL, bool PIPE>
__device__ __forceinline__ void attn_core(const bf16_t* Qlane, const bf16_t* __restrict__ Kh, int ldk, const bf16_t* __restrict__ Vh, int ldv, int NT, int qpos, int qlo, int kch0,
                                          char* lds, f32x16 (&o)[4], float& l_reg) {
    constexpr int PITCH = KT * 2, SHM_K = KVBLK * PITCH, NKL = KT / 64, CPR = KT / 8;
    const int tid = opaque_tid(), wid = __builtin_amdgcn_readfirstlane(tid >> 6), lane = tid & 63, r32 = lane & 31, hi = lane >> 5;
    char* V_lds = lds; char* K_lds = lds + 2 * SHM_V;
    float* ws = (float*)(lds + 2 * SHM_V + 2 * SHM_K) + wid * 64; float* al_l = ws + 32;
    float m_reg = -1e30f; l_reg = 0.f;
#pragma unroll
    for (int d = 0; d < 4; ++d) o[d] = f32x16{};
    bf16x8 qr[ND0];
#pragma unroll
    for (int d0 = 0; d0 < ND0; ++d0) qr[d0] = *reinterpret_cast<const bf16x8*>(Qlane + d0 * 16);
    const int sr = tid >> 4, sc = (tid & 15) * 8, vst0 = v_st(sr, sc), vst1 = v_st(32 + sr, sc);
    const int vb0 = (int)(uintptr_t)V_lds + v_rd_base(lane);
    int krow[NKL], kcc[NKL];
#pragma unroll
    for (int i = 0; i < NKL; ++i) { const int cid = tid + 512 * i; krow[i] = cid / CPR; kcc[i] = cid - krow[i] * CPR; }
    bf16x8 st_v0, st_v1, st_k[NKL];
#define SLOAD(k0) do { st_v0 = *reinterpret_cast<const bf16x8*>(Vh + (size_t)((k0) + sr) * ldv + sc); st_v1 = *reinterpret_cast<const bf16x8*>(Vh + (size_t)((k0) + 32 + sr) * ldv + sc); \
        _Pragma("unroll") for (int i_ = 0; i_ < NKL; ++i_) st_k[i_] = *reinterpret_cast<const bf16x8*>(Kh + (size_t)((k0) + krow[i_]) * ldk + kcc[i_] * 8); } while (0)
#define SWRITE(b) do { *(bf16x8*)(V_lds + (b) * SHM_V + vst0) = st_v0; *(bf16x8*)(V_lds + (b) * SHM_V + vst1) = st_v1; \
        _Pragma("unroll") for (int i_ = 0; i_ < NKL; ++i_) *(bf16x8*)(K_lds + (b) * SHM_K + kswz<PITCH>(krow[i_], kcc[i_] * 16)) = st_k[i_]; } while (0)
#define RESC(a) do { if (__any((a) < 1.f)) { if (hi == 0) al_l[r32] = (a); asm volatile("s_waitcnt lgkmcnt(0)" ::: "memory"); \
        _Pragma("unroll") for (int d_ = 0; d_ < 4; ++d_) _Pragma("unroll") for (int r = 0; r < 16; ++r) o[d_][r] *= al_l[crow(r, hi)]; } } while (0)
#define MASKT(P0_, P1_, t) do { if (CAUSAL) { const int kb_ = (t) * KVBLK; if (kb_ + KVBLK - 1 > qlo) mask_tile(P0_, P1_, qpos - kb_ - 4 * hi); } } while (0)
    if constexpr (PIPE) {
    f32x16 pA0, pA1, pB0, pB1; float alA, alB; bf16x8 pa0, pa1, pa2, pa3;
    SLOAD(0); VM_WAIT(); SWRITE(0); __syncthreads();
    qkt<PITCH, ND0>(pA0, pA1, K_lds, r32, hi, kch0, qr); MASKT(pA0, pA1, 0); partialSM(pA0, pA1, m_reg, alA);
    SLOAD(KVBLK); VM_WAIT(); SWRITE(1); __syncthreads();
    for (int j = 1; j + 1 < NT; j += 2) {
        SBAR(); qkt<PITCH, ND0>(pB0, pB1, K_lds + SHM_K, r32, hi, kch0, qr);
        finishSM(pA0, pA1, alA, l_reg, pa0, pa1, pa2, pa3); SBAR();
        SLOAD((j + 1) * KVBLK); SBAR();
        pv_tile(o, vb0, pa0, pa1, pa2, pa3); MASKT(pB0, pB1, j); partialSM(pB0, pB1, m_reg, alB);
        __syncthreads(); VM_WAIT(); SWRITE(0);
        RESC(alB); __syncthreads();
        SBAR(); qkt<PITCH, ND0>(pA0, pA1, K_lds, r32, hi, kch0, qr);
        finishSM(pB0, pB1, alB, l_reg, pa0, pa1, pa2, pa3); SBAR();
        SLOAD((j + 2) * KVBLK); SBAR();
        pv_tile(o, vb0 + SHM_V, pa0, pa1, pa2, pa3); MASKT(pA0, pA1, j + 1); partialSM(pA0, pA1, m_reg, alA);
        __syncthreads(); VM_WAIT(); SWRITE(1);
        RESC(alA); __syncthreads();
    }
    SBAR(); qkt<PITCH, ND0>(pB0, pB1, K_lds + SHM_K, r32, hi, kch0, qr);
    finishSM(pA0, pA1, alA, l_reg, pa0, pa1, pa2, pa3); SBAR();
    pv_tile(o, vb0, pa0, pa1, pa2, pa3); MASKT(pB0, pB1, NT - 1); partialSM(pB0, pB1, m_reg, alB);
    RESC(alB);
    finishSM(pB0, pB1, alB, l_reg, pa0, pa1, pa2, pa3); SBAR();
    pv_tile(o, vb0 + SHM_V, pa0, pa1, pa2, pa3);
    } else {
    f32x16 p0, p1; float al; bf16x8 pa0, pa1, pa2, pa3;
    SLOAD(0); VM_WAIT(); SWRITE(0); __syncthreads();
    for (int t = 0; t < NT; t += 2) {
        SBAR(); SLOAD((t + 1) * KVBLK); SBAR();
        qkt<PITCH, ND0>(p0, p1, K_lds, r32, hi, kch0, qr); MASKT(p0, p1, t); partialSM(p0, p1, m_reg, al); RESC(al);
        finishSM(p0, p1, al, l_reg, pa0, pa1, pa2, pa3); SBAR();
        pv_tile(o, vb0, pa0, pa1, pa2, pa3);
        VM_WAIT(); SWRITE(1); __syncthreads();
        SBAR(); if (t + 2 < NT) SLOAD((t + 2) * KVBLK); SBAR();
        qkt<PITCH, ND0>(p0, p1, K_lds + SHM_K, r32, hi, kch0, qr); MASKT(p0, p1, t + 1); partialSM(p0, p1, m_reg, al); RESC(al);
        finishSM(p0, p1, al, l_reg, pa0, pa1, pa2, pa3); SBAR();
        pv_tile(o, vb0 + SHM_V, pa0, pa1, pa2, pa3);
        if (t + 2 < NT) { VM_WAIT(); SWRITE(0); } __syncthreads();
    }
    }
#undef SLOAD
#undef SWRITE
#undef RESC
#undef MASKT
}

template <bool NEGM = true>
__device__ __forceinline__ void partialSM_rel(f32x16& p0, f32x16& p1, float& m_reg, f32x16& negm, float& alpha, bool first) {
    float pmax = p0[0];
#pragma unroll
    for (int r = 1; r < 16; ++r) pmax = fmaxf(pmax, p0[r]);
#pragma unroll
    for (int r = 0; r < 16; ++r) pmax = fmaxf(pmax, p1[r]);
    { auto rr = __builtin_amdgcn_permlane32_swap(__float_as_uint(pmax), __float_as_uint(pmax), false, false); pmax = fmaxf(__uint_as_float(rr[0]), __uint_as_float(rr[1])); }
    if (__builtin_expect(!first && __all(pmax <= THRL), 1)) { alpha = 1.f; }
    else { const float dl = first ? pmax : fmaxf(pmax, 0.f); alpha = first ? 1.f : __builtin_amdgcn_exp2f(-dl); m_reg += dl;
#pragma unroll
        for (int r = 0; r < 16; ++r) { p0[r] -= dl; p1[r] -= dl; }
        if constexpr (NEGM) {
#pragma unroll
            for (int r = 0; r < 16; ++r) negm[r] = -m_reg; } }
#pragma unroll
    for (int r = 0; r < 16; ++r) p0[r] = __builtin_amdgcn_exp2f(p0[r]);
}
template <int PITCH, int ND0>
__device__ __forceinline__ void qkt_rel(f32x16& p0, f32x16& p1, const char* Kb, int r32, int hi, int kch0, const bf16x8* qr, const f32x16& negm) {
    const char* kb[4];
#pragma unroll
    for (int dd = 0; dd < 4; ++dd) kb[dd] = Kb + kswz<PITCH>(r32, (kch0 + dd * 2 + hi) * 16);
#pragma unroll
    for (int d0 = 0; d0 < ND0; ++d0) { const char* a = (PITCH % 256 == 0) ? Kb + kswz<PITCH>(r32, (kch0 + d0 * 2 + hi) * 16) : kb[d0 & 3] + (d0 >> 2) * 128;
        const bf16x8 b0 = *reinterpret_cast<const bf16x8*>(a);
        const bf16x8 b1 = *reinterpret_cast<const bf16x8*>(a + 32 * PITCH);
        p0 = __builtin_amdgcn_mfma_f32_32x32x16_bf16(b0, qr[d0], d0 == 0 ? negm : p0, 0, 0, 0);
        p1 = __builtin_amdgcn_mfma_f32_32x32x16_bf16(b1, qr[d0], d0 == 0 ? negm : p1, 0, 0, 0); }
}

template <int PITCH, int ND0, int PF>
__device__ __forceinline__ void qkt_rel_pf(f32x16& p0, f32x16& p1, const char* Kb, int r32, int hi, int kch0, const bf16x8* qr, const f32x16& negm_) {
    static_assert(PITCH % 256 == 128 || ND0 <= 4, "the +128 B immediate offsets need the 3-bit swizzle");
    f32x16 negm = negm_;
    int kb[4];
#pragma unroll
    for (int dd = 0; dd < 4; ++dd) kb[dd] = (int)(uintptr_t)Kb + kswz<PITCH>(r32, (kch0 + dd * 2 + hi) * 16);
    bf16x8 f[PF + 1][2];
#define KRD(d) do { asm volatile("ds_read_b128 %0, %1 offset:%2" : "=v"(f[(d) % (PF + 1)][0]) : "v"(kb[(d) & 3]), "i"(((d) >> 2) * 128)); \
                    asm volatile("ds_read_b128 %0, %1 offset:%2" : "=v"(f[(d) % (PF + 1)][1]) : "v"(kb[(d) & 3]), "i"(((d) >> 2) * 128 + 32 * PITCH)); } while (0)
#pragma unroll
    for (int d = 0; d < PF && d < ND0; ++d) KRD(d);
#pragma unroll
    for (int d0 = 0; d0 < ND0; ++d0) {
        if (d0 + PF < ND0) KRD(d0 + PF);
        const int ahead = (d0 + PF < ND0 ? PF : ND0 - 1 - d0) * 2;
        if (ahead >= 4) asm volatile("s_waitcnt lgkmcnt(4)" : "+v"(f[d0 % (PF + 1)][0]), "+v"(f[d0 % (PF + 1)][1]));
        else if (ahead == 2) asm volatile("s_waitcnt lgkmcnt(2)" : "+v"(f[d0 % (PF + 1)][0]), "+v"(f[d0 % (PF + 1)][1]));
        else asm volatile("s_waitcnt lgkmcnt(0)" : "+v"(f[d0 % (PF + 1)][0]), "+v"(f[d0 % (PF + 1)][1]));
        p0 = __builtin_amdgcn_mfma_f32_32x32x16_bf16(f[d0 % (PF + 1)][0], qr[d0], d0 == 0 ? negm : p0, 0, 0, 0);
        p1 = __builtin_amdgcn_mfma_f32_32x32x16_bf16(f[d0 % (PF + 1)][1], qr[d0], d0 == 0 ? negm : p1, 0, 0, 0);
    }
#undef KRD
}

template <int PITCH, int ND0>
__device__ __forceinline__ void pv_qk(f32x16* o, int vb0, bf16x8 pa0, bf16x8 pa1, bf16x8 pa2, bf16x8 pa3,
                                      f32x16& p0, f32x16& p1, const char* Kb, int r32, int hi, int kch0, const bf16x8* qr, const f32x16& negm_) {
    constexpr int PF = 2;
    static_assert(PITCH % 256 == 128 || ND0 <= 4, "the +128 B immediate offsets need the 3-bit swizzle");
    f32x16 negm = negm_;
    s16x4 va[8], vb[8];
    int kb[4];
#pragma unroll
    for (int dd = 0; dd < 4; ++dd) kb[dd] = (int)(uintptr_t)Kb + kswz<PITCH>(r32, (kch0 + dd * 2 + hi) * 16);
    bf16x8 f[PF + 1][2];
#define TRRD(dst, off) asm volatile("ds_read_b64_tr_b16 %0, %1 offset:%2" : "=&v"(dst) : "v"(vb0), "i"(off) : "memory")
#define PV_RD(v, d0) do { constexpr int b_ = v_rd_off(d0, 0, 0); TRRD(v[0], b_); TRRD(v[1], b_ + 2048); TRRD(v[2], b_ + 4096); TRRD(v[3], b_ + 6144); TRRD(v[4], b_ + 8192); TRRD(v[5], b_ + 10240); TRRD(v[6], b_ + 12288); TRRD(v[7], b_ + 14336); } while (0)
#define PV_MM(v, d0) do { \
        o[d0] = __builtin_amdgcn_mfma_f32_32x32x16_bf16(pa0, (bf16x8){v[0][0], v[0][1], v[0][2], v[0][3], v[1][0], v[1][1], v[1][2], v[1][3]}, o[d0], 0, 0, 0); \
        o[d0] = __builtin_amdgcn_mfma_f32_32x32x16_bf16(pa1, (bf16x8){v[2][0], v[2][1], v[2][2], v[2][3], v[3][0], v[3][1], v[3][2], v[3][3]}, o[d0], 0, 0, 0); \
        o[d0] = __builtin_amdgcn_mfma_f32_32x32x16_bf16(pa2, (bf16x8){v[4][0], v[4][1], v[4][2], v[4][3], v[5][0], v[5][1], v[5][2], v[5][3]}, o[d0], 0, 0, 0); \
        o[d0] = __builtin_amdgcn_mfma_f32_32x32x16_bf16(pa3, (bf16x8){v[6][0], v[6][1], v[6][2], v[6][3], v[7][0], v[7][1], v[7][2], v[7][3]}, o[d0], 0, 0, 0); } while (0)
#define PV_WN(v, n) asm volatile("s_waitcnt lgkmcnt(%8)" : "+v"(v[0]), "+v"(v[1]), "+v"(v[2]), "+v"(v[3]), "+v"(v[4]), "+v"(v[5]), "+v"(v[6]), "+v"(v[7]) : "n"(n) : "memory")
#define KRD(d) do { asm volatile("ds_read_b128 %0, %1 offset:%2" : "=v"(f[(d) % (PF + 1)][0]) : "v"(kb[(d) & 3]), "i"(((d) >> 2) * 128) : "memory"); \
                    asm volatile("ds_read_b128 %0, %1 offset:%2" : "=v"(f[(d) % (PF + 1)][1]) : "v"(kb[(d) & 3]), "i"(((d) >> 2) * 128 + 32 * PITCH) : "memory"); } while (0)
#define PV_RDK(v, ks) do { TRRD(v[0], v_rd_off(0, ks, 0)); TRRD(v[1], v_rd_off(0, ks, 1)); TRRD(v[2], v_rd_off(1, ks, 0)); TRRD(v[3], v_rd_off(1, ks, 1)); \
                            TRRD(v[4], v_rd_off(2, ks, 0)); TRRD(v[5], v_rd_off(2, ks, 1)); TRRD(v[6], v_rd_off(3, ks, 0)); TRRD(v[7], v_rd_off(3, ks, 1)); } while (0)
#define PV_MMK(v, pa) do { \
        o[0] = __builtin_amdgcn_mfma_f32_32x32x16_bf16(pa, (bf16x8){v[0][0], v[0][1], v[0][2], v[0][3], v[1][0], v[1][1], v[1][2], v[1][3]}, o[0], 0, 0, 0); \
        o[1] = __builtin_amdgcn_mfma_f32_32x32x16_bf16(pa, (bf16x8){v[2][0], v[2][1], v[2][2], v[2][3], v[3][0], v[3][1], v[3][2], v[3][3]}, o[1], 0, 0, 0); \
        o[2] = __builtin_amdgcn_mfma_f32_32x32x16_bf16(pa, (bf16x8){v[4][0], v[4][1], v[4][2], v[4][3], v[5][0], v[5][1], v[5][2], v[5][3]}, o[2], 0, 0, 0); \
        o[3] = __builtin_amdgcn_mfma_f32_32x32x16_bf16(pa, (bf16x8){v[6][0], v[6][1], v[6][2], v[6][3], v[7][0], v[7][1], v[7][2], v[7][3]}, o[3], 0, 0, 0); } while (0)
    PV_RDK(va, 0); PV_RDK(vb, 1); PV_WN(va, 8); SBAR(); PV_MMK(va, pa0);
    PV_RDK(va, 2); PV_WN(vb, 8); SBAR(); PV_MMK(vb, pa1);
    PV_RDK(vb, 3); PV_WN(va, 8); SBAR(); PV_MMK(va, pa2);
    KRD(0); KRD(1);
    PV_WN(vb, 4); SBAR(); PV_MMK(vb, pa3);
#undef PV_MMK
#undef PV_RDK
    SBAR();
#pragma unroll
    for (int d0 = 0; d0 < ND0; ++d0) {
        if (d0 + PF < ND0) KRD(d0 + PF);
        const int ahead = (d0 + PF < ND0 ? PF : ND0 - 1 - d0) * 2;
        if (ahead >= 4) asm volatile("s_waitcnt lgkmcnt(4)" : "+v"(f[d0 % (PF + 1)][0]), "+v"(f[d0 % (PF + 1)][1]) :: "memory");
        else if (ahead == 2) asm volatile("s_waitcnt lgkmcnt(2)" : "+v"(f[d0 % (PF + 1)][0]), "+v"(f[d0 % (PF + 1)][1]) :: "memory");
        else asm volatile("s_waitcnt lgkmcnt(0)" : "+v"(f[d0 % (PF + 1)][0]), "+v"(f[d0 % (PF + 1)][1]) :: "memory");
        p0 = __builtin_amdgcn_mfma_f32_32x32x16_bf16(f[d0 % (PF + 1)][0], qr[d0], d0 == 0 ? negm : p0, 0, 0, 0);
        p1 = __builtin_amdgcn_mfma_f32_32x32x16_bf16(f[d0 % (PF + 1)][1], qr[d0], d0 == 0 ? negm : p1, 0, 0, 0);
    }
#undef KRD
#undef PV_WN
#undef PV_MM
#undef PV_RD
#undef TRRD
}

__device__ __forceinline__ void glds16(unsigned lds_addr, const void* sbase, unsigned voff) {
    unsigned keep;
    asm volatile("s_mov_b32 %0, m0\n\ts_mov_b32 m0, %1\n\ts_nop 0\n\tglobal_load_lds_dwordx4 %2, %3\n\ts_mov_b32 m0, %0" : "=&s"(keep) : "s"(lds_addr), "v"(voff), "s"(sbase) : "memory");
}
template <int KT, int ND0, bool CAUSAL>
__device__ __forceinline__ void attn_core_ring(const bf16_t* Qlane, const bf16_t* __restrict__ Kh, int ldk, const bf16_t* __restrict__ Vh, int ldv, int NT, int qpos, int qlo, int kch0,
                                               char* lds, f32x16 (&o)[4], float& l_reg) {
    constexpr int PITCH = KT * 2, SHM_K = KVBLK * PITCH, NKP = SHM_K / 8192, NVP = SHM_V / 8192;
    const int tid = opaque_tid(), wid = __builtin_amdgcn_readfirstlane(tid >> 6), lane = tid & 63, r32 = lane & 31, hi = lane >> 5;
    char* V_lds = lds; char* K_lds = lds + 3 * SHM_V;
    float* ws = (float*)(lds + 3 * SHM_V + 3 * SHM_K) + wid * 64; float* al_l = ws + 32;
    float m_reg = 0.f; l_reg = 0.f; f32x16 negm = f32x16{};
#pragma unroll
    for (int d = 0; d < 4; ++d) o[d] = f32x16{};
    bf16x8 qr[ND0];
#pragma unroll
    for (int d0 = 0; d0 < ND0; ++d0) qr[d0] = *reinterpret_cast<const bf16x8*>(Qlane + d0 * 16);
    const int vb0 = (int)(uintptr_t)V_lds + v_rd_base(lane);
    unsigned koff[NKP], voff[NVP];
#pragma unroll
    for (int i = 0; i < NKP; ++i) { const int a = (wid * NKP + i) * 1024 + lane * 16, row = a / PITCH, cpos = (a - row * PITCH) >> 4, f = kfl<PITCH>(row);
        const int chunk = cpos ^ f; koff[i] = (unsigned)(row * ldk * 2 + chunk * 16); }
#pragma unroll
    for (int i = 0; i < NVP; ++i) { const int a = (wid * NVP + i) * 1024 + lane * 16, sub = a >> 9, rem = a & 511, kk = (sub >> 2) * 8 + (rem >> 6), c = (sub & 3) * 32 + ((rem & 63) >> 1);
        const int k = kk; voff[i] = (unsigned)(k * ldv * 2 + c * 2); }
    const unsigned ldsK = (unsigned)(uintptr_t)K_lds + (unsigned)(wid * NKP) * 1024u, ldsV = (unsigned)(uintptr_t)V_lds + (unsigned)(wid * NVP) * 1024u;
#define DMA_TILE(t, slot) do { const char* kb_ = (const char*)Kh + (size_t)(t) * KVBLK * ldk * 2; const char* vb_ = (const char*)Vh + (size_t)(t) * KVBLK * ldv * 2; \
        _Pragma("unroll") for (int i_ = 0; i_ < NKP; ++i_) glds16(ldsK + (slot) * SHM_K + i_ * 1024, kb_, koff[i_]); \
        _Pragma("unroll") for (int i_ = 0; i_ < NVP; ++i_) glds16(ldsV + (slot) * SHM_V + i_ * 1024, vb_, voff[i_]); } while (0)
#define RING_SYNC(more) do { if (more) asm volatile("s_waitcnt vmcnt(%0)" :: "n"(NKP + NVP) : "memory"); else asm volatile("s_waitcnt vmcnt(0)" ::: "memory"); \
        asm volatile("s_waitcnt lgkmcnt(0)" ::: "memory"); __builtin_amdgcn_s_barrier(); asm volatile("" ::: "memory"); } while (0)
#define RESC(a) do { if (__any((a) < 1.f)) { if (hi == 0) al_l[r32] = (a); asm volatile("s_waitcnt lgkmcnt(0)" ::: "memory"); \
        _Pragma("unroll") for (int d_ = 0; d_ < 4; ++d_) _Pragma("unroll") for (int r = 0; r < 16; ++r) o[d_][r] *= al_l[crow(r, hi)]; } } while (0)
#define MASKT(P0_, P1_, t) do { if (CAUSAL) { const int kb_ = (t) * KVBLK; if (kb_ + KVBLK - 1 > qlo) mask_tile(P0_, P1_, qpos - kb_ - 4 * hi); } } while (0)
    f32x16 p0, p1; float al; bf16x8 pa0, pa1, pa2, pa3;
    asm volatile("s_waitcnt vmcnt(0)" ::: "memory");
#pragma unroll
    for (int d0 = 0; d0 < ND0; ++d0) asm volatile("" : "+v"(qr[d0]));
    DMA_TILE(0, 0); if (NT > 1) DMA_TILE(1, 1);
    RING_SYNC(NT > 1);
    int slot = 0;
    for (int t = 0; t < NT; ++t) {
        const int s2 = slot == 0 ? 2 : slot - 1;
        SBAR(); if (t + 2 < NT) DMA_TILE(t + 2, s2); SBAR();
        qkt_rel_pf<PITCH, ND0, 2>(p0, p1, K_lds + slot * SHM_K, r32, hi, kch0, qr, negm); MASKT(p0, p1, t); partialSM_rel(p0, p1, m_reg, negm, al, t == 0); RESC(al);
        finishSM(p0, p1, al, l_reg, pa0, pa1, pa2, pa3); SBAR();
        pv_tile(o, vb0 + slot * SHM_V, pa0, pa1, pa2, pa3);
        RING_SYNC(t + 2 < NT);
        slot = slot == 2 ? 0 : slot + 1;
    }
#undef DMA_TILE
#undef RING_SYNC
#undef RESC
#undef MASKT
}
template <int KT, int ND0, bool CAUSAL, bool NEGM>
__device__ __forceinline__ void attn_core_pp(const bf16_t* Qlane, const bf16_t* __restrict__ Kh, int ldk, const bf16_t* __restrict__ Vh, int ldv, int NT, int qpos, int qlo, int kch0,
                                             char* lds, f32x16 (&o)[4], float& l_reg) {
    constexpr int PITCH = KT * 2, SHM_K = KVBLK * PITCH, NKP = SHM_K / 8192, NVP = SHM_V / 8192;
    const int tid = opaque_tid(), wid = __builtin_amdgcn_readfirstlane(tid >> 6), lane = tid & 63, r32 = lane & 31, hi = lane >> 5;
    const bool grpB = wid >= 4;
    char* V_lds = lds; char* K_lds = lds + 3 * SHM_V;
    float* ws = (float*)(lds + 3 * SHM_V + 3 * SHM_K) + wid * 64; float* al_l = ws + 32;
    float m_reg = 0.f; l_reg = 0.f; f32x16 negm = f32x16{};
#pragma unroll
    for (int d = 0; d < 4; ++d) o[d] = f32x16{};
    bf16x8 qr[ND0];
#pragma unroll
    for (int d0 = 0; d0 < ND0; ++d0) qr[d0] = *reinterpret_cast<const bf16x8*>(Qlane + d0 * 16);
    const int vb0 = (int)(uintptr_t)V_lds + v_rd_base(lane);
    unsigned koff[NKP], voff[NVP];
#pragma unroll
    for (int i = 0; i < NKP; ++i) { const int a = (wid * NKP + i) * 1024 + lane * 16, row = a / PITCH, cpos = (a - row * PITCH) >> 4, f = kfl<PITCH>(row);
        const int chunk = cpos ^ f; koff[i] = (unsigned)(row * ldk * 2 + chunk * 16); }
#pragma unroll
    for (int i = 0; i < NVP; ++i) { const int a = (wid * NVP + i) * 1024 + lane * 16, sub = a >> 9, rem = a & 511, kk = (sub >> 2) * 8 + (rem >> 6), c = (sub & 3) * 32 + ((rem & 63) >> 1);
        const int k = kk; voff[i] = (unsigned)(k * ldv * 2 + c * 2); }
    const unsigned ldsK = (unsigned)(uintptr_t)K_lds + (unsigned)(wid * NKP) * 1024u, ldsV = (unsigned)(uintptr_t)V_lds + (unsigned)(wid * NVP) * 1024u;
#define DMA_K(t, slot) do { const char* kb_ = (const char*)Kh + (size_t)(t) * KVBLK * ldk * 2; _Pragma("unroll") for (int i_ = 0; i_ < NKP; ++i_) glds16(ldsK + (slot) * SHM_K + i_ * 1024, kb_, koff[i_]); } while (0)
#define DMA_V(t, slot) do { const char* vb_ = (const char*)Vh + (size_t)(t) * KVBLK * ldv * 2; _Pragma("unroll") for (int i_ = 0; i_ < NVP; ++i_) glds16(ldsV + (slot) * SHM_V + i_ * 1024, vb_, voff[i_]); } while (0)
#define ISSUE(u, ksl, vsl) do { if ((u) < NT) DMA_K(u, ksl); if ((u) - 1 < NT) DMA_V((u) - 1, vsl); } while (0)
#define PAIR_WAIT(t) do { if ((t) + 2 < NT) asm volatile("s_waitcnt vmcnt(%0)" :: "n"(NKP + NVP) : "memory"); else if ((t) + 2 == NT) asm volatile("s_waitcnt vmcnt(%0)" :: "n"(NVP) : "memory"); \
        else asm volatile("s_waitcnt vmcnt(0)" ::: "memory"); } while (0)
#define BAR() do { SBAR(); asm volatile("s_waitcnt lgkmcnt(0)" ::: "memory"); __builtin_amdgcn_s_barrier(); asm volatile("" ::: "memory"); SBAR(); } while (0)
#define RESC(a) do { if (__any((a) < 1.f)) { if (hi == 0) al_l[r32] = (a); asm volatile("s_waitcnt lgkmcnt(0)" ::: "memory"); \
        _Pragma("unroll") for (int d_ = 0; d_ < 4; ++d_) _Pragma("unroll") for (int r = 0; r < 16; ++r) o[d_][r] *= al_l[crow(r, hi)]; } } while (0)
#define MASKT(P0_, P1_, t) do { if (CAUSAL) { const int kb_ = (t) * KVBLK; if (kb_ + KVBLK - 1 > qlo) mask_tile(P0_, P1_, qpos - kb_ - 4 * hi); } } while (0)
    f32x16 p0, p1; float al; bf16x8 pa0, pa1, pa2, pa3;
    asm volatile("s_waitcnt vmcnt(0)" ::: "memory");
#pragma unroll
    for (int d0 = 0; d0 < ND0; ++d0) asm volatile("" : "+v"(qr[d0]));
    DMA_K(0, 0);
    if (NT > 1) DMA_K(1, 1);
    DMA_V(0, 0);
    if (NT > 1) asm volatile("s_waitcnt vmcnt(%0)" :: "n"(NKP + NVP) : "memory"); else asm volatile("s_waitcnt vmcnt(%0)" :: "n"(NVP) : "memory");
    BAR();
    if (grpB) { ISSUE(2, 2, 1); BAR(); }
#define QK_(ksl) do { if constexpr (NEGM) qkt_rel_pf<PITCH, ND0, 2>(p0, p1, K_lds + (ksl) * SHM_K, r32, hi, kch0, qr, negm); \
        else { f32x16 c_; const float nm_ = -m_reg; _Pragma("unroll") for (int r = 0; r < 16; ++r) c_[r] = nm_; qkt_rel_pf<PITCH, ND0, 2>(p0, p1, K_lds + (ksl) * SHM_K, r32, hi, kch0, qr, c_); } } while (0)
#define Y_(t_, first_) do { MASKT(p0, p1, t_); partialSM_rel<NEGM>(p0, p1, m_reg, negm, al, first_); RESC(al); finishSM(p0, p1, al, l_reg, pa0, pa1, pa2, pa3); } while (0)
    QK_(0);
    if (grpB) PAIR_WAIT(0);
    BAR();
    if (grpB) ISSUE(3, 0, 2); else ISSUE(2, 2, 1);
    SBAR();
    Y_(0, true);
    if (!grpB) PAIR_WAIT(0);
    BAR();
    int ks = 1;
    for (int t = 1; t < NT; ++t) {
        const int kp = ks == 0 ? 2 : ks - 1, kn = ks == 2 ? 0 : ks + 1;
        if constexpr (NEGM) pv_qk<PITCH, ND0>(o, vb0 + kp * SHM_V, pa0, pa1, pa2, pa3, p0, p1, K_lds + ks * SHM_K, r32, hi, kch0, qr, negm);
        else { f32x16 c_; const float nm_ = -m_reg; _Pragma("unroll") for (int r = 0; r < 16; ++r) c_[r] = nm_; pv_qk<PITCH, ND0>(o, vb0 + kp * SHM_V, pa0, pa1, pa2, pa3, p0, p1, K_lds + ks * SHM_K, r32, hi, kch0, qr, c_); }
#ifdef PROBE_XMFMA
        if constexpr (ND0 == 4) { f32x16 dz_ = f32x16{}; _Pragma("unroll") for (int i_ = 0; i_ < PROBE_XMFMA; ++i_) asm volatile("v_mfma_f32_32x32x16_bf16 %0, %1, %2, %0" : "+v"(dz_) : "v"(qr[0]), "v"(qr[1])); asm volatile("s_nop 15\n\ts_nop 15" :: "v"(dz_)); }
#endif
        if (grpB) PAIR_WAIT(t);
        BAR();
        if (grpB) ISSUE(t + 3, ks, kp); else ISSUE(t + 2, kp, kn);
        SBAR();
        Y_(t, false);
#ifdef PROBE_YEXP
        if constexpr (ND0 == 4) { float dm_ = al; _Pragma("unroll") for (int i_ = 0; i_ < PROBE_YEXP; ++i_) asm volatile("v_exp_f32 %0, %1" : "=v"(dm_) : "v"(al)); asm volatile("" :: "v"(dm_)); }
#endif

        if (!grpB) PAIR_WAIT(t);
        BAR();
        ks = kn;
    }
    pv_tile(o, vb0 + (ks == 0 ? 2 : ks - 1) * SHM_V, pa0, pa1, pa2, pa3);
    BAR();
#undef QK_
#undef Y_
    if (!grpB) BAR();
#undef DMA_K
#undef DMA_V
#undef ISSUE
#undef PAIR_WAIT
#undef BAR
#undef RESC
#undef MASKT
}
__device__ __forceinline__ void normalize_o(f32x16 (&o)[4], float l_reg, float* ws, int r32, int hi) {
    if (hi == 0) ws[r32] = l_reg; asm volatile("s_waitcnt lgkmcnt(0)" ::: "memory");
#pragma unroll
    for (int r = 0; r < 16; ++r) { const float rl = __builtin_amdgcn_rcpf(ws[crow(r, hi)]);
#pragma unroll
        for (int d0 = 0; d0 < 4; ++d0) o[d0][r] *= rl; }
}
__device__ __forceinline__ void store_o_bf16(const f32x16 (&o)[4], bf16_t* Ow, int ldo, int r32, int hi) {
#pragma unroll
    for (int r = 0; r < 16; ++r) { const int orow = crow(r, hi);
#pragma unroll
        for (int d0 = 0; d0 < 4; ++d0) { const float v = o[d0][r]; const float vn = shflx(v, 1, hi * 32 + r32);
            if ((r32 & 1) == 0) *(unsigned*)(Ow + (size_t)orow * ldo + d0 * 32 + r32) = cvt_pk_bf16(v, vn); } }
}
}

constexpr size_t MiB = 1u << 20;
constexpr size_t WS_CTL = 0, CTL_ZERO_BYTES = 4 * MiB;
constexpr size_t WS_SSQ = 1 * MiB;
constexpr size_t WS_W = 4 * MiB, LW_BYTES = 269 * MiB / 2;
constexpr size_t LW_IN = 0, LW_QUP = 44 * MiB, LW_KVUP = LW_QUP + 3 * MiB / 2, LW_GLU = LW_KVUP + 1 * MiB, LW_BR = LW_GLU + 4 * MiB, LW_OUT = LW_BR + 12 * MiB,
                 LW_XQ = LW_OUT + 8 * MiB, LW_XKV = LW_XQ + 2 * MiB, LW_XO = LW_XKV + 4 * MiB, LW_TEXT = LW_XO + 2 * MiB, LW_WSL = LW_TEXT + 40 * MiB;
static_assert(LW_WSL + 16 * MiB == LW_BYTES, "layer weight block");
constexpr size_t WS_FFN = WS_W + 2 * LW_BYTES;
constexpr size_t WS_MOE = WS_FFN + 66 * MiB;
constexpr size_t WS_XS = WS_MOE + 8 * 66 * MiB + 1 * MiB;
static_assert(WS_XS == 868 * MiB, "map");
constexpr size_t WS_XN = WS_XS + 128 * MiB;
constexpr size_t WS_TABD = WS_XN + 64 * MiB, WS_TABM = WS_TABD + 1 * MiB, WS_XKV = WS_TABM + 4 * MiB, WS_MEMB = WS_XKV + 1 * MiB, WS_ROUTE = WS_MEMB + 1 * MiB, WS_ORDER = WS_ROUTE + 1 * MiB;
constexpr size_t WS_A32 = WS_ORDER + 64 * 1024;
constexpr size_t WS_PSQ = WS_ORDER + 1 * MiB;
constexpr size_t WS_MIX = WS_TABD + 12 * MiB;
static_assert(WS_MIX == 1072 * MiB, "map");
constexpr size_t WS_QD = WS_MIX, WS_KD = WS_QD + 32 * MiB, WS_VD = WS_KD + 32 * MiB, WS_MQ = WS_VD + 32 * MiB, WS_MKV = WS_MQ + 16 * MiB, WS_KM = WS_MKV + 8 * MiB, WS_VM = WS_KM + 48 * MiB,
                 WS_QM = WS_VM + 32 * MiB, WS_SU = WS_QM + 48 * MiB, WS_GATES = WS_SU + 40 * MiB, WS_SLOC = WS_GATES + 192 * MiB, WS_YG = WS_SLOC + 16 * MiB, WS_BR = WS_YG + 32 * MiB,
                 WS_TMP = WS_BR + 96 * MiB, WS_MG = WS_TMP + 128 * MiB, WS_XQ = WS_MG + 64 * MiB, WS_XO = WS_XQ + 16 * MiB, WS_XN8 = WS_XO + 16 * MiB  , WS_END = WS_XN8 + 32 * MiB;
static_assert(WS_END == 1952 * MiB, "map");
constexpr size_t WS_XG = WS_MIX, WS_HG = WS_XG + 136 * MiB, WS_OG = WS_HG + 374 * MiB;
static_assert(WS_OG + 272 * MiB <= WS_XQ, "ffn overlay");
constexpr int CW_TMO = 0, CW_DBG = 2, CW_BAR = 4096, CW_ATTQ = 16384, CW_MOECNT = 16640, CW_MOECUR = 16704;

#define XB_TMO      128
#define XB_XCNT(j)  (256  + 64 * (j))
#define XB_XSUB(j)  (1280 + 64 * (j))
#define XB_XGEN(j)  (2304 + 64 * (j))
#define XB_TOP      3328
#define XB_TOPGEN   3392
#define XCD_BAR_WORDS 3456
#define XB_SPIN_CAP (1u << 22)
__device__ __forceinline__ unsigned xb_ld(unsigned* p)              { return __hip_atomic_load(p, __ATOMIC_RELAXED, __HIP_MEMORY_SCOPE_AGENT); }
__device__ __forceinline__ unsigned xb_add(unsigned* p, unsigned v) { return __hip_atomic_fetch_add(p, v, __ATOMIC_RELAXED, __HIP_MEMORY_SCOPE_AGENT); }
__device__ __forceinline__ unsigned xb_xcc_id() { return (unsigned)__builtin_amdgcn_s_getreg((3 << 11) | 20) & 0xFu; }
#define XB_SPIN(cond, bar) do { unsigned _sp = 0; while (cond) { __builtin_amdgcn_s_sleep(1); \
    if ((++_sp & 255u) == 0u) { if (xb_ld(&(bar)[XB_TMO])) break; if (_sp > XB_SPIN_CAP) { atomicAdd(&(bar)[XB_TMO], 1u); break; } } } } while (0)
struct XcdBarrier { unsigned* bar; unsigned x; volatile LAS unsigned* st; };
__device__ __forceinline__ XcdBarrier xcd_barrier_post(unsigned* bar, volatile LAS unsigned* st) {
    XcdBarrier b; b.bar = bar; b.x = xb_xcc_id(); b.st = st;
    if (threadIdx.x == 0) (void)xb_add(&bar[XB_XCNT(b.x)], 1u);
    return b;
}
__device__ __forceinline__ void xcd_barrier_complete(unsigned* bar, unsigned x, unsigned& nloc, unsigned& nx) {
    const unsigned G = gridDim.x * gridDim.y * gridDim.z;
    unsigned sum, cnt, mine, sp = 0u;
    for (;;) {
        sum = 0u; cnt = 0u; mine = 0u;
#pragma nounroll
        for (unsigned j = 0; j < 16; ++j) { const unsigned c = xb_ld(&bar[XB_XCNT(j)]); sum += c; cnt += (c > 0u) ? 1u : 0u; mine = (j == x) ? c : mine; }
        if (sum == G) break;
        __builtin_amdgcn_s_sleep(1);
        if ((++sp & 255u) == 0u) { if (xb_ld(&bar[XB_TMO])) break; if (sp > XB_SPIN_CAP) { atomicAdd(&bar[XB_TMO], 1u); break; } }
    }
    nloc = mine > 0u ? mine : 1u; nx = cnt > 0u ? cnt : 1u;
}
__device__ __forceinline__ void xcd_barrier_setup(const XcdBarrier& b) {
    if (threadIdx.x == 0) { unsigned nloc, nx; xcd_barrier_complete(b.bar, b.x, nloc, nx); b.st[0] = nloc; b.st[1] = nx; }
    __syncthreads();
}
__device__ __forceinline__ void xcd_barrier(const XcdBarrier& b) {
    asm volatile("s_waitcnt vmcnt(0)" ::: "memory");
    __syncthreads();
    if (opaque_tid() == 0) {
        unsigned* bar = b.bar;
        __builtin_amdgcn_s_waitcnt(0);
        const unsigned nloc = b.st[0], nx = b.st[1];
        const unsigned old = xb_add(&bar[XB_XSUB(b.x)], 1u);
        const unsigned gen = old / nloc;
        if (old + 1u == (gen + 1u) * nloc) {
            __builtin_amdgcn_fence(__ATOMIC_RELEASE, "agent");
            asm volatile("s_waitcnt vmcnt(0)" ::: "memory");
            const unsigned og = xb_add(&bar[XB_TOP], 1u);
            const unsigned tg = og / nx;
            if (og + 1u == (tg + 1u) * nx) xb_add(&bar[XB_TOPGEN], 1u);
            else XB_SPIN(xb_ld(&bar[XB_TOPGEN]) == tg, bar);
            __builtin_amdgcn_fence(__ATOMIC_ACQUIRE, "agent");
            xb_add(&bar[XB_XGEN(b.x)], 1u);
            asm volatile("s_waitcnt vmcnt(0)" ::: "memory");
        } else {
            XB_SPIN(xb_ld(&bar[XB_XGEN(b.x)]) == gen, bar);
            __builtin_amdgcn_fence(__ATOMIC_ACQUIRE, "agent");
            asm volatile("s_waitcnt vmcnt(0)" ::: "memory");
        }
    }
    __syncthreads();
}

struct Args { const void* in[35]; float* out; unsigned char* ws; int ph_lo, ph_hi; };
struct PTab { volatile LAS unsigned long long* t; __device__ __forceinline__ const void* operator[](int i) const { const unsigned long long v = t[i];
    const unsigned lo_ = __builtin_amdgcn_readfirstlane((unsigned)v), hi_ = __builtin_amdgcn_readfirstlane((unsigned)(v >> 32)); return (const void*)(GAS const char*)(((unsigned long long)hi_ << 32) | lo_); } };
struct ArgsD { PTab in; unsigned char* ws; };
enum { I_X = 0, I_MEM, I_POS, I_WIN, I_WQUP, I_WKVUP, I_QNG, I_KVNG, I_DLAM, I_SUBLN, I_LRE, I_LIM, I_BRE, I_BIM, I_CRE, I_CIM, I_SSMD, I_LOGDT, I_GLUW, I_WBR, I_WOUT, I_LNMG, I_LNMB,
       I_WXQ, I_WXKV, I_WXO, I_LNXG, I_LNXB, I_FGU, I_FDN, I_ROUTER, I_MGU, I_MDN, I_LNFG, I_LNFB };
constexpr int NPL = 16, NPHASE = 1 + DEPTH * NPL;
constexpr int LDS_BYTES = 147456;
constexpr int LDS_MISC = 131072 + 8192;

__device__ __forceinline__ float lam_init_of(int l) { return l == 0 ? 0.2f : 0.35550906759f; }

struct Mat { const float* src; bf16_t* dst; int K, N, kind; const float* ksc; int kmod; float kmul; int fp8; };
__device__ __forceinline__ int map_row(int kind, int n, int N) {
    if (kind == 0) return n;
    if (kind == 1) {
        if (n < 2048) { const int hc = n & 63; if (hc < 16) return (n - hc) + (hc < 8 ? 2 * hc : 2 * (hc - 8) + 1); return n; }
        if (n < 3840) return n;
        if (n < 3904) { const int hc = n - 3840; return 3840 + (hc < 32 ? 2 * hc : 2 * (hc - 32) + 1); }
        return n + 192;
    }
    if (kind == 2) { const int h = n / 192; int hc = n - h * 192; if (hc >= 128) { const int r = hc - 128; hc = 128 + (r < 32 ? 2 * r : 2 * (r - 32) + 1); } return h * 192 + hc; }
    const int half = N >> 1;
    if (n < half) return (n >> 7) * 256 + (n & 127);
    const int mm = n - half; return (mm >> 7) * 256 + 128 + (mm & 127);
}
__device__ __forceinline__ Mat get_mat(const ArgsD& a, int id) {
    Mat m; m.ksc = nullptr; m.kmod = 1; m.kmul = 1.f; m.kind = 0; m.fp8 = 0;
    unsigned char* ws = a.ws;
    if (id < 22) { const int l = id / 11, k = id % 11; unsigned char* lw = ws + WS_W + (size_t)l * LW_BYTES;
        switch (k) {
        case 0: m.src = (const float*)a.in[I_WIN] + (size_t)l * D * NIN_SRC; m.dst = (bf16_t*)(lw + LW_IN); m.K = D; m.N = NIN_SRC; m.kind = 1; break;
        case 1: m.src = (const float*)a.in[I_WQUP] + (size_t)l * 512 * 1536; m.dst = (bf16_t*)(lw + LW_QUP); m.K = 512; m.N = 1536; m.kind = 2; m.ksc = (const float*)a.in[I_QNG] + l * 512; m.kmod = 512; break;
        case 2: m.src = (const float*)a.in[I_WKVUP] + (size_t)l * 256 * 2048; m.dst = (bf16_t*)(lw + LW_KVUP); m.K = 256; m.N = 2048; m.ksc = (const float*)a.in[I_KVNG] + l * 256; m.kmod = 256; break;
        case 3: m.src = (const float*)a.in[I_GLUW] + (size_t)l * 1024 * 2048; m.dst = (bf16_t*)(lw + LW_GLU); m.K = 1024; m.N = 2048; m.kind = 3; break;
        case 4: m.src = (const float*)a.in[I_WBR] + (size_t)(l * 3 + 0) * 1024 * 2048; m.dst = (bf16_t*)(lw + LW_BR); m.K = 1024; m.N = 2048; m.ksc = (const float*)a.in[I_SUBLN] + l * 128; m.kmod = 128; m.kmul = 1.f - lam_init_of(l); break;
        case 5: m.src = (const float*)a.in[I_WBR] + (size_t)(l * 3 + 1) * 1024 * 2048; m.dst = (bf16_t*)(lw + LW_BR + 4 * MiB); m.K = 1024; m.N = 2048; break;
        case 6: m.src = (const float*)a.in[I_WBR] + (size_t)(l * 3 + 2) * 1024 * 2048; m.dst = (bf16_t*)(lw + LW_BR + 8 * MiB); m.K = 1024; m.N = 2048; break;
        case 7: m.src = (const float*)a.in[I_WOUT] + (size_t)l * 2048 * 2048; m.dst = (bf16_t*)(lw + LW_OUT); m.K = 2048; m.N = 2048; break;
        case 8: m.src = (const float*)a.in[I_WXQ] + (size_t)l * 2048 * 512; m.dst = (bf16_t*)(lw + LW_XQ); m.K = 2048; m.N = 512; break;
        case 9: m.src = (const float*)a.in[I_WXKV] + (size_t)l * 2048 * 1024; m.dst = (bf16_t*)(lw + LW_XKV); m.K = 2048; m.N = 1024; break;
        default: m.src = (const float*)a.in[I_WXO] + (size_t)l * 512 * 2048; m.dst = (bf16_t*)(lw + LW_XO); m.K = 512; m.N = 2048; break;
        }
    } else if (id == 22) { m.src = (const float*)a.in[I_FGU]; m.dst = (bf16_t*)(ws + WS_FFN); m.K = D; m.N = 2 * DFF; m.kind = 3; }
    else if (id == 23) { m.src = (const float*)a.in[I_FDN]; m.dst = (bf16_t*)(ws + WS_FFN + 44 * MiB); m.K = DFF; m.N = D; m.fp8 = 1; m.kmul = 256.f; }
    else { const int e = (id - 24) >> 1;
        m.fp8 = 1;
        if (((id - 24) & 1) == 0) { m.src = (const float*)a.in[I_MGU] + (size_t)e * D * 2 * DFF; m.dst = (bf16_t*)(ws + WS_MOE + (size_t)e * 66 * MiB); m.K = D; m.N = 2 * DFF; m.kind = 3; m.kmul = 64.f; }
        else { m.src = (const float*)a.in[I_MDN] + (size_t)e * DFF * D; m.dst = (bf16_t*)(ws + WS_MOE + (size_t)e * 66 * MiB + 44 * MiB); m.K = DFF; m.N = D; m.kmul = 256.f; }
    }
    return m;
}
constexpr int NMAT = 40;
__device__ __forceinline__ void cvt_item(const Mat& mt, LAS float* scr, int item, int lane) {
    const int nblk = mt.N / 64, kb = item / nblk, nb = item - kb * nblk, k0 = 64 * kb, n0 = 64 * nb;
    const bool g8 = mt.kind == 1 && n0 >= 3072;
    const bool f8 = mt.fp8 || g8; const float kmul = g8 ? 64.f : mt.kmul;
    const int lr = lane >> 4, lc = (lane & 15) * 4;
    f32x4 v[16];
#pragma unroll
    for (int i = 0; i < 16; ++i) v[i] = *(const f32x4*)(mt.src + (size_t)(k0 + 4 * i + lr) * mt.N + n0 + lc);
    if (mt.ksc) {
#pragma unroll
        for (int i = 0; i < 16; ++i) v[i] = v[i] * (mt.ksc[(k0 + 4 * i + lr) % mt.kmod] * mt.kmul); }
    else if (f8) {
#pragma unroll
        for (int i = 0; i < 16; ++i) v[i] = v[i] * kmul; }
#pragma unroll
    for (int i = 0; i < 16; ++i) { LAS float* p = scr + (4 * i + lr) * 65 + lc; p[0] = v[i][0]; p[1] = v[i][1]; p[2] = v[i][2]; p[3] = v[i][3]; }
    LDS_WAIT(); asm volatile("" ::: "memory");
    const int c = lane & 7;
#pragma unroll
    for (int j = 0; j < 8; ++j) { const int n = (lane >> 3) + 8 * j; const LAS float* s = scr + (8 * c) * 65 + n;
        if (f8) { const u32x2 o = pack8_fp8((f32x4){s[0 * 65], s[1 * 65], s[2 * 65], s[3 * 65]}, (f32x4){s[4 * 65], s[5 * 65], s[6 * 65], s[7 * 65]}); const int r_ = map_row(mt.kind, n0 + n, mt.N);
            unsigned char* d8 = g8 ? (unsigned char*)mt.dst + (size_t)NIN_BF * mt.K * 2 + (size_t)(r_ - NIN_BF) * mt.K : (unsigned char*)mt.dst + (size_t)r_ * mt.K;
            *(u32x2*)(d8 + k0 + 8 * c) = o; }
        else { u32x4 o; o.x = cvt_pk_bf16(s[0 * 65], s[1 * 65]); o.y = cvt_pk_bf16(s[2 * 65], s[3 * 65]); o.z = cvt_pk_bf16(s[4 * 65], s[5 * 65]); o.w = cvt_pk_bf16(s[6 * 65], s[7 * 65]);
            *(u32x4*)(mt.dst + (size_t)map_row(mt.kind, n0 + n, mt.N) * mt.K + k0 + 8 * c) = o; } }
    LDS_WAIT(); asm volatile("" ::: "memory");
}
__device__ __forceinline__ void cvt_tile_wg(const Mat& mt, LAS float* scr, int tile, int tid) {
    const int nblk = mt.N / 256, kb = tile / nblk, nb = tile - kb * nblk, k0 = 64 * kb, n0 = 256 * nb;
    const int lane = tid & 63, w = tid >> 6;
    f32x4 v[8];
#pragma unroll
    for (int i = 0; i < 8; ++i) v[i] = *(const f32x4*)(mt.src + (size_t)(k0 + 8 * w + i) * mt.N + n0 + lane * 4);
    if (mt.ksc) {
#pragma unroll
        for (int i = 0; i < 8; ++i) v[i] = v[i] * (mt.ksc[(k0 + 8 * w + i) % mt.kmod] * mt.kmul); }
    else if (mt.fp8) {
#pragma unroll
        for (int i = 0; i < 8; ++i) v[i] = v[i] * mt.kmul; }
#pragma unroll
    for (int i = 0; i < 8; ++i) { LAS float* p = scr + (8 * w + i) * 257 + lane * 4; p[0] = v[i][0]; p[1] = v[i][1]; p[2] = v[i][2]; p[3] = v[i][3]; }
    __syncthreads();
    const int c = tid & 7;
#pragma unroll
    for (int j = 0; j < 4; ++j) { const int n = (tid >> 3) + 64 * j; const LAS float* s = scr + (8 * c) * 257 + n; const int r_ = map_row(mt.kind, n0 + n, mt.N);
        if (mt.fp8) *(u32x2*)((unsigned char*)mt.dst + (size_t)r_ * mt.K + k0 + 8 * c) = pack8_fp8((f32x4){s[0 * 257], s[1 * 257], s[2 * 257], s[3 * 257]}, (f32x4){s[4 * 257], s[5 * 257], s[6 * 257], s[7 * 257]});
        else { u32x4 o; o.x = cvt_pk_bf16(s[0 * 257], s[1 * 257]); o.y = cvt_pk_bf16(s[2 * 257], s[3 * 257]); o.z = cvt_pk_bf16(s[4 * 257], s[5 * 257]); o.w = cvt_pk_bf16(s[6 * 257], s[7 * 257]);
            *(u32x4*)(mt.dst + (size_t)r_ * mt.K + k0 + 8 * c) = o; } }
    __syncthreads();
}
__device__ __forceinline__ void ssm_build(const ArgsD& a, int l, int g, int half, LAS unsigned char* lds) {
    LAS float* Ap = (LAS float*)lds;
    LAS float* Bb = Ap + 33 * 64 * 2;
    LAS float* Cc = Bb + 64 * 16 * 2;
    LAS float* Mk = Cc + 16 * 64 * 2;
    const int tid = opaque_tid();
    const float* lre = (const float*)a.in[I_LRE] + (l * 64 + g) * 64; const float* lim = (const float*)a.in[I_LIM] + (l * 64 + g) * 64;
    const float* bre = (const float*)a.in[I_BRE] + (size_t)(l * 64 + g) * 1024; const float* bim = (const float*)a.in[I_BIM] + (size_t)(l * 64 + g) * 1024;
    const float* cre = (const float*)a.in[I_CRE] + (size_t)(l * 64 + g) * 1024; const float* cim = (const float*)a.in[I_CIM] + (size_t)(l * 64 + g) * 1024;
    const double dt = exp((double)((const float*)a.in[I_LOGDT])[l * 64 + g]);
    for (int idx = tid; idx < 33 * 64; idx += 512) { const int n = idx & 63, k = idx >> 6; const double re = lre[n], im = lim[n];
        const double mag = exp(re * dt * k), ang = im * dt * k; Ap[idx * 2] = (float)(mag * cos(ang)); Ap[idx * 2 + 1] = (float)(mag * sin(ang)); }
    if (tid < 64) { float* a32 = (float*)(a.ws + WS_A32) + (size_t)((l * 64 + g) * 64 + tid) * 2; const double re = lre[tid], im = lim[tid]; const double mag = exp(32.0 * re * dt), ang = 32.0 * im * dt;
        a32[0] = (float)(mag * cos(ang)); a32[1] = (float)(mag * sin(ang)); }
    for (int idx = tid; idx < 1024; idx += 512) { const int n = idx >> 4; const double re = lre[n], im = lim[n]; const double mag = exp(re * dt), ang = im * dt;
        const double lr = mag * cos(ang) - 1.0, li = mag * sin(ang), den = re * re + im * im;
        const double fr_ = (lr * re + li * im) / den, fi_ = (li * re - lr * im) / den; const double br = bre[idx], bi = bim[idx];
        Bb[idx * 2] = (float)(fr_ * br - fi_ * bi); Bb[idx * 2 + 1] = (float)(fr_ * bi + fi_ * br);
        Cc[idx * 2] = cre[idx]; Cc[idx * 2 + 1] = cim[idx]; }
    __syncthreads();
    { const int k = tid >> 4, p = tid & 15; float acc[16];
#pragma unroll
        for (int q = 0; q < 16; ++q) acc[q] = 0.f;
        for (int n = 0; n < 64; ++n) { const float ar = Ap[(k * 64 + n) * 2], ai = Ap[(k * 64 + n) * 2 + 1], cr = Cc[(p * 64 + n) * 2], ci = Cc[(p * 64 + n) * 2 + 1];
            const float ur = cr * ar - ci * ai, ui = cr * ai + ci * ar; const LAS f32x4* bq = (const LAS f32x4*)(Bb + n * 32);
#pragma unroll
            for (int q4 = 0; q4 < 8; ++q4) { const f32x4 bv = bq[q4]; acc[2 * q4] += bv[0] * ur - bv[1] * ui; acc[2 * q4 + 1] += bv[2] * ur - bv[3] * ui; } }
#pragma unroll
        for (int q = 0; q < 16; ++q) Mk[tid * 16 + q] = acc[q]; }
    __syncthreads();
    unsigned char* lw = a.ws + WS_W + (size_t)l * LW_BYTES;
    bf16_t* T = (bf16_t*)(lw + LW_TEXT) + (size_t)g * 512 * SSM_KX; bf16_t* W = (bf16_t*)(lw + LW_WSL) + (size_t)g * 256 * 512;
    for (int it = 0; it < 40; ++it) { const int c = it * 512 + tid, Rl = c / 80, ch = c - Rl * 80, R = 256 * half + Rl, i = R >> 4, p = R & 15; u32x4 w = {0u, 0u, 0u, 0u};
        if (ch < 64) { const int j = ch >> 1, q0 = (ch & 1) * 8;
            if (j <= i) { const LAS float* mp = Mk + ((i - j) * 16 + p) * 16 + q0; w.x = cvt_pk_bf16(mp[0], mp[1]); w.y = cvt_pk_bf16(mp[2], mp[3]); w.z = cvt_pk_bf16(mp[4], mp[5]); w.w = cvt_pk_bf16(mp[6], mp[7]); } }
        else { const int cc = ch - 64; float v[8];
#pragma unroll
            for (int e = 0; e < 4; ++e) { const int n = cc * 4 + e; const float cr = Cc[(p * 64 + n) * 2], ci = Cc[(p * 64 + n) * 2 + 1], ar = Ap[((i + 1) * 64 + n) * 2], ai = Ap[((i + 1) * 64 + n) * 2 + 1];
                v[2 * e] = cr * ar - ci * ai; v[2 * e + 1] = -(cr * ai + ci * ar); }
            w.x = cvt_pk_bf16(v[0], v[1]); w.y = cvt_pk_bf16(v[2], v[3]); w.z = cvt_pk_bf16(v[4], v[5]); w.w = cvt_pk_bf16(v[6], v[7]); }
        *(u32x4*)(T + (size_t)R * SSM_KX + ch * 8) = w; }
    for (int it = 0; it < 16; ++it) { const int c = it * 512 + tid, R = 128 * half + (c >> 6), ch = c & 63; u32x4 w = {0u, 0u, 0u, 0u};
        if (R < 128) { const int n = R >> 1, im = R & 1, j = ch >> 1, q0 = (ch & 1) * 8; float v[8]; const float ar = Ap[((31 - j) * 64 + n) * 2], ai = Ap[((31 - j) * 64 + n) * 2 + 1];
#pragma unroll
            for (int e = 0; e < 8; ++e) { const float br = Bb[(n * 16 + q0 + e) * 2], bi = Bb[(n * 16 + q0 + e) * 2 + 1]; v[e] = im ? (ar * bi + ai * br) : (ar * br - ai * bi); }
            w.x = cvt_pk_bf16(v[0], v[1]); w.y = cvt_pk_bf16(v[2], v[3]); w.z = cvt_pk_bf16(v[4], v[5]); w.w = cvt_pk_bf16(v[6], v[7]); }
        *(u32x4*)(W + (size_t)R * 512 + ch * 8) = w; }
    __syncthreads();
}

struct LnArgs { bf16_t* X; float* outf; unsigned char* outq; const float* g; const float* b;
                const float* og; const int* slot; int* r_e; float* r_w; unsigned* cnt; };
template <int MODE>
__device__ __forceinline__ void ln_phase(const LnArgs& A, LAS unsigned char* lds, int G) {
    const int tid = opaque_tid(), lane = tid & 63, wave = __builtin_amdgcn_readfirstlane(tid >> 6);
    const int gw = blockIdx.x * 8 + wave, NGW = G * 8;
    f32x4 gv[8], bv[8];
    if (MODE != 1) {
#pragma unroll
        for (int j = 0; j < 8; ++j) { gv[j] = *(const f32x4*)(A.g + lane * 8 + 512 * (j >> 1) + 4 * (j & 1)); bv[j] = *(const f32x4*)(A.b + lane * 8 + 512 * (j >> 1) + 4 * (j & 1)); } }
    for (int row = gw; row < M; row += NGW) {
        bf16_t* xr = A.X + (size_t)row * D + lane * 8;
        f32x4 v[8]; float s = 0.f;
#pragma unroll
        for (int j = 0; j < 4; ++j) { const u32x4 w = *(const u32x4*)(xr + 512 * j); v[2 * j] = (f32x4){bf_lo(w.x), bf_hi(w.x), bf_lo(w.y), bf_hi(w.y)}; v[2 * j + 1] = (f32x4){bf_lo(w.z), bf_hi(w.z), bf_lo(w.w), bf_hi(w.w)}; }
        if (MODE == 2) { const int s0 = A.slot[row * 2], s1 = A.slot[row * 2 + 1]; const float* o0 = A.og + (size_t)s0 * D + lane * 8; const float* o1 = A.og + (size_t)s1 * D + lane * 8;
#pragma unroll
            for (int j = 0; j < 8; ++j) { const int e = 512 * (j >> 1) + 4 * (j & 1); v[j] = v[j] * ALPHA + *(const f32x4*)(o0 + e) + *(const f32x4*)(o1 + e); } }
#pragma unroll
        for (int j = 0; j < 8; ++j) s += (v[j][0] + v[j][1]) + (v[j][2] + v[j][3]);
        const float mean = wave_sum(s, lane) * (1.f / D); float s2 = 0.f;
#pragma unroll
        for (int j = 0; j < 8; ++j) { v[j] = v[j] - mean; s2 += (v[j][0] * v[j][0] + v[j][1] * v[j][1]) + (v[j][2] * v[j][2] + v[j][3] * v[j][3]); }
        const float rstd = 1.f / sqrtf(wave_sum(s2, lane) * (1.f / D) + LN_EPS);
#pragma unroll
        for (int j = 0; j < 8; ++j) { if (MODE == 1) { gv[j] = *(const f32x4*)(A.g + lane * 8 + 512 * (j >> 1) + 4 * (j & 1)); bv[j] = *(const f32x4*)(A.b + lane * 8 + 512 * (j >> 1) + 4 * (j & 1)); }
            v[j] = v[j] * rstd * gv[j] + bv[j]; }
        if (A.outf) { float* of = A.outf + (size_t)row * D + lane * 8;
#pragma unroll
            for (int j = 0; j < 8; ++j) *(f32x4*)(of + 512 * (j >> 1) + 4 * (j & 1)) = v[j]; }
        else {
#pragma unroll
            for (int j = 0; j < 4; ++j) *(u32x4*)(xr + 512 * j) = pack8(v[2 * j], v[2 * j + 1]); }
        if (A.outq) { unsigned char* oq = A.outq + (size_t)row * D + lane * 8;
#pragma unroll
            for (int j = 0; j < 4; ++j) *(u32x2*)(oq + 512 * j) = pack8_fp8(v[2 * j], v[2 * j + 1]); }
        if (MODE == 1) {
            const LAS float* wr_ = (const LAS float*)lds;
            int i0 = 0, i1 = 0; float v0 = -__builtin_inff(), v1 = -__builtin_inff();
#pragma unroll 1
            for (int e = 0; e < 8; ++e) { float acc = 0.f;
#pragma unroll
                for (int j = 0; j < 8; ++j) { const f32x4 w = *(const LAS f32x4*)(wr_ + e * D + lane * 8 + 512 * (j >> 1) + 4 * (j & 1)); acc += (v[j][0] * w[0] + v[j][1] * w[1]) + (v[j][2] * w[2] + v[j][3] * w[3]); }
                const float sg = wave_sum(acc, lane);
                if (sg > v0) { v1 = v0; i1 = i0; v0 = sg; i0 = e; } else if (sg > v1) { v1 = sg; i1 = e; } }
            const float w0 = 1.f / (1.f + expf(v1 - v0)), w1 = 1.f - w0;
            if (lane == 0) { A.r_e[row * 2] = i0; A.r_e[row * 2 + 1] = i1; A.r_w[row * 2] = w0; A.r_w[row * 2 + 1] = w1;
                __hip_atomic_fetch_add(A.cnt + i0, 1u, RLX_AGENT); __hip_atomic_fetch_add(A.cnt + i1, 1u, RLX_AGENT); }
        }
    }
}
__device__ __forceinline__ void moe_offsets(const unsigned* cnt, int (&off)[9]) {
    int acc = 0;
#pragma unroll
    for (int e = 0; e < 8; ++e) { off[e] = acc; const int c = (int)__hip_atomic_load(cnt + e, RLX_AGENT); acc += ((c + 255) >> 8) << 8; }
    off[8] = acc;
}

struct AttPtrs { const bf16_t *QD, *KD, *VD, *QM, *KM, *VM; bf16_t *BR0, *BR1; };
__device__ __forceinline__ void mla_unit(const AttPtrs& P, int h, int qb, char* lds) {
    const int tid = opaque_tid(), wid = __builtin_amdgcn_readfirstlane(tid >> 6), lane = tid & 63, r32 = lane & 31, hi = lane >> 5;
    const int q0 = qb * 256 + wid * 32; f32x16 o[4]; float l;
    att::attn_core_pp<192, 12, true, false>(P.QM + (size_t)(q0 + r32) * 1536 + h * 192 + hi * 8, P.KM + h * 192, 1536, P.VM + h * 128, 1024, 4 * (qb + 1), q0 + r32, q0, 0, lds, o, l);
    float* ws = (float*)(lds + 3 * att::SHM_V + 3 * 64 * 384) + wid * 64;
    att::normalize_o(o, l, ws, r32, hi);
    att::store_o_bf16(o, P.BR1 + (size_t)q0 * 1024 + h * 128, 1024, r32, hi);
    __syncthreads();
}
__device__ __forceinline__ void diff_unit(const AttPtrs& P, int h, int qb, float lam, char* lds) {
    const int tid = opaque_tid(), wid = __builtin_amdgcn_readfirstlane(tid >> 6), lane = tid & 63, r32 = lane & 31, hi = lane >> 5;
    const int mp = wid >> 2, w4 = wid & 3, q0 = qb * 128 + w4 * 32; f32x16 o[4]; float l;
    att::attn_core_pp<128, 4, true, true>(P.QD + (size_t)(q0 + r32) * 1024 + h * 128 + mp * 64 + hi * 8, P.KD + h * 128, 1024, P.VD + h * 128, 1024, 2 * (qb + 1), q0 + r32, q0, mp * 8, lds, o, l);
    float* ws = (float*)(lds + 3 * att::SHM_V + 3 * 64 * 256) + wid * 64;
    att::normalize_o(o, l, ws, r32, hi);
    __syncthreads();
    float* xch = (float*)lds + w4 * 4096 + lane;
    if (mp == 1) {
#pragma unroll
        for (int d0 = 0; d0 < 4; ++d0)
#pragma unroll
            for (int r = 0; r < 16; ++r) xch[(d0 * 16 + r) * 64] = o[d0][r];
    }
    __syncthreads();
    if (mp == 0) {
        float ss[16];
#pragma unroll
        for (int r = 0; r < 16; ++r) { float s = 0.f;
#pragma unroll
            for (int d0 = 0; d0 < 4; ++d0) { const float dv = o[d0][r] - lam * xch[(d0 * 16 + r) * 64]; o[d0][r] = dv; s += dv * dv; }
            ss[r] = s; }
#pragma unroll
        for (int r = 0; r < 16; ++r) { float s = ss[r];
#pragma unroll
            for (int off = 1; off < 32; off <<= 1) s += shflx(s, off, lane);
            const float rs = __builtin_amdgcn_rsqf(s * (1.f / 128.f) + RMS_EPS);
#pragma unroll
            for (int d0 = 0; d0 < 4; ++d0) o[d0][r] *= rs; }
        att::store_o_bf16(o, P.BR0 + (size_t)q0 * 1024 + h * 128, 1024, r32, hi);
    }
    __syncthreads();
}
__device__ __forceinline__ void cross_unit(const bf16_t* XQ, const bf16_t* XKV, bf16_t* XO, int h, int qb, char* lds) {
    const int tid = opaque_tid(), wid = __builtin_amdgcn_readfirstlane(tid >> 6), lane = tid & 63, r32 = lane & 31, hi = lane >> 5;
    const int q0 = qb * 256 + wid * 32; f32x16 o[4]; float l;
    att::attn_core<128, 8, false, true>(XQ + (size_t)(q0 + r32) * 512 + h * 128 + hi * 8, XKV + h * 128, 1024, XKV + 512 + h * 128, 1024, 4, 0, 0, 0, lds, o, l);
    float* ws = (float*)(lds + 2 * att::SHM_V + 2 * 64 * 256) + wid * 64;
    att::normalize_o(o, l, ws, r32, hi);
    att::store_o_bf16(o, XO + (size_t)q0 * 512 + h * 128, 512, r32, hi);
    __syncthreads();
}

__global__ void __launch_bounds__(512, 2) fwd_kernel(Args args) {
    extern __shared__ __attribute__((aligned(16))) unsigned char lds_raw[];
    LAS unsigned char* lds = (LAS unsigned char*)lds_raw;
    const int tid = threadIdx.x, lane = tid & 63, wave = __builtin_amdgcn_readfirstlane(tid >> 6);
    const int G = gridDim.x, bx = blockIdx.x;
    unsigned char* ws = (unsigned char*)(GAS unsigned char*)(unsigned long long)args.ws;
    unsigned* ctl = (unsigned*)(ws + WS_CTL);
    volatile LAS unsigned* MISC = (volatile LAS unsigned*)(lds + LDS_MISC);
    if (tid < 32) MISC[tid] = 0u;
    if (lane == 0) ((volatile LAS int*)LDS_WTAB)[__builtin_amdgcn_s_getreg(0x2804)] = wave;
    { volatile LAS unsigned long long* pt = (volatile LAS unsigned long long*)(lds + LDS_MISC + 256); if (tid < 35) pt[tid] = (unsigned long long)args.in[tid]; if (tid == 35) pt[35] = (unsigned long long)args.out; }
    __syncthreads();
    ArgsD ad; ad.in.t = (volatile LAS unsigned long long*)(lds + LDS_MISC + 256); ad.ws = ws;
    const int lo = args.ph_lo, hi = args.ph_hi;
    XcdBarrier bar; bar.bar = ctl + CW_BAR; bar.x = 0; bar.st = nullptr;
    if (hi - lo > 1) { bar = xcd_barrier_post(ctl + CW_BAR, MISC + 8); xcd_barrier_setup(bar); }
#ifndef PH_SEL
#define PH_SEL 0xFFFFFFFFu
#endif
#define INR(k) (lo <= (k) && (k) < hi)
#define IN0() (((PH_SEL) & 1u) && INR(0))
#define INL(j) ((((PH_SEL) >> ((j) + 1)) & 1u) && INR(pb + (j)))
#define SEAM(k) do { if (INR(k) && INR((k) + 1)) xcd_barrier(bar); } while (0)
    const int gw = bx * 8 + wave, NGW = G * 8;
    const int gtid = bx * 512 + tid, NGT = G * 512;

    if (IN0()) {
      {
        { int start = bx;
            for (int id = 0; id < NMAT; ++id) { const Mat mt = get_mat(ad, id); if (mt.kind == 1) continue; const int nit = (mt.K / 64) * (mt.N / 256);
                int it = start; for (; it < nit; it += G) cvt_tile_wg(mt, (LAS float*)lds, it, tid);
                start = it - nit; } }
        { LAS float* scr = (LAS float*)(lds + wave * 16640); int start = gw;
            for (int id = 0; id < 22; id += 11) { const Mat mt = get_mat(ad, id); const int nit = (mt.K / 64) * (mt.N / 64);
                int it = start; for (; it < nit; it += NGW) cvt_item(mt, scr, it, lane);
                start = it - nit; } }
        for (int l = 0; l < DEPTH; ++l) { u32x4* p = (u32x4*)((unsigned char*)(ws + WS_W + (size_t)l * LW_BYTES + LW_IN) + (size_t)NIN_BF * D * 2 + (size_t)(3904 - NIN_BF) * D);
            for (int i = gtid; i < 192 * D / 16; i += NGT) p[i] = (u32x4){0u, 0u, 0u, 0u}; }
        { const float* x = (const float*)ad.in[I_X]; bf16_t* xn = (bf16_t*)(ws + WS_XN);
            unsigned char* x8 = ws + WS_XN8;
            for (size_t i = gtid; i < (size_t)M * D / 8; i += NGT) { const f32x4 a = *(const f32x4*)(x + i * 8), b = *(const f32x4*)(x + i * 8 + 4); *(u32x4*)(xn + i * 8) = pack8(a, b); *(u32x2*)(x8 + i * 8) = pack8_fp8(a, b); }
            const float* mem = (const float*)ad.in[I_MEM]; bf16_t* mb = (bf16_t*)(ws + WS_MEMB);
            for (int i = gtid; i < MEM_LEN * D / 8; i += NGT) { const f32x4 a = *(const f32x4*)(mem + i * 8), b = *(const f32x4*)(mem + i * 8 + 4); *(u32x4*)(mb + i * 8) = pack8(a, b); } }
        { const int* pos = (const int*)ad.in[I_POS]; float* td = (float*)(ws + WS_TABD); float* tm = (float*)(ws + WS_TABM);
            for (int i = gtid; i < M * 40; i += NGT) { const int t = i / 40, k = i - t * 40; const double p = (double)pos[t];
                const double inv = (k < 8) ? exp(-(double)k * (13.122363377404328 / 8.0)) : exp(-(double)(k - 8) * (13.122363377404328 / 32.0));
                const double ang = p * inv; const float c = (float)cos(ang), s = (float)sin(ang);
                if (k < 8) { td[(t * 8 + k) * 2] = c; td[(t * 8 + k) * 2 + 1] = s; } else { tm[(t * 32 + k - 8) * 2] = c; tm[(t * 32 + k - 8) * 2 + 1] = s; } } }
        if (bx == 0 && tid < 192) { int* ord = (int*)(ws + WS_ORDER); const int mine = tid < 64 ? 160 * (tid + 1) : 48 * (tid - 64 + 1); int rank = 0;
            for (int c = 0; c < 192; ++c) { const int cc = c < 64 ? 160 * (c + 1) : 48 * (c - 64 + 1); rank += (cc > mine || (cc == mine && c < tid)) ? 1 : 0; }
            const int code = tid < 64 ? ((1 << 16) | (tid << 8)) : ((tid - 64) << 8);
            for (int h = 0; h < 8; ++h) ord[rank * 8 + h] = code | h; }
        __syncthreads();
#ifdef PROBE_SSMB
#pragma nounroll
        for (int rep_ = 0; rep_ < 2; ++rep_)
#endif
        for (int uidx = bx; uidx < DEPTH * 64 * 2; uidx += G) ssm_build(ad, uidx >> 7, (uidx >> 1) & 63, uidx & 1, lds);
        __syncthreads();
      }
    }
    SEAM(0);

    unsigned char* const ws_k = ws; const int bx_k = bx;
    for (int l = 0; l < DEPTH; ++l) {
        const int pb = 1 + l * NPL;
        if (!(lo < pb + NPL && pb < hi)) continue;
        int bx = bx_k; asm volatile("" : "+s"(bx));
        unsigned long long ws_i = (unsigned long long)ws_k; asm volatile("" : "+s"(ws_i)); unsigned char* ws = (unsigned char*)(GAS unsigned char*)ws_i;
#define PH_TID const int tid = opaque_tid(), lane = tid & 63, wave = __builtin_amdgcn_readfirstlane(tid >> 6); const int gw = bx * 8 + wave, NGW = G * 8; (void)lane; (void)wave; (void)gw; (void)NGW
#define lw (ws + WS_W + (size_t)l * LW_BYTES)
#define ssq_q ((float*)(ws + WS_PSQ))
#define ssq_kv (ssq_q + (size_t)8 * M)
#define XS ((float*)(ws + WS_XS))
#define XN ((bf16_t*)(ws + WS_XN))
#define tabd ((const float*)(ws + WS_TABD))
#define tabm ((const float*)(ws + WS_TABM))
#define QD ((bf16_t*)(ws + WS_QD))
#define KD ((bf16_t*)(ws + WS_KD))
#define VD ((bf16_t*)(ws + WS_VD))
#define MQ ((bf16_t*)(ws + WS_MQ))
#define MKV ((bf16_t*)(ws + WS_MKV))
#define KM ((bf16_t*)(ws + WS_KM))
#define VM ((bf16_t*)(ws + WS_VM))
#define QM ((bf16_t*)(ws + WS_QM))
#define SU ((bf16_t*)(ws + WS_SU))
#define GATES ((bf16_t*)(ws + WS_GATES))
#define SLOC ((float*)(ws + WS_SLOC))
#define YG ((bf16_t*)(ws + WS_YG))
#define BR ((bf16_t*)(ws + WS_BR))
#define TMP ((float*)(ws + WS_TMP))
#define MG ((bf16_t*)(ws + WS_MG))
#define XQ ((bf16_t*)(ws + WS_XQ))
#define XO ((bf16_t*)(ws + WS_XO))
#define XKV ((bf16_t*)(ws + WS_XKV) + (size_t)l * 256 * 1024)
#define r_e ((int*)(ws + WS_ROUTE))
#define r_w ((float*)(ws + WS_ROUTE + 128 * 1024))
#define slot ((int*)(ws + WS_ROUTE + 256 * 1024))
#define wslot ((float*)(ws + WS_ROUTE + 384 * 1024))
        if (INL(0)) {
#if !defined(SUBSEL) || (SUBSEL & 1)
            { pg8::Gemm g{XN, (const bf16_t*)(lw + LW_IN), (D) * 2, (D) * 2, (D) * 2, 0}; SchedPlain S; S.init(M / 256, NIN_BF / 256, D, D, G, bx);
              EpiInProj E{QD, KD, VD, MQ, MKV, KM, SU, GATES, ssq_q, ssq_kv, tabd, tabm, 0};
              pg8::gemm_phase(lds, g, S, E); }
            { pg8::Gemm g{ws + WS_XN8, lw + LW_IN + (size_t)NIN_BF * D * 2, D, D, D, 0}; SchedPlain S; S.T.init(M / 256, NIN_G8 / 256); S.G = G; S.c = bx; S.tA = (size_t)256 * D; S.tB = S.tA;
              EpiInProj E{QD, KD, VD, MQ, MKV, KM, SU, GATES, ssq_q, ssq_kv, tabd, tabm, 12};
              pg8::gemm_phase_t<true, 0x7C7C7C7C>(lds, g, S, E); }
#endif
#if !defined(SUBSEL) || (SUBSEL & 2)
            { pg8::Gemm g{(const bf16_t*)(ws + WS_MEMB), (const bf16_t*)(lw + LW_XKV), (D) * 2, (D) * 2, (D) * 2, 0}; SchedPlain S; S.init(1, 4, D, D, G, (bx + 128) % G);
              EpiBf16 E{XKV, 1024, 1.f};
              pg8::gemm_phase(lds, g, S, E); }
#endif
        }
        SEAM(pb + 0);
        if (INL(1)) {
#if !defined(SUBSEL) || (SUBSEL & 1)
            { pg8::Gemm g{MQ, (const bf16_t*)(lw + LW_QUP), (512) * 2, (512) * 2, (512) * 2, 0}; SchedPlain S; S.init(M / 256, 6, 512, 512, G, bx);
              EpiQup E{QM, ssq_q, tabm}; pg8::gemm_phase(lds, g, S, E); }
#endif
#if !defined(SUBSEL) || (SUBSEL & 2)
            { pg8::Gemm g{MKV, (const bf16_t*)(lw + LW_KVUP), (256) * 2, (256) * 2, (256) * 2, 0}; SchedPlain S; S.init(M / 256, 8, 256, 256, G, (bx + 128) % G);
              EpiKVup E{KM, VM, ssq_kv}; pg8::gemm_phase(lds, g, S, E); }
#endif
#if !defined(SUBSEL) || (SUBSEL & 4)
            { pg8::Gemm g{SU, (const bf16_t*)(lw + LW_WSL), (SSM_KX) * 2, (512) * 2, (512) * 2, 0}; SchedBatch S{2, 1, 64, G, (bx + 128) % G  , (size_t)256 * SSM_KX * 2, (size_t)256 * 512 * 2, (size_t)SSM_NCH * SSM_KX * 2, (size_t)256 * 512 * 2};
              EpiSloc E{SLOC}; pg8::gemm_phase(lds, g, S, E); }
#endif
        }
        SEAM(pb + 1);
        if (INL(2)) {
            PH_TID;
            if (bx < 64) { const int g = bx, n = lane, w = wave;
                const float* a32 = (const float*)(ws + WS_A32) + (size_t)((l * 64 + g) * 64 + n) * 2; const float ar = a32[0], ai = a32[1];
                const float* __restrict__ lp = SLOC + ((size_t)g * SSM_NCH + 64 * w) * 128 + 2 * n; bf16_t* __restrict__ sp = SU + ((size_t)g * SSM_NCH + 64 * w) * SSM_KX + 512 + 2 * n;
                float br[64], bi[64]; float sr = 0.f, si = 0.f;
#pragma unroll
                for (int c0 = 0; c0 < 64; c0 += 32) { f32x2 lv[32];
#pragma unroll
                    for (int k = 0; k < 32; ++k) lv[k] = *(const f32x2*)(lp + (size_t)(c0 + k) * 128);
#pragma unroll
                    for (int k = 0; k < 32; ++k) { br[c0 + k] = sr; bi[c0 + k] = si; const float nr = ar * sr - ai * si + lv[k][0], ni = ar * si + ai * sr + lv[k][1]; sr = nr; si = ni; } }
                LAS float* ex = (LAS float*)lds;
                ex[(w * 64 + n) * 2] = sr; ex[(w * 64 + n) * 2 + 1] = si;
                float pr = ar, pi = ai;
#pragma unroll
                for (int q = 0; q < 6; ++q) { const float tr = pr * pr - pi * pi, ti = 2.f * pr * pi; pr = tr; pi = ti; }
                __syncthreads();
                float cr = 0.f, ci = 0.f;
                for (int uu = 0; uu < w; ++uu) { const float er = ex[(uu * 64 + n) * 2], ei = ex[(uu * 64 + n) * 2 + 1]; const float tr = pr * cr - pi * ci + er, ti = pr * ci + pi * cr + ei; cr = tr; ci = ti; }
#pragma unroll
                for (int k = 0; k < 64; ++k) { *(unsigned*)(sp + (size_t)k * SSM_KX) = cvt_pk_bf16(br[k] + cr, bi[k] + ci);
                    const float tr = ar * cr - ai * ci, ti = ar * ci + ai * cr; cr = tr; ci = ti; } }
        }
        SEAM(pb + 2);
        if (INL(3)) {
#if !defined(SUBSEL) || (SUBSEL & 1)
            { pg8::Gemm g{SU, (const bf16_t*)(lw + LW_TEXT), (SSM_KX) * 2, (SSM_KX) * 2, (SSM_KX) * 2, 0}; SchedBatch S{2, 2, 64, G, bx, (size_t)256 * SSM_KX * 2, (size_t)256 * SSM_KX * 2, (size_t)SSM_NCH * SSM_KX * 2, (size_t)512 * SSM_KX * 2};
              EpiSsmY E{YG, SU, (const float*)ad.in[I_SSMD] + l * 1024}; pg8::gemm_phase(lds, g, S, E); }
#endif
            PH_TID;
            const float* dl = (const float*)ad.in[I_DLAM] + l * 256;
            const float lam = expf(wave_sum(dl[lane] * dl[64 + lane], lane)) - expf(wave_sum(dl[128 + lane] * dl[192 + lane], lane)) + lam_init_of(l);
            const AttPtrs P{QD, KD, VD, QM, KM, VM, BR, BR + (size_t)M * 1024};
            const int* ord = (const int*)(ws + WS_ORDER);
            __syncthreads();
#ifndef PROBE_ATT
#define PROBE_ATT 0
#endif
            const unsigned myx = xb_xcc_id() & 7u;
#pragma nounroll
            for (int rep = 0; rep < (PROBE_ATT ? 2 : 1); ++rep)
#pragma nounroll
            for (int sq = 0; sq < 8; ++sq) { const int q = (int)((myx + sq) & 7u);
            for (;;) {
                if (tid == 0) MISC[0] = __hip_atomic_fetch_add(ctl + CW_ATTQ + 64 * l + 32 * rep + q, 1u, RLX_AGENT);
                __syncthreads();
                const unsigned it = MISC[0];
                __syncthreads();
                if (it >= 192u) break;
                const int code = ord[it * 8 + q], h = code & 255, qb = (code >> 8) & 255;
                if ((code >> 16) && (rep == 0 || (PROBE_ATT & 1))) mla_unit(P, h, qb, (char*)lds_raw);
                if (!(code >> 16) && (rep == 0 || (PROBE_ATT & 2))) diff_unit(P, h, qb, lam, (char*)lds_raw);
            } }
        }
        SEAM(pb + 3);
        if (INL(4)) {
            pg8::Gemm g{YG, (const bf16_t*)(lw + LW_GLU), (1024) * 2, (1024) * 2, (1024) * 2, 0}; SchedPlain S; S.init(M / 256, 8, 1024, 1024, G, bx);
            EpiGated<0> E{BR + (size_t)2 * M * 1024, 1024}; pg8::gemm_phase(lds, g, S, E);
        }
        SEAM(pb + 4);
        if (INL(5)) {
            pg8::Gemm g{BR, (const bf16_t*)(lw + LW_BR), (1024) * 2, (1024) * 2, (1024) * 2, 0}; SchedBranch S; S.T.init(M / 256, 8); S.G = G; S.c = bx; S.tA = (size_t)256 * 1024 * 2; S.tB = S.tA; S.zA = (size_t)M * 1024 * 2; S.zB = (size_t)2048 * 1024 * 2;
            EpiBranch E{GATES, (bf16_t*)TMP, MG}; pg8::gemm_phase(lds, g, S, E);
        }
        SEAM(pb + 5);
        if (INL(6)) {
            pg8::Gemm g{MG, (const bf16_t*)(lw + LW_OUT), (D) * 2, (D) * 2, (D) * 2, 0}; SchedPlain S; S.init(M / 256, 8, D, D, G, bx);
            EpiResid E{XN}; pg8::gemm_phase(lds, g, S, E);
        }
        SEAM(pb + 6);
        if (INL(7)) { const LnArgs A{XN, nullptr, nullptr, (const float*)ad.in[I_LNMG] + l * D, (const float*)ad.in[I_LNMB] + l * D, nullptr, nullptr, nullptr, nullptr, nullptr}; ln_phase<0>(A, lds, G); }
        SEAM(pb + 7);
        if (INL(8)) {
            pg8::Gemm g{XN, (const bf16_t*)(lw + LW_XQ), (D) * 2, (D) * 2, (D) * 2, 0}; SchedPlain S; S.T.init(M / 128, 2); S.G = G; S.c = bx; S.tA = (size_t)128 * D * 2; S.tB = (size_t)256 * D * 2;
            EpiBf16Half E{XQ, 512, C2_X}; pg8::gemm_phase(lds, g, S, E);
        }
        SEAM(pb + 8);
        if (INL(9)) { for (int uidx = bx; uidx < 256; uidx += G) cross_unit(XQ, XKV, XO, uidx & 3, uidx >> 2, (char*)lds_raw); }
        SEAM(pb + 9);
        if (INL(10)) {
            pg8::Gemm g{XO, (const bf16_t*)(lw + LW_XO), (512) * 2, (512) * 2, (512) * 2, 0}; SchedPlain S; S.init(M / 256, 8, 512, 512, G, bx);
            EpiResid E{XN}; pg8::gemm_phase(lds, g, S, E);
        }
        SEAM(pb + 10);
        if (INL(11)) {
            const LnArgs A{XN, nullptr, nullptr, (const float*)ad.in[I_LNXG] + l * D, (const float*)ad.in[I_LNXB] + l * D, nullptr, nullptr, r_e, r_w, ctl + CW_MOECNT};
            if (l == 0) ln_phase<0>(A, lds, G);
            else { PH_TID; const float* rw = (const float*)ad.in[I_ROUTER]; LAS float* wl = (LAS float*)lds;
                for (int i = tid; i < D * 8; i += 512) wl[(i & 7) * D + (i >> 3)] = rw[i];
                __syncthreads(); ln_phase<1>(A, lds, G); __syncthreads(); }
        }
        SEAM(pb + 11);
        if (l == 1) {
            if (INL(12)) { PH_TID; int off[9]; moe_offsets(ctl + CW_MOECNT, off); bf16_t* XG = (bf16_t*)(ws + WS_XG);
                for (int row = gw; row < M; row += NGW) { int s0 = 0, s1 = 0;
                    if (lane == 0) { const int e0 = r_e[row * 2], e1 = r_e[row * 2 + 1];
                        s0 = off[e0] + (int)__hip_atomic_fetch_add(ctl + CW_MOECUR + e0, 1u, RLX_AGENT); s1 = off[e1] + (int)__hip_atomic_fetch_add(ctl + CW_MOECUR + e1, 1u, RLX_AGENT);
                        slot[row * 2] = s0; slot[row * 2 + 1] = s1; wslot[s0] = r_w[row * 2]; wslot[s1] = r_w[row * 2 + 1]; }
                    s0 = __builtin_amdgcn_readfirstlane(s0); s1 = __builtin_amdgcn_readfirstlane(s1);
                    const u32x4* src = (const u32x4*)(XN + (size_t)row * D) + lane; u32x2* d0 = (u32x2*)((unsigned char*)XG + (size_t)s0 * D) + lane; u32x2* d1 = (u32x2*)((unsigned char*)XG + (size_t)s1 * D) + lane;
#pragma unroll
                    for (int j = 0; j < 4; ++j) { const u32x4 v = src[64 * j];
                        const u32x2 q = pack8_fp8((f32x4){bf_lo(v.x), bf_hi(v.x), bf_lo(v.y), bf_hi(v.y)}, (f32x4){bf_lo(v.z), bf_hi(v.z), bf_lo(v.w), bf_hi(v.w)}); d0[64 * j] = q; d1[64 * j] = q; } } }
            SEAM(pb + 12);
        }
        if (INL(13)) {
            if (l == 0) { pg8::Gemm g{XN, (const bf16_t*)(ws + WS_FFN), (D) * 2, (D) * 2, (D) * 2, 0}; SchedPlain S; S.init(M / 256, 44, D, D, G, bx);
                EpiSwigluF8 E{ws + WS_HG, DFF}; pg8::gemm_phase(lds, g, S, E); }
            else { int off[9]; moe_offsets(ctl + CW_MOECNT, off);
                pg8::Gemm g{ws + WS_XG, ws + WS_MOE, D, D, D, 0x7C7C7C7C}; SchedMoe S; S.T.init(off[8] >> 8, 44); S.G = G; S.c = bx; S.tA = (size_t)256 * D; S.tB = S.tA; S.zB = 66 * MiB;
#pragma unroll
                for (int k = 0; k < 7; ++k) S.off[k] = off[k + 1];
                EpiSwigluF8 E{ws + WS_HG, DFF}; pg8::gemm_phase_t<true, 0x7C7C7C7C>(lds, g, S, E); }
        }
        SEAM(pb + 13);
        if (INL(14)) {
            if (l == 0) { pg8::Gemm g{ws + WS_HG, ws + WS_FFN + 44 * MiB, DFF, DFF, DFF, 0x7B7B7B7B}; SchedPlain S; S.init(M / 256, 8, DFF / 2, DFF / 2, G, bx);
                EpiResid E{XN}; pg8::gemm_phase_t<true, 0x7B7B7B7B>(lds, g, S, E); }
            else { int off[9]; moe_offsets(ctl + CW_MOECNT, off);
                pg8::Gemm g{ws + WS_HG, ws + WS_MOE + 44 * MiB, DFF, DFF, DFF, 0x7B7B7B7B}; SchedMoe S; S.T.init(off[8] >> 8, 8); S.G = G; S.c = bx; S.tA = (size_t)256 * DFF; S.tB = S.tA; S.zB = 66 * MiB;
#pragma unroll
                for (int k = 0; k < 7; ++k) S.off[k] = off[k + 1];
                EpiMoeDown E{(float*)(ws + WS_OG), wslot}; pg8::gemm_phase_t<true, 0x7B7B7B7B>(lds, g, S, E); }
        }
        SEAM(pb + 14);
        if (INL(15)) {
            const LnArgs A{XN, (l == DEPTH - 1) ? (float*)ad.in[35] : nullptr, (l == DEPTH - 1) ? nullptr : ws + WS_XN8, (const float*)ad.in[I_LNFG] + l * D, (const float*)ad.in[I_LNFB] + l * D, (const float*)(ws + WS_OG), slot, nullptr, nullptr, nullptr};
            if (l == 0) ln_phase<0>(A, lds, G); else ln_phase<2>(A, lds, G);
        }
        SEAM(pb + 15);
    }
#undef INR
#undef IN0
#undef INL
#undef SEAM
}

extern "C" void kernel_launch(void* const* d_in, const int* in_sizes, int n_in, void* d_out, int out_size, void* d_ws, size_t ws_size, hipStream_t stream) {
    static int grid = 0;
    if (grid == 0) {
        if (n_in != 35 || out_size != M * D || ws_size < WS_END) { fprintf(stderr, "kernel_launch: shape/workspace mismatch: n_in %d out %d ws %zu (need %zu)\n", n_in, out_size, ws_size, (size_t)WS_END); grid = -1; return; }
        int dev = 0, cus = 0, per_cu = 0;
        if (hipGetDevice(&dev) != hipSuccess || hipDeviceGetAttribute(&cus, hipDeviceAttributeMultiprocessorCount, dev) != hipSuccess) { grid = -1; return; }
        if (hipFuncSetAttribute((const void*)fwd_kernel, hipFuncAttributeMaxDynamicSharedMemorySize, LDS_BYTES) != hipSuccess) { fprintf(stderr, "kernel_launch: hipFuncSetAttribute failed\n"); grid = -1; return; }
        if (hipOccupancyMaxActiveBlocksPerMultiprocessor(&per_cu, (const void*)fwd_kernel, 512, LDS_BYTES) != hipSuccess || per_cu < 1) { fprintf(stderr, "kernel_launch: occupancy query says %d\n", per_cu); }
        (void)hipGetLastError();
        grid = cus;
    }
    if (grid < 0) return;
    if (hipMemsetAsync((char*)d_ws + WS_CTL, 0, CTL_ZERO_BYTES, stream) != hipSuccess) return;
    Args a{};
    for (int i = 0; i < 35; ++i) a.in[i] = d_in[i];
    a.out = (float*)d_out; a.ws = (unsigned char*)d_ws;
#if MK_MULTI
    for (int p = 0; p < NPHASE; ++p) { if (p == 1 + 12) continue; a.ph_lo = p; a.ph_hi = p + 1; hipLaunchKernelGGL(fwd_kernel, dim3(grid), dim3(512), LDS_BYTES, stream, a); }
#else
    a.ph_lo = 0; a.ph_hi = NPHASE;
    hipLaunchKernelGGL(fwd_kernel, dim3(grid), dim3(512), LDS_BYTES, stream, a);
#endif
    const hipError_t le = hipPeekAtLastError();
    if (le != hipSuccess) fprintf(stderr, "kernel_launch: launch failed: %s\n", hipGetErrorName(le));
}
```

```cpp
#include <hip/hip_runtime.h>
#include <cstdio>
#include <cstdint>
#include <cmath>

#ifndef MK_MULTI
#define MK_MULTI 0
#endif
#ifndef MK_DBG
#define MK_DBG 0
#endif

#define GAS __attribute__((address_space(1)))
#define LAS __attribute__((address_space(3)))
typedef unsigned short bf16_t;
typedef short bf16x8 __attribute__((ext_vector_type(8)));
typedef short s16x4 __attribute__((ext_vector_type(4)));
typedef float f32x2 __attribute__((ext_vector_type(2)));
typedef float f32x4 __attribute__((ext_vector_type(4)));
typedef float f32x16 __attribute__((ext_vector_type(16)));
typedef unsigned u32x2 __attribute__((ext_vector_type(2)));
typedef unsigned u32x4 __attribute__((ext_vector_type(4)));
typedef GAS unsigned gu32;
#define RLX_AGENT __ATOMIC_RELAXED, __HIP_MEMORY_SCOPE_AGENT
#define LDS_WAIT() asm volatile("s_waitcnt lgkmcnt(0)" ::: "memory")
#define VM_WAIT() asm volatile("s_waitcnt vmcnt(0)" ::: "memory")
#define SBAR() __builtin_amdgcn_sched_barrier(0)

constexpr int M = 16384, D = 2048, DEPTH = 2, MEM_LEN = 256;
constexpr int NIN = 11264, NIN_BF = 3072  , NIN_G8 = 8192  ;
constexpr int NIN_SRC = 11072;
constexpr int DFF = 5632, NEXP = 8;
constexpr int SSM_L = 32, SSM_NCH = M / SSM_L  , SSM_KX = 640  ;
constexpr float LN_EPS = 1e-5f, RMS_EPS = 1e-6f;
constexpr float ALPHA = 1.4142135623730951f;
constexpr float LOG2E = 1.4426950408889634f;
constexpr float C2_DIFF = 0.125f * LOG2E;
constexpr float C2_MLA = 0.07216878364870323f * LOG2E;
constexpr float C2_X = 0.08838834764831845f * LOG2E;
constexpr int MOE_MAXROWS = 34816;

typedef __bf16 bf16x2_t __attribute__((ext_vector_type(2)));
__device__ __forceinline__ unsigned cvt_pk_bf16(float lo, float hi) { const f32x2 v = {lo, hi}; const bf16x2_t b = __builtin_convertvector(v, bf16x2_t); return __builtin_bit_cast(unsigned, b); }
__device__ __forceinline__ float bf_lo(unsigned w) { return __uint_as_float(w << 16); }
__device__ __forceinline__ float bf_hi(unsigned w) { return __uint_as_float(w & 0xffff0000u); }
__device__ __forceinline__ u32x4 pack8(f32x4 a, f32x4 b) { u32x4 w; w.x = cvt_pk_bf16(a[0], a[1]); w.y = cvt_pk_bf16(a[2], a[3]); w.z = cvt_pk_bf16(b[0], b[1]); w.w = cvt_pk_bf16(b[2], b[3]); return w; }
__device__ __forceinline__ u32x2 pack8_fp8(f32x4 a, f32x4 b) { int w0 = 0, w1 = 0;
    w0 = __builtin_amdgcn_cvt_pk_fp8_f32(a[0], a[1], w0, false); w0 = __builtin_amdgcn_cvt_pk_fp8_f32(a[2], a[3], w0, true);
    w1 = __builtin_amdgcn_cvt_pk_fp8_f32(b[0], b[1], w1, false); w1 = __builtin_amdgcn_cvt_pk_fp8_f32(b[2], b[3], w1, true);
    u32x2 r; r.x = (unsigned)w0; r.y = (unsigned)w1; return r; }
__device__ __forceinline__ float fast_sigmoid(float x) { return __builtin_amdgcn_rcpf(1.f + __builtin_amdgcn_exp2f(-x * LOG2E)); }
constexpr int LDS_WTAB = 131072 + 8192 + 1024;
__device__ __forceinline__ int opaque_tid() {
    const unsigned hw = __builtin_amdgcn_s_getreg(0x2804);
    const int wave = __builtin_amdgcn_readfirstlane(((volatile LAS int*)LDS_WTAB)[hw]);
    int lane; asm volatile("v_mbcnt_lo_u32_b32 %0, -1, 0\n\tv_mbcnt_hi_u32_b32 %0, -1, %0" : "=v"(lane));
    return wave * 64 + lane;
}
__device__ __forceinline__ float shflx(float v, int off, int lane) { return __int_as_float(__builtin_amdgcn_ds_bpermute((lane ^ off) << 2, __float_as_int(v))); }
__device__ __forceinline__ float wave_sum(float v, int lane) {
#pragma unroll
    for (int o = 1; o < 64; o <<= 1) v += shflx(v, o, lane);
    return v;
}

namespace pg8 {
constexpr int BM = 256, BK = 64, HALF = 128, HTB = HALF * BK * 2, STAGE_BYTES = 8 * HTB, NXCD = 8, WGM = 8;
__host__ __device__ __forceinline__ int lds_byte(int r, int c) { const int st = (r >> 4) * 2 + (c >> 5), rr = r & 15, cc = c & 31, ob = rr * 64 + cc * 2; return st * 1024 + (ob ^ (((ob >> 9) & 1) << 5)); }
__host__ __device__ __forceinline__ void stage_rc(int b, int& R, int& C) { const int st = b / 1024, sb = b % 1024, swz = sb ^ (((sb >> 9) & 1) << 5); R = (st >> 1) * 16 + swz / 64; C = (st & 1) * 32 + (swz % 64) / 2; }
__host__ __device__ __forceinline__ int perm32(int rho) { const int n = rho >> 4, i = rho & 15; return 8 * (i >> 2) + 4 * n + (i & 3); }

__device__ __forceinline__ size_t uni64(size_t v) { const unsigned lo_ = __builtin_amdgcn_readfirstlane((unsigned)v), hi_ = __builtin_amdgcn_readfirstlane((unsigned)(v >> 32)); return ((size_t)hi_ << 32) | lo_; }
struct Unit { int pm, pn, z; size_t offA, offB; };
struct Gemm { const void* A; const void* Bt; int ldaB, ldbB, KB; int wscale; };
typedef int v8i __attribute__((ext_vector_type(8)));
typedef int v4i __attribute__((ext_vector_type(4)));

struct TileOrder {
    int nM, nN, nwg;
    __device__ __forceinline__ void init(int nM_, int nN_) { nM = nM_; nN = nN_; nwg = nM * nN; }
    __device__ __forceinline__ bool map(long L, int& pm, int& pn) const {
        if (L >= nwg) return false;
        int wgid = (int)L; { const int q = nwg / NXCD, r = nwg % NXCD, xcd = wgid % NXCD, off = wgid / NXCD; wgid = (xcd < r ? xcd * (q + 1) : r * (q + 1) + (xcd - r) * q) + off; }
        const int nig = WGM * nN, gid = wgid / nig, fm = gid * WGM, gsz = (nM - fm) < WGM ? (nM - fm) : WGM;
        pm = __builtin_amdgcn_readfirstlane(fm + ((wgid % nig) % gsz)); pn = __builtin_amdgcn_readfirstlane((wgid % nig) / gsz); return true;
    }
};

template <bool FP8, int WSC, class Epi, class Sched>
__device__ __forceinline__ void gemm_phase_t(LAS unsigned char* lds, const Gemm g, const Sched& S, const Epi& E) {
    const int tid = opaque_tid(), wid = __builtin_amdgcn_readfirstlane(tid >> 6), lane = tid & 63, wr = wid >> 2, wc = wid & 3, fr = lane & 15, fq = lane >> 4;
    const int nt = g.KB / (BK * 2);
    unsigned voffA[2], voffB[2];
#pragma unroll
    for (int i = 0; i < 2; ++i) { int R, C; stage_rc(tid * 16 + i * 8192, R, C); const int Rb = (R & ~31) + perm32(R & 31);
        voffA[i] = (unsigned)(R * g.ldaB + C * 2); voffB[i] = (unsigned)(Rb * g.ldbB + C * 2); }
    const size_t kstep = (size_t)(BK * 2);
    const size_t hstepA = (size_t)HALF * g.ldaB, hstepB = (size_t)HALF * g.ldbB;
    const unsigned ldsw = (unsigned)wid * 1024u;
    const unsigned lds_u = __builtin_amdgcn_readfirstlane((unsigned)(uintptr_t)lds + ldsw);
    const int aoff = lds_byte(wr * 64 + fr, fq * 8), boff = lds_byte(wc * 32 + fr, fq * 8);
#define PG8_SA(b, h) (((b) * 2 + (h)) * HTB)
#define PG8_SB(b, h) ((4 + (b) * 2 + (h)) * HTB)
#define PG8_STAGE(bufoff, gbase, voff) do { _Pragma("unroll") for (int _i = 0; _i < 2; ++_i) \
        { unsigned _keep; asm volatile("s_mov_b32 %0, m0\n\ts_mov_b32 m0, %1\n\ts_nop 0\n\tglobal_load_lds_dwordx4 %2, %3\n\ts_mov_b32 m0, %0" : "=&s"(_keep) : "s"(lds_u + (unsigned)((bufoff) + _i * 8192)), "v"((voff)[_i]), "s"(gbase) : "memory"); } } while (0)
#define PG8_LD32(p) __builtin_shufflevector(*(const LAS v4i*)(p), *(const LAS v4i*)((p) + 1024), 0, 1, 2, 3, 4, 5, 6, 7)
#define PG8_LDA(dst, b, h) do { _Pragma("unroll") for (int m = 0; m < 4; ++m) dst[m] = PG8_LD32(lds + PG8_SA(b, h) + aoff + m * 2048); } while (0)
#define PG8_LDB(dst, b, h) do { _Pragma("unroll") for (int n = 0; n < 2; ++n) dst[n] = PG8_LD32(lds + PG8_SB(b, h) + boff + n * 2048); } while (0)
#define PG8_H0(x) __builtin_bit_cast(bf16x8, __builtin_shufflevector((x), (x), 0, 1, 2, 3))
#define PG8_H1(x) __builtin_bit_cast(bf16x8, __builtin_shufflevector((x), (x), 4, 5, 6, 7))
#define PG8_MMA(ai, bj, At, Bt) do { __builtin_amdgcn_s_setprio(1); _Pragma("unroll") for (int m = 0; m < 4; ++m) _Pragma("unroll") for (int n = 0; n < 2; ++n) { \
        if constexpr (FP8) asm volatile("v_mfma_scale_f32_16x16x128_f8f6f4 %0, %1, %2, %0, %3, %3 op_sel_hi:[0,0,0]" : "+v"(acc[ai][bj][m][n]) : "v"(Bt[n]), "v"(At[m]), "v"(wsc_v));     \
        else { acc[ai][bj][m][n] = __builtin_amdgcn_mfma_f32_16x16x32_bf16(PG8_H0(Bt[n]), PG8_H0(At[m]), acc[ai][bj][m][n], 0, 0, 0); acc[ai][bj][m][n] = __builtin_amdgcn_mfma_f32_16x16x32_bf16(PG8_H1(Bt[n]), PG8_H1(At[m]), acc[ai][bj][m][n], 0, 0, 0); } } \
        __builtin_amdgcn_s_setprio(0); } while (0)
#define PG8_WAIT_V(n) asm volatile("s_waitcnt vmcnt(" #n ")" ::: "memory")
#define PG8_WAIT_L(n) asm volatile("s_waitcnt lgkmcnt(" #n ")" ::: "memory")
#define PG8_BAR __builtin_amdgcn_s_barrier()
#define PG8_SCHED __builtin_amdgcn_sched_barrier(0)
    Unit cur, nxt; int ui = 0;
    if (!S.next(0, cur)) return;
    f32x4 acc[2][2][4][2];
#pragma unroll
    for (int a = 0; a < 2; ++a)
#pragma unroll
        for (int b = 0; b < 2; ++b)
#pragma unroll
            for (int m = 0; m < 4; ++m)
#pragma unroll
                for (int n = 0; n < 2; ++n) acc[a][b][m][n] = (f32x4){0.f, 0.f, 0.f, 0.f};
    v8i At[4], B0[2], B1[2]; const int wsc_v = WSC; (void)wsc_v;
    const char* cA = (const char*)g.A + uni64(cur.offA); const char* cB = (const char*)g.Bt + uni64(cur.offB);
    PG8_STAGE(PG8_SB(0, 0), cB, voffB); PG8_STAGE(PG8_SB(0, 1), cB + hstepB, voffB); PG8_STAGE(PG8_SA(0, 0), cA, voffA); PG8_STAGE(PG8_SA(0, 1), cA + hstepA, voffA);
    if (wr == 1) PG8_BAR;
    PG8_WAIT_V(2); PG8_BAR;
    PG8_STAGE(PG8_SB(1, 0), cB + kstep, voffB); PG8_STAGE(PG8_SA(1, 0), cA + kstep, voffA); PG8_STAGE(PG8_SB(1, 1), cB + hstepB + kstep, voffB);
    PG8_WAIT_V(6); PG8_BAR;
    for (;;) {
        const bool has_next = S.next(ui + 1, nxt);
        const char* nA = has_next ? (const char*)g.A + uni64(nxt.offA) : cA; const char* nB = has_next ? (const char*)g.Bt + uni64(nxt.offB) : cB;
        for (int t = 0; t < nt; t += 2) {
            const bool last = (t == nt - 2);
            const char* a1 = cA + (size_t)(t + 1) * kstep;
            const char* a2 = last ? nA : cA + (size_t)(t + 2) * kstep; const char* b2 = last ? nB : cB + (size_t)(t + 2) * kstep;
            const char* a3 = a2 + kstep; const char* b3 = b2 + kstep;
            PG8_LDB(B0, 0, 0); PG8_LDB(B1, 0, 1); PG8_SCHED; PG8_LDA(At, 0, 0); PG8_STAGE(PG8_SA(1, 1), a1 + hstepA, voffA);
            PG8_WAIT_V(8); PG8_WAIT_L(0); PG8_BAR; PG8_MMA(0, 0, At, B0); PG8_MMA(0, 1, At, B1); PG8_BAR; PG8_SCHED;
            PG8_LDA(At, 0, 1); PG8_STAGE(PG8_SB(0, 0), b2, voffB); PG8_STAGE(PG8_SB(0, 1), b2 + hstepB, voffB); PG8_STAGE(PG8_SA(0, 0), a2, voffA);
            PG8_WAIT_V(8); PG8_WAIT_L(0); PG8_BAR; PG8_MMA(1, 0, At, B0); PG8_MMA(1, 1, At, B1); PG8_BAR; PG8_SCHED;
            PG8_LDB(B0, 1, 0); PG8_LDB(B1, 1, 1); PG8_SCHED; PG8_LDA(At, 1, 0); PG8_STAGE(PG8_SA(0, 1), a2 + hstepA, voffA);
            PG8_WAIT_V(8); PG8_WAIT_L(0); PG8_BAR; PG8_MMA(0, 0, At, B0); PG8_MMA(0, 1, At, B1); PG8_BAR; PG8_SCHED;
            PG8_LDA(At, 1, 1); PG8_STAGE(PG8_SB(1, 0), b3, voffB); PG8_STAGE(PG8_SB(1, 1), b3 + hstepB, voffB); PG8_STAGE(PG8_SA(1, 0), a3, voffA);
            PG8_WAIT_V(8); PG8_WAIT_L(0); PG8_BAR; PG8_MMA(1, 0, At, B0); PG8_MMA(1, 1, At, B1); PG8_BAR; PG8_SCHED;
        }
        if (wr == 0) PG8_BAR;
        if constexpr (FP8) asm volatile("s_nop 15\n\ts_nop 15" ::: "memory");
        E(acc, cur, wr, wc, fr, fq);
        if (!has_next) break;
#pragma unroll
        for (int a = 0; a < 2; ++a)
#pragma unroll
            for (int b = 0; b < 2; ++b)
#pragma unroll
                for (int m = 0; m < 4; ++m)
#pragma unroll
                    for (int n = 0; n < 2; ++n) acc[a][b][m][n] = (f32x4){0.f, 0.f, 0.f, 0.f};
        cur = nxt; cA = nA; cB = nB; ++ui;
        if (wr == 1) PG8_BAR;
    }
    PG8_WAIT_V(0);
    PG8_BAR;
#undef PG8_SA
#undef PG8_SB
#undef PG8_STAGE
#undef PG8_LDA
#undef PG8_LDB
#undef PG8_MMA
#undef PG8_H0
#undef PG8_H1
#undef PG8_LD32
#undef PG8_WAIT_V
#undef PG8_WAIT_L
#undef PG8_BAR
#undef PG8_SCHED
}
template <class Epi, class Sched> __device__ __forceinline__ void gemm_phase(LAS unsigned char* lds, const Gemm g, const Sched& S, const Epi& E) { gemm_phase_t<false, 0>(lds, g, S, E); }
}

struct SchedPlain {
    pg8::TileOrder T; int G, c; size_t tA, tB;
    __device__ __forceinline__ void init(int nM, int nN, int lda, int ldb, int G_, int c_) { T.init(nM, nN); G = G_; c = c_; tA = (size_t)256 * lda * 2; tB = (size_t)256 * ldb * 2; }
    __device__ __forceinline__ bool next(int i, pg8::Unit& u) const { if (!T.map((long)i * G + c, u.pm, u.pn)) return false; u.z = 0; u.offA = u.pm * tA; u.offB = u.pn * tB; return true; }
};
struct SchedBatch {
    int nM, nN, nZ, G, c; size_t tA, tB, zA, zB;
    __device__ __forceinline__ bool next(int i, pg8::Unit& u) const {
        const long L = (long)i * G + c; const int per = nM * nN; if (L >= (long)per * nZ) return false;
        const int z = __builtin_amdgcn_readfirstlane((int)(L / per)), r = __builtin_amdgcn_readfirstlane((int)(L % per)); u.z = z; u.pm = __builtin_amdgcn_readfirstlane(r / nN); u.pn = __builtin_amdgcn_readfirstlane(r % nN); u.offA = z * zA + u.pm * tA; u.offB = z * zB + u.pn * tB; return true; }
};
struct SchedBranch {
    pg8::TileOrder T; int G, c; size_t tA, tB, zA, zB;
    __device__ __forceinline__ bool next(int i, pg8::Unit& u) const { const int t = i / 3, z = i - 3 * t; if (!T.map((long)t * G + c, u.pm, u.pn)) return false; u.z = z; u.offA = z * zA + u.pm * tA; u.offB = z * zB + u.pn * tB; return true; }
};
struct SchedMoe {
    pg8::TileOrder T; int G, c; size_t tA, tB, zB; int off[7];
    __device__ __forceinline__ bool next(int i, pg8::Unit& u) const {
        if (!T.map((long)i * G + c, u.pm, u.pn)) return false; const int r0 = u.pm * 256; int e = 0;
#pragma unroll
        for (int k = 0; k < 7; ++k) e += (r0 >= off[k]) ? 1 : 0;
        e = __builtin_amdgcn_readfirstlane(e); u.z = e; u.offA = u.pm * tA; u.offB = e * zB + u.pn * tB; return true; }
};

#define EPI_ARGS const f32x4 (&acc)[2][2][4][2], const pg8::Unit& u, int wr, int wc, int fr, int fq
#define EPI_ROW(ai, m) (u.pm * 256 + (ai) * 128 + wr * 64 + (m) * 16 + fr)
#define EPI_CB(bj) ((bj) * 128 + wc * 32 + fq * 8)
#define FOR_AI_M _Pragma("unroll") for (int ai = 0; ai < 2; ++ai) _Pragma("unroll") for (int m = 0; m < 4; ++m)
#define FOR_BJ _Pragma("unroll") for (int bj = 0; bj < 2; ++bj)

__device__ __forceinline__ void rope4(f32x4& v0, f32x4& v1, const f32x4 t0, const f32x4 t1) {
    const float a0 = v0[0] * t0[0] - v0[1] * t0[1], b0 = v0[1] * t0[0] + v0[0] * t0[1];
    const float a1 = v0[2] * t0[2] - v0[3] * t0[3], b1 = v0[3] * t0[2] + v0[2] * t0[3];
    const float a2 = v1[0] * t1[0] - v1[1] * t1[1], b2 = v1[1] * t1[0] + v1[0] * t1[1];
    const float a3 = v1[2] * t1[2] - v1[3] * t1[3], b3 = v1[3] * t1[2] + v1[2] * t1[3];
    v0 = (f32x4){a0, b0, a1, b1}; v1 = (f32x4){a2, b2, a3, b3};
}

struct EpiInProj {
    bf16_t *QD, *KD, *VD, *MQ, *MKV, *KM, *SU, *GATES; float *ssq_q, *ssq_kv; const float* tabd; const float* tabm;
    int pn_add;
    __device__ __forceinline__ void operator()(EPI_ARGS) const {
        const int pn = u.pn + pn_add;
        if (pn < 8) {
            bf16_t* O = pn < 4 ? QD : KD; const float sc = pn < 4 ? C2_DIFF : 1.f; const int colt = (pn & 3) * 256;
            const bool rp = ((wc & 1) == 0) && fq < 2;
#pragma unroll
            for (int ai = 0; ai < 2; ++ai) { f32x4 tt[4][2];
#pragma unroll
                for (int m = 0; m < 4; ++m) { tt[m][0] = (f32x4){1.f, 0.f, 1.f, 0.f}; tt[m][1] = (f32x4){1.f, 0.f, 1.f, 0.f};
                    if (rp) { const f32x4* tp = (const f32x4*)(tabd + (size_t)EPI_ROW(ai, m) * 16 + fq * 8); tt[m][0] = tp[0]; tt[m][1] = tp[1]; } }
#pragma unroll
                for (int m = 0; m < 4; ++m) { const int row = EPI_ROW(ai, m);
                    FOR_BJ { f32x4 v0 = acc[ai][bj][m][0], v1 = acc[ai][bj][m][1]; rope4(v0, v1, tt[m][0], tt[m][1]); v0 = v0 * sc; v1 = v1 * sc;
                        *(u32x4*)(O + (size_t)row * 1024 + colt + EPI_CB(bj)) = pack8(v0, v1); } } }
        } else if (pn < 12) {
            const int colt = (pn - 8) * 256;
            FOR_AI_M { const int row = EPI_ROW(ai, m); FOR_BJ { *(u32x4*)(VD + (size_t)row * 1024 + colt + EPI_CB(bj)) = pack8(acc[ai][bj][m][0], acc[ai][bj][m][1]); } }
        } else if (pn < 15) {
            bf16_t* O = pn < 14 ? MQ : MKV; const int ld = pn < 14 ? 512 : 256, colt = pn < 14 ? (pn - 12) * 256 : 0; float* ssq = pn < 14 ? ssq_q + (pn - 12) * 4 + wc : ssq_kv + wc; const int ns = pn < 14 ? 8 : 4;
            FOR_AI_M { const int row = EPI_ROW(ai, m); float s = 0.f;
                FOR_BJ { const f32x4 v0 = acc[ai][bj][m][0], v1 = acc[ai][bj][m][1]; s += (v0[0] * v0[0] + v0[1] * v0[1]) + (v0[2] * v0[2] + v0[3] * v0[3]) + (v1[0] * v1[0] + v1[1] * v1[1]) + (v1[2] * v1[2] + v1[3] * v1[3]);
                    *(u32x4*)(O + (size_t)row * ld + colt + EPI_CB(bj)) = pack8(v0, v1); }
                s += shflx(s, 16, fq * 16 + fr); s += shflx(s, 32, fq * 16 + fr);
                if (fq == 0) ssq[(size_t)row * ns] = s; }
        } else if (pn == 15) {
            if (wc < 2) {
                FOR_AI_M { const int row = EPI_ROW(ai, m); const f32x4* tp = (const f32x4*)(tabm + (size_t)row * 64 + (wc * 16 + fq * 4) * 2);
                    f32x4 v0 = acc[ai][0][m][0], v1 = acc[ai][0][m][1]; rope4(v0, v1, tp[0], tp[1]); const u32x4 w = pack8(v0, v1);
#pragma unroll
                    for (int h = 0; h < 8; ++h) *(u32x4*)(KM + (size_t)row * 1536 + h * 192 + 128 + wc * 32 + fq * 8) = w; }
            }
        } else if (pn < 20) {
            FOR_AI_M { const int row = EPI_ROW(ai, m); const int c = row >> 5, j = row & 31;
                FOR_BJ { const int ch = (pn - 16) * 256 + EPI_CB(bj), g = ch >> 4, q = ch & 15;
                    *(u32x4*)(SU + ((size_t)(g * SSM_NCH + c) * SSM_KX + j * 16 + q)) = pack8(acc[ai][bj][m][0], acc[ai][bj][m][1]); } }
        } else {
            const int colt = (pn - 20) * 256;
            FOR_AI_M { const int row = EPI_ROW(ai, m);
                FOR_BJ { f32x4 v0 = acc[ai][bj][m][0], v1 = acc[ai][bj][m][1];
#pragma unroll
                    for (int e = 0; e < 4; ++e) { v0[e] = fast_sigmoid(v0[e]); v1[e] = fast_sigmoid(v1[e]); }
                    *(u32x4*)(GATES + (size_t)row * 6144 + colt + EPI_CB(bj)) = pack8(v0, v1); } }
        }
    }
};
struct EpiQup {
    bf16_t* QM; const float* ssq; const float* tabm;
    __device__ __forceinline__ void operator()(EPI_ARGS) const {
#pragma unroll
        for (int ai = 0; ai < 2; ++ai) { f32x4 sq[4][2];
#pragma unroll
            for (int m = 0; m < 4; ++m) { const int row = EPI_ROW(ai, m); sq[m][0] = *(const f32x4*)(ssq + (size_t)row * 8); sq[m][1] = *(const f32x4*)(ssq + (size_t)row * 8 + 4); }
#pragma unroll
            for (int m = 0; m < 4; ++m) { const int row = EPI_ROW(ai, m); const f32x4 s0 = sq[m][0], s1 = sq[m][1];
                const float rq = __builtin_amdgcn_rsqf((((s0[0] + s0[1]) + (s0[2] + s0[3])) + ((s1[0] + s1[1]) + (s1[2] + s1[3]))) * (1.f / 512.f) + RMS_EPS) * C2_MLA;
                FOR_BJ { const int col = u.pn * 256 + EPI_CB(bj), h = col / 192, hc = col - h * 192; f32x4 v0 = acc[ai][bj][m][0], v1 = acc[ai][bj][m][1];
                    if (hc >= 128) { const f32x4* tp = (const f32x4*)(tabm + (size_t)row * 64 + (hc - 128)); rope4(v0, v1, tp[0], tp[1]); }
                    v0 = v0 * rq; v1 = v1 * rq; *(u32x4*)(QM + (size_t)row * 1536 + col) = pack8(v0, v1); } } }
    }
};
struct EpiKVup {
    bf16_t *KM, *VM; const float* ssq;
    __device__ __forceinline__ void operator()(EPI_ARGS) const {
#pragma unroll
        for (int ai = 0; ai < 2; ++ai) { float rk[4];
#pragma unroll
            for (int m = 0; m < 4; ++m) { const f32x4 s0 = *(const f32x4*)(ssq + (size_t)EPI_ROW(ai, m) * 4); rk[m] = ((s0[0] + s0[1]) + (s0[2] + s0[3])); }
#pragma unroll
            for (int m = 0; m < 4; ++m) { const int row = EPI_ROW(ai, m); const float r = __builtin_amdgcn_rsqf(rk[m] * (1.f / 256.f) + RMS_EPS); const int c = wc * 32 + fq * 8;
                *(u32x4*)(KM + (size_t)row * 1536 + u.pn * 192 + c) = pack8(acc[ai][0][m][0] * r, acc[ai][0][m][1] * r);
                *(u32x4*)(VM + (size_t)row * 1024 + u.pn * 128 + c) = pack8(acc[ai][1][m][0] * r, acc[ai][1][m][1] * r); } }
    }
};
struct EpiSloc {
    float* SLOC;
    __device__ __forceinline__ void operator()(EPI_ARGS) const {
        FOR_AI_M { const int c = EPI_ROW(ai, m); float* o = SLOC + ((size_t)(u.z * SSM_NCH + c) * 128 + wc * 32 + fq * 8);
            *(f32x4*)o = acc[ai][0][m][0]; *(f32x4*)(o + 4) = acc[ai][0][m][1]; }
    }
};
__device__ __forceinline__ float gelu_tanh(float x) { const float t = 1.5957691216057308f * (x + 0.044715f * x * x * x); return x * fast_sigmoid(t); }
struct EpiSsmY {
    bf16_t* YG; const bf16_t* SU; const float* dskip;
    __device__ __forceinline__ void operator()(EPI_ARGS) const {
        const int g = u.z; f32x4 d0[2], d1[2];
        FOR_BJ { const int col = u.pn * 256 + EPI_CB(bj), ch = g * 16 + (col & 15); d0[bj] = *(const f32x4*)(dskip + ch); d1[bj] = *(const f32x4*)(dskip + ch + 4); }
#pragma unroll
        for (int ai = 0; ai < 2; ++ai) { u32x4 uu[4][2];
#pragma unroll
            for (int m = 0; m < 4; ++m) { const int c = EPI_ROW(ai, m);
                FOR_BJ { const int col = u.pn * 256 + EPI_CB(bj), i = col >> 4, p0 = col & 15; uu[m][bj] = *(const u32x4*)(SU + ((size_t)(g * SSM_NCH + c) * SSM_KX + i * 16 + p0)); } }
#pragma unroll
            for (int m = 0; m < 4; ++m) { const int c = EPI_ROW(ai, m);
                FOR_BJ { const int col = u.pn * 256 + EPI_CB(bj), i = col >> 4, p0 = col & 15, t = c * SSM_L + i, ch = g * 16 + p0; const u32x4 w = uu[m][bj];
                    f32x4 v0 = acc[ai][bj][m][0], v1 = acc[ai][bj][m][1];
                    v0[0] += d0[bj][0] * bf_lo(w.x); v0[1] += d0[bj][1] * bf_hi(w.x); v0[2] += d0[bj][2] * bf_lo(w.y); v0[3] += d0[bj][3] * bf_hi(w.y);
                    v1[0] += d1[bj][0] * bf_lo(w.z); v1[1] += d1[bj][1] * bf_hi(w.z); v1[2] += d1[bj][2] * bf_lo(w.w); v1[3] += d1[bj][3] * bf_hi(w.w);
#pragma unroll
                    for (int e = 0; e < 4; ++e) { v0[e] = gelu_tanh(v0[e]); v1[e] = gelu_tanh(v1[e]); }
                    *(u32x4*)(YG + (size_t)t * 1024 + ch) = pack8(v0, v1); } } }
    }
};
template <int ACT  > struct EpiGated {
    bf16_t* O; int ldo;
    __device__ __forceinline__ void operator()(EPI_ARGS) const {
        FOR_AI_M { const int row = EPI_ROW(ai, m); f32x4 r[2];
#pragma unroll
            for (int n = 0; n < 2; ++n)
#pragma unroll
                for (int e = 0; e < 4; ++e) { const float a = acc[ai][0][m][n][e], b = acc[ai][1][m][n][e]; r[n][e] = ACT == 0 ? a * fast_sigmoid(b) : a * fast_sigmoid(a) * b; }
            *(u32x4*)(O + (size_t)row * ldo + u.pn * 128 + wc * 32 + fq * 8) = pack8(r[0], r[1]); }
    }
};
struct EpiSwigluF8 {
    unsigned char* O; int ldo;
    __device__ __forceinline__ void operator()(EPI_ARGS) const {
        FOR_AI_M { const int row = EPI_ROW(ai, m); f32x4 r[2];
#pragma unroll
            for (int n = 0; n < 2; ++n)
#pragma unroll
                for (int e = 0; e < 4; ++e) { const float a = acc[ai][0][m][n][e], b = acc[ai][1][m][n][e]; r[n][e] = a * fast_sigmoid(a) * b; }
            *(u32x2*)(O + (size_t)row * ldo + u.pn * 128 + wc * 32 + fq * 8) = pack8_fp8(r[0], r[1]); }
    }
};
struct EpiGatesF8 {
    bf16_t* GATES;
    __device__ __forceinline__ void operator()(EPI_ARGS) const {
        FOR_AI_M { const int row = EPI_ROW(ai, m);
            FOR_BJ { f32x4 v0 = acc[ai][bj][m][0], v1 = acc[ai][bj][m][1];
#pragma unroll
                for (int e = 0; e < 4; ++e) { v0[e] = fast_sigmoid(v0[e]); v1[e] = fast_sigmoid(v1[e]); }
                *(u32x4*)(GATES + (size_t)row * 6144 + u.pn * 256 + EPI_CB(bj)) = pack8(v0, v1); } }
    }
};
struct EpiBranch {
    const bf16_t* GATES; bf16_t* P; bf16_t* MG;
    __device__ __forceinline__ void operator()(EPI_ARGS) const {
        const int z = u.z;
#pragma unroll
        for (int ai = 0; ai < 2; ++ai)
#pragma unroll
            for (int mh = 0; mh < 2; ++mh) { u32x4 gg[2][2], pa[2][2], pb[2][2];
#pragma unroll
                for (int mm = 0; mm < 2; ++mm) { const int row = EPI_ROW(ai, mh * 2 + mm);
                    FOR_BJ { const int col = u.pn * 256 + EPI_CB(bj); gg[mm][bj] = *(const u32x4*)(GATES + (size_t)row * 6144 + z * 2048 + col);
                        if (z == 2) { const size_t o = (size_t)row * 2048 + col; pa[mm][bj] = *(const u32x4*)(P + o); pb[mm][bj] = *(const u32x4*)(P + (size_t)M * 2048 + o); } } }
#pragma unroll
                for (int mm = 0; mm < 2; ++mm) { const int m = mh * 2 + mm, row = EPI_ROW(ai, m);
                    FOR_BJ { const int col = u.pn * 256 + EPI_CB(bj); const u32x4 g = gg[mm][bj];
                        f32x4 v0 = acc[ai][bj][m][0], v1 = acc[ai][bj][m][1];
                        v0[0] *= bf_lo(g.x); v0[1] *= bf_hi(g.x); v0[2] *= bf_lo(g.y); v0[3] *= bf_hi(g.y);
                        v1[0] *= bf_lo(g.z); v1[1] *= bf_hi(g.z); v1[2] *= bf_lo(g.w); v1[3] *= bf_hi(g.w);
                        const size_t o = (size_t)row * 2048 + col;
                        if (z < 2) *(u32x4*)(P + (size_t)z * M * 2048 + o) = pack8(v0, v1);
                        else { const u32x4 a = pa[mm][bj], b = pb[mm][bj];
                            v0[0] += bf_lo(a.x) + bf_lo(b.x); v0[1] += bf_hi(a.x) + bf_hi(b.x); v0[2] += bf_lo(a.y) + bf_lo(b.y); v0[3] += bf_hi(a.y) + bf_hi(b.y);
                            v1[0] += bf_lo(a.z) + bf_lo(b.z); v1[1] += bf_hi(a.z) + bf_hi(b.z); v1[2] += bf_lo(a.w) + bf_lo(b.w); v1[3] += bf_hi(a.w) + bf_hi(b.w);
                            *(u32x4*)(MG + o) = pack8(v0, v1); } } } }
    }
};
struct EpiResid {
    bf16_t* X;
    __device__ __forceinline__ void operator()(EPI_ARGS) const {
#pragma unroll
        for (int ai = 0; ai < 2; ++ai) { u32x4 r[4][2];
#pragma unroll
            for (int m = 0; m < 4; ++m) { const int row = EPI_ROW(ai, m);
                FOR_BJ { r[m][bj] = *(const u32x4*)(X + (size_t)row * 2048 + u.pn * 256 + EPI_CB(bj)); } }
#pragma unroll
            for (int m = 0; m < 4; ++m) { const int row = EPI_ROW(ai, m);
                FOR_BJ { const u32x4 w = r[m][bj]; f32x4 v0 = acc[ai][bj][m][0], v1 = acc[ai][bj][m][1];
                    v0[0] += ALPHA * bf_lo(w.x); v0[1] += ALPHA * bf_hi(w.x); v0[2] += ALPHA * bf_lo(w.y); v0[3] += ALPHA * bf_hi(w.y);
                    v1[0] += ALPHA * bf_lo(w.z); v1[1] += ALPHA * bf_hi(w.z); v1[2] += ALPHA * bf_lo(w.w); v1[3] += ALPHA * bf_hi(w.w);
                    *(u32x4*)(X + (size_t)row * 2048 + u.pn * 256 + EPI_CB(bj)) = pack8(v0, v1); } } }
    }
};
struct EpiBf16 {
    bf16_t* O; int ldo; float scale;
    __device__ __forceinline__ void operator()(EPI_ARGS) const {
        FOR_AI_M { const int row = EPI_ROW(ai, m); FOR_BJ { *(u32x4*)(O + (size_t)row * ldo + u.pn * 256 + EPI_CB(bj)) = pack8(acc[ai][bj][m][0] * scale, acc[ai][bj][m][1] * scale); } }
    }
};
struct EpiBf16Half {
    bf16_t* O; int ldo; float scale;
    __device__ __forceinline__ void operator()(EPI_ARGS) const {
#pragma unroll
        for (int m = 0; m < 4; ++m) { const int row = u.pm * 128 + wr * 64 + m * 16 + fr;
            FOR_BJ { *(u32x4*)(O + (size_t)row * ldo + u.pn * 256 + EPI_CB(bj)) = pack8(acc[0][bj][m][0] * scale, acc[0][bj][m][1] * scale); } }
    }
};
struct EpiMoeDown {
    bf16_t* OG; const float* wslot;
    __device__ __forceinline__ void operator()(EPI_ARGS) const {
        float w[2][4];
        FOR_AI_M w[ai][m] = wslot[EPI_ROW(ai, m)];
        FOR_AI_M { const int row = EPI_ROW(ai, m);
            FOR_BJ { *(u32x4*)(OG + (size_t)row * 2048 + u.pn * 256 + EPI_CB(bj)) = pack8(acc[ai][bj][m][0] * w[ai][m], acc[ai][bj][m][1] * w[ai][m]); } }
    }
};

namespace att {
constexpr int KVBLK = 64, SHM_V = KVBLK * 128 * 2;
constexpr float THRL = 8.f;
__device__ __forceinline__ int crow(int r, int hi) { return (r & 3) + 8 * (r >> 2) + 4 * hi; }
template <int PITCH> __device__ __forceinline__ int kfl(int row) { return (PITCH % 256 == 128) ? ((row >> 1) & 7) : (row & 15); }
template <int PITCH> __device__ __forceinline__ int kswz(int row, int colB) { return row * PITCH + (colB ^ (kfl<PITCH>(row) << 4)); }
__device__ __forceinline__ int v_st(int k, int c) { const int kk = k; return ((kk >> 3) * 4 + (c >> 5)) * 512 + ((kk & 7) * 32 + (c & 31)) * 2; }
__device__ __forceinline__ int v_rd_base(int lane) { return ((lane & 3) << 3) | (((lane >> 2) & 3) << 6) | (((lane >> 4) & 1) << 5) | (((lane >> 5) & 1) << 8); }
constexpr int v_rd_off(int d0, int ks, int half) { return d0 * 512 + ks * 4096 + half * 2048; }

__device__ __forceinline__ void mask_tile(f32x16& p0, f32x16& p1, int dq) {
    const float NEG = -__builtin_inff();
#pragma unroll
    for (int r = 0; r < 16; ++r) { const int c = (r & 3) + 8 * (r >> 2); if (dq - c < 0) p0[r] = NEG; if (dq - c - 32 < 0) p1[r] = NEG; }
}
__device__ __forceinline__ void partialSM(f32x16& p0, f32x16& p1, float& m_reg, float& alpha) {
    float pmax = p0[0];
#pragma unroll
    for (int r = 1; r < 16; ++r) pmax = fmaxf(pmax, p0[r]);
#pragma unroll
    for (int r = 0; r < 16; ++r) pmax = fmaxf(pmax, p1[r]);
    { auto rr = __builtin_amdgcn_permlane32_swap(__float_as_uint(pmax), __float_as_uint(pmax), false, false); pmax = fmaxf(__uint_as_float(rr[0]), __uint_as_float(rr[1])); }
    float mn;
    if (__builtin_expect(__all(pmax - m_reg <= THRL), 1)) { mn = m_reg; alpha = 1.f; }
    else { mn = fmaxf(m_reg, pmax); alpha = __builtin_amdgcn_exp2f(m_reg - mn); m_reg = mn; }
#pragma unroll
    for (int r = 0; r < 16; ++r) { p0[r] -= mn; p1[r] -= mn; }
#pragma unroll
    for (int r = 0; r < 16; ++r) p0[r] = __builtin_amdgcn_exp2f(p0[r]);
}
__device__ __forceinline__ void finishSM(f32x16& p0, f32x16& p1, float alpha, float& l_reg, bf16x8& pa0, bf16x8& pa1, bf16x8& pa2, bf16x8& pa3) {
#pragma unroll
    for (int r = 0; r < 16; ++r) p1[r] = __builtin_amdgcn_exp2f(p1[r]);
    float ps = 0;
#pragma unroll
    for (int r = 0; r < 16; ++r) ps += p0[r];
#pragma unroll
    for (int r = 0; r < 16; ++r) ps += p1[r];
    { auto rr = __builtin_amdgcn_permlane32_swap(__float_as_uint(ps), __float_as_uint(ps), false, false); ps = __uint_as_float(rr[0]) + __uint_as_float(rr[1]); }
    l_reg = l_reg * alpha + ps;
#define PK4(P, B_, OUT) do { unsigned a0 = cvt_pk_bf16(P[B_+0], P[B_+1]), a1 = cvt_pk_bf16(P[B_+2], P[B_+3]); unsigned b0 = cvt_pk_bf16(P[B_+4], P[B_+5]), b1 = cvt_pk_bf16(P[B_+6], P[B_+7]); \
        u32x4 w = {a0, a1, b0, b1}; OUT = *reinterpret_cast<bf16x8*>(&w); } while (0)
    PK4(p0, 0, pa0); PK4(p0, 8, pa1); PK4(p1, 0, pa2); PK4(p1, 8, pa3);
#undef PK4
}
template <int PITCH, int ND0>
__device__ __forceinline__ void qkt(f32x16& p0, f32x16& p1, const char* Kb, int r32, int hi, int kch0, const bf16x8* qr) {
    p0 = f32x16{}; p1 = f32x16{};
    const char* kb[4];
#pragma unroll
    for (int dd = 0; dd < 4; ++dd) kb[dd] = Kb + kswz<PITCH>(r32, (kch0 + dd * 2 + hi) * 16);
#pragma unroll
    for (int d0 = 0; d0 < ND0; ++d0) { const char* a = (PITCH % 256 == 0) ? Kb + kswz<PITCH>(r32, (kch0 + d0 * 2 + hi) * 16) : kb[d0 & 3] + (d0 >> 2) * 128;
        const bf16x8 b0 = *reinterpret_cast<const bf16x8*>(a);
        const bf16x8 b1 = *reinterpret_cast<const bf16x8*>(a + 32 * PITCH);
        p0 = __builtin_amdgcn_mfma_f32_32x32x16_bf16(b0, qr[d0], p0, 0, 0, 0);
        p1 = __builtin_amdgcn_mfma_f32_32x32x16_bf16(b1, qr[d0], p1, 0, 0, 0); }
}
__device__ __forceinline__ void pv_tile(f32x16* o, int vb0, bf16x8 pa0, bf16x8 pa1, bf16x8 pa2, bf16x8 pa3) {
    s16x4 va[8], vb[8];
#define TRRD(dst, off) asm volatile("ds_read_b64_tr_b16 %0, %1 offset:%2" : "=&v"(dst) : "v"(vb0), "i"(off) : "memory")
#define PV_RD(v, d0) do { constexpr int b_ = v_rd_off(d0, 0, 0); TRRD(v[0], b_); TRRD(v[1], b_ + 2048); TRRD(v[2], b_ + 4096); TRRD(v[3], b_ + 6144); TRRD(v[4], b_ + 8192); TRRD(v[5], b_ + 10240); TRRD(v[6], b_ + 12288); TRRD(v[7], b_ + 14336); } while (0)
#define PV_MM(v, d0) do { \
        o[d0] = __builtin_amdgcn_mfma_f32_32x32x16_bf16(pa0, (bf16x8){v[0][0], v[0][1], v[0][2], v[0][3], v[1][0], v[1][1], v[1][2], v[1][3]}, o[d0], 0, 0, 0); \
        o[d0] = __builtin_amdgcn_mfma_f32_32x32x16_bf16(pa1, (bf16x8){v[2][0], v[2][1], v[2][2], v[2][3], v[3][0], v[3][1], v[3][2], v[3][3]}, o[d0], 0, 0, 0); \
        o[d0] = __builtin_amdgcn_mfma_f32_32x32x16_bf16(pa2, (bf16x8){v[4][0], v[4][1], v[4][2], v[4][3], v[5][0], v[5][1], v[5][2], v[5][3]}, o[d0], 0, 0, 0); \
        o[d0] = __builtin_amdgcn_mfma_f32_32x32x16_bf16(pa3, (bf16x8){v[6][0], v[6][1], v[6][2], v[6][3], v[7][0], v[7][1], v[7][2], v[7][3]}, o[d0], 0, 0, 0); } while (0)
#define PV_W8(v) asm volatile("s_waitcnt lgkmcnt(8)" : "+v"(v[0]), "+v"(v[1]), "+v"(v[2]), "+v"(v[3]), "+v"(v[4]), "+v"(v[5]), "+v"(v[6]), "+v"(v[7]) :: "memory")
#define PV_W0(v) asm volatile("s_waitcnt lgkmcnt(0)" : "+v"(v[0]), "+v"(v[1]), "+v"(v[2]), "+v"(v[3]), "+v"(v[4]), "+v"(v[5]), "+v"(v[6]), "+v"(v[7]) :: "memory")
    PV_RD(va, 0); PV_RD(vb, 1); PV_W8(va); SBAR(); PV_MM(va, 0);
    PV_RD(va, 2); PV_W8(vb); SBAR(); PV_MM(vb, 1);
    PV_RD(vb, 3); PV_W8(va); SBAR(); PV_MM(va, 2);
    PV_W0(vb); SBAR(); PV_MM(vb, 3);
#undef PV_W0
#undef PV_W8
#undef PV_MM
#undef PV_RD
#undef TRRD
}

template <int KT, int ND0, bool CAUSAL, bool PIPE>
__device__ __forceinline__ void attn_core(const bf16_t* Qlane, const bf16_t* __restrict__ Kh, int ldk, const bf16_t* __restrict__ Vh, int ldv, int NT, int qpos, int qlo, int kch0,
                                          char* lds, f32x16 (&o)[4], float& l_reg) {
    constexpr int PITCH = KT * 2, SHM_K = KVBLK * PITCH, NKL = KT / 64, CPR = KT / 8;
    const int tid = opaque_tid(), wid = __builtin_amdgcn_readfirstlane(tid >> 6), lane = tid & 63, r32 = lane & 31, hi = lane >> 5;
    char* V_lds = lds; char* K_lds = lds + 2 * SHM_V;
    float* ws = (float*)(lds + 2 * SHM_V + 2 * SHM_K) + wid * 64; float* al_l = ws + 32;
    float m_reg = -1e30f; l_reg = 0.f;
#pragma unroll
    for (int d = 0; d < 4; ++d) o[d] = f32x16{};
    bf16x8 qr[ND0];
#pragma unroll
    for (int d0 = 0; d0 < ND0; ++d0) qr[d0] = *reinterpret_cast<const bf16x8*>(Qlane + d0 * 16);
    const int sr = tid >> 4, sc = (tid & 15) * 8, vst0 = v_st(sr, sc), vst1 = v_st(32 + sr, sc);
    const int vb0 = (int)(uintptr_t)V_lds + v_rd_base(lane);
    int krow[NKL], kcc[NKL];
#pragma unroll
    for (int i = 0; i < NKL; ++i) { const int cid = tid + 512 * i; krow[i] = cid / CPR; kcc[i] = cid - krow[i] * CPR; }
    bf16x8 st_v0, st_v1, st_k[NKL];
#define SLOAD(k0) do { st_v0 = *reinterpret_cast<const bf16x8*>(Vh + (size_t)((k0) + sr) * ldv + sc); st_v1 = *reinterpret_cast<const bf16x8*>(Vh + (size_t)((k0) + 32 + sr) * ldv + sc); \
        _Pragma("unroll") for (int i_ = 0; i_ < NKL; ++i_) st_k[i_] = *reinterpret_cast<const bf16x8*>(Kh + (size_t)((k0) + krow[i_]) * ldk + kcc[i_] * 8); } while (0)
#define SWRITE(b) do { *(bf16x8*)(V_lds + (b) * SHM_V + vst0) = st_v0; *(bf16x8*)(V_lds + (b) * SHM_V + vst1) = st_v1; \
        _Pragma("unroll") for (int i_ = 0; i_ < NKL; ++i_) *(bf16x8*)(K_lds + (b) * SHM_K + kswz<PITCH>(krow[i_], kcc[i_] * 16)) = st_k[i_]; } while (0)
#define RESC(a) do { if (__any((a) < 1.f)) { if (hi == 0) al_l[r32] = (a); asm volatile("s_waitcnt lgkmcnt(0)" ::: "memory"); \
        _Pragma("unroll") for (int d_ = 0; d_ < 4; ++d_) _Pragma("unroll") for (int r = 0; r < 16; ++r) o[d_][r] *= al_l[crow(r, hi)]; } } while (0)
#define MASKT(P0_, P1_, t) do { if (CAUSAL) { const int kb_ = (t) * KVBLK; if (kb_ + KVBLK - 1 > qlo) mask_tile(P0_, P1_, qpos - kb_ - 4 * hi); } } while (0)
    if constexpr (PIPE) {
    f32x16 pA0, pA1, pB0, pB1; float alA, alB; bf16x8 pa0, pa1, pa2, pa3;
    SLOAD(0); VM_WAIT(); SWRITE(0); __syncthreads();
    qkt<PITCH, ND0>(pA0, pA1, K_lds, r32, hi, kch0, qr); MASKT(pA0, pA1, 0); partialSM(pA0, pA1, m_reg, alA);
    SLOAD(KVBLK); VM_WAIT(); SWRITE(1); __syncthreads();
    for (int j = 1; j + 1 < NT; j += 2) {
        SBAR(); qkt<PITCH, ND0>(pB0, pB1, K_lds + SHM_K, r32, hi, kch0, qr);
        finishSM(pA0, pA1, alA, l_reg, pa0, pa1, pa2, pa3); SBAR();
        SLOAD((j + 1) * KVBLK); SBAR();
        pv_tile(o, vb0, pa0, pa1, pa2, pa3); MASKT(pB0, pB1, j); partialSM(pB0, pB1, m_reg, alB);
        __syncthreads(); VM_WAIT(); SWRITE(0);
        RESC(alB); __syncthreads();
        SBAR(); qkt<PITCH, ND0>(pA0, pA1, K_lds, r32, hi, kch0, qr);
        finishSM(pB0, pB1, alB, l_reg, pa0, pa1, pa2, pa3); SBAR();
        SLOAD((j + 2) * KVBLK); SBAR();
        pv_tile(o, vb0 + SHM_V, pa0, pa1, pa2, pa3); MASKT(pA0, pA1, j + 1); partialSM(pA0, pA1, m_reg, alA);
        __syncthreads(); VM_WAIT(); SWRITE(1);
        RESC(alA); __syncthreads();
    }
    SBAR(); qkt<PITCH, ND0>(pB0, pB1, K_lds + SHM_K, r32, hi, kch0, qr);
    finishSM(pA0, pA1, alA, l_reg, pa0, pa1, pa2, pa3); SBAR();
    pv_tile(o, vb0, pa0, pa1, pa2, pa3); MASKT(pB0, pB1, NT - 1); partialSM(pB0, pB1, m_reg, alB);
    RESC(alB);
    finishSM(pB0, pB1, alB, l_reg, pa0, pa1, pa2, pa3); SBAR();
    pv_tile(o, vb0 + SHM_V, pa0, pa1, pa2, pa3);
    } else {
    f32x16 p0, p1; float al; bf16x8 pa0, pa1, pa2, pa3;
    SLOAD(0); VM_WAIT(); SWRITE(0); __syncthreads();
    for (int t = 0; t < NT; t += 2) {
        SBAR(); SLOAD((t + 1) * KVBLK); SBAR();
        qkt<PITCH, ND0>(p0, p1, K_lds, r32, hi, kch0, qr); MASKT(p0, p1, t); partialSM(p0, p1, m_reg, al); RESC(al);
        finishSM(p0, p1, al, l_reg, pa0, pa1, pa2, pa3); SBAR();
        pv_tile(o, vb0, pa0, pa1, pa2, pa3);
        VM_WAIT(); SWRITE(1); __syncthreads();
        SBAR(); if (t + 2 < NT) SLOAD((t + 2) * KVBLK); SBAR();
        qkt<PITCH, ND0>(p0, p1, K_lds + SHM_K, r32, hi, kch0, qr); MASKT(p0, p1, t + 1); partialSM(p0, p1, m_reg, al); RESC(al);
        finishSM(p0, p1, al, l_reg, pa0, pa1, pa2, pa3); SBAR();
        pv_tile(o, vb0 + SHM_V, pa0, pa1, pa2, pa3);
        if (t + 2 < NT) { VM_WAIT(); SWRITE(0); } __syncthreads();
    }
    }
#undef SLOAD
#undef SWRITE
#undef RESC
#undef MASKT
}

template <bool NEGM = true>
__device__ __forceinline__ void partialSM_rel(f32x16& p0, f32x16& p1, float& m_reg, f32x16& negm, float& alpha, bool first) {
    float pmax = p0[0];
#pragma unroll
    for (int r = 1; r < 16; ++r) pmax = fmaxf(pmax, p0[r]);
#pragma unroll
    for (int r = 0; r < 16; ++r) pmax = fmaxf(pmax, p1[r]);
    { auto rr = __builtin_amdgcn_permlane32_swap(__float_as_uint(pmax), __float_as_uint(pmax), false, false); pmax = fmaxf(__uint_as_float(rr[0]), __uint_as_float(rr[1])); }
    if (__builtin_expect(!first && __all(pmax <= THRL), 1)) { alpha = 1.f; }
    else { const float dl = first ? pmax : fmaxf(pmax, 0.f); alpha = first ? 1.f : __builtin_amdgcn_exp2f(-dl); m_reg += dl;
#pragma unroll
        for (int r = 0; r < 16; ++r) { p0[r] -= dl; p1[r] -= dl; }
        if constexpr (NEGM) {
#pragma unroll
            for (int r = 0; r < 16; ++r) negm[r] = -m_reg; } }
#pragma unroll
    for (int r = 0; r < 16; ++r) p0[r] = __builtin_amdgcn_exp2f(p0[r]);
}
template <int PITCH, int ND0>
__device__ __forceinline__ void qkt_rel(f32x16& p0, f32x16& p1, const char* Kb, int r32, int hi, int kch0, const bf16x8* qr, const f32x16& negm) {
    const char* kb[4];
#pragma unroll
    for (int dd = 0; dd < 4; ++dd) kb[dd] = Kb + kswz<PITCH>(r32, (kch0 + dd * 2 + hi) * 16);
#pragma unroll
    for (int d0 = 0; d0 < ND0; ++d0) { const char* a = (PITCH % 256 == 0) ? Kb + kswz<PITCH>(r32, (kch0 + d0 * 2 + hi) * 16) : kb[d0 & 3] + (d0 >> 2) * 128;
        const bf16x8 b0 = *reinterpret_cast<const bf16x8*>(a);
        const bf16x8 b1 = *reinterpret_cast<const bf16x8*>(a + 32 * PITCH);
        p0 = __builtin_amdgcn_mfma_f32_32x32x16_bf16(b0, qr[d0], d0 == 0 ? negm : p0, 0, 0, 0);
        p1 = __builtin_amdgcn_mfma_f32_32x32x16_bf16(b1, qr[d0], d0 == 0 ? negm : p1, 0, 0, 0); }
}

template <int PITCH, int ND0, int PF>
__device__ __forceinline__ void qkt_rel_pf(f32x16& p0, f32x16& p1, const char* Kb, int r32, int hi, int kch0, const bf16x8* qr, const f32x16& negm_) {
    static_assert(PITCH % 256 == 128 || ND0 <= 4, "the +128 B immediate offsets need the 3-bit swizzle");
    f32x16 negm = negm_;
    int kb[4];
#pragma unroll
    for (int dd = 0; dd < 4; ++dd) kb[dd] = (int)(uintptr_t)Kb + kswz<PITCH>(r32, (kch0 + dd * 2 + hi) * 16);
    bf16x8 f[PF + 1][2];
#define KRD(d) do { asm volatile("ds_read_b128 %0, %1 offset:%2" : "=v"(f[(d) % (PF + 1)][0]) : "v"(kb[(d) & 3]), "i"(((d) >> 2) * 128)); \
                    asm volatile("ds_read_b128 %0, %1 offset:%2" : "=v"(f[(d) % (PF + 1)][1]) : "v"(kb[(d) & 3]), "i"(((d) >> 2) * 128 + 32 * PITCH)); } while (0)
#pragma unroll
    for (int d = 0; d < PF && d < ND0; ++d) KRD(d);
#pragma unroll
    for (int d0 = 0; d0 < ND0; ++d0) {
        if (d0 + PF < ND0) KRD(d0 + PF);
        const int ahead = (d0 + PF < ND0 ? PF : ND0 - 1 - d0) * 2;
        if (ahead >= 4) asm volatile("s_waitcnt lgkmcnt(4)" : "+v"(f[d0 % (PF + 1)][0]), "+v"(f[d0 % (PF + 1)][1]));
        else if (ahead == 2) asm volatile("s_waitcnt lgkmcnt(2)" : "+v"(f[d0 % (PF + 1)][0]), "+v"(f[d0 % (PF + 1)][1]));
        else asm volatile("s_waitcnt lgkmcnt(0)" : "+v"(f[d0 % (PF + 1)][0]), "+v"(f[d0 % (PF + 1)][1]));
        p0 = __builtin_amdgcn_mfma_f32_32x32x16_bf16(f[d0 % (PF + 1)][0], qr[d0], d0 == 0 ? negm : p0, 0, 0, 0);
        p1 = __builtin_amdgcn_mfma_f32_32x32x16_bf16(f[d0 % (PF + 1)][1], qr[d0], d0 == 0 ? negm : p1, 0, 0, 0);
    }
#undef KRD
}

template <int PITCH, int ND0>
__device__ __forceinline__ void pv_qk(f32x16* o, int vb0, bf16x8 pa0, bf16x8 pa1, bf16x8 pa2, bf16x8 pa3,
                                      f32x16& p0, f32x16& p1, const char* Kb, int r32, int hi, int kch0, const bf16x8* qr, const f32x16& negm_) {
    constexpr int PF = 2;
    static_assert(PITCH % 256 == 128 || ND0 <= 4, "the +128 B immediate offsets need the 3-bit swizzle");
    f32x16 negm = negm_;
    s16x4 va[8], vb[8];
    int kb[4];
#pragma unroll
    for (int dd = 0; dd < 4; ++dd) kb[dd] = (int)(uintptr_t)Kb + kswz<PITCH>(r32, (kch0 + dd * 2 + hi) * 16);
    bf16x8 f[PF + 1][2];
#define TRRD(dst, off) asm volatile("ds_read_b64_tr_b16 %0, %1 offset:%2" : "=&v"(dst) : "v"(vb0), "i"(off) : "memory")
#define PV_RD(v, d0) do { constexpr int b_ = v_rd_off(d0, 0, 0); TRRD(v[0], b_); TRRD(v[1], b_ + 2048); TRRD(v[2], b_ + 4096); TRRD(v[3], b_ + 6144); TRRD(v[4], b_ + 8192); TRRD(v[5], b_ + 10240); TRRD(v[6], b_ + 12288); TRRD(v[7], b_ + 14336); } while (0)
#define PV_MM(v, d0) do { \
        o[d0] = __builtin_amdgcn_mfma_f32_32x32x16_bf16(pa0, (bf16x8){v[0][0], v[0][1], v[0][2], v[0][3], v[1][0], v[1][1], v[1][2], v[1][3]}, o[d0], 0, 0, 0); \
        o[d0] = __builtin_amdgcn_mfma_f32_32x32x16_bf16(pa1, (bf16x8){v[2][0], v[2][1], v[2][2], v[2][3], v[3][0], v[3][1], v[3][2], v[3][3]}, o[d0], 0, 0, 0); \
        o[d0] = __builtin_amdgcn_mfma_f32_32x32x16_bf16(pa2, (bf16x8){v[4][0], v[4][1], v[4][2], v[4][3], v[5][0], v[5][1], v[5][2], v[5][3]}, o[d0], 0, 0, 0); \
        o[d0] = __builtin_amdgcn_mfma_f32_32x32x16_bf16(pa3, (bf16x8){v[6][0], v[6][1], v[6][2], v[6][3], v[7][0], v[7][1], v[7][2], v[7][3]}, o[d0], 0, 0, 0); } while (0)
#define PV_WN(v, n) asm volatile("s_waitcnt lgkmcnt(%8)" : "+v"(v[0]), "+v"(v[1]), "+v"(v[2]), "+v"(v[3]), "+v"(v[4]), "+v"(v[5]), "+v"(v[6]), "+v"(v[7]) : "n"(n) : "memory")
#define KRD(d) do { asm volatile("ds_read_b128 %0, %1 offset:%2" : "=v"(f[(d) % (PF + 1)][0]) : "v"(kb[(d) & 3]), "i"(((d) >> 2) * 128) : "memory"); \
                    asm volatile("ds_read_b128 %0, %1 offset:%2" : "=v"(f[(d) % (PF + 1)][1]) : "v"(kb[(d) & 3]), "i"(((d) >> 2) * 128 + 32 * PITCH) : "memory"); } while (0)
#define PV_RDK(v, ks) do { TRRD(v[0], v_rd_off(0, ks, 0)); TRRD(v[1], v_rd_off(0, ks, 1)); TRRD(v[2], v_rd_off(1, ks, 0)); TRRD(v[3], v_rd_off(1, ks, 1)); \
                            TRRD(v[4], v_rd_off(2, ks, 0)); TRRD(v[5], v_rd_off(2, ks, 1)); TRRD(v[6], v_rd_off(3, ks, 0)); TRRD(v[7], v_rd_off(3, ks, 1)); } while (0)
#define PV_MMK(v, pa) do { \
        o[0] = __builtin_amdgcn_mfma_f32_32x32x16_bf16(pa, (bf16x8){v[0][0], v[0][1], v[0][2], v[0][3], v[1][0], v[1][1], v[1][2], v[1][3]}, o[0], 0, 0, 0); \
        o[1] = __builtin_amdgcn_mfma_f32_32x32x16_bf16(pa, (bf16x8){v[2][0], v[2][1], v[2][2], v[2][3], v[3][0], v[3][1], v[3][2], v[3][3]}, o[1], 0, 0, 0); \
        o[2] = __builtin_amdgcn_mfma_f32_32x32x16_bf16(pa, (bf16x8){v[4][0], v[4][1], v[4][2], v[4][3], v[5][0], v[5][1], v[5][2], v[5][3]}, o[2], 0, 0, 0); \
        o[3] = __builtin_amdgcn_mfma_f32_32x32x16_bf16(pa, (bf16x8){v[6][0], v[6][1], v[6][2], v[6][3], v[7][0], v[7][1], v[7][2], v[7][3]}, o[3], 0, 0, 0); } while (0)
    PV_RDK(va, 0); PV_RDK(vb, 1); PV_WN(va, 8); SBAR(); PV_MMK(va, pa0);
    PV_RDK(va, 2); PV_WN(vb, 8); SBAR(); PV_MMK(vb, pa1);
    PV_RDK(vb, 3); PV_WN(va, 8); SBAR(); PV_MMK(va, pa2);
    KRD(0); KRD(1);
    PV_WN(vb, 4); SBAR(); PV_MMK(vb, pa3);
#undef PV_MMK
#undef PV_RDK
    SBAR();
#pragma unroll
    for (int d0 = 0; d0 < ND0; ++d0) {
        if (d0 + PF < ND0) KRD(d0 + PF);
        const int ahead = (d0 + PF < ND0 ? PF : ND0 - 1 - d0) * 2;
        if (ahead >= 4) asm volatile("s_waitcnt lgkmcnt(4)" : "+v"(f[d0 % (PF + 1)][0]), "+v"(f[d0 % (PF + 1)][1]) :: "memory");
        else if (ahead == 2) asm volatile("s_waitcnt lgkmcnt(2)" : "+v"(f[d0 % (PF + 1)][0]), "+v"(f[d0 % (PF + 1)][1]) :: "memory");
        else asm volatile("s_waitcnt lgkmcnt(0)" : "+v"(f[d0 % (PF + 1)][0]), "+v"(f[d0 % (PF + 1)][1]) :: "memory");
        p0 = __builtin_amdgcn_mfma_f32_32x32x16_bf16(f[d0 % (PF + 1)][0], qr[d0], d0 == 0 ? negm : p0, 0, 0, 0);
        p1 = __builtin_amdgcn_mfma_f32_32x32x16_bf16(f[d0 % (PF + 1)][1], qr[d0], d0 == 0 ? negm : p1, 0, 0, 0);
    }
#undef KRD
#undef PV_WN
#undef PV_MM
#undef PV_RD
#undef TRRD
}

__device__ __forceinline__ void glds16(unsigned lds_addr, const void* sbase, unsigned voff) {
    unsigned keep;
    asm volatile("s_mov_b32 %0, m0\n\ts_mov_b32 m0, %1\n\ts_nop 0\n\tglobal_load_lds_dwordx4 %2, %3\n\ts_mov_b32 m0, %0" : "=&s"(keep) : "s"(lds_addr), "v"(voff), "s"(sbase) : "memory");
}
template <int KT, int ND0, bool CAUSAL>
__device__ __forceinline__ void attn_core_ring(const bf16_t* Qlane, const bf16_t* __restrict__ Kh, int ldk, const bf16_t* __restrict__ Vh, int ldv, int NT, int qpos, int qlo, int kch0,
                                               char* lds, f32x16 (&o)[4], float& l_reg) {
    constexpr int PITCH = KT * 2, SHM_K = KVBLK * PITCH, NKP = SHM_K / 8192, NVP = SHM_V / 8192;
    const int tid = opaque_tid(), wid = __builtin_amdgcn_readfirstlane(tid >> 6), lane = tid & 63, r32 = lane & 31, hi = lane >> 5;
    char* V_lds = lds; char* K_lds = lds + 3 * SHM_V;
    float* ws = (float*)(lds + 3 * SHM_V + 3 * SHM_K) + wid * 64; float* al_l = ws + 32;
    float m_reg = 0.f; l_reg = 0.f; f32x16 negm = f32x16{};
#pragma unroll
    for (int d = 0; d < 4; ++d) o[d] = f32x16{};
    bf16x8 qr[ND0];
#pragma unroll
    for (int d0 = 0; d0 < ND0; ++d0) qr[d0] = *reinterpret_cast<const bf16x8*>(Qlane + d0 * 16);
    const int vb0 = (int)(uintptr_t)V_lds + v_rd_base(lane);
    unsigned koff[NKP], voff[NVP];
#pragma unroll
    for (int i = 0; i < NKP; ++i) { const int a = (wid * NKP + i) * 1024 + lane * 16, row = a / PITCH, cpos = (a - row * PITCH) >> 4, f = kfl<PITCH>(row);
        const int chunk = cpos ^ f; koff[i] = (unsigned)(row * ldk * 2 + chunk * 16); }
#pragma unroll
    for (int i = 0; i < NVP; ++i) { const int a = (wid * NVP + i) * 1024 + lane * 16, sub = a >> 9, rem = a & 511, kk = (sub >> 2) * 8 + (rem >> 6), c = (sub & 3) * 32 + ((rem & 63) >> 1);
        const int k = kk; voff[i] = (unsigned)(k * ldv * 2 + c * 2); }
    const unsigned ldsK = (unsigned)(uintptr_t)K_lds + (unsigned)(wid * NKP) * 1024u, ldsV = (unsigned)(uintptr_t)V_lds + (unsigned)(wid * NVP) * 1024u;
#define DMA_TILE(t, slot) do { const char* kb_ = (const char*)Kh + (size_t)(t) * KVBLK * ldk * 2; const char* vb_ = (const char*)Vh + (size_t)(t) * KVBLK * ldv * 2; \
        _Pragma("unroll") for (int i_ = 0; i_ < NKP; ++i_) glds16(ldsK + (slot) * SHM_K + i_ * 1024, kb_, koff[i_]); \
        _Pragma("unroll") for (int i_ = 0; i_ < NVP; ++i_) glds16(ldsV + (slot) * SHM_V + i_ * 1024, vb_, voff[i_]); } while (0)
#define RING_SYNC(more) do { if (more) asm volatile("s_waitcnt vmcnt(%0)" :: "n"(NKP + NVP) : "memory"); else asm volatile("s_waitcnt vmcnt(0)" ::: "memory"); \
        asm volatile("s_waitcnt lgkmcnt(0)" ::: "memory"); __builtin_amdgcn_s_barrier(); asm volatile("" ::: "memory"); } while (0)
#define RESC(a) do { if (__any((a) < 1.f)) { if (hi == 0) al_l[r32] = (a); asm volatile("s_waitcnt lgkmcnt(0)" ::: "memory"); \
        _Pragma("unroll") for (int d_ = 0; d_ < 4; ++d_) _Pragma("unroll") for (int r = 0; r < 16; ++r) o[d_][r] *= al_l[crow(r, hi)]; } } while (0)
#define MASKT(P0_, P1_, t) do { if (CAUSAL) { const int kb_ = (t) * KVBLK; if (kb_ + KVBLK - 1 > qlo) mask_tile(P0_, P1_, qpos - kb_ - 4 * hi); } } while (0)
    f32x16 p0, p1; float al; bf16x8 pa0, pa1, pa2, pa3;
    asm volatile("s_waitcnt vmcnt(0)" ::: "memory");
#pragma unroll
    for (int d0 = 0; d0 < ND0; ++d0) asm volatile("" : "+v"(qr[d0]));
    DMA_TILE(0, 0); if (NT > 1) DMA_TILE(1, 1);
    RING_SYNC(NT > 1);
    int slot = 0;
    for (int t = 0; t < NT; ++t) {
        const int s2 = slot == 0 ? 2 : slot - 1;
        SBAR(); if (t + 2 < NT) DMA_TILE(t + 2, s2); SBAR();
        qkt_rel_pf<PITCH, ND0, 2>(p0, p1, K_lds + slot * SHM_K, r32, hi, kch0, qr, negm); MASKT(p0, p1, t); partialSM_rel(p0, p1, m_reg, negm, al, t == 0); RESC(al);
        finishSM(p0, p1, al, l_reg, pa0, pa1, pa2, pa3); SBAR();
        pv_tile(o, vb0 + slot * SHM_V, pa0, pa1, pa2, pa3);
        RING_SYNC(t + 2 < NT);
        slot = slot == 2 ? 0 : slot + 1;
    }
#undef DMA_TILE
#undef RING_SYNC
#undef RESC
#undef MASKT
}
template <int KT, int ND0, bool CAUSAL, bool NEGM>
__device__ __forceinline__ void attn_core_pp(const bf16_t* Qlane, const bf16_t* __restrict__ Kh, int ldk, const bf16_t* __restrict__ Vh, int ldv, int NT, int qpos, int qlo, int kch0,
                                             char* lds, f32x16 (&o)[4], float& l_reg) {
    constexpr int PITCH = KT * 2, SHM_K = KVBLK * PITCH, NKP = SHM_K / 8192, NVP = SHM_V / 8192;
    const int tid = opaque_tid(), wid = __builtin_amdgcn_readfirstlane(tid >> 6), lane = tid & 63, r32 = lane & 31, hi = lane >> 5;
    const bool grpB = wid >= 4;
    char* V_lds = lds; char* K_lds = lds + 3 * SHM_V;
    float* ws = (float*)(lds + 3 * SHM_V + 3 * SHM_K) + wid * 64; float* al_l = ws + 32;
    float m_reg = 0.f; l_reg = 0.f; f32x16 negm = f32x16{};
#pragma unroll
    for (int d = 0; d < 4; ++d) o[d] = f32x16{};
    bf16x8 qr[ND0];
#pragma unroll
    for (int d0 = 0; d0 < ND0; ++d0) qr[d0] = *reinterpret_cast<const bf16x8*>(Qlane + d0 * 16);
    const int vb0 = (int)(uintptr_t)V_lds + v_rd_base(lane);
    unsigned koff[NKP], voff[NVP];
#pragma unroll
    for (int i = 0; i < NKP; ++i) { const int a = (wid * NKP + i) * 1024 + lane * 16, row = a / PITCH, cpos = (a - row * PITCH) >> 4, f = kfl<PITCH>(row);
        const int chunk = cpos ^ f; koff[i] = (unsigned)(row * ldk * 2 + chunk * 16); }
#pragma unroll
    for (int i = 0; i < NVP; ++i) { const int a = (wid * NVP + i) * 1024 + lane * 16, sub = a >> 9, rem = a & 511, kk = (sub >> 2) * 8 + (rem >> 6), c = (sub & 3) * 32 + ((rem & 63) >> 1);
        const int k = kk; voff[i] = (unsigned)(k * ldv * 2 + c * 2); }
    const unsigned ldsK = (unsigned)(uintptr_t)K_lds + (unsigned)(wid * NKP) * 1024u, ldsV = (unsigned)(uintptr_t)V_lds + (unsigned)(wid * NVP) * 1024u;
#define DMA_K(t, slot) do { const char* kb_ = (const char*)Kh + (size_t)(t) * KVBLK * ldk * 2; _Pragma("unroll") for (int i_ = 0; i_ < NKP; ++i_) glds16(ldsK + (slot) * SHM_K + i_ * 1024, kb_, koff[i_]); } while (0)
#define DMA_V(t, slot) do { const char* vb_ = (const char*)Vh + (size_t)(t) * KVBLK * ldv * 2; _Pragma("unroll") for (int i_ = 0; i_ < NVP; ++i_) glds16(ldsV + (slot) * SHM_V + i_ * 1024, vb_, voff[i_]); } while (0)
#define ISSUE(u, ksl, vsl) do { if ((u) < NT) DMA_K(u, ksl); if ((u) - 1 < NT) DMA_V((u) - 1, vsl); } while (0)
#define PAIR_WAIT(t) do { if ((t) + 2 < NT) asm volatile("s_waitcnt vmcnt(%0)" :: "n"(NKP + NVP) : "memory"); else if ((t) + 2 == NT) asm volatile("s_waitcnt vmcnt(%0)" :: "n"(NVP) : "memory"); \
        else asm volatile("s_waitcnt vmcnt(0)" ::: "memory"); } while (0)
#define BAR() do { SBAR(); asm volatile("s_waitcnt lgkmcnt(0)" ::: "memory"); __builtin_amdgcn_s_barrier(); asm volatile("" ::: "memory"); SBAR(); } while (0)
#define RESC(a) do { if (__any((a) < 1.f)) { if (hi == 0) al_l[r32] = (a); asm volatile("s_waitcnt lgkmcnt(0)" ::: "memory"); \
        _Pragma("unroll") for (int d_ = 0; d_ < 4; ++d_) _Pragma("unroll") for (int r = 0; r < 16; ++r) o[d_][r] *= al_l[crow(r, hi)]; } } while (0)
#define MASKT(P0_, P1_, t) do { if (CAUSAL) { const int kb_ = (t) * KVBLK; if (kb_ + KVBLK - 1 > qlo) mask_tile(P0_, P1_, qpos - kb_ - 4 * hi); } } while (0)
    f32x16 p0, p1; float al; bf16x8 pa0, pa1, pa2, pa3;
    asm volatile("s_waitcnt vmcnt(0)" ::: "memory");
#pragma unroll
    for (int d0 = 0; d0 < ND0; ++d0) asm volatile("" : "+v"(qr[d0]));
    DMA_K(0, 0);
    if (NT > 1) DMA_K(1, 1);
    DMA_V(0, 0);
    if (NT > 1) asm volatile("s_waitcnt vmcnt(%0)" :: "n"(NKP + NVP) : "memory"); else asm volatile("s_waitcnt vmcnt(%0)" :: "n"(NVP) : "memory");
    BAR();
    if (grpB) { ISSUE(2, 2, 1); BAR(); }
#define QK_(ksl) do { if constexpr (NEGM) qkt_rel_pf<PITCH, ND0, 2>(p0, p1, K_lds + (ksl) * SHM_K, r32, hi, kch0, qr, negm); \
        else { f32x16 c_; const float nm_ = -m_reg; _Pragma("unroll") for (int r = 0; r < 16; ++r) c_[r] = nm_; qkt_rel_pf<PITCH, ND0, 2>(p0, p1, K_lds + (ksl) * SHM_K, r32, hi, kch0, qr, c_); } } while (0)
#define Y_(t_, first_) do { MASKT(p0, p1, t_); partialSM_rel<NEGM>(p0, p1, m_reg, negm, al, first_); RESC(al); finishSM(p0, p1, al, l_reg, pa0, pa1, pa2, pa3); } while (0)
    QK_(0);
    if (grpB) PAIR_WAIT(0);
    BAR();
    if (grpB) ISSUE(3, 0, 2); else ISSUE(2, 2, 1);
    SBAR();
    Y_(0, true);
    if (!grpB) PAIR_WAIT(0);
    BAR();
    int ks = 1;
    for (int t = 1; t < NT; ++t) {
        const int kp = ks == 0 ? 2 : ks - 1, kn = ks == 2 ? 0 : ks + 1;
        if constexpr (NEGM) pv_qk<PITCH, ND0>(o, vb0 + kp * SHM_V, pa0, pa1, pa2, pa3, p0, p1, K_lds + ks * SHM_K, r32, hi, kch0, qr, negm);
        else { f32x16 c_; const float nm_ = -m_reg; _Pragma("unroll") for (int r = 0; r < 16; ++r) c_[r] = nm_; pv_qk<PITCH, ND0>(o, vb0 + kp * SHM_V, pa0, pa1, pa2, pa3, p0, p1, K_lds + ks * SHM_K, r32, hi, kch0, qr, c_); }
#ifdef PROBE_XMFMA
        if constexpr (ND0 == 4) { f32x16 dz_ = f32x16{}; _Pragma("unroll") for (int i_ = 0; i_ < PROBE_XMFMA; ++i_) asm volatile("v_mfma_f32_32x32x16_bf16 %0, %1, %2, %0" : "+v"(dz_) : "v"(qr[0]), "v"(qr[1])); asm volatile("s_nop 15\n\ts_nop 15" :: "v"(dz_)); }
#endif
        if (grpB) PAIR_WAIT(t);
        BAR();
        if (grpB) ISSUE(t + 3, ks, kp); else ISSUE(t + 2, kp, kn);
        SBAR();
        Y_(t, false);
#ifdef PROBE_YEXP
        if constexpr (ND0 == 4) { float dm_ = al; _Pragma("unroll") for (int i_ = 0; i_ < PROBE_YEXP; ++i_) asm volatile("v_exp_f32 %0, %1" : "=v"(dm_) : "v"(al)); asm volatile("" :: "v"(dm_)); }
#endif

        if (!grpB) PAIR_WAIT(t);
        BAR();
        ks = kn;
    }
    pv_tile(o, vb0 + (ks == 0 ? 2 : ks - 1) * SHM_V, pa0, pa1, pa2, pa3);
    BAR();
#undef QK_
#undef Y_
    if (!grpB) BAR();
#undef DMA_K
#undef DMA_V
#undef ISSUE
#undef PAIR_WAIT
#undef BAR
#undef RESC
#undef MASKT
}
__device__ __forceinline__ void normalize_o(f32x16 (&o)[4], float l_reg, float* ws, int r32, int hi) {
    if (hi == 0) ws[r32] = l_reg; asm volatile("s_waitcnt lgkmcnt(0)" ::: "memory");
#pragma unroll
    for (int r = 0; r < 16; ++r) { const float rl = __builtin_amdgcn_rcpf(ws[crow(r, hi)]);
#pragma unroll
        for (int d0 = 0; d0 < 4; ++d0) o[d0][r] *= rl; }
}
__device__ __forceinline__ void store_o_bf16(const f32x16 (&o)[4], bf16_t* Ow, int ldo, int r32, int hi) {
#pragma unroll
    for (int r = 0; r < 16; ++r) { const int orow = crow(r, hi);
#pragma unroll
        for (int d0 = 0; d0 < 4; ++d0) { const float v = o[d0][r]; const float vn = shflx(v, 1, hi * 32 + r32);
            if ((r32 & 1) == 0) *(unsigned*)(Ow + (size_t)orow * ldo + d0 * 32 + r32) = cvt_pk_bf16(v, vn); } }
}
}

constexpr size_t MiB = 1u << 20;
constexpr size_t WS_CTL = 0, CTL_ZERO_BYTES = 4 * MiB;
constexpr size_t WS_SSQ = 1 * MiB;
constexpr size_t WS_W = 4 * MiB, LW_BYTES = 269 * MiB / 2;
constexpr size_t LW_IN = 0, LW_QUP = 44 * MiB, LW_KVUP = LW_QUP + 3 * MiB / 2, LW_GLU = LW_KVUP + 1 * MiB, LW_BR = LW_GLU + 4 * MiB, LW_OUT = LW_BR + 12 * MiB,
                 LW_XQ = LW_OUT + 8 * MiB, LW_XKV = LW_XQ + 2 * MiB, LW_XO = LW_XKV + 4 * MiB, LW_TEXT = LW_XO + 2 * MiB, LW_WSL = LW_TEXT + 40 * MiB;
static_assert(LW_WSL + 16 * MiB == LW_BYTES, "layer weight block");
constexpr size_t WS_FFN = WS_W + 2 * LW_BYTES;
constexpr size_t WS_MOE = WS_FFN + 66 * MiB;
constexpr size_t WS_XS = WS_MOE + 8 * 66 * MiB + 1 * MiB;
static_assert(WS_XS == 868 * MiB, "map");
constexpr size_t WS_XN = WS_XS + 128 * MiB;
constexpr size_t WS_TABD = WS_XN + 64 * MiB, WS_TABM = WS_TABD + 1 * MiB, WS_XKV = WS_TABM + 4 * MiB, WS_MEMB = WS_XKV + 1 * MiB, WS_ROUTE = WS_MEMB + 1 * MiB, WS_ORDER = WS_ROUTE + 1 * MiB;
constexpr size_t WS_A32 = WS_ORDER + 64 * 1024;
constexpr size_t WS_PSQ = WS_ORDER + 1 * MiB;
constexpr size_t WS_MIX = WS_TABD + 12 * MiB;
static_assert(WS_MIX == 1072 * MiB, "map");
constexpr size_t WS_QD = WS_MIX, WS_KD = WS_QD + 32 * MiB, WS_VD = WS_KD + 32 * MiB, WS_MQ = WS_VD + 32 * MiB, WS_MKV = WS_MQ + 16 * MiB, WS_KM = WS_MKV + 8 * MiB, WS_VM = WS_KM + 48 * MiB,
                 WS_QM = WS_VM + 32 * MiB, WS_SU = WS_QM + 48 * MiB, WS_GATES = WS_SU + 40 * MiB, WS_SLOC = WS_GATES + 192 * MiB, WS_YG = WS_SLOC + 16 * MiB, WS_BR = WS_YG + 32 * MiB,
                 WS_TMP = WS_BR + 96 * MiB, WS_MG = WS_TMP + 128 * MiB, WS_XQ = WS_MG + 64 * MiB, WS_XO = WS_XQ + 16 * MiB, WS_XN8 = WS_XO + 16 * MiB  , WS_END = WS_XN8 + 32 * MiB;
static_assert(WS_END == 1952 * MiB, "map");
constexpr size_t WS_XG = WS_MIX, WS_HG = WS_XG + 136 * MiB, WS_OG = WS_HG + 374 * MiB;
static_assert(WS_OG + 272 * MiB <= WS_XQ, "ffn overlay");
constexpr int CW_TMO = 0, CW_DBG = 2, CW_BAR = 4096, CW_ATTQ = 16384, CW_MOECNT = 16640, CW_MOECUR = 16704;

#define XB_TMO      128
#define XB_XCNT(j)  (256  + 64 * (j))
#define XB_XSUB(j)  (1280 + 64 * (j))
#define XB_XGEN(j)  (2304 + 64 * (j))
#define XB_TOP      3328
#define XB_TOPGEN   3392
#define XCD_BAR_WORDS 3456
#define XB_SPIN_CAP (1u << 22)
__device__ __forceinline__ unsigned xb_ld(unsigned* p)              { return __hip_atomic_load(p, __ATOMIC_RELAXED, __HIP_MEMORY_SCOPE_AGENT); }
__device__ __forceinline__ unsigned xb_add(unsigned* p, unsigned v) { return __hip_atomic_fetch_add(p, v, __ATOMIC_RELAXED, __HIP_MEMORY_SCOPE_AGENT); }
__device__ __forceinline__ unsigned xb_xcc_id() { return (unsigned)__builtin_amdgcn_s_getreg((3 << 11) | 20) & 0xFu; }
#define XB_SPIN(cond, bar) do { unsigned _sp = 0; while (cond) { __builtin_amdgcn_s_sleep(1); \
    if ((++_sp & 255u) == 0u) { if (xb_ld(&(bar)[XB_TMO])) break; if (_sp > XB_SPIN_CAP) { atomicAdd(&(bar)[XB_TMO], 1u); break; } } } } while (0)
struct XcdBarrier { unsigned* bar; unsigned x; volatile LAS unsigned* st; };
__device__ __forceinline__ XcdBarrier xcd_barrier_post(unsigned* bar, volatile LAS unsigned* st) {
    XcdBarrier b; b.bar = bar; b.x = xb_xcc_id(); b.st = st;
    if (threadIdx.x == 0) (void)xb_add(&bar[XB_XCNT(b.x)], 1u);
    return b;
}
__device__ __forceinline__ void xcd_barrier_complete(unsigned* bar, unsigned x, unsigned& nloc, unsigned& nx) {
    const unsigned G = gridDim.x * gridDim.y * gridDim.z;
    unsigned sum, cnt, mine, sp = 0u;
    for (;;) {
        sum = 0u; cnt = 0u; mine = 0u;
#pragma nounroll
        for (unsigned j = 0; j < 16; ++j) { const unsigned c = xb_ld(&bar[XB_XCNT(j)]); sum += c; cnt += (c > 0u) ? 1u : 0u; mine = (j == x) ? c : mine; }
        if (sum == G) break;
        __builtin_amdgcn_s_sleep(1);
        if ((++sp & 255u) == 0u) { if (xb_ld(&bar[XB_TMO])) break; if (sp > XB_SPIN_CAP) { atomicAdd(&bar[XB_TMO], 1u); break; } }
    }
    nloc = mine > 0u ? mine : 1u; nx = cnt > 0u ? cnt : 1u;
}
__device__ __forceinline__ void xcd_barrier_setup(const XcdBarrier& b) {
    if (threadIdx.x == 0) { unsigned nloc, nx; xcd_barrier_complete(b.bar, b.x, nloc, nx); b.st[0] = nloc; b.st[1] = nx; }
    __syncthreads();
}
__device__ __forceinline__ void xcd_barrier(const XcdBarrier& b) {
    asm volatile("s_waitcnt vmcnt(0)" ::: "memory");
    __syncthreads();
    if (opaque_tid() == 0) {
        unsigned* bar = b.bar;
        __builtin_amdgcn_s_waitcnt(0);
        const unsigned nloc = b.st[0], nx = b.st[1];
        const unsigned old = xb_add(&bar[XB_XSUB(b.x)], 1u);
        const unsigned gen = old / nloc;
        if (old + 1u == (gen + 1u) * nloc) {
            __builtin_amdgcn_fence(__ATOMIC_RELEASE, "agent");
            asm volatile("s_waitcnt vmcnt(0)" ::: "memory");
            const unsigned og = xb_add(&bar[XB_TOP], 1u);
            const unsigned tg = og / nx;
            if (og + 1u == (tg + 1u) * nx) xb_add(&bar[XB_TOPGEN], 1u);
            else XB_SPIN(xb_ld(&bar[XB_TOPGEN]) == tg, bar);
            __builtin_amdgcn_fence(__ATOMIC_ACQUIRE, "agent");
            xb_add(&bar[XB_XGEN(b.x)], 1u);
            asm volatile("s_waitcnt vmcnt(0)" ::: "memory");
        } else {
            XB_SPIN(xb_ld(&bar[XB_XGEN(b.x)]) == gen, bar);
            __builtin_amdgcn_fence(__ATOMIC_ACQUIRE, "agent");
            asm volatile("s_waitcnt vmcnt(0)" ::: "memory");
        }
    }
    __syncthreads();
}

struct Args { const void* in[35]; float* out; unsigned char* ws; int ph_lo, ph_hi; };
struct PTab { volatile LAS unsigned long long* t; __device__ __forceinline__ const void* operator[](int i) const { const unsigned long long v = t[i];
    const unsigned lo_ = __builtin_amdgcn_readfirstlane((unsigned)v), hi_ = __builtin_amdgcn_readfirstlane((unsigned)(v >> 32)); return (const void*)(GAS const char*)(((unsigned long long)hi_ << 32) | lo_); } };
struct ArgsD { PTab in; unsigned char* ws; };
enum { I_X = 0, I_MEM, I_POS, I_WIN, I_WQUP, I_WKVUP, I_QNG, I_KVNG, I_DLAM, I_SUBLN, I_LRE, I_LIM, I_BRE, I_BIM, I_CRE, I_CIM, I_SSMD, I_LOGDT, I_GLUW, I_WBR, I_WOUT, I_LNMG, I_LNMB,
       I_WXQ, I_WXKV, I_WXO, I_LNXG, I_LNXB, I_FGU, I_FDN, I_ROUTER, I_MGU, I_MDN, I_LNFG, I_LNFB };
constexpr int NPL = 16, NPHASE = 1 + DEPTH * NPL;
constexpr int LDS_BYTES = 147456;
constexpr int LDS_MISC = 131072 + 8192;

__device__ __forceinline__ float lam_init_of(int l) { return l == 0 ? 0.2f : 0.35550906759f; }

struct Mat { const float* src; bf16_t* dst; int K, N, kind; const float* ksc; int kmod; float kmul; int fp8; };
__device__ __forceinline__ int map_row(int kind, int n, int N) {
    if (kind == 0) return n;
    if (kind == 1) {
        if (n < 2048) { const int hc = n & 63; if (hc < 16) return (n - hc) + (hc < 8 ? 2 * hc : 2 * (hc - 8) + 1); return n; }
        if (n < 3840) return n;
        if (n < 3904) { const int hc = n - 3840; return 3840 + (hc < 32 ? 2 * hc : 2 * (hc - 32) + 1); }
        return n + 192;
    }
    if (kind == 2) { const int h = n / 192; int hc = n - h * 192; if (hc >= 128) { const int r = hc - 128; hc = 128 + (r < 32 ? 2 * r : 2 * (r - 32) + 1); } return h * 192 + hc; }
    const int half = N >> 1;
    if (n < half) return (n >> 7) * 256 + (n & 127);
    const int mm = n - half; return (mm >> 7) * 256 + 128 + (mm & 127);
}
__device__ __forceinline__ Mat get_mat(const ArgsD& a, int id) {
    Mat m; m.ksc = nullptr; m.kmod = 1; m.kmul = 1.f; m.kind = 0; m.fp8 = 0;
    unsigned char* ws = a.ws;
    if (id < 22) { const int l = id / 11, k = id % 11; unsigned char* lw = ws + WS_W + (size_t)l * LW_BYTES;
        switch (k) {
        case 0: m.src = (const float*)a.in[I_WIN] + (size_t)l * D * NIN_SRC; m.dst = (bf16_t*)(lw + LW_IN); m.K = D; m.N = NIN_SRC; m.kind = 1; break;
        case 1: m.src = (const float*)a.in[I_WQUP] + (size_t)l * 512 * 1536; m.dst = (bf16_t*)(lw + LW_QUP); m.K = 512; m.N = 1536; m.kind = 2; m.ksc = (const float*)a.in[I_QNG] + l * 512; m.kmod = 512; break;
        case 2: m.src = (const float*)a.in[I_WKVUP] + (size_t)l * 256 * 2048; m.dst = (bf16_t*)(lw + LW_KVUP); m.K = 256; m.N = 2048; m.ksc = (const float*)a.in[I_KVNG] + l * 256; m.kmod = 256; break;
        case 3: m.src = (const float*)a.in[I_GLUW] + (size_t)l * 1024 * 2048; m.dst = (bf16_t*)(lw + LW_GLU); m.K = 1024; m.N = 2048; m.kind = 3; break;
        case 4: m.src = (const float*)a.in[I_WBR] + (size_t)(l * 3 + 0) * 1024 * 2048; m.dst = (bf16_t*)(lw + LW_BR); m.K = 1024; m.N = 2048; m.ksc = (const float*)a.in[I_SUBLN] + l * 128; m.kmod = 128; m.kmul = 1.f - lam_init_of(l); break;
        case 5: m.src = (const float*)a.in[I_WBR] + (size_t)(l * 3 + 1) * 1024 * 2048; m.dst = (bf16_t*)(lw + LW_BR + 4 * MiB); m.K = 1024; m.N = 2048; break;
        case 6: m.src = (const float*)a.in[I_WBR] + (size_t)(l * 3 + 2) * 1024 * 2048; m.dst = (bf16_t*)(lw + LW_BR + 8 * MiB); m.K = 1024; m.N = 2048; break;
        case 7: m.src = (const float*)a.in[I_WOUT] + (size_t)l * 2048 * 2048; m.dst = (bf16_t*)(lw + LW_OUT); m.K = 2048; m.N = 2048; break;
        case 8: m.src = (const float*)a.in[I_WXQ] + (size_t)l * 2048 * 512; m.dst = (bf16_t*)(lw + LW_XQ); m.K = 2048; m.N = 512; break;
        case 9: m.src = (const float*)a.in[I_WXKV] + (size_t)l * 2048 * 1024; m.dst = (bf16_t*)(lw + LW_XKV); m.K = 2048; m.N = 1024; break;
        default: m.src = (const float*)a.in[I_WXO] + (size_t)l * 512 * 2048; m.dst = (bf16_t*)(lw + LW_XO); m.K = 512; m.N = 2048; break;
        }
    } else if (id == 22) { m.src = (const float*)a.in[I_FGU]; m.dst = (bf16_t*)(ws + WS_FFN); m.K = D; m.N = 2 * DFF; m.kind = 3; }
    else if (id == 23) { m.src = (const float*)a.in[I_FDN]; m.dst = (bf16_t*)(ws + WS_FFN + 44 * MiB); m.K = DFF; m.N = D; m.fp8 = 1; m.kmul = 256.f; }
    else { const int e = (id - 24) >> 1;
        m.fp8 = 1;
        if (((id - 24) & 1) == 0) { m.src = (const float*)a.in[I_MGU] + (size_t)e * D * 2 * DFF; m.dst = (bf16_t*)(ws + WS_MOE + (size_t)e * 66 * MiB); m.K = D; m.N = 2 * DFF; m.kind = 3; m.kmul = 64.f; }
        else { m.src = (const float*)a.in[I_MDN] + (size_t)e * DFF * D; m.dst = (bf16_t*)(ws + WS_MOE + (size_t)e * 66 * MiB + 44 * MiB); m.K = DFF; m.N = D; m.kmul = 256.f; }
    }
    return m;
}
constexpr int NMAT = 40;
__device__ __forceinline__ void cvt_item(const Mat& mt, LAS float* scr, int item, int lane) {
    const int nblk = mt.N / 64, kb = item / nblk, nb = item - kb * nblk, k0 = 64 * kb, n0 = 64 * nb;
    const bool g8 = mt.kind == 1 && n0 >= 3072;
    const bool f8 = mt.fp8 || g8; const float kmul = g8 ? 64.f : mt.kmul;
    const int lr = lane >> 4, lc = (lane & 15) * 4;
    f32x4 v[16];
#pragma unroll
    for (int i = 0; i < 16; ++i) v[i] = *(const f32x4*)(mt.src + (size_t)(k0 + 4 * i + lr) * mt.N + n0 + lc);
    if (mt.ksc) {
#pragma unroll
        for (int i = 0; i < 16; ++i) v[i] = v[i] * (mt.ksc[(k0 + 4 * i + lr) % mt.kmod] * mt.kmul); }
    else if (f8) {
#pragma unroll
        for (int i = 0; i < 16; ++i) v[i] = v[i] * kmul; }
#pragma unroll
    for (int i = 0; i < 16; ++i) { LAS float* p = scr + (4 * i + lr) * 65 + lc; p[0] = v[i][0]; p[1] = v[i][1]; p[2] = v[i][2]; p[3] = v[i][3]; }
    LDS_WAIT(); asm volatile("" ::: "memory");
    const int c = lane & 7;
#pragma unroll
    for (int j = 0; j < 8; ++j) { const int n = (lane >> 3) + 8 * j; const LAS float* s = scr + (8 * c) * 65 + n;
        if (f8) { const u32x2 o = pack8_fp8((f32x4){s[0 * 65], s[1 * 65], s[2 * 65], s[3 * 65]}, (f32x4){s[4 * 65], s[5 * 65], s[6 * 65], s[7 * 65]}); const int r_ = map_row(mt.kind, n0 + n, mt.N);
            unsigned char* d8 = g8 ? (unsigned char*)mt.dst + (size_t)NIN_BF * mt.K * 2 + (size_t)(r_ - NIN_BF) * mt.K : (unsigned char*)mt.dst + (size_t)r_ * mt.K;
            *(u32x2*)(d8 + k0 + 8 * c) = o; }
        else { u32x4 o; o.x = cvt_pk_bf16(s[0 * 65], s[1 * 65]); o.y = cvt_pk_bf16(s[2 * 65], s[3 * 65]); o.z = cvt_pk_bf16(s[4 * 65], s[5 * 65]); o.w = cvt_pk_bf16(s[6 * 65], s[7 * 65]);
            *(u32x4*)(mt.dst + (size_t)map_row(mt.kind, n0 + n, mt.N) * mt.K + k0 + 8 * c) = o; } }
    LDS_WAIT(); asm volatile("" ::: "memory");
}
__device__ __forceinline__ void cvt_tile_wg(const Mat& mt, LAS float* scr, int tile, int tid) {
    const int nblk = mt.N / 256, kb = tile / nblk, nb = tile - kb * nblk, k0 = 64 * kb, n0 = 256 * nb;
    const int lane = tid & 63, w = tid >> 6;
    f32x4 v[8];
#pragma unroll
    for (int i = 0; i < 8; ++i) v[i] = *(const f32x4*)(mt.src + (size_t)(k0 + 8 * w + i) * mt.N + n0 + lane * 4);
    if (mt.ksc) {
#pragma unroll
        for (int i = 0; i < 8; ++i) v[i] = v[i] * (mt.ksc[(k0 + 8 * w + i) % mt.kmod] * mt.kmul); }
    else if (mt.fp8) {
#pragma unroll
        for (int i = 0; i < 8; ++i) v[i] = v[i] * mt.kmul; }
#pragma unroll
    for (int i = 0; i < 8; ++i) { LAS float* p = scr + (8 * w + i) * 257 + lane * 4; p[0] = v[i][0]; p[1] = v[i][1]; p[2] = v[i][2]; p[3] = v[i][3]; }
    __syncthreads();
    const int c = tid & 7;
#pragma unroll
    for (int j = 0; j < 4; ++j) { const int n = (tid >> 3) + 64 * j; const LAS float* s = scr + (8 * c) * 257 + n; const int r_ = map_row(mt.kind, n0 + n, mt.N);
        if (mt.fp8) *(u32x2*)((unsigned char*)mt.dst + (size_t)r_ * mt.K + k0 + 8 * c) = pack8_fp8((f32x4){s[0 * 257], s[1 * 257], s[2 * 257], s[3 * 257]}, (f32x4){s[4 * 257], s[5 * 257], s[6 * 257], s[7 * 257]});
        else { u32x4 o; o.x = cvt_pk_bf16(s[0 * 257], s[1 * 257]); o.y = cvt_pk_bf16(s[2 * 257], s[3 * 257]); o.z = cvt_pk_bf16(s[4 * 257], s[5 * 257]); o.w = cvt_pk_bf16(s[6 * 257], s[7 * 257]);
            *(u32x4*)(mt.dst + (size_t)r_ * mt.K + k0 + 8 * c) = o; } }
    __syncthreads();
}
__device__ __forceinline__ void ssm_build(const ArgsD& a, int l, int g, int half, LAS unsigned char* lds) {
    LAS float* Ap = (LAS float*)lds;
    LAS float* Bb = Ap + 33 * 64 * 2;
    LAS float* Cc = Bb + 64 * 16 * 2;
    LAS float* Mk = Cc + 16 * 64 * 2;
    const int tid = opaque_tid();
    const float* lre = (const float*)a.in[I_LRE] + (l * 64 + g) * 64; const float* lim = (const float*)a.in[I_LIM] + (l * 64 + g) * 64;
    const float* bre = (const float*)a.in[I_BRE] + (size_t)(l * 64 + g) * 1024; const float* bim = (const float*)a.in[I_BIM] + (size_t)(l * 64 + g) * 1024;
    const float* cre = (const float*)a.in[I_CRE] + (size_t)(l * 64 + g) * 1024; const float* cim = (const float*)a.in[I_CIM] + (size_t)(l * 64 + g) * 1024;
    const double dt = exp((double)((const float*)a.in[I_LOGDT])[l * 64 + g]);
    for (int idx = tid; idx < 33 * 64; idx += 512) { const int n = idx & 63, k = idx >> 6; const double re = lre[n], im = lim[n];
        const double mag = exp(re * dt * k), ang = im * dt * k; Ap[idx * 2] = (float)(mag * cos(ang)); Ap[idx * 2 + 1] = (float)(mag * sin(ang)); }
    if (tid < 64) { float* a32 = (float*)(a.ws + WS_A32) + (size_t)((l * 64 + g) * 64 + tid) * 2; const double re = lre[tid], im = lim[tid]; const double mag = exp(32.0 * re * dt), ang = 32.0 * im * dt;
        a32[0] = (float)(mag * cos(ang)); a32[1] = (float)(mag * sin(ang)); }
    for (int idx = tid; idx < 1024; idx += 512) { const int n = idx >> 4; const double re = lre[n], im = lim[n]; const double mag = exp(re * dt), ang = im * dt;
        const double lr = mag * cos(ang) - 1.0, li = mag * sin(ang), den = re * re + im * im;
        const double fr_ = (lr * re + li * im) / den, fi_ = (li * re - lr * im) / den; const double br = bre[idx], bi = bim[idx];
        Bb[idx * 2] = (float)(fr_ * br - fi_ * bi); Bb[idx * 2 + 1] = (float)(fr_ * bi + fi_ * br);
        Cc[idx * 2] = cre[idx]; Cc[idx * 2 + 1] = cim[idx]; }
    __syncthreads();
    { const int k = tid >> 4, p = tid & 15; float acc[16];
#pragma unroll
        for (int q = 0; q < 16; ++q) acc[q] = 0.f;
        for (int n = 0; n < 64; ++n) { const float ar = Ap[(k * 64 + n) * 2], ai = Ap[(k * 64 + n) * 2 + 1], cr = Cc[(p * 64 + n) * 2], ci = Cc[(p * 64 + n) * 2 + 1];
            const float ur = cr * ar - ci * ai, ui = cr * ai + ci * ar; const LAS f32x4* bq = (const LAS f32x4*)(Bb + n * 32);
#pragma unroll
            for (int q4 = 0; q4 < 8; ++q4) { const f32x4 bv = bq[q4]; acc[2 * q4] += bv[0] * ur - bv[1] * ui; acc[2 * q4 + 1] += bv[2] * ur - bv[3] * ui; } }
#pragma unroll
        for (int q = 0; q < 16; ++q) Mk[tid * 16 + q] = acc[q]; }
    __syncthreads();
    unsigned char* lw = a.ws + WS_W + (size_t)l * LW_BYTES;
    bf16_t* T = (bf16_t*)(lw + LW_TEXT) + (size_t)g * 512 * SSM_KX; bf16_t* W = (bf16_t*)(lw + LW_WSL) + (size_t)g * 256 * 512;
    for (int it = 0; it < 40; ++it) { const int c = it * 512 + tid, Rl = c / 80, ch = c - Rl * 80, R = 256 * half + Rl, i = R >> 4, p = R & 15; u32x4 w = {0u, 0u, 0u, 0u};
        if (ch < 64) { const int j = ch >> 1, q0 = (ch & 1) * 8;
            if (j <= i) { const LAS float* mp = Mk + ((i - j) * 16 + p) * 16 + q0; w.x = cvt_pk_bf16(mp[0], mp[1]); w.y = cvt_pk_bf16(mp[2], mp[3]); w.z = cvt_pk_bf16(mp[4], mp[5]); w.w = cvt_pk_bf16(mp[6], mp[7]); } }
        else { const int cc = ch - 64; float v[8];
#pragma unroll
            for (int e = 0; e < 4; ++e) { const int n = cc * 4 + e; const float cr = Cc[(p * 64 + n) * 2], ci = Cc[(p * 64 + n) * 2 + 1], ar = Ap[((i + 1) * 64 + n) * 2], ai = Ap[((i + 1) * 64 + n) * 2 + 1];
                v[2 * e] = cr * ar - ci * ai; v[2 * e + 1] = -(cr * ai + ci * ar); }
            w.x = cvt_pk_bf16(v[0], v[1]); w.y = cvt_pk_bf16(v[2], v[3]); w.z = cvt_pk_bf16(v[4], v[5]); w.w = cvt_pk_bf16(v[6], v[7]); }
        *(u32x4*)(T + (size_t)R * SSM_KX + ch * 8) = w; }
    for (int it = 0; it < 16; ++it) { const int c = it * 512 + tid, R = 128 * half + (c >> 6), ch = c & 63; u32x4 w = {0u, 0u, 0u, 0u};
        if (R < 128) { const int n = R >> 1, im = R & 1, j = ch >> 1, q0 = (ch & 1) * 8; float v[8]; const float ar = Ap[((31 - j) * 64 + n) * 2], ai = Ap[((31 - j) * 64 + n) * 2 + 1];
#pragma unroll
            for (int e = 0; e < 8; ++e) { const float br = Bb[(n * 16 + q0 + e) * 2], bi = Bb[(n * 16 + q0 + e) * 2 + 1]; v[e] = im ? (ar * bi + ai * br) : (ar * br - ai * bi); }
            w.x = cvt_pk_bf16(v[0], v[1]); w.y = cvt_pk_bf16(v[2], v[3]); w.z = cvt_pk_bf16(v[4], v[5]); w.w = cvt_pk_bf16(v[6], v[7]); }
        *(u32x4*)(W + (size_t)R * 512 + ch * 8) = w; }
    __syncthreads();
}

struct LnArgs { bf16_t* X; float* outf; unsigned char* outq; const float* g; const float* b;
                const float* og; const int* slot; int* r_e; float* r_w; unsigned* cnt; };
template <int MODE>
__device__ __forceinline__ void ln_phase(const LnArgs& A, LAS unsigned char* lds, int G) {
    const int tid = opaque_tid(), lane = tid & 63, wave = __builtin_amdgcn_readfirstlane(tid >> 6);
    const int gw = blockIdx.x * 8 + wave, NGW = G * 8;
    f32x4 gv[8], bv[8];
    if (MODE != 1) {
#pragma unroll
        for (int j = 0; j < 8; ++j) { gv[j] = *(const f32x4*)(A.g + lane * 8 + 512 * (j >> 1) + 4 * (j & 1)); bv[j] = *(const f32x4*)(A.b + lane * 8 + 512 * (j >> 1) + 4 * (j & 1)); } }
    for (int row = gw; row < M; row += NGW) {
        bf16_t* xr = A.X + (size_t)row * D + lane * 8;
        f32x4 v[8]; float s = 0.f;
#pragma unroll
        for (int j = 0; j < 4; ++j) { const u32x4 w = *(const u32x4*)(xr + 512 * j); v[2 * j] = (f32x4){bf_lo(w.x), bf_hi(w.x), bf_lo(w.y), bf_hi(w.y)}; v[2 * j + 1] = (f32x4){bf_lo(w.z), bf_hi(w.z), bf_lo(w.w), bf_hi(w.w)}; }
        if (MODE == 2) { const int s0 = A.slot[row * 2], s1 = A.slot[row * 2 + 1]; const bf16_t* o0 = (const bf16_t*)A.og + (size_t)s0 * D + lane * 8; const bf16_t* o1 = (const bf16_t*)A.og + (size_t)s1 * D + lane * 8;
#pragma unroll
            for (int j = 0; j < 4; ++j) { const u32x4 a = *(const u32x4*)(o0 + 512 * j), b = *(const u32x4*)(o1 + 512 * j);
                v[2 * j] = v[2 * j] * ALPHA + (f32x4){bf_lo(a.x), bf_hi(a.x), bf_lo(a.y), bf_hi(a.y)} + (f32x4){bf_lo(b.x), bf_hi(b.x), bf_lo(b.y), bf_hi(b.y)};
                v[2 * j + 1] = v[2 * j + 1] * ALPHA + (f32x4){bf_lo(a.z), bf_hi(a.z), bf_lo(a.w), bf_hi(a.w)} + (f32x4){bf_lo(b.z), bf_hi(b.z), bf_lo(b.w), bf_hi(b.w)}; } }
#pragma unroll
        for (int j = 0; j < 8; ++j) s += (v[j][0] + v[j][1]) + (v[j][2] + v[j][3]);
        const float mean = wave_sum(s, lane) * (1.f / D); float s2 = 0.f;
#pragma unroll
        for (int j = 0; j < 8; ++j) { v[j] = v[j] - mean; s2 += (v[j][0] * v[j][0] + v[j][1] * v[j][1]) + (v[j][2] * v[j][2] + v[j][3] * v[j][3]); }
        const float rstd = 1.f / sqrtf(wave_sum(s2, lane) * (1.f / D) + LN_EPS);
#pragma unroll
        for (int j = 0; j < 8; ++j) { if (MODE == 1) { gv[j] = *(const f32x4*)(A.g + lane * 8 + 512 * (j >> 1) + 4 * (j & 1)); bv[j] = *(const f32x4*)(A.b + lane * 8 + 512 * (j >> 1) + 4 * (j & 1)); }
            v[j] = v[j] * rstd * gv[j] + bv[j]; }
        if (A.outf) { float* of = A.outf + (size_t)row * D + lane * 8;
#pragma unroll
            for (int j = 0; j < 8; ++j) *(f32x4*)(of + 512 * (j >> 1) + 4 * (j & 1)) = v[j]; }
        else {
#pragma unroll
            for (int j = 0; j < 4; ++j) *(u32x4*)(xr + 512 * j) = pack8(v[2 * j], v[2 * j + 1]); }
        if (A.outq) { unsigned char* oq = A.outq + (size_t)row * D + lane * 8;
#pragma unroll
            for (int j = 0; j < 4; ++j) *(u32x2*)(oq + 512 * j) = pack8_fp8(v[2 * j], v[2 * j + 1]); }
        if (MODE == 1) {
            const LAS float* wr_ = (const LAS float*)lds;
            int i0 = 0, i1 = 0; float v0 = -__builtin_inff(), v1 = -__builtin_inff();
#pragma unroll 1
            for (int e = 0; e < 8; ++e) { float acc = 0.f;
#pragma unroll
                for (int j = 0; j < 8; ++j) { const f32x4 w = *(const LAS f32x4*)(wr_ + e * D + lane * 8 + 512 * (j >> 1) + 4 * (j & 1)); acc += (v[j][0] * w[0] + v[j][1] * w[1]) + (v[j][2] * w[2] + v[j][3] * w[3]); }
                const float sg = wave_sum(acc, lane);
                if (sg > v0) { v1 = v0; i1 = i0; v0 = sg; i0 = e; } else if (sg > v1) { v1 = sg; i1 = e; } }
            const float w0 = 1.f / (1.f + expf(v1 - v0)), w1 = 1.f - w0;
            if (lane == 0) { A.r_e[row * 2] = i0; A.r_e[row * 2 + 1] = i1; A.r_w[row * 2] = w0; A.r_w[row * 2 + 1] = w1;
                __hip_atomic_fetch_add(A.cnt + i0, 1u, RLX_AGENT); __hip_atomic_fetch_add(A.cnt + i1, 1u, RLX_AGENT); }
        }
    }
}
__device__ __forceinline__ void moe_offsets(const unsigned* cnt, int (&off)[9]) {
    int acc = 0;
#pragma unroll
    for (int e = 0; e < 8; ++e) { off[e] = acc; const int c = (int)__hip_atomic_load(cnt + e, RLX_AGENT); acc += ((c + 255) >> 8) << 8; }
    off[8] = acc;
}

struct AttPtrs { const bf16_t *QD, *KD, *VD, *QM, *KM, *VM; bf16_t *BR0, *BR1; };
__device__ __forceinline__ void mla_unit(const AttPtrs& P, int h, int qb, char* lds) {
    const int tid = opaque_tid(), wid = __builtin_amdgcn_readfirstlane(tid >> 6), lane = tid & 63, r32 = lane & 31, hi = lane >> 5;
    const int q0 = qb * 256 + wid * 32; f32x16 o[4]; float l;
    att::attn_core_pp<192, 12, true, false>(P.QM + (size_t)(q0 + r32) * 1536 + h * 192 + hi * 8, P.KM + h * 192, 1536, P.VM + h * 128, 1024, 4 * (qb + 1), q0 + r32, q0, 0, lds, o, l);
    float* ws = (float*)(lds + 3 * att::SHM_V + 3 * 64 * 384) + wid * 64;
    att::normalize_o(o, l, ws, r32, hi);
    att::store_o_bf16(o, P.BR1 + (size_t)q0 * 1024 + h * 128, 1024, r32, hi);
    __syncthreads();
}
__device__ __forceinline__ void diff_unit(const AttPtrs& P, int h, int qb, float lam, char* lds) {
    const int tid = opaque_tid(), wid = __builtin_amdgcn_readfirstlane(tid >> 6), lane = tid & 63, r32 = lane & 31, hi = lane >> 5;
    const int mp = wid >> 2, w4 = wid & 3, q0 = qb * 128 + w4 * 32; f32x16 o[4]; float l;
    att::attn_core_pp<128, 4, true, true>(P.QD + (size_t)(q0 + r32) * 1024 + h * 128 + mp * 64 + hi * 8, P.KD + h * 128, 1024, P.VD + h * 128, 1024, 2 * (qb + 1), q0 + r32, q0, mp * 8, lds, o, l);
    float* ws = (float*)(lds + 3 * att::SHM_V + 3 * 64 * 256) + wid * 64;
    att::normalize_o(o, l, ws, r32, hi);
    __syncthreads();
    float* xch = (float*)lds + w4 * 4096 + lane;
    if (mp == 1) {
#pragma unroll
        for (int d0 = 0; d0 < 4; ++d0)
#pragma unroll
            for (int r = 0; r < 16; ++r) xch[(d0 * 16 + r) * 64] = o[d0][r];
    }
    __syncthreads();
    if (mp == 0) {
        float ss[16];
#pragma unroll
        for (int r = 0; r < 16; ++r) { float s = 0.f;
#pragma unroll
            for (int d0 = 0; d0 < 4; ++d0) { const float dv = o[d0][r] - lam * xch[(d0 * 16 + r) * 64]; o[d0][r] = dv; s += dv * dv; }
            ss[r] = s; }
#pragma unroll
        for (int r = 0; r < 16; ++r) { float s = ss[r];
#pragma unroll
            for (int off = 1; off < 32; off <<= 1) s += shflx(s, off, lane);
            const float rs = __builtin_amdgcn_rsqf(s * (1.f / 128.f) + RMS_EPS);
#pragma unroll
            for (int d0 = 0; d0 < 4; ++d0) o[d0][r] *= rs; }
        att::store_o_bf16(o, P.BR0 + (size_t)q0 * 1024 + h * 128, 1024, r32, hi);
    }
    __syncthreads();
}
__device__ __forceinline__ void cross_unit(const bf16_t* XQ, const bf16_t* XKV, bf16_t* XO, int h, int qb, char* lds) {
    const int tid = opaque_tid(), wid = __builtin_amdgcn_readfirstlane(tid >> 6), lane = tid & 63, r32 = lane & 31, hi = lane >> 5;
    const int q0 = qb * 256 + wid * 32; f32x16 o[4]; float l;
    att::attn_core<128, 8, false, true>(XQ + (size_t)(q0 + r32) * 512 + h * 128 + hi * 8, XKV + h * 128, 1024, XKV + 512 + h * 128, 1024, 4, 0, 0, 0, lds, o, l);
    float* ws = (float*)(lds + 2 * att::SHM_V + 2 * 64 * 256) + wid * 64;
    att::normalize_o(o, l, ws, r32, hi);
    att::store_o_bf16(o, XO + (size_t)q0 * 512 + h * 128, 512, r32, hi);
    __syncthreads();
}

__global__ void __launch_bounds__(512, 2) fwd_kernel(Args args) {
    extern __shared__ __attribute__((aligned(16))) unsigned char lds_raw[];
    LAS unsigned char* lds = (LAS unsigned char*)lds_raw;
    const int tid = threadIdx.x, lane = tid & 63, wave = __builtin_amdgcn_readfirstlane(tid >> 6);
    const int G = gridDim.x, bx = blockIdx.x;
    unsigned char* ws = (unsigned char*)(GAS unsigned char*)(unsigned long long)args.ws;
    unsigned* ctl = (unsigned*)(ws + WS_CTL);
    volatile LAS unsigned* MISC = (volatile LAS unsigned*)(lds + LDS_MISC);
    if (tid < 32) MISC[tid] = 0u;
    if (lane == 0) ((volatile LAS int*)LDS_WTAB)[__builtin_amdgcn_s_getreg(0x2804)] = wave;
    { volatile LAS unsigned long long* pt = (volatile LAS unsigned long long*)(lds + LDS_MISC + 256); if (tid < 35) pt[tid] = (unsigned long long)args.in[tid]; if (tid == 35) pt[35] = (unsigned long long)args.out; }
    __syncthreads();
    ArgsD ad; ad.in.t = (volatile LAS unsigned long long*)(lds + LDS_MISC + 256); ad.ws = ws;
    const int lo = args.ph_lo, hi = args.ph_hi;
    XcdBarrier bar; bar.bar = ctl + CW_BAR; bar.x = 0; bar.st = nullptr;
    if (hi - lo > 1) { bar = xcd_barrier_post(ctl + CW_BAR, MISC + 8); xcd_barrier_setup(bar); }
#ifndef PH_SEL
#define PH_SEL 0xFFFFFFFFu
#endif
#define INR(k) (lo <= (k) && (k) < hi)
#define IN0() (((PH_SEL) & 1u) && INR(0))
#define INL(j) ((((PH_SEL) >> ((j) + 1)) & 1u) && INR(pb + (j)))
#define SEAM(k) do { if (INR(k) && INR((k) + 1)) xcd_barrier(bar); } while (0)
    const int gw = bx * 8 + wave, NGW = G * 8;
    const int gtid = bx * 512 + tid, NGT = G * 512;

    if (IN0()) {
      {
        { int start = bx;
            for (int id = 0; id < NMAT; ++id) { const Mat mt = get_mat(ad, id); if (mt.kind == 1) continue; const int nit = (mt.K / 64) * (mt.N / 256);
                int it = start; for (; it < nit; it += G) cvt_tile_wg(mt, (LAS float*)lds, it, tid);
                start = it - nit; } }
        { LAS float* scr = (LAS float*)(lds + wave * 16640); int start = gw;
            for (int id = 0; id < 22; id += 11) { const Mat mt = get_mat(ad, id); const int nit = (mt.K / 64) * (mt.N / 64);
                int it = start; for (; it < nit; it += NGW) cvt_item(mt, scr, it, lane);
                start = it - nit; } }
        for (int l = 0; l < DEPTH; ++l) { u32x4* p = (u32x4*)((unsigned char*)(ws + WS_W + (size_t)l * LW_BYTES + LW_IN) + (size_t)NIN_BF * D * 2 + (size_t)(3904 - NIN_BF) * D);
            for (int i = gtid; i < 192 * D / 16; i += NGT) p[i] = (u32x4){0u, 0u, 0u, 0u}; }
        { const float* x = (const float*)ad.in[I_X]; bf16_t* xn = (bf16_t*)(ws + WS_XN);
            unsigned char* x8 = ws + WS_XN8;
            for (size_t i = gtid; i < (size_t)M * D / 8; i += NGT) { const f32x4 a = *(const f32x4*)(x + i * 8), b = *(const f32x4*)(x + i * 8 + 4); *(u32x4*)(xn + i * 8) = pack8(a, b); *(u32x2*)(x8 + i * 8) = pack8_fp8(a, b); }
            const float* mem = (const float*)ad.in[I_MEM]; bf16_t* mb = (bf16_t*)(ws + WS_MEMB);
            for (int i = gtid; i < MEM_LEN * D / 8; i += NGT) { const f32x4 a = *(const f32x4*)(mem + i * 8), b = *(const f32x4*)(mem + i * 8 + 4); *(u32x4*)(mb + i * 8) = pack8(a, b); } }
        { const int* pos = (const int*)ad.in[I_POS]; float* td = (float*)(ws + WS_TABD); float* tm = (float*)(ws + WS_TABM);
            for (int i = gtid; i < M * 40; i += NGT) { const int t = i / 40, k = i - t * 40; const double p = (double)pos[t];
                const double inv = (k < 8) ? exp(-(double)k * (13.122363377404328 / 8.0)) : exp(-(double)(k - 8) * (13.122363377404328 / 32.0));
                const double ang = p * inv; const float c = (float)cos(ang), s = (float)sin(ang);
                if (k < 8) { td[(t * 8 + k) * 2] = c; td[(t * 8 + k) * 2 + 1] = s; } else { tm[(t * 32 + k - 8) * 2] = c; tm[(t * 32 + k - 8) * 2 + 1] = s; } } }
        if (bx == 0 && tid < 192) { int* ord = (int*)(ws + WS_ORDER); const int mine = tid < 64 ? 160 * (tid + 1) : 48 * (tid - 64 + 1); int rank = 0;
            for (int c = 0; c < 192; ++c) { const int cc = c < 64 ? 160 * (c + 1) : 48 * (c - 64 + 1); rank += (cc > mine || (cc == mine && c < tid)) ? 1 : 0; }
            const int code = tid < 64 ? ((1 << 16) | (tid << 8)) : ((tid - 64) << 8);
            for (int h = 0; h < 8; ++h) ord[rank * 8 + h] = code | h; }
        __syncthreads();
#ifdef PROBE_SSMB
#pragma nounroll
        for (int rep_ = 0; rep_ < 2; ++rep_)
#endif
        for (int uidx = bx; uidx < DEPTH * 64 * 2; uidx += G) ssm_build(ad, uidx >> 7, (uidx >> 1) & 63, uidx & 1, lds);
        __syncthreads();
      }
    }
    SEAM(0);

    unsigned char* const ws_k = ws; const int bx_k = bx;
    for (int l = 0; l < DEPTH; ++l) {
        const int pb = 1 + l * NPL;
        if (!(lo < pb + NPL && pb < hi)) continue;
        int bx = bx_k; asm volatile("" : "+s"(bx));
        unsigned long long ws_i = (unsigned long long)ws_k; asm volatile("" : "+s"(ws_i)); unsigned char* ws = (unsigned char*)(GAS unsigned char*)ws_i;
#define PH_TID const int tid = opaque_tid(), lane = tid & 63, wave = __builtin_amdgcn_readfirstlane(tid >> 6); const int gw = bx * 8 + wave, NGW = G * 8; (void)lane; (void)wave; (void)gw; (void)NGW
#define lw (ws + WS_W + (size_t)l * LW_BYTES)
#define ssq_q ((float*)(ws + WS_PSQ))
#define ssq_kv (ssq_q + (size_t)8 * M)
#define XS ((float*)(ws + WS_XS))
#define XN ((bf16_t*)(ws + WS_XN))
#define tabd ((const float*)(ws + WS_TABD))
#define tabm ((const float*)(ws + WS_TABM))
#define QD ((bf16_t*)(ws + WS_QD))
#define KD ((bf16_t*)(ws + WS_KD))
#define VD ((bf16_t*)(ws + WS_VD))
#define MQ ((bf16_t*)(ws + WS_MQ))
#define MKV ((bf16_t*)(ws + WS_MKV))
#define KM ((bf16_t*)(ws + WS_KM))
#define VM ((bf16_t*)(ws + WS_VM))
#define QM ((bf16_t*)(ws + WS_QM))
#define SU ((bf16_t*)(ws + WS_SU))
#define GATES ((bf16_t*)(ws + WS_GATES))
#define SLOC ((float*)(ws + WS_SLOC))
#define YG ((bf16_t*)(ws + WS_YG))
#define BR ((bf16_t*)(ws + WS_BR))
#define TMP ((float*)(ws + WS_TMP))
#define MG ((bf16_t*)(ws + WS_MG))
#define XQ ((bf16_t*)(ws + WS_XQ))
#define XO ((bf16_t*)(ws + WS_XO))
#define XKV ((bf16_t*)(ws + WS_XKV) + (size_t)l * 256 * 1024)
#define r_e ((int*)(ws + WS_ROUTE))
#define r_w ((float*)(ws + WS_ROUTE + 128 * 1024))
#define slot ((int*)(ws + WS_ROUTE + 256 * 1024))
#define wslot ((float*)(ws + WS_ROUTE + 384 * 1024))
        if (INL(0)) {
#if !defined(SUBSEL) || (SUBSEL & 1)
            { pg8::Gemm g{XN, (const bf16_t*)(lw + LW_IN), (D) * 2, (D) * 2, (D) * 2, 0}; SchedPlain S; S.init(M / 256, NIN_BF / 256, D, D, G, bx);
              EpiInProj E{QD, KD, VD, MQ, MKV, KM, SU, GATES, ssq_q, ssq_kv, tabd, tabm, 0};
              pg8::gemm_phase(lds, g, S, E); }
            { pg8::Gemm g{ws + WS_XN8, lw + LW_IN + (size_t)NIN_BF * D * 2, D, D, D, 0}; SchedPlain S; S.T.init(M / 256, NIN_G8 / 256); S.G = G; S.c = bx; S.tA = (size_t)256 * D; S.tB = S.tA;
              EpiInProj E{QD, KD, VD, MQ, MKV, KM, SU, GATES, ssq_q, ssq_kv, tabd, tabm, 12};
              pg8::gemm_phase_t<true, 0x7C7C7C7C>(lds, g, S, E); }
#endif
#if !defined(SUBSEL) || (SUBSEL & 2)
            { pg8::Gemm g{(const bf16_t*)(ws + WS_MEMB), (const bf16_t*)(lw + LW_XKV), (D) * 2, (D) * 2, (D) * 2, 0}; SchedPlain S; S.init(1, 4, D, D, G, (bx + 128) % G);
              EpiBf16 E{XKV, 1024, 1.f};
              pg8::gemm_phase(lds, g, S, E); }
#endif
        }
        SEAM(pb + 0);
        if (INL(1)) {
#if !defined(SUBSEL) || (SUBSEL & 1)
            { pg8::Gemm g{MQ, (const bf16_t*)(lw + LW_QUP), (512) * 2, (512) * 2, (512) * 2, 0}; SchedPlain S; S.init(M / 256, 6, 512, 512, G, bx);
              EpiQup E{QM, ssq_q, tabm}; pg8::gemm_phase(lds, g, S, E); }
#endif
#if !defined(SUBSEL) || (SUBSEL & 2)
            { pg8::Gemm g{MKV, (const bf16_t*)(lw + LW_KVUP), (256) * 2, (256) * 2, (256) * 2, 0}; SchedPlain S; S.init(M / 256, 8, 256, 256, G, (bx + 128) % G);
              EpiKVup E{KM, VM, ssq_kv}; pg8::gemm_phase(lds, g, S, E); }
#endif
#if !defined(SUBSEL) || (SUBSEL & 4)
            { pg8::Gemm g{SU, (const bf16_t*)(lw + LW_WSL), (SSM_KX) * 2, (512) * 2, (512) * 2, 0}; SchedBatch S{2, 1, 64, G, (bx + 128) % G  , (size_t)256 * SSM_KX * 2, (size_t)256 * 512 * 2, (size_t)SSM_NCH * SSM_KX * 2, (size_t)256 * 512 * 2};
              EpiSloc E{SLOC}; pg8::gemm_phase(lds, g, S, E); }
#endif
        }
        SEAM(pb + 1);
        if (INL(2)) {
            PH_TID;
            if (bx < 64) { const int g = bx, n = lane, w = wave;
                const float* a32 = (const float*)(ws + WS_A32) + (size_t)((l * 64 + g) * 64 + n) * 2; const float ar = a32[0], ai = a32[1];
                const float* __restrict__ lp = SLOC + ((size_t)g * SSM_NCH + 64 * w) * 128 + 2 * n; bf16_t* __restrict__ sp = SU + ((size_t)g * SSM_NCH + 64 * w) * SSM_KX + 512 + 2 * n;
                float br[64], bi[64]; float sr = 0.f, si = 0.f;
#pragma unroll
                for (int c0 = 0; c0 < 64; c0 += 32) { f32x2 lv[32];
#pragma unroll
                    for (int k = 0; k < 32; ++k) lv[k] = *(const f32x2*)(lp + (size_t)(c0 + k) * 128);
#pragma unroll
                    for (int k = 0; k < 32; ++k) { br[c0 + k] = sr; bi[c0 + k] = si; const float nr = ar * sr - ai * si + lv[k][0], ni = ar * si + ai * sr + lv[k][1]; sr = nr; si = ni; } }
                LAS float* ex = (LAS float*)lds;
                ex[(w * 64 + n) * 2] = sr; ex[(w * 64 + n) * 2 + 1] = si;
                float pr = ar, pi = ai;
#pragma unroll
                for (int q = 0; q < 6; ++q) { const float tr = pr * pr - pi * pi, ti = 2.f * pr * pi; pr = tr; pi = ti; }
                __syncthreads();
                float cr = 0.f, ci = 0.f;
                for (int uu = 0; uu < w; ++uu) { const float er = ex[(uu * 64 + n) * 2], ei = ex[(uu * 64 + n) * 2 + 1]; const float tr = pr * cr - pi * ci + er, ti = pr * ci + pi * cr + ei; cr = tr; ci = ti; }
#pragma unroll
                for (int k = 0; k < 64; ++k) { *(unsigned*)(sp + (size_t)k * SSM_KX) = cvt_pk_bf16(br[k] + cr, bi[k] + ci);
                    const float tr = ar * cr - ai * ci, ti = ar * ci + ai * cr; cr = tr; ci = ti; } }
        }
        SEAM(pb + 2);
        if (INL(3)) {
#if !defined(SUBSEL) || (SUBSEL & 1)
            { pg8::Gemm g{SU, (const bf16_t*)(lw + LW_TEXT), (SSM_KX) * 2, (SSM_KX) * 2, (SSM_KX) * 2, 0}; SchedBatch S{2, 2, 64, G, bx, (size_t)256 * SSM_KX * 2, (size_t)256 * SSM_KX * 2, (size_t)SSM_NCH * SSM_KX * 2, (size_t)512 * SSM_KX * 2};
              EpiSsmY E{YG, SU, (const float*)ad.in[I_SSMD] + l * 1024}; pg8::gemm_phase(lds, g, S, E); }
#endif
            PH_TID;
            const float* dl = (const float*)ad.in[I_DLAM] + l * 256;
            const float lam = expf(wave_sum(dl[lane] * dl[64 + lane], lane)) - expf(wave_sum(dl[128 + lane] * dl[192 + lane], lane)) + lam_init_of(l);
            const AttPtrs P{QD, KD, VD, QM, KM, VM, BR, BR + (size_t)M * 1024};
            const int* ord = (const int*)(ws + WS_ORDER);
            __syncthreads();
#ifndef PROBE_ATT
#define PROBE_ATT 0
#endif
            const unsigned myx = xb_xcc_id() & 7u;
#pragma nounroll
            for (int rep = 0; rep < (PROBE_ATT ? 2 : 1); ++rep)
#pragma nounroll
            for (int sq = 0; sq < 8; ++sq) { const int q = (int)((myx + sq) & 7u);
            for (;;) {
                if (tid == 0) MISC[0] = __hip_atomic_fetch_add(ctl + CW_ATTQ + 64 * l + 32 * rep + q, 1u, RLX_AGENT);
                __syncthreads();
                const unsigned it = MISC[0];
                __syncthreads();
                if (it >= 192u) break;
                const int code = ord[it * 8 + q], h = code & 255, qb = (code >> 8) & 255;
                if ((code >> 16) && (rep == 0 || (PROBE_ATT & 1))) mla_unit(P, h, qb, (char*)lds_raw);
                if (!(code >> 16) && (rep == 0 || (PROBE_ATT & 2))) diff_unit(P, h, qb, lam, (char*)lds_raw);
            } }
        }
        SEAM(pb + 3);
        if (INL(4)) {
            pg8::Gemm g{YG, (const bf16_t*)(lw + LW_GLU), (1024) * 2, (1024) * 2, (1024) * 2, 0}; SchedPlain S; S.init(M / 256, 8, 1024, 1024, G, bx);
            EpiGated<0> E{BR + (size_t)2 * M * 1024, 1024}; pg8::gemm_phase(lds, g, S, E);
        }
        SEAM(pb + 4);
        if (INL(5)) {
            pg8::Gemm g{BR, (const bf16_t*)(lw + LW_BR), (1024) * 2, (1024) * 2, (1024) * 2, 0}; SchedBranch S; S.T.init(M / 256, 8); S.G = G; S.c = bx; S.tA = (size_t)256 * 1024 * 2; S.tB = S.tA; S.zA = (size_t)M * 1024 * 2; S.zB = (size_t)2048 * 1024 * 2;
            EpiBranch E{GATES, (bf16_t*)TMP, MG}; pg8::gemm_phase(lds, g, S, E);
        }
        SEAM(pb + 5);
        if (INL(6)) {
            pg8::Gemm g{MG, (const bf16_t*)(lw + LW_OUT), (D) * 2, (D) * 2, (D) * 2, 0}; SchedPlain S; S.init(M / 256, 8, D, D, G, bx);
            EpiResid E{XN}; pg8::gemm_phase(lds, g, S, E);
        }
        SEAM(pb + 6);
        if (INL(7)) { const LnArgs A{XN, nullptr, nullptr, (const float*)ad.in[I_LNMG] + l * D, (const float*)ad.in[I_LNMB] + l * D, nullptr, nullptr, nullptr, nullptr, nullptr}; ln_phase<0>(A, lds, G); }
        SEAM(pb + 7);
        if (INL(8)) {
            pg8::Gemm g{XN, (const bf16_t*)(lw + LW_XQ), (D) * 2, (D) * 2, (D) * 2, 0}; SchedPlain S; S.T.init(M / 128, 2); S.G = G; S.c = bx; S.tA = (size_t)128 * D * 2; S.tB = (size_t)256 * D * 2;
            EpiBf16Half E{XQ, 512, C2_X}; pg8::gemm_phase(lds, g, S, E);
        }
        SEAM(pb + 8);
        if (INL(9)) { for (int uidx = bx; uidx < 256; uidx += G) cross_unit(XQ, XKV, XO, uidx & 3, uidx >> 2, (char*)lds_raw); }
        SEAM(pb + 9);
        if (INL(10)) {
            pg8::Gemm g{XO, (const bf16_t*)(lw + LW_XO), (512) * 2, (512) * 2, (512) * 2, 0}; SchedPlain S; S.init(M / 256, 8, 512, 512, G, bx);
            EpiResid E{XN}; pg8::gemm_phase(lds, g, S, E);
        }
        SEAM(pb + 10);
        if (INL(11)) {
            const LnArgs A{XN, nullptr, nullptr, (const float*)ad.in[I_LNXG] + l * D, (const float*)ad.in[I_LNXB] + l * D, nullptr, nullptr, r_e, r_w, ctl + CW_MOECNT};
            if (l == 0) ln_phase<0>(A, lds, G);
            else { PH_TID; const float* rw = (const float*)ad.in[I_ROUTER]; LAS float* wl = (LAS float*)lds;
                for (int i = tid; i < D * 8; i += 512) wl[(i & 7) * D + (i >> 3)] = rw[i];
                __syncthreads(); ln_phase<1>(A, lds, G); __syncthreads(); }
        }
        SEAM(pb + 11);
        if (l == 1) {
            if (INL(12)) { PH_TID; int off[9]; moe_offsets(ctl + CW_MOECNT, off); bf16_t* XG = (bf16_t*)(ws + WS_XG);
                for (int row = gw; row < M; row += NGW) { int s0 = 0, s1 = 0;
                    if (lane == 0) { const int e0 = r_e[row * 2], e1 = r_e[row * 2 + 1];
                        s0 = off[e0] + (int)__hip_atomic_fetch_add(ctl + CW_MOECUR + e0, 1u, RLX_AGENT); s1 = off[e1] + (int)__hip_atomic_fetch_add(ctl + CW_MOECUR + e1, 1u, RLX_AGENT);
                        slot[row * 2] = s0; slot[row * 2 + 1] = s1; wslot[s0] = r_w[row * 2]; wslot[s1] = r_w[row * 2 + 1]; }
                    s0 = __builtin_amdgcn_readfirstlane(s0); s1 = __builtin_amdgcn_readfirstlane(s1);
                    const u32x4* src = (const u32x4*)(XN + (size_t)row * D) + lane; u32x2* d0 = (u32x2*)((unsigned char*)XG + (size_t)s0 * D) + lane; u32x2* d1 = (u32x2*)((unsigned char*)XG + (size_t)s1 * D) + lane;
#pragma unroll
                    for (int j = 0; j < 4; ++j) { const u32x4 v = src[64 * j];
                        const u32x2 q = pack8_fp8((f32x4){bf_lo(v.x), bf_hi(v.x), bf_lo(v.y), bf_hi(v.y)}, (f32x4){bf_lo(v.z), bf_hi(v.z), bf_lo(v.w), bf_hi(v.w)}); d0[64 * j] = q; d1[64 * j] = q; } } }
            SEAM(pb + 12);
        }
        if (INL(13)) {
            if (l == 0) { pg8::Gemm g{XN, (const bf16_t*)(ws + WS_FFN), (D) * 2, (D) * 2, (D) * 2, 0}; SchedPlain S; S.init(M / 256, 44, D, D, G, bx);
                EpiSwigluF8 E{ws + WS_HG, DFF}; pg8::gemm_phase(lds, g, S, E); }
            else { int off[9]; moe_offsets(ctl + CW_MOECNT, off);
                pg8::Gemm g{ws + WS_XG, ws + WS_MOE, D, D, D, 0x7C7C7C7C}; SchedMoe S; S.T.init(off[8] >> 8, 44); S.G = G; S.c = bx; S.tA = (size_t)256 * D; S.tB = S.tA; S.zB = 66 * MiB;
#pragma unroll
                for (int k = 0; k < 7; ++k) S.off[k] = off[k + 1];
                EpiSwigluF8 E{ws + WS_HG, DFF}; pg8::gemm_phase_t<true, 0x7C7C7C7C>(lds, g, S, E); }
        }
        SEAM(pb + 13);
        if (INL(14)) {
            if (l == 0) { pg8::Gemm g{ws + WS_HG, ws + WS_FFN + 44 * MiB, DFF, DFF, DFF, 0x7B7B7B7B}; SchedPlain S; S.init(M / 256, 8, DFF / 2, DFF / 2, G, bx);
                EpiResid E{XN}; pg8::gemm_phase_t<true, 0x7B7B7B7B>(lds, g, S, E); }
            else { int off[9]; moe_offsets(ctl + CW_MOECNT, off);
                pg8::Gemm g{ws + WS_HG, ws + WS_MOE + 44 * MiB, DFF, DFF, DFF, 0x7B7B7B7B}; SchedMoe S; S.T.init(off[8] >> 8, 8); S.G = G; S.c = bx; S.tA = (size_t)256 * DFF; S.tB = S.tA; S.zB = 66 * MiB;
#pragma unroll
                for (int k = 0; k < 7; ++k) S.off[k] = off[k + 1];
                EpiMoeDown E{(bf16_t*)(ws + WS_OG), wslot}; pg8::gemm_phase_t<true, 0x7B7B7B7B>(lds, g, S, E); }
        }
        SEAM(pb + 14);
        if (INL(15)) {
            const LnArgs A{XN, (l == DEPTH - 1) ? (float*)ad.in[35] : nullptr, (l == DEPTH - 1) ? nullptr : ws + WS_XN8, (const float*)ad.in[I_LNFG] + l * D, (const float*)ad.in[I_LNFB] + l * D, (const float*)(ws + WS_OG), slot, nullptr, nullptr, nullptr};
            if (l == 0) ln_phase<0>(A, lds, G); else ln_phase<2>(A, lds, G);
        }
        SEAM(pb + 15);
    }
#undef INR
#undef IN0
#undef INL
#undef SEAM
}

extern "C" void kernel_launch(void* const* d_in, const int* in_sizes, int n_in, void* d_out, int out_size, void* d_ws, size_t ws_size, hipStream_t stream) {
    static int grid = 0;
    if (grid == 0) {
        if (n_in != 35 || out_size != M * D || ws_size < WS_END) { fprintf(stderr, "kernel_launch: shape/workspace mismatch: n_in %d out %d ws %zu (need %zu)\n", n_in, out_size, ws_size, (size_t)WS_END); grid = -1; return; }
        int dev = 0, cus = 0, per_cu = 0;
        if (hipGetDevice(&dev) != hipSuccess || hipDeviceGetAttribute(&cus, hipDeviceAttributeMultiprocessorCount, dev) != hipSuccess) { grid = -1; return; }
        if (hipFuncSetAttribute((const void*)fwd_kernel, hipFuncAttributeMaxDynamicSharedMemorySize, LDS_BYTES) != hipSuccess) { fprintf(stderr, "kernel_launch: hipFuncSetAttribute failed\n"); grid = -1; return; }
        if (hipOccupancyMaxActiveBlocksPerMultiprocessor(&per_cu, (const void*)fwd_kernel, 512, LDS_BYTES) != hipSuccess || per_cu < 1) { fprintf(stderr, "kernel_launch: occupancy query says %d\n", per_cu); }
        (void)hipGetLastError();
        grid = cus;
    }
    if (grid < 0) return;
    if (hipMemsetAsync((char*)d_ws + WS_CTL, 0, CTL_ZERO_BYTES, stream) != hipSuccess) return;
    Args a{};
    for (int i = 0; i < 35; ++i) a.in[i] = d_in[i];
    a.out = (float*)d_out; a.ws = (unsigned char*)d_ws;
#if MK_MULTI
    for (int p = 0; p < NPHASE; ++p) { if (p == 1 + 12) continue; a.ph_lo = p; a.ph_hi = p + 1; hipLaunchKernelGGL(fwd_kernel, dim3(grid), dim3(512), LDS_BYTES, stream, a); }
#else
    a.ph_lo = 0; a.ph_hi = NPHASE;
    hipLaunchKernelGGL(fwd_kernel, dim3(grid), dim3(512), LDS_BYTES, stream, a);
#endif
    const hipError_t le = hipPeekAtLastError();
    if (le != hipSuccess) fprintf(stderr, "kernel_launch: launch failed: %s\n", hipGetErrorName(le));
}
```

```cpp
#include <hip/hip_runtime.h>
#include <cstdio>
#include <cstdint>
#include <cmath>

#ifndef MK_MULTI
#define MK_MULTI 0
#endif
#ifndef MK_DBG
#define MK_DBG 0
#endif

#define GAS __attribute__((address_space(1)))
#define LAS __attribute__((address_space(3)))
typedef unsigned short bf16_t;
typedef short bf16x8 __attribute__((ext_vector_type(8)));
typedef short s16x4 __attribute__((ext_vector_type(4)));
typedef float f32x2 __attribute__((ext_vector_type(2)));
typedef float f32x4 __attribute__((ext_vector_type(4)));
typedef float f32x16 __attribute__((ext_vector_type(16)));
typedef unsigned u32x2 __attribute__((ext_vector_type(2)));
typedef unsigned u32x4 __attribute__((ext_vector_type(4)));
typedef GAS unsigned gu32;
#define RLX_AGENT __ATOMIC_RELAXED, __HIP_MEMORY_SCOPE_AGENT
#define LDS_WAIT() asm volatile("s_waitcnt lgkmcnt(0)" ::: "memory")
#define VM_WAIT() asm volatile("s_waitcnt vmcnt(0)" ::: "memory")
#define SBAR() __builtin_amdgcn_sched_barrier(0)

constexpr int M = 16384, D = 2048, DEPTH = 2, MEM_LEN = 256;
constexpr int NIN = 11264, NIN_BF = 3072  , NIN_G8 = 8192  ;
constexpr int NIN_SRC = 11072;
constexpr int DFF = 5632, NEXP = 8;
constexpr int SSM_L = 32, SSM_NCH = M / SSM_L  , SSM_KX = 640  ;
constexpr float LN_EPS = 1e-5f, RMS_EPS = 1e-6f;
constexpr float ALPHA = 1.4142135623730951f;
constexpr float LOG2E = 1.4426950408889634f;
constexpr float C2_DIFF = 0.125f * LOG2E;
constexpr float C2_MLA = 0.07216878364870323f * LOG2E;
constexpr float C2_X = 0.08838834764831845f * LOG2E;
constexpr int MOE_MAXROWS = 34816;

typedef __bf16 bf16x2_t __attribute__((ext_vector_type(2)));
__device__ __forceinline__ unsigned cvt_pk_bf16(float lo, float hi) { const f32x2 v = {lo, hi}; const bf16x2_t b = __builtin_convertvector(v, bf16x2_t); return __builtin_bit_cast(unsigned, b); }
__device__ __forceinline__ float bf_lo(unsigned w) { return __uint_as_float(w << 16); }
__device__ __forceinline__ float bf_hi(unsigned w) { return __uint_as_float(w & 0xffff0000u); }
__device__ __forceinline__ u32x4 pack8(f32x4 a, f32x4 b) { u32x4 w; w.x = cvt_pk_bf16(a[0], a[1]); w.y = cvt_pk_bf16(a[2], a[3]); w.z = cvt_pk_bf16(b[0], b[1]); w.w = cvt_pk_bf16(b[2], b[3]); return w; }
__device__ __forceinline__ u32x2 pack8_fp8(f32x4 a, f32x4 b) { int w0 = 0, w1 = 0;
    w0 = __builtin_amdgcn_cvt_pk_fp8_f32(a[0], a[1], w0, false); w0 = __builtin_amdgcn_cvt_pk_fp8_f32(a[2], a[3], w0, true);
    w1 = __builtin_amdgcn_cvt_pk_fp8_f32(b[0], b[1], w1, false); w1 = __builtin_amdgcn_cvt_pk_fp8_f32(b[2], b[3], w1, true);
    u32x2 r; r.x = (unsigned)w0; r.y = (unsigned)w1; return r; }
__device__ __forceinline__ float fast_sigmoid(float x) { return __builtin_amdgcn_rcpf(1.f + __builtin_amdgcn_exp2f(-x * LOG2E)); }
constexpr int LDS_WTAB = 131072 + 8192 + 1024;
__device__ __forceinline__ int opaque_tid() {
    const unsigned hw = __builtin_amdgcn_s_getreg(0x2804);
    const int wave = __builtin_amdgcn_readfirstlane(((volatile LAS int*)LDS_WTAB)[hw]);
    int lane; asm volatile("v_mbcnt_lo_u32_b32 %0, -1, 0\n\tv_mbcnt_hi_u32_b32 %0, -1, %0" : "=v"(lane));
    return wave * 64 + lane;
}
__device__ __forceinline__ float shflx(float v, int off, int lane) { return __int_as_float(__builtin_amdgcn_ds_bpermute((lane ^ off) << 2, __float_as_int(v))); }
__device__ __forceinline__ float wave_sum(float v, int lane) {
#pragma unroll
    for (int o = 1; o < 64; o <<= 1) v += shflx(v, o, lane);
    return v;
}

namespace pg8 {
constexpr int BM = 256, BK = 64, HALF = 128, HTB = HALF * BK * 2, STAGE_BYTES = 8 * HTB, NXCD = 8, WGM = 8;
__host__ __device__ __forceinline__ int lds_byte(int r, int c) { const int st = (r >> 4) * 2 + (c >> 5), rr = r & 15, cc = c & 31, ob = rr * 64 + cc * 2; return st * 1024 + (ob ^ (((ob >> 9) & 1) << 5)); }
__host__ __device__ __forceinline__ void stage_rc(int b, int& R, int& C) { const int st = b / 1024, sb = b % 1024, swz = sb ^ (((sb >> 9) & 1) << 5); R = (st >> 1) * 16 + swz / 64; C = (st & 1) * 32 + (swz % 64) / 2; }
__host__ __device__ __forceinline__ int perm32(int rho) { const int n = rho >> 4, i = rho & 15; return 8 * (i >> 2) + 4 * n + (i & 3); }

__device__ __forceinline__ size_t uni64(size_t v) { const unsigned lo_ = __builtin_amdgcn_readfirstlane((unsigned)v), hi_ = __builtin_amdgcn_readfirstlane((unsigned)(v >> 32)); return ((size_t)hi_ << 32) | lo_; }
struct Unit { int pm, pn, z; size_t offA, offB; };
struct Gemm { const void* A; const void* Bt; int ldaB, ldbB, KB; int wscale; };
typedef int v8i __attribute__((ext_vector_type(8)));
typedef int v4i __attribute__((ext_vector_type(4)));

struct TileOrder {
    int nM, nN, nwg;
    __device__ __forceinline__ void init(int nM_, int nN_) { nM = nM_; nN = nN_; nwg = nM * nN; }
    __device__ __forceinline__ bool map(long L, int& pm, int& pn) const {
        if (L >= nwg) return false;
        int wgid = (int)L; { const int q = nwg / NXCD, r = nwg % NXCD, xcd = wgid % NXCD, off = wgid / NXCD; wgid = (xcd < r ? xcd * (q + 1) : r * (q + 1) + (xcd - r) * q) + off; }
        const int nig = WGM * nN, gid = wgid / nig, fm = gid * WGM, gsz = (nM - fm) < WGM ? (nM - fm) : WGM;
        pm = __builtin_amdgcn_readfirstlane(fm + ((wgid % nig) % gsz)); pn = __builtin_amdgcn_readfirstlane((wgid % nig) / gsz); return true;
    }
};

template <bool FP8, int WSC, class Epi, class Sched>
__device__ __forceinline__ void gemm_phase_t(LAS unsigned char* lds, const Gemm g, const Sched& S, const Epi& E) {
    const int tid = opaque_tid(), wid = __builtin_amdgcn_readfirstlane(tid >> 6), lane = tid & 63, wr = wid >> 2, wc = wid & 3, fr = lane & 15, fq = lane >> 4;
    const int nt = g.KB / (BK * 2);
    unsigned voffA[2], voffB[2];
#pragma unroll
    for (int i = 0; i < 2; ++i) { int R, C; stage_rc(tid * 16 + i * 8192, R, C); const int Rb = (R & ~31) + perm32(R & 31);
        voffA[i] = (unsigned)(R * g.ldaB + C * 2); voffB[i] = (unsigned)(Rb * g.ldbB + C * 2); }
    const size_t kstep = (size_t)(BK * 2);
    const size_t hstepA = (size_t)HALF * g.ldaB, hstepB = (size_t)HALF * g.ldbB;
    const unsigned ldsw = (unsigned)wid * 1024u;
    const unsigned lds_u = __builtin_amdgcn_readfirstlane((unsigned)(uintptr_t)lds + ldsw);
    const int aoff = lds_byte(wr * 64 + fr, fq * 8), boff = lds_byte(wc * 32 + fr, fq * 8);
#define PG8_SA(b, h) (((b) * 2 + (h)) * HTB)
#define PG8_SB(b, h) ((4 + (b) * 2 + (h)) * HTB)
#define PG8_STAGE(bufoff, gbase, voff) do { _Pragma("unroll") for (int _i = 0; _i < 2; ++_i) \
        { unsigned _keep; asm volatile("s_mov_b32 %0, m0\n\ts_mov_b32 m0, %1\n\ts_nop 0\n\tglobal_load_lds_dwordx4 %2, %3\n\ts_mov_b32 m0, %0" : "=&s"(_keep) : "s"(lds_u + (unsigned)((bufoff) + _i * 8192)), "v"((voff)[_i]), "s"(gbase) : "memory"); } } while (0)
#define PG8_LD32(p) __builtin_shufflevector(*(const LAS v4i*)(p), *(const LAS v4i*)((p) + 1024), 0, 1, 2, 3, 4, 5, 6, 7)
#define PG8_LDA(dst, b, h) do { _Pragma("unroll") for (int m = 0; m < 4; ++m) dst[m] = PG8_LD32(lds + PG8_SA(b, h) + aoff + m * 2048); } while (0)
#define PG8_LDB(dst, b, h) do { _Pragma("unroll") for (int n = 0; n < 2; ++n) dst[n] = PG8_LD32(lds + PG8_SB(b, h) + boff + n * 2048); } while (0)
#define PG8_H0(x) __builtin_bit_cast(bf16x8, __builtin_shufflevector((x), (x), 0, 1, 2, 3))
#define PG8_H1(x) __builtin_bit_cast(bf16x8, __builtin_shufflevector((x), (x), 4, 5, 6, 7))
#define PG8_MMA(ai, bj, At, Bt) do { __builtin_amdgcn_s_setprio(1); _Pragma("unroll") for (int m = 0; m < 4; ++m) _Pragma("unroll") for (int n = 0; n < 2; ++n) { \
        if constexpr (FP8) asm volatile("v_mfma_scale_f32_16x16x128_f8f6f4 %0, %1, %2, %0, %3, %3 op_sel_hi:[0,0,0]" : "+v"(acc[ai][bj][m][n]) : "v"(Bt[n]), "v"(At[m]), "v"(wsc_v));     \
        else { acc[ai][bj][m][n] = __builtin_amdgcn_mfma_f32_16x16x32_bf16(PG8_H0(Bt[n]), PG8_H0(At[m]), acc[ai][bj][m][n], 0, 0, 0); acc[ai][bj][m][n] = __builtin_amdgcn_mfma_f32_16x16x32_bf16(PG8_H1(Bt[n]), PG8_H1(At[m]), acc[ai][bj][m][n], 0, 0, 0); } } \
        __builtin_amdgcn_s_setprio(0); } while (0)
#define PG8_WAIT_V(n) asm volatile("s_waitcnt vmcnt(" #n ")" ::: "memory")
#define PG8_WAIT_L(n) asm volatile("s_waitcnt lgkmcnt(" #n ")" ::: "memory")
#define PG8_BAR __builtin_amdgcn_s_barrier()
#define PG8_SCHED __builtin_amdgcn_sched_barrier(0)
    Unit cur, nxt; int ui = 0;
    if (!S.next(0, cur)) return;
    f32x4 acc[2][2][4][2];
#pragma unroll
    for (int a = 0; a < 2; ++a)
#pragma unroll
        for (int b = 0; b < 2; ++b)
#pragma unroll
            for (int m = 0; m < 4; ++m)
#pragma unroll
                for (int n = 0; n < 2; ++n) acc[a][b][m][n] = (f32x4){0.f, 0.f, 0.f, 0.f};
    v8i At[4], B0[2], B1[2]; const int wsc_v = WSC; (void)wsc_v;
    const char* cA = (const char*)g.A + uni64(cur.offA); const char* cB = (const char*)g.Bt + uni64(cur.offB);
    PG8_STAGE(PG8_SB(0, 0), cB, voffB); PG8_STAGE(PG8_SB(0, 1), cB + hstepB, voffB); PG8_STAGE(PG8_SA(0, 0), cA, voffA); PG8_STAGE(PG8_SA(0, 1), cA + hstepA, voffA);
    if (wr == 1) PG8_BAR;
    PG8_WAIT_V(2); PG8_BAR;
    PG8_STAGE(PG8_SB(1, 0), cB + kstep, voffB); PG8_STAGE(PG8_SA(1, 0), cA + kstep, voffA); PG8_STAGE(PG8_SB(1, 1), cB + hstepB + kstep, voffB);
    PG8_WAIT_V(6); PG8_BAR;
    for (;;) {
        const bool has_next = S.next(ui + 1, nxt);
        const char* nA = has_next ? (const char*)g.A + uni64(nxt.offA) : cA; const char* nB = has_next ? (const char*)g.Bt + uni64(nxt.offB) : cB;
        for (int t = 0; t < nt; t += 2) {
            const bool last = (t == nt - 2);
            const char* a1 = cA + (size_t)(t + 1) * kstep;
            const char* a2 = last ? nA : cA + (size_t)(t + 2) * kstep; const char* b2 = last ? nB : cB + (size_t)(t + 2) * kstep;
            const char* a3 = a2 + kstep; const char* b3 = b2 + kstep;
            PG8_LDB(B0, 0, 0); PG8_LDB(B1, 0, 1); PG8_SCHED; PG8_LDA(At, 0, 0); PG8_STAGE(PG8_SA(1, 1), a1 + hstepA, voffA);
            PG8_WAIT_V(8); PG8_WAIT_L(0); PG8_BAR; PG8_MMA(0, 0, At, B0); PG8_MMA(0, 1, At, B1); PG8_BAR; PG8_SCHED;
            PG8_LDA(At, 0, 1); PG8_STAGE(PG8_SB(0, 0), b2, voffB); PG8_STAGE(PG8_SB(0, 1), b2 + hstepB, voffB); PG8_STAGE(PG8_SA(0, 0), a2, voffA);
            PG8_WAIT_V(8); PG8_WAIT_L(0); PG8_BAR; PG8_MMA(1, 0, At, B0); PG8_MMA(1, 1, At, B1); PG8_BAR; PG8_SCHED;
            PG8_LDB(B0, 1, 0); PG8_LDB(B1, 1, 1); PG8_SCHED; PG8_LDA(At, 1, 0); PG8_STAGE(PG8_SA(0, 1), a2 + hstepA, voffA);
            PG8_WAIT_V(8); PG8_WAIT_L(0); PG8_BAR; PG8_MMA(0, 0, At, B0); PG8_MMA(0, 1, At, B1); PG8_BAR; PG8_SCHED;
            PG8_LDA(At, 1, 1); PG8_STAGE(PG8_SB(1, 0), b3, voffB); PG8_STAGE(PG8_SB(1, 1), b3 + hstepB, voffB); PG8_STAGE(PG8_SA(1, 0), a3, voffA);
            PG8_WAIT_V(8); PG8_WAIT_L(0); PG8_BAR; PG8_MMA(1, 0, At, B0); PG8_MMA(1, 1, At, B1); PG8_BAR; PG8_SCHED;
        }
        if (wr == 0) PG8_BAR;
        if constexpr (FP8) asm volatile("s_nop 15\n\ts_nop 15" ::: "memory");
        E(acc, cur, wr, wc, fr, fq);
        if (!has_next) break;
#pragma unroll
        for (int a = 0; a < 2; ++a)
#pragma unroll
            for (int b = 0; b < 2; ++b)
#pragma unroll
                for (int m = 0; m < 4; ++m)
#pragma unroll
                    for (int n = 0; n < 2; ++n) acc[a][b][m][n] = (f32x4){0.f, 0.f, 0.f, 0.f};
        cur = nxt; cA = nA; cB = nB; ++ui;
        if (wr == 1) PG8_BAR;
    }
    PG8_WAIT_V(0);
    PG8_BAR;
#undef PG8_SA
#undef PG8_SB
#undef PG8_STAGE
#undef PG8_LDA
#undef PG8_LDB
#undef PG8_MMA
#undef PG8_H0
#undef PG8_H1
#undef PG8_LD32
#undef PG8_WAIT_V
#undef PG8_WAIT_L
#undef PG8_BAR
#undef PG8_SCHED
}
template <class Epi, class Sched> __device__ __forceinline__ void gemm_phase(LAS unsigned char* lds, const Gemm g, const Sched& S, const Epi& E) { gemm_phase_t<false, 0>(lds, g, S, E); }
}

struct SchedPlain {
    pg8::TileOrder T; int G, c; size_t tA, tB;
    __device__ __forceinline__ void init(int nM, int nN, int lda, int ldb, int G_, int c_) { T.init(nM, nN); G = G_; c = c_; tA = (size_t)256 * lda * 2; tB = (size_t)256 * ldb * 2; }
    __device__ __forceinline__ bool next(int i, pg8::Unit& u) const { if (!T.map((long)i * G + c, u.pm, u.pn)) return false; u.z = 0; u.offA = u.pm * tA; u.offB = u.pn * tB; return true; }
};
struct SchedBatch {
    int nM, nN, nZ, G, c; size_t tA, tB, zA, zB;
    __device__ __forceinline__ bool next(int i, pg8::Unit& u) const {
        const long L = (long)i * G + c; const int per = nM * nN; if (L >= (long)per * nZ) return false;
        const int z = __builtin_amdgcn_readfirstlane((int)(L / per)), r = __builtin_amdgcn_readfirstlane((int)(L % per)); u.z = z; u.pm = __builtin_amdgcn_readfirstlane(r / nN); u.pn = __builtin_amdgcn_readfirstlane(r % nN); u.offA = z * zA + u.pm * tA; u.offB = z * zB + u.pn * tB; return true; }
};
struct SchedBranch {
    pg8::TileOrder T; int G, c; size_t tA, tB, zA, zB;
    __device__ __forceinline__ bool next(int i, pg8::Unit& u) const { const int t = i / 3, z = i - 3 * t; if (!T.map((long)t * G + c, u.pm, u.pn)) return false; u.z = z; u.offA = z * zA + u.pm * tA; u.offB = z * zB + u.pn * tB; return true; }
};
struct SchedMoe {
    pg8::TileOrder T; int G, c; size_t tA, tB, zB; int off[7];
    __device__ __forceinline__ bool next(int i, pg8::Unit& u) const {
        if (!T.map((long)i * G + c, u.pm, u.pn)) return false; const int r0 = u.pm * 256; int e = 0;
#pragma unroll
        for (int k = 0; k < 7; ++k) e += (r0 >= off[k]) ? 1 : 0;
        e = __builtin_amdgcn_readfirstlane(e); u.z = e; u.offA = u.pm * tA; u.offB = e * zB + u.pn * tB; return true; }
};

#define EPI_ARGS const f32x4 (&acc)[2][2][4][2], const pg8::Unit& u, int wr, int wc, int fr, int fq
#define EPI_ROW(ai, m) (u.pm * 256 + (ai) * 128 + wr * 64 + (m) * 16 + fr)
#define EPI_CB(bj) ((bj) * 128 + wc * 32 + fq * 8)
#define FOR_AI_M _Pragma("unroll") for (int ai = 0; ai < 2; ++ai) _Pragma("unroll") for (int m = 0; m < 4; ++m)
#define FOR_BJ _Pragma("unroll") for (int bj = 0; bj < 2; ++bj)

__device__ __forceinline__ void rope4(f32x4& v0, f32x4& v1, const f32x4 t0, const f32x4 t1) {
    const float a0 = v0[0] * t0[0] - v0[1] * t0[1], b0 = v0[1] * t0[0] + v0[0] * t0[1];
    const float a1 = v0[2] * t0[2] - v0[3] * t0[3], b1 = v0[3] * t0[2] + v0[2] * t0[3];
    const float a2 = v1[0] * t1[0] - v1[1] * t1[1], b2 = v1[1] * t1[0] + v1[0] * t1[1];
    const float a3 = v1[2] * t1[2] - v1[3] * t1[3], b3 = v1[3] * t1[2] + v1[2] * t1[3];
    v0 = (f32x4){a0, b0, a1, b1}; v1 = (f32x4){a2, b2, a3, b3};
}

struct EpiInProj {
    bf16_t *QD, *KD, *VD, *MQ, *MKV, *KM, *SU, *GATES; float *ssq_q, *ssq_kv; const float* tabd; const float* tabm;
    int pn_add;
    __device__ __forceinline__ void operator()(EPI_ARGS) const {
        const int pn = u.pn + pn_add;
        if (pn < 8) {
            bf16_t* O = pn < 4 ? QD : KD; const float sc = pn < 4 ? C2_DIFF : 1.f; const int colt = (pn & 3) * 256;
            const bool rp = ((wc & 1) == 0) && fq < 2;
#pragma unroll
            for (int ai = 0; ai < 2; ++ai) { f32x4 tt[4][2];
#pragma unroll
                for (int m = 0; m < 4; ++m) { tt[m][0] = (f32x4){1.f, 0.f, 1.f, 0.f}; tt[m][1] = (f32x4){1.f, 0.f, 1.f, 0.f};
                    if (rp) { const f32x4* tp = (const f32x4*)(tabd + (size_t)EPI_ROW(ai, m) * 16 + fq * 8); tt[m][0] = tp[0]; tt[m][1] = tp[1]; } }
#pragma unroll
                for (int m = 0; m < 4; ++m) { const int row = EPI_ROW(ai, m);
                    FOR_BJ { f32x4 v0 = acc[ai][bj][m][0], v1 = acc[ai][bj][m][1]; rope4(v0, v1, tt[m][0], tt[m][1]); v0 = v0 * sc; v1 = v1 * sc;
                        *(u32x4*)(O + (size_t)row * 1024 + colt + EPI_CB(bj)) = pack8(v0, v1); } } }
        } else if (pn < 12) {
            const int colt = (pn - 8) * 256;
            FOR_AI_M { const int row = EPI_ROW(ai, m); FOR_BJ { *(u32x4*)(VD + (size_t)row * 1024 + colt + EPI_CB(bj)) = pack8(acc[ai][bj][m][0], acc[ai][bj][m][1]); } }
        } else if (pn < 15) {
            bf16_t* O = pn < 14 ? MQ : MKV; const int ld = pn < 14 ? 512 : 256, colt = pn < 14 ? (pn - 12) * 256 : 0; float* ssq = pn < 14 ? ssq_q + (pn - 12) * 4 + wc : ssq_kv + wc; const int ns = pn < 14 ? 8 : 4;
            FOR_AI_M { const int row = EPI_ROW(ai, m); float s = 0.f;
                FOR_BJ { const f32x4 v0 = acc[ai][bj][m][0], v1 = acc[ai][bj][m][1]; s += (v0[0] * v0[0] + v0[1] * v0[1]) + (v0[2] * v0[2] + v0[3] * v0[3]) + (v1[0] * v1[0] + v1[1] * v1[1]) + (v1[2] * v1[2] + v1[3] * v1[3]);
                    *(u32x4*)(O + (size_t)row * ld + colt + EPI_CB(bj)) = pack8(v0, v1); }
                s += shflx(s, 16, fq * 16 + fr); s += shflx(s, 32, fq * 16 + fr);
                if (fq == 0) ssq[(size_t)row * ns] = s; }
        } else if (pn == 15) {
            if (wc < 2) {
                FOR_AI_M { const int row = EPI_ROW(ai, m); const f32x4* tp = (const f32x4*)(tabm + (size_t)row * 64 + (wc * 16 + fq * 4) * 2);
                    f32x4 v0 = acc[ai][0][m][0], v1 = acc[ai][0][m][1]; rope4(v0, v1, tp[0], tp[1]); const u32x4 w = pack8(v0, v1);
#pragma unroll
                    for (int h = 0; h < 8; ++h) *(u32x4*)(KM + (size_t)row * 1536 + h * 192 + 128 + wc * 32 + fq * 8) = w; }
            }
        } else if (pn < 20) {
            FOR_AI_M { const int row = EPI_ROW(ai, m); const int c = row >> 5, j = row & 31;
                FOR_BJ { const int ch = (pn - 16) * 256 + EPI_CB(bj), g = ch >> 4, q = ch & 15;
                    *(u32x4*)(SU + ((size_t)(g * SSM_NCH + c) * SSM_KX + j * 16 + q)) = pack8(acc[ai][bj][m][0], acc[ai][bj][m][1]); } }
        } else {
            const int colt = (pn - 20) * 256;
            FOR_AI_M { const int row = EPI_ROW(ai, m);
                FOR_BJ { f32x4 v0 = acc[ai][bj][m][0], v1 = acc[ai][bj][m][1];
#pragma unroll
                    for (int e = 0; e < 4; ++e) { v0[e] = fast_sigmoid(v0[e]); v1[e] = fast_sigmoid(v1[e]); }
                    *(u32x4*)(GATES + (size_t)row * 6144 + colt + EPI_CB(bj)) = pack8(v0, v1); } }
        }
    }
};
struct EpiQup {
    bf16_t* QM; const float* ssq; const float* tabm;
    __device__ __forceinline__ void operator()(EPI_ARGS) const {
#pragma unroll
        for (int ai = 0; ai < 2; ++ai) { f32x4 sq[4][2];
#pragma unroll
            for (int m = 0; m < 4; ++m) { const int row = EPI_ROW(ai, m); sq[m][0] = *(const f32x4*)(ssq + (size_t)row * 8); sq[m][1] = *(const f32x4*)(ssq + (size_t)row * 8 + 4); }
#pragma unroll
            for (int m = 0; m < 4; ++m) { const int row = EPI_ROW(ai, m); const f32x4 s0 = sq[m][0], s1 = sq[m][1];
                const float rq = __builtin_amdgcn_rsqf((((s0[0] + s0[1]) + (s0[2] + s0[3])) + ((s1[0] + s1[1]) + (s1[2] + s1[3]))) * (1.f / 512.f) + RMS_EPS) * C2_MLA;
                FOR_BJ { const int col = u.pn * 256 + EPI_CB(bj), h = col / 192, hc = col - h * 192; f32x4 v0 = acc[ai][bj][m][0], v1 = acc[ai][bj][m][1];
                    if (hc >= 128) { const f32x4* tp = (const f32x4*)(tabm + (size_t)row * 64 + (hc - 128)); rope4(v0, v1, tp[0], tp[1]); }
                    v0 = v0 * rq; v1 = v1 * rq; *(u32x4*)(QM + (size_t)row * 1536 + col) = pack8(v0, v1); } } }
    }
};
struct EpiKVup {
    bf16_t *KM, *VM; const float* ssq;
    __device__ __forceinline__ void operator()(EPI_ARGS) const {
#pragma unroll
        for (int ai = 0; ai < 2; ++ai) { float rk[4];
#pragma unroll
            for (int m = 0; m < 4; ++m) { const f32x4 s0 = *(const f32x4*)(ssq + (size_t)EPI_ROW(ai, m) * 4); rk[m] = ((s0[0] + s0[1]) + (s0[2] + s0[3])); }
#pragma unroll
            for (int m = 0; m < 4; ++m) { const int row = EPI_ROW(ai, m); const float r = __builtin_amdgcn_rsqf(rk[m] * (1.f / 256.f) + RMS_EPS); const int c = wc * 32 + fq * 8;
                *(u32x4*)(KM + (size_t)row * 1536 + u.pn * 192 + c) = pack8(acc[ai][0][m][0] * r, acc[ai][0][m][1] * r);
                *(u32x4*)(VM + (size_t)row * 1024 + u.pn * 128 + c) = pack8(acc[ai][1][m][0] * r, acc[ai][1][m][1] * r); } }
    }
};
struct EpiSloc {
    float* SLOC;
    __device__ __forceinline__ void operator()(EPI_ARGS) const {
        FOR_AI_M { const int c = EPI_ROW(ai, m); float* o = SLOC + ((size_t)(u.z * SSM_NCH + c) * 128 + wc * 32 + fq * 8);
            *(f32x4*)o = acc[ai][0][m][0]; *(f32x4*)(o + 4) = acc[ai][0][m][1]; }
    }
};
__device__ __forceinline__ float gelu_tanh(float x) { const float t = 1.5957691216057308f * (x + 0.044715f * x * x * x); return x * fast_sigmoid(t); }
struct EpiSsmY {
    bf16_t* YG; const bf16_t* SU; const float* dskip;
    __device__ __forceinline__ void operator()(EPI_ARGS) const {
        const int g = u.z; f32x4 d0[2], d1[2];
        FOR_BJ { const int col = u.pn * 256 + EPI_CB(bj), ch = g * 16 + (col & 15); d0[bj] = *(const f32x4*)(dskip + ch); d1[bj] = *(const f32x4*)(dskip + ch + 4); }
#pragma unroll
        for (int ai = 0; ai < 2; ++ai) { u32x4 uu[4][2];
#pragma unroll
            for (int m = 0; m < 4; ++m) { const int c = EPI_ROW(ai, m);
                FOR_BJ { const int col = u.pn * 256 + EPI_CB(bj), i = col >> 4, p0 = col & 15; uu[m][bj] = *(const u32x4*)(SU + ((size_t)(g * SSM_NCH + c) * SSM_KX + i * 16 + p0)); } }
#pragma unroll
            for (int m = 0; m < 4; ++m) { const int c = EPI_ROW(ai, m);
                FOR_BJ { const int col = u.pn * 256 + EPI_CB(bj), i = col >> 4, p0 = col & 15, t = c * SSM_L + i, ch = g * 16 + p0; const u32x4 w = uu[m][bj];
                    f32x4 v0 = acc[ai][bj][m][0], v1 = acc[ai][bj][m][1];
                    v0[0] += d0[bj][0] * bf_lo(w.x); v0[1] += d0[bj][1] * bf_hi(w.x); v0[2] += d0[bj][2] * bf_lo(w.y); v0[3] += d0[bj][3] * bf_hi(w.y);
                    v1[0] += d1[bj][0] * bf_lo(w.z); v1[1] += d1[bj][1] * bf_hi(w.z); v1[2] += d1[bj][2] * bf_lo(w.w); v1[3] += d1[bj][3] * bf_hi(w.w);
#pragma unroll
                    for (int e = 0; e < 4; ++e) { v0[e] = gelu_tanh(v0[e]); v1[e] = gelu_tanh(v1[e]); }
                    *(u32x4*)(YG + (size_t)t * 1024 + ch) = pack8(v0, v1); } } }
    }
};
template <int ACT  > struct EpiGated {
    bf16_t* O; int ldo;
    __device__ __forceinline__ void operator()(EPI_ARGS) const {
        FOR_AI_M { const int row = EPI_ROW(ai, m); f32x4 r[2];
#pragma unroll
            for (int n = 0; n < 2; ++n)
#pragma unroll
                for (int e = 0; e < 4; ++e) { const float a = acc[ai][0][m][n][e], b = acc[ai][1][m][n][e]; r[n][e] = ACT == 0 ? a * fast_sigmoid(b) : a * fast_sigmoid(a) * b; }
            *(u32x4*)(O + (size_t)row * ldo + u.pn * 128 + wc * 32 + fq * 8) = pack8(r[0], r[1]); }
    }
};
struct EpiSwigluF8 {
    unsigned char* O; int ldo;
    __device__ __forceinline__ void operator()(EPI_ARGS) const {
        FOR_AI_M { const int row = EPI_ROW(ai, m); f32x4 r[2];
#pragma unroll
            for (int n = 0; n < 2; ++n)
#pragma unroll
                for (int e = 0; e < 4; ++e) { const float a = acc[ai][0][m][n][e], b = acc[ai][1][m][n][e]; r[n][e] = a * fast_sigmoid(a) * b; }
            *(u32x2*)(O + (size_t)row * ldo + u.pn * 128 + wc * 32 + fq * 8) = pack8_fp8(r[0], r[1]); }
    }
};
struct EpiGatesF8 {
    bf16_t* GATES;
    __device__ __forceinline__ void operator()(EPI_ARGS) const {
        FOR_AI_M { const int row = EPI_ROW(ai, m);
            FOR_BJ { f32x4 v0 = acc[ai][bj][m][0], v1 = acc[ai][bj][m][1];
#pragma unroll
                for (int e = 0; e < 4; ++e) { v0[e] = fast_sigmoid(v0[e]); v1[e] = fast_sigmoid(v1[e]); }
                *(u32x4*)(GATES + (size_t)row * 6144 + u.pn * 256 + EPI_CB(bj)) = pack8(v0, v1); } }
    }
};
struct EpiBranch {
    const bf16_t* GATES; bf16_t* P; bf16_t* MG;
    __device__ __forceinline__ void operator()(EPI_ARGS) const {
        const int z = u.z;
#pragma unroll
        for (int ai = 0; ai < 2; ++ai)
#pragma unroll
            for (int mh = 0; mh < 2; ++mh) { u32x4 gg[2][2], pa[2][2], pb[2][2];
#pragma unroll
                for (int mm = 0; mm < 2; ++mm) { const int row = EPI_ROW(ai, mh * 2 + mm);
                    FOR_BJ { const int col = u.pn * 256 + EPI_CB(bj); gg[mm][bj] = *(const u32x4*)(GATES + (size_t)row * 6144 + z * 2048 + col);
                        if (z == 2) { const size_t o = (size_t)row * 2048 + col; pa[mm][bj] = *(const u32x4*)(P + o); pb[mm][bj] = *(const u32x4*)(P + (size_t)M * 2048 + o); } } }
#pragma unroll
                for (int mm = 0; mm < 2; ++mm) { const int m = mh * 2 + mm, row = EPI_ROW(ai, m);
                    FOR_BJ { const int col = u.pn * 256 + EPI_CB(bj); const u32x4 g = gg[mm][bj];
                        f32x4 v0 = acc[ai][bj][m][0], v1 = acc[ai][bj][m][1];
                        v0[0] *= bf_lo(g.x); v0[1] *= bf_hi(g.x); v0[2] *= bf_lo(g.y); v0[3] *= bf_hi(g.y);
                        v1[0] *= bf_lo(g.z); v1[1] *= bf_hi(g.z); v1[2] *= bf_lo(g.w); v1[3] *= bf_hi(g.w);
                        const size_t o = (size_t)row * 2048 + col;
                        if (z < 2) *(u32x4*)(P + (size_t)z * M * 2048 + o) = pack8(v0, v1);
                        else { const u32x4 a = pa[mm][bj], b = pb[mm][bj];
                            v0[0] += bf_lo(a.x) + bf_lo(b.x); v0[1] += bf_hi(a.x) + bf_hi(b.x); v0[2] += bf_lo(a.y) + bf_lo(b.y); v0[3] += bf_hi(a.y) + bf_hi(b.y);
                            v1[0] += bf_lo(a.z) + bf_lo(b.z); v1[1] += bf_hi(a.z) + bf_hi(b.z); v1[2] += bf_lo(a.w) + bf_lo(b.w); v1[3] += bf_hi(a.w) + bf_hi(b.w);
                            *(u32x4*)(MG + o) = pack8(v0, v1); } } } }
    }
};
struct EpiResid {
    bf16_t* X;
    __device__ __forceinline__ void operator()(EPI_ARGS) const {
#pragma unroll
        for (int ai = 0; ai < 2; ++ai) { u32x4 r[4][2];
#pragma unroll
            for (int m = 0; m < 4; ++m) { const int row = EPI_ROW(ai, m);
                FOR_BJ { r[m][bj] = *(const u32x4*)(X + (size_t)row * 2048 + u.pn * 256 + EPI_CB(bj)); } }
#pragma unroll
            for (int m = 0; m < 4; ++m) { const int row = EPI_ROW(ai, m);
                FOR_BJ { const u32x4 w = r[m][bj]; f32x4 v0 = acc[ai][bj][m][0], v1 = acc[ai][bj][m][1];
                    v0[0] += ALPHA * bf_lo(w.x); v0[1] += ALPHA * bf_hi(w.x); v0[2] += ALPHA * bf_lo(w.y); v0[3] += ALPHA * bf_hi(w.y);
                    v1[0] += ALPHA * bf_lo(w.z); v1[1] += ALPHA * bf_hi(w.z); v1[2] += ALPHA * bf_lo(w.w); v1[3] += ALPHA * bf_hi(w.w);
                    *(u32x4*)(X + (size_t)row * 2048 + u.pn * 256 + EPI_CB(bj)) = pack8(v0, v1); } } }
    }
};
struct EpiBf16 {
    bf16_t* O; int ldo; float scale;
    __device__ __forceinline__ void operator()(EPI_ARGS) const {
        FOR_AI_M { const int row = EPI_ROW(ai, m); FOR_BJ { *(u32x4*)(O + (size_t)row * ldo + u.pn * 256 + EPI_CB(bj)) = pack8(acc[ai][bj][m][0] * scale, acc[ai][bj][m][1] * scale); } }
    }
};
struct EpiBf16Half {
    bf16_t* O; int ldo; float scale;
    __device__ __forceinline__ void operator()(EPI_ARGS) const {
#pragma unroll
        for (int m = 0; m < 4; ++m) { const int row = u.pm * 128 + wr * 64 + m * 16 + fr;
            FOR_BJ { *(u32x4*)(O + (size_t)row * ldo + u.pn * 256 + EPI_CB(bj)) = pack8(acc[0][bj][m][0] * scale, acc[0][bj][m][1] * scale); } }
    }
};
struct EpiMoeDown {
    bf16_t* OG; const float* wslot;
    __device__ __forceinline__ void operator()(EPI_ARGS) const {
        float w[2][4];
        FOR_AI_M w[ai][m] = wslot[EPI_ROW(ai, m)];
        FOR_AI_M { const int row = EPI_ROW(ai, m);
            FOR_BJ { *(u32x4*)(OG + (size_t)row * 2048 + u.pn * 256 + EPI_CB(bj)) = pack8(acc[ai][bj][m][0] * w[ai][m], acc[ai][bj][m][1] * w[ai][m]); } }
    }
};

namespace att {
constexpr int KVBLK = 64, SHM_V = KVBLK * 128 * 2;
constexpr float THRL = 8.f;
__device__ __forceinline__ int crow(int r, int hi) { return (r & 3) + 8 * (r >> 2) + 4 * hi; }
template <int PITCH> __device__ __forceinline__ int kfl(int row) { return (PITCH % 256 == 128) ? ((row >> 1) & 7) : (row & 15); }
template <int PITCH> __device__ __forceinline__ int kswz(int row, int colB) { return row * PITCH + (colB ^ (kfl<PITCH>(row) << 4)); }
__device__ __forceinline__ int v_st(int k, int c) { const int kk = k; return ((kk >> 3) * 4 + (c >> 5)) * 512 + ((kk & 7) * 32 + (c & 31)) * 2; }
__device__ __forceinline__ int v_rd_base(int lane) { return ((lane & 3) << 3) | (((lane >> 2) & 3) << 6) | (((lane >> 4) & 1) << 5) | (((lane >> 5) & 1) << 8); }
constexpr int v_rd_off(int d0, int ks, int half) { return d0 * 512 + ks * 4096 + half * 2048; }

__device__ __forceinline__ void mask_tile(f32x16& p0, f32x16& p1, int dq) {
    const float NEG = -__builtin_inff();
#pragma unroll
    for (int r = 0; r < 16; ++r) { const int c = (r & 3) + 8 * (r >> 2); if (dq - c < 0) p0[r] = NEG; if (dq - c - 32 < 0) p1[r] = NEG; }
}
__device__ __forceinline__ void partialSM(f32x16& p0, f32x16& p1, float& m_reg, float& alpha) {
    float pmax = p0[0];
#pragma unroll
    for (int r = 1; r < 16; ++r) pmax = fmaxf(pmax, p0[r]);
#pragma unroll
    for (int r = 0; r < 16; ++r) pmax = fmaxf(pmax, p1[r]);
    { auto rr = __builtin_amdgcn_permlane32_swap(__float_as_uint(pmax), __float_as_uint(pmax), false, false); pmax = fmaxf(__uint_as_float(rr[0]), __uint_as_float(rr[1])); }
    float mn;
    if (__builtin_expect(__all(pmax - m_reg <= THRL), 1)) { mn = m_reg; alpha = 1.f; }
    else { mn = fmaxf(m_reg, pmax); alpha = __builtin_amdgcn_exp2f(m_reg - mn); m_reg = mn; }
#pragma unroll
    for (int r = 0; r < 16; ++r) { p0[r] -= mn; p1[r] -= mn; }
#pragma unroll
    for (int r = 0; r < 16; ++r) p0[r] = __builtin_amdgcn_exp2f(p0[r]);
}
__device__ __forceinline__ void finishSM(f32x16& p0, f32x16& p1, float alpha, float& l_reg, bf16x8& pa0, bf16x8& pa1, bf16x8& pa2, bf16x8& pa3) {
#pragma unroll
    for (int r = 0; r < 16; ++r) p1[r] = __builtin_amdgcn_exp2f(p1[r]);
    float ps = 0;
#pragma unroll
    for (int r = 0; r < 16; ++r) ps += p0[r];
#pragma unroll
    for (int r = 0; r < 16; ++r) ps += p1[r];
    { auto rr = __builtin_amdgcn_permlane32_swap(__float_as_uint(ps), __float_as_uint(ps), false, false); ps = __uint_as_float(rr[0]) + __uint_as_float(rr[1]); }
    l_reg = l_reg * alpha + ps;
#define PK4(P, B_, OUT) do { unsigned a0 = cvt_pk_bf16(P[B_+0], P[B_+1]), a1 = cvt_pk_bf16(P[B_+2], P[B_+3]); unsigned b0 = cvt_pk_bf16(P[B_+4], P[B_+5]), b1 = cvt_pk_bf16(P[B_+6], P[B_+7]); \
        u32x4 w = {a0, a1, b0, b1}; OUT = *reinterpret_cast<bf16x8*>(&w); } while (0)
    PK4(p0, 0, pa0); PK4(p0, 8, pa1); PK4(p1, 0, pa2); PK4(p1, 8, pa3);
#undef PK4
}
template <int PITCH, int ND0>
__device__ __forceinline__ void qkt(f32x16& p0, f32x16& p1, const char* Kb, int r32, int hi, int kch0, const bf16x8* qr) {
    p0 = f32x16{}; p1 = f32x16{};
    const char* kb[4];
#pragma unroll
    for (int dd = 0; dd < 4; ++dd) kb[dd] = Kb + kswz<PITCH>(r32, (kch0 + dd * 2 + hi) * 16);
#pragma unroll
    for (int d0 = 0; d0 < ND0; ++d0) { const char* a = (PITCH % 256 == 0) ? Kb + kswz<PITCH>(r32, (kch0 + d0 * 2 + hi) * 16) : kb[d0 & 3] + (d0 >> 2) * 128;
        const bf16x8 b0 = *reinterpret_cast<const bf16x8*>(a);
        const bf16x8 b1 = *reinterpret_cast<const bf16x8*>(a + 32 * PITCH);
        p0 = __builtin_amdgcn_mfma_f32_32x32x16_bf16(b0, qr[d0], p0, 0, 0, 0);
        p1 = __builtin_amdgcn_mfma_f32_32x32x16_bf16(b1, qr[d0], p1, 0, 0, 0); }
}
__device__ __forceinline__ void pv_tile(f32x16* o, int vb0, bf16x8 pa0, bf16x8 pa1, bf16x8 pa2, bf16x8 pa3) {
    s16x4 va[8], vb[8];
#define TRRD(dst, off) asm volatile("ds_read_b64_tr_b16 %0, %1 offset:%2" : "=&v"(dst) : "v"(vb0), "i"(off) : "memory")
#define PV_RD(v, d0) do { constexpr int b_ = v_rd_off(d0, 0, 0); TRRD(v[0], b_); TRRD(v[1], b_ + 2048); TRRD(v[2], b_ + 4096); TRRD(v[3], b_ + 6144); TRRD(v[4], b_ + 8192); TRRD(v[5], b_ + 10240); TRRD(v[6], b_ + 12288); TRRD(v[7], b_ + 14336); } while (0)
#define PV_MM(v, d0) do { \
        o[d0] = __builtin_amdgcn_mfma_f32_32x32x16_bf16(pa0, (bf16x8){v[0][0], v[0][1], v[0][2], v[0][3], v[1][0], v[1][1], v[1][2], v[1][3]}, o[d0], 0, 0, 0); \
        o[d0] = __builtin_amdgcn_mfma_f32_32x32x16_bf16(pa1, (bf16x8){v[2][0], v[2][1], v[2][2], v[2][3], v[3][0], v[3][1], v[3][2], v[3][3]}, o[d0], 0, 0, 0); \
        o[d0] = __builtin_amdgcn_mfma_f32_32x32x16_bf16(pa2, (bf16x8){v[4][0], v[4][1], v[4][2], v[4][3], v[5][0], v[5][1], v[5][2], v[5][3]}, o[d0], 0, 0, 0); \
        o[d0] = __builtin_amdgcn_mfma_f32_32x32x16_bf16(pa3, (bf16x8){v[6][0], v[6][1], v[6][2], v[6][3], v[7][0], v[7][1], v[7][2], v[7][3]}, o[d0], 0, 0, 0); } while (0)
#define PV_W8(v) asm volatile("s_waitcnt lgkmcnt(8)" : "+v"(v[0]), "+v"(v[1]), "+v"(v[2]), "+v"(v[3]), "+v"(v[4]), "+v"(v[5]), "+v"(v[6]), "+v"(v[7]) :: "memory")
#define PV_W0(v) asm volatile("s_waitcnt lgkmcnt(0)" : "+v"(v[0]), "+v"(v[1]), "+v"(v[2]), "+v"(v[3]), "+v"(v[4]), "+v"(v[5]), "+v"(v[6]), "+v"(v[7]) :: "memory")
    PV_RD(va, 0); PV_RD(vb, 1); PV_W8(va); SBAR(); PV_MM(va, 0);
    PV_RD(va, 2); PV_W8(vb); SBAR(); PV_MM(vb, 1);
    PV_RD(vb, 3); PV_W8(va); SBAR(); PV_MM(va, 2);
    PV_W0(vb); SBAR(); PV_MM(vb, 3);
#undef PV_W0
#undef PV_W8
#undef PV_MM
#undef PV_RD
#undef TRRD
}

template <int KT, int ND0, bool CAUSAL, bool PIPE>
__device__ __forceinline__ void attn_core(const bf16_t* Qlane, const bf16_t* __restrict__ Kh, int ldk, const bf16_t* __restrict__ Vh, int ldv, int NT, int qpos, int qlo, int kch0,
                                          char* lds, f32x16 (&o)[4], float& l_reg) {
    constexpr int PITCH = KT * 2, SHM_K = KVBLK * PITCH, NKL = KT / 64, CPR = KT / 8;
    const int tid = opaque_tid(), wid = __builtin_amdgcn_readfirstlane(tid >> 6), lane = tid & 63, r32 = lane & 31, hi = lane >> 5;
    char* V_lds = lds; char* K_lds = lds + 2 * SHM_V;
    float* ws = (float*)(lds + 2 * SHM_V + 2 * SHM_K) + wid * 64; float* al_l = ws + 32;
    float m_reg = -1e30f; l_reg = 0.f;
#pragma unroll
    for (int d = 0; d < 4; ++d) o[d] = f32x16{};
    bf16x8 qr[ND0];
#pragma unroll
    for (int d0 = 0; d0 < ND0; ++d0) qr[d0] = *reinterpret_cast<const bf16x8*>(Qlane + d0 * 16);
    const int sr = tid >> 4, sc = (tid & 15) * 8, vst0 = v_st(sr, sc), vst1 = v_st(32 + sr, sc);
    const int vb0 = (int)(uintptr_t)V_lds + v_rd_base(lane);
    int krow[NKL], kcc[NKL];
#pragma unroll
    for (int i = 0; i < NKL; ++i) { const int cid = tid + 512 * i; krow[i] = cid / CPR; kcc[i] = cid - krow[i] * CPR; }
    bf16x8 st_v0, st_v1, st_k[NKL];
#define SLOAD(k0) do { st_v0 = *reinterpret_cast<const bf16x8*>(Vh + (size_t)((k0) + sr) * ldv + sc); st_v1 = *reinterpret_cast<const bf16x8*>(Vh + (size_t)((k0) + 32 + sr) * ldv + sc); \
        _Pragma("unroll") for (int i_ = 0; i_ < NKL; ++i_) st_k[i_] = *reinterpret_cast<const bf16x8*>(Kh + (size_t)((k0) + krow[i_]) * ldk + kcc[i_] * 8); } while (0)
#define SWRITE(b) do { *(bf16x8*)(V_lds + (b) * SHM_V + vst0) = st_v0; *(bf16x8*)(V_lds + (b) * SHM_V + vst1) = st_v1; \
        _Pragma("unroll") for (int i_ = 0; i_ < NKL; ++i_) *(bf16x8*)(K_lds + (b) * SHM_K + kswz<PITCH>(krow[i_], kcc[i_] * 16)) = st_k[i_]; } while (0)
#define RESC(a) do { if (__any((a) < 1.f)) { if (hi == 0) al_l[r32] = (a); asm volatile("s_waitcnt lgkmcnt(0)" ::: "memory"); \
        _Pragma("unroll") for (int d_ = 0; d_ < 4; ++d_) _Pragma("unroll") for (int r = 0; r < 16; ++r) o[d_][r] *= al_l[crow(r, hi)]; } } while (0)
#define MASKT(P0_, P1_, t) do { if (CAUSAL) { const int kb_ = (t) * KVBLK; if (kb_ + KVBLK - 1 > qlo) mask_tile(P0_, P1_, qpos - kb_ - 4 * hi); } } while (0)
    if constexpr (PIPE) {
    f32x16 pA0, pA1, pB0, pB1; float alA, alB; bf16x8 pa0, pa1, pa2, pa3;
    SLOAD(0); VM_WAIT(); SWRITE(0); __syncthreads();
    qkt<PITCH, ND0>(pA0, pA1, K_lds, r32, hi, kch0, qr); MASKT(pA0, pA1, 0); partialSM(pA0, pA1, m_reg, alA);
    SLOAD(KVBLK); VM_WAIT(); SWRITE(1); __syncthreads();
    for (int j = 1; j + 1 < NT; j += 2) {
        SBAR(); qkt<PITCH, ND0>(pB0, pB1, K_lds + SHM_K, r32, hi, kch0, qr);
        finishSM(pA0, pA1, alA, l_reg, pa0, pa1, pa2, pa3); SBAR();
        SLOAD((j + 1) * KVBLK); SBAR();
        pv_tile(o, vb0, pa0, pa1, pa2, pa3); MASKT(pB0, pB1, j); partialSM(pB0, pB1, m_reg, alB);
        __syncthreads(); VM_WAIT(); SWRITE(0);
        RESC(alB); __syncthreads();
        SBAR(); qkt<PITCH, ND0>(pA0, pA1, K_lds, r32, hi, kch0, qr);
        finishSM(pB0, pB1, alB, l_reg, pa0, pa1, pa2, pa3); SBAR();
        SLOAD((j + 2) * KVBLK); SBAR();
        pv_tile(o, vb0 + SHM_V, pa0, pa1, pa2, pa3); MASKT(pA0, pA1, j + 1); partialSM(pA0, pA1, m_reg, alA);
        __syncthreads(); VM_WAIT(); SWRITE(1);
        RESC(alA); __syncthreads();
    }
    SBAR(); qkt<PITCH, ND0>(pB0, pB1, K_lds + SHM_K, r32, hi, kch0, qr);
    finishSM(pA0, pA1, alA, l_reg, pa0, pa1, pa2, pa3); SBAR();
    pv_tile(o, vb0, pa0, pa1, pa2, pa3); MASKT(pB0, pB1, NT - 1); partialSM(pB0, pB1, m_reg, alB);
    RESC(alB);
    finishSM(pB0, pB1, alB, l_reg, pa0, pa1, pa2, pa3); SBAR();
    pv_tile(o, vb0 + SHM_V, pa0, pa1, pa2, pa3);
    } else {
    f32x16 p0, p1; float al; bf16x8 pa0, pa1, pa2, pa3;
    SLOAD(0); VM_WAIT(); SWRITE(0); __syncthreads();
    for (int t = 0; t < NT; t += 2) {
        SBAR(); SLOAD((t + 1) * KVBLK); SBAR();
        qkt<PITCH, ND0>(p0, p1, K_lds, r32, hi, kch0, qr); MASKT(p0, p1, t); partialSM(p0, p1, m_reg, al); RESC(al);
        finishSM(p0, p1, al, l_reg, pa0, pa1, pa2, pa3); SBAR();
        pv_tile(o, vb0, pa0, pa1, pa2, pa3);
        VM_WAIT(); SWRITE(1); __syncthreads();
        SBAR(); if (t + 2 < NT) SLOAD((t + 2) * KVBLK); SBAR();
        qkt<PITCH, ND0>(p0, p1, K_lds + SHM_K, r32, hi, kch0, qr); MASKT(p0, p1, t + 1); partialSM(p0, p1, m_reg, al); RESC(al);
        finishSM(p0, p1, al, l_reg, pa0, pa1, pa2, pa3); SBAR();
        pv_tile(o, vb0 + SHM_V, pa0, pa1, pa2, pa3);
        if (t + 2 < NT) { VM_WAIT(); SWRITE(0); } __syncthreads();
    }
    }
#undef SLOAD
#undef SWRITE
#undef RESC
#undef MASKT
}

template <bool NEGM = true>
__device__ __forceinline__ void partialSM_rel(f32x16& p0, f32x16& p1, float& m_reg, f32x16& negm, float& alpha, bool first) {
    float pmax = p0[0];
#pragma unroll
    for (int r = 1; r < 16; ++r) pmax = fmaxf(pmax, p0[r]);
#pragma unroll
    for (int r = 0; r < 16; ++r) pmax = fmaxf(pmax, p1[r]);
    { auto rr = __builtin_amdgcn_permlane32_swap(__float_as_uint(pmax), __float_as_uint(pmax), false, false); pmax = fmaxf(__uint_as_float(rr[0]), __uint_as_float(rr[1])); }
    if (__builtin_expect(!first && __all(pmax <= THRL), 1)) { alpha = 1.f; }
    else { const float dl = first ? pmax : fmaxf(pmax, 0.f); alpha = first ? 1.f : __builtin_amdgcn_exp2f(-dl); m_reg += dl;
#pragma unroll
        for (int r = 0; r < 16; ++r) { p0[r] -= dl; p1[r] -= dl; }
        if constexpr (NEGM) {
#pragma unroll
            for (int r = 0; r < 16; ++r) negm[r] = -m_reg; } }
#pragma unroll
    for (int r = 0; r < 16; ++r) p0[r] = __builtin_amdgcn_exp2f(p0[r]);
}
template <int PITCH, int ND0>
__device__ __forceinline__ void qkt_rel(f32x16& p0, f32x16& p1, const char* Kb, int r32, int hi, int kch0, const bf16x8* qr, const f32x16& negm) {
    const char* kb[4];
#pragma unroll
    for (int dd = 0; dd < 4; ++dd) kb[dd] = Kb + kswz<PITCH>(r32, (kch0 + dd * 2 + hi) * 16);
#pragma unroll
    for (int d0 = 0; d0 < ND0; ++d0) { const char* a = (PITCH % 256 == 0) ? Kb + kswz<PITCH>(r32, (kch0 + d0 * 2 + hi) * 16) : kb[d0 & 3] + (d0 >> 2) * 128;
        const bf16x8 b0 = *reinterpret_cast<const bf16x8*>(a);
        const bf16x8 b1 = *reinterpret_cast<const bf16x8*>(a + 32 * PITCH);
        p0 = __builtin_amdgcn_mfma_f32_32x32x16_bf16(b0, qr[d0], d0 == 0 ? negm : p0, 0, 0, 0);
        p1 = __builtin_amdgcn_mfma_f32_32x32x16_bf16(b1, qr[d0], d0 == 0 ? negm : p1, 0, 0, 0); }
}

template <int PITCH, int ND0, int PF>
__device__ __forceinline__ void qkt_rel_pf(f32x16& p0, f32x16& p1, const char* Kb, int r32, int hi, int kch0, const bf16x8* qr, const f32x16& negm_) {
    static_assert(PITCH % 256 == 128 || ND0 <= 4, "the +128 B immediate offsets need the 3-bit swizzle");
    f32x16 negm = negm_;
    int kb[4];
#pragma unroll
    for (int dd = 0; dd < 4; ++dd) kb[dd] = (int)(uintptr_t)Kb + kswz<PITCH>(r32, (kch0 + dd * 2 + hi) * 16);
    bf16x8 f[PF + 1][2];
#define KRD(d) do { asm volatile("ds_read_b128 %0, %1 offset:%2" : "=v"(f[(d) % (PF + 1)][0]) : "v"(kb[(d) & 3]), "i"(((d) >> 2) * 128)); \
                    asm volatile("ds_read_b128 %0, %1 offset:%2" : "=v"(f[(d) % (PF + 1)][1]) : "v"(kb[(d) & 3]), "i"(((d) >> 2) * 128 + 32 * PITCH)); } while (0)
#pragma unroll
    for (int d = 0; d < PF && d < ND0; ++d) KRD(d);
#pragma unroll
    for (int d0 = 0; d0 < ND0; ++d0) {
        if (d0 + PF < ND0) KRD(d0 + PF);
        const int ahead = (d0 + PF < ND0 ? PF : ND0 - 1 - d0) * 2;
        if (ahead >= 4) asm volatile("s_waitcnt lgkmcnt(4)" : "+v"(f[d0 % (PF + 1)][0]), "+v"(f[d0 % (PF + 1)][1]));
        else if (ahead == 2) asm volatile("s_waitcnt lgkmcnt(2)" : "+v"(f[d0 % (PF + 1)][0]), "+v"(f[d0 % (PF + 1)][1]));
        else asm volatile("s_waitcnt lgkmcnt(0)" : "+v"(f[d0 % (PF + 1)][0]), "+v"(f[d0 % (PF + 1)][1]));
        p0 = __builtin_amdgcn_mfma_f32_32x32x16_bf16(f[d0 % (PF + 1)][0], qr[d0], d0 == 0 ? negm : p0, 0, 0, 0);
        p1 = __builtin_amdgcn_mfma_f32_32x32x16_bf16(f[d0 % (PF + 1)][1], qr[d0], d0 == 0 ? negm : p1, 0, 0, 0);
    }
#undef KRD
}

template <int PITCH, int ND0>
__device__ __forceinline__ void pv_qk(f32x16* o, int vb0, bf16x8 pa0, bf16x8 pa1, bf16x8 pa2, bf16x8 pa3,
                                      f32x16& p0, f32x16& p1, const char* Kb, int r32, int hi, int kch0, const bf16x8* qr, const f32x16& negm_) {
    constexpr int PF = 2;
    static_assert(PITCH % 256 == 128 || ND0 <= 4, "the +128 B immediate offsets need the 3-bit swizzle");
    f32x16 negm = negm_;
    s16x4 va[8], vb[8];
    int kb[4];
#pragma unroll
    for (int dd = 0; dd < 4; ++dd) kb[dd] = (int)(uintptr_t)Kb + kswz<PITCH>(r32, (kch0 + dd * 2 + hi) * 16);
    bf16x8 f[PF + 1][2];
#define TRRD(dst, off) asm volatile("ds_read_b64_tr_b16 %0, %1 offset:%2" : "=&v"(dst) : "v"(vb0), "i"(off) : "memory")
#define PV_RD(v, d0) do { constexpr int b_ = v_rd_off(d0, 0, 0); TRRD(v[0], b_); TRRD(v[1], b_ + 2048); TRRD(v[2], b_ + 4096); TRRD(v[3], b_ + 6144); TRRD(v[4], b_ + 8192); TRRD(v[5], b_ + 10240); TRRD(v[6], b_ + 12288); TRRD(v[7], b_ + 14336); } while (0)
#define PV_MM(v, d0) do { \
        o[d0] = __builtin_amdgcn_mfma_f32_32x32x16_bf16(pa0, (bf16x8){v[0][0], v[0][1], v[0][2], v[0][3], v[1][0], v[1][1], v[1][2], v[1][3]}, o[d0], 0, 0, 0); \
        o[d0] = __builtin_amdgcn_mfma_f32_32x32x16_bf16(pa1, (bf16x8){v[2][0], v[2][1], v[2][2], v[2][3], v[3][0], v[3][1], v[3][2], v[3][3]}, o[d0], 0, 0, 0); \
        o[d0] = __builtin_amdgcn_mfma_f32_32x32x16_bf16(pa2, (bf16x8){v[4][0], v[4][1], v[4][2], v[4][3], v[5][0], v[5][1], v[5][2], v[5][3]}, o[d0], 0, 0, 0); \
        o[d0] = __builtin_amdgcn_mfma_f32_32x32x16_bf16(pa3, (bf16x8){v[6][0], v[6][1], v[6][2], v[6][3], v[7][0], v[7][1], v[7][2], v[7][3]}, o[d0], 0, 0, 0); } while (0)
#define PV_WN(v, n) asm volatile("s_waitcnt lgkmcnt(%8)" : "+v"(v[0]), "+v"(v[1]), "+v"(v[2]), "+v"(v[3]), "+v"(v[4]), "+v"(v[5]), "+v"(v[6]), "+v"(v[7]) : "n"(n) : "memory")
#define KRD(d) do { asm volatile("ds_read_b128 %0, %1 offset:%2" : "=v"(f[(d) % (PF + 1)][0]) : "v"(kb[(d) & 3]), "i"(((d) >> 2) * 128) : "memory"); \
                    asm volatile("ds_read_b128 %0, %1 offset:%2" : "=v"(f[(d) % (PF + 1)][1]) : "v"(kb[(d) & 3]), "i"(((d) >> 2) * 128 + 32 * PITCH) : "memory"); } while (0)
#define PV_RDK(v, ks) do { TRRD(v[0], v_rd_off(0, ks, 0)); TRRD(v[1], v_rd_off(0, ks, 1)); TRRD(v[2], v_rd_off(1, ks, 0)); TRRD(v[3], v_rd_off(1, ks, 1)); \
                            TRRD(v[4], v_rd_off(2, ks, 0)); TRRD(v[5], v_rd_off(2, ks, 1)); TRRD(v[6], v_rd_off(3, ks, 0)); TRRD(v[7], v_rd_off(3, ks, 1)); } while (0)
#define PV_MMK(v, pa) do { \
        o[0] = __builtin_amdgcn_mfma_f32_32x32x16_bf16(pa, (bf16x8){v[0][0], v[0][1], v[0][2], v[0][3], v[1][0], v[1][1], v[1][2], v[1][3]}, o[0], 0, 0, 0); \
        o[1] = __builtin_amdgcn_mfma_f32_32x32x16_bf16(pa, (bf16x8){v[2][0], v[2][1], v[2][2], v[2][3], v[3][0], v[3][1], v[3][2], v[3][3]}, o[1], 0, 0, 0); \
        o[2] = __builtin_amdgcn_mfma_f32_32x32x16_bf16(pa, (bf16x8){v[4][0], v[4][1], v[4][2], v[4][3], v[5][0], v[5][1], v[5][2], v[5][3]}, o[2], 0, 0, 0); \
        o[3] = __builtin_amdgcn_mfma_f32_32x32x16_bf16(pa, (bf16x8){v[6][0], v[6][1], v[6][2], v[6][3], v[7][0], v[7][1], v[7][2], v[7][3]}, o[3], 0, 0, 0); } while (0)
    PV_RDK(va, 0); PV_RDK(vb, 1); PV_WN(va, 8); SBAR(); PV_MMK(va, pa0);
    PV_RDK(va, 2); PV_WN(vb, 8); SBAR(); PV_MMK(vb, pa1);
    PV_RDK(vb, 3); PV_WN(va, 8); SBAR(); PV_MMK(va, pa2);
    KRD(0); KRD(1);
    PV_WN(vb, 4); SBAR(); PV_MMK(vb, pa3);
#undef PV_MMK
#undef PV_RDK
    SBAR();
#pragma unroll
    for (int d0 = 0; d0 < ND0; ++d0) {
        if (d0 + PF < ND0) KRD(d0 + PF);
        const int ahead = (d0 + PF < ND0 ? PF : ND0 - 1 - d0) * 2;
        if (ahead >= 4) asm volatile("s_waitcnt lgkmcnt(4)" : "+v"(f[d0 % (PF + 1)][0]), "+v"(f[d0 % (PF + 1)][1]) :: "memory");
        else if (ahead == 2) asm volatile("s_waitcnt lgkmcnt(2)" : "+v"(f[d0 % (PF + 1)][0]), "+v"(f[d0 % (PF + 1)][1]) :: "memory");
        else asm volatile("s_waitcnt lgkmcnt(0)" : "+v"(f[d0 % (PF + 1)][0]), "+v"(f[d0 % (PF + 1)][1]) :: "memory");
        p0 = __builtin_amdgcn_mfma_f32_32x32x16_bf16(f[d0 % (PF + 1)][0], qr[d0], d0 == 0 ? negm : p0, 0, 0, 0);
        p1 = __builtin_amdgcn_mfma_f32_32x32x16_bf16(f[d0 % (PF + 1)][1], qr[d0], d0 == 0 ? negm : p1, 0, 0, 0);
    }
#undef KRD
#undef PV_WN
#undef PV_MM
#undef PV_RD
#undef TRRD
}

__device__ __forceinline__ void glds16(unsigned lds_addr, const void* sbase, unsigned voff) {
    unsigned keep;
    asm volatile("s_mov_b32 %0, m0\n\ts_mov_b32 m0, %1\n\ts_nop 0\n\tglobal_load_lds_dwordx4 %2, %3\n\ts_mov_b32 m0, %0" : "=&s"(keep) : "s"(lds_addr), "v"(voff), "s"(sbase) : "memory");
}
template <int KT, int ND0, bool CAUSAL>
__device__ __forceinline__ void attn_core_ring(const bf16_t* Qlane, const bf16_t* __restrict__ Kh, int ldk, const bf16_t* __restrict__ Vh, int ldv, int NT, int qpos, int qlo, int kch0,
                                               char* lds, f32x16 (&o)[4], float& l_reg) {
    constexpr int PITCH = KT * 2, SHM_K = KVBLK * PITCH, NKP = SHM_K / 8192, NVP = SHM_V / 8192;
    const int tid = opaque_tid(), wid = __builtin_amdgcn_readfirstlane(tid >> 6), lane = tid & 63, r32 = lane & 31, hi = lane >> 5;
    char* V_lds = lds; char* K_lds = lds + 3 * SHM_V;
    float* ws = (float*)(lds + 3 * SHM_V + 3 * SHM_K) + wid * 64; float* al_l = ws + 32;
    float m_reg = 0.f; l_reg = 0.f; f32x16 negm = f32x16{};
#pragma unroll
    for (int d = 0; d < 4; ++d) o[d] = f32x16{};
    bf16x8 qr[ND0];
#pragma unroll
    for (int d0 = 0; d0 < ND0; ++d0) qr[d0] = *reinterpret_cast<const bf16x8*>(Qlane + d0 * 16);
    const int vb0 = (int)(uintptr_t)V_lds + v_rd_base(lane);
    unsigned koff[NKP], voff[NVP];
#pragma unroll
    for (int i = 0; i < NKP; ++i) { const int a = (wid * NKP + i) * 1024 + lane * 16, row = a / PITCH, cpos = (a - row * PITCH) >> 4, f = kfl<PITCH>(row);
        const int chunk = cpos ^ f; koff[i] = (unsigned)(row * ldk * 2 + chunk * 16); }
#pragma unroll
    for (int i = 0; i < NVP; ++i) { const int a = (wid * NVP + i) * 1024 + lane * 16, sub = a >> 9, rem = a & 511, kk = (sub >> 2) * 8 + (rem >> 6), c = (sub & 3) * 32 + ((rem & 63) >> 1);
        const int k = kk; voff[i] = (unsigned)(k * ldv * 2 + c * 2); }
    const unsigned ldsK = (unsigned)(uintptr_t)K_lds + (unsigned)(wid * NKP) * 1024u, ldsV = (unsigned)(uintptr_t)V_lds + (unsigned)(wid * NVP) * 1024u;
#define DMA_TILE(t, slot) do { const char* kb_ = (const char*)Kh + (size_t)(t) * KVBLK * ldk * 2; const char* vb_ = (const char*)Vh + (size_t)(t) * KVBLK * ldv * 2; \
        _Pragma("unroll") for (int i_ = 0; i_ < NKP; ++i_) glds16(ldsK + (slot) * SHM_K + i_ * 1024, kb_, koff[i_]); \
        _Pragma("unroll") for (int i_ = 0; i_ < NVP; ++i_) glds16(ldsV + (slot) * SHM_V + i_ * 1024, vb_, voff[i_]); } while (0)
#define RING_SYNC(more) do { if (more) asm volatile("s_waitcnt vmcnt(%0)" :: "n"(NKP + NVP) : "memory"); else asm volatile("s_waitcnt vmcnt(0)" ::: "memory"); \
        asm volatile("s_waitcnt lgkmcnt(0)" ::: "memory"); __builtin_amdgcn_s_barrier(); asm volatile("" ::: "memory"); } while (0)
#define RESC(a) do { if (__any((a) < 1.f)) { if (hi == 0) al_l[r32] = (a); asm volatile("s_waitcnt lgkmcnt(0)" ::: "memory"); \
        _Pragma("unroll") for (int d_ = 0; d_ < 4; ++d_) _Pragma("unroll") for (int r = 0; r < 16; ++r) o[d_][r] *= al_l[crow(r, hi)]; } } while (0)
#define MASKT(P0_, P1_, t) do { if (CAUSAL) { const int kb_ = (t) * KVBLK; if (kb_ + KVBLK - 1 > qlo) mask_tile(P0_, P1_, qpos - kb_ - 4 * hi); } } while (0)
    f32x16 p0, p1; float al; bf16x8 pa0, pa1, pa2, pa3;
    asm volatile("s_waitcnt vmcnt(0)" ::: "memory");
#pragma unroll
    for (int d0 = 0; d0 < ND0; ++d0) asm volatile("" : "+v"(qr[d0]));
    DMA_TILE(0, 0); if (NT > 1) DMA_TILE(1, 1);
    RING_SYNC(NT > 1);
    int slot = 0;
    for (int t = 0; t < NT; ++t) {
        const int s2 = slot == 0 ? 2 : slot - 1;
        SBAR(); if (t + 2 < NT) DMA_TILE(t + 2, s2); SBAR();
        qkt_rel_pf<PITCH, ND0, 2>(p0, p1, K_lds + slot * SHM_K, r32, hi, kch0, qr, negm); MASKT(p0, p1, t); partialSM_rel(p0, p1, m_reg, negm, al, t == 0); RESC(al);
        finishSM(p0, p1, al, l_reg, pa0, pa1, pa2, pa3); SBAR();
        pv_tile(o, vb0 + slot * SHM_V, pa0, pa1, pa2, pa3);
        RING_SYNC(t + 2 < NT);
        slot = slot == 2 ? 0 : slot + 1;
    }
#undef DMA_TILE
#undef RING_SYNC
#undef RESC
#undef MASKT
}
template <int KT, int ND0, bool CAUSAL, bool NEGM>
__device__ __forceinline__ void attn_core_pp(const bf16_t* Qlane, const bf16_t* __restrict__ Kh, int ldk, const bf16_t* __restrict__ Vh, int ldv, int NT, int qpos, int qlo, int kch0,
                                             char* lds, f32x16 (&o)[4], float& l_reg) {
    constexpr int PITCH = KT * 2, SHM_K = KVBLK * PITCH, NKP = SHM_K / 8192, NVP = SHM_V / 8192;
    const int tid = opaque_tid(), wid = __builtin_amdgcn_readfirstlane(tid >> 6), lane = tid & 63, r32 = lane & 31, hi = lane >> 5;
    const bool grpB = wid >= 4;
    char* V_lds = lds; char* K_lds = lds + 3 * SHM_V;
    float* ws = (float*)(lds + 3 * SHM_V + 3 * SHM_K) + wid * 64; float* al_l = ws + 32;
    float m_reg = 0.f; l_reg = 0.f; f32x16 negm = f32x16{};
#pragma unroll
    for (int d = 0; d < 4; ++d) o[d] = f32x16{};
    bf16x8 qr[ND0];
#pragma unroll
    for (int d0 = 0; d0 < ND0; ++d0) qr[d0] = *reinterpret_cast<const bf16x8*>(Qlane + d0 * 16);
    const int vb0 = (int)(uintptr_t)V_lds + v_rd_base(lane);
    unsigned koff[NKP], voff[NVP];
#pragma unroll
    for (int i = 0; i < NKP; ++i) { const int a = (wid * NKP + i) * 1024 + lane * 16, row = a / PITCH, cpos = (a - row * PITCH) >> 4, f = kfl<PITCH>(row);
        const int chunk = cpos ^ f; koff[i] = (unsigned)(row * ldk * 2 + chunk * 16); }
#pragma unroll
    for (int i = 0; i < NVP; ++i) { const int a = (wid * NVP + i) * 1024 + lane * 16, sub = a >> 9, rem = a & 511, kk = (sub >> 2) * 8 + (rem >> 6), c = (sub & 3) * 32 + ((rem & 63) >> 1);
        const int k = kk; voff[i] = (unsigned)(k * ldv * 2 + c * 2); }
    const unsigned ldsK = (unsigned)(uintptr_t)K_lds + (unsigned)(wid * NKP) * 1024u, ldsV = (unsigned)(uintptr_t)V_lds + (unsigned)(wid * NVP) * 1024u;
#define DMA_K(t, slot) do { const char* kb_ = (const char*)Kh + (size_t)(t) * KVBLK * ldk * 2; _Pragma("unroll") for (int i_ = 0; i_ < NKP; ++i_) glds16(ldsK + (slot) * SHM_K + i_ * 1024, kb_, koff[i_]); } while (0)
#define DMA_V(t, slot) do { const char* vb_ = (const char*)Vh + (size_t)(t) * KVBLK * ldv * 2; _Pragma("unroll") for (int i_ = 0; i_ < NVP; ++i_) glds16(ldsV + (slot) * SHM_V + i_ * 1024, vb_, voff[i_]); } while (0)
#define ISSUE(u, ksl, vsl) do { if ((u) < NT) DMA_K(u, ksl); if ((u) - 1 < NT) DMA_V((u) - 1, vsl); } while (0)
#define PAIR_WAIT(t) do { if ((t) + 2 < NT) asm volatile("s_waitcnt vmcnt(%0)" :: "n"(NKP + NVP) : "memory"); else if ((t) + 2 == NT) asm volatile("s_waitcnt vmcnt(%0)" :: "n"(NVP) : "memory"); \
        else asm volatile("s_waitcnt vmcnt(0)" ::: "memory"); } while (0)
#define BAR() do { SBAR(); asm volatile("s_waitcnt lgkmcnt(0)" ::: "memory"); __builtin_amdgcn_s_barrier(); asm volatile("" ::: "memory"); SBAR(); } while (0)
#define RESC(a) do { if (__any((a) < 1.f)) { if (hi == 0) al_l[r32] = (a); asm volatile("s_waitcnt lgkmcnt(0)" ::: "memory"); \
        _Pragma("unroll") for (int d_ = 0; d_ < 4; ++d_) _Pragma("unroll") for (int r = 0; r < 16; ++r) o[d_][r] *= al_l[crow(r, hi)]; } } while (0)
#define MASKT(P0_, P1_, t) do { if (CAUSAL) { const int kb_ = (t) * KVBLK; if (kb_ + KVBLK - 1 > qlo) mask_tile(P0_, P1_, qpos - kb_ - 4 * hi); } } while (0)
    f32x16 p0, p1; float al; bf16x8 pa0, pa1, pa2, pa3;
    asm volatile("s_waitcnt vmcnt(0)" ::: "memory");
#pragma unroll
    for (int d0 = 0; d0 < ND0; ++d0) asm volatile("" : "+v"(qr[d0]));
    DMA_K(0, 0);
    if (NT > 1) DMA_K(1, 1);
    DMA_V(0, 0);
    if (NT > 1) asm volatile("s_waitcnt vmcnt(%0)" :: "n"(NKP + NVP) : "memory"); else asm volatile("s_waitcnt vmcnt(%0)" :: "n"(NVP) : "memory");
    BAR();
    if (grpB) { ISSUE(2, 2, 1); BAR(); }
#define QK_(ksl) do { if constexpr (NEGM) qkt_rel_pf<PITCH, ND0, 2>(p0, p1, K_lds + (ksl) * SHM_K, r32, hi, kch0, qr, negm); \
        else { f32x16 c_; const float nm_ = -m_reg; _Pragma("unroll") for (int r = 0; r < 16; ++r) c_[r] = nm_; qkt_rel_pf<PITCH, ND0, 2>(p0, p1, K_lds + (ksl) * SHM_K, r32, hi, kch0, qr, c_); } } while (0)
#define Y_(t_, first_) do { MASKT(p0, p1, t_); partialSM_rel<NEGM>(p0, p1, m_reg, negm, al, first_); RESC(al); finishSM(p0, p1, al, l_reg, pa0, pa1, pa2, pa3); } while (0)
    QK_(0);
    if (grpB) PAIR_WAIT(0);
    BAR();
    if (grpB) ISSUE(3, 0, 2); else ISSUE(2, 2, 1);
    SBAR();
    Y_(0, true);
    if (!grpB) PAIR_WAIT(0);
    BAR();
    int ks = 1;
    for (int t = 1; t < NT; ++t) {
        const int kp = ks == 0 ? 2 : ks - 1, kn = ks == 2 ? 0 : ks + 1;
        if constexpr (NEGM) pv_qk<PITCH, ND0>(o, vb0 + kp * SHM_V, pa0, pa1, pa2, pa3, p0, p1, K_lds + ks * SHM_K, r32, hi, kch0, qr, negm);
        else { f32x16 c_; const float nm_ = -m_reg; _Pragma("unroll") for (int r = 0; r < 16; ++r) c_[r] = nm_; pv_qk<PITCH, ND0>(o, vb0 + kp * SHM_V, pa0, pa1, pa2, pa3, p0, p1, K_lds + ks * SHM_K, r32, hi, kch0, qr, c_); }
#ifdef PROBE_XMFMA
        if constexpr (ND0 == 4) { f32x16 dz_ = f32x16{}; _Pragma("unroll") for (int i_ = 0; i_ < PROBE_XMFMA; ++i_) asm volatile("v_mfma_f32_32x32x16_bf16 %0, %1, %2, %0" : "+v"(dz_) : "v"(qr[0]), "v"(qr[1])); asm volatile("s_nop 15\n\ts_nop 15" :: "v"(dz_)); }
#endif
        if (grpB) PAIR_WAIT(t);
        BAR();
        if (grpB) ISSUE(t + 3, ks, kp); else ISSUE(t + 2, kp, kn);
        SBAR();
        Y_(t, false);
#ifdef PROBE_YEXP
        if constexpr (ND0 == 4) { float dm_ = al; _Pragma("unroll") for (int i_ = 0; i_ < PROBE_YEXP; ++i_) asm volatile("v_exp_f32 %0, %1" : "=v"(dm_) : "v"(al)); asm volatile("" :: "v"(dm_)); }
#endif

        if (!grpB) PAIR_WAIT(t);
        BAR();
        ks = kn;
    }
    pv_tile(o, vb0 + (ks == 0 ? 2 : ks - 1) * SHM_V, pa0, pa1, pa2, pa3);
    BAR();
#undef QK_
#undef Y_
    if (!grpB) BAR();
#undef DMA_K
#undef DMA_V
#undef ISSUE
#undef PAIR_WAIT
#undef BAR
#undef RESC
#undef MASKT
}
__device__ __forceinline__ void normalize_o(f32x16 (&o)[4], float l_reg, float* ws, int r32, int hi) {
    if (hi == 0) ws[r32] = l_reg; asm volatile("s_waitcnt lgkmcnt(0)" ::: "memory");
#pragma unroll
    for (int r = 0; r < 16; ++r) { const float rl = __builtin_amdgcn_rcpf(ws[crow(r, hi)]);
#pragma unroll
        for (int d0 = 0; d0 < 4; ++d0) o[d0][r] *= rl; }
}
__device__ __forceinline__ void store_o_bf16(const f32x16 (&o)[4], bf16_t* Ow, int ldo, int r32, int hi) {
#pragma unroll
    for (int r = 0; r < 16; ++r) { const int orow = crow(r, hi);
#pragma unroll
        for (int d0 = 0; d0 < 4; ++d0) { const float v = o[d0][r]; const float vn = shflx(v, 1, hi * 32 + r32);
            if ((r32 & 1) == 0) *(unsigned*)(Ow + (size_t)orow * ldo + d0 * 32 + r32) = cvt_pk_bf16(v, vn); } }
}
}

constexpr size_t MiB = 1u << 20;
constexpr size_t WS_CTL = 0, CTL_ZERO_BYTES = 4 * MiB;
constexpr size_t WS_SSQ = 1 * MiB;
constexpr size_t WS_W = 4 * MiB, LW_BYTES = 269 * MiB / 2;
constexpr size_t LW_IN = 0, LW_QUP = 44 * MiB, LW_KVUP = LW_QUP + 3 * MiB / 2, LW_GLU = LW_KVUP + 1 * MiB, LW_BR = LW_GLU + 4 * MiB, LW_OUT = LW_BR + 12 * MiB,
                 LW_XQ = LW_OUT + 8 * MiB, LW_XKV = LW_XQ + 2 * MiB, LW_XO = LW_XKV + 4 * MiB, LW_TEXT = LW_XO + 2 * MiB, LW_WSL = LW_TEXT + 40 * MiB;
static_assert(LW_WSL + 16 * MiB == LW_BYTES, "layer weight block");
constexpr size_t WS_FFN = WS_W + 2 * LW_BYTES;
constexpr size_t WS_MOE = WS_FFN + 66 * MiB;
constexpr size_t WS_XS = WS_MOE + 8 * 66 * MiB + 1 * MiB;
static_assert(WS_XS == 868 * MiB, "map");
constexpr size_t WS_XN = WS_XS + 128 * MiB;
constexpr size_t WS_TABD = WS_XN + 64 * MiB, WS_TABM = WS_TABD + 1 * MiB, WS_XKV = WS_TABM + 4 * MiB, WS_MEMB = WS_XKV + 1 * MiB, WS_ROUTE = WS_MEMB + 1 * MiB, WS_ORDER = WS_ROUTE + 1 * MiB;
constexpr size_t WS_A32 = WS_ORDER + 64 * 1024;
constexpr size_t WS_PSQ = WS_ORDER + 1 * MiB;
constexpr size_t WS_MIX = WS_TABD + 12 * MiB;
static_assert(WS_MIX == 1072 * MiB, "map");
constexpr size_t WS_QD = WS_MIX, WS_KD = WS_QD + 32 * MiB, WS_VD = WS_KD + 32 * MiB, WS_MQ = WS_VD + 32 * MiB, WS_MKV = WS_MQ + 16 * MiB, WS_KM = WS_MKV + 8 * MiB, WS_VM = WS_KM + 48 * MiB,
                 WS_QM = WS_VM + 32 * MiB, WS_SU = WS_QM + 48 * MiB, WS_GATES = WS_SU + 40 * MiB, WS_SLOC = WS_GATES + 192 * MiB, WS_YG = WS_SLOC + 16 * MiB, WS_BR = WS_YG + 32 * MiB,
                 WS_TMP = WS_BR + 96 * MiB, WS_MG = WS_TMP + 128 * MiB, WS_XQ = WS_MG + 64 * MiB, WS_XO = WS_XQ + 16 * MiB, WS_XN8 = WS_XO + 16 * MiB  , WS_END = WS_XN8 + 32 * MiB;
static_assert(WS_END == 1952 * MiB, "map");
constexpr size_t WS_XG = WS_MIX, WS_HG = WS_XG + 136 * MiB, WS_OG = WS_HG + 374 * MiB;
static_assert(WS_OG + 272 * MiB <= WS_XQ, "ffn overlay");
constexpr int CW_TMO = 0, CW_DBG = 2, CW_BAR = 4096, CW_ATTQ = 16384, CW_MOECNT = 16640, CW_MOECUR = 16704;

#define XB_TMO      128
#define XB_XCNT(j)  (256  + 64 * (j))
#define XB_XSUB(j)  (1280 + 64 * (j))
#define XB_XGEN(j)  (2304 + 64 * (j))
#define XB_TOP      3328
#define XB_TOPGEN   3392
#define XCD_BAR_WORDS 3456
#define XB_SPIN_CAP (1u << 22)
__device__ __forceinline__ unsigned xb_ld(unsigned* p)              { return __hip_atomic_load(p, __ATOMIC_RELAXED, __HIP_MEMORY_SCOPE_AGENT); }
__device__ __forceinline__ unsigned xb_add(unsigned* p, unsigned v) { return __hip_atomic_fetch_add(p, v, __ATOMIC_RELAXED, __HIP_MEMORY_SCOPE_AGENT); }
__device__ __forceinline__ unsigned xb_xcc_id() { return (unsigned)__builtin_amdgcn_s_getreg((3 << 11) | 20) & 0xFu; }
#define XB_SPIN(cond, bar) do { unsigned _sp = 0; while (cond) { __builtin_amdgcn_s_sleep(1); \
    if ((++_sp & 255u) == 0u) { if (xb_ld(&(bar)[XB_TMO])) break; if (_sp > XB_SPIN_CAP) { atomicAdd(&(bar)[XB_TMO], 1u); break; } } } } while (0)
struct XcdBarrier { unsigned* bar; unsigned x; volatile LAS unsigned* st; };
__device__ __forceinline__ XcdBarrier xcd_barrier_post(unsigned* bar, volatile LAS unsigned* st) {
    XcdBarrier b; b.bar = bar; b.x = xb_xcc_id(); b.st = st;
    if (threadIdx.x == 0) (void)xb_add(&bar[XB_XCNT(b.x)], 1u);
    return b;
}
__device__ __forceinline__ void xcd_barrier_complete(unsigned* bar, unsigned x, unsigned& nloc, unsigned& nx) {
    const unsigned G = gridDim.x * gridDim.y * gridDim.z;
    unsigned sum, cnt, mine, sp = 0u;
    for (;;) {
        sum = 0u; cnt = 0u; mine = 0u;
#pragma nounroll
        for (unsigned j = 0; j < 16; ++j) { const unsigned c = xb_ld(&bar[XB_XCNT(j)]); sum += c; cnt += (c > 0u) ? 1u : 0u; mine = (j == x) ? c : mine; }
        if (sum == G) break;
        __builtin_amdgcn_s_sleep(1);
        if ((++sp & 255u) == 0u) { if (xb_ld(&bar[XB_TMO])) break; if (sp > XB_SPIN_CAP) { atomicAdd(&bar[XB_TMO], 1u); break; } }
    }
    nloc = mine > 0u ? mine : 1u; nx = cnt > 0u ? cnt : 1u;
}
__device__ __forceinline__ void xcd_barrier_setup(const XcdBarrier& b) {
    if (threadIdx.x == 0) { unsigned nloc, nx; xcd_barrier_complete(b.bar, b.x, nloc, nx); b.st[0] = nloc; b.st[1] = nx; }
    __syncthreads();
}
__device__ __forceinline__ void xcd_barrier(const XcdBarrier& b) {
    asm volatile("s_waitcnt vmcnt(0)" ::: "memory");
    __syncthreads();
    if (opaque_tid() == 0) {
        unsigned* bar = b.bar;
        __builtin_amdgcn_s_waitcnt(0);
        const unsigned nloc = b.st[0], nx = b.st[1];
        const unsigned old = xb_add(&bar[XB_XSUB(b.x)], 1u);
        const unsigned gen = old / nloc;
        if (old + 1u == (gen + 1u) * nloc) {
            __builtin_amdgcn_fence(__ATOMIC_RELEASE, "agent");
            asm volatile("s_waitcnt vmcnt(0)" ::: "memory");
            const unsigned og = xb_add(&bar[XB_TOP], 1u);
            const unsigned tg = og / nx;
            if (og + 1u == (tg + 1u) * nx) xb_add(&bar[XB_TOPGEN], 1u);
            else XB_SPIN(xb_ld(&bar[XB_TOPGEN]) == tg, bar);
            __builtin_amdgcn_fence(__ATOMIC_ACQUIRE, "agent");
            xb_add(&bar[XB_XGEN(b.x)], 1u);
            asm volatile("s_waitcnt vmcnt(0)" ::: "memory");
        } else {
            XB_SPIN(xb_ld(&bar[XB_XGEN(b.x)]) == gen, bar);
            __builtin_amdgcn_fence(__ATOMIC_ACQUIRE, "agent");
            asm volatile("s_waitcnt vmcnt(0)" ::: "memory");
        }
    }
    __syncthreads();
}

struct Args { const void* in[35]; float* out; unsigned char* ws; int ph_lo, ph_hi; };
struct PTab { volatile LAS unsigned long long* t; __device__ __forceinline__ const void* operator[](int i) const { const unsigned long long v = t[i];
    const unsigned lo_ = __builtin_amdgcn_readfirstlane((unsigned)v), hi_ = __builtin_amdgcn_readfirstlane((unsigned)(v >> 32)); return (const void*)(GAS const char*)(((unsigned long long)hi_ << 32) | lo_); } };
struct ArgsD { PTab in; unsigned char* ws; };
enum { I_X = 0, I_MEM, I_POS, I_WIN, I_WQUP, I_WKVUP, I_QNG, I_KVNG, I_DLAM, I_SUBLN, I_LRE, I_LIM, I_BRE, I_BIM, I_CRE, I_CIM, I_SSMD, I_LOGDT, I_GLUW, I_WBR, I_WOUT, I_LNMG, I_LNMB,
       I_WXQ, I_WXKV, I_WXO, I_LNXG, I_LNXB, I_FGU, I_FDN, I_ROUTER, I_MGU, I_MDN, I_LNFG, I_LNFB };
constexpr int NPL = 16, NPHASE = 1 + DEPTH * NPL;
constexpr int LDS_BYTES = 147456;
constexpr int LDS_MISC = 131072 + 8192;

__device__ __forceinline__ float lam_init_of(int l) { return l == 0 ? 0.2f : 0.35550906759f; }

struct Mat { const float* src; bf16_t* dst; int K, N, kind; const float* ksc; int kmod; float kmul; int fp8; };
__device__ __forceinline__ int map_row(int kind, int n, int N) {
    if (kind == 0) return n;
    if (kind == 1) {
        if (n < 2048) { const int hc = n & 63; if (hc < 16) return (n - hc) + (hc < 8 ? 2 * hc : 2 * (hc - 8) + 1); return n; }
        if (n < 3840) return n;
        if (n < 3904) { const int hc = n - 3840; return 3840 + (hc < 32 ? 2 * hc : 2 * (hc - 32) + 1); }
        return n + 192;
    }
    if (kind == 2) { const int h = n / 192; int hc = n - h * 192; if (hc >= 128) { const int r = hc - 128; hc = 128 + (r < 32 ? 2 * r : 2 * (r - 32) + 1); } return h * 192 + hc; }
    const int half = N >> 1;
    if (n < half) return (n >> 7) * 256 + (n & 127);
    const int mm = n - half; return (mm >> 7) * 256 + 128 + (mm & 127);
}
__device__ __forceinline__ Mat get_mat(const ArgsD& a, int id) {
    Mat m; m.ksc = nullptr; m.kmod = 1; m.kmul = 1.f; m.kind = 0; m.fp8 = 0;
    unsigned char* ws = a.ws;
    if (id < 22) { const int l = id / 11, k = id % 11; unsigned char* lw = ws + WS_W + (size_t)l * LW_BYTES;
        switch (k) {
        case 0: m.src = (const float*)a.in[I_WIN] + (size_t)l * D * NIN_SRC; m.dst = (bf16_t*)(lw + LW_IN); m.K = D; m.N = NIN_SRC; m.kind = 1; break;
        case 1: m.src = (const float*)a.in[I_WQUP] + (size_t)l * 512 * 1536; m.dst = (bf16_t*)(lw + LW_QUP); m.K = 512; m.N = 1536; m.kind = 2; m.ksc = (const float*)a.in[I_QNG] + l * 512; m.kmod = 512; break;
        case 2: m.src = (const float*)a.in[I_WKVUP] + (size_t)l * 256 * 2048; m.dst = (bf16_t*)(lw + LW_KVUP); m.K = 256; m.N = 2048; m.ksc = (const float*)a.in[I_KVNG] + l * 256; m.kmod = 256; break;
        case 3: m.src = (const float*)a.in[I_GLUW] + (size_t)l * 1024 * 2048; m.dst = (bf16_t*)(lw + LW_GLU); m.K = 1024; m.N = 2048; m.kind = 3; break;
        case 4: m.src = (const float*)a.in[I_WBR] + (size_t)(l * 3 + 0) * 1024 * 2048; m.dst = (bf16_t*)(lw + LW_BR); m.K = 1024; m.N = 2048; m.ksc = (const float*)a.in[I_SUBLN] + l * 128; m.kmod = 128; m.kmul = 1.f - lam_init_of(l); break;
        case 5: m.src = (const float*)a.in[I_WBR] + (size_t)(l * 3 + 1) * 1024 * 2048; m.dst = (bf16_t*)(lw + LW_BR + 4 * MiB); m.K = 1024; m.N = 2048; break;
        case 6: m.src = (const float*)a.in[I_WBR] + (size_t)(l * 3 + 2) * 1024 * 2048; m.dst = (bf16_t*)(lw + LW_BR + 8 * MiB); m.K = 1024; m.N = 2048; break;
        case 7: m.src = (const float*)a.in[I_WOUT] + (size_t)l * 2048 * 2048; m.dst = (bf16_t*)(lw + LW_OUT); m.K = 2048; m.N = 2048; break;
        case 8: m.src = (const float*)a.in[I_WXQ] + (size_t)l * 2048 * 512; m.dst = (bf16_t*)(lw + LW_XQ); m.K = 2048; m.N = 512; break;
        case 9: m.src = (const float*)a.in[I_WXKV] + (size_t)l * 2048 * 1024; m.dst = (bf16_t*)(lw + LW_XKV); m.K = 2048; m.N = 1024; break;
        default: m.src = (const float*)a.in[I_WXO] + (size_t)l * 512 * 2048; m.dst = (bf16_t*)(lw + LW_XO); m.K = 512; m.N = 2048; break;
        }
    } else if (id == 22) { m.src = (const float*)a.in[I_FGU]; m.dst = (bf16_t*)(ws + WS_FFN); m.K = D; m.N = 2 * DFF; m.kind = 3; }
    else if (id == 23) { m.src = (const float*)a.in[I_FDN]; m.dst = (bf16_t*)(ws + WS_FFN + 44 * MiB); m.K = DFF; m.N = D; m.fp8 = 1; m.kmul = 256.f; }
    else { const int e = (id - 24) >> 1;
        m.fp8 = 1;
        if (((id - 24) & 1) == 0) { m.src = (const float*)a.in[I_MGU] + (size_t)e * D * 2 * DFF; m.dst = (bf16_t*)(ws + WS_MOE + (size_t)e * 66 * MiB); m.K = D; m.N = 2 * DFF; m.kind = 3; m.kmul = 64.f; }
        else { m.src = (const float*)a.in[I_MDN] + (size_t)e * DFF * D; m.dst = (bf16_t*)(ws + WS_MOE + (size_t)e * 66 * MiB + 44 * MiB); m.K = DFF; m.N = D; m.kmul = 256.f; }
    }
    return m;
}
constexpr int NMAT = 40;
__device__ __forceinline__ void cvt_item(const Mat& mt, LAS float* scr, int item, int lane) {
    const int nblk = mt.N / 64, kb = item / nblk, nb = item - kb * nblk, k0 = 64 * kb, n0 = 64 * nb;
    const bool g8 = mt.kind == 1 && n0 >= 3072;
    const bool f8 = mt.fp8 || g8; const float kmul = g8 ? 64.f : mt.kmul;
    const int lr = lane >> 4, lc = (lane & 15) * 4;
    f32x4 v[16];
#pragma unroll
    for (int i = 0; i < 16; ++i) v[i] = *(const f32x4*)(mt.src + (size_t)(k0 + 4 * i + lr) * mt.N + n0 + lc);
    if (mt.ksc) {
#pragma unroll
        for (int i = 0; i < 16; ++i) v[i] = v[i] * (mt.ksc[(k0 + 4 * i + lr) % mt.kmod] * mt.kmul); }
    else if (f8) {
#pragma unroll
        for (int i = 0; i < 16; ++i) v[i] = v[i] * kmul; }
#pragma unroll
    for (int i = 0; i < 16; ++i) { LAS float* p = scr + (4 * i + lr) * 65 + lc; p[0] = v[i][0]; p[1] = v[i][1]; p[2] = v[i][2]; p[3] = v[i][3]; }
    LDS_WAIT(); asm volatile("" ::: "memory");
    const int c = lane & 7;
#pragma unroll
    for (int j = 0; j < 8; ++j) { const int n = (lane >> 3) + 8 * j; const LAS float* s = scr + (8 * c) * 65 + n;
        if (f8) { const u32x2 o = pack8_fp8((f32x4){s[0 * 65], s[1 * 65], s[2 * 65], s[3 * 65]}, (f32x4){s[4 * 65], s[5 * 65], s[6 * 65], s[7 * 65]}); const int r_ = map_row(mt.kind, n0 + n, mt.N);
            unsigned char* d8 = g8 ? (unsigned char*)mt.dst + (size_t)NIN_BF * mt.K * 2 + (size_t)(r_ - NIN_BF) * mt.K : (unsigned char*)mt.dst + (size_t)r_ * mt.K;
            *(u32x2*)(d8 + k0 + 8 * c) = o; }
        else { u32x4 o; o.x = cvt_pk_bf16(s[0 * 65], s[1 * 65]); o.y = cvt_pk_bf16(s[2 * 65], s[3 * 65]); o.z = cvt_pk_bf16(s[4 * 65], s[5 * 65]); o.w = cvt_pk_bf16(s[6 * 65], s[7 * 65]);
            *(u32x4*)(mt.dst + (size_t)map_row(mt.kind, n0 + n, mt.N) * mt.K + k0 + 8 * c) = o; } }
    LDS_WAIT(); asm volatile("" ::: "memory");
}
__device__ __forceinline__ void cvt_tile_wg(const Mat& mt, LAS float* scr, int tile, int tid) {
    const int nblk = mt.N / 256, kb = tile / nblk, nb = tile - kb * nblk, k0 = 64 * kb, n0 = 256 * nb;
    const int lane = tid & 63, w = tid >> 6;
    f32x4 v[8];
#pragma unroll
    for (int i = 0; i < 8; ++i) v[i] = *(const f32x4*)(mt.src + (size_t)(k0 + 8 * w + i) * mt.N + n0 + lane * 4);
    if (mt.ksc) {
#pragma unroll
        for (int i = 0; i < 8; ++i) v[i] = v[i] * (mt.ksc[(k0 + 8 * w + i) % mt.kmod] * mt.kmul); }
    else if (mt.fp8) {
#pragma unroll
        for (int i = 0; i < 8; ++i) v[i] = v[i] * mt.kmul; }
#pragma unroll
    for (int i = 0; i < 8; ++i) { LAS float* p = scr + (8 * w + i) * 257 + lane * 4; p[0] = v[i][0]; p[1] = v[i][1]; p[2] = v[i][2]; p[3] = v[i][3]; }
    __syncthreads();
    const int c = tid & 7;
#pragma unroll
    for (int j = 0; j < 4; ++j) { const int n = (tid >> 3) + 64 * j; const LAS float* s = scr + (8 * c) * 257 + n; const int r_ = map_row(mt.kind, n0 + n, mt.N);
        if (mt.fp8) *(u32x2*)((unsigned char*)mt.dst + (size_t)r_ * mt.K + k0 + 8 * c) = pack8_fp8((f32x4){s[0 * 257], s[1 * 257], s[2 * 257], s[3 * 257]}, (f32x4){s[4 * 257], s[5 * 257], s[6 * 257], s[7 * 257]});
        else { u32x4 o; o.x = cvt_pk_bf16(s[0 * 257], s[1 * 257]); o.y = cvt_pk_bf16(s[2 * 257], s[3 * 257]); o.z = cvt_pk_bf16(s[4 * 257], s[5 * 257]); o.w = cvt_pk_bf16(s[6 * 257], s[7 * 257]);
            *(u32x4*)(mt.dst + (size_t)r_ * mt.K + k0 + 8 * c) = o; } }
    __syncthreads();
}
__device__ __forceinline__ void ssm_build(const ArgsD& a, int l, int g, int half, LAS unsigned char* lds) {
    LAS float* Ap = (LAS float*)lds;
    LAS float* Bb = Ap + 33 * 64 * 2;
    LAS float* Cc = Bb + 64 * 16 * 2;
    LAS float* Mk = Cc + 16 * 64 * 2;
    const int tid = opaque_tid();
    const float* lre = (const float*)a.in[I_LRE] + (l * 64 + g) * 64; const float* lim = (const float*)a.in[I_LIM] + (l * 64 + g) * 64;
    const float* bre = (const float*)a.in[I_BRE] + (size_t)(l * 64 + g) * 1024; const float* bim = (const float*)a.in[I_BIM] + (size_t)(l * 64 + g) * 1024;
    const float* cre = (const float*)a.in[I_CRE] + (size_t)(l * 64 + g) * 1024; const float* cim = (const float*)a.in[I_CIM] + (size_t)(l * 64 + g) * 1024;
    const double dt = exp((double)((const float*)a.in[I_LOGDT])[l * 64 + g]);
    for (int idx = tid; idx < 33 * 64; idx += 512) { const int n = idx & 63, k = idx >> 6; const double re = lre[n], im = lim[n];
        const double mag = exp(re * dt * k), ang = im * dt * k; Ap[idx * 2] = (float)(mag * cos(ang)); Ap[idx * 2 + 1] = (float)(mag * sin(ang)); }
    if (tid < 64) { float* a32 = (float*)(a.ws + WS_A32) + (size_t)((l * 64 + g) * 64 + tid) * 2; const double re = lre[tid], im = lim[tid]; const double mag = exp(32.0 * re * dt), ang = 32.0 * im * dt;
        a32[0] = (float)(mag * cos(ang)); a32[1] = (float)(mag * sin(ang)); }
    for (int idx = tid; idx < 1024; idx += 512) { const int n = idx >> 4; const double re = lre[n], im = lim[n]; const double mag = exp(re * dt), ang = im * dt;
        const double lr = mag * cos(ang) - 1.0, li = mag * sin(ang), den = re * re + im * im;
        const double fr_ = (lr * re + li * im) / den, fi_ = (li * re - lr * im) / den; const double br = bre[idx], bi = bim[idx];
        Bb[idx * 2] = (float)(fr_ * br - fi_ * bi); Bb[idx * 2 + 1] = (float)(fr_ * bi + fi_ * br);
        Cc[idx * 2] = cre[idx]; Cc[idx * 2 + 1] = cim[idx]; }
    __syncthreads();
    { const int k = tid >> 4, p = tid & 15; float acc[16];
#pragma unroll
        for (int q = 0; q < 16; ++q) acc[q] = 0.f;
        for (int n = 0; n < 64; ++n) { const float ar = Ap[(k * 64 + n) * 2], ai = Ap[(k * 64 + n) * 2 + 1], cr = Cc[(p * 64 + n) * 2], ci = Cc[(p * 64 + n) * 2 + 1];
            const float ur = cr * ar - ci * ai, ui = cr * ai + ci * ar; const LAS f32x4* bq = (const LAS f32x4*)(Bb + n * 32);
#pragma unroll
            for (int q4 = 0; q4 < 8; ++q4) { const f32x4 bv = bq[q4]; acc[2 * q4] += bv[0] * ur - bv[1] * ui; acc[2 * q4 + 1] += bv[2] * ur - bv[3] * ui; } }
#pragma unroll
        for (int q = 0; q < 16; ++q) Mk[tid * 16 + q] = acc[q]; }
    __syncthreads();
    unsigned char* lw = a.ws + WS_W + (size_t)l * LW_BYTES;
    bf16_t* T = (bf16_t*)(lw + LW_TEXT) + (size_t)g * 512 * SSM_KX; bf16_t* W = (bf16_t*)(lw + LW_WSL) + (size_t)g * 256 * 512;
    for (int it = 0; it < 40; ++it) { const int c = it * 512 + tid, Rl = c / 80, ch = c - Rl * 80, R = 256 * half + Rl, i = R >> 4, p = R & 15; u32x4 w = {0u, 0u, 0u, 0u};
        if (ch < 64) { const int j = ch >> 1, q0 = (ch & 1) * 8;
            if (j <= i) { const LAS float* mp = Mk + ((i - j) * 16 + p) * 16 + q0; w.x = cvt_pk_bf16(mp[0], mp[1]); w.y = cvt_pk_bf16(mp[2], mp[3]); w.z = cvt_pk_bf16(mp[4], mp[5]); w.w = cvt_pk_bf16(mp[6], mp[7]); } }
        else { const int cc = ch - 64; float v[8];
#pragma unroll
            for (int e = 0; e < 4; ++e) { const int n = cc * 4 + e; const float cr = Cc[(p * 64 + n) * 2], ci = Cc[(p * 64 + n) * 2 + 1], ar = Ap[((i + 1) * 64 + n) * 2], ai = Ap[((i + 1) * 64 + n) * 2 + 1];
                v[2 * e] = cr * ar - ci * ai; v[2 * e + 1] = -(cr * ai + ci * ar); }
            w.x = cvt_pk_bf16(v[0], v[1]); w.y = cvt_pk_bf16(v[2], v[3]); w.z = cvt_pk_bf16(v[4], v[5]); w.w = cvt_pk_bf16(v[6], v[7]); }
        *(u32x4*)(T + (size_t)R * SSM_KX + ch * 8) = w; }
    for (int it = 0; it < 16; ++it) { const int c = it * 512 + tid, R = 128 * half + (c >> 6), ch = c & 63; u32x4 w = {0u, 0u, 0u, 0u};
        if (R < 128) { const int n = R >> 1, im = R & 1, j = ch >> 1, q0 = (ch & 1) * 8; float v[8]; const float ar = Ap[((31 - j) * 64 + n) * 2], ai = Ap[((31 - j) * 64 + n) * 2 + 1];
#pragma unroll
            for (int e = 0; e < 8; ++e) { const float br = Bb[(n * 16 + q0 + e) * 2], bi = Bb[(n * 16 + q0 + e) * 2 + 1]; v[e] = im ? (ar * bi + ai * br) : (ar * br - ai * bi); }
            w.x = cvt_pk_bf16(v[0], v[1]); w.y = cvt_pk_bf16(v[2], v[3]); w.z = cvt_pk_bf16(v[4], v[5]); w.w = cvt_pk_bf16(v[6], v[7]); }
        *(u32x4*)(W + (size_t)R * 512 + ch * 8) = w; }
    __syncthreads();
}

struct LnArgs { bf16_t* X; float* outf; unsigned char* outq; const float* g; const float* b;
                const float* og; const int* slot; int* r_e; float* r_w; unsigned* cnt; };
template <int MODE>
__device__ __forceinline__ void ln_phase(const LnArgs& A, LAS unsigned char* lds, int G) {
    const int tid = opaque_tid(), lane = tid & 63, wave = __builtin_amdgcn_readfirstlane(tid >> 6);
    const int gw = blockIdx.x * 8 + wave, NGW = G * 8;
    f32x4 gv[8], bv[8];
    if (MODE != 1) {
#pragma unroll
        for (int j = 0; j < 8; ++j) { gv[j] = *(const f32x4*)(A.g + lane * 8 + 512 * (j >> 1) + 4 * (j & 1)); bv[j] = *(const f32x4*)(A.b + lane * 8 + 512 * (j >> 1) + 4 * (j & 1)); } }
    for (int row = gw; row < M; row += NGW) {
        bf16_t* xr = A.X + (size_t)row * D + lane * 8;
        f32x4 v[8]; float s = 0.f;
#pragma unroll
        for (int j = 0; j < 4; ++j) { const u32x4 w = *(const u32x4*)(xr + 512 * j); v[2 * j] = (f32x4){bf_lo(w.x), bf_hi(w.x), bf_lo(w.y), bf_hi(w.y)}; v[2 * j + 1] = (f32x4){bf_lo(w.z), bf_hi(w.z), bf_lo(w.w), bf_hi(w.w)}; }
        if (MODE == 2) { const int s0 = A.slot[row * 2], s1 = A.slot[row * 2 + 1]; const bf16_t* o0 = (const bf16_t*)A.og + (size_t)s0 * D + lane * 8; const bf16_t* o1 = (const bf16_t*)A.og + (size_t)s1 * D + lane * 8;
#pragma unroll
            for (int j = 0; j < 4; ++j) { const u32x4 a = *(const u32x4*)(o0 + 512 * j), b = *(const u32x4*)(o1 + 512 * j);
                v[2 * j] = v[2 * j] * ALPHA + (f32x4){bf_lo(a.x), bf_hi(a.x), bf_lo(a.y), bf_hi(a.y)} + (f32x4){bf_lo(b.x), bf_hi(b.x), bf_lo(b.y), bf_hi(b.y)};
                v[2 * j + 1] = v[2 * j + 1] * ALPHA + (f32x4){bf_lo(a.z), bf_hi(a.z), bf_lo(a.w), bf_hi(a.w)} + (f32x4){bf_lo(b.z), bf_hi(b.z), bf_lo(b.w), bf_hi(b.w)}; } }
#pragma unroll
        for (int j = 0; j < 8; ++j) s += (v[j][0] + v[j][1]) + (v[j][2] + v[j][3]);
        const float mean = wave_sum(s, lane) * (1.f / D); float s2 = 0.f;
#pragma unroll
        for (int j = 0; j < 8; ++j) { v[j] = v[j] - mean; s2 += (v[j][0] * v[j][0] + v[j][1] * v[j][1]) + (v[j][2] * v[j][2] + v[j][3] * v[j][3]); }
        const float rstd = 1.f / sqrtf(wave_sum(s2, lane) * (1.f / D) + LN_EPS);
#pragma unroll
        for (int j = 0; j < 8; ++j) { if (MODE == 1) { gv[j] = *(const f32x4*)(A.g + lane * 8 + 512 * (j >> 1) + 4 * (j & 1)); bv[j] = *(const f32x4*)(A.b + lane * 8 + 512 * (j >> 1) + 4 * (j & 1)); }
            v[j] = v[j] * rstd * gv[j] + bv[j]; }
        if (A.outf) { float* of = A.outf + (size_t)row * D + lane * 8;
#pragma unroll
            for (int j = 0; j < 8; ++j) *(f32x4*)(of + 512 * (j >> 1) + 4 * (j & 1)) = v[j]; }
        else {
#pragma unroll
            for (int j = 0; j < 4; ++j) *(u32x4*)(xr + 512 * j) = pack8(v[2 * j], v[2 * j + 1]); }
        if (A.outq) { unsigned char* oq = A.outq + (size_t)row * D + lane * 8;
#pragma unroll
            for (int j = 0; j < 4; ++j) *(u32x2*)(oq + 512 * j) = pack8_fp8(v[2 * j], v[2 * j + 1]); }
        if (MODE == 1) {
            const LAS float* wr_ = (const LAS float*)lds;
            int i0 = 0, i1 = 0; float v0 = -__builtin_inff(), v1 = -__builtin_inff();
#pragma unroll 1
            for (int e = 0; e < 8; ++e) { float acc = 0.f;
#pragma unroll
                for (int j = 0; j < 8; ++j) { const f32x4 w = *(const LAS f32x4*)(wr_ + e * D + lane * 8 + 512 * (j >> 1) + 4 * (j & 1)); acc += (v[j][0] * w[0] + v[j][1] * w[1]) + (v[j][2] * w[2] + v[j][3] * w[3]); }
                const float sg = wave_sum(acc, lane);
                if (sg > v0) { v1 = v0; i1 = i0; v0 = sg; i0 = e; } else if (sg > v1) { v1 = sg; i1 = e; } }
            const float w0 = 1.f / (1.f + expf(v1 - v0)), w1 = 1.f - w0;
            if (lane == 0) { A.r_e[row * 2] = i0; A.r_e[row * 2 + 1] = i1; A.r_w[row * 2] = w0; A.r_w[row * 2 + 1] = w1;
                __hip_atomic_fetch_add(A.cnt + i0, 1u, RLX_AGENT); __hip_atomic_fetch_add(A.cnt + i1, 1u, RLX_AGENT); }
        }
    }
}
__device__ __forceinline__ void moe_offsets(const unsigned* cnt, int (&off)[9]) {
    int acc = 0;
#pragma unroll
    for (int e = 0; e < 8; ++e) { off[e] = acc; const int c = (int)__hip_atomic_load(cnt + e, RLX_AGENT); acc += ((c + 255) >> 8) << 8; }
    off[8] = acc;
}

struct AttPtrs { const bf16_t *QD, *KD, *VD, *QM, *KM, *VM; bf16_t *BR0, *BR1; };
__device__ __forceinline__ void mla_unit(const AttPtrs& P, int h, int qb, char* lds) {
    const int tid = opaque_tid(), wid = __builtin_amdgcn_readfirstlane(tid >> 6), lane = tid & 63, r32 = lane & 31, hi = lane >> 5;
    const int q0 = qb * 256 + wid * 32; f32x16 o[4]; float l;
    att::attn_core_pp<192, 12, true, true>(P.QM + (size_t)(q0 + r32) * 1536 + h * 192 + hi * 8, P.KM + h * 192, 1536, P.VM + h * 128, 1024, 4 * (qb + 1), q0 + r32, q0, 0, lds, o, l);
    float* ws = (float*)(lds + 3 * att::SHM_V + 3 * 64 * 384) + wid * 64;
    att::normalize_o(o, l, ws, r32, hi);
    att::store_o_bf16(o, P.BR1 + (size_t)q0 * 1024 + h * 128, 1024, r32, hi);
    __syncthreads();
}
__device__ __forceinline__ void diff_unit(const AttPtrs& P, int h, int qb, float lam, char* lds) {
    const int tid = opaque_tid(), wid = __builtin_amdgcn_readfirstlane(tid >> 6), lane = tid & 63, r32 = lane & 31, hi = lane >> 5;
    const int mp = wid >> 2, w4 = wid & 3, q0 = qb * 128 + w4 * 32; f32x16 o[4]; float l;
    att::attn_core_pp<128, 4, true, true>(P.QD + (size_t)(q0 + r32) * 1024 + h * 128 + mp * 64 + hi * 8, P.KD + h * 128, 1024, P.VD + h * 128, 1024, 2 * (qb + 1), q0 + r32, q0, mp * 8, lds, o, l);
    float* ws = (float*)(lds + 3 * att::SHM_V + 3 * 64 * 256) + wid * 64;
    att::normalize_o(o, l, ws, r32, hi);
    __syncthreads();
    float* xch = (float*)lds + w4 * 4096 + lane;
    if (mp == 1) {
#pragma unroll
        for (int d0 = 0; d0 < 4; ++d0)
#pragma unroll
            for (int r = 0; r < 16; ++r) xch[(d0 * 16 + r) * 64] = o[d0][r];
    }
    __syncthreads();
    if (mp == 0) {
        float ss[16];
#pragma unroll
        for (int r = 0; r < 16; ++r) { float s = 0.f;
#pragma unroll
            for (int d0 = 0; d0 < 4; ++d0) { const float dv = o[d0][r] - lam * xch[(d0 * 16 + r) * 64]; o[d0][r] = dv; s += dv * dv; }
            ss[r] = s; }
#pragma unroll
        for (int r = 0; r < 16; ++r) { float s = ss[r];
#pragma unroll
            for (int off = 1; off < 32; off <<= 1) s += shflx(s, off, lane);
            const float rs = __builtin_amdgcn_rsqf(s * (1.f / 128.f) + RMS_EPS);
#pragma unroll
            for (int d0 = 0; d0 < 4; ++d0) o[d0][r] *= rs; }
        att::store_o_bf16(o, P.BR0 + (size_t)q0 * 1024 + h * 128, 1024, r32, hi);
    }
    __syncthreads();
}
__device__ __forceinline__ void cross_unit(const bf16_t* XQ, const bf16_t* XKV, bf16_t* XO, int h, int qb, char* lds) {
    const int tid = opaque_tid(), wid = __builtin_amdgcn_readfirstlane(tid >> 6), lane = tid & 63, r32 = lane & 31, hi = lane >> 5;
    const int q0 = qb * 256 + wid * 32; f32x16 o[4]; float l;
    att::attn_core<128, 8, false, true>(XQ + (size_t)(q0 + r32) * 512 + h * 128 + hi * 8, XKV + h * 128, 1024, XKV + 512 + h * 128, 1024, 4, 0, 0, 0, lds, o, l);
    float* ws = (float*)(lds + 2 * att::SHM_V + 2 * 64 * 256) + wid * 64;
    att::normalize_o(o, l, ws, r32, hi);
    att::store_o_bf16(o, XO + (size_t)q0 * 512 + h * 128, 512, r32, hi);
    __syncthreads();
}

__global__ void __launch_bounds__(512, 2) fwd_kernel(Args args) {
    extern __shared__ __attribute__((aligned(16))) unsigned char lds_raw[];
    LAS unsigned char* lds = (LAS unsigned char*)lds_raw;
    const int tid = threadIdx.x, lane = tid & 63, wave = __builtin_amdgcn_readfirstlane(tid >> 6);
    const int G = gridDim.x, bx = blockIdx.x;
    unsigned char* ws = (unsigned char*)(GAS unsigned char*)(unsigned long long)args.ws;
    unsigned* ctl = (unsigned*)(ws + WS_CTL);
    volatile LAS unsigned* MISC = (volatile LAS unsigned*)(lds + LDS_MISC);
    if (tid < 32) MISC[tid] = 0u;
    if (lane == 0) ((volatile LAS int*)LDS_WTAB)[__builtin_amdgcn_s_getreg(0x2804)] = wave;
    { volatile LAS unsigned long long* pt = (volatile LAS unsigned long long*)(lds + LDS_MISC + 256); if (tid < 35) pt[tid] = (unsigned long long)args.in[tid]; if (tid == 35) pt[35] = (unsigned long long)args.out; }
    __syncthreads();
    ArgsD ad; ad.in.t = (volatile LAS unsigned long long*)(lds + LDS_MISC + 256); ad.ws = ws;
    const int lo = args.ph_lo, hi = args.ph_hi;
    XcdBarrier bar; bar.bar = ctl + CW_BAR; bar.x = 0; bar.st = nullptr;
    if (hi - lo > 1) { bar = xcd_barrier_post(ctl + CW_BAR, MISC + 8); xcd_barrier_setup(bar); }
#ifndef PH_SEL
#define PH_SEL 0xFFFFFFFFu
#endif
#define INR(k) (lo <= (k) && (k) < hi)
#define IN0() (((PH_SEL) & 1u) && INR(0))
#define INL(j) ((((PH_SEL) >> ((j) + 1)) & 1u) && INR(pb + (j)))
#define SEAM(k) do { if (INR(k) && INR((k) + 1)) xcd_barrier(bar); } while (0)
    const int gw = bx * 8 + wave, NGW = G * 8;
    const int gtid = bx * 512 + tid, NGT = G * 512;

    if (IN0()) {
      {
        { int start = bx;
            for (int id = 0; id < NMAT; ++id) { const Mat mt = get_mat(ad, id); if (mt.kind == 1) continue; const int nit = (mt.K / 64) * (mt.N / 256);
                int it = start; for (; it < nit; it += G) cvt_tile_wg(mt, (LAS float*)lds, it, tid);
                start = it - nit; } }
        { LAS float* scr = (LAS float*)(lds + wave * 16640); int start = gw;
            for (int id = 0; id < 22; id += 11) { const Mat mt = get_mat(ad, id); const int nit = (mt.K / 64) * (mt.N / 64);
                int it = start; for (; it < nit; it += NGW) cvt_item(mt, scr, it, lane);
                start = it - nit; } }
        for (int l = 0; l < DEPTH; ++l) { u32x4* p = (u32x4*)((unsigned char*)(ws + WS_W + (size_t)l * LW_BYTES + LW_IN) + (size_t)NIN_BF * D * 2 + (size_t)(3904 - NIN_BF) * D);
            for (int i = gtid; i < 192 * D / 16; i += NGT) p[i] = (u32x4){0u, 0u, 0u, 0u}; }
        { const float* x = (const float*)ad.in[I_X]; bf16_t* xn = (bf16_t*)(ws + WS_XN);
            unsigned char* x8 = ws + WS_XN8;
            for (size_t i = gtid; i < (size_t)M * D / 8; i += NGT) { const f32x4 a = *(const f32x4*)(x + i * 8), b = *(const f32x4*)(x + i * 8 + 4); *(u32x4*)(xn + i * 8) = pack8(a, b); *(u32x2*)(x8 + i * 8) = pack8_fp8(a, b); }
            const float* mem = (const float*)ad.in[I_MEM]; bf16_t* mb = (bf16_t*)(ws + WS_MEMB);
            for (int i = gtid; i < MEM_LEN * D / 8; i += NGT) { const f32x4 a = *(const f32x4*)(mem + i * 8), b = *(const f32x4*)(mem + i * 8 + 4); *(u32x4*)(mb + i * 8) = pack8(a, b); } }
        { const int* pos = (const int*)ad.in[I_POS]; float* td = (float*)(ws + WS_TABD); float* tm = (float*)(ws + WS_TABM);
            for (int i = gtid; i < M * 40; i += NGT) { const int t = i / 40, k = i - t * 40; const double p = (double)pos[t];
                const double inv = (k < 8) ? exp(-(double)k * (13.122363377404328 / 8.0)) : exp(-(double)(k - 8) * (13.122363377404328 / 32.0));
                const double ang = p * inv; const float c = (float)cos(ang), s = (float)sin(ang);
                if (k < 8) { td[(t * 8 + k) * 2] = c; td[(t * 8 + k) * 2 + 1] = s; } else { tm[(t * 32 + k - 8) * 2] = c; tm[(t * 32 + k - 8) * 2 + 1] = s; } } }
        if (bx == 0 && tid < 192) { int* ord = (int*)(ws + WS_ORDER); const int mine = tid < 64 ? 160 * (tid + 1) : 48 * (tid - 64 + 1); int rank = 0;
            for (int c = 0; c < 192; ++c) { const int cc = c < 64 ? 160 * (c + 1) : 48 * (c - 64 + 1); rank += (cc > mine || (cc == mine && c < tid)) ? 1 : 0; }
            const int code = tid < 64 ? ((1 << 16) | (tid << 8)) : ((tid - 64) << 8);
            for (int h = 0; h < 8; ++h) ord[rank * 8 + h] = code | h; }
        __syncthreads();
#ifdef PROBE_SSMB
#pragma nounroll
        for (int rep_ = 0; rep_ < 2; ++rep_)
#endif
        for (int uidx = bx; uidx < DEPTH * 64 * 2; uidx += G) ssm_build(ad, uidx >> 7, (uidx >> 1) & 63, uidx & 1, lds);
        __syncthreads();
      }
    }
    SEAM(0);

    unsigned char* const ws_k = ws; const int bx_k = bx;
    for (int l = 0; l < DEPTH; ++l) {
        const int pb = 1 + l * NPL;
        if (!(lo < pb + NPL && pb < hi)) continue;
        int bx = bx_k; asm volatile("" : "+s"(bx));
        unsigned long long ws_i = (unsigned long long)ws_k; asm volatile("" : "+s"(ws_i)); unsigned char* ws = (unsigned char*)(GAS unsigned char*)ws_i;
#define PH_TID const int tid = opaque_tid(), lane = tid & 63, wave = __builtin_amdgcn_readfirstlane(tid >> 6); const int gw = bx * 8 + wave, NGW = G * 8; (void)lane; (void)wave; (void)gw; (void)NGW
#define lw (ws + WS_W + (size_t)l * LW_BYTES)
#define ssq_q ((float*)(ws + WS_PSQ))
#define ssq_kv (ssq_q + (size_t)8 * M)
#define XS ((float*)(ws + WS_XS))
#define XN ((bf16_t*)(ws + WS_XN))
#define tabd ((const float*)(ws + WS_TABD))
#define tabm ((const float*)(ws + WS_TABM))
#define QD ((bf16_t*)(ws + WS_QD))
#define KD ((bf16_t*)(ws + WS_KD))
#define VD ((bf16_t*)(ws + WS_VD))
#define MQ ((bf16_t*)(ws + WS_MQ))
#define MKV ((bf16_t*)(ws + WS_MKV))
#define KM ((bf16_t*)(ws + WS_KM))
#define VM ((bf16_t*)(ws + WS_VM))
#define QM ((bf16_t*)(ws + WS_QM))
#define SU ((bf16_t*)(ws + WS_SU))
#define GATES ((bf16_t*)(ws + WS_GATES))
#define SLOC ((float*)(ws + WS_SLOC))
#define YG ((bf16_t*)(ws + WS_YG))
#define BR ((bf16_t*)(ws + WS_BR))
#define TMP ((float*)(ws + WS_TMP))
#define MG ((bf16_t*)(ws + WS_MG))
#define XQ ((bf16_t*)(ws + WS_XQ))
#define XO ((bf16_t*)(ws + WS_XO))
#define XKV ((bf16_t*)(ws + WS_XKV) + (size_t)l * 256 * 1024)
#define r_e ((int*)(ws + WS_ROUTE))
#define r_w ((float*)(ws + WS_ROUTE + 128 * 1024))
#define slot ((int*)(ws + WS_ROUTE + 256 * 1024))
#define wslot ((float*)(ws + WS_ROUTE + 384 * 1024))
        if (INL(0)) {
#if !defined(SUBSEL) || (SUBSEL & 1)
            { pg8::Gemm g{XN, (const bf16_t*)(lw + LW_IN), (D) * 2, (D) * 2, (D) * 2, 0}; SchedPlain S; S.init(M / 256, NIN_BF / 256, D, D, G, bx);
              EpiInProj E{QD, KD, VD, MQ, MKV, KM, SU, GATES, ssq_q, ssq_kv, tabd, tabm, 0};
              pg8::gemm_phase(lds, g, S, E); }
            { pg8::Gemm g{ws + WS_XN8, lw + LW_IN + (size_t)NIN_BF * D * 2, D, D, D, 0}; SchedPlain S; S.T.init(M / 256, NIN_G8 / 256); S.G = G; S.c = bx; S.tA = (size_t)256 * D; S.tB = S.tA;
              EpiInProj E{QD, KD, VD, MQ, MKV, KM, SU, GATES, ssq_q, ssq_kv, tabd, tabm, 12};
              pg8::gemm_phase_t<true, 0x7C7C7C7C>(lds, g, S, E); }
#endif
#if !defined(SUBSEL) || (SUBSEL & 2)
            { pg8::Gemm g{(const bf16_t*)(ws + WS_MEMB), (const bf16_t*)(lw + LW_XKV), (D) * 2, (D) * 2, (D) * 2, 0}; SchedPlain S; S.init(1, 4, D, D, G, (bx + 128) % G);
              EpiBf16 E{XKV, 1024, 1.f};
              pg8::gemm_phase(lds, g, S, E); }
#endif
        }
        SEAM(pb + 0);
        if (INL(1)) {
#if !defined(SUBSEL) || (SUBSEL & 1)
            { pg8::Gemm g{MQ, (const bf16_t*)(lw + LW_QUP), (512) * 2, (512) * 2, (512) * 2, 0}; SchedPlain S; S.init(M / 256, 6, 512, 512, G, bx);
              EpiQup E{QM, ssq_q, tabm}; pg8::gemm_phase(lds, g, S, E); }
#endif
#if !defined(SUBSEL) || (SUBSEL & 2)
            { pg8::Gemm g{MKV, (const bf16_t*)(lw + LW_KVUP), (256) * 2, (256) * 2, (256) * 2, 0}; SchedPlain S; S.init(M / 256, 8, 256, 256, G, (bx + 128) % G);
              EpiKVup E{KM, VM, ssq_kv}; pg8::gemm_phase(lds, g, S, E); }
#endif
#if !defined(SUBSEL) || (SUBSEL & 4)
            { pg8::Gemm g{SU, (const bf16_t*)(lw + LW_WSL), (SSM_KX) * 2, (512) * 2, (512) * 2, 0}; SchedBatch S{2, 1, 64, G, (bx + 128) % G  , (size_t)256 * SSM_KX * 2, (size_t)256 * 512 * 2, (size_t)SSM_NCH * SSM_KX * 2, (size_t)256 * 512 * 2};
              EpiSloc E{SLOC}; pg8::gemm_phase(lds, g, S, E); }
#endif
        }
        SEAM(pb + 1);
        if (INL(2)) {
            PH_TID;
            if (bx < 64) { const int g = bx, n = lane, w = wave;
                const float* a32 = (const float*)(ws + WS_A32) + (size_t)((l * 64 + g) * 64 + n) * 2; const float ar = a32[0], ai = a32[1];
                const float* __restrict__ lp = SLOC + ((size_t)g * SSM_NCH + 64 * w) * 128 + 2 * n; bf16_t* __restrict__ sp = SU + ((size_t)g * SSM_NCH + 64 * w) * SSM_KX + 512 + 2 * n;
                float br[64], bi[64]; float sr = 0.f, si = 0.f;
#pragma unroll
                for (int c0 = 0; c0 < 64; c0 += 32) { f32x2 lv[32];
#pragma unroll
                    for (int k = 0; k < 32; ++k) lv[k] = *(const f32x2*)(lp + (size_t)(c0 + k) * 128);
#pragma unroll
                    for (int k = 0; k < 32; ++k) { br[c0 + k] = sr; bi[c0 + k] = si; const float nr = ar * sr - ai * si + lv[k][0], ni = ar * si + ai * sr + lv[k][1]; sr = nr; si = ni; } }
                LAS float* ex = (LAS float*)lds;
                ex[(w * 64 + n) * 2] = sr; ex[(w * 64 + n) * 2 + 1] = si;
                float pr = ar, pi = ai;
#pragma unroll
                for (int q = 0; q < 6; ++q) { const float tr = pr * pr - pi * pi, ti = 2.f * pr * pi; pr = tr; pi = ti; }
                __syncthreads();
                float cr = 0.f, ci = 0.f;
                for (int uu = 0; uu < w; ++uu) { const float er = ex[(uu * 64 + n) * 2], ei = ex[(uu * 64 + n) * 2 + 1]; const float tr = pr * cr - pi * ci + er, ti = pr * ci + pi * cr + ei; cr = tr; ci = ti; }
#pragma unroll
                for (int k = 0; k < 64; ++k) { *(unsigned*)(sp + (size_t)k * SSM_KX) = cvt_pk_bf16(br[k] + cr, bi[k] + ci);
                    const float tr = ar * cr - ai * ci, ti = ar * ci + ai * cr; cr = tr; ci = ti; } }
        }
        SEAM(pb + 2);
        if (INL(3)) {
#if !defined(SUBSEL) || (SUBSEL & 1)
            { pg8::Gemm g{SU, (const bf16_t*)(lw + LW_TEXT), (SSM_KX) * 2, (SSM_KX) * 2, (SSM_KX) * 2, 0}; SchedBatch S{2, 2, 64, G, bx, (size_t)256 * SSM_KX * 2, (size_t)256 * SSM_KX * 2, (size_t)SSM_NCH * SSM_KX * 2, (size_t)512 * SSM_KX * 2};
              EpiSsmY E{YG, SU, (const float*)ad.in[I_SSMD] + l * 1024}; pg8::gemm_phase(lds, g, S, E); }
#endif
            PH_TID;
            const float* dl = (const float*)ad.in[I_DLAM] + l * 256;
            const float lam = expf(wave_sum(dl[lane] * dl[64 + lane], lane)) - expf(wave_sum(dl[128 + lane] * dl[192 + lane], lane)) + lam_init_of(l);
            const AttPtrs P{QD, KD, VD, QM, KM, VM, BR, BR + (size_t)M * 1024};
            const int* ord = (const int*)(ws + WS_ORDER);
            __syncthreads();
#ifndef PROBE_ATT
#define PROBE_ATT 0
#endif
            const unsigned myx = xb_xcc_id() & 7u;
#pragma nounroll
            for (int rep = 0; rep < (PROBE_ATT ? 2 : 1); ++rep)
#pragma nounroll
            for (int sq = 0; sq < 8; ++sq) { const int q = (int)((myx + sq) & 7u);
            for (;;) {
                if (tid == 0) MISC[0] = __hip_atomic_fetch_add(ctl + CW_ATTQ + 64 * l + 32 * rep + q, 1u, RLX_AGENT);
                __syncthreads();
                const unsigned it = MISC[0];
                __syncthreads();
                if (it >= 192u) break;
                const int code = ord[it * 8 + q], h = code & 255, qb = (code >> 8) & 255;
                if ((code >> 16) && (rep == 0 || (PROBE_ATT & 1))) mla_unit(P, h, qb, (char*)lds_raw);
                if (!(code >> 16) && (rep == 0 || (PROBE_ATT & 2))) diff_unit(P, h, qb, lam, (char*)lds_raw);
            } }
        }
        SEAM(pb + 3);
        if (INL(4)) {
            pg8::Gemm g{YG, (const bf16_t*)(lw + LW_GLU), (1024) * 2, (1024) * 2, (1024) * 2, 0}; SchedPlain S; S.init(M / 256, 8, 1024, 1024, G, bx);
            EpiGated<0> E{BR + (size_t)2 * M * 1024, 1024}; pg8::gemm_phase(lds, g, S, E);
        }
        SEAM(pb + 4);
        if (INL(5)) {
            pg8::Gemm g{BR, (const bf16_t*)(lw + LW_BR), (1024) * 2, (1024) * 2, (1024) * 2, 0}; SchedBranch S; S.T.init(M / 256, 8); S.G = G; S.c = bx; S.tA = (size_t)256 * 1024 * 2; S.tB = S.tA; S.zA = (size_t)M * 1024 * 2; S.zB = (size_t)2048 * 1024 * 2;
            EpiBranch E{GATES, (bf16_t*)TMP, MG}; pg8::gemm_phase(lds, g, S, E);
        }
        SEAM(pb + 5);
        if (INL(6)) {
            pg8::Gemm g{MG, (const bf16_t*)(lw + LW_OUT), (D) * 2, (D) * 2, (D) * 2, 0}; SchedPlain S; S.init(M / 256, 8, D, D, G, bx);
            EpiResid E{XN}; pg8::gemm_phase(lds, g, S, E);
        }
        SEAM(pb + 6);
        if (INL(7)) { const LnArgs A{XN, nullptr, nullptr, (const float*)ad.in[I_LNMG] + l * D, (const float*)ad.in[I_LNMB] + l * D, nullptr, nullptr, nullptr, nullptr, nullptr}; ln_phase<0>(A, lds, G); }
        SEAM(pb + 7);
        if (INL(8)) {
            pg8::Gemm g{XN, (const bf16_t*)(lw + LW_XQ), (D) * 2, (D) * 2, (D) * 2, 0}; SchedPlain S; S.T.init(M / 128, 2); S.G = G; S.c = bx; S.tA = (size_t)128 * D * 2; S.tB = (size_t)256 * D * 2;
            EpiBf16Half E{XQ, 512, C2_X}; pg8::gemm_phase(lds, g, S, E);
        }
        SEAM(pb + 8);
        if (INL(9)) { for (int uidx = bx; uidx < 256; uidx += G) cross_unit(XQ, XKV, XO, uidx & 3, uidx >> 2, (char*)lds_raw); }
        SEAM(pb + 9);
        if (INL(10)) {
            pg8::Gemm g{XO, (const bf16_t*)(lw + LW_XO), (512) * 2, (512) * 2, (512) * 2, 0}; SchedPlain S; S.init(M / 256, 8, 512, 512, G, bx);
            EpiResid E{XN}; pg8::gemm_phase(lds, g, S, E);
        }
        SEAM(pb + 10);
        if (INL(11)) {
            const LnArgs A{XN, nullptr, nullptr, (const float*)ad.in[I_LNXG] + l * D, (const float*)ad.in[I_LNXB] + l * D, nullptr, nullptr, r_e, r_w, ctl + CW_MOECNT};
            if (l == 0) ln_phase<0>(A, lds, G);
            else { PH_TID; const float* rw = (const float*)ad.in[I_ROUTER]; LAS float* wl = (LAS float*)lds;
                for (int i = tid; i < D * 8; i += 512) wl[(i & 7) * D + (i >> 3)] = rw[i];
                __syncthreads(); ln_phase<1>(A, lds, G); __syncthreads(); }
        }
        SEAM(pb + 11);
        if (l == 1) {
            if (INL(12)) { PH_TID; int off[9]; moe_offsets(ctl + CW_MOECNT, off); bf16_t* XG = (bf16_t*)(ws + WS_XG);
                for (int row = gw; row < M; row += NGW) { int s0 = 0, s1 = 0;
                    if (lane == 0) { const int e0 = r_e[row * 2], e1 = r_e[row * 2 + 1];
                        s0 = off[e0] + (int)__hip_atomic_fetch_add(ctl + CW_MOECUR + e0, 1u, RLX_AGENT); s1 = off[e1] + (int)__hip_atomic_fetch_add(ctl + CW_MOECUR + e1, 1u, RLX_AGENT);
                        slot[row * 2] = s0; slot[row * 2 + 1] = s1; wslot[s0] = r_w[row * 2]; wslot[s1] = r_w[row * 2 + 1]; }
                    s0 = __builtin_amdgcn_readfirstlane(s0); s1 = __builtin_amdgcn_readfirstlane(s1);
                    const u32x4* src = (const u32x4*)(XN + (size_t)row * D) + lane; u32x2* d0 = (u32x2*)((unsigned char*)XG + (size_t)s0 * D) + lane; u32x2* d1 = (u32x2*)((unsigned char*)XG + (size_t)s1 * D) + lane;
#pragma unroll
                    for (int j = 0; j < 4; ++j) { const u32x4 v = src[64 * j];
                        const u32x2 q = pack8_fp8((f32x4){bf_lo(v.x), bf_hi(v.x), bf_lo(v.y), bf_hi(v.y)}, (f32x4){bf_lo(v.z), bf_hi(v.z), bf_lo(v.w), bf_hi(v.w)}); d0[64 * j] = q; d1[64 * j] = q; } } }
            SEAM(pb + 12);
        }
        if (INL(13)) {
            if (l == 0) { pg8::Gemm g{XN, (const bf16_t*)(ws + WS_FFN), (D) * 2, (D) * 2, (D) * 2, 0}; SchedPlain S; S.init(M / 256, 44, D, D, G, bx);
                EpiSwigluF8 E{ws + WS_HG, DFF}; pg8::gemm_phase(lds, g, S, E); }
            else { int off[9]; moe_offsets(ctl + CW_MOECNT, off);
                pg8::Gemm g{ws + WS_XG, ws + WS_MOE, D, D, D, 0x7C7C7C7C}; SchedMoe S; S.T.init(off[8] >> 8, 44); S.G = G; S.c = bx; S.tA = (size_t)256 * D; S.tB = S.tA; S.zB = 66 * MiB;
#pragma unroll
                for (int k = 0; k < 7; ++k) S.off[k] = off[k + 1];
                EpiSwigluF8 E{ws + WS_HG, DFF}; pg8::gemm_phase_t<true, 0x7C7C7C7C>(lds, g, S, E); }
        }
        SEAM(pb + 13);
        if (INL(14)) {
            if (l == 0) { pg8::Gemm g{ws + WS_HG, ws + WS_FFN + 44 * MiB, DFF, DFF, DFF, 0x7B7B7B7B}; SchedPlain S; S.init(M / 256, 8, DFF / 2, DFF / 2, G, bx);
                EpiResid E{XN}; pg8::gemm_phase_t<true, 0x7B7B7B7B>(lds, g, S, E); }
            else { int off[9]; moe_offsets(ctl + CW_MOECNT, off);
                pg8::Gemm g{ws + WS_HG, ws + WS_MOE + 44 * MiB, DFF, DFF, DFF, 0x7B7B7B7B}; SchedMoe S; S.T.init(off[8] >> 8, 8); S.G = G; S.c = bx; S.tA = (size_t)256 * DFF; S.tB = S.tA; S.zB = 66 * MiB;
#pragma unroll
                for (int k = 0; k < 7; ++k) S.off[k] = off[k + 1];
                EpiMoeDown E{(bf16_t*)(ws + WS_OG), wslot}; pg8::gemm_phase_t<true, 0x7B7B7B7B>(lds, g, S, E); }
        }
        SEAM(pb + 14);
        if (INL(15)) {
            const LnArgs A{XN, (l == DEPTH - 1) ? (float*)ad.in[35] : nullptr, (l == DEPTH - 1) ? nullptr : ws + WS_XN8, (const float*)ad.in[I_LNFG] + l * D, (const float*)ad.in[I_LNFB] + l * D, (const float*)(ws + WS_OG), slot, nullptr, nullptr, nullptr};
            if (l == 0) ln_phase<0>(A, lds, G); else ln_phase<2>(A, lds, G);
        }
        SEAM(pb + 15);
    }
#undef INR
#undef IN0
#undef INL
#undef SEAM
}

extern "C" void kernel_launch(void* const* d_in, const int* in_sizes, int n_in, void* d_out, int out_size, void* d_ws, size_t ws_size, hipStream_t stream) {
    static int grid = 0;
    if (grid == 0) {
        if (n_in != 35 || out_size != M * D || ws_size < WS_END) { fprintf(stderr, "kernel_launch: shape/workspace mismatch: n_in %d out %d ws %zu (need %zu)\n", n_in, out_size, ws_size, (size_t)WS_END); grid = -1; return; }
        int dev = 0, cus = 0, per_cu = 0;
        if (hipGetDevice(&dev) != hipSuccess || hipDeviceGetAttribute(&cus, hipDeviceAttributeMultiprocessorCount, dev) != hipSuccess) { grid = -1; return; }
        if (hipFuncSetAttribute((const void*)fwd_kernel, hipFuncAttributeMaxDynamicSharedMemorySize, LDS_BYTES) != hipSuccess) { fprintf(stderr, "kernel_launch: hipFuncSetAttribute failed\n"); grid = -1; return; }
        if (hipOccupancyMaxActiveBlocksPerMultiprocessor(&per_cu, (const void*)fwd_kernel, 512, LDS_BYTES) != hipSuccess || per_cu < 1) { fprintf(stderr, "kernel_launch: occupancy query says %d\n", per_cu); }
        (void)hipGetLastError();
        grid = cus;
    }
    if (grid < 0) return;
    if (hipMemsetAsync((char*)d_ws + WS_CTL, 0, CTL_ZERO_BYTES, stream) != hipSuccess) return;
    Args a{};
    for (int i = 0; i < 35; ++i) a.in[i] = d_in[i];
    a.out = (float*)d_out; a.ws = (unsigned char*)d_ws;
#if MK_MULTI
    for (int p = 0; p < NPHASE; ++p) { if (p == 1 + 12) continue; a.ph_lo = p; a.ph_hi = p + 1; hipLaunchKernelGGL(fwd_kernel, dim3(grid), dim3(512), LDS_BYTES, stream, a); }
#else
    a.ph_lo = 0; a.ph_hi = NPHASE;
    hipLaunchKernelGGL(fwd_kernel, dim3(grid), dim3(512), LDS_BYTES, stream, a);
#endif
    const hipError_t le = hipPeekAtLastError();
    if (le != hipSuccess) fprintf(stderr, "kernel_launch: launch failed: %s\n", hipGetErrorName(le));
}
```

```cpp
#include <hip/hip_runtime.h>
#include <cstdio>
#include <cstdint>
#include <cmath>

#ifndef MK_MULTI
#define MK_MULTI 0
#endif
#ifndef MK_DBG
#define MK_DBG 0
#endif

#define GAS __attribute__((address_space(1)))
#define LAS __attribute__((address_space(3)))
typedef unsigned short bf16_t;
typedef short bf16x8 __attribute__((ext_vector_type(8)));
typedef short s16x4 __attribute__((ext_vector_type(4)));
typedef float f32x2 __attribute__((ext_vector_type(2)));
typedef float f32x4 __attribute__((ext_vector_type(4)));
typedef float f32x16 __attribute__((ext_vector_type(16)));
typedef unsigned u32x2 __attribute__((ext_vector_type(2)));
typedef unsigned u32x4 __attribute__((ext_vector_type(4)));
typedef GAS unsigned gu32;
#define RLX_AGENT __ATOMIC_RELAXED, __HIP_MEMORY_SCOPE_AGENT
#define LDS_WAIT() asm volatile("s_waitcnt lgkmcnt(0)" ::: "memory")
#define VM_WAIT() asm volatile("s_waitcnt vmcnt(0)" ::: "memory")
#define SBAR() __builtin_amdgcn_sched_barrier(0)

constexpr int M = 16384, D = 2048, DEPTH = 2, MEM_LEN = 256;
constexpr int NIN = 11264, NIN_BF = 3072  , NIN_G8 = 8192  ;
constexpr int NIN_SRC = 11072;
constexpr int DFF = 5632, NEXP = 8;
constexpr int SSM_L = 32, SSM_NCH = M / SSM_L  , SSM_KX = 640  ;
constexpr float LN_EPS = 1e-5f, RMS_EPS = 1e-6f;
constexpr float ALPHA = 1.4142135623730951f;
constexpr float LOG2E = 1.4426950408889634f;
constexpr float C2_DIFF = 0.125f * LOG2E;
constexpr float C2_MLA = 0.07216878364870323f * LOG2E;
constexpr float C2_X = 0.08838834764831845f * LOG2E;
constexpr int MOE_MAXROWS = 34816;

typedef __bf16 bf16x2_t __attribute__((ext_vector_type(2)));
__device__ __forceinline__ unsigned cvt_pk_bf16(float lo, float hi) { const f32x2 v = {lo, hi}; const bf16x2_t b = __builtin_convertvector(v, bf16x2_t); return __builtin_bit_cast(unsigned, b); }
__device__ __forceinline__ float bf_lo(unsigned w) { return __uint_as_float(w << 16); }
__device__ __forceinline__ float bf_hi(unsigned w) { return __uint_as_float(w & 0xffff0000u); }
__device__ __forceinline__ u32x4 pack8(f32x4 a, f32x4 b) { u32x4 w; w.x = cvt_pk_bf16(a[0], a[1]); w.y = cvt_pk_bf16(a[2], a[3]); w.z = cvt_pk_bf16(b[0], b[1]); w.w = cvt_pk_bf16(b[2], b[3]); return w; }
__device__ __forceinline__ u32x2 pack8_fp8(f32x4 a, f32x4 b) { int w0 = 0, w1 = 0;
    w0 = __builtin_amdgcn_cvt_pk_fp8_f32(a[0], a[1], w0, false); w0 = __builtin_amdgcn_cvt_pk_fp8_f32(a[2], a[3], w0, true);
    w1 = __builtin_amdgcn_cvt_pk_fp8_f32(b[0], b[1], w1, false); w1 = __builtin_amdgcn_cvt_pk_fp8_f32(b[2], b[3], w1, true);
    u32x2 r; r.x = (unsigned)w0; r.y = (unsigned)w1; return r; }
__device__ __forceinline__ float fast_sigmoid(float x) { return __builtin_amdgcn_rcpf(1.f + __builtin_amdgcn_exp2f(-x * LOG2E)); }
constexpr int LDS_WTAB = 131072 + 8192 + 1024;
__device__ __forceinline__ int opaque_tid() {
    const unsigned hw = __builtin_amdgcn_s_getreg(0x2804);
    const int wave = __builtin_amdgcn_readfirstlane(((volatile LAS int*)LDS_WTAB)[hw]);
    int lane; asm volatile("v_mbcnt_lo_u32_b32 %0, -1, 0\n\tv_mbcnt_hi_u32_b32 %0, -1, %0" : "=v"(lane));
    return wave * 64 + lane;
}
__device__ __forceinline__ float shflx(float v, int off, int lane) { return __int_as_float(__builtin_amdgcn_ds_bpermute((lane ^ off) << 2, __float_as_int(v))); }
__device__ __forceinline__ float wave_sum(float v, int lane) {
#pragma unroll
    for (int o = 1; o < 64; o <<= 1) v += shflx(v, o, lane);
    return v;
}

namespace pg8 {
constexpr int BM = 256, BK = 64, HALF = 128, HTB = HALF * BK * 2, STAGE_BYTES = 8 * HTB, NXCD = 8, WGM = 8;
__host__ __device__ __forceinline__ int lds_byte(int r, int c) { const int st = (r >> 4) * 2 + (c >> 5), rr = r & 15, cc = c & 31, ob = rr * 64 + cc * 2; return st * 1024 + (ob ^ (((ob >> 9) & 1) << 5)); }
__host__ __device__ __forceinline__ void stage_rc(int b, int& R, int& C) { const int st = b / 1024, sb = b % 1024, swz = sb ^ (((sb >> 9) & 1) << 5); R = (st >> 1) * 16 + swz / 64; C = (st & 1) * 32 + (swz % 64) / 2; }
__host__ __device__ __forceinline__ int perm32(int rho) { const int n = rho >> 4, i = rho & 15; return 8 * (i >> 2) + 4 * n + (i & 3); }

__device__ __forceinline__ size_t uni64(size_t v) { const unsigned lo_ = __builtin_amdgcn_readfirstlane((unsigned)v), hi_ = __builtin_amdgcn_readfirstlane((unsigned)(v >> 32)); return ((size_t)hi_ << 32) | lo_; }
struct Unit { int pm, pn, z; size_t offA, offB; };
struct Gemm { const void* A; const void* Bt; int ldaB, ldbB, KB; int wscale; };
typedef int v8i __attribute__((ext_vector_type(8)));
typedef int v4i __attribute__((ext_vector_type(4)));

struct TileOrder {
    int nM, nN, nwg;
    __device__ __forceinline__ void init(int nM_, int nN_) { nM = nM_; nN = nN_; nwg = nM * nN; }
    __device__ __forceinline__ bool map(long L, int& pm, int& pn) const {
        if (L >= nwg) return false;
        int wgid = (int)L; { const int q = nwg / NXCD, r = nwg % NXCD, xcd = wgid % NXCD, off = wgid / NXCD; wgid = (xcd < r ? xcd * (q + 1) : r * (q + 1) + (xcd - r) * q) + off; }
        const int nig = WGM * nN, gid = wgid / nig, fm = gid * WGM, gsz = (nM - fm) < WGM ? (nM - fm) : WGM;
        pm = __builtin_amdgcn_readfirstlane(fm + ((wgid % nig) % gsz)); pn = __builtin_amdgcn_readfirstlane((wgid % nig) / gsz); return true;
    }
};

template <bool FP8, int WSC, class Epi, class Sched>
__device__ __forceinline__ void gemm_phase_t(LAS unsigned char* lds, const Gemm g, const Sched& S, const Epi& E) {
    const int tid = opaque_tid(), wid = __builtin_amdgcn_readfirstlane(tid >> 6), lane = tid & 63, wr = wid >> 2, wc = wid & 3, fr = lane & 15, fq = lane >> 4;
    const int nt = g.KB / (BK * 2);
    unsigned voffA[2], voffB[2];
#pragma unroll
    for (int i = 0; i < 2; ++i) { int R, C; stage_rc(tid * 16 + i * 8192, R, C); const int Rb = (R & ~31) + perm32(R & 31);
        voffA[i] = (unsigned)(R * g.ldaB + C * 2); voffB[i] = (unsigned)(Rb * g.ldbB + C * 2); }
    const size_t kstep = (size_t)(BK * 2);
    const size_t hstepA = (size_t)HALF * g.ldaB, hstepB = (size_t)HALF * g.ldbB;
    const unsigned ldsw = (unsigned)wid * 1024u;
    const unsigned lds_u = __builtin_amdgcn_readfirstlane((unsigned)(uintptr_t)lds + ldsw);
    const int aoff = lds_byte(wr * 64 + fr, fq * 8), boff = lds_byte(wc * 32 + fr, fq * 8);
#define PG8_SA(b, h) (((b) * 2 + (h)) * HTB)
#define PG8_SB(b, h) ((4 + (b) * 2 + (h)) * HTB)
#define PG8_STAGE(bufoff, gbase, voff) do { _Pragma("unroll") for (int _i = 0; _i < 2; ++_i) \
        { unsigned _keep; asm volatile("s_mov_b32 %0, m0\n\ts_mov_b32 m0, %1\n\ts_nop 0\n\tglobal_load_lds_dwordx4 %2, %3\n\ts_mov_b32 m0, %0" : "=&s"(_keep) : "s"(lds_u + (unsigned)((bufoff) + _i * 8192)), "v"((voff)[_i]), "s"(gbase) : "memory"); } } while (0)
#define PG8_LD32(p) __builtin_shufflevector(*(const LAS v4i*)(p), *(const LAS v4i*)((p) + 1024), 0, 1, 2, 3, 4, 5, 6, 7)
#define PG8_LDA(dst, b, h) do { _Pragma("unroll") for (int m = 0; m < 4; ++m) dst[m] = PG8_LD32(lds + PG8_SA(b, h) + aoff + m * 2048); } while (0)
#define PG8_LDB(dst, b, h) do { _Pragma("unroll") for (int n = 0; n < 2; ++n) dst[n] = PG8_LD32(lds + PG8_SB(b, h) + boff + n * 2048); } while (0)
#define PG8_H0(x) __builtin_bit_cast(bf16x8, __builtin_shufflevector((x), (x), 0, 1, 2, 3))
#define PG8_H1(x) __builtin_bit_cast(bf16x8, __builtin_shufflevector((x), (x), 4, 5, 6, 7))
#define PG8_MMA(ai, bj, At, Bt) do { __builtin_amdgcn_s_setprio(1); _Pragma("unroll") for (int m = 0; m < 4; ++m) _Pragma("unroll") for (int n = 0; n < 2; ++n) { \
        if constexpr (FP8) asm volatile("v_mfma_scale_f32_16x16x128_f8f6f4 %0, %1, %2, %0, %3, %3 op_sel_hi:[0,0,0]" : "+v"(acc[ai][bj][m][n]) : "v"(Bt[n]), "v"(At[m]), "v"(wsc_v));     \
        else { acc[ai][bj][m][n] = __builtin_amdgcn_mfma_f32_16x16x32_bf16(PG8_H0(Bt[n]), PG8_H0(At[m]), acc[ai][bj][m][n], 0, 0, 0); acc[ai][bj][m][n] = __builtin_amdgcn_mfma_f32_16x16x32_bf16(PG8_H1(Bt[n]), PG8_H1(At[m]), acc[ai][bj][m][n], 0, 0, 0); } } \
        __builtin_amdgcn_s_setprio(0); } while (0)
#define PG8_WAIT_V(n) asm volatile("s_waitcnt vmcnt(" #n ")" ::: "memory")
#define PG8_WAIT_L(n) asm volatile("s_waitcnt lgkmcnt(" #n ")" ::: "memory")
#define PG8_BAR __builtin_amdgcn_s_barrier()
#define PG8_SCHED __builtin_amdgcn_sched_barrier(0)
    Unit cur, nxt; int ui = 0;
    if (!S.next(0, cur)) return;
    f32x4 acc[2][2][4][2];
#pragma unroll
    for (int a = 0; a < 2; ++a)
#pragma unroll
        for (int b = 0; b < 2; ++b)
#pragma unroll
            for (int m = 0; m < 4; ++m)
#pragma unroll
                for (int n = 0; n < 2; ++n) acc[a][b][m][n] = (f32x4){0.f, 0.f, 0.f, 0.f};
    v8i At[4], B0[2], B1[2]; const int wsc_v = WSC; (void)wsc_v;
    const char* cA = (const char*)g.A + uni64(cur.offA); const char* cB = (const char*)g.Bt + uni64(cur.offB);
    PG8_STAGE(PG8_SB(0, 0), cB, voffB); PG8_STAGE(PG8_SB(0, 1), cB + hstepB, voffB); PG8_STAGE(PG8_SA(0, 0), cA, voffA); PG8_STAGE(PG8_SA(0, 1), cA + hstepA, voffA);
    if (wr == 1) PG8_BAR;
    PG8_WAIT_V(2); PG8_BAR;
    PG8_STAGE(PG8_SB(1, 0), cB + kstep, voffB); PG8_STAGE(PG8_SA(1, 0), cA + kstep, voffA); PG8_STAGE(PG8_SB(1, 1), cB + hstepB + kstep, voffB);
    PG8_WAIT_V(6); PG8_BAR;
    for (;;) {
        const bool has_next = S.next(ui + 1, nxt);
        const char* nA = has_next ? (const char*)g.A + uni64(nxt.offA) : cA; const char* nB = has_next ? (const char*)g.Bt + uni64(nxt.offB) : cB;
        for (int t = 0; t < nt; t += 2) {
            const bool last = (t == nt - 2);
            const char* a1 = cA + (size_t)(t + 1) * kstep;
            const char* a2 = last ? nA : cA + (size_t)(t + 2) * kstep; const char* b2 = last ? nB : cB + (size_t)(t + 2) * kstep;
            const char* a3 = a2 + kstep; const char* b3 = b2 + kstep;
            PG8_LDB(B0, 0, 0); PG8_LDB(B1, 0, 1); PG8_SCHED; PG8_LDA(At, 0, 0); PG8_STAGE(PG8_SA(1, 1), a1 + hstepA, voffA);
            PG8_WAIT_V(8); PG8_WAIT_L(0); PG8_BAR; PG8_MMA(0, 0, At, B0); PG8_MMA(0, 1, At, B1); PG8_BAR; PG8_SCHED;
            PG8_LDA(At, 0, 1); PG8_STAGE(PG8_SB(0, 0), b2, voffB); PG8_STAGE(PG8_SB(0, 1), b2 + hstepB, voffB); PG8_STAGE(PG8_SA(0, 0), a2, voffA);
            PG8_WAIT_V(8); PG8_WAIT_L(0); PG8_BAR; PG8_MMA(1, 0, At, B0); PG8_MMA(1, 1, At, B1); PG8_BAR; PG8_SCHED;
            PG8_LDB(B0, 1, 0); PG8_LDB(B1, 1, 1); PG8_SCHED; PG8_LDA(At, 1, 0); PG8_STAGE(PG8_SA(0, 1), a2 + hstepA, voffA);
            PG8_WAIT_V(8); PG8_WAIT_L(0); PG8_BAR; PG8_MMA(0, 0, At, B0); PG8_MMA(0, 1, At, B1); PG8_BAR; PG8_SCHED;
            PG8_LDA(At, 1, 1); PG8_STAGE(PG8_SB(1, 0), b3, voffB); PG8_STAGE(PG8_SB(1, 1), b3 + hstepB, voffB); PG8_STAGE(PG8_SA(1, 0), a3, voffA);
            PG8_WAIT_V(8); PG8_WAIT_L(0); PG8_BAR; PG8_MMA(1, 0, At, B0); PG8_MMA(1, 1, At, B1); PG8_BAR; PG8_SCHED;
        }
        if (wr == 0) PG8_BAR;
        if constexpr (FP8) asm volatile("s_nop 15\n\ts_nop 15" ::: "memory");
        E(acc, cur, wr, wc, fr, fq);
        if (!has_next) break;
#pragma unroll
        for (int a = 0; a < 2; ++a)
#pragma unroll
            for (int b = 0; b < 2; ++b)
#pragma unroll
                for (int m = 0; m < 4; ++m)
#pragma unroll
                    for (int n = 0; n < 2; ++n) acc[a][b][m][n] = (f32x4){0.f, 0.f, 0.f, 0.f};
        cur = nxt; cA = nA; cB = nB; ++ui;
        if (wr == 1) PG8_BAR;
    }
    PG8_WAIT_V(0);
    PG8_BAR;
#undef PG8_SA
#undef PG8_SB
#undef PG8_STAGE
#undef PG8_LDA
#undef PG8_LDB
#undef PG8_MMA
#undef PG8_H0
#undef PG8_H1
#undef PG8_LD32
#undef PG8_WAIT_V
#undef PG8_WAIT_L
#undef PG8_BAR
#undef PG8_SCHED
}
template <class Epi, class Sched> __device__ __forceinline__ void gemm_phase(LAS unsigned char* lds, const Gemm g, const Sched& S, const Epi& E) { gemm_phase_t<false, 0>(lds, g, S, E); }
}

struct SchedPlain {
    pg8::TileOrder T; int G, c; size_t tA, tB;
    __device__ __forceinline__ void init(int nM, int nN, int lda, int ldb, int G_, int c_) { T.init(nM, nN); G = G_; c = c_; tA = (size_t)256 * lda * 2; tB = (size_t)256 * ldb * 2; }
    __device__ __forceinline__ bool next(int i, pg8::Unit& u) const { if (!T.map((long)i * G + c, u.pm, u.pn)) return false; u.z = 0; u.offA = u.pm * tA; u.offB = u.pn * tB; return true; }
};
struct SchedBatch {
    int nM, nN, nZ, G, c; size_t tA, tB, zA, zB;
    __device__ __forceinline__ bool next(int i, pg8::Unit& u) const {
        const long L = (long)i * G + c; const int per = nM * nN; if (L >= (long)per * nZ) return false;
        const int z = __builtin_amdgcn_readfirstlane((int)(L / per)), r = __builtin_amdgcn_readfirstlane((int)(L % per)); u.z = z; u.pm = __builtin_amdgcn_readfirstlane(r / nN); u.pn = __builtin_amdgcn_readfirstlane(r % nN); u.offA = z * zA + u.pm * tA; u.offB = z * zB + u.pn * tB; return true; }
};
struct SchedBranch {
    pg8::TileOrder T; int G, c; size_t tA, tB, zA, zB;
    __device__ __forceinline__ bool next(int i, pg8::Unit& u) const { const int t = i / 3, z = i - 3 * t; if (!T.map((long)t * G + c, u.pm, u.pn)) return false; u.z = z; u.offA = z * zA + u.pm * tA; u.offB = z * zB + u.pn * tB; return true; }
};
struct SchedMoe {
    pg8::TileOrder T; int G, c; size_t tA, tB, zB; int off[7];
    __device__ __forceinline__ bool next(int i, pg8::Unit& u) const {
        if (!T.map((long)i * G + c, u.pm, u.pn)) return false; const int r0 = u.pm * 256; int e = 0;
#pragma unroll
        for (int k = 0; k < 7; ++k) e += (r0 >= off[k]) ? 1 : 0;
        e = __builtin_amdgcn_readfirstlane(e); u.z = e; u.offA = u.pm * tA; u.offB = e * zB + u.pn * tB; return true; }
};

#define EPI_ARGS const f32x4 (&acc)[2][2][4][2], const pg8::Unit& u, int wr, int wc, int fr, int fq
#define EPI_ROW(ai, m) (u.pm * 256 + (ai) * 128 + wr * 64 + (m) * 16 + fr)
#define EPI_CB(bj) ((bj) * 128 + wc * 32 + fq * 8)
#define FOR_AI_M _Pragma("unroll") for (int ai = 0; ai < 2; ++ai) _Pragma("unroll") for (int m = 0; m < 4; ++m)
#define FOR_BJ _Pragma("unroll") for (int bj = 0; bj < 2; ++bj)

__device__ __forceinline__ void rope4(f32x4& v0, f32x4& v1, const f32x4 t0, const f32x4 t1) {
    const float a0 = v0[0] * t0[0] - v0[1] * t0[1], b0 = v0[1] * t0[0] + v0[0] * t0[1];
    const float a1 = v0[2] * t0[2] - v0[3] * t0[3], b1 = v0[3] * t0[2] + v0[2] * t0[3];
    const float a2 = v1[0] * t1[0] - v1[1] * t1[1], b2 = v1[1] * t1[0] + v1[0] * t1[1];
    const float a3 = v1[2] * t1[2] - v1[3] * t1[3], b3 = v1[3] * t1[2] + v1[2] * t1[3];
    v0 = (f32x4){a0, b0, a1, b1}; v1 = (f32x4){a2, b2, a3, b3};
}

struct EpiInProj {
    bf16_t *QD, *KD, *VD, *MQ, *MKV, *KM, *SU, *GATES; float *ssq_q, *ssq_kv; const float* tabd; const float* tabm;
    int pn_add;
    __device__ __forceinline__ void operator()(EPI_ARGS) const {
        const int pn = u.pn + pn_add;
        if (pn < 8) {
            bf16_t* O = pn < 4 ? QD : KD; const float sc = pn < 4 ? C2_DIFF : 1.f; const int colt = (pn & 3) * 256;
            const bool rp = ((wc & 1) == 0) && fq < 2;
#pragma unroll
            for (int ai = 0; ai < 2; ++ai) { f32x4 tt[4][2];
#pragma unroll
                for (int m = 0; m < 4; ++m) { tt[m][0] = (f32x4){1.f, 0.f, 1.f, 0.f}; tt[m][1] = (f32x4){1.f, 0.f, 1.f, 0.f};
                    if (rp) { const f32x4* tp = (const f32x4*)(tabd + (size_t)EPI_ROW(ai, m) * 16 + fq * 8); tt[m][0] = tp[0]; tt[m][1] = tp[1]; } }
#pragma unroll
                for (int m = 0; m < 4; ++m) { const int row = EPI_ROW(ai, m);
                    FOR_BJ { f32x4 v0 = acc[ai][bj][m][0], v1 = acc[ai][bj][m][1]; rope4(v0, v1, tt[m][0], tt[m][1]); v0 = v0 * sc; v1 = v1 * sc;
                        *(u32x4*)(O + (size_t)row * 1024 + colt + EPI_CB(bj)) = pack8(v0, v1); } } }
        } else if (pn < 12) {
            const int colt = (pn - 8) * 256;
            FOR_AI_M { const int row = EPI_ROW(ai, m); FOR_BJ { *(u32x4*)(VD + (size_t)row * 1024 + colt + EPI_CB(bj)) = pack8(acc[ai][bj][m][0], acc[ai][bj][m][1]); } }
        } else if (pn < 15) {
            bf16_t* O = pn < 14 ? MQ : MKV; const int ld = pn < 14 ? 512 : 256, colt = pn < 14 ? (pn - 12) * 256 : 0; float* ssq = pn < 14 ? ssq_q + (pn - 12) * 4 + wc : ssq_kv + wc; const int ns = pn < 14 ? 8 : 4;
            FOR_AI_M { const int row = EPI_ROW(ai, m); float s = 0.f;
                FOR_BJ { const f32x4 v0 = acc[ai][bj][m][0], v1 = acc[ai][bj][m][1]; s += (v0[0] * v0[0] + v0[1] * v0[1]) + (v0[2] * v0[2] + v0[3] * v0[3]) + (v1[0] * v1[0] + v1[1] * v1[1]) + (v1[2] * v1[2] + v1[3] * v1[3]);
                    *(u32x4*)(O + (size_t)row * ld + colt + EPI_CB(bj)) = pack8(v0, v1); }
                s += shflx(s, 16, fq * 16 + fr); s += shflx(s, 32, fq * 16 + fr);
                if (fq == 0) ssq[(size_t)row * ns] = s; }
        } else if (pn == 15) {
            if (wc < 2) {
                FOR_AI_M { const int row = EPI_ROW(ai, m); const f32x4* tp = (const f32x4*)(tabm + (size_t)row * 64 + (wc * 16 + fq * 4) * 2);
                    f32x4 v0 = acc[ai][0][m][0], v1 = acc[ai][0][m][1]; rope4(v0, v1, tp[0], tp[1]); const u32x4 w = pack8(v0, v1);
#pragma unroll
                    for (int h = 0; h < 8; ++h) *(u32x4*)(KM + (size_t)row * 1536 + h * 192 + 128 + wc * 32 + fq * 8) = w; }
            }
        } else if (pn < 20) {
            FOR_AI_M { const int row = EPI_ROW(ai, m); const int c = row >> 5, j = row & 31;
                FOR_BJ { const int ch = (pn - 16) * 256 + EPI_CB(bj), g = ch >> 4, q = ch & 15;
                    *(u32x4*)(SU + ((size_t)(g * SSM_NCH + c) * SSM_KX + j * 16 + q)) = pack8(acc[ai][bj][m][0], acc[ai][bj][m][1]); } }
        } else {
            const int colt = (pn - 20) * 256;
            FOR_AI_M { const int row = EPI_ROW(ai, m);
                FOR_BJ { f32x4 v0 = acc[ai][bj][m][0], v1 = acc[ai][bj][m][1];
#pragma unroll
                    for (int e = 0; e < 4; ++e) { v0[e] = fast_sigmoid(v0[e]); v1[e] = fast_sigmoid(v1[e]); }
                    *(u32x4*)(GATES + (size_t)row * 6144 + colt + EPI_CB(bj)) = pack8(v0, v1); } }
        }
    }
};
struct EpiQup {
    bf16_t* QM; const float* ssq; const float* tabm;
    __device__ __forceinline__ void operator()(EPI_ARGS) const {
#pragma unroll
        for (int ai = 0; ai < 2; ++ai) { f32x4 sq[4][2];
#pragma unroll
            for (int m = 0; m < 4; ++m) { const int row = EPI_ROW(ai, m); sq[m][0] = *(const f32x4*)(ssq + (size_t)row * 8); sq[m][1] = *(const f32x4*)(ssq + (size_t)row * 8 + 4); }
#pragma unroll
            for (int m = 0; m < 4; ++m) { const int row = EPI_ROW(ai, m); const f32x4 s0 = sq[m][0], s1 = sq[m][1];
                const float rq = __builtin_amdgcn_rsqf((((s0[0] + s0[1]) + (s0[2] + s0[3])) + ((s1[0] + s1[1]) + (s1[2] + s1[3]))) * (1.f / 512.f) + RMS_EPS) * C2_MLA;
                FOR_BJ { const int col = u.pn * 256 + EPI_CB(bj), h = col / 192, hc = col - h * 192; f32x4 v0 = acc[ai][bj][m][0], v1 = acc[ai][bj][m][1];
                    if (hc >= 128) { const f32x4* tp = (const f32x4*)(tabm + (size_t)row * 64 + (hc - 128)); rope4(v0, v1, tp[0], tp[1]); }
                    v0 = v0 * rq; v1 = v1 * rq; *(u32x4*)(QM + (size_t)row * 1536 + col) = pack8(v0, v1); } } }
    }
};
struct EpiKVup {
    bf16_t *KM, *VM; const float* ssq;
    __device__ __forceinline__ void operator()(EPI_ARGS) const {
#pragma unroll
        for (int ai = 0; ai < 2; ++ai) { float rk[4];
#pragma unroll
            for (int m = 0; m < 4; ++m) { const f32x4 s0 = *(const f32x4*)(ssq + (size_t)EPI_ROW(ai, m) * 4); rk[m] = ((s0[0] + s0[1]) + (s0[2] + s0[3])); }
#pragma unroll
            for (int m = 0; m < 4; ++m) { const int row = EPI_ROW(ai, m); const float r = __builtin_amdgcn_rsqf(rk[m] * (1.f / 256.f) + RMS_EPS); const int c = wc * 32 + fq * 8;
                *(u32x4*)(KM + (size_t)row * 1536 + u.pn * 192 + c) = pack8(acc[ai][0][m][0] * r, acc[ai][0][m][1] * r);
                *(u32x4*)(VM + (size_t)row * 1024 + u.pn * 128 + c) = pack8(acc[ai][1][m][0] * r, acc[ai][1][m][1] * r); } }
    }
};
struct EpiSloc {
    float* SLOC;
    __device__ __forceinline__ void operator()(EPI_ARGS) const {
        FOR_AI_M { const int c = EPI_ROW(ai, m); float* o = SLOC + ((size_t)(u.z * SSM_NCH + c) * 128 + wc * 32 + fq * 8);
            *(f32x4*)o = acc[ai][0][m][0]; *(f32x4*)(o + 4) = acc[ai][0][m][1]; }
    }
};
__device__ __forceinline__ float gelu_tanh(float x) { const float t = 1.5957691216057308f * (x + 0.044715f * x * x * x); return x * fast_sigmoid(t); }
struct EpiSsmY {
    bf16_t* YG; const bf16_t* SU; const float* dskip;
    __device__ __forceinline__ void operator()(EPI_ARGS) const {
        const int g = u.z; f32x4 d0[2], d1[2];
        FOR_BJ { const int col = u.pn * 256 + EPI_CB(bj), ch = g * 16 + (col & 15); d0[bj] = *(const f32x4*)(dskip + ch); d1[bj] = *(const f32x4*)(dskip + ch + 4); }
#pragma unroll
        for (int ai = 0; ai < 2; ++ai) { u32x4 uu[4][2];
#pragma unroll
            for (int m = 0; m < 4; ++m) { const int c = EPI_ROW(ai, m);
                FOR_BJ { const int col = u.pn * 256 + EPI_CB(bj), i = col >> 4, p0 = col & 15; uu[m][bj] = *(const u32x4*)(SU + ((size_t)(g * SSM_NCH + c) * SSM_KX + i * 16 + p0)); } }
#pragma unroll
            for (int m = 0; m < 4; ++m) { const int c = EPI_ROW(ai, m);
                FOR_BJ { const int col = u.pn * 256 + EPI_CB(bj), i = col >> 4, p0 = col & 15, t = c * SSM_L + i, ch = g * 16 + p0; const u32x4 w = uu[m][bj];
                    f32x4 v0 = acc[ai][bj][m][0], v1 = acc[ai][bj][m][1];
                    v0[0] += d0[bj][0] * bf_lo(w.x); v0[1] += d0[bj][1] * bf_hi(w.x); v0[2] += d0[bj][2] * bf_lo(w.y); v0[3] += d0[bj][3] * bf_hi(w.y);
                    v1[0] += d1[bj][0] * bf_lo(w.z); v1[1] += d1[bj][1] * bf_hi(w.z); v1[2] += d1[bj][2] * bf_lo(w.w); v1[3] += d1[bj][3] * bf_hi(w.w);
#pragma unroll
                    for (int e = 0; e < 4; ++e) { v0[e] = gelu_tanh(v0[e]); v1[e] = gelu_tanh(v1[e]); }
                    *(u32x4*)(YG + (size_t)t * 1024 + ch) = pack8(v0, v1); } } }
    }
};
template <int ACT  > struct EpiGated {
    bf16_t* O; int ldo;
    __device__ __forceinline__ void operator()(EPI_ARGS) const {
        FOR_AI_M { const int row = EPI_ROW(ai, m); f32x4 r[2];
#pragma unroll
            for (int n = 0; n < 2; ++n)
#pragma unroll
                for (int e = 0; e < 4; ++e) { const float a = acc[ai][0][m][n][e], b = acc[ai][1][m][n][e]; r[n][e] = ACT == 0 ? a * fast_sigmoid(b) : a * fast_sigmoid(a) * b; }
            *(u32x4*)(O + (size_t)row * ldo + u.pn * 128 + wc * 32 + fq * 8) = pack8(r[0], r[1]); }
    }
};
struct EpiSwigluF8 {
    unsigned char* O; int ldo;
    __device__ __forceinline__ void operator()(EPI_ARGS) const {
        FOR_AI_M { const int row = EPI_ROW(ai, m); f32x4 r[2];
#pragma unroll
            for (int n = 0; n < 2; ++n)
#pragma unroll
                for (int e = 0; e < 4; ++e) { const float a = acc[ai][0][m][n][e], b = acc[ai][1][m][n][e]; r[n][e] = a * fast_sigmoid(a) * b; }
            *(u32x2*)(O + (size_t)row * ldo + u.pn * 128 + wc * 32 + fq * 8) = pack8_fp8(r[0], r[1]); }
    }
};
struct EpiGatesF8 {
    bf16_t* GATES;
    __device__ __forceinline__ void operator()(EPI_ARGS) const {
        FOR_AI_M { const int row = EPI_ROW(ai, m);
            FOR_BJ { f32x4 v0 = acc[ai][bj][m][0], v1 = acc[ai][bj][m][1];
#pragma unroll
                for (int e = 0; e < 4; ++e) { v0[e] = fast_sigmoid(v0[e]); v1[e] = fast_sigmoid(v1[e]); }
                *(u32x4*)(GATES + (size_t)row * 6144 + u.pn * 256 + EPI_CB(bj)) = pack8(v0, v1); } }
    }
};
struct EpiBranch {
    const bf16_t* GATES; bf16_t* P; bf16_t* MG;
    __device__ __forceinline__ void operator()(EPI_ARGS) const {
        const int z = u.z;
#pragma unroll
        for (int ai = 0; ai < 2; ++ai)
#pragma unroll
            for (int mh = 0; mh < 2; ++mh) { u32x4 gg[2][2], pa[2][2], pb[2][2];
#pragma unroll
                for (int mm = 0; mm < 2; ++mm) { const int row = EPI_ROW(ai, mh * 2 + mm);
                    FOR_BJ { const int col = u.pn * 256 + EPI_CB(bj); gg[mm][bj] = *(const u32x4*)(GATES + (size_t)row * 6144 + z * 2048 + col);
                        if (z == 2) { const size_t o = (size_t)row * 2048 + col; pa[mm][bj] = *(const u32x4*)(P + o); pb[mm][bj] = *(const u32x4*)(P + (size_t)M * 2048 + o); } } }
#pragma unroll
                for (int mm = 0; mm < 2; ++mm) { const int m = mh * 2 + mm, row = EPI_ROW(ai, m);
                    FOR_BJ { const int col = u.pn * 256 + EPI_CB(bj); const u32x4 g = gg[mm][bj];
                        f32x4 v0 = acc[ai][bj][m][0], v1 = acc[ai][bj][m][1];
                        v0[0] *= bf_lo(g.x); v0[1] *= bf_hi(g.x); v0[2] *= bf_lo(g.y); v0[3] *= bf_hi(g.y);
                        v1[0] *= bf_lo(g.z); v1[1] *= bf_hi(g.z); v1[2] *= bf_lo(g.w); v1[3] *= bf_hi(g.w);
                        const size_t o = (size_t)row * 2048 + col;
                        if (z < 2) *(u32x4*)(P + (size_t)z * M * 2048 + o) = pack8(v0, v1);
                        else { const u32x4 a = pa[mm][bj], b = pb[mm][bj];
                            v0[0] += bf_lo(a.x) + bf_lo(b.x); v0[1] += bf_hi(a.x) + bf_hi(b.x); v0[2] += bf_lo(a.y) + bf_lo(b.y); v0[3] += bf_hi(a.y) + bf_hi(b.y);
                            v1[0] += bf_lo(a.z) + bf_lo(b.z); v1[1] += bf_hi(a.z) + bf_hi(b.z); v1[2] += bf_lo(a.w) + bf_lo(b.w); v1[3] += bf_hi(a.w) + bf_hi(b.w);
                            *(u32x4*)(MG + o) = pack8(v0, v1); } } } }
    }
};
struct EpiResid {
    bf16_t* X;
    __device__ __forceinline__ void operator()(EPI_ARGS) const {
#pragma unroll
        for (int ai = 0; ai < 2; ++ai) { u32x4 r[4][2];
#pragma unroll
            for (int m = 0; m < 4; ++m) { const int row = EPI_ROW(ai, m);
                FOR_BJ { r[m][bj] = *(const u32x4*)(X + (size_t)row * 2048 + u.pn * 256 + EPI_CB(bj)); } }
#pragma unroll
            for (int m = 0; m < 4; ++m) { const int row = EPI_ROW(ai, m);
                FOR_BJ { const u32x4 w = r[m][bj]; f32x4 v0 = acc[ai][bj][m][0], v1 = acc[ai][bj][m][1];
                    v0[0] += ALPHA * bf_lo(w.x); v0[1] += ALPHA * bf_hi(w.x); v0[2] += ALPHA * bf_lo(w.y); v0[3] += ALPHA * bf_hi(w.y);
                    v1[0] += ALPHA * bf_lo(w.z); v1[1] += ALPHA * bf_hi(w.z); v1[2] += ALPHA * bf_lo(w.w); v1[3] += ALPHA * bf_hi(w.w);
                    *(u32x4*)(X + (size_t)row * 2048 + u.pn * 256 + EPI_CB(bj)) = pack8(v0, v1); } } }
    }
};
struct EpiBf16 {
    bf16_t* O; int ldo; float scale;
    __device__ __forceinline__ void operator()(EPI_ARGS) const {
        FOR_AI_M { const int row = EPI_ROW(ai, m); FOR_BJ { *(u32x4*)(O + (size_t)row * ldo + u.pn * 256 + EPI_CB(bj)) = pack8(acc[ai][bj][m][0] * scale, acc[ai][bj][m][1] * scale); } }
    }
};
struct EpiBf16Half {
    bf16_t* O; int ldo; float scale;
    __device__ __forceinline__ void operator()(EPI_ARGS) const {
#pragma unroll
        for (int m = 0; m < 4; ++m) { const int row = u.pm * 128 + wr * 64 + m * 16 + fr;
            FOR_BJ { *(u32x4*)(O + (size_t)row * ldo + u.pn * 256 + EPI_CB(bj)) = pack8(acc[0][bj][m][0] * scale, acc[0][bj][m][1] * scale); } }
    }
};
struct EpiMoeDown {
    bf16_t* OG; const float* wslot;
    __device__ __forceinline__ void operator()(EPI_ARGS) const {
        float w[2][4];
        FOR_AI_M w[ai][m] = wslot[EPI_ROW(ai, m)];
        FOR_AI_M { const int row = EPI_ROW(ai, m);
            FOR_BJ { *(u32x4*)(OG + (size_t)row * 2048 + u.pn * 256 + EPI_CB(bj)) = pack8(acc[ai][bj][m][0] * w[ai][m], acc[ai][bj][m][1] * w[ai][m]); } }
    }
};

namespace att {
constexpr int KVBLK = 64, SHM_V = KVBLK * 128 * 2;
constexpr float THRL = 8.f;
__device__ __forceinline__ int crow(int r, int hi) { return (r & 3) + 8 * (r >> 2) + 4 * hi; }
template <int PITCH> __device__ __forceinline__ int kfl(int row) { return (PITCH % 256 == 128) ? ((row >> 1) & 7) : (row & 15); }
template <int PITCH> __device__ __forceinline__ int kswz(int row, int colB) { return row * PITCH + (colB ^ (kfl<PITCH>(row) << 4)); }
__device__ __forceinline__ int v_st(int k, int c) { const int kk = k; return ((kk >> 3) * 4 + (c >> 5)) * 512 + ((kk & 7) * 32 + (c & 31)) * 2; }
__device__ __forceinline__ int v_rd_base(int lane) { return ((lane & 3) << 3) | (((lane >> 2) & 3) << 6) | (((lane >> 4) & 1) << 5) | (((lane >> 5) & 1) << 8); }
constexpr int v_rd_off(int d0, int ks, int half) { return d0 * 512 + ks * 4096 + half * 2048; }

__device__ __forceinline__ void mask_tile(f32x16& p0, f32x16& p1, int dq) {
    const float NEG = -__builtin_inff();
#pragma unroll
    for (int r = 0; r < 16; ++r) { const int c = (r & 3) + 8 * (r >> 2); if (dq - c < 0) p0[r] = NEG; if (dq - c - 32 < 0) p1[r] = NEG; }
}
__device__ __forceinline__ void partialSM(f32x16& p0, f32x16& p1, float& m_reg, float& alpha) {
    float pmax = p0[0];
#pragma unroll
    for (int r = 1; r < 16; ++r) pmax = fmaxf(pmax, p0[r]);
#pragma unroll
    for (int r = 0; r < 16; ++r) pmax = fmaxf(pmax, p1[r]);
    { auto rr = __builtin_amdgcn_permlane32_swap(__float_as_uint(pmax), __float_as_uint(pmax), false, false); pmax = fmaxf(__uint_as_float(rr[0]), __uint_as_float(rr[1])); }
    float mn;
    if (__builtin_expect(__all(pmax - m_reg <= THRL), 1)) { mn = m_reg; alpha = 1.f; }
    else { mn = fmaxf(m_reg, pmax); alpha = __builtin_amdgcn_exp2f(m_reg - mn); m_reg = mn; }
#pragma unroll
    for (int r = 0; r < 16; ++r) { p0[r] -= mn; p1[r] -= mn; }
#pragma unroll
    for (int r = 0; r < 16; ++r) p0[r] = __builtin_amdgcn_exp2f(p0[r]);
}
__device__ __forceinline__ void finishSM(f32x16& p0, f32x16& p1, float alpha, float& l_reg, bf16x8& pa0, bf16x8& pa1, bf16x8& pa2, bf16x8& pa3) {
#pragma unroll
    for (int r = 0; r < 16; ++r) p1[r] = __builtin_amdgcn_exp2f(p1[r]);
    float ps = 0;
#pragma unroll
    for (int r = 0; r < 16; ++r) ps += p0[r];
#pragma unroll
    for (int r = 0; r < 16; ++r) ps += p1[r];
    { auto rr = __builtin_amdgcn_permlane32_swap(__float_as_uint(ps), __float_as_uint(ps), false, false); ps = __uint_as_float(rr[0]) + __uint_as_float(rr[1]); }
    l_reg = l_reg * alpha + ps;
#define PK4(P, B_, OUT) do { unsigned a0 = cvt_pk_bf16(P[B_+0], P[B_+1]), a1 = cvt_pk_bf16(P[B_+2], P[B_+3]); unsigned b0 = cvt_pk_bf16(P[B_+4], P[B_+5]), b1 = cvt_pk_bf16(P[B_+6], P[B_+7]); \
        u32x4 w = {a0, a1, b0, b1}; OUT = *reinterpret_cast<bf16x8*>(&w); } while (0)
    PK4(p0, 0, pa0); PK4(p0, 8, pa1); PK4(p1, 0, pa2); PK4(p1, 8, pa3);
#undef PK4
}
template <int PITCH, int ND0>
__device__ __forceinline__ void qkt(f32x16& p0, f32x16& p1, const char* Kb, int r32, int hi, int kch0, const bf16x8* qr) {
    p0 = f32x16{}; p1 = f32x16{};
    const char* kb[4];
#pragma unroll
    for (int dd = 0; dd < 4; ++dd) kb[dd] = Kb + kswz<PITCH>(r32, (kch0 + dd * 2 + hi) * 16);
#pragma unroll
    for (int d0 = 0; d0 < ND0; ++d0) { const char* a = (PITCH % 256 == 0) ? Kb + kswz<PITCH>(r32, (kch0 + d0 * 2 + hi) * 16) : kb[d0 & 3] + (d0 >> 2) * 128;
        const bf16x8 b0 = *reinterpret_cast<const bf16x8*>(a);
        const bf16x8 b1 = *reinterpret_cast<const bf16x8*>(a + 32 * PITCH);
        p0 = __builtin_amdgcn_mfma_f32_32x32x16_bf16(b0, qr[d0], p0, 0, 0, 0);
        p1 = __builtin_amdgcn_mfma_f32_32x32x16_bf16(b1, qr[d0], p1, 0, 0, 0); }
}
__device__ __forceinline__ void pv_tile(f32x16* o, int vb0, bf16x8 pa0, bf16x8 pa1, bf16x8 pa2, bf16x8 pa3) {
    s16x4 va[8], vb[8];
#define TRRD(dst, off) asm volatile("ds_read_b64_tr_b16 %0, %1 offset:%2" : "=&v"(dst) : "v"(vb0), "i"(off) : "memory")
#define PV_RD(v, d0) do { constexpr int b_ = v_rd_off(d0, 0, 0); TRRD(v[0], b_); TRRD(v[1], b_ + 2048); TRRD(v[2], b_ + 4096); TRRD(v[3], b_ + 6144); TRRD(v[4], b_ + 8192); TRRD(v[5], b_ + 10240); TRRD(v[6], b_ + 12288); TRRD(v[7], b_ + 14336); } while (0)
#define PV_MM(v, d0) do { \
        o[d0] = __builtin_amdgcn_mfma_f32_32x32x16_bf16(pa0, (bf16x8){v[0][0], v[0][1], v[0][2], v[0][3], v[1][0], v[1][1], v[1][2], v[1][3]}, o[d0], 0, 0, 0); \
        o[d0] = __builtin_amdgcn_mfma_f32_32x32x16_bf16(pa1, (bf16x8){v[2][0], v[2][1], v[2][2], v[2][3], v[3][0], v[3][1], v[3][2], v[3][3]}, o[d0], 0, 0, 0); \
        o[d0] = __builtin_amdgcn_mfma_f32_32x32x16_bf16(pa2, (bf16x8){v[4][0], v[4][1], v[4][2], v[4][3], v[5][0], v[5][1], v[5][2], v[5][3]}, o[d0], 0, 0, 0); \
        o[d0] = __builtin_amdgcn_mfma_f32_32x32x16_bf16(pa3, (bf16x8){v[6][0], v[6][1], v[6][2], v[6][3], v[7][0], v[7][1], v[7][2], v[7][3]}, o[d0], 0, 0, 0); } while (0)
#define PV_W8(v) asm volatile("s_waitcnt lgkmcnt(8)" : "+v"(v[0]), "+v"(v[1]), "+v"(v[2]), "+v"(v[3]), "+v"(v[4]), "+v"(v[5]), "+v"(v[6]), "+v"(v[7]) :: "memory")
#define PV_W0(v) asm volatile("s_waitcnt lgkmcnt(0)" : "+v"(v[0]), "+v"(v[1]), "+v"(v[2]), "+v"(v[3]), "+v"(v[4]), "+v"(v[5]), "+v"(v[6]), "+v"(v[7]) :: "memory")
    PV_RD(va, 0); PV_RD(vb, 1); PV_W8(va); SBAR(); PV_MM(va, 0);
    PV_RD(va, 2); PV_W8(vb); SBAR(); PV_MM(vb, 1);
    PV_RD(vb, 3); PV_W8(va); SBAR(); PV_MM(va, 2);
    PV_W0(vb); SBAR(); PV_MM(vb, 3);
#undef PV_W0
#undef PV_W8
#undef PV_MM
#undef PV_RD
#undef TRRD
}

template <int KT, int ND0, bool CAUSAL, bool PIPE>
__device__ __forceinline__ void attn_core(const bf16_t* Qlane, const bf16_t* __restrict__ Kh, int ldk, const bf16_t* __restrict__ Vh, int ldv, int NT, int qpos, int qlo, int kch0,
                                          char* lds, f32x16 (&o)[4], float& l_reg) {
    constexpr int PITCH = KT * 2, SHM_K = KVBLK * PITCH, NKL = KT / 64, CPR = KT / 8;
    const int tid = opaque_tid(), wid = __builtin_amdgcn_readfirstlane(tid >> 6), lane = tid & 63, r32 = lane & 31, hi = lane >> 5;
    char* V_lds = lds; char* K_lds = lds + 2 * SHM_V;
    float* ws = (float*)(lds + 2 * SHM_V + 2 * SHM_K) + wid * 64; float* al_l = ws + 32;
    float m_reg = -1e30f; l_reg = 0.f;
#pragma unroll
    for (int d = 0; d < 4; ++d) o[d] = f32x16{};
    bf16x8 qr[ND0];
#pragma unroll
    for (int d0 = 0; d0 < ND0; ++d0) qr[d0] = *reinterpret_cast<const bf16x8*>(Qlane + d0 * 16);
    const int sr = tid >> 4, sc = (tid & 15) * 8, vst0 = v_st(sr, sc), vst1 = v_st(32 + sr, sc);
    const int vb0 = (int)(uintptr_t)V_lds + v_rd_base(lane);
    int krow[NKL], kcc[NKL];
#pragma unroll
    for (int i = 0; i < NKL; ++i) { const int cid = tid + 512 * i; krow[i] = cid / CPR; kcc[i] = cid - krow[i] * CPR; }
    bf16x8 st_v0, st_v1, st_k[NKL];
#define SLOAD(k0) do { st_v0 = *reinterpret_cast<const bf16x8*>(Vh + (size_t)((k0) + sr) * ldv + sc); st_v1 = *reinterpret_cast<const bf16x8*>(Vh + (size_t)((k0) + 32 + sr) * ldv + sc); \
        _Pragma("unroll") for (int i_ = 0; i_ < NKL; ++i_) st_k[i_] = *reinterpret_cast<const bf16x8*>(Kh + (size_t)((k0) + krow[i_]) * ldk + kcc[i_] * 8); } while (0)
#define SWRITE(b) do { *(bf16x8*)(V_lds + (b) * SHM_V + vst0) = st_v0; *(bf16x8*)(V_lds + (b) * SHM_V + vst1) = st_v1; \
        _Pragma("unroll") for (int i_ = 0; i_ < NKL; ++i_) *(bf16x8*)(K_lds + (b) * SHM_K + kswz<PITCH>(krow[i_], kcc[i_] * 16)) = st_k[i_]; } while (0)
#define RESC(a) do { if (__any((a) < 1.f)) { if (hi == 0) al_l[r32] = (a); asm volatile("s_waitcnt lgkmcnt(0)" ::: "memory"); \
        _Pragma("unroll") for (int d_ = 0; d_ < 4; ++d_) _Pragma("unroll") for (int r = 0; r < 16; ++r) o[d_][r] *= al_l[crow(r, hi)]; } } while (0)
#define MASKT(P0_, P1_, t) do { if (CAUSAL) { const int kb_ = (t) * KVBLK; if (kb_ + KVBLK - 1 > qlo) mask_tile(P0_, P1_, qpos - kb_ - 4 * hi); } } while (0)
    if constexpr (PIPE) {
    f32x16 pA0, pA1, pB0, pB1; float alA, alB; bf16x8 pa0, pa1, pa2, pa3;
    SLOAD(0); VM_WAIT(); SWRITE(0); __syncthreads();
    qkt<PITCH, ND0>(pA0, pA1, K_lds, r32, hi, kch0, qr); MASKT(pA0, pA1, 0); partialSM(pA0, pA1, m_reg, alA);
    SLOAD(KVBLK); VM_WAIT(); SWRITE(1); __syncthreads();
    for (int j = 1; j + 1 < NT; j += 2) {
        SBAR(); qkt<PITCH, ND0>(pB0, pB1, K_lds + SHM_K, r32, hi, kch0, qr);
        finishSM(pA0, pA1, alA, l_reg, pa0, pa1, pa2, pa3); SBAR();
        SLOAD((j + 1) * KVBLK); SBAR();
        pv_tile(o, vb0, pa0, pa1, pa2, pa3); MASKT(pB0, pB1, j); partialSM(pB0, pB1, m_reg, alB);
        __syncthreads(); VM_WAIT(); SWRITE(0);
        RESC(alB); __syncthreads();
        SBAR(); qkt<PITCH, ND0>(pA0, pA1, K_lds, r32, hi, kch0, qr);
        finishSM(pB0, pB1, alB, l_reg, pa0, pa1, pa2, pa3); SBAR();
        SLOAD((j + 2) * KVBLK); SBAR();
        pv_tile(o, vb0 + SHM_V, pa0, pa1, pa2, pa3); MASKT(pA0, pA1, j + 1); partialSM(pA0, pA1, m_reg, alA);
        __syncthreads(); VM_WAIT(); SWRITE(1);
        RESC(alA); __syncthreads();
    }
    SBAR(); qkt<PITCH, ND0>(pB0, pB1, K_lds + SHM_K, r32, hi, kch0, qr);
    finishSM(pA0, pA1, alA, l_reg, pa0, pa1, pa2, pa3); SBAR();
    pv_tile(o, vb0, pa0, pa1, pa2, pa3); MASKT(pB0, pB1, NT - 1); partialSM(pB0, pB1, m_reg, alB);
    RESC(alB);
    finishSM(pB0, pB1, alB, l_reg, pa0, pa1, pa2, pa3); SBAR();
    pv_tile(o, vb0 + SHM_V, pa0, pa1, pa2, pa3);
    } else {
    f32x16 p0, p1; float al; bf16x8 pa0, pa1, pa2, pa3;
    SLOAD(0); VM_WAIT(); SWRITE(0); __syncthreads();
    for (int t = 0; t < NT; t += 2) {
        SBAR(); SLOAD((t + 1) * KVBLK); SBAR();
        qkt<PITCH, ND0>(p0, p1, K_lds, r32, hi, kch0, qr); MASKT(p0, p1, t); partialSM(p0, p1, m_reg, al); RESC(al);
        finishSM(p0, p1, al, l_reg, pa0, pa1, pa2, pa3); SBAR();
        pv_tile(o, vb0, pa0, pa1, pa2, pa3);
        VM_WAIT(); SWRITE(1); __syncthreads();
        SBAR(); if (t + 2 < NT) SLOAD((t + 2) * KVBLK); SBAR();
        qkt<PITCH, ND0>(p0, p1, K_lds + SHM_K, r32, hi, kch0, qr); MASKT(p0, p1, t + 1); partialSM(p0, p1, m_reg, al); RESC(al);
        finishSM(p0, p1, al, l_reg, pa0, pa1, pa2, pa3); SBAR();
        pv_tile(o, vb0 + SHM_V, pa0, pa1, pa2, pa3);
        if (t + 2 < NT) { VM_WAIT(); SWRITE(0); } __syncthreads();
    }
    }
#undef SLOAD
#undef SWRITE
#undef RESC
#undef MASKT
}

template <bool NEGM = true>
__device__ __forceinline__ void partialSM_rel(f32x16& p0, f32x16& p1, float& m_reg, f32x16& negm, float& alpha, bool first) {
    float pmax = p0[0];
#pragma unroll
    for (int r = 1; r < 16; ++r) pmax = fmaxf(pmax, p0[r]);
#pragma unroll
    for (int r = 0; r < 16; ++r) pmax = fmaxf(pmax, p1[r]);
    { auto rr = __builtin_amdgcn_permlane32_swap(__float_as_uint(pmax), __float_as_uint(pmax), false, false); pmax = fmaxf(__uint_as_float(rr[0]), __uint_as_float(rr[1])); }
    if (__builtin_expect(!first && __all(pmax <= THRL), 1)) { alpha = 1.f; }
    else { const float dl = first ? pmax : fmaxf(pmax, 0.f); alpha = first ? 1.f : __builtin_amdgcn_exp2f(-dl); m_reg += dl;
#pragma unroll
        for (int r = 0; r < 16; ++r) { p0[r] -= dl; p1[r] -= dl; }
        if constexpr (NEGM) {
#pragma unroll
            for (int r = 0; r < 16; ++r) negm[r] = -m_reg; } }
#pragma unroll
    for (int r = 0; r < 16; ++r) p0[r] = __builtin_amdgcn_exp2f(p0[r]);
}
template <int PITCH, int ND0>
__device__ __forceinline__ void qkt_rel(f32x16& p0, f32x16& p1, const char* Kb, int r32, int hi, int kch0, const bf16x8* qr, const f32x16& negm) {
    const char* kb[4];
#pragma unroll
    for (int dd = 0; dd < 4; ++dd) kb[dd] = Kb + kswz<PITCH>(r32, (kch0 + dd * 2 + hi) * 16);
#pragma unroll
    for (int d0 = 0; d0 < ND0; ++d0) { const char* a = (PITCH % 256 == 0) ? Kb + kswz<PITCH>(r32, (kch0 + d0 * 2 + hi) * 16) : kb[d0 & 3] + (d0 >> 2) * 128;
        const bf16x8 b0 = *reinterpret_cast<const bf16x8*>(a);
        const bf16x8 b1 = *reinterpret_cast<const bf16x8*>(a + 32 * PITCH);
        p0 = __builtin_amdgcn_mfma_f32_32x32x16_bf16(b0, qr[d0], d0 == 0 ? negm : p0, 0, 0, 0);
        p1 = __builtin_amdgcn_mfma_f32_32x32x16_bf16(b1, qr[d0], d0 == 0 ? negm : p1, 0, 0, 0); }
}

template <int PITCH, int ND0, int PF>
__device__ __forceinline__ void qkt_rel_pf(f32x16& p0, f32x16& p1, const char* Kb, int r32, int hi, int kch0, const bf16x8* qr, const f32x16& negm_) {
    static_assert(PITCH % 256 == 128 || ND0 <= 4, "the +128 B immediate offsets need the 3-bit swizzle");
    f32x16 negm = negm_;
    int kb[4];
#pragma unroll
    for (int dd = 0; dd < 4; ++dd) kb[dd] = (int)(uintptr_t)Kb + kswz<PITCH>(r32, (kch0 + dd * 2 + hi) * 16);
    bf16x8 f[PF + 1][2];
#define KRD(d) do { asm volatile("ds_read_b128 %0, %1 offset:%2" : "=v"(f[(d) % (PF + 1)][0]) : "v"(kb[(d) & 3]), "i"(((d) >> 2) * 128)); \
                    asm volatile("ds_read_b128 %0, %1 offset:%2" : "=v"(f[(d) % (PF + 1)][1]) : "v"(kb[(d) & 3]), "i"(((d) >> 2) * 128 + 32 * PITCH)); } while (0)
#pragma unroll
    for (int d = 0; d < PF && d < ND0; ++d) KRD(d);
#pragma unroll
    for (int d0 = 0; d0 < ND0; ++d0) {
        if (d0 + PF < ND0) KRD(d0 + PF);
        const int ahead = (d0 + PF < ND0 ? PF : ND0 - 1 - d0) * 2;
        if (ahead >= 4) asm volatile("s_waitcnt lgkmcnt(4)" : "+v"(f[d0 % (PF + 1)][0]), "+v"(f[d0 % (PF + 1)][1]));
        else if (ahead == 2) asm volatile("s_waitcnt lgkmcnt(2)" : "+v"(f[d0 % (PF + 1)][0]), "+v"(f[d0 % (PF + 1)][1]));
        else asm volatile("s_waitcnt lgkmcnt(0)" : "+v"(f[d0 % (PF + 1)][0]), "+v"(f[d0 % (PF + 1)][1]));
        if (d0 == 0) {
            asm volatile("s_nop 1\n\tv_mfma_f32_32x32x16_bf16 %0, %1, %2, %3" : "=&v"(p0) : "v"(f[0][0]), "v"(qr[0]), "v"(negm));
            asm volatile("v_mfma_f32_32x32x16_bf16 %0, %1, %2, %3" : "=&v"(p1) : "v"(f[0][1]), "v"(qr[0]), "v"(negm));
        } else {
            p0 = __builtin_amdgcn_mfma_f32_32x32x16_bf16(f[d0 % (PF + 1)][0], qr[d0], p0, 0, 0, 0);
            p1 = __builtin_amdgcn_mfma_f32_32x32x16_bf16(f[d0 % (PF + 1)][1], qr[d0], p1, 0, 0, 0); }
    }
#undef KRD
}

template <int PITCH, int ND0>
__device__ __forceinline__ void pv_qk(f32x16* o, int vb0, bf16x8 pa0, bf16x8 pa1, bf16x8 pa2, bf16x8 pa3,
                                      f32x16& p0, f32x16& p1, const char* Kb, int r32, int hi, int kch0, const bf16x8* qr, const f32x16& negm_) {
    constexpr int PF = 2;
    static_assert(PITCH % 256 == 128 || ND0 <= 4, "the +128 B immediate offsets need the 3-bit swizzle");
    f32x16 negm = negm_;
    s16x4 va[8], vb[8];
    int kb[4];
#pragma unroll
    for (int dd = 0; dd < 4; ++dd) kb[dd] = (int)(uintptr_t)Kb + kswz<PITCH>(r32, (kch0 + dd * 2 + hi) * 16);
    bf16x8 f[PF + 1][2];
#define TRRD(dst, off) asm volatile("ds_read_b64_tr_b16 %0, %1 offset:%2" : "=&v"(dst) : "v"(vb0), "i"(off) : "memory")
#define PV_RD(v, d0) do { constexpr int b_ = v_rd_off(d0, 0, 0); TRRD(v[0], b_); TRRD(v[1], b_ + 2048); TRRD(v[2], b_ + 4096); TRRD(v[3], b_ + 6144); TRRD(v[4], b_ + 8192); TRRD(v[5], b_ + 10240); TRRD(v[6], b_ + 12288); TRRD(v[7], b_ + 14336); } while (0)
#define PV_MM(v, d0) do { \
        o[d0] = __builtin_amdgcn_mfma_f32_32x32x16_bf16(pa0, (bf16x8){v[0][0], v[0][1], v[0][2], v[0][3], v[1][0], v[1][1], v[1][2], v[1][3]}, o[d0], 0, 0, 0); \
        o[d0] = __builtin_amdgcn_mfma_f32_32x32x16_bf16(pa1, (bf16x8){v[2][0], v[2][1], v[2][2], v[2][3], v[3][0], v[3][1], v[3][2], v[3][3]}, o[d0], 0, 0, 0); \
        o[d0] = __builtin_amdgcn_mfma_f32_32x32x16_bf16(pa2, (bf16x8){v[4][0], v[4][1], v[4][2], v[4][3], v[5][0], v[5][1], v[5][2], v[5][3]}, o[d0], 0, 0, 0); \
        o[d0] = __builtin_amdgcn_mfma_f32_32x32x16_bf16(pa3, (bf16x8){v[6][0], v[6][1], v[6][2], v[6][3], v[7][0], v[7][1], v[7][2], v[7][3]}, o[d0], 0, 0, 0); } while (0)
#define PV_WN(v, n) asm volatile("s_waitcnt lgkmcnt(%8)" : "+v"(v[0]), "+v"(v[1]), "+v"(v[2]), "+v"(v[3]), "+v"(v[4]), "+v"(v[5]), "+v"(v[6]), "+v"(v[7]) : "n"(n) : "memory")
#define KRD(d) do { asm volatile("ds_read_b128 %0, %1 offset:%2" : "=v"(f[(d) % (PF + 1)][0]) : "v"(kb[(d) & 3]), "i"(((d) >> 2) * 128) : "memory"); \
                    asm volatile("ds_read_b128 %0, %1 offset:%2" : "=v"(f[(d) % (PF + 1)][1]) : "v"(kb[(d) & 3]), "i"(((d) >> 2) * 128 + 32 * PITCH) : "memory"); } while (0)
#define PV_RDK(v, ks) do { TRRD(v[0], v_rd_off(0, ks, 0)); TRRD(v[1], v_rd_off(0, ks, 1)); TRRD(v[2], v_rd_off(1, ks, 0)); TRRD(v[3], v_rd_off(1, ks, 1)); \
                            TRRD(v[4], v_rd_off(2, ks, 0)); TRRD(v[5], v_rd_off(2, ks, 1)); TRRD(v[6], v_rd_off(3, ks, 0)); TRRD(v[7], v_rd_off(3, ks, 1)); } while (0)
#define PV_MMK(v, pa) do { \
        o[0] = __builtin_amdgcn_mfma_f32_32x32x16_bf16(pa, (bf16x8){v[0][0], v[0][1], v[0][2], v[0][3], v[1][0], v[1][1], v[1][2], v[1][3]}, o[0], 0, 0, 0); \
        o[1] = __builtin_amdgcn_mfma_f32_32x32x16_bf16(pa, (bf16x8){v[2][0], v[2][1], v[2][2], v[2][3], v[3][0], v[3][1], v[3][2], v[3][3]}, o[1], 0, 0, 0); \
        o[2] = __builtin_amdgcn_mfma_f32_32x32x16_bf16(pa, (bf16x8){v[4][0], v[4][1], v[4][2], v[4][3], v[5][0], v[5][1], v[5][2], v[5][3]}, o[2], 0, 0, 0); \
        o[3] = __builtin_amdgcn_mfma_f32_32x32x16_bf16(pa, (bf16x8){v[6][0], v[6][1], v[6][2], v[6][3], v[7][0], v[7][1], v[7][2], v[7][3]}, o[3], 0, 0, 0); } while (0)
    PV_RDK(va, 0); PV_RDK(vb, 1); PV_WN(va, 8); SBAR(); PV_MMK(va, pa0);
    PV_RDK(va, 2); PV_WN(vb, 8); SBAR(); PV_MMK(vb, pa1);
    PV_RDK(vb, 3); PV_WN(va, 8); SBAR(); PV_MMK(va, pa2);
    KRD(0); KRD(1);
    PV_WN(vb, 4); SBAR(); PV_MMK(vb, pa3);
#undef PV_MMK
#undef PV_RDK
    SBAR();
#pragma unroll
    for (int d0 = 0; d0 < ND0; ++d0) {
        if (d0 + PF < ND0) KRD(d0 + PF);
        const int ahead = (d0 + PF < ND0 ? PF : ND0 - 1 - d0) * 2;
        if (ahead >= 4) asm volatile("s_waitcnt lgkmcnt(4)" : "+v"(f[d0 % (PF + 1)][0]), "+v"(f[d0 % (PF + 1)][1]) :: "memory");
        else if (ahead == 2) asm volatile("s_waitcnt lgkmcnt(2)" : "+v"(f[d0 % (PF + 1)][0]), "+v"(f[d0 % (PF + 1)][1]) :: "memory");
        else asm volatile("s_waitcnt lgkmcnt(0)" : "+v"(f[d0 % (PF + 1)][0]), "+v"(f[d0 % (PF + 1)][1]) :: "memory");
        if (d0 == 0) {
            asm volatile("s_nop 1\n\tv_mfma_f32_32x32x16_bf16 %0, %1, %2, %3" : "=&v"(p0) : "v"(f[0][0]), "v"(qr[0]), "v"(negm));
            asm volatile("v_mfma_f32_32x32x16_bf16 %0, %1, %2, %3" : "=&v"(p1) : "v"(f[0][1]), "v"(qr[0]), "v"(negm));
        } else {
            p0 = __builtin_amdgcn_mfma_f32_32x32x16_bf16(f[d0 % (PF + 1)][0], qr[d0], p0, 0, 0, 0);
            p1 = __builtin_amdgcn_mfma_f32_32x32x16_bf16(f[d0 % (PF + 1)][1], qr[d0], p1, 0, 0, 0); }
    }
#undef KRD
#undef PV_WN
#undef PV_MM
#undef PV_RD
#undef TRRD
}

__device__ __forceinline__ void glds16(unsigned lds_addr, const void* sbase, unsigned voff) {
    unsigned keep;
    asm volatile("s_mov_b32 %0, m0\n\ts_mov_b32 m0, %1\n\ts_nop 0\n\tglobal_load_lds_dwordx4 %2, %3\n\ts_mov_b32 m0, %0" : "=&s"(keep) : "s"(lds_addr), "v"(voff), "s"(sbase) : "memory");
}
template <int KT, int ND0, bool CAUSAL>
__device__ __forceinline__ void attn_core_ring(const bf16_t* Qlane, const bf16_t* __restrict__ Kh, int ldk, const bf16_t* __restrict__ Vh, int ldv, int NT, int qpos, int qlo, int kch0,
                                               char* lds, f32x16 (&o)[4], float& l_reg) {
    constexpr int PITCH = KT * 2, SHM_K = KVBLK * PITCH, NKP = SHM_K / 8192, NVP = SHM_V / 8192;
    const int tid = opaque_tid(), wid = __builtin_amdgcn_readfirstlane(tid >> 6), lane = tid & 63, r32 = lane & 31, hi = lane >> 5;
    char* V_lds = lds; char* K_lds = lds + 3 * SHM_V;
    float* ws = (float*)(lds + 3 * SHM_V + 3 * SHM_K) + wid * 64; float* al_l = ws + 32;
    float m_reg = 0.f; l_reg = 0.f; f32x16 negm = f32x16{};
#pragma unroll
    for (int d = 0; d < 4; ++d) o[d] = f32x16{};
    bf16x8 qr[ND0];
#pragma unroll
    for (int d0 = 0; d0 < ND0; ++d0) qr[d0] = *reinterpret_cast<const bf16x8*>(Qlane + d0 * 16);
    const int vb0 = (int)(uintptr_t)V_lds + v_rd_base(lane);
    unsigned koff[NKP], voff[NVP];
#pragma unroll
    for (int i = 0; i < NKP; ++i) { const int a = (wid * NKP + i) * 1024 + lane * 16, row = a / PITCH, cpos = (a - row * PITCH) >> 4, f = kfl<PITCH>(row);
        const int chunk = cpos ^ f; koff[i] = (unsigned)(row * ldk * 2 + chunk * 16); }
#pragma unroll
    for (int i = 0; i < NVP; ++i) { const int a = (wid * NVP + i) * 1024 + lane * 16, sub = a >> 9, rem = a & 511, kk = (sub >> 2) * 8 + (rem >> 6), c = (sub & 3) * 32 + ((rem & 63) >> 1);
        const int k = kk; voff[i] = (unsigned)(k * ldv * 2 + c * 2); }
    const unsigned ldsK = (unsigned)(uintptr_t)K_lds + (unsigned)(wid * NKP) * 1024u, ldsV = (unsigned)(uintptr_t)V_lds + (unsigned)(wid * NVP) * 1024u;
#define DMA_TILE(t, slot) do { const char* kb_ = (const char*)Kh + (size_t)(t) * KVBLK * ldk * 2; const char* vb_ = (const char*)Vh + (size_t)(t) * KVBLK * ldv * 2; \
        _Pragma("unroll") for (int i_ = 0; i_ < NKP; ++i_) glds16(ldsK + (slot) * SHM_K + i_ * 1024, kb_, koff[i_]); \
        _Pragma("unroll") for (int i_ = 0; i_ < NVP; ++i_) glds16(ldsV + (slot) * SHM_V + i_ * 1024, vb_, voff[i_]); } while (0)
#define RING_SYNC(more) do { if (more) asm volatile("s_waitcnt vmcnt(%0)" :: "n"(NKP + NVP) : "memory"); else asm volatile("s_waitcnt vmcnt(0)" ::: "memory"); \
        asm volatile("s_waitcnt lgkmcnt(0)" ::: "memory"); __builtin_amdgcn_s_barrier(); asm volatile("" ::: "memory"); } while (0)
#define RESC(a) do { if (__any((a) < 1.f)) { if (hi == 0) al_l[r32] = (a); asm volatile("s_waitcnt lgkmcnt(0)" ::: "memory"); \
        _Pragma("unroll") for (int d_ = 0; d_ < 4; ++d_) _Pragma("unroll") for (int r = 0; r < 16; ++r) o[d_][r] *= al_l[crow(r, hi)]; } } while (0)
#define MASKT(P0_, P1_, t) do { if (CAUSAL) { const int kb_ = (t) * KVBLK; if (kb_ + KVBLK - 1 > qlo) mask_tile(P0_, P1_, qpos - kb_ - 4 * hi); } } while (0)
    f32x16 p0, p1; float al; bf16x8 pa0, pa1, pa2, pa3;
    asm volatile("s_waitcnt vmcnt(0)" ::: "memory");
#pragma unroll
    for (int d0 = 0; d0 < ND0; ++d0) asm volatile("" : "+v"(qr[d0]));
    DMA_TILE(0, 0); if (NT > 1) DMA_TILE(1, 1);
    RING_SYNC(NT > 1);
    int slot = 0;
    for (int t = 0; t < NT; ++t) {
        const int s2 = slot == 0 ? 2 : slot - 1;
        SBAR(); if (t + 2 < NT) DMA_TILE(t + 2, s2); SBAR();
        qkt_rel_pf<PITCH, ND0, 2>(p0, p1, K_lds + slot * SHM_K, r32, hi, kch0, qr, negm); MASKT(p0, p1, t); partialSM_rel(p0, p1, m_reg, negm, al, t == 0); RESC(al);
        finishSM(p0, p1, al, l_reg, pa0, pa1, pa2, pa3); SBAR();
        pv_tile(o, vb0 + slot * SHM_V, pa0, pa1, pa2, pa3);
        RING_SYNC(t + 2 < NT);
        slot = slot == 2 ? 0 : slot + 1;
    }
#undef DMA_TILE
#undef RING_SYNC
#undef RESC
#undef MASKT
}
template <int KT, int ND0, bool CAUSAL, bool NEGM>
__device__ __forceinline__ void attn_core_pp(const bf16_t* Qlane, const bf16_t* __restrict__ Kh, int ldk, const bf16_t* __restrict__ Vh, int ldv, int NT, int qpos, int qlo, int kch0,
                                             char* lds, f32x16 (&o)[4], float& l_reg) {
    constexpr int PITCH = KT * 2, SHM_K = KVBLK * PITCH, NKP = SHM_K / 8192, NVP = SHM_V / 8192;
    const int tid = opaque_tid(), wid = __builtin_amdgcn_readfirstlane(tid >> 6), lane = tid & 63, r32 = lane & 31, hi = lane >> 5;
    const bool grpB = wid >= 4;
    char* V_lds = lds; char* K_lds = lds + 3 * SHM_V;
    float* ws = (float*)(lds + 3 * SHM_V + 3 * SHM_K) + wid * 64; float* al_l = ws + 32;
    float m_reg = 0.f; l_reg = 0.f; f32x16 negm = f32x16{};
#pragma unroll
    for (int d = 0; d < 4; ++d) o[d] = f32x16{};
    bf16x8 qr[ND0];
#pragma unroll
    for (int d0 = 0; d0 < ND0; ++d0) qr[d0] = *reinterpret_cast<const bf16x8*>(Qlane + d0 * 16);
    const int vb0 = (int)(uintptr_t)V_lds + v_rd_base(lane);
    unsigned koff[NKP], voff[NVP];
#pragma unroll
    for (int i = 0; i < NKP; ++i) { const int a = (wid * NKP + i) * 1024 + lane * 16, row = a / PITCH, cpos = (a - row * PITCH) >> 4, f = kfl<PITCH>(row);
        const int chunk = cpos ^ f; koff[i] = (unsigned)(row * ldk * 2 + chunk * 16); }
#pragma unroll
    for (int i = 0; i < NVP; ++i) { const int a = (wid * NVP + i) * 1024 + lane * 16, sub = a >> 9, rem = a & 511, kk = (sub >> 2) * 8 + (rem >> 6), c = (sub & 3) * 32 + ((rem & 63) >> 1);
        const int k = kk; voff[i] = (unsigned)(k * ldv * 2 + c * 2); }
    const unsigned ldsK = (unsigned)(uintptr_t)K_lds + (unsigned)(wid * NKP) * 1024u, ldsV = (unsigned)(uintptr_t)V_lds + (unsigned)(wid * NVP) * 1024u;
#define DMA_K(t, slot) do { const char* kb_ = (const char*)Kh + (size_t)(t) * KVBLK * ldk * 2; _Pragma("unroll") for (int i_ = 0; i_ < NKP; ++i_) glds16(ldsK + (slot) * SHM_K + i_ * 1024, kb_, koff[i_]); } while (0)
#define DMA_V(t, slot) do { const char* vb_ = (const char*)Vh + (size_t)(t) * KVBLK * ldv * 2; _Pragma("unroll") for (int i_ = 0; i_ < NVP; ++i_) glds16(ldsV + (slot) * SHM_V + i_ * 1024, vb_, voff[i_]); } while (0)
#define ISSUE(u, ksl, vsl) do { if ((u) < NT) DMA_K(u, ksl); if ((u) - 1 < NT) DMA_V((u) - 1, vsl); } while (0)
#define PAIR_WAIT(t) do { if ((t) + 2 < NT) asm volatile("s_waitcnt vmcnt(%0)" :: "n"(NKP + NVP) : "memory"); else if ((t) + 2 == NT) asm volatile("s_waitcnt vmcnt(%0)" :: "n"(NVP) : "memory"); \
        else asm volatile("s_waitcnt vmcnt(0)" ::: "memory"); } while (0)
#define BAR() do { SBAR(); asm volatile("s_waitcnt lgkmcnt(0)" ::: "memory"); __builtin_amdgcn_s_barrier(); asm volatile("" ::: "memory"); SBAR(); } while (0)
#define RESC(a) do { if (__any((a) < 1.f)) { if (hi == 0) al_l[r32] = (a); asm volatile("s_waitcnt lgkmcnt(0)" ::: "memory"); \
        _Pragma("unroll") for (int d_ = 0; d_ < 4; ++d_) _Pragma("unroll") for (int r = 0; r < 16; ++r) o[d_][r] *= al_l[crow(r, hi)]; } } while (0)
#define MASKT(P0_, P1_, t) do { if (CAUSAL) { const int kb_ = (t) * KVBLK; if (kb_ + KVBLK - 1 > qlo) mask_tile(P0_, P1_, qpos - kb_ - 4 * hi); } } while (0)
    f32x16 p0, p1; float al; bf16x8 pa0, pa1, pa2, pa3;
    asm volatile("s_waitcnt vmcnt(0)" ::: "memory");
#pragma unroll
    for (int d0 = 0; d0 < ND0; ++d0) asm volatile("" : "+v"(qr[d0]));
    DMA_K(0, 0);
    if (NT > 1) DMA_K(1, 1);
    DMA_V(0, 0);
    if (NT > 1) asm volatile("s_waitcnt vmcnt(%0)" :: "n"(NKP + NVP) : "memory"); else asm volatile("s_waitcnt vmcnt(%0)" :: "n"(NVP) : "memory");
    BAR();
    if (grpB) { ISSUE(2, 2, 1); BAR(); }
#define QK_(ksl) do { if constexpr (NEGM) qkt_rel_pf<PITCH, ND0, 2>(p0, p1, K_lds + (ksl) * SHM_K, r32, hi, kch0, qr, negm); \
        else { f32x16 c_; const float nm_ = -m_reg; _Pragma("unroll") for (int r = 0; r < 16; ++r) c_[r] = nm_; qkt_rel_pf<PITCH, ND0, 2>(p0, p1, K_lds + (ksl) * SHM_K, r32, hi, kch0, qr, c_); } } while (0)
#define Y_(t_, first_) do { MASKT(p0, p1, t_); partialSM_rel<NEGM>(p0, p1, m_reg, negm, al, first_); RESC(al); finishSM(p0, p1, al, l_reg, pa0, pa1, pa2, pa3); } while (0)
    QK_(0);
    if (grpB) PAIR_WAIT(0);
    BAR();
    if (grpB) ISSUE(3, 0, 2); else ISSUE(2, 2, 1);
    SBAR();
    Y_(0, true);
    if (!grpB) PAIR_WAIT(0);
    BAR();
    int ks = 1;
    for (int t = 1; t < NT; ++t) {
        const int kp = ks == 0 ? 2 : ks - 1, kn = ks == 2 ? 0 : ks + 1;
        if constexpr (NEGM) pv_qk<PITCH, ND0>(o, vb0 + kp * SHM_V, pa0, pa1, pa2, pa3, p0, p1, K_lds + ks * SHM_K, r32, hi, kch0, qr, negm);
        else { f32x16 c_; const float nm_ = -m_reg; _Pragma("unroll") for (int r = 0; r < 16; ++r) c_[r] = nm_; pv_qk<PITCH, ND0>(o, vb0 + kp * SHM_V, pa0, pa1, pa2, pa3, p0, p1, K_lds + ks * SHM_K, r32, hi, kch0, qr, c_); }
#ifdef PROBE_XMFMA
        if constexpr (ND0 == 4) { f32x16 dz_ = f32x16{}; _Pragma("unroll") for (int i_ = 0; i_ < PROBE_XMFMA; ++i_) asm volatile("v_mfma_f32_32x32x16_bf16 %0, %1, %2, %0" : "+v"(dz_) : "v"(qr[0]), "v"(qr[1])); asm volatile("s_nop 15\n\ts_nop 15" :: "v"(dz_)); }
#endif
        if (grpB) PAIR_WAIT(t);
        BAR();
        if (grpB) ISSUE(t + 3, ks, kp); else ISSUE(t + 2, kp, kn);
        SBAR();
        Y_(t, false);
#ifdef PROBE_YEXP
        if constexpr (ND0 == 4) { float dm_ = al; _Pragma("unroll") for (int i_ = 0; i_ < PROBE_YEXP; ++i_) asm volatile("v_exp_f32 %0, %1" : "=v"(dm_) : "v"(al)); asm volatile("" :: "v"(dm_)); }
#endif

        if (!grpB) PAIR_WAIT(t);
        BAR();
        ks = kn;
    }
    pv_tile(o, vb0 + (ks == 0 ? 2 : ks - 1) * SHM_V, pa0, pa1, pa2, pa3);
    BAR();
#undef QK_
#undef Y_
    if (!grpB) BAR();
#undef DMA_K
#undef DMA_V
#undef ISSUE
#undef PAIR_WAIT
#undef BAR
#undef RESC
#undef MASKT
}
__device__ __forceinline__ void normalize_o(f32x16 (&o)[4], float l_reg, float* ws, int r32, int hi) {
    if (hi == 0) ws[r32] = l_reg; asm volatile("s_waitcnt lgkmcnt(0)" ::: "memory");
#pragma unroll
    for (int r = 0; r < 16; ++r) { const float rl = __builtin_amdgcn_rcpf(ws[crow(r, hi)]);
#pragma unroll
        for (int d0 = 0; d0 < 4; ++d0) o[d0][r] *= rl; }
}
__device__ __forceinline__ void store_o_bf16(const f32x16 (&o)[4], bf16_t* Ow, int ldo, int r32, int hi) {
#pragma unroll
    for (int r = 0; r < 16; ++r) { const int orow = crow(r, hi);
#pragma unroll
        for (int d0 = 0; d0 < 4; ++d0) { const float v = o[d0][r]; const float vn = shflx(v, 1, hi * 32 + r32);
            if ((r32 & 1) == 0) *(unsigned*)(Ow + (size_t)orow * ldo + d0 * 32 + r32) = cvt_pk_bf16(v, vn); } }
}
}

constexpr size_t MiB = 1u << 20;
constexpr size_t WS_CTL = 0, CTL_ZERO_BYTES = 4 * MiB;
constexpr size_t WS_SSQ = 1 * MiB;
constexpr size_t WS_W = 4 * MiB, LW_BYTES = 269 * MiB / 2;
constexpr size_t LW_IN = 0, LW_QUP = 44 * MiB, LW_KVUP = LW_QUP + 3 * MiB / 2, LW_GLU = LW_KVUP + 1 * MiB, LW_BR = LW_GLU + 4 * MiB, LW_OUT = LW_BR + 12 * MiB,
                 LW_XQ = LW_OUT + 8 * MiB, LW_XKV = LW_XQ + 2 * MiB, LW_XO = LW_XKV + 4 * MiB, LW_TEXT = LW_XO + 2 * MiB, LW_WSL = LW_TEXT + 40 * MiB;
static_assert(LW_WSL + 16 * MiB == LW_BYTES, "layer weight block");
constexpr size_t WS_FFN = WS_W + 2 * LW_BYTES;
constexpr size_t WS_MOE = WS_FFN + 66 * MiB;
constexpr size_t WS_XS = WS_MOE + 8 * 66 * MiB + 1 * MiB;
static_assert(WS_XS == 868 * MiB, "map");
constexpr size_t WS_XN = WS_XS + 128 * MiB;
constexpr size_t WS_TABD = WS_XN + 64 * MiB, WS_TABM = WS_TABD + 1 * MiB, WS_XKV = WS_TABM + 4 * MiB, WS_MEMB = WS_XKV + 1 * MiB, WS_ROUTE = WS_MEMB + 1 * MiB, WS_ORDER = WS_ROUTE + 1 * MiB;
constexpr size_t WS_A32 = WS_ORDER + 64 * 1024;
constexpr size_t WS_PSQ = WS_ORDER + 1 * MiB;
constexpr size_t WS_MIX = WS_TABD + 12 * MiB;
static_assert(WS_MIX == 1072 * MiB, "map");
constexpr size_t WS_QD = WS_MIX, WS_KD = WS_QD + 32 * MiB, WS_VD = WS_KD + 32 * MiB, WS_MQ = WS_VD + 32 * MiB, WS_MKV = WS_MQ + 16 * MiB, WS_KM = WS_MKV + 8 * MiB, WS_VM = WS_KM + 48 * MiB,
                 WS_QM = WS_VM + 32 * MiB, WS_SU = WS_QM + 48 * MiB, WS_GATES = WS_SU + 40 * MiB, WS_SLOC = WS_GATES + 192 * MiB, WS_YG = WS_SLOC + 16 * MiB, WS_BR = WS_YG + 32 * MiB,
                 WS_TMP = WS_BR + 96 * MiB, WS_MG = WS_TMP + 128 * MiB, WS_XQ = WS_MG + 64 * MiB, WS_XO = WS_XQ + 16 * MiB, WS_XN8 = WS_XO + 16 * MiB  , WS_END = WS_XN8 + 32 * MiB;
static_assert(WS_END == 1952 * MiB, "map");
constexpr size_t WS_XG = WS_MIX, WS_HG = WS_XG + 136 * MiB, WS_OG = WS_HG + 374 * MiB;
static_assert(WS_OG + 272 * MiB <= WS_XQ, "ffn overlay");
constexpr int CW_TMO = 0, CW_DBG = 2, CW_BAR = 4096, CW_ATTQ = 16384, CW_MOECNT = 16640, CW_MOECUR = 16704;

#define XB_TMO      128
#define XB_XCNT(j)  (256  + 64 * (j))
#define XB_XSUB(j)  (1280 + 64 * (j))
#define XB_XGEN(j)  (2304 + 64 * (j))
#define XB_TOP      3328
#define XB_TOPGEN   3392
#define XCD_BAR_WORDS 3456
#define XB_SPIN_CAP (1u << 22)
__device__ __forceinline__ unsigned xb_ld(unsigned* p)              { return __hip_atomic_load(p, __ATOMIC_RELAXED, __HIP_MEMORY_SCOPE_AGENT); }
__device__ __forceinline__ unsigned xb_add(unsigned* p, unsigned v) { return __hip_atomic_fetch_add(p, v, __ATOMIC_RELAXED, __HIP_MEMORY_SCOPE_AGENT); }
__device__ __forceinline__ unsigned xb_xcc_id() { return (unsigned)__builtin_amdgcn_s_getreg((3 << 11) | 20) & 0xFu; }
#define XB_SPIN(cond, bar) do { unsigned _sp = 0; while (cond) { __builtin_amdgcn_s_sleep(1); \
    if ((++_sp & 255u) == 0u) { if (xb_ld(&(bar)[XB_TMO])) break; if (_sp > XB_SPIN_CAP) { atomicAdd(&(bar)[XB_TMO], 1u); break; } } } } while (0)
struct XcdBarrier { unsigned* bar; unsigned x; volatile LAS unsigned* st; };
__device__ __forceinline__ XcdBarrier xcd_barrier_post(unsigned* bar, volatile LAS unsigned* st) {
    XcdBarrier b; b.bar = bar; b.x = xb_xcc_id(); b.st = st;
    if (threadIdx.x == 0) (void)xb_add(&bar[XB_XCNT(b.x)], 1u);
    return b;
}
__device__ __forceinline__ void xcd_barrier_complete(unsigned* bar, unsigned x, unsigned& nloc, unsigned& nx) {
    const unsigned G = gridDim.x * gridDim.y * gridDim.z;
    unsigned sum, cnt, mine, sp = 0u;
    for (;;) {
        sum = 0u; cnt = 0u; mine = 0u;
#pragma nounroll
        for (unsigned j = 0; j < 16; ++j) { const unsigned c = xb_ld(&bar[XB_XCNT(j)]); sum += c; cnt += (c > 0u) ? 1u : 0u; mine = (j == x) ? c : mine; }
        if (sum == G) break;
        __builtin_amdgcn_s_sleep(1);
        if ((++sp & 255u) == 0u) { if (xb_ld(&bar[XB_TMO])) break; if (sp > XB_SPIN_CAP) { atomicAdd(&bar[XB_TMO], 1u); break; } }
    }
    nloc = mine > 0u ? mine : 1u; nx = cnt > 0u ? cnt : 1u;
}
__device__ __forceinline__ void xcd_barrier_setup(const XcdBarrier& b) {
    if (threadIdx.x == 0) { unsigned nloc, nx; xcd_barrier_complete(b.bar, b.x, nloc, nx); b.st[0] = nloc; b.st[1] = nx; }
    __syncthreads();
}
__device__ __forceinline__ void xcd_barrier(const XcdBarrier& b) {
    asm volatile("s_waitcnt vmcnt(0)" ::: "memory");
    __syncthreads();
    if (opaque_tid() == 0) {
        unsigned* bar = b.bar;
        __builtin_amdgcn_s_waitcnt(0);
        const unsigned nloc = b.st[0], nx = b.st[1];
        const unsigned old = xb_add(&bar[XB_XSUB(b.x)], 1u);
        const unsigned gen = old / nloc;
        if (old + 1u == (gen + 1u) * nloc) {
            __builtin_amdgcn_fence(__ATOMIC_RELEASE, "agent");
            asm volatile("s_waitcnt vmcnt(0)" ::: "memory");
            const unsigned og = xb_add(&bar[XB_TOP], 1u);
            const unsigned tg = og / nx;
            if (og + 1u == (tg + 1u) * nx) xb_add(&bar[XB_TOPGEN], 1u);
            else XB_SPIN(xb_ld(&bar[XB_TOPGEN]) == tg, bar);
            __builtin_amdgcn_fence(__ATOMIC_ACQUIRE, "agent");
            xb_add(&bar[XB_XGEN(b.x)], 1u);
            asm volatile("s_waitcnt vmcnt(0)" ::: "memory");
        } else {
            XB_SPIN(xb_ld(&bar[XB_XGEN(b.x)]) == gen, bar);
            __builtin_amdgcn_fence(__ATOMIC_ACQUIRE, "agent");
            asm volatile("s_waitcnt vmcnt(0)" ::: "memory");
        }
    }
    __syncthreads();
}

struct Args { const void* in[35]; float* out; unsigned char* ws; int ph_lo, ph_hi; };
struct PTab { volatile LAS unsigned long long* t; __device__ __forceinline__ const void* operator[](int i) const { const unsigned long long v = t[i];
    const unsigned lo_ = __builtin_amdgcn_readfirstlane((unsigned)v), hi_ = __builtin_amdgcn_readfirstlane((unsigned)(v >> 32)); return (const void*)(GAS const char*)(((unsigned long long)hi_ << 32) | lo_); } };
struct ArgsD { PTab in; unsigned char* ws; };
enum { I_X = 0, I_MEM, I_POS, I_WIN, I_WQUP, I_WKVUP, I_QNG, I_KVNG, I_DLAM, I_SUBLN, I_LRE, I_LIM, I_BRE, I_BIM, I_CRE, I_CIM, I_SSMD, I_LOGDT, I_GLUW, I_WBR, I_WOUT, I_LNMG, I_LNMB,
       I_WXQ, I_WXKV, I_WXO, I_LNXG, I_LNXB, I_FGU, I_FDN, I_ROUTER, I_MGU, I_MDN, I_LNFG, I_LNFB };
constexpr int NPL = 16, NPHASE = 1 + DEPTH * NPL;
constexpr int LDS_BYTES = 147456;
constexpr int LDS_MISC = 131072 + 8192;

__device__ __forceinline__ float lam_init_of(int l) { return l == 0 ? 0.2f : 0.35550906759f; }

struct Mat { const float* src; bf16_t* dst; int K, N, kind; const float* ksc; int kmod; float kmul; int fp8; };
__device__ __forceinline__ int map_row(int kind, int n, int N) {
    if (kind == 0) return n;
    if (kind == 1) {
        if (n < 2048) { const int hc = n & 63; if (hc < 16) return (n - hc) + (hc < 8 ? 2 * hc : 2 * (hc - 8) + 1); return n; }
        if (n < 3840) return n;
        if (n < 3904) { const int hc = n - 3840; return 3840 + (hc < 32 ? 2 * hc : 2 * (hc - 32) + 1); }
        return n + 192;
    }
    if (kind == 2) { const int h = n / 192; int hc = n - h * 192; if (hc >= 128) { const int r = hc - 128; hc = 128 + (r < 32 ? 2 * r : 2 * (r - 32) + 1); } return h * 192 + hc; }
    const int half = N >> 1;
    if (n < half) return (n >> 7) * 256 + (n & 127);
    const int mm = n - half; return (mm >> 7) * 256 + 128 + (mm & 127);
}
__device__ __forceinline__ Mat get_mat(const ArgsD& a, int id) {
    Mat m; m.ksc = nullptr; m.kmod = 1; m.kmul = 1.f; m.kind = 0; m.fp8 = 0;
    unsigned char* ws = a.ws;
    if (id < 22) { const int l = id / 11, k = id % 11; unsigned char* lw = ws + WS_W + (size_t)l * LW_BYTES;
        switch (k) {
        case 0: m.src = (const float*)a.in[I_WIN] + (size_t)l * D * NIN_SRC; m.dst = (bf16_t*)(lw + LW_IN); m.K = D; m.N = NIN_SRC; m.kind = 1; break;
        case 1: m.src = (const float*)a.in[I_WQUP] + (size_t)l * 512 * 1536; m.dst = (bf16_t*)(lw + LW_QUP); m.K = 512; m.N = 1536; m.kind = 2; m.ksc = (const float*)a.in[I_QNG] + l * 512; m.kmod = 512; break;
        case 2: m.src = (const float*)a.in[I_WKVUP] + (size_t)l * 256 * 2048; m.dst = (bf16_t*)(lw + LW_KVUP); m.K = 256; m.N = 2048; m.ksc = (const float*)a.in[I_KVNG] + l * 256; m.kmod = 256; break;
        case 3: m.src = (const float*)a.in[I_GLUW] + (size_t)l * 1024 * 2048; m.dst = (bf16_t*)(lw + LW_GLU); m.K = 1024; m.N = 2048; m.kind = 3; break;
        case 4: m.src = (const float*)a.in[I_WBR] + (size_t)(l * 3 + 0) * 1024 * 2048; m.dst = (bf16_t*)(lw + LW_BR); m.K = 1024; m.N = 2048; m.ksc = (const float*)a.in[I_SUBLN] + l * 128; m.kmod = 128; m.kmul = 1.f - lam_init_of(l); break;
        case 5: m.src = (const float*)a.in[I_WBR] + (size_t)(l * 3 + 1) * 1024 * 2048; m.dst = (bf16_t*)(lw + LW_BR + 4 * MiB); m.K = 1024; m.N = 2048; break;
        case 6: m.src = (const float*)a.in[I_WBR] + (size_t)(l * 3 + 2) * 1024 * 2048; m.dst = (bf16_t*)(lw + LW_BR + 8 * MiB); m.K = 1024; m.N = 2048; break;
        case 7: m.src = (const float*)a.in[I_WOUT] + (size_t)l * 2048 * 2048; m.dst = (bf16_t*)(lw + LW_OUT); m.K = 2048; m.N = 2048; break;
        case 8: m.src = (const float*)a.in[I_WXQ] + (size_t)l * 2048 * 512; m.dst = (bf16_t*)(lw + LW_XQ); m.K = 2048; m.N = 512; break;
        case 9: m.src = (const float*)a.in[I_WXKV] + (size_t)l * 2048 * 1024; m.dst = (bf16_t*)(lw + LW_XKV); m.K = 2048; m.N = 1024; break;
        default: m.src = (const float*)a.in[I_WXO] + (size_t)l * 512 * 2048; m.dst = (bf16_t*)(lw + LW_XO); m.K = 512; m.N = 2048; break;
        }
    } else if (id == 22) { m.src = (const float*)a.in[I_FGU]; m.dst = (bf16_t*)(ws + WS_FFN); m.K = D; m.N = 2 * DFF; m.kind = 3; }
    else if (id == 23) { m.src = (const float*)a.in[I_FDN]; m.dst = (bf16_t*)(ws + WS_FFN + 44 * MiB); m.K = DFF; m.N = D; m.fp8 = 1; m.kmul = 256.f; }
    else { const int e = (id - 24) >> 1;
        m.fp8 = 1;
        if (((id - 24) & 1) == 0) { m.src = (const float*)a.in[I_MGU] + (size_t)e * D * 2 * DFF; m.dst = (bf16_t*)(ws + WS_MOE + (size_t)e * 66 * MiB); m.K = D; m.N = 2 * DFF; m.kind = 3; m.kmul = 64.f; }
        else { m.src = (const float*)a.in[I_MDN] + (size_t)e * DFF * D; m.dst = (bf16_t*)(ws + WS_MOE + (size_t)e * 66 * MiB + 44 * MiB); m.K = DFF; m.N = D; m.kmul = 256.f; }
    }
    return m;
}
constexpr int NMAT = 40;
__device__ __forceinline__ void cvt_item(const Mat& mt, LAS float* scr, int item, int lane) {
    const int nblk = mt.N / 64, kb = item / nblk, nb = item - kb * nblk, k0 = 64 * kb, n0 = 64 * nb;
    const bool g8 = mt.kind == 1 && n0 >= 3072;
    const bool f8 = mt.fp8 || g8; const float kmul = g8 ? 64.f : mt.kmul;
    const int lr = lane >> 4, lc = (lane & 15) * 4;
    f32x4 v[16];
#pragma unroll
    for (int i = 0; i < 16; ++i) v[i] = *(const f32x4*)(mt.src + (size_t)(k0 + 4 * i + lr) * mt.N + n0 + lc);
    if (mt.ksc) {
#pragma unroll
        for (int i = 0; i < 16; ++i) v[i] = v[i] * (mt.ksc[(k0 + 4 * i + lr) % mt.kmod] * mt.kmul); }
    else if (f8) {
#pragma unroll
        for (int i = 0; i < 16; ++i) v[i] = v[i] * kmul; }
#pragma unroll
    for (int i = 0; i < 16; ++i) { LAS float* p = scr + (4 * i + lr) * 65 + lc; p[0] = v[i][0]; p[1] = v[i][1]; p[2] = v[i][2]; p[3] = v[i][3]; }
    LDS_WAIT(); asm volatile("" ::: "memory");
    const int c = lane & 7;
#pragma unroll
    for (int j = 0; j < 8; ++j) { const int n = (lane >> 3) + 8 * j; const LAS float* s = scr + (8 * c) * 65 + n;
        if (f8) { const u32x2 o = pack8_fp8((f32x4){s[0 * 65], s[1 * 65], s[2 * 65], s[3 * 65]}, (f32x4){s[4 * 65], s[5 * 65], s[6 * 65], s[7 * 65]}); const int r_ = map_row(mt.kind, n0 + n, mt.N);
            unsigned char* d8 = g8 ? (unsigned char*)mt.dst + (size_t)NIN_BF * mt.K * 2 + (size_t)(r_ - NIN_BF) * mt.K : (unsigned char*)mt.dst + (size_t)r_ * mt.K;
            *(u32x2*)(d8 + k0 + 8 * c) = o; }
        else { u32x4 o; o.x = cvt_pk_bf16(s[0 * 65], s[1 * 65]); o.y = cvt_pk_bf16(s[2 * 65], s[3 * 65]); o.z = cvt_pk_bf16(s[4 * 65], s[5 * 65]); o.w = cvt_pk_bf16(s[6 * 65], s[7 * 65]);
            *(u32x4*)(mt.dst + (size_t)map_row(mt.kind, n0 + n, mt.N) * mt.K + k0 + 8 * c) = o; } }
    LDS_WAIT(); asm volatile("" ::: "memory");
}
__device__ __forceinline__ void cvt_tile_wg(const Mat& mt, LAS float* scr, int tile, int tid) {
    const int nblk = mt.N / 256, kb = tile / nblk, nb = tile - kb * nblk, k0 = 64 * kb, n0 = 256 * nb;
    const int lane = tid & 63, w = tid >> 6;
    f32x4 v[8];
#pragma unroll
    for (int i = 0; i < 8; ++i) v[i] = *(const f32x4*)(mt.src + (size_t)(k0 + 8 * w + i) * mt.N + n0 + lane * 4);
    if (mt.ksc) {
#pragma unroll
        for (int i = 0; i < 8; ++i) v[i] = v[i] * (mt.ksc[(k0 + 8 * w + i) % mt.kmod] * mt.kmul); }
    else if (mt.fp8) {
#pragma unroll
        for (int i = 0; i < 8; ++i) v[i] = v[i] * mt.kmul; }
#pragma unroll
    for (int i = 0; i < 8; ++i) { LAS float* p = scr + (8 * w + i) * 257 + lane * 4; p[0] = v[i][0]; p[1] = v[i][1]; p[2] = v[i][2]; p[3] = v[i][3]; }
    __syncthreads();
    const int c = tid & 7;
#pragma unroll
    for (int j = 0; j < 4; ++j) { const int n = (tid >> 3) + 64 * j; const LAS float* s = scr + (8 * c) * 257 + n; const int r_ = map_row(mt.kind, n0 + n, mt.N);
        if (mt.fp8) *(u32x2*)((unsigned char*)mt.dst + (size_t)r_ * mt.K + k0 + 8 * c) = pack8_fp8((f32x4){s[0 * 257], s[1 * 257], s[2 * 257], s[3 * 257]}, (f32x4){s[4 * 257], s[5 * 257], s[6 * 257], s[7 * 257]});
        else { u32x4 o; o.x = cvt_pk_bf16(s[0 * 257], s[1 * 257]); o.y = cvt_pk_bf16(s[2 * 257], s[3 * 257]); o.z = cvt_pk_bf16(s[4 * 257], s[5 * 257]); o.w = cvt_pk_bf16(s[6 * 257], s[7 * 257]);
            *(u32x4*)(mt.dst + (size_t)r_ * mt.K + k0 + 8 * c) = o; } }
    __syncthreads();
}
__device__ __forceinline__ void ssm_build(const ArgsD& a, int l, int g, int half, LAS unsigned char* lds) {
    LAS float* Ap = (LAS float*)lds;
    LAS float* Bb = Ap + 33 * 64 * 2;
    LAS float* Cc = Bb + 64 * 16 * 2;
    LAS float* Mk = Cc + 16 * 64 * 2;
    const int tid = opaque_tid();
    const float* lre = (const float*)a.in[I_LRE] + (l * 64 + g) * 64; const float* lim = (const float*)a.in[I_LIM] + (l * 64 + g) * 64;
    const float* bre = (const float*)a.in[I_BRE] + (size_t)(l * 64 + g) * 1024; const float* bim = (const float*)a.in[I_BIM] + (size_t)(l * 64 + g) * 1024;
    const float* cre = (const float*)a.in[I_CRE] + (size_t)(l * 64 + g) * 1024; const float* cim = (const float*)a.in[I_CIM] + (size_t)(l * 64 + g) * 1024;
    const double dt = exp((double)((const float*)a.in[I_LOGDT])[l * 64 + g]);
    for (int idx = tid; idx < 33 * 64; idx += 512) { const int n = idx & 63, k = idx >> 6; const double re = lre[n], im = lim[n];
        const double mag = exp(re * dt * k), ang = im * dt * k; Ap[idx * 2] = (float)(mag * cos(ang)); Ap[idx * 2 + 1] = (float)(mag * sin(ang)); }
    if (tid < 64) { float* a32 = (float*)(a.ws + WS_A32) + (size_t)((l * 64 + g) * 64 + tid) * 2; const double re = lre[tid], im = lim[tid]; const double mag = exp(32.0 * re * dt), ang = 32.0 * im * dt;
        a32[0] = (float)(mag * cos(ang)); a32[1] = (float)(mag * sin(ang)); }
    for (int idx = tid; idx < 1024; idx += 512) { const int n = idx >> 4; const double re = lre[n], im = lim[n]; const double mag = exp(re * dt), ang = im * dt;
        const double lr = mag * cos(ang) - 1.0, li = mag * sin(ang), den = re * re + im * im;
        const double fr_ = (lr * re + li * im) / den, fi_ = (li * re - lr * im) / den; const double br = bre[idx], bi = bim[idx];
        Bb[idx * 2] = (float)(fr_ * br - fi_ * bi); Bb[idx * 2 + 1] = (float)(fr_ * bi + fi_ * br);
        Cc[idx * 2] = cre[idx]; Cc[idx * 2 + 1] = cim[idx]; }
    __syncthreads();
    { const int k = tid >> 4, p = tid & 15; float acc[16];
#pragma unroll
        for (int q = 0; q < 16; ++q) acc[q] = 0.f;
        for (int n = 0; n < 64; ++n) { const float ar = Ap[(k * 64 + n) * 2], ai = Ap[(k * 64 + n) * 2 + 1], cr = Cc[(p * 64 + n) * 2], ci = Cc[(p * 64 + n) * 2 + 1];
            const float ur = cr * ar - ci * ai, ui = cr * ai + ci * ar; const LAS f32x4* bq = (const LAS f32x4*)(Bb + n * 32);
#pragma unroll
            for (int q4 = 0; q4 < 8; ++q4) { const f32x4 bv = bq[q4]; acc[2 * q4] += bv[0] * ur - bv[1] * ui; acc[2 * q4 + 1] += bv[2] * ur - bv[3] * ui; } }
#pragma unroll
        for (int q = 0; q < 16; ++q) Mk[tid * 16 + q] = acc[q]; }
    __syncthreads();
    unsigned char* lw = a.ws + WS_W + (size_t)l * LW_BYTES;
    bf16_t* T = (bf16_t*)(lw + LW_TEXT) + (size_t)g * 512 * SSM_KX; bf16_t* W = (bf16_t*)(lw + LW_WSL) + (size_t)g * 256 * 512;
    for (int it = 0; it < 40; ++it) { const int c = it * 512 + tid, Rl = c / 80, ch = c - Rl * 80, R = 256 * half + Rl, i = R >> 4, p = R & 15; u32x4 w = {0u, 0u, 0u, 0u};
        if (ch < 64) { const int j = ch >> 1, q0 = (ch & 1) * 8;
            if (j <= i) { const LAS float* mp = Mk + ((i - j) * 16 + p) * 16 + q0; w.x = cvt_pk_bf16(mp[0], mp[1]); w.y = cvt_pk_bf16(mp[2], mp[3]); w.z = cvt_pk_bf16(mp[4], mp[5]); w.w = cvt_pk_bf16(mp[6], mp[7]); } }
        else { const int cc = ch - 64; float v[8];
#pragma unroll
            for (int e = 0; e < 4; ++e) { const int n = cc * 4 + e; const float cr = Cc[(p * 64 + n) * 2], ci = Cc[(p * 64 + n) * 2 + 1], ar = Ap[((i + 1) * 64 + n) * 2], ai = Ap[((i + 1) * 64 + n) * 2 + 1];
                v[2 * e] = cr * ar - ci * ai; v[2 * e + 1] = -(cr * ai + ci * ar); }
            w.x = cvt_pk_bf16(v[0], v[1]); w.y = cvt_pk_bf16(v[2], v[3]); w.z = cvt_pk_bf16(v[4], v[5]); w.w = cvt_pk_bf16(v[6], v[7]); }
        *(u32x4*)(T + (size_t)R * SSM_KX + ch * 8) = w; }
    for (int it = 0; it < 16; ++it) { const int c = it * 512 + tid, R = 128 * half + (c >> 6), ch = c & 63; u32x4 w = {0u, 0u, 0u, 0u};
        if (R < 128) { const int n = R >> 1, im = R & 1, j = ch >> 1, q0 = (ch & 1) * 8; float v[8]; const float ar = Ap[((31 - j) * 64 + n) * 2], ai = Ap[((31 - j) * 64 + n) * 2 + 1];
#pragma unroll
            for (int e = 0; e < 8; ++e) { const float br = Bb[(n * 16 + q0 + e) * 2], bi = Bb[(n * 16 + q0 + e) * 2 + 1]; v[e] = im ? (ar * bi + ai * br) : (ar * br - ai * bi); }
            w.x = cvt_pk_bf16(v[0], v[1]); w.y = cvt_pk_bf16(v[2], v[3]); w.z = cvt_pk_bf16(v[4], v[5]); w.w = cvt_pk_bf16(v[6], v[7]); }
        *(u32x4*)(W + (size_t)R * 512 + ch * 8) = w; }
    __syncthreads();
}

struct LnArgs { bf16_t* X; float* outf; unsigned char* outq; const float* g; const float* b;
                const float* og; const int* slot; int* r_e; float* r_w; unsigned* cnt; };
template <int MODE>
__device__ __forceinline__ void ln_phase(const LnArgs& A, LAS unsigned char* lds, int G) {
    const int tid = opaque_tid(), lane = tid & 63, wave = __builtin_amdgcn_readfirstlane(tid >> 6);
    const int gw = blockIdx.x * 8 + wave, NGW = G * 8;
    f32x4 gv[8], bv[8];
    if (MODE != 1) {
#pragma unroll
        for (int j = 0; j < 8; ++j) { gv[j] = *(const f32x4*)(A.g + lane * 8 + 512 * (j >> 1) + 4 * (j & 1)); bv[j] = *(const f32x4*)(A.b + lane * 8 + 512 * (j >> 1) + 4 * (j & 1)); } }
    for (int row = gw; row < M; row += NGW) {
        bf16_t* xr = A.X + (size_t)row * D + lane * 8;
        f32x4 v[8]; float s = 0.f;
#pragma unroll
        for (int j = 0; j < 4; ++j) { const u32x4 w = *(const u32x4*)(xr + 512 * j); v[2 * j] = (f32x4){bf_lo(w.x), bf_hi(w.x), bf_lo(w.y), bf_hi(w.y)}; v[2 * j + 1] = (f32x4){bf_lo(w.z), bf_hi(w.z), bf_lo(w.w), bf_hi(w.w)}; }
        if (MODE == 2) { const int s0 = A.slot[row * 2], s1 = A.slot[row * 2 + 1]; const bf16_t* o0 = (const bf16_t*)A.og + (size_t)s0 * D + lane * 8; const bf16_t* o1 = (const bf16_t*)A.og + (size_t)s1 * D + lane * 8;
#pragma unroll
            for (int j = 0; j < 4; ++j) { const u32x4 a = *(const u32x4*)(o0 + 512 * j), b = *(const u32x4*)(o1 + 512 * j);
                v[2 * j] = v[2 * j] * ALPHA + (f32x4){bf_lo(a.x), bf_hi(a.x), bf_lo(a.y), bf_hi(a.y)} + (f32x4){bf_lo(b.x), bf_hi(b.x), bf_lo(b.y), bf_hi(b.y)};
                v[2 * j + 1] = v[2 * j + 1] * ALPHA + (f32x4){bf_lo(a.z), bf_hi(a.z), bf_lo(a.w), bf_hi(a.w)} + (f32x4){bf_lo(b.z), bf_hi(b.z), bf_lo(b.w), bf_hi(b.w)}; } }
#pragma unroll
        for (int j = 0; j < 8; ++j) s += (v[j][0] + v[j][1]) + (v[j][2] + v[j][3]);
        const float mean = wave_sum(s, lane) * (1.f / D); float s2 = 0.f;
#pragma unroll
        for (int j = 0; j < 8; ++j) { v[j] = v[j] - mean; s2 += (v[j][0] * v[j][0] + v[j][1] * v[j][1]) + (v[j][2] * v[j][2] + v[j][3] * v[j][3]); }
        const float rstd = 1.f / sqrtf(wave_sum(s2, lane) * (1.f / D) + LN_EPS);
#pragma unroll
        for (int j = 0; j < 8; ++j) { if (MODE == 1) { gv[j] = *(const f32x4*)(A.g + lane * 8 + 512 * (j >> 1) + 4 * (j & 1)); bv[j] = *(const f32x4*)(A.b + lane * 8 + 512 * (j >> 1) + 4 * (j & 1)); }
            v[j] = v[j] * rstd * gv[j] + bv[j]; }
        if (A.outf) { float* of = A.outf + (size_t)row * D + lane * 8;
#pragma unroll
            for (int j = 0; j < 8; ++j) *(f32x4*)(of + 512 * (j >> 1) + 4 * (j & 1)) = v[j]; }
        else {
#pragma unroll
            for (int j = 0; j < 4; ++j) *(u32x4*)(xr + 512 * j) = pack8(v[2 * j], v[2 * j + 1]); }
        if (A.outq) { unsigned char* oq = A.outq + (size_t)row * D + lane * 8;
#pragma unroll
            for (int j = 0; j < 4; ++j) *(u32x2*)(oq + 512 * j) = pack8_fp8(v[2 * j], v[2 * j + 1]); }
        if (MODE == 1) {
            const LAS float* wr_ = (const LAS float*)lds;
            int i0 = 0, i1 = 0; float v0 = -__builtin_inff(), v1 = -__builtin_inff();
#pragma unroll 1
            for (int e = 0; e < 8; ++e) { float acc = 0.f;
#pragma unroll
                for (int j = 0; j < 8; ++j) { const f32x4 w = *(const LAS f32x4*)(wr_ + e * D + lane * 8 + 512 * (j >> 1) + 4 * (j & 1)); acc += (v[j][0] * w[0] + v[j][1] * w[1]) + (v[j][2] * w[2] + v[j][3] * w[3]); }
                const float sg = wave_sum(acc, lane);
                if (sg > v0) { v1 = v0; i1 = i0; v0 = sg; i0 = e; } else if (sg > v1) { v1 = sg; i1 = e; } }
            const float w0 = 1.f / (1.f + expf(v1 - v0)), w1 = 1.f - w0;
            if (lane == 0) { A.r_e[row * 2] = i0; A.r_e[row * 2 + 1] = i1; A.r_w[row * 2] = w0; A.r_w[row * 2 + 1] = w1;
                __hip_atomic_fetch_add(A.cnt + i0, 1u, RLX_AGENT); __hip_atomic_fetch_add(A.cnt + i1, 1u, RLX_AGENT); }
        }
    }
}
__device__ __forceinline__ void moe_offsets(const unsigned* cnt, int (&off)[9]) {
    int acc = 0;
#pragma unroll
    for (int e = 0; e < 8; ++e) { off[e] = acc; const int c = (int)__hip_atomic_load(cnt + e, RLX_AGENT); acc += ((c + 255) >> 8) << 8; }
    off[8] = acc;
}

struct AttPtrs { const bf16_t *QD, *KD, *VD, *QM, *KM, *VM; bf16_t *BR0, *BR1; };
__device__ __forceinline__ void mla_unit(const AttPtrs& P, int h, int qb, char* lds) {
    const int tid = opaque_tid(), wid = __builtin_amdgcn_readfirstlane(tid >> 6), lane = tid & 63, r32 = lane & 31, hi = lane >> 5;
    const int q0 = qb * 256 + wid * 32; f32x16 o[4]; float l;
    att::attn_core_pp<192, 12, true, true>(P.QM + (size_t)(q0 + r32) * 1536 + h * 192 + hi * 8, P.KM + h * 192, 1536, P.VM + h * 128, 1024, 4 * (qb + 1), q0 + r32, q0, 0, lds, o, l);
    float* ws = (float*)(lds + 3 * att::SHM_V + 3 * 64 * 384) + wid * 64;
    att::normalize_o(o, l, ws, r32, hi);
    att::store_o_bf16(o, P.BR1 + (size_t)q0 * 1024 + h * 128, 1024, r32, hi);
    __syncthreads();
}
__device__ __forceinline__ void diff_unit(const AttPtrs& P, int h, int qb, float lam, char* lds) {
    const int tid = opaque_tid(), wid = __builtin_amdgcn_readfirstlane(tid >> 6), lane = tid & 63, r32 = lane & 31, hi = lane >> 5;
    const int mp = wid >> 2, w4 = wid & 3, q0 = qb * 128 + w4 * 32; f32x16 o[4]; float l;
    att::attn_core_pp<128, 4, true, true>(P.QD + (size_t)(q0 + r32) * 1024 + h * 128 + mp * 64 + hi * 8, P.KD + h * 128, 1024, P.VD + h * 128, 1024, 2 * (qb + 1), q0 + r32, q0, mp * 8, lds, o, l);
    float* ws = (float*)(lds + 3 * att::SHM_V + 3 * 64 * 256) + wid * 64;
    att::normalize_o(o, l, ws, r32, hi);
    __syncthreads();
    float* xch = (float*)lds + w4 * 4096 + lane;
    if (mp == 1) {
#pragma unroll
        for (int d0 = 0; d0 < 4; ++d0)
#pragma unroll
            for (int r = 0; r < 16; ++r) xch[(d0 * 16 + r) * 64] = o[d0][r];
    }
    __syncthreads();
    if (mp == 0) {
        float ss[16];
#pragma unroll
        for (int r = 0; r < 16; ++r) { float s = 0.f;
#pragma unroll
            for (int d0 = 0; d0 < 4; ++d0) { const float dv = o[d0][r] - lam * xch[(d0 * 16 + r) * 64]; o[d0][r] = dv; s += dv * dv; }
            ss[r] = s; }
#pragma unroll
        for (int r = 0; r < 16; ++r) { float s = ss[r];
#pragma unroll
            for (int off = 1; off < 32; off <<= 1) s += shflx(s, off, lane);
            const float rs = __builtin_amdgcn_rsqf(s * (1.f / 128.f) + RMS_EPS);
#pragma unroll
            for (int d0 = 0; d0 < 4; ++d0) o[d0][r] *= rs; }
        att::store_o_bf16(o, P.BR0 + (size_t)q0 * 1024 + h * 128, 1024, r32, hi);
    }
    __syncthreads();
}
__device__ __forceinline__ void cross_unit(const bf16_t* XQ, const bf16_t* XKV, bf16_t* XO, int h, int qb, char* lds) {
    const int tid = opaque_tid(), wid = __builtin_amdgcn_readfirstlane(tid >> 6), lane = tid & 63, r32 = lane & 31, hi = lane >> 5;
    const int q0 = qb * 256 + wid * 32; f32x16 o[4]; float l;
    att::attn_core<128, 8, false, true>(XQ + (size_t)(q0 + r32) * 512 + h * 128 + hi * 8, XKV + h * 128, 1024, XKV + 512 + h * 128, 1024, 4, 0, 0, 0, lds, o, l);
    float* ws = (float*)(lds + 2 * att::SHM_V + 2 * 64 * 256) + wid * 64;
    att::normalize_o(o, l, ws, r32, hi);
    att::store_o_bf16(o, XO + (size_t)q0 * 512 + h * 128, 512, r32, hi);
    __syncthreads();
}

__global__ void __launch_bounds__(512, 2) fwd_kernel(Args args) {
    extern __shared__ __attribute__((aligned(16))) unsigned char lds_raw[];
    LAS unsigned char* lds = (LAS unsigned char*)lds_raw;
    const int tid = threadIdx.x, lane = tid & 63, wave = __builtin_amdgcn_readfirstlane(tid >> 6);
    const int G = gridDim.x, bx = blockIdx.x;
    unsigned char* ws = (unsigned char*)(GAS unsigned char*)(unsigned long long)args.ws;
    unsigned* ctl = (unsigned*)(ws + WS_CTL);
    volatile LAS unsigned* MISC = (volatile LAS unsigned*)(lds + LDS_MISC);
    if (tid < 32) MISC[tid] = 0u;
    if (lane == 0) ((volatile LAS int*)LDS_WTAB)[__builtin_amdgcn_s_getreg(0x2804)] = wave;
    { volatile LAS unsigned long long* pt = (volatile LAS unsigned long long*)(lds + LDS_MISC + 256); if (tid < 35) pt[tid] = (unsigned long long)args.in[tid]; if (tid == 35) pt[35] = (unsigned long long)args.out; }
    __syncthreads();
    ArgsD ad; ad.in.t = (volatile LAS unsigned long long*)(lds + LDS_MISC + 256); ad.ws = ws;
    const int lo = args.ph_lo, hi = args.ph_hi;
    XcdBarrier bar; bar.bar = ctl + CW_BAR; bar.x = 0; bar.st = nullptr;
    if (hi - lo > 1) { bar = xcd_barrier_post(ctl + CW_BAR, MISC + 8); xcd_barrier_setup(bar); }
#ifndef PH_SEL
#define PH_SEL 0xFFFFFFFFu
#endif
#define INR(k) (lo <= (k) && (k) < hi)
#define IN0() (((PH_SEL) & 1u) && INR(0))
#define INL(j) ((((PH_SEL) >> ((j) + 1)) & 1u) && INR(pb + (j)))
#define SEAM(k) do { if (INR(k) && INR((k) + 1)) xcd_barrier(bar); } while (0)
    const int gw = bx * 8 + wave, NGW = G * 8;
    const int gtid = bx * 512 + tid, NGT = G * 512;

    if (IN0()) {
      {
        { int start = bx;
            for (int id = 0; id < NMAT; ++id) { const Mat mt = get_mat(ad, id); if (mt.kind == 1) continue; const int nit = (mt.K / 64) * (mt.N / 256);
                int it = start; for (; it < nit; it += G) cvt_tile_wg(mt, (LAS float*)lds, it, tid);
                start = it - nit; } }
        { LAS float* scr = (LAS float*)(lds + wave * 16640); int start = gw;
            for (int id = 0; id < 22; id += 11) { const Mat mt = get_mat(ad, id); const int nit = (mt.K / 64) * (mt.N / 64);
                int it = start; for (; it < nit; it += NGW) cvt_item(mt, scr, it, lane);
                start = it - nit; } }
        for (int l = 0; l < DEPTH; ++l) { u32x4* p = (u32x4*)((unsigned char*)(ws + WS_W + (size_t)l * LW_BYTES + LW_IN) + (size_t)NIN_BF * D * 2 + (size_t)(3904 - NIN_BF) * D);
            for (int i = gtid; i < 192 * D / 16; i += NGT) p[i] = (u32x4){0u, 0u, 0u, 0u}; }
        { const float* x = (const float*)ad.in[I_X]; bf16_t* xn = (bf16_t*)(ws + WS_XN);
            unsigned char* x8 = ws + WS_XN8;
            for (size_t i = gtid; i < (size_t)M * D / 8; i += NGT) { const f32x4 a = *(const f32x4*)(x + i * 8), b = *(const f32x4*)(x + i * 8 + 4); *(u32x4*)(xn + i * 8) = pack8(a, b); *(u32x2*)(x8 + i * 8) = pack8_fp8(a, b); }
            const float* mem = (const float*)ad.in[I_MEM]; bf16_t* mb = (bf16_t*)(ws + WS_MEMB);
            for (int i = gtid; i < MEM_LEN * D / 8; i += NGT) { const f32x4 a = *(const f32x4*)(mem + i * 8), b = *(const f32x4*)(mem + i * 8 + 4); *(u32x4*)(mb + i * 8) = pack8(a, b); } }
        { const int* pos = (const int*)ad.in[I_POS]; float* td = (float*)(ws + WS_TABD); float* tm = (float*)(ws + WS_TABM);
            for (int i = gtid; i < M * 40; i += NGT) { const int t = i / 40, k = i - t * 40; const double p = (double)pos[t];
                const double inv = (k < 8) ? exp(-(double)k * (13.122363377404328 / 8.0)) : exp(-(double)(k - 8) * (13.122363377404328 / 32.0));
                const double ang = p * inv; const float c = (float)cos(ang), s = (float)sin(ang);
                if (k < 8) { td[(t * 8 + k) * 2] = c; td[(t * 8 + k) * 2 + 1] = s; } else { tm[(t * 32 + k - 8) * 2] = c; tm[(t * 32 + k - 8) * 2 + 1] = s; } } }
        if (bx == 0 && tid < 192) { int* ord = (int*)(ws + WS_ORDER); const int mine = tid < 64 ? 160 * (tid + 1) : 48 * (tid - 64 + 1); int rank = 0;
            for (int c = 0; c < 192; ++c) { const int cc = c < 64 ? 160 * (c + 1) : 48 * (c - 64 + 1); rank += (cc > mine || (cc == mine && c < tid)) ? 1 : 0; }
            const int code = tid < 64 ? ((1 << 16) | (tid << 8)) : ((tid - 64) << 8);
            for (int h = 0; h < 8; ++h) ord[rank * 8 + h] = code | h; }
        __syncthreads();
#ifdef PROBE_SSMB
#pragma nounroll
        for (int rep_ = 0; rep_ < 2; ++rep_)
#endif
        for (int uidx = bx; uidx < DEPTH * 64 * 2; uidx += G) ssm_build(ad, uidx >> 7, (uidx >> 1) & 63, uidx & 1, lds);
        __syncthreads();
      }
    }
    SEAM(0);

    unsigned char* const ws_k = ws; const int bx_k = bx;
    for (int l = 0; l < DEPTH; ++l) {
        const int pb = 1 + l * NPL;
        if (!(lo < pb + NPL && pb < hi)) continue;
        int bx = bx_k; asm volatile("" : "+s"(bx));
        unsigned long long ws_i = (unsigned long long)ws_k; asm volatile("" : "+s"(ws_i)); unsigned char* ws = (unsigned char*)(GAS unsigned char*)ws_i;
#define PH_TID const int tid = opaque_tid(), lane = tid & 63, wave = __builtin_amdgcn_readfirstlane(tid >> 6); const int gw = bx * 8 + wave, NGW = G * 8; (void)lane; (void)wave; (void)gw; (void)NGW
#define lw (ws + WS_W + (size_t)l * LW_BYTES)
#define ssq_q ((float*)(ws + WS_PSQ))
#define ssq_kv (ssq_q + (size_t)8 * M)
#define XS ((float*)(ws + WS_XS))
#define XN ((bf16_t*)(ws + WS_XN))
#define tabd ((const float*)(ws + WS_TABD))
#define tabm ((const float*)(ws + WS_TABM))
#define QD ((bf16_t*)(ws + WS_QD))
#define KD ((bf16_t*)(ws + WS_KD))
#define VD ((bf16_t*)(ws + WS_VD))
#define MQ ((bf16_t*)(ws + WS_MQ))
#define MKV ((bf16_t*)(ws + WS_MKV))
#define KM ((bf16_t*)(ws + WS_KM))
#define VM ((bf16_t*)(ws + WS_VM))
#define QM ((bf16_t*)(ws + WS_QM))
#define SU ((bf16_t*)(ws + WS_SU))
#define GATES ((bf16_t*)(ws + WS_GATES))
#define SLOC ((float*)(ws + WS_SLOC))
#define YG ((bf16_t*)(ws + WS_YG))
#define BR ((bf16_t*)(ws + WS_BR))
#define TMP ((float*)(ws + WS_TMP))
#define MG ((bf16_t*)(ws + WS_MG))
#define XQ ((bf16_t*)(ws + WS_XQ))
#define XO ((bf16_t*)(ws + WS_XO))
#define XKV ((bf16_t*)(ws + WS_XKV) + (size_t)l * 256 * 1024)
#define r_e ((int*)(ws + WS_ROUTE))
#define r_w ((float*)(ws + WS_ROUTE + 128 * 1024))
#define slot ((int*)(ws + WS_ROUTE + 256 * 1024))
#define wslot ((float*)(ws + WS_ROUTE + 384 * 1024))
        if (INL(0)) {
#if !defined(SUBSEL) || (SUBSEL & 1)
            { pg8::Gemm g{XN, (const bf16_t*)(lw + LW_IN), (D) * 2, (D) * 2, (D) * 2, 0}; SchedPlain S; S.init(M / 256, NIN_BF / 256, D, D, G, bx);
              EpiInProj E{QD, KD, VD, MQ, MKV, KM, SU, GATES, ssq_q, ssq_kv, tabd, tabm, 0};
              pg8::gemm_phase(lds, g, S, E); }
            { pg8::Gemm g{ws + WS_XN8, lw + LW_IN + (size_t)NIN_BF * D * 2, D, D, D, 0}; SchedPlain S; S.T.init(M / 256, NIN_G8 / 256); S.G = G; S.c = bx; S.tA = (size_t)256 * D; S.tB = S.tA;
              EpiInProj E{QD, KD, VD, MQ, MKV, KM, SU, GATES, ssq_q, ssq_kv, tabd, tabm, 12};
              pg8::gemm_phase_t<true, 0x7C7C7C7C>(lds, g, S, E); }
#endif
#if !defined(SUBSEL) || (SUBSEL & 2)
            { pg8::Gemm g{(const bf16_t*)(ws + WS_MEMB), (const bf16_t*)(lw + LW_XKV), (D) * 2, (D) * 2, (D) * 2, 0}; SchedPlain S; S.init(1, 4, D, D, G, (bx + 128) % G);
              EpiBf16 E{XKV, 1024, 1.f};
              pg8::gemm_phase(lds, g, S, E); }
#endif
        }
        SEAM(pb + 0);
        if (INL(1)) {
#if !defined(SUBSEL) || (SUBSEL & 1)
            { pg8::Gemm g{MQ, (const bf16_t*)(lw + LW_QUP), (512) * 2, (512) * 2, (512) * 2, 0}; SchedPlain S; S.init(M / 256, 6, 512, 512, G, bx);
              EpiQup E{QM, ssq_q, tabm}; pg8::gemm_phase(lds, g, S, E); }
#endif
#if !defined(SUBSEL) || (SUBSEL & 2)
            { pg8::Gemm g{MKV, (const bf16_t*)(lw + LW_KVUP), (256) * 2, (256) * 2, (256) * 2, 0}; SchedPlain S; S.init(M / 256, 8, 256, 256, G, (bx + 128) % G);
              EpiKVup E{KM, VM, ssq_kv}; pg8::gemm_phase(lds, g, S, E); }
#endif
#if !defined(SUBSEL) || (SUBSEL & 4)
            { pg8::Gemm g{SU, (const bf16_t*)(lw + LW_WSL), (SSM_KX) * 2, (512) * 2, (512) * 2, 0}; SchedBatch S{2, 1, 64, G, (bx + 128) % G  , (size_t)256 * SSM_KX * 2, (size_t)256 * 512 * 2, (size_t)SSM_NCH * SSM_KX * 2, (size_t)256 * 512 * 2};
              EpiSloc E{SLOC}; pg8::gemm_phase(lds, g, S, E); }
#endif
        }
        SEAM(pb + 1);
        if (INL(2)) {
            PH_TID;
            if (bx < 64) { const int g = bx, n = lane, w = wave;
                const float* a32 = (const float*)(ws + WS_A32) + (size_t)((l * 64 + g) * 64 + n) * 2; const float ar = a32[0], ai = a32[1];
                const float* __restrict__ lp = SLOC + ((size_t)g * SSM_NCH + 64 * w) * 128 + 2 * n; bf16_t* __restrict__ sp = SU + ((size_t)g * SSM_NCH + 64 * w) * SSM_KX + 512 + 2 * n;
                float br[64], bi[64]; float sr = 0.f, si = 0.f;
#pragma unroll
                for (int c0 = 0; c0 < 64; c0 += 32) { f32x2 lv[32];
#pragma unroll
                    for (int k = 0; k < 32; ++k) lv[k] = *(const f32x2*)(lp + (size_t)(c0 + k) * 128);
#pragma unroll
                    for (int k = 0; k < 32; ++k) { br[c0 + k] = sr; bi[c0 + k] = si; const float nr = ar * sr - ai * si + lv[k][0], ni = ar * si + ai * sr + lv[k][1]; sr = nr; si = ni; } }
                LAS float* ex = (LAS float*)lds;
                ex[(w * 64 + n) * 2] = sr; ex[(w * 64 + n) * 2 + 1] = si;
                float pr = ar, pi = ai;
#pragma unroll
                for (int q = 0; q < 6; ++q) { const float tr = pr * pr - pi * pi, ti = 2.f * pr * pi; pr = tr; pi = ti; }
                __syncthreads();
                float cr = 0.f, ci = 0.f;
                for (int uu = 0; uu < w; ++uu) { const float er = ex[(uu * 64 + n) * 2], ei = ex[(uu * 64 + n) * 2 + 1]; const float tr = pr * cr - pi * ci + er, ti = pr * ci + pi * cr + ei; cr = tr; ci = ti; }
#pragma unroll
                for (int k = 0; k < 64; ++k) { *(unsigned*)(sp + (size_t)k * SSM_KX) = cvt_pk_bf16(br[k] + cr, bi[k] + ci);
                    const float tr = ar * cr - ai * ci, ti = ar * ci + ai * cr; cr = tr; ci = ti; } }
        }
        SEAM(pb + 2);
        if (INL(3)) {
#if !defined(SUBSEL) || (SUBSEL & 1)
            { pg8::Gemm g{SU, (const bf16_t*)(lw + LW_TEXT), (SSM_KX) * 2, (SSM_KX) * 2, (SSM_KX) * 2, 0}; SchedBatch S{2, 2, 64, G, bx, (size_t)256 * SSM_KX * 2, (size_t)256 * SSM_KX * 2, (size_t)SSM_NCH * SSM_KX * 2, (size_t)512 * SSM_KX * 2};
              EpiSsmY E{YG, SU, (const float*)ad.in[I_SSMD] + l * 1024}; pg8::gemm_phase(lds, g, S, E); }
#endif
            PH_TID;
            const float* dl = (const float*)ad.in[I_DLAM] + l * 256;
            const float lam = expf(wave_sum(dl[lane] * dl[64 + lane], lane)) - expf(wave_sum(dl[128 + lane] * dl[192 + lane], lane)) + lam_init_of(l);
            const AttPtrs P{QD, KD, VD, QM, KM, VM, BR, BR + (size_t)M * 1024};
            const int* ord = (const int*)(ws + WS_ORDER);
            __syncthreads();
#ifndef PROBE_ATT
#define PROBE_ATT 0
#endif
            const unsigned myx = xb_xcc_id() & 7u;
#pragma nounroll
            for (int rep = 0; rep < (PROBE_ATT ? 2 : 1); ++rep)
#pragma nounroll
            for (int sq = 0; sq < 8; ++sq) { const int q = (int)((myx + sq) & 7u);
            for (;;) {
                if (tid == 0) MISC[0] = __hip_atomic_fetch_add(ctl + CW_ATTQ + 64 * l + 32 * rep + q, 1u, RLX_AGENT);
                __syncthreads();
                const unsigned it = MISC[0];
                __syncthreads();
                if (it >= 192u) break;
                const int code = ord[it * 8 + q], h = code & 255, qb = (code >> 8) & 255;
                if ((code >> 16) && (rep == 0 || (PROBE_ATT & 1))) mla_unit(P, h, qb, (char*)lds_raw);
                if (!(code >> 16) && (rep == 0 || (PROBE_ATT & 2))) diff_unit(P, h, qb, lam, (char*)lds_raw);
            } }
        }
        SEAM(pb + 3);
        if (INL(4)) {
            pg8::Gemm g{YG, (const bf16_t*)(lw + LW_GLU), (1024) * 2, (1024) * 2, (1024) * 2, 0}; SchedPlain S; S.init(M / 256, 8, 1024, 1024, G, bx);
            EpiGated<0> E{BR + (size_t)2 * M * 1024, 1024}; pg8::gemm_phase(lds, g, S, E);
        }
        SEAM(pb + 4);
        if (INL(5)) {
            pg8::Gemm g{BR, (const bf16_t*)(lw + LW_BR), (1024) * 2, (1024) * 2, (1024) * 2, 0}; SchedBranch S; S.T.init(M / 256, 8); S.G = G; S.c = bx; S.tA = (size_t)256 * 1024 * 2; S.tB = S.tA; S.zA = (size_t)M * 1024 * 2; S.zB = (size_t)2048 * 1024 * 2;
            EpiBranch E{GATES, (bf16_t*)TMP, MG}; pg8::gemm_phase(lds, g, S, E);
        }
        SEAM(pb + 5);
        if (INL(6)) {
            pg8::Gemm g{MG, (const bf16_t*)(lw + LW_OUT), (D) * 2, (D) * 2, (D) * 2, 0}; SchedPlain S; S.init(M / 256, 8, D, D, G, bx);
            EpiResid E{XN}; pg8::gemm_phase(lds, g, S, E);
        }
        SEAM(pb + 6);
        if (INL(7)) { const LnArgs A{XN, nullptr, nullptr, (const float*)ad.in[I_LNMG] + l * D, (const float*)ad.in[I_LNMB] + l * D, nullptr, nullptr, nullptr, nullptr, nullptr}; ln_phase<0>(A, lds, G); }
        SEAM(pb + 7);
        if (INL(8)) {
            pg8::Gemm g{XN, (const bf16_t*)(lw + LW_XQ), (D) * 2, (D) * 2, (D) * 2, 0}; SchedPlain S; S.T.init(M / 128, 2); S.G = G; S.c = bx; S.tA = (size_t)128 * D * 2; S.tB = (size_t)256 * D * 2;
            EpiBf16Half E{XQ, 512, C2_X}; pg8::gemm_phase(lds, g, S, E);
        }
        SEAM(pb + 8);
        if (INL(9)) { for (int uidx = bx; uidx < 256; uidx += G) cross_unit(XQ, XKV, XO, uidx & 3, uidx >> 2, (char*)lds_raw); }
        SEAM(pb + 9);
        if (INL(10)) {
            pg8::Gemm g{XO, (const bf16_t*)(lw + LW_XO), (512) * 2, (512) * 2, (512) * 2, 0}; SchedPlain S; S.init(M / 256, 8, 512, 512, G, bx);
            EpiResid E{XN}; pg8::gemm_phase(lds, g, S, E);
        }
        SEAM(pb + 10);
        if (INL(11)) {
            const LnArgs A{XN, nullptr, nullptr, (const float*)ad.in[I_LNXG] + l * D, (const float*)ad.in[I_LNXB] + l * D, nullptr, nullptr, r_e, r_w, ctl + CW_MOECNT};
            if (l == 0) ln_phase<0>(A, lds, G);
            else { PH_TID; const float* rw = (const float*)ad.in[I_ROUTER]; LAS float* wl = (LAS float*)lds;
                for (int i = tid; i < D * 8; i += 512) wl[(i & 7) * D + (i >> 3)] = rw[i];
                __syncthreads(); ln_phase<1>(A, lds, G); __syncthreads(); }
        }
        SEAM(pb + 11);
        if (l == 1) {
            if (INL(12)) { PH_TID; int off[9]; moe_offsets(ctl + CW_MOECNT, off); bf16_t* XG = (bf16_t*)(ws + WS_XG);
                for (int row = gw; row < M; row += NGW) { int s0 = 0, s1 = 0;
                    if (lane == 0) { const int e0 = r_e[row * 2], e1 = r_e[row * 2 + 1];
                        s0 = off[e0] + (int)__hip_atomic_fetch_add(ctl + CW_MOECUR + e0, 1u, RLX_AGENT); s1 = off[e1] + (int)__hip_atomic_fetch_add(ctl + CW_MOECUR + e1, 1u, RLX_AGENT);
                        slot[row * 2] = s0; slot[row * 2 + 1] = s1; wslot[s0] = r_w[row * 2]; wslot[s1] = r_w[row * 2 + 1]; }
                    s0 = __builtin_amdgcn_readfirstlane(s0); s1 = __builtin_amdgcn_readfirstlane(s1);
                    const u32x4* src = (const u32x4*)(XN + (size_t)row * D) + lane; u32x2* d0 = (u32x2*)((unsigned char*)XG + (size_t)s0 * D) + lane; u32x2* d1 = (u32x2*)((unsigned char*)XG + (size_t)s1 * D) + lane;
#pragma unroll
                    for (int j = 0; j < 4; ++j) { const u32x4 v = src[64 * j];
                        const u32x2 q = pack8_fp8((f32x4){bf_lo(v.x), bf_hi(v.x), bf_lo(v.y), bf_hi(v.y)}, (f32x4){bf_lo(v.z), bf_hi(v.z), bf_lo(v.w), bf_hi(v.w)}); d0[64 * j] = q; d1[64 * j] = q; } } }
            SEAM(pb + 12);
        }
        if (INL(13)) {
            if (l == 0) { pg8::Gemm g{XN, (const bf16_t*)(ws + WS_FFN), (D) * 2, (D) * 2, (D) * 2, 0}; SchedPlain S; S.init(M / 256, 44, D, D, G, bx);
                EpiSwigluF8 E{ws + WS_HG, DFF}; pg8::gemm_phase(lds, g, S, E); }
            else { int off[9]; moe_offsets(ctl + CW_MOECNT, off);
                pg8::Gemm g{ws + WS_XG, ws + WS_MOE, D, D, D, 0x7C7C7C7C}; SchedMoe S; S.T.init(off[8] >> 8, 44); S.G = G; S.c = bx; S.tA = (size_t)256 * D; S.tB = S.tA; S.zB = 66 * MiB;
#pragma unroll
                for (int k = 0; k < 7; ++k) S.off[k] = off[k + 1];
                EpiSwigluF8 E{ws + WS_HG, DFF}; pg8::gemm_phase_t<true, 0x7C7C7C7C>(lds, g, S, E); }
        }
        SEAM(pb + 13);
        if (INL(14)) {
            if (l == 0) { pg8::Gemm g{ws + WS_HG, ws + WS_FFN + 44 * MiB, DFF, DFF, DFF, 0x7B7B7B7B}; SchedPlain S; S.init(M / 256, 8, DFF / 2, DFF / 2, G, bx);
                EpiResid E{XN}; pg8::gemm_phase_t<true, 0x7B7B7B7B>(lds, g, S, E); }
            else { int off[9]; moe_offsets(ctl + CW_MOECNT, off);
                pg8::Gemm g{ws + WS_HG, ws + WS_MOE + 44 * MiB, DFF, DFF, DFF, 0x7B7B7B7B}; SchedMoe S; S.T.init(off[8] >> 8, 8); S.G = G; S.c = bx; S.tA = (size_t)256 * DFF; S.tB = S.tA; S.zB = 66 * MiB;
#pragma unroll
                for (int k = 0; k < 7; ++k) S.off[k] = off[k + 1];
                EpiMoeDown E{(bf16_t*)(ws + WS_OG), wslot}; pg8::gemm_phase_t<true, 0x7B7B7B7B>(lds, g, S, E); }
        }
        SEAM(pb + 14);
        if (INL(15)) {
            const LnArgs A{XN, (l == DEPTH - 1) ? (float*)ad.in[35] : nullptr, (l == DEPTH - 1) ? nullptr : ws + WS_XN8, (const float*)ad.in[I_LNFG] + l * D, (const float*)ad.in[I_LNFB] + l * D, (const float*)(ws + WS_OG), slot, nullptr, nullptr, nullptr};
            if (l == 0) ln_phase<0>(A, lds, G); else ln_phase<2>(A, lds, G);
        }
        SEAM(pb + 15);
    }
#undef INR
#undef IN0
#undef INL
#undef SEAM
}

extern "C" void kernel_launch(void* const* d_in, const int* in_sizes, int n_in, void* d_out, int out_size, void* d_ws, size_t ws_size, hipStream_t stream) {
    static int grid = 0;
    if (grid == 0) {
        if (n_in != 35 || out_size != M * D || ws_size < WS_END) { fprintf(stderr, "kernel_launch: shape/workspace mismatch: n_in %d out %d ws %zu (need %zu)\n", n_in, out_size, ws_size, (size_t)WS_END); grid = -1; return; }
        int dev = 0, cus = 0, per_cu = 0;
        if (hipGetDevice(&dev) != hipSuccess || hipDeviceGetAttribute(&cus, hipDeviceAttributeMultiprocessorCount, dev) != hipSuccess) { grid = -1; return; }
        if (hipFuncSetAttribute((const void*)fwd_kernel, hipFuncAttributeMaxDynamicSharedMemorySize, LDS_BYTES) != hipSuccess) { fprintf(stderr, "kernel_launch: hipFuncSetAttribute failed\n"); grid = -1; return; }
        if (hipOccupancyMaxActiveBlocksPerMultiprocessor(&per_cu, (const void*)fwd_kernel, 512, LDS_BYTES) != hipSuccess || per_cu < 1) { fprintf(stderr, "kernel_launch: occupancy query says %d\n", per_cu); }
        (void)hipGetLastError();
        grid = cus;
    }
    if (grid < 0) return;
    if (hipMemsetAsync((char*)d_ws + WS_CTL, 0, CTL_ZERO_BYTES, stream) != hipSuccess) return;
    Args a{};
    for (int i = 0; i < 35; ++i) a.in[i] = d_in[i];
    a.out = (float*)d_out; a.ws = (unsigned char*)d_ws;
#if MK_MULTI
    for (int p = 0; p < NPHASE; ++p) { if (p == 1 + 12) continue; a.ph_lo = p; a.ph_hi = p + 1; hipLaunchKernelGGL(fwd_kernel, dim3(grid), dim3(512), LDS_BYTES, stream, a); }
#else
    a.ph_lo = 0; a.ph_hi = NPHASE;
    hipLaunchKernelGGL(fwd_kernel, dim3(grid), dim3(512), LDS_BYTES, stream, a);
#endif
    const hipError_t le = hipPeekAtLastError();
    if (le != hipSuccess) fprintf(stderr, "kernel_launch: launch failed: %s\n", hipGetErrorName(le));
}
```

```cpp
#include <hip/hip_runtime.h>
#include <cstdio>
#include <cstdint>
#include <cmath>

#ifndef MK_MULTI
#define MK_MULTI 0
#endif
#ifndef MK_DBG
#define MK_DBG 0
#endif

#define GAS __attribute__((address_space(1)))
#define LAS __attribute__((address_space(3)))
typedef unsigned short bf16_t;
typedef short bf16x8 __attribute__((ext_vector_type(8)));
typedef short s16x4 __attribute__((ext_vector_type(4)));
typedef float f32x2 __attribute__((ext_vector_type(2)));
typedef float f32x4 __attribute__((ext_vector_type(4)));
typedef float f32x16 __attribute__((ext_vector_type(16)));
typedef unsigned u32x2 __attribute__((ext_vector_type(2)));
typedef unsigned u32x4 __attribute__((ext_vector_type(4)));
typedef GAS unsigned gu32;
#define RLX_AGENT __ATOMIC_RELAXED, __HIP_MEMORY_SCOPE_AGENT
#define LDS_WAIT() asm volatile("s_waitcnt lgkmcnt(0)" ::: "memory")
#define VM_WAIT() asm volatile("s_waitcnt vmcnt(0)" ::: "memory")
#define SBAR() __builtin_amdgcn_sched_barrier(0)

constexpr int M = 16384, D = 2048, DEPTH = 2, MEM_LEN = 256;
constexpr int NIN = 11264, NIN_BF = 3072  , NIN_G8 = 8192  ;
constexpr int NIN_SRC = 11072;
constexpr int DFF = 5632, NEXP = 8;
constexpr int SSM_L = 32, SSM_NCH = M / SSM_L  , SSM_KX = 640  ;
constexpr float LN_EPS = 1e-5f, RMS_EPS = 1e-6f;
constexpr float ALPHA = 1.4142135623730951f;
constexpr float LOG2E = 1.4426950408889634f;
constexpr float C2_DIFF = 0.125f * LOG2E;
constexpr float C2_MLA = 0.07216878364870323f * LOG2E;
constexpr float C2_X = 0.08838834764831845f * LOG2E;
constexpr int MOE_MAXROWS = 34816;

typedef __bf16 bf16x2_t __attribute__((ext_vector_type(2)));
__device__ __forceinline__ unsigned cvt_pk_bf16(float lo, float hi) { const f32x2 v = {lo, hi}; const bf16x2_t b = __builtin_convertvector(v, bf16x2_t); return __builtin_bit_cast(unsigned, b); }
__device__ __forceinline__ float bf_lo(unsigned w) { return __uint_as_float(w << 16); }
__device__ __forceinline__ float bf_hi(unsigned w) { return __uint_as_float(w & 0xffff0000u); }
__device__ __forceinline__ u32x4 pack8(f32x4 a, f32x4 b) { u32x4 w; w.x = cvt_pk_bf16(a[0], a[1]); w.y = cvt_pk_bf16(a[2], a[3]); w.z = cvt_pk_bf16(b[0], b[1]); w.w = cvt_pk_bf16(b[2], b[3]); return w; }
__device__ __forceinline__ u32x2 pack8_fp8(f32x4 a, f32x4 b) { int w0 = 0, w1 = 0;
    w0 = __builtin_amdgcn_cvt_pk_fp8_f32(a[0], a[1], w0, false); w0 = __builtin_amdgcn_cvt_pk_fp8_f32(a[2], a[3], w0, true);
    w1 = __builtin_amdgcn_cvt_pk_fp8_f32(b[0], b[1], w1, false); w1 = __builtin_amdgcn_cvt_pk_fp8_f32(b[2], b[3], w1, true);
    u32x2 r; r.x = (unsigned)w0; r.y = (unsigned)w1; return r; }
__device__ __forceinline__ float fast_sigmoid(float x) { return __builtin_amdgcn_rcpf(1.f + __builtin_amdgcn_exp2f(-x * LOG2E)); }
constexpr int LDS_WTAB = 131072 + 8192 + 1024;
__device__ __forceinline__ int opaque_tid() {
    const unsigned hw = __builtin_amdgcn_s_getreg(0x2804);
    const int wave = __builtin_amdgcn_readfirstlane(((volatile LAS int*)LDS_WTAB)[hw]);
    int lane; asm volatile("v_mbcnt_lo_u32_b32 %0, -1, 0\n\tv_mbcnt_hi_u32_b32 %0, -1, %0" : "=v"(lane));
    return wave * 64 + lane;
}
__device__ __forceinline__ float shflx(float v, int off, int lane) { return __int_as_float(__builtin_amdgcn_ds_bpermute((lane ^ off) << 2, __float_as_int(v))); }
__device__ __forceinline__ float wave_sum(float v, int lane) {
#pragma unroll
    for (int o = 1; o < 64; o <<= 1) v += shflx(v, o, lane);
    return v;
}

namespace pg8 {
constexpr int BM = 256, BK = 64, HALF = 128, HTB = HALF * BK * 2, STAGE_BYTES = 8 * HTB, NXCD = 8, WGM = 4;
__host__ __device__ __forceinline__ int lds_byte(int r, int c) { const int st = (r >> 4) * 2 + (c >> 5), rr = r & 15, cc = c & 31, ob = rr * 64 + cc * 2; return st * 1024 + (ob ^ (((ob >> 9) & 1) << 5)); }
__host__ __device__ __forceinline__ void stage_rc(int b, int& R, int& C) { const int st = b / 1024, sb = b % 1024, swz = sb ^ (((sb >> 9) & 1) << 5); R = (st >> 1) * 16 + swz / 64; C = (st & 1) * 32 + (swz % 64) / 2; }
__host__ __device__ __forceinline__ int perm32(int rho) { const int n = rho >> 4, i = rho & 15; return 8 * (i >> 2) + 4 * n + (i & 3); }

__device__ __forceinline__ size_t uni64(size_t v) { const unsigned lo_ = __builtin_amdgcn_readfirstlane((unsigned)v), hi_ = __builtin_amdgcn_readfirstlane((unsigned)(v >> 32)); return ((size_t)hi_ << 32) | lo_; }
struct Unit { int pm, pn, z; size_t offA, offB; };
struct Gemm { const void* A; const void* Bt; int ldaB, ldbB, KB; int wscale; };
typedef int v8i __attribute__((ext_vector_type(8)));
typedef int v4i __attribute__((ext_vector_type(4)));

struct TileOrder {
    int nM, nN, nwg;
    __device__ __forceinline__ void init(int nM_, int nN_) { nM = nM_; nN = nN_; nwg = nM * nN; }
    __device__ __forceinline__ bool map(long L, int& pm, int& pn) const {
        if (L >= nwg) return false;
        int wgid = (int)L; { const int q = nwg / NXCD, r = nwg % NXCD, xcd = wgid % NXCD, off = wgid / NXCD; wgid = (xcd < r ? xcd * (q + 1) : r * (q + 1) + (xcd - r) * q) + off; }
        const int nig = WGM * nN, gid = wgid / nig, fm = gid * WGM, gsz = (nM - fm) < WGM ? (nM - fm) : WGM;
        pm = __builtin_amdgcn_readfirstlane(fm + ((wgid % nig) % gsz)); pn = __builtin_amdgcn_readfirstlane((wgid % nig) / gsz); return true;
    }
};

template <bool FP8, int WSC, class Epi, class Sched>
__device__ __forceinline__ void gemm_phase_t(LAS unsigned char* lds, const Gemm g, const Sched& S, const Epi& E) {
    const int tid = opaque_tid(), wid = __builtin_amdgcn_readfirstlane(tid >> 6), lane = tid & 63, wr = wid >> 2, wc = wid & 3, fr = lane & 15, fq = lane >> 4;
    const int nt = g.KB / (BK * 2);
    unsigned voffA[2], voffB[2];
#pragma unroll
    for (int i = 0; i < 2; ++i) { int R, C; stage_rc(tid * 16 + i * 8192, R, C); const int Rb = (R & ~31) + perm32(R & 31);
        voffA[i] = (unsigned)(R * g.ldaB + C * 2); voffB[i] = (unsigned)(Rb * g.ldbB + C * 2); }
    const size_t kstep = (size_t)(BK * 2);
    const size_t hstepA = (size_t)HALF * g.ldaB, hstepB = (size_t)HALF * g.ldbB;
    const unsigned ldsw = (unsigned)wid * 1024u;
    const unsigned lds_u = __builtin_amdgcn_readfirstlane((unsigned)(uintptr_t)lds + ldsw);
    const int aoff = lds_byte(wr * 64 + fr, fq * 8), boff = lds_byte(wc * 32 + fr, fq * 8);
#define PG8_SA(b, h) (((b) * 2 + (h)) * HTB)
#define PG8_SB(b, h) ((4 + (b) * 2 + (h)) * HTB)
#define PG8_STAGE(bufoff, gbase, voff) do { _Pragma("unroll") for (int _i = 0; _i < 2; ++_i) \
        { unsigned _keep; asm volatile("s_mov_b32 %0, m0\n\ts_mov_b32 m0, %1\n\ts_nop 0\n\tglobal_load_lds_dwordx4 %2, %3\n\ts_mov_b32 m0, %0" : "=&s"(_keep) : "s"(lds_u + (unsigned)((bufoff) + _i * 8192)), "v"((voff)[_i]), "s"(gbase) : "memory"); } } while (0)
#define PG8_LD32(p) __builtin_shufflevector(*(const LAS v4i*)(p), *(const LAS v4i*)((p) + 1024), 0, 1, 2, 3, 4, 5, 6, 7)
#define PG8_LDA(dst, b, h) do { _Pragma("unroll") for (int m = 0; m < 4; ++m) dst[m] = PG8_LD32(lds + PG8_SA(b, h) + aoff + m * 2048); } while (0)
#define PG8_LDB(dst, b, h) do { _Pragma("unroll") for (int n = 0; n < 2; ++n) dst[n] = PG8_LD32(lds + PG8_SB(b, h) + boff + n * 2048); } while (0)
#define PG8_H0(x) __builtin_bit_cast(bf16x8, __builtin_shufflevector((x), (x), 0, 1, 2, 3))
#define PG8_H1(x) __builtin_bit_cast(bf16x8, __builtin_shufflevector((x), (x), 4, 5, 6, 7))
#define PG8_MMA(ai, bj, At, Bt) do { __builtin_amdgcn_s_setprio(1); _Pragma("unroll") for (int m = 0; m < 4; ++m) _Pragma("unroll") for (int n = 0; n < 2; ++n) { \
        if constexpr (FP8) asm volatile("v_mfma_scale_f32_16x16x128_f8f6f4 %0, %1, %2, %0, %3, %3 op_sel_hi:[0,0,0]" : "+v"(acc[ai][bj][m][n]) : "v"(Bt[n]), "v"(At[m]), "v"(wsc_v));     \
        else { acc[ai][bj][m][n] = __builtin_amdgcn_mfma_f32_16x16x32_bf16(PG8_H0(Bt[n]), PG8_H0(At[m]), acc[ai][bj][m][n], 0, 0, 0); acc[ai][bj][m][n] = __builtin_amdgcn_mfma_f32_16x16x32_bf16(PG8_H1(Bt[n]), PG8_H1(At[m]), acc[ai][bj][m][n], 0, 0, 0); } } \
        __builtin_amdgcn_s_setprio(0); } while (0)
#define PG8_WAIT_V(n) asm volatile("s_waitcnt vmcnt(" #n ")" ::: "memory")
#define PG8_WAIT_L(n) asm volatile("s_waitcnt lgkmcnt(" #n ")" ::: "memory")
#define PG8_BAR __builtin_amdgcn_s_barrier()
#define PG8_SCHED __builtin_amdgcn_sched_barrier(0)
    Unit cur, nxt; int ui = 0;
    if (!S.next(0, cur)) return;
    f32x4 acc[2][2][4][2];
#pragma unroll
    for (int a = 0; a < 2; ++a)
#pragma unroll
        for (int b = 0; b < 2; ++b)
#pragma unroll
            for (int m = 0; m < 4; ++m)
#pragma unroll
                for (int n = 0; n < 2; ++n) acc[a][b][m][n] = (f32x4){0.f, 0.f, 0.f, 0.f};
    v8i At[4], B0[2], B1[2]; const int wsc_v = WSC; (void)wsc_v;
    const char* cA = (const char*)g.A + uni64(cur.offA); const char* cB = (const char*)g.Bt + uni64(cur.offB);
    PG8_STAGE(PG8_SB(0, 0), cB, voffB); PG8_STAGE(PG8_SB(0, 1), cB + hstepB, voffB); PG8_STAGE(PG8_SA(0, 0), cA, voffA); PG8_STAGE(PG8_SA(0, 1), cA + hstepA, voffA);
    if (wr == 1) PG8_BAR;
    PG8_WAIT_V(2); PG8_BAR;
    PG8_STAGE(PG8_SB(1, 0), cB + kstep, voffB); PG8_STAGE(PG8_SA(1, 0), cA + kstep, voffA); PG8_STAGE(PG8_SB(1, 1), cB + hstepB + kstep, voffB);
    PG8_WAIT_V(6); PG8_BAR;
    for (;;) {
        const bool has_next = S.next(ui + 1, nxt);
        const char* nA = has_next ? (const char*)g.A + uni64(nxt.offA) : cA; const char* nB = has_next ? (const char*)g.Bt + uni64(nxt.offB) : cB;
        for (int t = 0; t < nt; t += 2) {
            const bool last = (t == nt - 2);
            const char* a1 = cA + (size_t)(t + 1) * kstep;
            const char* a2 = last ? nA : cA + (size_t)(t + 2) * kstep; const char* b2 = last ? nB : cB + (size_t)(t + 2) * kstep;
            const char* a3 = a2 + kstep; const char* b3 = b2 + kstep;
            PG8_LDB(B0, 0, 0); PG8_LDB(B1, 0, 1); PG8_SCHED; PG8_LDA(At, 0, 0); PG8_STAGE(PG8_SA(1, 1), a1 + hstepA, voffA);
            PG8_WAIT_V(8); PG8_WAIT_L(0); PG8_BAR; PG8_MMA(0, 0, At, B0); PG8_MMA(0, 1, At, B1); PG8_BAR; PG8_SCHED;
            PG8_LDA(At, 0, 1); PG8_STAGE(PG8_SB(0, 0), b2, voffB); PG8_STAGE(PG8_SB(0, 1), b2 + hstepB, voffB); PG8_STAGE(PG8_SA(0, 0), a2, voffA);
            PG8_WAIT_V(8); PG8_WAIT_L(0); PG8_BAR; PG8_MMA(1, 0, At, B0); PG8_MMA(1, 1, At, B1); PG8_BAR; PG8_SCHED;
            PG8_LDB(B0, 1, 0); PG8_LDB(B1, 1, 1); PG8_SCHED; PG8_LDA(At, 1, 0); PG8_STAGE(PG8_SA(0, 1), a2 + hstepA, voffA);
            PG8_WAIT_V(8); PG8_WAIT_L(0); PG8_BAR; PG8_MMA(0, 0, At, B0); PG8_MMA(0, 1, At, B1); PG8_BAR; PG8_SCHED;
            PG8_LDA(At, 1, 1); PG8_STAGE(PG8_SB(1, 0), b3, voffB); PG8_STAGE(PG8_SB(1, 1), b3 + hstepB, voffB); PG8_STAGE(PG8_SA(1, 0), a3, voffA);
            PG8_WAIT_V(8); PG8_WAIT_L(0); PG8_BAR; PG8_MMA(1, 0, At, B0); PG8_MMA(1, 1, At, B1); PG8_BAR; PG8_SCHED;
        }
        if (wr == 0) PG8_BAR;
        if constexpr (FP8) asm volatile("s_nop 15\n\ts_nop 15" ::: "memory");
        E(acc, cur, wr, wc, fr, fq);
        if (!has_next) break;
#pragma unroll
        for (int a = 0; a < 2; ++a)
#pragma unroll
            for (int b = 0; b < 2; ++b)
#pragma unroll
                for (int m = 0; m < 4; ++m)
#pragma unroll
                    for (int n = 0; n < 2; ++n) acc[a][b][m][n] = (f32x4){0.f, 0.f, 0.f, 0.f};
        cur = nxt; cA = nA; cB = nB; ++ui;
        if (wr == 1) PG8_BAR;
    }
    PG8_WAIT_V(0);
    PG8_BAR;
#undef PG8_SA
#undef PG8_SB
#undef PG8_STAGE
#undef PG8_LDA
#undef PG8_LDB
#undef PG8_MMA
#undef PG8_H0
#undef PG8_H1
#undef PG8_LD32
#undef PG8_WAIT_V
#undef PG8_WAIT_L
#undef PG8_BAR
#undef PG8_SCHED
}
template <class Epi, class Sched> __device__ __forceinline__ void gemm_phase(LAS unsigned char* lds, const Gemm g, const Sched& S, const Epi& E) { gemm_phase_t<false, 0>(lds, g, S, E); }
}

struct SchedPlain {
    pg8::TileOrder T; int G, c; size_t tA, tB;
    __device__ __forceinline__ void init(int nM, int nN, int lda, int ldb, int G_, int c_) { T.init(nM, nN); G = G_; c = c_; tA = (size_t)256 * lda * 2; tB = (size_t)256 * ldb * 2; }
    __device__ __forceinline__ bool next(int i, pg8::Unit& u) const { if (!T.map((long)i * G + c, u.pm, u.pn)) return false; u.z = 0; u.offA = u.pm * tA; u.offB = u.pn * tB; return true; }
};
struct SchedBatch {
    int nM, nN, nZ, G, c; size_t tA, tB, zA, zB;
    __device__ __forceinline__ bool next(int i, pg8::Unit& u) const {
        const long L = (long)i * G + c; const int per = nM * nN; if (L >= (long)per * nZ) return false;
        const int z = __builtin_amdgcn_readfirstlane((int)(L / per)), r = __builtin_amdgcn_readfirstlane((int)(L % per)); u.z = z; u.pm = __builtin_amdgcn_readfirstlane(r / nN); u.pn = __builtin_amdgcn_readfirstlane(r % nN); u.offA = z * zA + u.pm * tA; u.offB = z * zB + u.pn * tB; return true; }
};
struct SchedBranch {
    pg8::TileOrder T; int G, c; size_t tA, tB, zA, zB;
    __device__ __forceinline__ bool next(int i, pg8::Unit& u) const { const int t = i / 3, z = i - 3 * t; if (!T.map((long)t * G + c, u.pm, u.pn)) return false; u.z = z; u.offA = z * zA + u.pm * tA; u.offB = z * zB + u.pn * tB; return true; }
};
struct SchedMoe {
    pg8::TileOrder T; int G, c; size_t tA, tB, zB; int off[7];
    __device__ __forceinline__ bool next(int i, pg8::Unit& u) const {
        if (!T.map((long)i * G + c, u.pm, u.pn)) return false; const int r0 = u.pm * 256; int e = 0;
#pragma unroll
        for (int k = 0; k < 7; ++k) e += (r0 >= off[k]) ? 1 : 0;
        e = __builtin_amdgcn_readfirstlane(e); u.z = e; u.offA = u.pm * tA; u.offB = e * zB + u.pn * tB; return true; }
};

#define EPI_ARGS const f32x4 (&acc)[2][2][4][2], const pg8::Unit& u, int wr, int wc, int fr, int fq
#define EPI_ROW(ai, m) (u.pm * 256 + (ai) * 128 + wr * 64 + (m) * 16 + fr)
#define EPI_CB(bj) ((bj) * 128 + wc * 32 + fq * 8)
#define FOR_AI_M _Pragma("unroll") for (int ai = 0; ai < 2; ++ai) _Pragma("unroll") for (int m = 0; m < 4; ++m)
#define FOR_BJ _Pragma("unroll") for (int bj = 0; bj < 2; ++bj)

__device__ __forceinline__ void rope4(f32x4& v0, f32x4& v1, const f32x4 t0, const f32x4 t1) {
    const float a0 = v0[0] * t0[0] - v0[1] * t0[1], b0 = v0[1] * t0[0] + v0[0] * t0[1];
    const float a1 = v0[2] * t0[2] - v0[3] * t0[3], b1 = v0[3] * t0[2] + v0[2] * t0[3];
    const float a2 = v1[0] * t1[0] - v1[1] * t1[1], b2 = v1[1] * t1[0] + v1[0] * t1[1];
    const float a3 = v1[2] * t1[2] - v1[3] * t1[3], b3 = v1[3] * t1[2] + v1[2] * t1[3];
    v0 = (f32x4){a0, b0, a1, b1}; v1 = (f32x4){a2, b2, a3, b3};
}

struct EpiInProj {
    bf16_t *QD, *KD, *VD, *MQ, *MKV, *KM, *SU, *GATES; float *ssq_q, *ssq_kv; const float* tabd; const float* tabm;
    int pn_add;
    __device__ __forceinline__ void operator()(EPI_ARGS) const {
        const int pn = u.pn + pn_add;
        if (pn < 8) {
            bf16_t* O = pn < 4 ? QD : KD; const float sc = pn < 4 ? C2_DIFF : 1.f; const int colt = (pn & 3) * 256;
            const bool rp = ((wc & 1) == 0) && fq < 2;
#pragma unroll
            for (int ai = 0; ai < 2; ++ai) { f32x4 tt[4][2];
#pragma unroll
                for (int m = 0; m < 4; ++m) { tt[m][0] = (f32x4){1.f, 0.f, 1.f, 0.f}; tt[m][1] = (f32x4){1.f, 0.f, 1.f, 0.f};
                    if (rp) { const f32x4* tp = (const f32x4*)(tabd + (size_t)EPI_ROW(ai, m) * 16 + fq * 8); tt[m][0] = tp[0]; tt[m][1] = tp[1]; } }
#pragma unroll
                for (int m = 0; m < 4; ++m) { const int row = EPI_ROW(ai, m);
                    FOR_BJ { f32x4 v0 = acc[ai][bj][m][0], v1 = acc[ai][bj][m][1]; rope4(v0, v1, tt[m][0], tt[m][1]); v0 = v0 * sc; v1 = v1 * sc;
                        *(u32x4*)(O + (size_t)row * 1024 + colt + EPI_CB(bj)) = pack8(v0, v1); } } }
        } else if (pn < 12) {
            const int colt = (pn - 8) * 256;
            FOR_AI_M { const int row = EPI_ROW(ai, m); FOR_BJ { *(u32x4*)(VD + (size_t)row * 1024 + colt + EPI_CB(bj)) = pack8(acc[ai][bj][m][0], acc[ai][bj][m][1]); } }
        } else if (pn < 15) {
            bf16_t* O = pn < 14 ? MQ : MKV; const int ld = pn < 14 ? 512 : 256, colt = pn < 14 ? (pn - 12) * 256 : 0; float* ssq = pn < 14 ? ssq_q + (pn - 12) * 4 + wc : ssq_kv + wc; const int ns = pn < 14 ? 8 : 4;
            FOR_AI_M { const int row = EPI_ROW(ai, m); float s = 0.f;
                FOR_BJ { const f32x4 v0 = acc[ai][bj][m][0], v1 = acc[ai][bj][m][1]; s += (v0[0] * v0[0] + v0[1] * v0[1]) + (v0[2] * v0[2] + v0[3] * v0[3]) + (v1[0] * v1[0] + v1[1] * v1[1]) + (v1[2] * v1[2] + v1[3] * v1[3]);
                    *(u32x4*)(O + (size_t)row * ld + colt + EPI_CB(bj)) = pack8(v0, v1); }
                s += shflx(s, 16, fq * 16 + fr); s += shflx(s, 32, fq * 16 + fr);
                if (fq == 0) ssq[(size_t)row * ns] = s; }
        } else if (pn == 15) {
            if (wc < 2) {
                FOR_AI_M { const int row = EPI_ROW(ai, m); const f32x4* tp = (const f32x4*)(tabm + (size_t)row * 64 + (wc * 16 + fq * 4) * 2);
                    f32x4 v0 = acc[ai][0][m][0], v1 = acc[ai][0][m][1]; rope4(v0, v1, tp[0], tp[1]); const u32x4 w = pack8(v0, v1);
#pragma unroll
                    for (int h = 0; h < 8; ++h) *(u32x4*)(KM + (size_t)row * 1536 + h * 192 + 128 + wc * 32 + fq * 8) = w; }
            }
        } else if (pn < 20) {
            FOR_AI_M { const int row = EPI_ROW(ai, m); const int c = row >> 5, j = row & 31;
                FOR_BJ { const int ch = (pn - 16) * 256 + EPI_CB(bj), g = ch >> 4, q = ch & 15;
                    *(u32x4*)(SU + ((size_t)(g * SSM_NCH + c) * SSM_KX + j * 16 + q)) = pack8(acc[ai][bj][m][0], acc[ai][bj][m][1]); } }
        } else {
            const int colt = (pn - 20) * 256;
            FOR_AI_M { const int row = EPI_ROW(ai, m);
                FOR_BJ { f32x4 v0 = acc[ai][bj][m][0], v1 = acc[ai][bj][m][1];
#pragma unroll
                    for (int e = 0; e < 4; ++e) { v0[e] = fast_sigmoid(v0[e]); v1[e] = fast_sigmoid(v1[e]); }
                    *(u32x4*)(GATES + (size_t)row * 6144 + colt + EPI_CB(bj)) = pack8(v0, v1); } }
        }
    }
};
struct EpiQup {
    bf16_t* QM; const float* ssq; const float* tabm;
    __device__ __forceinline__ void operator()(EPI_ARGS) const {
#pragma unroll
        for (int ai = 0; ai < 2; ++ai) { f32x4 sq[4][2];
#pragma unroll
            for (int m = 0; m < 4; ++m) { const int row = EPI_ROW(ai, m); sq[m][0] = *(const f32x4*)(ssq + (size_t)row * 8); sq[m][1] = *(const f32x4*)(ssq + (size_t)row * 8 + 4); }
#pragma unroll
            for (int m = 0; m < 4; ++m) { const int row = EPI_ROW(ai, m); const f32x4 s0 = sq[m][0], s1 = sq[m][1];
                const float rq = __builtin_amdgcn_rsqf((((s0[0] + s0[1]) + (s0[2] + s0[3])) + ((s1[0] + s1[1]) + (s1[2] + s1[3]))) * (1.f / 512.f) + RMS_EPS) * C2_MLA;
                FOR_BJ { const int col = u.pn * 256 + EPI_CB(bj), h = col / 192, hc = col - h * 192; f32x4 v0 = acc[ai][bj][m][0], v1 = acc[ai][bj][m][1];
                    if (hc >= 128) { const f32x4* tp = (const f32x4*)(tabm + (size_t)row * 64 + (hc - 128)); rope4(v0, v1, tp[0], tp[1]); }
                    v0 = v0 * rq; v1 = v1 * rq; *(u32x4*)(QM + (size_t)row * 1536 + col) = pack8(v0, v1); } } }
    }
};
struct EpiKVup {
    bf16_t *KM, *VM; const float* ssq;
    __device__ __forceinline__ void operator()(EPI_ARGS) const {
#pragma unroll
        for (int ai = 0; ai < 2; ++ai) { float rk[4];
#pragma unroll
            for (int m = 0; m < 4; ++m) { const f32x4 s0 = *(const f32x4*)(ssq + (size_t)EPI_ROW(ai, m) * 4); rk[m] = ((s0[0] + s0[1]) + (s0[2] + s0[3])); }
#pragma unroll
            for (int m = 0; m < 4; ++m) { const int row = EPI_ROW(ai, m); const float r = __builtin_amdgcn_rsqf(rk[m] * (1.f / 256.f) + RMS_EPS); const int c = wc * 32 + fq * 8;
                *(u32x4*)(KM + (size_t)row * 1536 + u.pn * 192 + c) = pack8(acc[ai][0][m][0] * r, acc[ai][0][m][1] * r);
                *(u32x4*)(VM + (size_t)row * 1024 + u.pn * 128 + c) = pack8(acc[ai][1][m][0] * r, acc[ai][1][m][1] * r); } }
    }
};
struct EpiSloc {
    float* SLOC;
    __device__ __forceinline__ void operator()(EPI_ARGS) const {
        FOR_AI_M { const int c = EPI_ROW(ai, m); float* o = SLOC + ((size_t)(u.z * SSM_NCH + c) * 128 + wc * 32 + fq * 8);
            *(f32x4*)o = acc[ai][0][m][0]; *(f32x4*)(o + 4) = acc[ai][0][m][1]; }
    }
};
__device__ __forceinline__ float gelu_tanh(float x) { const float t = 1.5957691216057308f * (x + 0.044715f * x * x * x); return x * fast_sigmoid(t); }
struct EpiSsmY {
    bf16_t* YG; const bf16_t* SU; const float* dskip;
    __device__ __forceinline__ void operator()(EPI_ARGS) const {
        const int g = u.z; f32x4 d0[2], d1[2];
        FOR_BJ { const int col = u.pn * 256 + EPI_CB(bj), ch = g * 16 + (col & 15); d0[bj] = *(const f32x4*)(dskip + ch); d1[bj] = *(const f32x4*)(dskip + ch + 4); }
#pragma unroll
        for (int ai = 0; ai < 2; ++ai) { u32x4 uu[4][2];
#pragma unroll
            for (int m = 0; m < 4; ++m) { const int c = EPI_ROW(ai, m);
                FOR_BJ { const int col = u.pn * 256 + EPI_CB(bj), i = col >> 4, p0 = col & 15; uu[m][bj] = *(const u32x4*)(SU + ((size_t)(g * SSM_NCH + c) * SSM_KX + i * 16 + p0)); } }
#pragma unroll
            for (int m = 0; m < 4; ++m) { const int c = EPI_ROW(ai, m);
                FOR_BJ { const int col = u.pn * 256 + EPI_CB(bj), i = col >> 4, p0 = col & 15, t = c * SSM_L + i, ch = g * 16 + p0; const u32x4 w = uu[m][bj];
                    f32x4 v0 = acc[ai][bj][m][0], v1 = acc[ai][bj][m][1];
                    v0[0] += d0[bj][0] * bf_lo(w.x); v0[1] += d0[bj][1] * bf_hi(w.x); v0[2] += d0[bj][2] * bf_lo(w.y); v0[3] += d0[bj][3] * bf_hi(w.y);
                    v1[0] += d1[bj][0] * bf_lo(w.z); v1[1] += d1[bj][1] * bf_hi(w.z); v1[2] += d1[bj][2] * bf_lo(w.w); v1[3] += d1[bj][3] * bf_hi(w.w);
#pragma unroll
                    for (int e = 0; e < 4; ++e) { v0[e] = gelu_tanh(v0[e]); v1[e] = gelu_tanh(v1[e]); }
                    *(u32x4*)(YG + (size_t)t * 1024 + ch) = pack8(v0, v1); } } }
    }
};
template <int ACT  > struct EpiGated {
    bf16_t* O; int ldo;
    __device__ __forceinline__ void operator()(EPI_ARGS) const {
        FOR_AI_M { const int row = EPI_ROW(ai, m); f32x4 r[2];
#pragma unroll
            for (int n = 0; n < 2; ++n)
#pragma unroll
                for (int e = 0; e < 4; ++e) { const float a = acc[ai][0][m][n][e], b = acc[ai][1][m][n][e]; r[n][e] = ACT == 0 ? a * fast_sigmoid(b) : a * fast_sigmoid(a) * b; }
            *(u32x4*)(O + (size_t)row * ldo + u.pn * 128 + wc * 32 + fq * 8) = pack8(r[0], r[1]); }
    }
};
struct EpiSwigluF8 {
    unsigned char* O; int ldo;
    __device__ __forceinline__ void operator()(EPI_ARGS) const {
        FOR_AI_M { const int row = EPI_ROW(ai, m); f32x4 r[2];
#pragma unroll
            for (int n = 0; n < 2; ++n)
#pragma unroll
                for (int e = 0; e < 4; ++e) { const float a = acc[ai][0][m][n][e], b = acc[ai][1][m][n][e]; r[n][e] = a * fast_sigmoid(a) * b; }
            *(u32x2*)(O + (size_t)row * ldo + u.pn * 128 + wc * 32 + fq * 8) = pack8_fp8(r[0], r[1]); }
    }
};
struct EpiGatesF8 {
    bf16_t* GATES;
    __device__ __forceinline__ void operator()(EPI_ARGS) const {
        FOR_AI_M { const int row = EPI_ROW(ai, m);
            FOR_BJ { f32x4 v0 = acc[ai][bj][m][0], v1 = acc[ai][bj][m][1];
#pragma unroll
                for (int e = 0; e < 4; ++e) { v0[e] = fast_sigmoid(v0[e]); v1[e] = fast_sigmoid(v1[e]); }
                *(u32x4*)(GATES + (size_t)row * 6144 + u.pn * 256 + EPI_CB(bj)) = pack8(v0, v1); } }
    }
};
struct EpiBranch {
    const bf16_t* GATES; bf16_t* P; bf16_t* MG;
    __device__ __forceinline__ void operator()(EPI_ARGS) const {
        const int z = u.z;
#pragma unroll
        for (int ai = 0; ai < 2; ++ai)
#pragma unroll
            for (int mh = 0; mh < 2; ++mh) { u32x4 gg[2][2], pa[2][2], pb[2][2];
#pragma unroll
                for (int mm = 0; mm < 2; ++mm) { const int row = EPI_ROW(ai, mh * 2 + mm);
                    FOR_BJ { const int col = u.pn * 256 + EPI_CB(bj); gg[mm][bj] = *(const u32x4*)(GATES + (size_t)row * 6144 + z * 2048 + col);
                        if (z == 2) { const size_t o = (size_t)row * 2048 + col; pa[mm][bj] = *(const u32x4*)(P + o); pb[mm][bj] = *(const u32x4*)(P + (size_t)M * 2048 + o); } } }
#pragma unroll
                for (int mm = 0; mm < 2; ++mm) { const int m = mh * 2 + mm, row = EPI_ROW(ai, m);
                    FOR_BJ { const int col = u.pn * 256 + EPI_CB(bj); const u32x4 g = gg[mm][bj];
                        f32x4 v0 = acc[ai][bj][m][0], v1 = acc[ai][bj][m][1];
                        v0[0] *= bf_lo(g.x); v0[1] *= bf_hi(g.x); v0[2] *= bf_lo(g.y); v0[3] *= bf_hi(g.y);
                        v1[0] *= bf_lo(g.z); v1[1] *= bf_hi(g.z); v1[2] *= bf_lo(g.w); v1[3] *= bf_hi(g.w);
                        const size_t o = (size_t)row * 2048 + col;
                        if (z < 2) *(u32x4*)(P + (size_t)z * M * 2048 + o) = pack8(v0, v1);
                        else { const u32x4 a = pa[mm][bj], b = pb[mm][bj];
                            v0[0] += bf_lo(a.x) + bf_lo(b.x); v0[1] += bf_hi(a.x) + bf_hi(b.x); v0[2] += bf_lo(a.y) + bf_lo(b.y); v0[3] += bf_hi(a.y) + bf_hi(b.y);
                            v1[0] += bf_lo(a.z) + bf_lo(b.z); v1[1] += bf_hi(a.z) + bf_hi(b.z); v1[2] += bf_lo(a.w) + bf_lo(b.w); v1[3] += bf_hi(a.w) + bf_hi(b.w);
                            *(u32x4*)(MG + o) = pack8(v0, v1); } } } }
    }
};
struct EpiResid {
    bf16_t* X;
    __device__ __forceinline__ void operator()(EPI_ARGS) const {
#pragma unroll
        for (int ai = 0; ai < 2; ++ai) { u32x4 r[4][2];
#pragma unroll
            for (int m = 0; m < 4; ++m) { const int row = EPI_ROW(ai, m);
                FOR_BJ { r[m][bj] = *(const u32x4*)(X + (size_t)row * 2048 + u.pn * 256 + EPI_CB(bj)); } }
#pragma unroll
            for (int m = 0; m < 4; ++m) { const int row = EPI_ROW(ai, m);
                FOR_BJ { const u32x4 w = r[m][bj]; f32x4 v0 = acc[ai][bj][m][0], v1 = acc[ai][bj][m][1];
                    v0[0] += ALPHA * bf_lo(w.x); v0[1] += ALPHA * bf_hi(w.x); v0[2] += ALPHA * bf_lo(w.y); v0[3] += ALPHA * bf_hi(w.y);
                    v1[0] += ALPHA * bf_lo(w.z); v1[1] += ALPHA * bf_hi(w.z); v1[2] += ALPHA * bf_lo(w.w); v1[3] += ALPHA * bf_hi(w.w);
                    *(u32x4*)(X + (size_t)row * 2048 + u.pn * 256 + EPI_CB(bj)) = pack8(v0, v1); } } }
    }
};
struct EpiBf16 {
    bf16_t* O; int ldo; float scale;
    __device__ __forceinline__ void operator()(EPI_ARGS) const {
        FOR_AI_M { const int row = EPI_ROW(ai, m); FOR_BJ { *(u32x4*)(O + (size_t)row * ldo + u.pn * 256 + EPI_CB(bj)) = pack8(acc[ai][bj][m][0] * scale, acc[ai][bj][m][1] * scale); } }
    }
};
struct EpiBf16Half {
    bf16_t* O; int ldo; float scale;
    __device__ __forceinline__ void operator()(EPI_ARGS) const {
#pragma unroll
        for (int m = 0; m < 4; ++m) { const int row = u.pm * 128 + wr * 64 + m * 16 + fr;
            FOR_BJ { *(u32x4*)(O + (size_t)row * ldo + u.pn * 256 + EPI_CB(bj)) = pack8(acc[0][bj][m][0] * scale, acc[0][bj][m][1] * scale); } }
    }
};
struct EpiMoeDown {
    bf16_t* OG; const float* wslot;
    __device__ __forceinline__ void operator()(EPI_ARGS) const {
        float w[2][4];
        FOR_AI_M w[ai][m] = wslot[EPI_ROW(ai, m)];
        FOR_AI_M { const int row = EPI_ROW(ai, m);
            FOR_BJ { *(u32x4*)(OG + (size_t)row * 2048 + u.pn * 256 + EPI_CB(bj)) = pack8(acc[ai][bj][m][0] * w[ai][m], acc[ai][bj][m][1] * w[ai][m]); } }
    }
};

namespace att {
constexpr int KVBLK = 64, SHM_V = KVBLK * 128 * 2;
constexpr float THRL = 8.f;
__device__ __forceinline__ int crow(int r, int hi) { return (r & 3) + 8 * (r >> 2) + 4 * hi; }
template <int PITCH> __device__ __forceinline__ int kfl(int row) { return (PITCH % 256 == 128) ? ((row >> 1) & 7) : (row & 15); }
template <int PITCH> __device__ __forceinline__ int kswz(int row, int colB) { return row * PITCH + (colB ^ (kfl<PITCH>(row) << 4)); }
__device__ __forceinline__ int v_st(int k, int c) { const int kk = k; return ((kk >> 3) * 4 + (c >> 5)) * 512 + ((kk & 7) * 32 + (c & 31)) * 2; }
__device__ __forceinline__ int v_rd_base(int lane) { return ((lane & 3) << 3) | (((lane >> 2) & 3) << 6) | (((lane >> 4) & 1) << 5) | (((lane >> 5) & 1) << 8); }
constexpr int v_rd_off(int d0, int ks, int half) { return d0 * 512 + ks * 4096 + half * 2048; }

__device__ __forceinline__ void mask_tile(f32x16& p0, f32x16& p1, int dq) {
    const float NEG = -__builtin_inff();
#pragma unroll
    for (int r = 0; r < 16; ++r) { const int c = (r & 3) + 8 * (r >> 2); if (dq - c < 0) p0[r] = NEG; if (dq - c - 32 < 0) p1[r] = NEG; }
}
__device__ __forceinline__ void partialSM(f32x16& p0, f32x16& p1, float& m_reg, float& alpha) {
    float pmax = p0[0];
#pragma unroll
    for (int r = 1; r < 16; ++r) pmax = fmaxf(pmax, p0[r]);
#pragma unroll
    for (int r = 0; r < 16; ++r) pmax = fmaxf(pmax, p1[r]);
    { auto rr = __builtin_amdgcn_permlane32_swap(__float_as_uint(pmax), __float_as_uint(pmax), false, false); pmax = fmaxf(__uint_as_float(rr[0]), __uint_as_float(rr[1])); }
    float mn;
    if (__builtin_expect(__all(pmax - m_reg <= THRL), 1)) { mn = m_reg; alpha = 1.f; }
    else { mn = fmaxf(m_reg, pmax); alpha = __builtin_amdgcn_exp2f(m_reg - mn); m_reg = mn; }
#pragma unroll
    for (int r = 0; r < 16; ++r) { p0[r] -= mn; p1[r] -= mn; }
#pragma unroll
    for (int r = 0; r < 16; ++r) p0[r] = __builtin_amdgcn_exp2f(p0[r]);
}
__device__ __forceinline__ void finishSM(f32x16& p0, f32x16& p1, float alpha, float& l_reg, bf16x8& pa0, bf16x8& pa1, bf16x8& pa2, bf16x8& pa3) {
#pragma unroll
    for (int r = 0; r < 16; ++r) p1[r] = __builtin_amdgcn_exp2f(p1[r]);
    float ps = 0;
#pragma unroll
    for (int r = 0; r < 16; ++r) ps += p0[r];
#pragma unroll
    for (int r = 0; r < 16; ++r) ps += p1[r];
    { auto rr = __builtin_amdgcn_permlane32_swap(__float_as_uint(ps), __float_as_uint(ps), false, false); ps = __uint_as_float(rr[0]) + __uint_as_float(rr[1]); }
    l_reg = l_reg * alpha + ps;
#define PK4(P, B_, OUT) do { unsigned a0 = cvt_pk_bf16(P[B_+0], P[B_+1]), a1 = cvt_pk_bf16(P[B_+2], P[B_+3]); unsigned b0 = cvt_pk_bf16(P[B_+4], P[B_+5]), b1 = cvt_pk_bf16(P[B_+6], P[B_+7]); \
        u32x4 w = {a0, a1, b0, b1}; OUT = *reinterpret_cast<bf16x8*>(&w); } while (0)
    PK4(p0, 0, pa0); PK4(p0, 8, pa1); PK4(p1, 0, pa2); PK4(p1, 8, pa3);
#undef PK4
}
template <int PITCH, int ND0>
__device__ __forceinline__ void qkt(f32x16& p0, f32x16& p1, const char* Kb, int r32, int hi, int kch0, const bf16x8* qr) {
    p0 = f32x16{}; p1 = f32x16{};
    const char* kb[4];
#pragma unroll
    for (int dd = 0; dd < 4; ++dd) kb[dd] = Kb + kswz<PITCH>(r32, (kch0 + dd * 2 + hi) * 16);
#pragma unroll
    for (int d0 = 0; d0 < ND0; ++d0) { const char* a = (PITCH % 256 == 0) ? Kb + kswz<PITCH>(r32, (kch0 + d0 * 2 + hi) * 16) : kb[d0 & 3] + (d0 >> 2) * 128;
        const bf16x8 b0 = *reinterpret_cast<const bf16x8*>(a);
        const bf16x8 b1 = *reinterpret_cast<const bf16x8*>(a + 32 * PITCH);
        p0 = __builtin_amdgcn_mfma_f32_32x32x16_bf16(b0, qr[d0], p0, 0, 0, 0);
        p1 = __builtin_amdgcn_mfma_f32_32x32x16_bf16(b1, qr[d0], p1, 0, 0, 0); }
}
__device__ __forceinline__ void pv_tile(f32x16* o, int vb0, bf16x8 pa0, bf16x8 pa1, bf16x8 pa2, bf16x8 pa3) {
    s16x4 va[8], vb[8];
#define TRRD(dst, off) asm volatile("ds_read_b64_tr_b16 %0, %1 offset:%2" : "=&v"(dst) : "v"(vb0), "i"(off) : "memory")
#define PV_RD(v, d0) do { constexpr int b_ = v_rd_off(d0, 0, 0); TRRD(v[0], b_); TRRD(v[1], b_ + 2048); TRRD(v[2], b_ + 4096); TRRD(v[3], b_ + 6144); TRRD(v[4], b_ + 8192); TRRD(v[5], b_ + 10240); TRRD(v[6], b_ + 12288); TRRD(v[7], b_ + 14336); } while (0)
#define PV_MM(v, d0) do { \
        o[d0] = __builtin_amdgcn_mfma_f32_32x32x16_bf16(pa0, (bf16x8){v[0][0], v[0][1], v[0][2], v[0][3], v[1][0], v[1][1], v[1][2], v[1][3]}, o[d0], 0, 0, 0); \
        o[d0] = __builtin_amdgcn_mfma_f32_32x32x16_bf16(pa1, (bf16x8){v[2][0], v[2][1], v[2][2], v[2][3], v[3][0], v[3][1], v[3][2], v[3][3]}, o[d0], 0, 0, 0); \
        o[d0] = __builtin_amdgcn_mfma_f32_32x32x16_bf16(pa2, (bf16x8){v[4][0], v[4][1], v[4][2], v[4][3], v[5][0], v[5][1], v[5][2], v[5][3]}, o[d0], 0, 0, 0); \
        o[d0] = __builtin_amdgcn_mfma_f32_32x32x16_bf16(pa3, (bf16x8){v[6][0], v[6][1], v[6][2], v[6][3], v[7][0], v[7][1], v[7][2], v[7][3]}, o[d0], 0, 0, 0); } while (0)
#define PV_W8(v) asm volatile("s_waitcnt lgkmcnt(8)" : "+v"(v[0]), "+v"(v[1]), "+v"(v[2]), "+v"(v[3]), "+v"(v[4]), "+v"(v[5]), "+v"(v[6]), "+v"(v[7]) :: "memory")
#define PV_W0(v) asm volatile("s_waitcnt lgkmcnt(0)" : "+v"(v[0]), "+v"(v[1]), "+v"(v[2]), "+v"(v[3]), "+v"(v[4]), "+v"(v[5]), "+v"(v[6]), "+v"(v[7]) :: "memory")
    PV_RD(va, 0); PV_RD(vb, 1); PV_W8(va); SBAR(); PV_MM(va, 0);
    PV_RD(va, 2); PV_W8(vb); SBAR(); PV_MM(vb, 1);
    PV_RD(vb, 3); PV_W8(va); SBAR(); PV_MM(va, 2);
    PV_W0(vb); SBAR(); PV_MM(vb, 3);
#undef PV_W0
#undef PV_W8
#undef PV_MM
#undef PV_RD
#undef TRRD
}

template <int KT, int ND0, bool CAUSAL, bool PIPE>
__device__ __forceinline__ void attn_core(const bf16_t* Qlane, const bf16_t* __restrict__ Kh, int ldk, const bf16_t* __restrict__ Vh, int ldv, int NT, int qpos, int qlo, int kch0,
                                          char* lds, f32x16 (&o)[4], float& l_reg) {
    constexpr int PITCH = KT * 2, SHM_K = KVBLK * PITCH, NKL = KT / 64, CPR = KT / 8;
    const int tid = opaque_tid(), wid = __builtin_amdgcn_readfirstlane(tid >> 6), lane = tid & 63, r32 = lane & 31, hi = lane >> 5;
    char* V_lds = lds; char* K_lds = lds + 2 * SHM_V;
    float* ws = (float*)(lds + 2 * SHM_V + 2 * SHM_K) + wid * 64; float* al_l = ws + 32;
    float m_reg = -1e30f; l_reg = 0.f;
#pragma unroll
    for (int d = 0; d < 4; ++d) o[d] = f32x16{};
    bf16x8 qr[ND0];
#pragma unroll
    for (int d0 = 0; d0 < ND0; ++d0) qr[d0] = *reinterpret_cast<const bf16x8*>(Qlane + d0 * 16);
    const int sr = tid >> 4, sc = (tid & 15) * 8, vst0 = v_st(sr, sc), vst1 = v_st(32 + sr, sc);
    const int vb0 = (int)(uintptr_t)V_lds + v_rd_base(lane);
    int krow[NKL], kcc[NKL];
#pragma unroll
    for (int i = 0; i < NKL; ++i) { const int cid = tid + 512 * i; krow[i] = cid / CPR; kcc[i] = cid - krow[i] * CPR; }
    bf16x8 st_v0, st_v1, st_k[NKL];
#define SLOAD(k0) do { st_v0 = *reinterpret_cast<const bf16x8*>(Vh + (size_t)((k0) + sr) * ldv + sc); st_v1 = *reinterpret_cast<const bf16x8*>(Vh + (size_t)((k0) + 32 + sr) * ldv + sc); \
        _Pragma("unroll") for (int i_ = 0; i_ < NKL; ++i_) st_k[i_] = *reinterpret_cast<const bf16x8*>(Kh + (size_t)((k0) + krow[i_]) * ldk + kcc[i_] * 8); } while (0)
#define SWRITE(b) do { *(bf16x8*)(V_lds + (b) * SHM_V + vst0) = st_v0; *(bf16x8*)(V_lds + (b) * SHM_V + vst1) = st_v1; \
        _Pragma("unroll") for (int i_ = 0; i_ < NKL; ++i_) *(bf16x8*)(K_lds + (b) * SHM_K + kswz<PITCH>(krow[i_], kcc[i_] * 16)) = st_k[i_]; } while (0)
#define RESC(a) do { if (__any((a) < 1.f)) { if (hi == 0) al_l[r32] = (a); asm volatile("s_waitcnt lgkmcnt(0)" ::: "memory"); \
        _Pragma("unroll") for (int d_ = 0; d_ < 4; ++d_) _Pragma("unroll") for (int r = 0; r < 16; ++r) o[d_][r] *= al_l[crow(r, hi)]; } } while (0)
#define MASKT(P0_, P1_, t) do { if (CAUSAL) { const int kb_ = (t) * KVBLK; if (kb_ + KVBLK - 1 > qlo) mask_tile(P0_, P1_, qpos - kb_ - 4 * hi); } } while (0)
    if constexpr (PIPE) {
    f32x16 pA0, pA1, pB0, pB1; float alA, alB; bf16x8 pa0, pa1, pa2, pa3;
    SLOAD(0); VM_WAIT(); SWRITE(0); __syncthreads();
    qkt<PITCH, ND0>(pA0, pA1, K_lds, r32, hi, kch0, qr); MASKT(pA0, pA1, 0); partialSM(pA0, pA1, m_reg, alA);
    SLOAD(KVBLK); VM_WAIT(); SWRITE(1); __syncthreads();
    for (int j = 1; j + 1 < NT; j += 2) {
        SBAR(); qkt<PITCH, ND0>(pB0, pB1, K_lds + SHM_K, r32, hi, kch0, qr);
        finishSM(pA0, pA1, alA, l_reg, pa0, pa1, pa2, pa3); SBAR();
        SLOAD((j + 1) * KVBLK); SBAR();
        pv_tile(o, vb0, pa0, pa1, pa2, pa3); MASKT(pB0, pB1, j); partialSM(pB0, pB1, m_reg, alB);
        __syncthreads(); VM_WAIT(); SWRITE(0);
        RESC(alB); __syncthreads();
        SBAR(); qkt<PITCH, ND0>(pA0, pA1, K_lds, r32, hi, kch0, qr);
        finishSM(pB0, pB1, alB, l_reg, pa0, pa1, pa2, pa3); SBAR();
        SLOAD((j + 2) * KVBLK); SBAR();
        pv_tile(o, vb0 + SHM_V, pa0, pa1, pa2, pa3); MASKT(pA0, pA1, j + 1); partialSM(pA0, pA1, m_reg, alA);
        __syncthreads(); VM_WAIT(); SWRITE(1);
        RESC(alA); __syncthreads();
    }
    SBAR(); qkt<PITCH, ND0>(pB0, pB1, K_lds + SHM_K, r32, hi, kch0, qr);
    finishSM(pA0, pA1, alA, l_reg, pa0, pa1, pa2, pa3); SBAR();
    pv_tile(o, vb0, pa0, pa1, pa2, pa3); MASKT(pB0, pB1, NT - 1); partialSM(pB0, pB1, m_reg, alB);
    RESC(alB);
    finishSM(pB0, pB1, alB, l_reg, pa0, pa1, pa2, pa3); SBAR();
    pv_tile(o, vb0 + SHM_V, pa0, pa1, pa2, pa3);
    } else {
    f32x16 p0, p1; float al; bf16x8 pa0, pa1, pa2, pa3;
    SLOAD(0); VM_WAIT(); SWRITE(0); __syncthreads();
    for (int t = 0; t < NT; t += 2) {
        SBAR(); SLOAD((t + 1) * KVBLK); SBAR();
        qkt<PITCH, ND0>(p0, p1, K_lds, r32, hi, kch0, qr); MASKT(p0, p1, t); partialSM(p0, p1, m_reg, al); RESC(al);
        finishSM(p0, p1, al, l_reg, pa0, pa1, pa2, pa3); SBAR();
        pv_tile(o, vb0, pa0, pa1, pa2, pa3);
        VM_WAIT(); SWRITE(1); __syncthreads();
        SBAR(); if (t + 2 < NT) SLOAD((t + 2) * KVBLK); SBAR();
        qkt<PITCH, ND0>(p0, p1, K_lds + SHM_K, r32, hi, kch0, qr); MASKT(p0, p1, t + 1); partialSM(p0, p1, m_reg, al); RESC(al);
        finishSM(p0, p1, al, l_reg, pa0, pa1, pa2, pa3); SBAR();
        pv_tile(o, vb0 + SHM_V, pa0, pa1, pa2, pa3);
        if (t + 2 < NT) { VM_WAIT(); SWRITE(0); } __syncthreads();
    }
    }
#undef SLOAD
#undef SWRITE
#undef RESC
#undef MASKT
}

template <bool NEGM = true>
__device__ __forceinline__ void partialSM_rel(f32x16& p0, f32x16& p1, float& m_reg, f32x16& negm, float& alpha, bool first) {
    float pmax = p0[0];
#pragma unroll
    for (int r = 1; r < 16; ++r) pmax = fmaxf(pmax, p0[r]);
#pragma unroll
    for (int r = 0; r < 16; ++r) pmax = fmaxf(pmax, p1[r]);
    { auto rr = __builtin_amdgcn_permlane32_swap(__float_as_uint(pmax), __float_as_uint(pmax), false, false); pmax = fmaxf(__uint_as_float(rr[0]), __uint_as_float(rr[1])); }
    if (__builtin_expect(!first && __all(pmax <= THRL), 1)) { alpha = 1.f; }
    else { const float dl = first ? pmax : fmaxf(pmax, 0.f); alpha = first ? 1.f : __builtin_amdgcn_exp2f(-dl); m_reg += dl;
#pragma unroll
        for (int r = 0; r < 16; ++r) { p0[r] -= dl; p1[r] -= dl; }
        if constexpr (NEGM) {
#pragma unroll
            for (int r = 0; r < 16; ++r) negm[r] = -m_reg; } }
#pragma unroll
    for (int r = 0; r < 16; ++r) p0[r] = __builtin_amdgcn_exp2f(p0[r]);
}
template <int PITCH, int ND0>
__device__ __forceinline__ void qkt_rel(f32x16& p0, f32x16& p1, const char* Kb, int r32, int hi, int kch0, const bf16x8* qr, const f32x16& negm) {
    const char* kb[4];
#pragma unroll
    for (int dd = 0; dd < 4; ++dd) kb[dd] = Kb + kswz<PITCH>(r32, (kch0 + dd * 2 + hi) * 16);
#pragma unroll
    for (int d0 = 0; d0 < ND0; ++d0) { const char* a = (PITCH % 256 == 0) ? Kb + kswz<PITCH>(r32, (kch0 + d0 * 2 + hi) * 16) : kb[d0 & 3] + (d0 >> 2) * 128;
        const bf16x8 b0 = *reinterpret_cast<const bf16x8*>(a);
        const bf16x8 b1 = *reinterpret_cast<const bf16x8*>(a + 32 * PITCH);
        p0 = __builtin_amdgcn_mfma_f32_32x32x16_bf16(b0, qr[d0], d0 == 0 ? negm : p0, 0, 0, 0);
        p1 = __builtin_amdgcn_mfma_f32_32x32x16_bf16(b1, qr[d0], d0 == 0 ? negm : p1, 0, 0, 0); }
}

template <int PITCH, int ND0, int PF>
__device__ __forceinline__ void qkt_rel_pf(f32x16& p0, f32x16& p1, const char* Kb, int r32, int hi, int kch0, const bf16x8* qr, const f32x16& negm_) {
    static_assert(PITCH % 256 == 128 || ND0 <= 4, "the +128 B immediate offsets need the 3-bit swizzle");
    f32x16 negm = negm_;
    int kb[4];
#pragma unroll
    for (int dd = 0; dd < 4; ++dd) kb[dd] = (int)(uintptr_t)Kb + kswz<PITCH>(r32, (kch0 + dd * 2 + hi) * 16);
    bf16x8 f[PF + 1][2];
#define KRD(d) do { asm volatile("ds_read_b128 %0, %1 offset:%2" : "=v"(f[(d) % (PF + 1)][0]) : "v"(kb[(d) & 3]), "i"(((d) >> 2) * 128)); \
                    asm volatile("ds_read_b128 %0, %1 offset:%2" : "=v"(f[(d) % (PF + 1)][1]) : "v"(kb[(d) & 3]), "i"(((d) >> 2) * 128 + 32 * PITCH)); } while (0)
#pragma unroll
    for (int d = 0; d < PF && d < ND0; ++d) KRD(d);
#pragma unroll
    for (int d0 = 0; d0 < ND0; ++d0) {
        if (d0 + PF < ND0) KRD(d0 + PF);
        const int ahead = (d0 + PF < ND0 ? PF : ND0 - 1 - d0) * 2;
        if (ahead >= 4) asm volatile("s_waitcnt lgkmcnt(4)" : "+v"(f[d0 % (PF + 1)][0]), "+v"(f[d0 % (PF + 1)][1]));
        else if (ahead == 2) asm volatile("s_waitcnt lgkmcnt(2)" : "+v"(f[d0 % (PF + 1)][0]), "+v"(f[d0 % (PF + 1)][1]));
        else asm volatile("s_waitcnt lgkmcnt(0)" : "+v"(f[d0 % (PF + 1)][0]), "+v"(f[d0 % (PF + 1)][1]));
        if (d0 == 0) {
            asm volatile("s_nop 1\n\tv_mfma_f32_32x32x16_bf16 %0, %1, %2, %3" : "=&v"(p0) : "v"(f[0][0]), "v"(qr[0]), "v"(negm));
            asm volatile("v_mfma_f32_32x32x16_bf16 %0, %1, %2, %3" : "=&v"(p1) : "v"(f[0][1]), "v"(qr[0]), "v"(negm));
        } else {
            p0 = __builtin_amdgcn_mfma_f32_32x32x16_bf16(f[d0 % (PF + 1)][0], qr[d0], p0, 0, 0, 0);
            p1 = __builtin_amdgcn_mfma_f32_32x32x16_bf16(f[d0 % (PF + 1)][1], qr[d0], p1, 0, 0, 0); }
    }
#undef KRD
}

template <int PITCH, int ND0>
__device__ __forceinline__ void pv_qk(f32x16* o, int vb0, bf16x8 pa0, bf16x8 pa1, bf16x8 pa2, bf16x8 pa3,
                                      f32x16& p0, f32x16& p1, const char* Kb, int r32, int hi, int kch0, const bf16x8* qr, const f32x16& negm_) {
    constexpr int PF = 2;
    static_assert(PITCH % 256 == 128 || ND0 <= 4, "the +128 B immediate offsets need the 3-bit swizzle");
    f32x16 negm = negm_;
    s16x4 va[8], vb[8];
    int kb[4];
#pragma unroll
    for (int dd = 0; dd < 4; ++dd) kb[dd] = (int)(uintptr_t)Kb + kswz<PITCH>(r32, (kch0 + dd * 2 + hi) * 16);
    bf16x8 f[PF + 1][2];
#define TRRD(dst, off) asm volatile("ds_read_b64_tr_b16 %0, %1 offset:%2" : "=&v"(dst) : "v"(vb0), "i"(off) : "memory")
#define PV_RD(v, d0) do { constexpr int b_ = v_rd_off(d0, 0, 0); TRRD(v[0], b_); TRRD(v[1], b_ + 2048); TRRD(v[2], b_ + 4096); TRRD(v[3], b_ + 6144); TRRD(v[4], b_ + 8192); TRRD(v[5], b_ + 10240); TRRD(v[6], b_ + 12288); TRRD(v[7], b_ + 14336); } while (0)
#define PV_MM(v, d0) do { \
        o[d0] = __builtin_amdgcn_mfma_f32_32x32x16_bf16(pa0, (bf16x8){v[0][0], v[0][1], v[0][2], v[0][3], v[1][0], v[1][1], v[1][2], v[1][3]}, o[d0], 0, 0, 0); \
        o[d0] = __builtin_amdgcn_mfma_f32_32x32x16_bf16(pa1, (bf16x8){v[2][0], v[2][1], v[2][2], v[2][3], v[3][0], v[3][1], v[3][2], v[3][3]}, o[d0], 0, 0, 0); \
        o[d0] = __builtin_amdgcn_mfma_f32_32x32x16_bf16(pa2, (bf16x8){v[4][0], v[4][1], v[4][2], v[4][3], v[5][0], v[5][1], v[5][2], v[5][3]}, o[d0], 0, 0, 0); \
        o[d0] = __builtin_amdgcn_mfma_f32_32x32x16_bf16(pa3, (bf16x8){v[6][0], v[6][1], v[6][2], v[6][3], v[7][0], v[7][1], v[7][2], v[7][3]}, o[d0], 0, 0, 0); } while (0)
#define PV_WN(v, n) asm volatile("s_waitcnt lgkmcnt(%8)" : "+v"(v[0]), "+v"(v[1]), "+v"(v[2]), "+v"(v[3]), "+v"(v[4]), "+v"(v[5]), "+v"(v[6]), "+v"(v[7]) : "n"(n) : "memory")
#define KRD(d) do { asm volatile("ds_read_b128 %0, %1 offset:%2" : "=v"(f[(d) % (PF + 1)][0]) : "v"(kb[(d) & 3]), "i"(((d) >> 2) * 128) : "memory"); \
                    asm volatile("ds_read_b128 %0, %1 offset:%2" : "=v"(f[(d) % (PF + 1)][1]) : "v"(kb[(d) & 3]), "i"(((d) >> 2) * 128 + 32 * PITCH) : "memory"); } while (0)
#define PV_RDK(v, ks) do { TRRD(v[0], v_rd_off(0, ks, 0)); TRRD(v[1], v_rd_off(0, ks, 1)); TRRD(v[2], v_rd_off(1, ks, 0)); TRRD(v[3], v_rd_off(1, ks, 1)); \
                            TRRD(v[4], v_rd_off(2, ks, 0)); TRRD(v[5], v_rd_off(2, ks, 1)); TRRD(v[6], v_rd_off(3, ks, 0)); TRRD(v[7], v_rd_off(3, ks, 1)); } while (0)
#define PV_MMK(v, pa) do { \
        o[0] = __builtin_amdgcn_mfma_f32_32x32x16_bf16(pa, (bf16x8){v[0][0], v[0][1], v[0][2], v[0][3], v[1][0], v[1][1], v[1][2], v[1][3]}, o[0], 0, 0, 0); \
        o[1] = __builtin_amdgcn_mfma_f32_32x32x16_bf16(pa, (bf16x8){v[2][0], v[2][1], v[2][2], v[2][3], v[3][0], v[3][1], v[3][2], v[3][3]}, o[1], 0, 0, 0); \
        o[2] = __builtin_amdgcn_mfma_f32_32x32x16_bf16(pa, (bf16x8){v[4][0], v[4][1], v[4][2], v[4][3], v[5][0], v[5][1], v[5][2], v[5][3]}, o[2], 0, 0, 0); \
        o[3] = __builtin_amdgcn_mfma_f32_32x32x16_bf16(pa, (bf16x8){v[6][0], v[6][1], v[6][2], v[6][3], v[7][0], v[7][1], v[7][2], v[7][3]}, o[3], 0, 0, 0); } while (0)
    PV_RDK(va, 0); PV_RDK(vb, 1); PV_WN(va, 8); SBAR(); PV_MMK(va, pa0);
    PV_RDK(va, 2); PV_WN(vb, 8); SBAR(); PV_MMK(vb, pa1);
    PV_RDK(vb, 3); PV_WN(va, 8); SBAR(); PV_MMK(va, pa2);
    KRD(0); KRD(1);
    PV_WN(vb, 4); SBAR(); PV_MMK(vb, pa3);
#undef PV_MMK
#undef PV_RDK
    SBAR();
#pragma unroll
    for (int d0 = 0; d0 < ND0; ++d0) {
        if (d0 + PF < ND0) KRD(d0 + PF);
        const int ahead = (d0 + PF < ND0 ? PF : ND0 - 1 - d0) * 2;
        if (ahead >= 4) asm volatile("s_waitcnt lgkmcnt(4)" : "+v"(f[d0 % (PF + 1)][0]), "+v"(f[d0 % (PF + 1)][1]) :: "memory");
        else if (ahead == 2) asm volatile("s_waitcnt lgkmcnt(2)" : "+v"(f[d0 % (PF + 1)][0]), "+v"(f[d0 % (PF + 1)][1]) :: "memory");
        else asm volatile("s_waitcnt lgkmcnt(0)" : "+v"(f[d0 % (PF + 1)][0]), "+v"(f[d0 % (PF + 1)][1]) :: "memory");
        if (d0 == 0) {
            asm volatile("s_nop 1\n\tv_mfma_f32_32x32x16_bf16 %0, %1, %2, %3" : "=&v"(p0) : "v"(f[0][0]), "v"(qr[0]), "v"(negm));
            asm volatile("v_mfma_f32_32x32x16_bf16 %0, %1, %2, %3" : "=&v"(p1) : "v"(f[0][1]), "v"(qr[0]), "v"(negm));
        } else {
            p0 = __builtin_amdgcn_mfma_f32_32x32x16_bf16(f[d0 % (PF + 1)][0], qr[d0], p0, 0, 0, 0);
            p1 = __builtin_amdgcn_mfma_f32_32x32x16_bf16(f[d0 % (PF + 1)][1], qr[d0], p1, 0, 0, 0); }
    }
#undef KRD
#undef PV_WN
#undef PV_MM
#undef PV_RD
#undef TRRD
}

__device__ __forceinline__ void glds16(unsigned lds_addr, const void* sbase, unsigned voff) {
    unsigned keep;
    asm volatile("s_mov_b32 %0, m0\n\ts_mov_b32 m0, %1\n\ts_nop 0\n\tglobal_load_lds_dwordx4 %2, %3\n\ts_mov_b32 m0, %0" : "=&s"(keep) : "s"(lds_addr), "v"(voff), "s"(sbase) : "memory");
}
template <int KT, int ND0, bool CAUSAL>
__device__ __forceinline__ void attn_core_ring(const bf16_t* Qlane, const bf16_t* __restrict__ Kh, int ldk, const bf16_t* __restrict__ Vh, int ldv, int NT, int qpos, int qlo, int kch0,
                                               char* lds, f32x16 (&o)[4], float& l_reg) {
    constexpr int PITCH = KT * 2, SHM_K = KVBLK * PITCH, NKP = SHM_K / 8192, NVP = SHM_V / 8192;
    const int tid = opaque_tid(), wid = __builtin_amdgcn_readfirstlane(tid >> 6), lane = tid & 63, r32 = lane & 31, hi = lane >> 5;
    char* V_lds = lds; char* K_lds = lds + 3 * SHM_V;
    float* ws = (float*)(lds + 3 * SHM_V + 3 * SHM_K) + wid * 64; float* al_l = ws + 32;
    float m_reg = 0.f; l_reg = 0.f; f32x16 negm = f32x16{};
#pragma unroll
    for (int d = 0; d < 4; ++d) o[d] = f32x16{};
    bf16x8 qr[ND0];
#pragma unroll
    for (int d0 = 0; d0 < ND0; ++d0) qr[d0] = *reinterpret_cast<const bf16x8*>(Qlane + d0 * 16);
    const int vb0 = (int)(uintptr_t)V_lds + v_rd_base(lane);
    unsigned koff[NKP], voff[NVP];
#pragma unroll
    for (int i = 0; i < NKP; ++i) { const int a = (wid * NKP + i) * 1024 + lane * 16, row = a / PITCH, cpos = (a - row * PITCH) >> 4, f = kfl<PITCH>(row);
        const int chunk = cpos ^ f; koff[i] = (unsigned)(row * ldk * 2 + chunk * 16); }
#pragma unroll
    for (int i = 0; i < NVP; ++i) { const int a = (wid * NVP + i) * 1024 + lane * 16, sub = a >> 9, rem = a & 511, kk = (sub >> 2) * 8 + (rem >> 6), c = (sub & 3) * 32 + ((rem & 63) >> 1);
        const int k = kk; voff[i] = (unsigned)(k * ldv * 2 + c * 2); }
    const unsigned ldsK = (unsigned)(uintptr_t)K_lds + (unsigned)(wid * NKP) * 1024u, ldsV = (unsigned)(uintptr_t)V_lds + (unsigned)(wid * NVP) * 1024u;
#define DMA_TILE(t, slot) do { const char* kb_ = (const char*)Kh + (size_t)(t) * KVBLK * ldk * 2; const char* vb_ = (const char*)Vh + (size_t)(t) * KVBLK * ldv * 2; \
        _Pragma("unroll") for (int i_ = 0; i_ < NKP; ++i_) glds16(ldsK + (slot) * SHM_K + i_ * 1024, kb_, koff[i_]); \
        _Pragma("unroll") for (int i_ = 0; i_ < NVP; ++i_) glds16(ldsV + (slot) * SHM_V + i_ * 1024, vb_, voff[i_]); } while (0)
#define RING_SYNC(more) do { if (more) asm volatile("s_waitcnt vmcnt(%0)" :: "n"(NKP + NVP) : "memory"); else asm volatile("s_waitcnt vmcnt(0)" ::: "memory"); \
        asm volatile("s_waitcnt lgkmcnt(0)" ::: "memory"); __builtin_amdgcn_s_barrier(); asm volatile("" ::: "memory"); } while (0)
#define RESC(a) do { if (__any((a) < 1.f)) { if (hi == 0) al_l[r32] = (a); asm volatile("s_waitcnt lgkmcnt(0)" ::: "memory"); \
        _Pragma("unroll") for (int d_ = 0; d_ < 4; ++d_) _Pragma("unroll") for (int r = 0; r < 16; ++r) o[d_][r] *= al_l[crow(r, hi)]; } } while (0)
#define MASKT(P0_, P1_, t) do { if (CAUSAL) { const int kb_ = (t) * KVBLK; if (kb_ + KVBLK - 1 > qlo) mask_tile(P0_, P1_, qpos - kb_ - 4 * hi); } } while (0)
    f32x16 p0, p1; float al; bf16x8 pa0, pa1, pa2, pa3;
    asm volatile("s_waitcnt vmcnt(0)" ::: "memory");
#pragma unroll
    for (int d0 = 0; d0 < ND0; ++d0) asm volatile("" : "+v"(qr[d0]));
    DMA_TILE(0, 0); if (NT > 1) DMA_TILE(1, 1);
    RING_SYNC(NT > 1);
    int slot = 0;
    for (int t = 0; t < NT; ++t) {
        const int s2 = slot == 0 ? 2 : slot - 1;
        SBAR(); if (t + 2 < NT) DMA_TILE(t + 2, s2); SBAR();
        qkt_rel_pf<PITCH, ND0, 2>(p0, p1, K_lds + slot * SHM_K, r32, hi, kch0, qr, negm); MASKT(p0, p1, t); partialSM_rel(p0, p1, m_reg, negm, al, t == 0); RESC(al);
        finishSM(p0, p1, al, l_reg, pa0, pa1, pa2, pa3); SBAR();
        pv_tile(o, vb0 + slot * SHM_V, pa0, pa1, pa2, pa3);
        RING_SYNC(t + 2 < NT);
        slot = slot == 2 ? 0 : slot + 1;
    }
#undef DMA_TILE
#undef RING_SYNC
#undef RESC
#undef MASKT
}
template <int KT, int ND0, bool CAUSAL, bool NEGM>
__device__ __forceinline__ void attn_core_pp(const bf16_t* Qlane, const bf16_t* __restrict__ Kh, int ldk, const bf16_t* __restrict__ Vh, int ldv, int NT, int qpos, int qlo, int kch0,
                                             char* lds, f32x16 (&o)[4], float& l_reg) {
    constexpr int PITCH = KT * 2, SHM_K = KVBLK * PITCH, NKP = SHM_K / 8192, NVP = SHM_V / 8192;
    const int tid = opaque_tid(), wid = __builtin_amdgcn_readfirstlane(tid >> 6), lane = tid & 63, r32 = lane & 31, hi = lane >> 5;
    const bool grpB = wid >= 4;
    char* V_lds = lds; char* K_lds = lds + 3 * SHM_V;
    float* ws = (float*)(lds + 3 * SHM_V + 3 * SHM_K) + wid * 64; float* al_l = ws + 32;
    float m_reg = 0.f; l_reg = 0.f; f32x16 negm = f32x16{};
#pragma unroll
    for (int d = 0; d < 4; ++d) o[d] = f32x16{};
    bf16x8 qr[ND0];
#pragma unroll
    for (int d0 = 0; d0 < ND0; ++d0) qr[d0] = *reinterpret_cast<const bf16x8*>(Qlane + d0 * 16);
    const int vb0 = (int)(uintptr_t)V_lds + v_rd_base(lane);
    unsigned koff[NKP], voff[NVP];
#pragma unroll
    for (int i = 0; i < NKP; ++i) { const int a = (wid * NKP + i) * 1024 + lane * 16, row = a / PITCH, cpos = (a - row * PITCH) >> 4, f = kfl<PITCH>(row);
        const int chunk = cpos ^ f; koff[i] = (unsigned)(row * ldk * 2 + chunk * 16); }
#pragma unroll
    for (int i = 0; i < NVP; ++i) { const int a = (wid * NVP + i) * 1024 + lane * 16, sub = a >> 9, rem = a & 511, kk = (sub >> 2) * 8 + (rem >> 6), c = (sub & 3) * 32 + ((rem & 63) >> 1);
        const int k = kk; voff[i] = (unsigned)(k * ldv * 2 + c * 2); }
    const unsigned ldsK = (unsigned)(uintptr_t)K_lds + (unsigned)(wid * NKP) * 1024u, ldsV = (unsigned)(uintptr_t)V_lds + (unsigned)(wid * NVP) * 1024u;
#define DMA_K(t, slot) do { const char* kb_ = (const char*)Kh + (size_t)(t) * KVBLK * ldk * 2; _Pragma("unroll") for (int i_ = 0; i_ < NKP; ++i_) glds16(ldsK + (slot) * SHM_K + i_ * 1024, kb_, koff[i_]); } while (0)
#define DMA_V(t, slot) do { const char* vb_ = (const char*)Vh + (size_t)(t) * KVBLK * ldv * 2; _Pragma("unroll") for (int i_ = 0; i_ < NVP; ++i_) glds16(ldsV + (slot) * SHM_V + i_ * 1024, vb_, voff[i_]); } while (0)
#define ISSUE(u, ksl, vsl) do { if ((u) < NT) DMA_K(u, ksl); if ((u) - 1 < NT) DMA_V((u) - 1, vsl); } while (0)
#define PAIR_WAIT(t) do { if ((t) + 2 < NT) asm volatile("s_waitcnt vmcnt(%0)" :: "n"(NKP + NVP) : "memory"); else if ((t) + 2 == NT) asm volatile("s_waitcnt vmcnt(%0)" :: "n"(NVP) : "memory"); \
        else asm volatile("s_waitcnt vmcnt(0)" ::: "memory"); } while (0)
#define BAR() do { SBAR(); asm volatile("s_waitcnt lgkmcnt(0)" ::: "memory"); __builtin_amdgcn_s_barrier(); asm volatile("" ::: "memory"); SBAR(); } while (0)
#define RESC(a) do { if (__any((a) < 1.f)) { if (hi == 0) al_l[r32] = (a); asm volatile("s_waitcnt lgkmcnt(0)" ::: "memory"); \
        _Pragma("unroll") for (int d_ = 0; d_ < 4; ++d_) _Pragma("unroll") for (int r = 0; r < 16; ++r) o[d_][r] *= al_l[crow(r, hi)]; } } while (0)
#define MASKT(P0_, P1_, t) do { if (CAUSAL) { const int kb_ = (t) * KVBLK; if (kb_ + KVBLK - 1 > qlo) mask_tile(P0_, P1_, qpos - kb_ - 4 * hi); } } while (0)
    f32x16 p0, p1; float al; bf16x8 pa0, pa1, pa2, pa3;
    asm volatile("s_waitcnt vmcnt(0)" ::: "memory");
#pragma unroll
    for (int d0 = 0; d0 < ND0; ++d0) asm volatile("" : "+v"(qr[d0]));
    DMA_K(0, 0);
    if (NT > 1) DMA_K(1, 1);
    DMA_V(0, 0);
    if (NT > 1) asm volatile("s_waitcnt vmcnt(%0)" :: "n"(NKP + NVP) : "memory"); else asm volatile("s_waitcnt vmcnt(%0)" :: "n"(NVP) : "memory");
    BAR();
    if (grpB) { ISSUE(2, 2, 1); BAR(); }
#define QK_(ksl) do { if constexpr (NEGM) qkt_rel_pf<PITCH, ND0, 2>(p0, p1, K_lds + (ksl) * SHM_K, r32, hi, kch0, qr, negm); \
        else { f32x16 c_; const float nm_ = -m_reg; _Pragma("unroll") for (int r = 0; r < 16; ++r) c_[r] = nm_; qkt_rel_pf<PITCH, ND0, 2>(p0, p1, K_lds + (ksl) * SHM_K, r32, hi, kch0, qr, c_); } } while (0)
#define Y_(t_, first_) do { MASKT(p0, p1, t_); partialSM_rel<NEGM>(p0, p1, m_reg, negm, al, first_); RESC(al); finishSM(p0, p1, al, l_reg, pa0, pa1, pa2, pa3); } while (0)
    QK_(0);
    if (grpB) PAIR_WAIT(0);
    BAR();
    if (grpB) ISSUE(3, 0, 2); else ISSUE(2, 2, 1);
    SBAR();
    Y_(0, true);
    if (!grpB) PAIR_WAIT(0);
    BAR();
    int ks = 1;
    for (int t = 1; t < NT; ++t) {
        const int kp = ks == 0 ? 2 : ks - 1, kn = ks == 2 ? 0 : ks + 1;
        if constexpr (NEGM) pv_qk<PITCH, ND0>(o, vb0 + kp * SHM_V, pa0, pa1, pa2, pa3, p0, p1, K_lds + ks * SHM_K, r32, hi, kch0, qr, negm);
        else { f32x16 c_; const float nm_ = -m_reg; _Pragma("unroll") for (int r = 0; r < 16; ++r) c_[r] = nm_; pv_qk<PITCH, ND0>(o, vb0 + kp * SHM_V, pa0, pa1, pa2, pa3, p0, p1, K_lds + ks * SHM_K, r32, hi, kch0, qr, c_); }
#ifdef PROBE_XMFMA
        if constexpr (ND0 == 4) { f32x16 dz_ = f32x16{}; _Pragma("unroll") for (int i_ = 0; i_ < PROBE_XMFMA; ++i_) asm volatile("v_mfma_f32_32x32x16_bf16 %0, %1, %2, %0" : "+v"(dz_) : "v"(qr[0]), "v"(qr[1])); asm volatile("s_nop 15\n\ts_nop 15" :: "v"(dz_)); }
#endif
        if (grpB) PAIR_WAIT(t);
        BAR();
        if (grpB) ISSUE(t + 3, ks, kp); else ISSUE(t + 2, kp, kn);
        SBAR();
        Y_(t, false);
#ifdef PROBE_YEXP
        if constexpr (ND0 == 4) { float dm_ = al; _Pragma("unroll") for (int i_ = 0; i_ < PROBE_YEXP; ++i_) asm volatile("v_exp_f32 %0, %1" : "=v"(dm_) : "v"(al)); asm volatile("" :: "v"(dm_)); }
#endif

        if (!grpB) PAIR_WAIT(t);
        BAR();
        ks = kn;
    }
    pv_tile(o, vb0 + (ks == 0 ? 2 : ks - 1) * SHM_V, pa0, pa1, pa2, pa3);
    BAR();
#undef QK_
#undef Y_
    if (!grpB) BAR();
#undef DMA_K
#undef DMA_V
#undef ISSUE
#undef PAIR_WAIT
#undef BAR
#undef RESC
#undef MASKT
}
__device__ __forceinline__ void normalize_o(f32x16 (&o)[4], float l_reg, float* ws, int r32, int hi) {
    if (hi == 0) ws[r32] = l_reg; asm volatile("s_waitcnt lgkmcnt(0)" ::: "memory");
#pragma unroll
    for (int r = 0; r < 16; ++r) { const float rl = __builtin_amdgcn_rcpf(ws[crow(r, hi)]);
#pragma unroll
        for (int d0 = 0; d0 < 4; ++d0) o[d0][r] *= rl; }
}
__device__ __forceinline__ void store_o_bf16(const f32x16 (&o)[4], bf16_t* Ow, int ldo, int r32, int hi) {
#pragma unroll
    for (int r = 0; r < 16; ++r) { const int orow = crow(r, hi);
#pragma unroll
        for (int d0 = 0; d0 < 4; ++d0) { const float v = o[d0][r]; const float vn = shflx(v, 1, hi * 32 + r32);
            if ((r32 & 1) == 0) *(unsigned*)(Ow + (size_t)orow * ldo + d0 * 32 + r32) = cvt_pk_bf16(v, vn); } }
}
}

constexpr size_t MiB = 1u << 20;
constexpr size_t WS_CTL = 0, CTL_ZERO_BYTES = 4 * MiB;
constexpr size_t WS_SSQ = 1 * MiB;
constexpr size_t WS_W = 4 * MiB, LW_BYTES = 269 * MiB / 2;
constexpr size_t LW_IN = 0, LW_QUP = 44 * MiB, LW_KVUP = LW_QUP + 3 * MiB / 2, LW_GLU = LW_KVUP + 1 * MiB, LW_BR = LW_GLU + 4 * MiB, LW_OUT = LW_BR + 12 * MiB,
                 LW_XQ = LW_OUT + 8 * MiB, LW_XKV = LW_XQ + 2 * MiB, LW_XO = LW_XKV + 4 * MiB, LW_TEXT = LW_XO + 2 * MiB, LW_WSL = LW_TEXT + 40 * MiB;
static_assert(LW_WSL + 16 * MiB == LW_BYTES, "layer weight block");
constexpr size_t WS_FFN = WS_W + 2 * LW_BYTES;
constexpr size_t WS_MOE = WS_FFN + 66 * MiB;
constexpr size_t WS_XS = WS_MOE + 8 * 66 * MiB + 1 * MiB;
static_assert(WS_XS == 868 * MiB, "map");
constexpr size_t WS_XN = WS_XS + 128 * MiB;
constexpr size_t WS_TABD = WS_XN + 64 * MiB, WS_TABM = WS_TABD + 1 * MiB, WS_XKV = WS_TABM + 4 * MiB, WS_MEMB = WS_XKV + 1 * MiB, WS_ROUTE = WS_MEMB + 1 * MiB, WS_ORDER = WS_ROUTE + 1 * MiB;
constexpr size_t WS_A32 = WS_ORDER + 64 * 1024;
constexpr size_t WS_PSQ = WS_ORDER + 1 * MiB;
constexpr size_t WS_MIX = WS_TABD + 12 * MiB;
static_assert(WS_MIX == 1072 * MiB, "map");
constexpr size_t WS_QD = WS_MIX, WS_KD = WS_QD + 32 * MiB, WS_VD = WS_KD + 32 * MiB, WS_MQ = WS_VD + 32 * MiB, WS_MKV = WS_MQ + 16 * MiB, WS_KM = WS_MKV + 8 * MiB, WS_VM = WS_KM + 48 * MiB,
                 WS_QM = WS_VM + 32 * MiB, WS_SU = WS_QM + 48 * MiB, WS_GATES = WS_SU + 40 * MiB, WS_SLOC = WS_GATES + 192 * MiB, WS_YG = WS_SLOC + 16 * MiB, WS_BR = WS_YG + 32 * MiB,
                 WS_TMP = WS_BR + 96 * MiB, WS_MG = WS_TMP + 128 * MiB, WS_XQ = WS_MG + 64 * MiB, WS_XO = WS_XQ + 16 * MiB, WS_XN8 = WS_XO + 16 * MiB  , WS_END = WS_XN8 + 32 * MiB;
static_assert(WS_END == 1952 * MiB, "map");
constexpr size_t WS_XG = WS_MIX, WS_HG = WS_XG + 136 * MiB, WS_OG = WS_HG + 374 * MiB;
static_assert(WS_OG + 272 * MiB <= WS_XQ, "ffn overlay");
constexpr int CW_TMO = 0, CW_DBG = 2, CW_BAR = 4096, CW_ATTQ = 16384, CW_MOECNT = 16640, CW_MOECUR = 16704;

#define XB_TMO      128
#define XB_XCNT(j)  (256  + 64 * (j))
#define XB_XSUB(j)  (1280 + 64 * (j))
#define XB_XGEN(j)  (2304 + 64 * (j))
#define XB_TOP      3328
#define XB_TOPGEN   3392
#define XCD_BAR_WORDS 3456
#define XB_SPIN_CAP (1u << 22)
__device__ __forceinline__ unsigned xb_ld(unsigned* p)              { return __hip_atomic_load(p, __ATOMIC_RELAXED, __HIP_MEMORY_SCOPE_AGENT); }
__device__ __forceinline__ unsigned xb_add(unsigned* p, unsigned v) { return __hip_atomic_fetch_add(p, v, __ATOMIC_RELAXED, __HIP_MEMORY_SCOPE_AGENT); }
__device__ __forceinline__ unsigned xb_xcc_id() { return (unsigned)__builtin_amdgcn_s_getreg((3 << 11) | 20) & 0xFu; }
#define XB_SPIN(cond, bar) do { unsigned _sp = 0; while (cond) { __builtin_amdgcn_s_sleep(1); \
    if ((++_sp & 255u) == 0u) { if (xb_ld(&(bar)[XB_TMO])) break; if (_sp > XB_SPIN_CAP) { atomicAdd(&(bar)[XB_TMO], 1u); break; } } } } while (0)
struct XcdBarrier { unsigned* bar; unsigned x; volatile LAS unsigned* st; };
__device__ __forceinline__ XcdBarrier xcd_barrier_post(unsigned* bar, volatile LAS unsigned* st) {
    XcdBarrier b; b.bar = bar; b.x = xb_xcc_id(); b.st = st;
    if (threadIdx.x == 0) (void)xb_add(&bar[XB_XCNT(b.x)], 1u);
    return b;
}
__device__ __forceinline__ void xcd_barrier_complete(unsigned* bar, unsigned x, unsigned& nloc, unsigned& nx) {
    const unsigned G = gridDim.x * gridDim.y * gridDim.z;
    unsigned sum, cnt, mine, sp = 0u;
    for (;;) {
        sum = 0u; cnt = 0u; mine = 0u;
#pragma nounroll
        for (unsigned j = 0; j < 16; ++j) { const unsigned c = xb_ld(&bar[XB_XCNT(j)]); sum += c; cnt += (c > 0u) ? 1u : 0u; mine = (j == x) ? c : mine; }
        if (sum == G) break;
        __builtin_amdgcn_s_sleep(1);
        if ((++sp & 255u) == 0u) { if (xb_ld(&bar[XB_TMO])) break; if (sp > XB_SPIN_CAP) { atomicAdd(&bar[XB_TMO], 1u); break; } }
    }
    nloc = mine > 0u ? mine : 1u; nx = cnt > 0u ? cnt : 1u;
}
__device__ __forceinline__ void xcd_barrier_setup(const XcdBarrier& b) {
    if (threadIdx.x == 0) { unsigned nloc, nx; xcd_barrier_complete(b.bar, b.x, nloc, nx); b.st[0] = nloc; b.st[1] = nx; }
    __syncthreads();
}
__device__ __forceinline__ void xcd_barrier(const XcdBarrier& b) {
    asm volatile("s_waitcnt vmcnt(0)" ::: "memory");
    __syncthreads();
    if (opaque_tid() == 0) {
        unsigned* bar = b.bar;
        __builtin_amdgcn_s_waitcnt(0);
        const unsigned nloc = b.st[0], nx = b.st[1];
        const unsigned old = xb_add(&bar[XB_XSUB(b.x)], 1u);
        const unsigned gen = old / nloc;
        if (old + 1u == (gen + 1u) * nloc) {
            __builtin_amdgcn_fence(__ATOMIC_RELEASE, "agent");
            asm volatile("s_waitcnt vmcnt(0)" ::: "memory");
            const unsigned og = xb_add(&bar[XB_TOP], 1u);
            const unsigned tg = og / nx;
            if (og + 1u == (tg + 1u) * nx) xb_add(&bar[XB_TOPGEN], 1u);
            else XB_SPIN(xb_ld(&bar[XB_TOPGEN]) == tg, bar);
            __builtin_amdgcn_fence(__ATOMIC_ACQUIRE, "agent");
            xb_add(&bar[XB_XGEN(b.x)], 1u);
            asm volatile("s_waitcnt vmcnt(0)" ::: "memory");
        } else {
            XB_SPIN(xb_ld(&bar[XB_XGEN(b.x)]) == gen, bar);
            __builtin_amdgcn_fence(__ATOMIC_ACQUIRE, "agent");
            asm volatile("s_waitcnt vmcnt(0)" ::: "memory");
        }
    }
    __syncthreads();
}

struct Args { const void* in[35]; float* out; unsigned char* ws; int ph_lo, ph_hi; };
struct PTab { volatile LAS unsigned long long* t; __device__ __forceinline__ const void* operator[](int i) const { const unsigned long long v = t[i];
    const unsigned lo_ = __builtin_amdgcn_readfirstlane((unsigned)v), hi_ = __builtin_amdgcn_readfirstlane((unsigned)(v >> 32)); return (const void*)(GAS const char*)(((unsigned long long)hi_ << 32) | lo_); } };
struct ArgsD { PTab in; unsigned char* ws; };
enum { I_X = 0, I_MEM, I_POS, I_WIN, I_WQUP, I_WKVUP, I_QNG, I_KVNG, I_DLAM, I_SUBLN, I_LRE, I_LIM, I_BRE, I_BIM, I_CRE, I_CIM, I_SSMD, I_LOGDT, I_GLUW, I_WBR, I_WOUT, I_LNMG, I_LNMB,
       I_WXQ, I_WXKV, I_WXO, I_LNXG, I_LNXB, I_FGU, I_FDN, I_ROUTER, I_MGU, I_MDN, I_LNFG, I_LNFB };
constexpr int NPL = 16, NPHASE = 1 + DEPTH * NPL;
constexpr int LDS_BYTES = 147456;
constexpr int LDS_MISC = 131072 + 8192;

__device__ __forceinline__ float lam_init_of(int l) { return l == 0 ? 0.2f : 0.35550906759f; }

struct Mat { const float* src; bf16_t* dst; int K, N, kind; const float* ksc; int kmod; float kmul; int fp8; };
__device__ __forceinline__ int map_row(int kind, int n, int N) {
    if (kind == 0) return n;
    if (kind == 1) {
        if (n < 2048) { const int hc = n & 63; if (hc < 16) return (n - hc) + (hc < 8 ? 2 * hc : 2 * (hc - 8) + 1); return n; }
        if (n < 3840) return n;
        if (n < 3904) { const int hc = n - 3840; return 3840 + (hc < 32 ? 2 * hc : 2 * (hc - 32) + 1); }
        return n + 192;
    }
    if (kind == 2) { const int h = n / 192; int hc = n - h * 192; if (hc >= 128) { const int r = hc - 128; hc = 128 + (r < 32 ? 2 * r : 2 * (r - 32) + 1); } return h * 192 + hc; }
    const int half = N >> 1;
    if (n < half) return (n >> 7) * 256 + (n & 127);
    const int mm = n - half; return (mm >> 7) * 256 + 128 + (mm & 127);
}
__device__ __forceinline__ Mat get_mat(const ArgsD& a, int id) {
    Mat m; m.ksc = nullptr; m.kmod = 1; m.kmul = 1.f; m.kind = 0; m.fp8 = 0;
    unsigned char* ws = a.ws;
    if (id < 22) { const int l = id / 11, k = id % 11; unsigned char* lw = ws + WS_W + (size_t)l * LW_BYTES;
        switch (k) {
        case 0: m.src = (const float*)a.in[I_WIN] + (size_t)l * D * NIN_SRC; m.dst = (bf16_t*)(lw + LW_IN); m.K = D; m.N = NIN_SRC; m.kind = 1; break;
        case 1: m.src = (const float*)a.in[I_WQUP] + (size_t)l * 512 * 1536; m.dst = (bf16_t*)(lw + LW_QUP); m.K = 512; m.N = 1536; m.kind = 2; m.ksc = (const float*)a.in[I_QNG] + l * 512; m.kmod = 512; break;
        case 2: m.src = (const float*)a.in[I_WKVUP] + (size_t)l * 256 * 2048; m.dst = (bf16_t*)(lw + LW_KVUP); m.K = 256; m.N = 2048; m.ksc = (const float*)a.in[I_KVNG] + l * 256; m.kmod = 256; break;
        case 3: m.src = (const float*)a.in[I_GLUW] + (size_t)l * 1024 * 2048; m.dst = (bf16_t*)(lw + LW_GLU); m.K = 1024; m.N = 2048; m.kind = 3; break;
        case 4: m.src = (const float*)a.in[I_WBR] + (size_t)(l * 3 + 0) * 1024 * 2048; m.dst = (bf16_t*)(lw + LW_BR); m.K = 1024; m.N = 2048; m.ksc = (const float*)a.in[I_SUBLN] + l * 128; m.kmod = 128; m.kmul = 1.f - lam_init_of(l); break;
        case 5: m.src = (const float*)a.in[I_WBR] + (size_t)(l * 3 + 1) * 1024 * 2048; m.dst = (bf16_t*)(lw + LW_BR + 4 * MiB); m.K = 1024; m.N = 2048; break;
        case 6: m.src = (const float*)a.in[I_WBR] + (size_t)(l * 3 + 2) * 1024 * 2048; m.dst = (bf16_t*)(lw + LW_BR + 8 * MiB); m.K = 1024; m.N = 2048; break;
        case 7: m.src = (const float*)a.in[I_WOUT] + (size_t)l * 2048 * 2048; m.dst = (bf16_t*)(lw + LW_OUT); m.K = 2048; m.N = 2048; break;
        case 8: m.src = (const float*)a.in[I_WXQ] + (size_t)l * 2048 * 512; m.dst = (bf16_t*)(lw + LW_XQ); m.K = 2048; m.N = 512; break;
        case 9: m.src = (const float*)a.in[I_WXKV] + (size_t)l * 2048 * 1024; m.dst = (bf16_t*)(lw + LW_XKV); m.K = 2048; m.N = 1024; break;
        default: m.src = (const float*)a.in[I_WXO] + (size_t)l * 512 * 2048; m.dst = (bf16_t*)(lw + LW_XO); m.K = 512; m.N = 2048; break;
        }
    } else if (id == 22) { m.src = (const float*)a.in[I_FGU]; m.dst = (bf16_t*)(ws + WS_FFN); m.K = D; m.N = 2 * DFF; m.kind = 3; }
    else if (id == 23) { m.src = (const float*)a.in[I_FDN]; m.dst = (bf16_t*)(ws + WS_FFN + 44 * MiB); m.K = DFF; m.N = D; m.fp8 = 1; m.kmul = 256.f; }
    else { const int e = (id - 24) >> 1;
        m.fp8 = 1;
        if (((id - 24) & 1) == 0) { m.src = (const float*)a.in[I_MGU] + (size_t)e * D * 2 * DFF; m.dst = (bf16_t*)(ws + WS_MOE + (size_t)e * 66 * MiB); m.K = D; m.N = 2 * DFF; m.kind = 3; m.kmul = 64.f; }
        else { m.src = (const float*)a.in[I_MDN] + (size_t)e * DFF * D; m.dst = (bf16_t*)(ws + WS_MOE + (size_t)e * 66 * MiB + 44 * MiB); m.K = DFF; m.N = D; m.kmul = 256.f; }
    }
    return m;
}
constexpr int NMAT = 40;
__device__ __forceinline__ void cvt_item(const Mat& mt, LAS float* scr, int item, int lane) {
    const int nblk = mt.N / 64, kb = item / nblk, nb = item - kb * nblk, k0 = 64 * kb, n0 = 64 * nb;
    const bool g8 = mt.kind == 1 && n0 >= 3072;
    const bool f8 = mt.fp8 || g8; const float kmul = g8 ? 64.f : mt.kmul;
    const int lr = lane >> 4, lc = (lane & 15) * 4;
    f32x4 v[16];
#pragma unroll
    for (int i = 0; i < 16; ++i) v[i] = *(const f32x4*)(mt.src + (size_t)(k0 + 4 * i + lr) * mt.N + n0 + lc);
    if (mt.ksc) {
#pragma unroll
        for (int i = 0; i < 16; ++i) v[i] = v[i] * (mt.ksc[(k0 + 4 * i + lr) % mt.kmod] * mt.kmul); }
    else if (f8) {
#pragma unroll
        for (int i = 0; i < 16; ++i) v[i] = v[i] * kmul; }
#pragma unroll
    for (int i = 0; i < 16; ++i) { LAS float* p = scr + (4 * i + lr) * 65 + lc; p[0] = v[i][0]; p[1] = v[i][1]; p[2] = v[i][2]; p[3] = v[i][3]; }
    LDS_WAIT(); asm volatile("" ::: "memory");
    const int c = lane & 7;
#pragma unroll
    for (int j = 0; j < 8; ++j) { const int n = (lane >> 3) + 8 * j; const LAS float* s = scr + (8 * c) * 65 + n;
        if (f8) { const u32x2 o = pack8_fp8((f32x4){s[0 * 65], s[1 * 65], s[2 * 65], s[3 * 65]}, (f32x4){s[4 * 65], s[5 * 65], s[6 * 65], s[7 * 65]}); const int r_ = map_row(mt.kind, n0 + n, mt.N);
            unsigned char* d8 = g8 ? (unsigned char*)mt.dst + (size_t)NIN_BF * mt.K * 2 + (size_t)(r_ - NIN_BF) * mt.K : (unsigned char*)mt.dst + (size_t)r_ * mt.K;
            *(u32x2*)(d8 + k0 + 8 * c) = o; }
        else { u32x4 o; o.x = cvt_pk_bf16(s[0 * 65], s[1 * 65]); o.y = cvt_pk_bf16(s[2 * 65], s[3 * 65]); o.z = cvt_pk_bf16(s[4 * 65], s[5 * 65]); o.w = cvt_pk_bf16(s[6 * 65], s[7 * 65]);
            *(u32x4*)(mt.dst + (size_t)map_row(mt.kind, n0 + n, mt.N) * mt.K + k0 + 8 * c) = o; } }
    LDS_WAIT(); asm volatile("" ::: "memory");
}
__device__ __forceinline__ void cvt_tile_wg(const Mat& mt, LAS float* scr, int tile, int tid) {
    const int nblk = mt.N / 256, kb = tile / nblk, nb = tile - kb * nblk, k0 = 64 * kb, n0 = 256 * nb;
    const int lane = tid & 63, w = tid >> 6;
    f32x4 v[8];
#pragma unroll
    for (int i = 0; i < 8; ++i) v[i] = *(const f32x4*)(mt.src + (size_t)(k0 + 8 * w + i) * mt.N + n0 + lane * 4);
    if (mt.ksc) {
#pragma unroll
        for (int i = 0; i < 8; ++i) v[i] = v[i] * (mt.ksc[(k0 + 8 * w + i) % mt.kmod] * mt.kmul); }
    else if (mt.fp8) {
#pragma unroll
        for (int i = 0; i < 8; ++i) v[i] = v[i] * mt.kmul; }
#pragma unroll
    for (int i = 0; i < 8; ++i) { LAS float* p = scr + (8 * w + i) * 257 + lane * 4; p[0] = v[i][0]; p[1] = v[i][1]; p[2] = v[i][2]; p[3] = v[i][3]; }
    __syncthreads();
    const int c = tid & 7;
#pragma unroll
    for (int j = 0; j < 4; ++j) { const int n = (tid >> 3) + 64 * j; const LAS float* s = scr + (8 * c) * 257 + n; const int r_ = map_row(mt.kind, n0 + n, mt.N);
        if (mt.fp8) *(u32x2*)((unsigned char*)mt.dst + (size_t)r_ * mt.K + k0 + 8 * c) = pack8_fp8((f32x4){s[0 * 257], s[1 * 257], s[2 * 257], s[3 * 257]}, (f32x4){s[4 * 257], s[5 * 257], s[6 * 257], s[7 * 257]});
        else { u32x4 o; o.x = cvt_pk_bf16(s[0 * 257], s[1 * 257]); o.y = cvt_pk_bf16(s[2 * 257], s[3 * 257]); o.z = cvt_pk_bf16(s[4 * 257], s[5 * 257]); o.w = cvt_pk_bf16(s[6 * 257], s[7 * 257]);
            *(u32x4*)(mt.dst + (size_t)r_ * mt.K + k0 + 8 * c) = o; } }
    __syncthreads();
}
__device__ __forceinline__ void ssm_build(const ArgsD& a, int l, int g, int half, LAS unsigned char* lds) {
    LAS float* Ap = (LAS float*)lds;
    LAS float* Bb = Ap + 33 * 64 * 2;
    LAS float* Cc = Bb + 64 * 16 * 2;
    LAS float* Mk = Cc + 16 * 64 * 2;
    const int tid = opaque_tid();
    const float* lre = (const float*)a.in[I_LRE] + (l * 64 + g) * 64; const float* lim = (const float*)a.in[I_LIM] + (l * 64 + g) * 64;
    const float* bre = (const float*)a.in[I_BRE] + (size_t)(l * 64 + g) * 1024; const float* bim = (const float*)a.in[I_BIM] + (size_t)(l * 64 + g) * 1024;
    const float* cre = (const float*)a.in[I_CRE] + (size_t)(l * 64 + g) * 1024; const float* cim = (const float*)a.in[I_CIM] + (size_t)(l * 64 + g) * 1024;
    const double dt = exp((double)((const float*)a.in[I_LOGDT])[l * 64 + g]);
    for (int idx = tid; idx < 33 * 64; idx += 512) { const int n = idx & 63, k = idx >> 6; const double re = lre[n], im = lim[n];
        const double mag = exp(re * dt * k), ang = im * dt * k; Ap[idx * 2] = (float)(mag * cos(ang)); Ap[idx * 2 + 1] = (float)(mag * sin(ang)); }
    if (tid < 64) { float* a32 = (float*)(a.ws + WS_A32) + (size_t)((l * 64 + g) * 64 + tid) * 2; const double re = lre[tid], im = lim[tid]; const double mag = exp(32.0 * re * dt), ang = 32.0 * im * dt;
        a32[0] = (float)(mag * cos(ang)); a32[1] = (float)(mag * sin(ang)); }
    for (int idx = tid; idx < 1024; idx += 512) { const int n = idx >> 4; const double re = lre[n], im = lim[n]; const double mag = exp(re * dt), ang = im * dt;
        const double lr = mag * cos(ang) - 1.0, li = mag * sin(ang), den = re * re + im * im;
        const double fr_ = (lr * re + li * im) / den, fi_ = (li * re - lr * im) / den; const double br = bre[idx], bi = bim[idx];
        Bb[idx * 2] = (float)(fr_ * br - fi_ * bi); Bb[idx * 2 + 1] = (float)(fr_ * bi + fi_ * br);
        Cc[idx * 2] = cre[idx]; Cc[idx * 2 + 1] = cim[idx]; }
    __syncthreads();
    { const int k = tid >> 4, p = tid & 15; float acc[16];
#pragma unroll
        for (int q = 0; q < 16; ++q) acc[q] = 0.f;
        for (int n = 0; n < 64; ++n) { const float ar = Ap[(k * 64 + n) * 2], ai = Ap[(k * 64 + n) * 2 + 1], cr = Cc[(p * 64 + n) * 2], ci = Cc[(p * 64 + n) * 2 + 1];
            const float ur = cr * ar - ci * ai, ui = cr * ai + ci * ar; const LAS f32x4* bq = (const LAS f32x4*)(Bb + n * 32);
#pragma unroll
            for (int q4 = 0; q4 < 8; ++q4) { const f32x4 bv = bq[q4]; acc[2 * q4] += bv[0] * ur - bv[1] * ui; acc[2 * q4 + 1] += bv[2] * ur - bv[3] * ui; } }
#pragma unroll
        for (int q = 0; q < 16; ++q) Mk[tid * 16 + q] = acc[q]; }
    __syncthreads();
    unsigned char* lw = a.ws + WS_W + (size_t)l * LW_BYTES;
    bf16_t* T = (bf16_t*)(lw + LW_TEXT) + (size_t)g * 512 * SSM_KX; bf16_t* W = (bf16_t*)(lw + LW_WSL) + (size_t)g * 256 * 512;
    for (int it = 0; it < 40; ++it) { const int c = it * 512 + tid, Rl = c / 80, ch = c - Rl * 80, R = 256 * half + Rl, i = R >> 4, p = R & 15; u32x4 w = {0u, 0u, 0u, 0u};
        if (ch < 64) { const int j = ch >> 1, q0 = (ch & 1) * 8;
            if (j <= i) { const LAS float* mp = Mk + ((i - j) * 16 + p) * 16 + q0; w.x = cvt_pk_bf16(mp[0], mp[1]); w.y = cvt_pk_bf16(mp[2], mp[3]); w.z = cvt_pk_bf16(mp[4], mp[5]); w.w = cvt_pk_bf16(mp[6], mp[7]); } }
        else { const int cc = ch - 64; float v[8];
#pragma unroll
            for (int e = 0; e < 4; ++e) { const int n = cc * 4 + e; const float cr = Cc[(p * 64 + n) * 2], ci = Cc[(p * 64 + n) * 2 + 1], ar = Ap[((i + 1) * 64 + n) * 2], ai = Ap[((i + 1) * 64 + n) * 2 + 1];
                v[2 * e] = cr * ar - ci * ai; v[2 * e + 1] = -(cr * ai + ci * ar); }
            w.x = cvt_pk_bf16(v[0], v[1]); w.y = cvt_pk_bf16(v[2], v[3]); w.z = cvt_pk_bf16(v[4], v[5]); w.w = cvt_pk_bf16(v[6], v[7]); }
        *(u32x4*)(T + (size_t)R * SSM_KX + ch * 8) = w; }
    for (int it = 0; it < 16; ++it) { const int c = it * 512 + tid, R = 128 * half + (c >> 6), ch = c & 63; u32x4 w = {0u, 0u, 0u, 0u};
        if (R < 128) { const int n = R >> 1, im = R & 1, j = ch >> 1, q0 = (ch & 1) * 8; float v[8]; const float ar = Ap[((31 - j) * 64 + n) * 2], ai = Ap[((31 - j) * 64 + n) * 2 + 1];
#pragma unroll
            for (int e = 0; e < 8; ++e) { const float br = Bb[(n * 16 + q0 + e) * 2], bi = Bb[(n * 16 + q0 + e) * 2 + 1]; v[e] = im ? (ar * bi + ai * br) : (ar * br - ai * bi); }
            w.x = cvt_pk_bf16(v[0], v[1]); w.y = cvt_pk_bf16(v[2], v[3]); w.z = cvt_pk_bf16(v[4], v[5]); w.w = cvt_pk_bf16(v[6], v[7]); }
        *(u32x4*)(W + (size_t)R * 512 + ch * 8) = w; }
    __syncthreads();
}

struct LnArgs { bf16_t* X; float* outf; unsigned char* outq; const float* g; const float* b;
                const float* og; const int* slot; int* r_e; float* r_w; unsigned* cnt; };
template <int MODE>
__device__ __forceinline__ void ln_phase(const LnArgs& A, LAS unsigned char* lds, int G) {
    const int tid = opaque_tid(), lane = tid & 63, wave = __builtin_amdgcn_readfirstlane(tid >> 6);
    const int gw = blockIdx.x * 8 + wave, NGW = G * 8;
    f32x4 gv[8], bv[8];
    if (MODE != 1) {
#pragma unroll
        for (int j = 0; j < 8; ++j) { gv[j] = *(const f32x4*)(A.g + lane * 8 + 512 * (j >> 1) + 4 * (j & 1)); bv[j] = *(const f32x4*)(A.b + lane * 8 + 512 * (j >> 1) + 4 * (j & 1)); } }
    for (int row = gw; row < M; row += NGW) {
        bf16_t* xr = A.X + (size_t)row * D + lane * 8;
        f32x4 v[8]; float s = 0.f;
#pragma unroll
        for (int j = 0; j < 4; ++j) { const u32x4 w = *(const u32x4*)(xr + 512 * j); v[2 * j] = (f32x4){bf_lo(w.x), bf_hi(w.x), bf_lo(w.y), bf_hi(w.y)}; v[2 * j + 1] = (f32x4){bf_lo(w.z), bf_hi(w.z), bf_lo(w.w), bf_hi(w.w)}; }
        if (MODE == 2) { const int s0 = A.slot[row * 2], s1 = A.slot[row * 2 + 1]; const bf16_t* o0 = (const bf16_t*)A.og + (size_t)s0 * D + lane * 8; const bf16_t* o1 = (const bf16_t*)A.og + (size_t)s1 * D + lane * 8;
#pragma unroll
            for (int j = 0; j < 4; ++j) { const u32x4 a = *(const u32x4*)(o0 + 512 * j), b = *(const u32x4*)(o1 + 512 * j);
                v[2 * j] = v[2 * j] * ALPHA + (f32x4){bf_lo(a.x), bf_hi(a.x), bf_lo(a.y), bf_hi(a.y)} + (f32x4){bf_lo(b.x), bf_hi(b.x), bf_lo(b.y), bf_hi(b.y)};
                v[2 * j + 1] = v[2 * j + 1] * ALPHA + (f32x4){bf_lo(a.z), bf_hi(a.z), bf_lo(a.w), bf_hi(a.w)} + (f32x4){bf_lo(b.z), bf_hi(b.z), bf_lo(b.w), bf_hi(b.w)}; } }
#pragma unroll
        for (int j = 0; j < 8; ++j) s += (v[j][0] + v[j][1]) + (v[j][2] + v[j][3]);
        const float mean = wave_sum(s, lane) * (1.f / D); float s2 = 0.f;
#pragma unroll
        for (int j = 0; j < 8; ++j) { v[j] = v[j] - mean; s2 += (v[j][0] * v[j][0] + v[j][1] * v[j][1]) + (v[j][2] * v[j][2] + v[j][3] * v[j][3]); }
        const float rstd = 1.f / sqrtf(wave_sum(s2, lane) * (1.f / D) + LN_EPS);
#pragma unroll
        for (int j = 0; j < 8; ++j) { if (MODE == 1) { gv[j] = *(const f32x4*)(A.g + lane * 8 + 512 * (j >> 1) + 4 * (j & 1)); bv[j] = *(const f32x4*)(A.b + lane * 8 + 512 * (j >> 1) + 4 * (j & 1)); }
            v[j] = v[j] * rstd * gv[j] + bv[j]; }
        if (A.outf) { float* of = A.outf + (size_t)row * D + lane * 8;
#pragma unroll
            for (int j = 0; j < 8; ++j) *(f32x4*)(of + 512 * (j >> 1) + 4 * (j & 1)) = v[j]; }
        else {
#pragma unroll
            for (int j = 0; j < 4; ++j) *(u32x4*)(xr + 512 * j) = pack8(v[2 * j], v[2 * j + 1]); }
        if (A.outq) { unsigned char* oq = A.outq + (size_t)row * D + lane * 8;
#pragma unroll
            for (int j = 0; j < 4; ++j) *(u32x2*)(oq + 512 * j) = pack8_fp8(v[2 * j], v[2 * j + 1]); }
        if (MODE == 1) {
            const LAS float* wr_ = (const LAS float*)lds;
            int i0 = 0, i1 = 0; float v0 = -__builtin_inff(), v1 = -__builtin_inff();
#pragma unroll 1
            for (int e = 0; e < 8; ++e) { float acc = 0.f;
#pragma unroll
                for (int j = 0; j < 8; ++j) { const f32x4 w = *(const LAS f32x4*)(wr_ + e * D + lane * 8 + 512 * (j >> 1) + 4 * (j & 1)); acc += (v[j][0] * w[0] + v[j][1] * w[1]) + (v[j][2] * w[2] + v[j][3] * w[3]); }
                const float sg = wave_sum(acc, lane);
                if (sg > v0) { v1 = v0; i1 = i0; v0 = sg; i0 = e; } else if (sg > v1) { v1 = sg; i1 = e; } }
            const float w0 = 1.f / (1.f + expf(v1 - v0)), w1 = 1.f - w0;
            if (lane == 0) { A.r_e[row * 2] = i0; A.r_e[row * 2 + 1] = i1; A.r_w[row * 2] = w0; A.r_w[row * 2 + 1] = w1;
                __hip_atomic_fetch_add(A.cnt + i0, 1u, RLX_AGENT); __hip_atomic_fetch_add(A.cnt + i1, 1u, RLX_AGENT); }
        }
    }
}
__device__ __forceinline__ void moe_offsets(const unsigned* cnt, int (&off)[9]) {
    int acc = 0;
#pragma unroll
    for (int e = 0; e < 8; ++e) { off[e] = acc; const int c = (int)__hip_atomic_load(cnt + e, RLX_AGENT); acc += ((c + 255) >> 8) << 8; }
    off[8] = acc;
}

struct AttPtrs { const bf16_t *QD, *KD, *VD, *QM, *KM, *VM; bf16_t *BR0, *BR1; };
__device__ __forceinline__ void mla_unit(const AttPtrs& P, int h, int qb, char* lds) {
    const int tid = opaque_tid(), wid = __builtin_amdgcn_readfirstlane(tid >> 6), lane = tid & 63, r32 = lane & 31, hi = lane >> 5;
    const int q0 = qb * 256 + wid * 32; f32x16 o[4]; float l;
    att::attn_core_pp<192, 12, true, true>(P.QM + (size_t)(q0 + r32) * 1536 + h * 192 + hi * 8, P.KM + h * 192, 1536, P.VM + h * 128, 1024, 4 * (qb + 1), q0 + r32, q0, 0, lds, o, l);
    float* ws = (float*)(lds + 3 * att::SHM_V + 3 * 64 * 384) + wid * 64;
    att::normalize_o(o, l, ws, r32, hi);
    att::store_o_bf16(o, P.BR1 + (size_t)q0 * 1024 + h * 128, 1024, r32, hi);
    __syncthreads();
}
__device__ __forceinline__ void diff_unit(const AttPtrs& P, int h, int qb, float lam, char* lds) {
    const int tid = opaque_tid(), wid = __builtin_amdgcn_readfirstlane(tid >> 6), lane = tid & 63, r32 = lane & 31, hi = lane >> 5;
    const int mp = wid >> 2, w4 = wid & 3, q0 = qb * 128 + w4 * 32; f32x16 o[4]; float l;
    att::attn_core_pp<128, 4, true, true>(P.QD + (size_t)(q0 + r32) * 1024 + h * 128 + mp * 64 + hi * 8, P.KD + h * 128, 1024, P.VD + h * 128, 1024, 2 * (qb + 1), q0 + r32, q0, mp * 8, lds, o, l);
    float* ws = (float*)(lds + 3 * att::SHM_V + 3 * 64 * 256) + wid * 64;
    att::normalize_o(o, l, ws, r32, hi);
    __syncthreads();
    float* xch = (float*)lds + w4 * 4096 + lane;
    if (mp == 1) {
#pragma unroll
        for (int d0 = 0; d0 < 4; ++d0)
#pragma unroll
            for (int r = 0; r < 16; ++r) xch[(d0 * 16 + r) * 64] = o[d0][r];
    }
    __syncthreads();
    if (mp == 0) {
        float ss[16];
#pragma unroll
        for (int r = 0; r < 16; ++r) { float s = 0.f;
#pragma unroll
            for (int d0 = 0; d0 < 4; ++d0) { const float dv = o[d0][r] - lam * xch[(d0 * 16 + r) * 64]; o[d0][r] = dv; s += dv * dv; }
            ss[r] = s; }
#pragma unroll
        for (int r = 0; r < 16; ++r) { float s = ss[r];
#pragma unroll
            for (int off = 1; off < 32; off <<= 1) s += shflx(s, off, lane);
            const float rs = __builtin_amdgcn_rsqf(s * (1.f / 128.f) + RMS_EPS);
#pragma unroll
            for (int d0 = 0; d0 < 4; ++d0) o[d0][r] *= rs; }
        att::store_o_bf16(o, P.BR0 + (size_t)q0 * 1024 + h * 128, 1024, r32, hi);
    }
    __syncthreads();
}
__device__ __forceinline__ void cross_unit(const bf16_t* XQ, const bf16_t* XKV, bf16_t* XO, int h, int qb, char* lds) {
    const int tid = opaque_tid(), wid = __builtin_amdgcn_readfirstlane(tid >> 6), lane = tid & 63, r32 = lane & 31, hi = lane >> 5;
    const int q0 = qb * 256 + wid * 32; f32x16 o[4]; float l;
    att::attn_core<128, 8, false, true>(XQ + (size_t)(q0 + r32) * 512 + h * 128 + hi * 8, XKV + h * 128, 1024, XKV + 512 + h * 128, 1024, 4, 0, 0, 0, lds, o, l);
    float* ws = (float*)(lds + 2 * att::SHM_V + 2 * 64 * 256) + wid * 64;
    att::normalize_o(o, l, ws, r32, hi);
    att::store_o_bf16(o, XO + (size_t)q0 * 512 + h * 128, 512, r32, hi);
    __syncthreads();
}

__global__ void __launch_bounds__(512, 2) fwd_kernel(Args args) {
    extern __shared__ __attribute__((aligned(16))) unsigned char lds_raw[];
    LAS unsigned char* lds = (LAS unsigned char*)lds_raw;
    const int tid = threadIdx.x, lane = tid & 63, wave = __builtin_amdgcn_readfirstlane(tid >> 6);
    const int G = gridDim.x, bx = blockIdx.x;
    unsigned char* ws = (unsigned char*)(GAS unsigned char*)(unsigned long long)args.ws;
    unsigned* ctl = (unsigned*)(ws + WS_CTL);
    volatile LAS unsigned* MISC = (volatile LAS unsigned*)(lds + LDS_MISC);
    if (tid < 32) MISC[tid] = 0u;
    if (lane == 0) ((volatile LAS int*)LDS_WTAB)[__builtin_amdgcn_s_getreg(0x2804)] = wave;
    { volatile LAS unsigned long long* pt = (volatile LAS unsigned long long*)(lds + LDS_MISC + 256); if (tid < 35) pt[tid] = (unsigned long long)args.in[tid]; if (tid == 35) pt[35] = (unsigned long long)args.out; }
    __syncthreads();
    ArgsD ad; ad.in.t = (volatile LAS unsigned long long*)(lds + LDS_MISC + 256); ad.ws = ws;
    const int lo = args.ph_lo, hi = args.ph_hi;
    XcdBarrier bar; bar.bar = ctl + CW_BAR; bar.x = 0; bar.st = nullptr;
    if (hi - lo > 1) { bar = xcd_barrier_post(ctl + CW_BAR, MISC + 8); xcd_barrier_setup(bar); }
#ifndef PH_SEL
#define PH_SEL 0xFFFFFFFFu
#endif
#define INR(k) (lo <= (k) && (k) < hi)
#define IN0() (((PH_SEL) & 1u) && INR(0))
#define INL(j) ((((PH_SEL) >> ((j) + 1)) & 1u) && INR(pb + (j)))
#define SEAM(k) do { if (INR(k) && INR((k) + 1)) xcd_barrier(bar); } while (0)
    const int gw = bx * 8 + wave, NGW = G * 8;
    const int gtid = bx * 512 + tid, NGT = G * 512;

    if (IN0()) {
      {
        { int start = bx;
            for (int id = 0; id < NMAT; ++id) { const Mat mt = get_mat(ad, id); if (mt.kind == 1) continue; const int nit = (mt.K / 64) * (mt.N / 256);
                int it = start; for (; it < nit; it += G) cvt_tile_wg(mt, (LAS float*)lds, it, tid);
                start = it - nit; } }
        { LAS float* scr = (LAS float*)(lds + wave * 16640); int start = gw;
            for (int id = 0; id < 22; id += 11) { const Mat mt = get_mat(ad, id); const int nit = (mt.K / 64) * (mt.N / 64);
                int it = start; for (; it < nit; it += NGW) cvt_item(mt, scr, it, lane);
                start = it - nit; } }
        for (int l = 0; l < DEPTH; ++l) { u32x4* p = (u32x4*)((unsigned char*)(ws + WS_W + (size_t)l * LW_BYTES + LW_IN) + (size_t)NIN_BF * D * 2 + (size_t)(3904 - NIN_BF) * D);
            for (int i = gtid; i < 192 * D / 16; i += NGT) p[i] = (u32x4){0u, 0u, 0u, 0u}; }
        { const float* x = (const float*)ad.in[I_X]; bf16_t* xn = (bf16_t*)(ws + WS_XN);
            unsigned char* x8 = ws + WS_XN8;
            for (size_t i = gtid; i < (size_t)M * D / 8; i += NGT) { const f32x4 a = *(const f32x4*)(x + i * 8), b = *(const f32x4*)(x + i * 8 + 4); *(u32x4*)(xn + i * 8) = pack8(a, b); *(u32x2*)(x8 + i * 8) = pack8_fp8(a, b); }
            const float* mem = (const float*)ad.in[I_MEM]; bf16_t* mb = (bf16_t*)(ws + WS_MEMB);
            for (int i = gtid; i < MEM_LEN * D / 8; i += NGT) { const f32x4 a = *(const f32x4*)(mem + i * 8), b = *(const f32x4*)(mem + i * 8 + 4); *(u32x4*)(mb + i * 8) = pack8(a, b); } }
        { const int* pos = (const int*)ad.in[I_POS]; float* td = (float*)(ws + WS_TABD); float* tm = (float*)(ws + WS_TABM);
            for (int i = gtid; i < M * 40; i += NGT) { const int t = i / 40, k = i - t * 40; const double p = (double)pos[t];
                const double inv = (k < 8) ? exp(-(double)k * (13.122363377404328 / 8.0)) : exp(-(double)(k - 8) * (13.122363377404328 / 32.0));
                const double ang = p * inv; const float c = (float)cos(ang), s = (float)sin(ang);
                if (k < 8) { td[(t * 8 + k) * 2] = c; td[(t * 8 + k) * 2 + 1] = s; } else { tm[(t * 32 + k - 8) * 2] = c; tm[(t * 32 + k - 8) * 2 + 1] = s; } } }
        if (bx == 0 && tid < 192) { int* ord = (int*)(ws + WS_ORDER); const int mine = tid < 64 ? 160 * (tid + 1) : 48 * (tid - 64 + 1); int rank = 0;
            for (int c = 0; c < 192; ++c) { const int cc = c < 64 ? 160 * (c + 1) : 48 * (c - 64 + 1); rank += (cc > mine || (cc == mine && c < tid)) ? 1 : 0; }
            const int code = tid < 64 ? ((1 << 16) | (tid << 8)) : ((tid - 64) << 8);
            for (int h = 0; h < 8; ++h) ord[rank * 8 + h] = code | h; }
        __syncthreads();
#ifdef PROBE_SSMB
#pragma nounroll
        for (int rep_ = 0; rep_ < 2; ++rep_)
#endif
        for (int uidx = bx; uidx < DEPTH * 64 * 2; uidx += G) ssm_build(ad, uidx >> 7, (uidx >> 1) & 63, uidx & 1, lds);
        __syncthreads();
      }
    }
    SEAM(0);

    unsigned char* const ws_k = ws; const int bx_k = bx;
    for (int l = 0; l < DEPTH; ++l) {
        const int pb = 1 + l * NPL;
        if (!(lo < pb + NPL && pb < hi)) continue;
        int bx = bx_k; asm volatile("" : "+s"(bx));
        unsigned long long ws_i = (unsigned long long)ws_k; asm volatile("" : "+s"(ws_i)); unsigned char* ws = (unsigned char*)(GAS unsigned char*)ws_i;
#define PH_TID const int tid = opaque_tid(), lane = tid & 63, wave = __builtin_amdgcn_readfirstlane(tid >> 6); const int gw = bx * 8 + wave, NGW = G * 8; (void)lane; (void)wave; (void)gw; (void)NGW
#define lw (ws + WS_W + (size_t)l * LW_BYTES)
#define ssq_q ((float*)(ws + WS_PSQ))
#define ssq_kv (ssq_q + (size_t)8 * M)
#define XS ((float*)(ws + WS_XS))
#define XN ((bf16_t*)(ws + WS_XN))
#define tabd ((const float*)(ws + WS_TABD))
#define tabm ((const float*)(ws + WS_TABM))
#define QD ((bf16_t*)(ws + WS_QD))
#define KD ((bf16_t*)(ws + WS_KD))
#define VD ((bf16_t*)(ws + WS_VD))
#define MQ ((bf16_t*)(ws + WS_MQ))
#define MKV ((bf16_t*)(ws + WS_MKV))
#define KM ((bf16_t*)(ws + WS_KM))
#define VM ((bf16_t*)(ws + WS_VM))
#define QM ((bf16_t*)(ws + WS_QM))
#define SU ((bf16_t*)(ws + WS_SU))
#define GATES ((bf16_t*)(ws + WS_GATES))
#define SLOC ((float*)(ws + WS_SLOC))
#define YG ((bf16_t*)(ws + WS_YG))
#define BR ((bf16_t*)(ws + WS_BR))
#define TMP ((float*)(ws + WS_TMP))
#define MG ((bf16_t*)(ws + WS_MG))
#define XQ ((bf16_t*)(ws + WS_XQ))
#define XO ((bf16_t*)(ws + WS_XO))
#define XKV ((bf16_t*)(ws + WS_XKV) + (size_t)l * 256 * 1024)
#define r_e ((int*)(ws + WS_ROUTE))
#define r_w ((float*)(ws + WS_ROUTE + 128 * 1024))
#define slot ((int*)(ws + WS_ROUTE + 256 * 1024))
#define wslot ((float*)(ws + WS_ROUTE + 384 * 1024))
        if (INL(0)) {
#if !defined(SUBSEL) || (SUBSEL & 1)
            { pg8::Gemm g{XN, (const bf16_t*)(lw + LW_IN), (D) * 2, (D) * 2, (D) * 2, 0}; SchedPlain S; S.init(M / 256, NIN_BF / 256, D, D, G, bx);
              EpiInProj E{QD, KD, VD, MQ, MKV, KM, SU, GATES, ssq_q, ssq_kv, tabd, tabm, 0};
              pg8::gemm_phase(lds, g, S, E); }
            { pg8::Gemm g{ws + WS_XN8, lw + LW_IN + (size_t)NIN_BF * D * 2, D, D, D, 0}; SchedPlain S; S.T.init(M / 256, NIN_G8 / 256); S.G = G; S.c = bx; S.tA = (size_t)256 * D; S.tB = S.tA;
              EpiInProj E{QD, KD, VD, MQ, MKV, KM, SU, GATES, ssq_q, ssq_kv, tabd, tabm, 12};
              pg8::gemm_phase_t<true, 0x7C7C7C7C>(lds, g, S, E); }
#endif
#if !defined(SUBSEL) || (SUBSEL & 2)
            { pg8::Gemm g{(const bf16_t*)(ws + WS_MEMB), (const bf16_t*)(lw + LW_XKV), (D) * 2, (D) * 2, (D) * 2, 0}; SchedPlain S; S.init(1, 4, D, D, G, (bx + 128) % G);
              EpiBf16 E{XKV, 1024, 1.f};
              pg8::gemm_phase(lds, g, S, E); }
#endif
        }
        SEAM(pb + 0);
        if (INL(1)) {
#if !defined(SUBSEL) || (SUBSEL & 1)
            { pg8::Gemm g{MQ, (const bf16_t*)(lw + LW_QUP), (512) * 2, (512) * 2, (512) * 2, 0}; SchedPlain S; S.init(M / 256, 6, 512, 512, G, bx);
              EpiQup E{QM, ssq_q, tabm}; pg8::gemm_phase(lds, g, S, E); }
#endif
#if !defined(SUBSEL) || (SUBSEL & 2)
            { pg8::Gemm g{MKV, (const bf16_t*)(lw + LW_KVUP), (256) * 2, (256) * 2, (256) * 2, 0}; SchedPlain S; S.init(M / 256, 8, 256, 256, G, (bx + 128) % G);
              EpiKVup E{KM, VM, ssq_kv}; pg8::gemm_phase(lds, g, S, E); }
#endif
#if !defined(SUBSEL) || (SUBSEL & 4)
            { pg8::Gemm g{SU, (const bf16_t*)(lw + LW_WSL), (SSM_KX) * 2, (512) * 2, (512) * 2, 0}; SchedBatch S{2, 1, 64, G, (bx + 128) % G  , (size_t)256 * SSM_KX * 2, (size_t)256 * 512 * 2, (size_t)SSM_NCH * SSM_KX * 2, (size_t)256 * 512 * 2};
              EpiSloc E{SLOC}; pg8::gemm_phase(lds, g, S, E); }
#endif
        }
        SEAM(pb + 1);
        if (INL(2)) {
            PH_TID;
            if (bx < 64) { const int g = bx, n = lane, w = wave;
                const float* a32 = (const float*)(ws + WS_A32) + (size_t)((l * 64 + g) * 64 + n) * 2; const float ar = a32[0], ai = a32[1];
                const float* __restrict__ lp = SLOC + ((size_t)g * SSM_NCH + 64 * w) * 128 + 2 * n; bf16_t* __restrict__ sp = SU + ((size_t)g * SSM_NCH + 64 * w) * SSM_KX + 512 + 2 * n;
                float br[64], bi[64]; float sr = 0.f, si = 0.f;
#pragma unroll
                for (int c0 = 0; c0 < 64; c0 += 32) { f32x2 lv[32];
#pragma unroll
                    for (int k = 0; k < 32; ++k) lv[k] = *(const f32x2*)(lp + (size_t)(c0 + k) * 128);
#pragma unroll
                    for (int k = 0; k < 32; ++k) { br[c0 + k] = sr; bi[c0 + k] = si; const float nr = ar * sr - ai * si + lv[k][0], ni = ar * si + ai * sr + lv[k][1]; sr = nr; si = ni; } }
                LAS float* ex = (LAS float*)lds;
                ex[(w * 64 + n) * 2] = sr; ex[(w * 64 + n) * 2 + 1] = si;
                float pr = ar, pi = ai;
#pragma unroll
                for (int q = 0; q < 6; ++q) { const float tr = pr * pr - pi * pi, ti = 2.f * pr * pi; pr = tr; pi = ti; }
                __syncthreads();
                float cr = 0.f, ci = 0.f;
                for (int uu = 0; uu < w; ++uu) { const float er = ex[(uu * 64 + n) * 2], ei = ex[(uu * 64 + n) * 2 + 1]; const float tr = pr * cr - pi * ci + er, ti = pr * ci + pi * cr + ei; cr = tr; ci = ti; }
#pragma unroll
                for (int k = 0; k < 64; ++k) { *(unsigned*)(sp + (size_t)k * SSM_KX) = cvt_pk_bf16(br[k] + cr, bi[k] + ci);
                    const float tr = ar * cr - ai * ci, ti = ar * ci + ai * cr; cr = tr; ci = ti; } }
        }
        SEAM(pb + 2);
        if (INL(3)) {
#if !defined(SUBSEL) || (SUBSEL & 1)
            { pg8::Gemm g{SU, (const bf16_t*)(lw + LW_TEXT), (SSM_KX) * 2, (SSM_KX) * 2, (SSM_KX) * 2, 0}; SchedBatch S{2, 2, 64, G, bx, (size_t)256 * SSM_KX * 2, (size_t)256 * SSM_KX * 2, (size_t)SSM_NCH * SSM_KX * 2, (size_t)512 * SSM_KX * 2};
              EpiSsmY E{YG, SU, (const float*)ad.in[I_SSMD] + l * 1024}; pg8::gemm_phase(lds, g, S, E); }
#endif
            PH_TID;
            const float* dl = (const float*)ad.in[I_DLAM] + l * 256;
            const float lam = expf(wave_sum(dl[lane] * dl[64 + lane], lane)) - expf(wave_sum(dl[128 + lane] * dl[192 + lane], lane)) + lam_init_of(l);
            const AttPtrs P{QD, KD, VD, QM, KM, VM, BR, BR + (size_t)M * 1024};
            const int* ord = (const int*)(ws + WS_ORDER);
            __syncthreads();
#ifndef PROBE_ATT
#define PROBE_ATT 0
#endif
            const unsigned myx = xb_xcc_id() & 7u;
#pragma nounroll
            for (int rep = 0; rep < (PROBE_ATT ? 2 : 1); ++rep)
#pragma nounroll
            for (int sq = 0; sq < 8; ++sq) { const int q = (int)((myx + sq) & 7u);
            for (;;) {
                if (tid == 0) MISC[0] = __hip_atomic_fetch_add(ctl + CW_ATTQ + 64 * l + 32 * rep + q, 1u, RLX_AGENT);
                __syncthreads();
                const unsigned it = MISC[0];
                __syncthreads();
                if (it >= 192u) break;
                const int code = ord[it * 8 + q], h = code & 255, qb = (code >> 8) & 255;
                if ((code >> 16) && (rep == 0 || (PROBE_ATT & 1))) mla_unit(P, h, qb, (char*)lds_raw);
                if (!(code >> 16) && (rep == 0 || (PROBE_ATT & 2))) diff_unit(P, h, qb, lam, (char*)lds_raw);
            } }
        }
        SEAM(pb + 3);
        if (INL(4)) {
            pg8::Gemm g{YG, (const bf16_t*)(lw + LW_GLU), (1024) * 2, (1024) * 2, (1024) * 2, 0}; SchedPlain S; S.init(M / 256, 8, 1024, 1024, G, bx);
            EpiGated<0> E{BR + (size_t)2 * M * 1024, 1024}; pg8::gemm_phase(lds, g, S, E);
        }
        SEAM(pb + 4);
        if (INL(5)) {
            pg8::Gemm g{BR, (const bf16_t*)(lw + LW_BR), (1024) * 2, (1024) * 2, (1024) * 2, 0}; SchedBranch S; S.T.init(M / 256, 8); S.G = G; S.c = bx; S.tA = (size_t)256 * 1024 * 2; S.tB = S.tA; S.zA = (size_t)M * 1024 * 2; S.zB = (size_t)2048 * 1024 * 2;
            EpiBranch E{GATES, (bf16_t*)TMP, MG}; pg8::gemm_phase(lds, g, S, E);
        }
        SEAM(pb + 5);
        if (INL(6)) {
            pg8::Gemm g{MG, (const bf16_t*)(lw + LW_OUT), (D) * 2, (D) * 2, (D) * 2, 0}; SchedPlain S; S.init(M / 256, 8, D, D, G, bx);
            EpiResid E{XN}; pg8::gemm_phase(lds, g, S, E);
        }
        SEAM(pb + 6);
        if (INL(7)) { const LnArgs A{XN, nullptr, nullptr, (const float*)ad.in[I_LNMG] + l * D, (const float*)ad.in[I_LNMB] + l * D, nullptr, nullptr, nullptr, nullptr, nullptr}; ln_phase<0>(A, lds, G); }
        SEAM(pb + 7);
        if (INL(8)) {
            pg8::Gemm g{XN, (const bf16_t*)(lw + LW_XQ), (D) * 2, (D) * 2, (D) * 2, 0}; SchedPlain S; S.T.init(M / 128, 2); S.G = G; S.c = bx; S.tA = (size_t)128 * D * 2; S.tB = (size_t)256 * D * 2;
            EpiBf16Half E{XQ, 512, C2_X}; pg8::gemm_phase(lds, g, S, E);
        }
        SEAM(pb + 8);
        if (INL(9)) { for (int uidx = bx; uidx < 256; uidx += G) cross_unit(XQ, XKV, XO, uidx & 3, uidx >> 2, (char*)lds_raw); }
        SEAM(pb + 9);
        if (INL(10)) {
            pg8::Gemm g{XO, (const bf16_t*)(lw + LW_XO), (512) * 2, (512) * 2, (512) * 2, 0}; SchedPlain S; S.init(M / 256, 8, 512, 512, G, bx);
            EpiResid E{XN}; pg8::gemm_phase(lds, g, S, E);
        }
        SEAM(pb + 10);
        if (INL(11)) {
            const LnArgs A{XN, nullptr, nullptr, (const float*)ad.in[I_LNXG] + l * D, (const float*)ad.in[I_LNXB] + l * D, nullptr, nullptr, r_e, r_w, ctl + CW_MOECNT};
            if (l == 0) ln_phase<0>(A, lds, G);
            else { PH_TID; const float* rw = (const float*)ad.in[I_ROUTER]; LAS float* wl = (LAS float*)lds;
                for (int i = tid; i < D * 8; i += 512) wl[(i & 7) * D + (i >> 3)] = rw[i];
                __syncthreads(); ln_phase<1>(A, lds, G); __syncthreads(); }
        }
        SEAM(pb + 11);
        if (l == 1) {
            if (INL(12)) { PH_TID; int off[9]; moe_offsets(ctl + CW_MOECNT, off); bf16_t* XG = (bf16_t*)(ws + WS_XG);
                for (int row = gw; row < M; row += NGW) { int s0 = 0, s1 = 0;
                    if (lane == 0) { const int e0 = r_e[row * 2], e1 = r_e[row * 2 + 1];
                        s0 = off[e0] + (int)__hip_atomic_fetch_add(ctl + CW_MOECUR + e0, 1u, RLX_AGENT); s1 = off[e1] + (int)__hip_atomic_fetch_add(ctl + CW_MOECUR + e1, 1u, RLX_AGENT);
                        slot[row * 2] = s0; slot[row * 2 + 1] = s1; wslot[s0] = r_w[row * 2]; wslot[s1] = r_w[row * 2 + 1]; }
                    s0 = __builtin_amdgcn_readfirstlane(s0); s1 = __builtin_amdgcn_readfirstlane(s1);
                    const u32x4* src = (const u32x4*)(XN + (size_t)row * D) + lane; u32x2* d0 = (u32x2*)((unsigned char*)XG + (size_t)s0 * D) + lane; u32x2* d1 = (u32x2*)((unsigned char*)XG + (size_t)s1 * D) + lane;
#pragma unroll
                    for (int j = 0; j < 4; ++j) { const u32x4 v = src[64 * j];
                        const u32x2 q = pack8_fp8((f32x4){bf_lo(v.x), bf_hi(v.x), bf_lo(v.y), bf_hi(v.y)}, (f32x4){bf_lo(v.z), bf_hi(v.z), bf_lo(v.w), bf_hi(v.w)}); d0[64 * j] = q; d1[64 * j] = q; } } }
            SEAM(pb + 12);
        }
        if (INL(13)) {
            if (l == 0) { pg8::Gemm g{XN, (const bf16_t*)(ws + WS_FFN), (D) * 2, (D) * 2, (D) * 2, 0}; SchedPlain S; S.init(M / 256, 44, D, D, G, bx);
                EpiSwigluF8 E{ws + WS_HG, DFF}; pg8::gemm_phase(lds, g, S, E); }
            else { int off[9]; moe_offsets(ctl + CW_MOECNT, off);
                pg8::Gemm g{ws + WS_XG, ws + WS_MOE, D, D, D, 0x7C7C7C7C}; SchedMoe S; S.T.init(off[8] >> 8, 44); S.G = G; S.c = bx; S.tA = (size_t)256 * D; S.tB = S.tA; S.zB = 66 * MiB;
#pragma unroll
                for (int k = 0; k < 7; ++k) S.off[k] = off[k + 1];
                EpiSwigluF8 E{ws + WS_HG, DFF}; pg8::gemm_phase_t<true, 0x7C7C7C7C>(lds, g, S, E); }
        }
        SEAM(pb + 13);
        if (INL(14)) {
            if (l == 0) { pg8::Gemm g{ws + WS_HG, ws + WS_FFN + 44 * MiB, DFF, DFF, DFF, 0x7B7B7B7B}; SchedPlain S; S.init(M / 256, 8, DFF / 2, DFF / 2, G, bx);
                EpiResid E{XN}; pg8::gemm_phase_t<true, 0x7B7B7B7B>(lds, g, S, E); }
            else { int off[9]; moe_offsets(ctl + CW_MOECNT, off);
                pg8::Gemm g{ws + WS_HG, ws + WS_MOE + 44 * MiB, DFF, DFF, DFF, 0x7B7B7B7B}; SchedMoe S; S.T.init(off[8] >> 8, 8); S.G = G; S.c = bx; S.tA = (size_t)256 * DFF; S.tB = S.tA; S.zB = 66 * MiB;
#pragma unroll
                for (int k = 0; k < 7; ++k) S.off[k] = off[k + 1];
                EpiMoeDown E{(bf16_t*)(ws + WS_OG), wslot}; pg8::gemm_phase_t<true, 0x7B7B7B7B>(lds, g, S, E); }
        }
        SEAM(pb + 14);
        if (INL(15)) {
            const LnArgs A{XN, (l == DEPTH - 1) ? (float*)ad.in[35] : nullptr, (l == DEPTH - 1) ? nullptr : ws + WS_XN8, (const float*)ad.in[I_LNFG] + l * D, (const float*)ad.in[I_LNFB] + l * D, (const float*)(ws + WS_OG), slot, nullptr, nullptr, nullptr};
            if (l == 0) ln_phase<0>(A, lds, G); else ln_phase<2>(A, lds, G);
        }
        SEAM(pb + 15);
    }
#undef INR
#undef IN0
#undef INL
#undef SEAM
}

extern "C" void kernel_launch(void* const* d_in, const int* in_sizes, int n_in, void* d_out, int out_size, void* d_ws, size_t ws_size, hipStream_t stream) {
    static int grid = 0;
    if (grid == 0) {
        if (n_in != 35 || out_size != M * D || ws_size < WS_END) { fprintf(stderr, "kernel_launch: shape/workspace mismatch: n_in %d out %d ws %zu (need %zu)\n", n_in, out_size, ws_size, (size_t)WS_END); grid = -1; return; }
        int dev = 0, cus = 0, per_cu = 0;
        if (hipGetDevice(&dev) != hipSuccess || hipDeviceGetAttribute(&cus, hipDeviceAttributeMultiprocessorCount, dev) != hipSuccess) { grid = -1; return; }
        if (hipFuncSetAttribute((const void*)fwd_kernel, hipFuncAttributeMaxDynamicSharedMemorySize, LDS_BYTES) != hipSuccess) { fprintf(stderr, "kernel_launch: hipFuncSetAttribute failed\n"); grid = -1; return; }
        if (hipOccupancyMaxActiveBlocksPerMultiprocessor(&per_cu, (const void*)fwd_kernel, 512, LDS_BYTES) != hipSuccess || per_cu < 1) { fprintf(stderr, "kernel_launch: occupancy query says %d\n", per_cu); }
        (void)hipGetLastError();
        grid = cus;
    }
    if (grid < 0) return;
    if (hipMemsetAsync((char*)d_ws + WS_CTL, 0, CTL_ZERO_BYTES, stream) != hipSuccess) return;
    Args a{};
    for (int i = 0; i < 35; ++i) a.in[i] = d_in[i];
    a.out = (float*)d_out; a.ws = (unsigned char*)d_ws;
#if MK_MULTI
    for (int p = 0; p < NPHASE; ++p) { if (p == 1 + 12) continue; a.ph_lo = p; a.ph_hi = p + 1; hipLaunchKernelGGL(fwd_kernel, dim3(grid), dim3(512), LDS_BYTES, stream, a); }
#else
    a.ph_lo = 0; a.ph_hi = NPHASE;
    hipLaunchKernelGGL(fwd_kernel, dim3(grid), dim3(512), LDS_BYTES, stream, a);
#endif
    const hipError_t le = hipPeekAtLastError();
    if (le != hipSuccess) fprintf(stderr, "kernel_launch: launch failed: %s\n", hipGetErrorName(le));
}
```

```cpp
#include <hip/hip_runtime.h>
#include <cstdio>
#include <cstdint>
#include <cmath>

#ifndef MK_MULTI
#define MK_MULTI 0
#endif
#ifndef MK_DBG
#define MK_DBG 0
#endif

#define GAS __attribute__((address_space(1)))
#define LAS __attribute__((address_space(3)))
typedef unsigned short bf16_t;
typedef short bf16x8 __attribute__((ext_vector_type(8)));
typedef short s16x4 __attribute__((ext_vector_type(4)));
typedef float f32x2 __attribute__((ext_vector_type(2)));
typedef float f32x4 __attribute__((ext_vector_type(4)));
typedef float f32x16 __attribute__((ext_vector_type(16)));
typedef unsigned u32x2 __attribute__((ext_vector_type(2)));
typedef unsigned u32x4 __attribute__((ext_vector_type(4)));
typedef GAS unsigned gu32;
#define RLX_AGENT __ATOMIC_RELAXED, __HIP_MEMORY_SCOPE_AGENT
#define LDS_WAIT() asm volatile("s_waitcnt lgkmcnt(0)" ::: "memory")
#define VM_WAIT() asm volatile("s_waitcnt vmcnt(0)" ::: "memory")
#define SBAR() __builtin_amdgcn_sched_barrier(0)

constexpr int M = 16384, D = 2048, DEPTH = 2, MEM_LEN = 256;
constexpr int NIN = 11264, NIN_BF = 3072  , NIN_G8 = 8192  ;
constexpr int NIN_SRC = 11072;
constexpr int DFF = 5632, NEXP = 8;
constexpr int SSM_L = 32, SSM_NCH = M / SSM_L  , SSM_KX = 640  ;
constexpr float LN_EPS = 1e-5f, RMS_EPS = 1e-6f;
constexpr float ALPHA = 1.4142135623730951f;
constexpr float LOG2E = 1.4426950408889634f;
constexpr float C2_DIFF = 0.125f * LOG2E;
constexpr float C2_MLA = 0.07216878364870323f * LOG2E;
constexpr float C2_X = 0.08838834764831845f * LOG2E;
constexpr int MOE_MAXROWS = 34816;

typedef __bf16 bf16x2_t __attribute__((ext_vector_type(2)));
__device__ __forceinline__ unsigned cvt_pk_bf16(float lo, float hi) { const f32x2 v = {lo, hi}; const bf16x2_t b = __builtin_convertvector(v, bf16x2_t); return __builtin_bit_cast(unsigned, b); }
__device__ __forceinline__ float bf_lo(unsigned w) { return __uint_as_float(w << 16); }
__device__ __forceinline__ float bf_hi(unsigned w) { return __uint_as_float(w & 0xffff0000u); }
__device__ __forceinline__ u32x4 pack8(f32x4 a, f32x4 b) { u32x4 w; w.x = cvt_pk_bf16(a[0], a[1]); w.y = cvt_pk_bf16(a[2], a[3]); w.z = cvt_pk_bf16(b[0], b[1]); w.w = cvt_pk_bf16(b[2], b[3]); return w; }
__device__ __forceinline__ u32x2 pack8_fp8(f32x4 a, f32x4 b) { int w0 = 0, w1 = 0;
    w0 = __builtin_amdgcn_cvt_pk_fp8_f32(a[0], a[1], w0, false); w0 = __builtin_amdgcn_cvt_pk_fp8_f32(a[2], a[3], w0, true);
    w1 = __builtin_amdgcn_cvt_pk_fp8_f32(b[0], b[1], w1, false); w1 = __builtin_amdgcn_cvt_pk_fp8_f32(b[2], b[3], w1, true);
    u32x2 r; r.x = (unsigned)w0; r.y = (unsigned)w1; return r; }
__device__ __forceinline__ float fast_sigmoid(float x) { return __builtin_amdgcn_rcpf(1.f + __builtin_amdgcn_exp2f(-x * LOG2E)); }
constexpr int LDS_WTAB = 131072 + 8192 + 1024;
__device__ __forceinline__ int opaque_tid() {
    const unsigned hw = __builtin_amdgcn_s_getreg(0x2804);
    const int wave = __builtin_amdgcn_readfirstlane(((volatile LAS int*)LDS_WTAB)[hw]);
    int lane; asm volatile("v_mbcnt_lo_u32_b32 %0, -1, 0\n\tv_mbcnt_hi_u32_b32 %0, -1, %0" : "=v"(lane));
    return wave * 64 + lane;
}
__device__ __forceinline__ float shflx(float v, int off, int lane) { return __int_as_float(__builtin_amdgcn_ds_bpermute((lane ^ off) << 2, __float_as_int(v))); }
__device__ __forceinline__ float wave_sum(float v, int lane) {
#pragma unroll
    for (int o = 1; o < 64; o <<= 1) v += shflx(v, o, lane);
    return v;
}

namespace pg8 {
constexpr int BM = 256, BK = 64, HALF = 128, HTB = HALF * BK * 2, STAGE_BYTES = 8 * HTB, NXCD = 8, WGM = 4;
__host__ __device__ __forceinline__ int lds_byte(int r, int c) { const int st = (r >> 4) * 2 + (c >> 5), rr = r & 15, cc = c & 31, ob = rr * 64 + cc * 2; return st * 1024 + (ob ^ (((ob >> 9) & 1) << 5)); }
__host__ __device__ __forceinline__ void stage_rc(int b, int& R, int& C) { const int st = b / 1024, sb = b % 1024, swz = sb ^ (((sb >> 9) & 1) << 5); R = (st >> 1) * 16 + swz / 64; C = (st & 1) * 32 + (swz % 64) / 2; }
__host__ __device__ __forceinline__ int perm32(int rho) { const int n = rho >> 4, i = rho & 15; return 8 * (i >> 2) + 4 * n + (i & 3); }

__device__ __forceinline__ size_t uni64(size_t v) { const unsigned lo_ = __builtin_amdgcn_readfirstlane((unsigned)v), hi_ = __builtin_amdgcn_readfirstlane((unsigned)(v >> 32)); return ((size_t)hi_ << 32) | lo_; }
struct Unit { int pm, pn, z; size_t offA, offB; };
struct Gemm { const void* A; const void* Bt; int ldaB, ldbB, KB; int wscale; };
typedef int v8i __attribute__((ext_vector_type(8)));
typedef int v4i __attribute__((ext_vector_type(4)));

struct TileOrder {
    int nM, nN, nwg;
    __device__ __forceinline__ void init(int nM_, int nN_) { nM = nM_; nN = nN_; nwg = nM * nN; }
    __device__ __forceinline__ bool map(long L, int& pm, int& pn) const {
        if (L >= nwg) return false;
        int wgid = (int)L; { const int q = nwg / NXCD, r = nwg % NXCD, xcd = wgid % NXCD, off = wgid / NXCD; wgid = (xcd < r ? xcd * (q + 1) : r * (q + 1) + (xcd - r) * q) + off; }
        const int nig = WGM * nN, gid = wgid / nig, fm = gid * WGM, gsz = (nM - fm) < WGM ? (nM - fm) : WGM;
        pm = __builtin_amdgcn_readfirstlane(fm + ((wgid % nig) % gsz)); pn = __builtin_amdgcn_readfirstlane((wgid % nig) / gsz); return true;
    }
};

template <bool FP8, int WSC, class Epi, class Sched>
__device__ __forceinline__ void gemm_phase_t(LAS unsigned char* lds, const Gemm g, const Sched& S, const Epi& E) {
    const int tid = opaque_tid(), wid = __builtin_amdgcn_readfirstlane(tid >> 6), lane = tid & 63, wr = wid >> 2, wc = wid & 3, fr = lane & 15, fq = lane >> 4;
    const int nt = g.KB / (BK * 2);
    unsigned voffA[2], voffB[2];
#pragma unroll
    for (int i = 0; i < 2; ++i) { int R, C; stage_rc(tid * 16 + i * 8192, R, C); const int Rb = (R & ~31) + perm32(R & 31);
        voffA[i] = (unsigned)(R * g.ldaB + C * 2); voffB[i] = (unsigned)(Rb * g.ldbB + C * 2); }
    const size_t kstep = (size_t)(BK * 2);
    const size_t hstepA = (size_t)HALF * g.ldaB, hstepB = (size_t)HALF * g.ldbB;
    const unsigned ldsw = (unsigned)wid * 1024u;
    const unsigned lds_u = __builtin_amdgcn_readfirstlane((unsigned)(uintptr_t)lds + ldsw);
    const int aoff = lds_byte(wr * 64 + fr, fq * 8), boff = lds_byte(wc * 32 + fr, fq * 8);
#define PG8_SA(b, h) (((b) * 2 + (h)) * HTB)
#define PG8_SB(b, h) ((4 + (b) * 2 + (h)) * HTB)
#define PG8_STAGE(bufoff, gbase, voff) do { _Pragma("unroll") for (int _i = 0; _i < 2; ++_i) \
        { unsigned _keep; asm volatile("s_mov_b32 %0, m0\n\ts_mov_b32 m0, %1\n\ts_nop 0\n\tglobal_load_lds_dwordx4 %2, %3\n\ts_mov_b32 m0, %0" : "=&s"(_keep) : "s"(lds_u + (unsigned)((bufoff) + _i * 8192)), "v"((voff)[_i]), "s"(gbase) : "memory"); } } while (0)
#define PG8_LD32(p) __builtin_shufflevector(*(const LAS v4i*)(p), *(const LAS v4i*)((p) + 1024), 0, 1, 2, 3, 4, 5, 6, 7)
#define PG8_LDA(dst, b, h) do { _Pragma("unroll") for (int m = 0; m < 4; ++m) dst[m] = PG8_LD32(lds + PG8_SA(b, h) + aoff + m * 2048); } while (0)
#define PG8_LDB(dst, b, h) do { _Pragma("unroll") for (int n = 0; n < 2; ++n) dst[n] = PG8_LD32(lds + PG8_SB(b, h) + boff + n * 2048); } while (0)
#define PG8_H0(x) __builtin_bit_cast(bf16x8, __builtin_shufflevector((x), (x), 0, 1, 2, 3))
#define PG8_H1(x) __builtin_bit_cast(bf16x8, __builtin_shufflevector((x), (x), 4, 5, 6, 7))
#define PG8_MMA(ai, bj, At, Bt) do { __builtin_amdgcn_s_setprio(1); _Pragma("unroll") for (int m = 0; m < 4; ++m) _Pragma("unroll") for (int n = 0; n < 2; ++n) { \
        if constexpr (FP8) asm volatile("v_mfma_scale_f32_16x16x128_f8f6f4 %0, %1, %2, %0, %3, %3 op_sel_hi:[0,0,0]" : "+v"(acc[ai][bj][m][n]) : "v"(Bt[n]), "v"(At[m]), "v"(wsc_v));     \
        else { acc[ai][bj][m][n] = __builtin_amdgcn_mfma_f32_16x16x32_bf16(PG8_H0(Bt[n]), PG8_H0(At[m]), acc[ai][bj][m][n], 0, 0, 0); acc[ai][bj][m][n] = __builtin_amdgcn_mfma_f32_16x16x32_bf16(PG8_H1(Bt[n]), PG8_H1(At[m]), acc[ai][bj][m][n], 0, 0, 0); } } \
        __builtin_amdgcn_s_setprio(0); } while (0)
#define PG8_WAIT_V(n) asm volatile("s_waitcnt vmcnt(" #n ")" ::: "memory")
#define PG8_WAIT_L(n) asm volatile("s_waitcnt lgkmcnt(" #n ")" ::: "memory")
#define PG8_BAR __builtin_amdgcn_s_barrier()
#define PG8_SCHED __builtin_amdgcn_sched_barrier(0)
    Unit cur, nxt; int ui = 0;
    if (!S.next(0, cur)) return;
    f32x4 acc[2][2][4][2];
#pragma unroll
    for (int a = 0; a < 2; ++a)
#pragma unroll
        for (int b = 0; b < 2; ++b)
#pragma unroll
            for (int m = 0; m < 4; ++m)
#pragma unroll
                for (int n = 0; n < 2; ++n) acc[a][b][m][n] = (f32x4){0.f, 0.f, 0.f, 0.f};
    v8i At[4], B0[2], B1[2]; const int wsc_v = WSC; (void)wsc_v;
    const char* cA = (const char*)g.A + uni64(cur.offA); const char* cB = (const char*)g.Bt + uni64(cur.offB);
    PG8_STAGE(PG8_SB(0, 0), cB, voffB); PG8_STAGE(PG8_SB(0, 1), cB + hstepB, voffB); PG8_STAGE(PG8_SA(0, 0), cA, voffA); PG8_STAGE(PG8_SA(0, 1), cA + hstepA, voffA);
    if (wr == 1) PG8_BAR;
    PG8_WAIT_V(2); PG8_BAR;
    PG8_STAGE(PG8_SB(1, 0), cB + kstep, voffB); PG8_STAGE(PG8_SA(1, 0), cA + kstep, voffA); PG8_STAGE(PG8_SB(1, 1), cB + hstepB + kstep, voffB);
    PG8_WAIT_V(6); PG8_BAR;
    for (;;) {
        const bool has_next = S.next(ui + 1, nxt);
        const char* nA = has_next ? (const char*)g.A + uni64(nxt.offA) : cA; const char* nB = has_next ? (const char*)g.Bt + uni64(nxt.offB) : cB;
        for (int t = 0; t < nt; t += 2) {
            const bool last = (t == nt - 2);
            const char* a1 = cA + (size_t)(t + 1) * kstep;
            const char* a2 = last ? nA : cA + (size_t)(t + 2) * kstep; const char* b2 = last ? nB : cB + (size_t)(t + 2) * kstep;
            const char* a3 = a2 + kstep; const char* b3 = b2 + kstep;
            PG8_LDB(B0, 0, 0); PG8_LDB(B1, 0, 1); PG8_SCHED; PG8_LDA(At, 0, 0); PG8_STAGE(PG8_SA(1, 1), a1 + hstepA, voffA);
            PG8_WAIT_V(8); PG8_WAIT_L(0); PG8_BAR; PG8_MMA(0, 0, At, B0); PG8_MMA(0, 1, At, B1); PG8_BAR; PG8_SCHED;
            PG8_LDA(At, 0, 1); PG8_STAGE(PG8_SB(0, 0), b2, voffB); PG8_STAGE(PG8_SB(0, 1), b2 + hstepB, voffB); PG8_STAGE(PG8_SA(0, 0), a2, voffA);
            PG8_WAIT_V(8); PG8_WAIT_L(0); PG8_BAR; PG8_MMA(1, 0, At, B0); PG8_MMA(1, 1, At, B1); PG8_BAR; PG8_SCHED;
            PG8_LDB(B0, 1, 0); PG8_LDB(B1, 1, 1); PG8_SCHED; PG8_LDA(At, 1, 0); PG8_STAGE(PG8_SA(0, 1), a2 + hstepA, voffA);
            PG8_WAIT_V(8); PG8_WAIT_L(0); PG8_BAR; PG8_MMA(0, 0, At, B0); PG8_MMA(0, 1, At, B1); PG8_BAR; PG8_SCHED;
            PG8_LDA(At, 1, 1); PG8_STAGE(PG8_SB(1, 0), b3, voffB); PG8_STAGE(PG8_SB(1, 1), b3 + hstepB, voffB); PG8_STAGE(PG8_SA(1, 0), a3, voffA);
            PG8_WAIT_V(8); PG8_WAIT_L(0); PG8_BAR; PG8_MMA(1, 0, At, B0); PG8_MMA(1, 1, At, B1); PG8_BAR; PG8_SCHED;
        }
        if (wr == 0) PG8_BAR;
        if constexpr (FP8) asm volatile("s_nop 15\n\ts_nop 15" ::: "memory");
        E(acc, cur, wr, wc, fr, fq);
        if (!has_next) break;
#pragma unroll
        for (int a = 0; a < 2; ++a)
#pragma unroll
            for (int b = 0; b < 2; ++b)
#pragma unroll
                for (int m = 0; m < 4; ++m)
#pragma unroll
                    for (int n = 0; n < 2; ++n) acc[a][b][m][n] = (f32x4){0.f, 0.f, 0.f, 0.f};
        cur = nxt; cA = nA; cB = nB; ++ui;
        if (wr == 1) PG8_BAR;
    }
    PG8_WAIT_V(0);
    PG8_BAR;
#undef PG8_SA
#undef PG8_SB
#undef PG8_STAGE
#undef PG8_LDA
#undef PG8_LDB
#undef PG8_MMA
#undef PG8_H0
#undef PG8_H1
#undef PG8_LD32
#undef PG8_WAIT_V
#undef PG8_WAIT_L
#undef PG8_BAR
#undef PG8_SCHED
}
template <class Epi, class Sched> __device__ __forceinline__ void gemm_phase(LAS unsigned char* lds, const Gemm g, const Sched& S, const Epi& E) { gemm_phase_t<false, 0>(lds, g, S, E); }
}

struct SchedPlain {
    pg8::TileOrder T; int G, c; size_t tA, tB;
    __device__ __forceinline__ void init(int nM, int nN, int lda, int ldb, int G_, int c_) { T.init(nM, nN); G = G_; c = c_; tA = (size_t)256 * lda * 2; tB = (size_t)256 * ldb * 2; }
    __device__ __forceinline__ bool next(int i, pg8::Unit& u) const { if (!T.map((long)i * G + c, u.pm, u.pn)) return false; u.z = 0; u.offA = u.pm * tA; u.offB = u.pn * tB; return true; }
};
struct SchedBatch {
    int nM, nN, nZ, G, c; size_t tA, tB, zA, zB;
    __device__ __forceinline__ bool next(int i, pg8::Unit& u) const {
        const long L = (long)i * G + c; const int per = nM * nN; if (L >= (long)per * nZ) return false;
        const int z = __builtin_amdgcn_readfirstlane((int)(L / per)), r = __builtin_amdgcn_readfirstlane((int)(L % per)); u.z = z; u.pm = __builtin_amdgcn_readfirstlane(r / nN); u.pn = __builtin_amdgcn_readfirstlane(r % nN); u.offA = z * zA + u.pm * tA; u.offB = z * zB + u.pn * tB; return true; }
};
struct SchedBranch {
    pg8::TileOrder T; int G, c; size_t tA, tB, zA, zB;
    __device__ __forceinline__ bool next(int i, pg8::Unit& u) const { const int t = i / 3, z = i - 3 * t; if (!T.map((long)t * G + c, u.pm, u.pn)) return false; u.z = z; u.offA = z * zA + u.pm * tA; u.offB = z * zB + u.pn * tB; return true; }
};
struct SchedMoe {
    pg8::TileOrder T; int G, c; size_t tA, tB, zB; int off[7];
    __device__ __forceinline__ bool next(int i, pg8::Unit& u) const {
        if (!T.map((long)i * G + c, u.pm, u.pn)) return false; const int r0 = u.pm * 256; int e = 0;
#pragma unroll
        for (int k = 0; k < 7; ++k) e += (r0 >= off[k]) ? 1 : 0;
        e = __builtin_amdgcn_readfirstlane(e); u.z = e; u.offA = u.pm * tA; u.offB = e * zB + u.pn * tB; return true; }
};

#define EPI_ARGS const f32x4 (&acc)[2][2][4][2], const pg8::Unit& u, int wr, int wc, int fr, int fq
#define EPI_ROW(ai, m) (u.pm * 256 + (ai) * 128 + wr * 64 + (m) * 16 + fr)
#define EPI_CB(bj) ((bj) * 128 + wc * 32 + fq * 8)
#define FOR_AI_M _Pragma("unroll") for (int ai = 0; ai < 2; ++ai) _Pragma("unroll") for (int m = 0; m < 4; ++m)
#define FOR_BJ _Pragma("unroll") for (int bj = 0; bj < 2; ++bj)

__device__ __forceinline__ void rope4(f32x4& v0, f32x4& v1, const f32x4 t0, const f32x4 t1) {
    const float a0 = v0[0] * t0[0] - v0[1] * t0[1], b0 = v0[1] * t0[0] + v0[0] * t0[1];
    const float a1 = v0[2] * t0[2] - v0[3] * t0[3], b1 = v0[3] * t0[2] + v0[2] * t0[3];
    const float a2 = v1[0] * t1[0] - v1[1] * t1[1], b2 = v1[1] * t1[0] + v1[0] * t1[1];
    const float a3 = v1[2] * t1[2] - v1[3] * t1[3], b3 = v1[3] * t1[2] + v1[2] * t1[3];
    v0 = (f32x4){a0, b0, a1, b1}; v1 = (f32x4){a2, b2, a3, b3};
}

struct EpiInProj {
    bf16_t *QD, *KD, *VD, *MQ, *MKV, *KM, *SU, *GATES; float *ssq_q, *ssq_kv; const float* tabd; const float* tabm;
    int pn_add;
    __device__ __forceinline__ void operator()(EPI_ARGS) const {
        const int pn = u.pn + pn_add;
        if (pn < 8) {
            bf16_t* O = pn < 4 ? QD : KD; const float sc = pn < 4 ? C2_DIFF : 1.f; const int colt = (pn & 3) * 256;
            const bool rp = ((wc & 1) == 0) && fq < 2;
#pragma unroll
            for (int ai = 0; ai < 2; ++ai) { f32x4 tt[4][2];
#pragma unroll
                for (int m = 0; m < 4; ++m) { tt[m][0] = (f32x4){1.f, 0.f, 1.f, 0.f}; tt[m][1] = (f32x4){1.f, 0.f, 1.f, 0.f};
                    if (rp) { const f32x4* tp = (const f32x4*)(tabd + (size_t)EPI_ROW(ai, m) * 16 + fq * 8); tt[m][0] = tp[0]; tt[m][1] = tp[1]; } }
#pragma unroll
                for (int m = 0; m < 4; ++m) { const int row = EPI_ROW(ai, m);
                    FOR_BJ { f32x4 v0 = acc[ai][bj][m][0], v1 = acc[ai][bj][m][1]; rope4(v0, v1, tt[m][0], tt[m][1]); v0 = v0 * sc; v1 = v1 * sc;
                        *(u32x4*)(O + (size_t)row * 1024 + colt + EPI_CB(bj)) = pack8(v0, v1); } } }
        } else if (pn < 12) {
            const int colt = (pn - 8) * 256;
            FOR_AI_M { const int row = EPI_ROW(ai, m); FOR_BJ { *(u32x4*)(VD + (size_t)row * 1024 + colt + EPI_CB(bj)) = pack8(acc[ai][bj][m][0], acc[ai][bj][m][1]); } }
        } else if (pn < 15) {
            bf16_t* O = pn < 14 ? MQ : MKV; const int ld = pn < 14 ? 512 : 256, colt = pn < 14 ? (pn - 12) * 256 : 0; float* ssq = pn < 14 ? ssq_q + (pn - 12) * 4 + wc : ssq_kv + wc; const int ns = pn < 14 ? 8 : 4;
            FOR_AI_M { const int row = EPI_ROW(ai, m); float s = 0.f;
                FOR_BJ { const f32x4 v0 = acc[ai][bj][m][0], v1 = acc[ai][bj][m][1]; s += (v0[0] * v0[0] + v0[1] * v0[1]) + (v0[2] * v0[2] + v0[3] * v0[3]) + (v1[0] * v1[0] + v1[1] * v1[1]) + (v1[2] * v1[2] + v1[3] * v1[3]);
                    *(u32x4*)(O + (size_t)row * ld + colt + EPI_CB(bj)) = pack8(v0, v1); }
                s += shflx(s, 16, fq * 16 + fr); s += shflx(s, 32, fq * 16 + fr);
                if (fq == 0) ssq[(size_t)row * ns] = s; }
        } else if (pn == 15) {
            if (wc < 2) {
                FOR_AI_M { const int row = EPI_ROW(ai, m); const f32x4* tp = (const f32x4*)(tabm + (size_t)row * 64 + (wc * 16 + fq * 4) * 2);
                    f32x4 v0 = acc[ai][0][m][0], v1 = acc[ai][0][m][1]; rope4(v0, v1, tp[0], tp[1]); const u32x4 w = pack8(v0, v1);
#pragma unroll
                    for (int h = 0; h < 8; ++h) *(u32x4*)(KM + (size_t)row * 1536 + h * 192 + 128 + wc * 32 + fq * 8) = w; }
            }
        } else if (pn < 20) {
            FOR_AI_M { const int row = EPI_ROW(ai, m); const int c = row >> 5, j = row & 31;
                FOR_BJ { const int ch = (pn - 16) * 256 + EPI_CB(bj), g = ch >> 4, q = ch & 15;
                    *(u32x4*)(SU + ((size_t)(g * SSM_NCH + c) * SSM_KX + j * 16 + q)) = pack8(acc[ai][bj][m][0], acc[ai][bj][m][1]); } }
        } else {
            const int colt = (pn - 20) * 256;
            FOR_AI_M { const int row = EPI_ROW(ai, m);
                FOR_BJ { f32x4 v0 = acc[ai][bj][m][0], v1 = acc[ai][bj][m][1];
#pragma unroll
                    for (int e = 0; e < 4; ++e) { v0[e] = fast_sigmoid(v0[e]); v1[e] = fast_sigmoid(v1[e]); }
                    *(u32x4*)(GATES + (size_t)row * 6144 + colt + EPI_CB(bj)) = pack8(v0, v1); } }
        }
    }
};
struct EpiQup {
    bf16_t* QM; const float* ssq; const float* tabm;
    __device__ __forceinline__ void operator()(EPI_ARGS) const {
#pragma unroll
        for (int ai = 0; ai < 2; ++ai) { f32x4 sq[4][2];
#pragma unroll
            for (int m = 0; m < 4; ++m) { const int row = EPI_ROW(ai, m); sq[m][0] = *(const f32x4*)(ssq + (size_t)row * 8); sq[m][1] = *(const f32x4*)(ssq + (size_t)row * 8 + 4); }
#pragma unroll
            for (int m = 0; m < 4; ++m) { const int row = EPI_ROW(ai, m); const f32x4 s0 = sq[m][0], s1 = sq[m][1];
                const float rq = __builtin_amdgcn_rsqf((((s0[0] + s0[1]) + (s0[2] + s0[3])) + ((s1[0] + s1[1]) + (s1[2] + s1[3]))) * (1.f / 512.f) + RMS_EPS) * C2_MLA;
                FOR_BJ { const int col = u.pn * 256 + EPI_CB(bj), h = col / 192, hc = col - h * 192; f32x4 v0 = acc[ai][bj][m][0], v1 = acc[ai][bj][m][1];
                    if (hc >= 128) { const f32x4* tp = (const f32x4*)(tabm + (size_t)row * 64 + (hc - 128)); rope4(v0, v1, tp[0], tp[1]); }
                    v0 = v0 * rq; v1 = v1 * rq; *(u32x4*)(QM + (size_t)row * 1536 + col) = pack8(v0, v1); } } }
    }
};
struct EpiKVup {
    bf16_t *KM, *VM; const float* ssq;
    __device__ __forceinline__ void operator()(EPI_ARGS) const {
#pragma unroll
        for (int ai = 0; ai < 2; ++ai) { float rk[4];
#pragma unroll
            for (int m = 0; m < 4; ++m) { const f32x4 s0 = *(const f32x4*)(ssq + (size_t)EPI_ROW(ai, m) * 4); rk[m] = ((s0[0] + s0[1]) + (s0[2] + s0[3])); }
#pragma unroll
            for (int m = 0; m < 4; ++m) { const int row = EPI_ROW(ai, m); const float r = __builtin_amdgcn_rsqf(rk[m] * (1.f / 256.f) + RMS_EPS); const int c = wc * 32 + fq * 8;
                *(u32x4*)(KM + (size_t)row * 1536 + u.pn * 192 + c) = pack8(acc[ai][0][m][0] * r, acc[ai][0][m][1] * r);
                *(u32x4*)(VM + (size_t)row * 1024 + u.pn * 128 + c) = pack8(acc[ai][1][m][0] * r, acc[ai][1][m][1] * r); } }
    }
};
struct EpiSloc {
    float* SLOC;
    __device__ __forceinline__ void operator()(EPI_ARGS) const {
        FOR_AI_M { const int c = EPI_ROW(ai, m); float* o = SLOC + ((size_t)(u.z * SSM_NCH + c) * 128 + wc * 32 + fq * 8);
            *(f32x4*)o = acc[ai][0][m][0]; *(f32x4*)(o + 4) = acc[ai][0][m][1]; }
    }
};
__device__ __forceinline__ float gelu_tanh(float x) { const float t = 1.5957691216057308f * (x + 0.044715f * x * x * x); return x * fast_sigmoid(t); }
struct EpiSsmY {
    bf16_t* YG; const bf16_t* SU; const float* dskip;
    __device__ __forceinline__ void operator()(EPI_ARGS) const {
        const int g = u.z; f32x4 d0[2], d1[2];
        FOR_BJ { const int col = u.pn * 256 + EPI_CB(bj), ch = g * 16 + (col & 15); d0[bj] = *(const f32x4*)(dskip + ch); d1[bj] = *(const f32x4*)(dskip + ch + 4); }
#pragma unroll
        for (int ai = 0; ai < 2; ++ai) { u32x4 uu[4][2];
#pragma unroll
            for (int m = 0; m < 4; ++m) { const int c = EPI_ROW(ai, m);
                FOR_BJ { const int col = u.pn * 256 + EPI_CB(bj), i = col >> 4, p0 = col & 15; uu[m][bj] = *(const u32x4*)(SU + ((size_t)(g * SSM_NCH + c) * SSM_KX + i * 16 + p0)); } }
#pragma unroll
            for (int m = 0; m < 4; ++m) { const int c = EPI_ROW(ai, m);
                FOR_BJ { const int col = u.pn * 256 + EPI_CB(bj), i = col >> 4, p0 = col & 15, t = c * SSM_L + i, ch = g * 16 + p0; const u32x4 w = uu[m][bj];
                    f32x4 v0 = acc[ai][bj][m][0], v1 = acc[ai][bj][m][1];
                    v0[0] += d0[bj][0] * bf_lo(w.x); v0[1] += d0[bj][1] * bf_hi(w.x); v0[2] += d0[bj][2] * bf_lo(w.y); v0[3] += d0[bj][3] * bf_hi(w.y);
                    v1[0] += d1[bj][0] * bf_lo(w.z); v1[1] += d1[bj][1] * bf_hi(w.z); v1[2] += d1[bj][2] * bf_lo(w.w); v1[3] += d1[bj][3] * bf_hi(w.w);
#pragma unroll
                    for (int e = 0; e < 4; ++e) { v0[e] = gelu_tanh(v0[e]); v1[e] = gelu_tanh(v1[e]); }
                    *(u32x4*)(YG + (size_t)t * 1024 + ch) = pack8(v0, v1); } } }
    }
};
template <int ACT  > struct EpiGated {
    bf16_t* O; int ldo;
    __device__ __forceinline__ void operator()(EPI_ARGS) const {
        FOR_AI_M { const int row = EPI_ROW(ai, m); f32x4 r[2];
#pragma unroll
            for (int n = 0; n < 2; ++n)
#pragma unroll
                for (int e = 0; e < 4; ++e) { const float a = acc[ai][0][m][n][e], b = acc[ai][1][m][n][e]; r[n][e] = ACT == 0 ? a * fast_sigmoid(b) : a * fast_sigmoid(a) * b; }
            *(u32x4*)(O + (size_t)row * ldo + u.pn * 128 + wc * 32 + fq * 8) = pack8(r[0], r[1]); }
    }
};
struct EpiSwigluF8 {
    unsigned char* O; int ldo;
    __device__ __forceinline__ void operator()(EPI_ARGS) const {
        FOR_AI_M { const int row = EPI_ROW(ai, m); f32x4 r[2];
#pragma unroll
            for (int n = 0; n < 2; ++n)
#pragma unroll
                for (int e = 0; e < 4; ++e) { const float a = acc[ai][0][m][n][e], b = acc[ai][1][m][n][e]; r[n][e] = a * fast_sigmoid(a) * b; }
            *(u32x2*)(O + (size_t)row * ldo + u.pn * 128 + wc * 32 + fq * 8) = pack8_fp8(r[0], r[1]); }
    }
};
struct EpiGatesF8 {
    bf16_t* GATES;
    __device__ __forceinline__ void operator()(EPI_ARGS) const {
        FOR_AI_M { const int row = EPI_ROW(ai, m);
            FOR_BJ { f32x4 v0 = acc[ai][bj][m][0], v1 = acc[ai][bj][m][1];
#pragma unroll
                for (int e = 0; e < 4; ++e) { v0[e] = fast_sigmoid(v0[e]); v1[e] = fast_sigmoid(v1[e]); }
                *(u32x4*)(GATES + (size_t)row * 6144 + u.pn * 256 + EPI_CB(bj)) = pack8(v0, v1); } }
    }
};
struct EpiBranch {
    const bf16_t* GATES; bf16_t* P; bf16_t* MG;
    __device__ __forceinline__ void operator()(EPI_ARGS) const {
        const int z = u.z;
#pragma unroll
        for (int ai = 0; ai < 2; ++ai)
#pragma unroll
            for (int mh = 0; mh < 2; ++mh) { u32x4 gg[2][2], pa[2][2], pb[2][2];
#pragma unroll
                for (int mm = 0; mm < 2; ++mm) { const int row = EPI_ROW(ai, mh * 2 + mm);
                    FOR_BJ { const int col = u.pn * 256 + EPI_CB(bj); gg[mm][bj] = *(const u32x4*)(GATES + (size_t)row * 6144 + z * 2048 + col);
                        if (z == 2) { const size_t o = (size_t)row * 2048 + col; pa[mm][bj] = *(const u32x4*)(P + o); pb[mm][bj] = *(const u32x4*)(P + (size_t)M * 2048 + o); } } }
#pragma unroll
                for (int mm = 0; mm < 2; ++mm) { const int m = mh * 2 + mm, row = EPI_ROW(ai, m);
                    FOR_BJ { const int col = u.pn * 256 + EPI_CB(bj); const u32x4 g = gg[mm][bj];
                        f32x4 v0 = acc[ai][bj][m][0], v1 = acc[ai][bj][m][1];
                        v0[0] *= bf_lo(g.x); v0[1] *= bf_hi(g.x); v0[2] *= bf_lo(g.y); v0[3] *= bf_hi(g.y);
                        v1[0] *= bf_lo(g.z); v1[1] *= bf_hi(g.z); v1[2] *= bf_lo(g.w); v1[3] *= bf_hi(g.w);
                        const size_t o = (size_t)row * 2048 + col;
                        if (z < 2) *(u32x4*)(P + (size_t)z * M * 2048 + o) = pack8(v0, v1);
                        else { const u32x4 a = pa[mm][bj], b = pb[mm][bj];
                            v0[0] += bf_lo(a.x) + bf_lo(b.x); v0[1] += bf_hi(a.x) + bf_hi(b.x); v0[2] += bf_lo(a.y) + bf_lo(b.y); v0[3] += bf_hi(a.y) + bf_hi(b.y);
                            v1[0] += bf_lo(a.z) + bf_lo(b.z); v1[1] += bf_hi(a.z) + bf_hi(b.z); v1[2] += bf_lo(a.w) + bf_lo(b.w); v1[3] += bf_hi(a.w) + bf_hi(b.w);
                            *(u32x4*)(MG + o) = pack8(v0, v1); } } } }
    }
};
struct EpiResid {
    bf16_t* X;
    __device__ __forceinline__ void operator()(EPI_ARGS) const {
#pragma unroll
        for (int ai = 0; ai < 2; ++ai) { u32x4 r[4][2];
#pragma unroll
            for (int m = 0; m < 4; ++m) { const int row = EPI_ROW(ai, m);
                FOR_BJ { r[m][bj] = *(const u32x4*)(X + (size_t)row * 2048 + u.pn * 256 + EPI_CB(bj)); } }
#pragma unroll
            for (int m = 0; m < 4; ++m) { const int row = EPI_ROW(ai, m);
                FOR_BJ { const u32x4 w = r[m][bj]; f32x4 v0 = acc[ai][bj][m][0], v1 = acc[ai][bj][m][1];
                    v0[0] += ALPHA * bf_lo(w.x); v0[1] += ALPHA * bf_hi(w.x); v0[2] += ALPHA * bf_lo(w.y); v0[3] += ALPHA * bf_hi(w.y);
                    v1[0] += ALPHA * bf_lo(w.z); v1[1] += ALPHA * bf_hi(w.z); v1[2] += ALPHA * bf_lo(w.w); v1[3] += ALPHA * bf_hi(w.w);
                    *(u32x4*)(X + (size_t)row * 2048 + u.pn * 256 + EPI_CB(bj)) = pack8(v0, v1); } } }
    }
};
struct EpiBf16 {
    bf16_t* O; int ldo; float scale;
    __device__ __forceinline__ void operator()(EPI_ARGS) const {
        FOR_AI_M { const int row = EPI_ROW(ai, m); FOR_BJ { *(u32x4*)(O + (size_t)row * ldo + u.pn * 256 + EPI_CB(bj)) = pack8(acc[ai][bj][m][0] * scale, acc[ai][bj][m][1] * scale); } }
    }
};
struct EpiBf16Half {
    bf16_t* O; int ldo; float scale;
    __device__ __forceinline__ void operator()(EPI_ARGS) const {
#pragma unroll
        for (int m = 0; m < 4; ++m) { const int row = u.pm * 128 + wr * 64 + m * 16 + fr;
            FOR_BJ { *(u32x4*)(O + (size_t)row * ldo + u.pn * 256 + EPI_CB(bj)) = pack8(acc[0][bj][m][0] * scale, acc[0][bj][m][1] * scale); } }
    }
};
struct EpiMoeDown {
    bf16_t* OG; const float* wslot;
    __device__ __forceinline__ void operator()(EPI_ARGS) const {
        float w[2][4];
        FOR_AI_M w[ai][m] = wslot[EPI_ROW(ai, m)];
        FOR_AI_M { const int row = EPI_ROW(ai, m);
            FOR_BJ { *(u32x4*)(OG + (size_t)row * 2048 + u.pn * 256 + EPI_CB(bj)) = pack8(acc[ai][bj][m][0] * w[ai][m], acc[ai][bj][m][1] * w[ai][m]); } }
    }
};

namespace att {
constexpr int KVBLK = 64, SHM_V = KVBLK * 128 * 2;
constexpr float THRL = 8.f;
__device__ __forceinline__ int crow(int r, int hi) { return (r & 3) + 8 * (r >> 2) + 4 * hi; }
template <int PITCH> __device__ __forceinline__ int kfl(int row) { return (PITCH % 256 == 128) ? ((row >> 1) & 7) : (row & 15); }
template <int PITCH> __device__ __forceinline__ int kswz(int row, int colB) { return row * PITCH + (colB ^ (kfl<PITCH>(row) << 4)); }
__device__ __forceinline__ int v_st(int k, int c) { const int kk = k; return ((kk >> 3) * 4 + (c >> 5)) * 512 + ((kk & 7) * 32 + (c & 31)) * 2; }
__device__ __forceinline__ int v_rd_base(int lane) { return ((lane & 3) << 3) | (((lane >> 2) & 3) << 6) | (((lane >> 4) & 1) << 5) | (((lane >> 5) & 1) << 8); }
constexpr int v_rd_off(int d0, int ks, int half) { return d0 * 512 + ks * 4096 + half * 2048; }

__device__ __forceinline__ void mask_tile(f32x16& p0, f32x16& p1, int dq) {
    const float NEG = -__builtin_inff();
#pragma unroll
    for (int r = 0; r < 16; ++r) { const int c = (r & 3) + 8 * (r >> 2); if (dq - c < 0) p0[r] = NEG; if (dq - c - 32 < 0) p1[r] = NEG; }
}
__device__ __forceinline__ void partialSM(f32x16& p0, f32x16& p1, float& m_reg, float& alpha) {
    float pmax = p0[0];
#pragma unroll
    for (int r = 1; r < 16; ++r) pmax = fmaxf(pmax, p0[r]);
#pragma unroll
    for (int r = 0; r < 16; ++r) pmax = fmaxf(pmax, p1[r]);
    { auto rr = __builtin_amdgcn_permlane32_swap(__float_as_uint(pmax), __float_as_uint(pmax), false, false); pmax = fmaxf(__uint_as_float(rr[0]), __uint_as_float(rr[1])); }
    float mn;
    if (__builtin_expect(__all(pmax - m_reg <= THRL), 1)) { mn = m_reg; alpha = 1.f; }
    else { mn = fmaxf(m_reg, pmax); alpha = __builtin_amdgcn_exp2f(m_reg - mn); m_reg = mn; }
#pragma unroll
    for (int r = 0; r < 16; ++r) { p0[r] -= mn; p1[r] -= mn; }
#pragma unroll
    for (int r = 0; r < 16; ++r) p0[r] = __builtin_amdgcn_exp2f(p0[r]);
}
__device__ __forceinline__ void finishSM(f32x16& p0, f32x16& p1, float alpha, float& l_reg, bf16x8& pa0, bf16x8& pa1, bf16x8& pa2, bf16x8& pa3) {
#pragma unroll
    for (int r = 0; r < 16; ++r) p1[r] = __builtin_amdgcn_exp2f(p1[r]);
    float ps = 0;
#pragma unroll
    for (int r = 0; r < 16; ++r) ps += p0[r];
#pragma unroll
    for (int r = 0; r < 16; ++r) ps += p1[r];
    { auto rr = __builtin_amdgcn_permlane32_swap(__float_as_uint(ps), __float_as_uint(ps), false, false); ps = __uint_as_float(rr[0]) + __uint_as_float(rr[1]); }
    l_reg = l_reg * alpha + ps;
#define PK4(P, B_, OUT) do { unsigned a0 = cvt_pk_bf16(P[B_+0], P[B_+1]), a1 = cvt_pk_bf16(P[B_+2], P[B_+3]); unsigned b0 = cvt_pk_bf16(P[B_+4], P[B_+5]), b1 = cvt_pk_bf16(P[B_+6], P[B_+7]); \
        u32x4 w = {a0, a1, b0, b1}; OUT = *reinterpret_cast<bf16x8*>(&w); } while (0)
    PK4(p0, 0, pa0); PK4(p0, 8, pa1); PK4(p1, 0, pa2); PK4(p1, 8, pa3);
#undef PK4
}
template <int PITCH, int ND0>
__device__ __forceinline__ void qkt(f32x16& p0, f32x16& p1, const char* Kb, int r32, int hi, int kch0, const bf16x8* qr) {
    p0 = f32x16{}; p1 = f32x16{};
    const char* kb[4];
#pragma unroll
    for (int dd = 0; dd < 4; ++dd) kb[dd] = Kb + kswz<PITCH>(r32, (kch0 + dd * 2 + hi) * 16);
#pragma unroll
    for (int d0 = 0; d0 < ND0; ++d0) { const char* a = (PITCH % 256 == 0) ? Kb + kswz<PITCH>(r32, (kch0 + d0 * 2 + hi) * 16) : kb[d0 & 3] + (d0 >> 2) * 128;
        const bf16x8 b0 = *reinterpret_cast<const bf16x8*>(a);
        const bf16x8 b1 = *reinterpret_cast<const bf16x8*>(a + 32 * PITCH);
        p0 = __builtin_amdgcn_mfma_f32_32x32x16_bf16(b0, qr[d0], p0, 0, 0, 0);
        p1 = __builtin_amdgcn_mfma_f32_32x32x16_bf16(b1, qr[d0], p1, 0, 0, 0); }
}
__device__ __forceinline__ void pv_tile(f32x16* o, int vb0, bf16x8 pa0, bf16x8 pa1, bf16x8 pa2, bf16x8 pa3) {
    s16x4 va[8], vb[8];
#define TRRD(dst, off) asm volatile("ds_read_b64_tr_b16 %0, %1 offset:%2" : "=&v"(dst) : "v"(vb0), "i"(off) : "memory")
#define PV_RD(v, d0) do { constexpr int b_ = v_rd_off(d0, 0, 0); TRRD(v[0], b_); TRRD(v[1], b_ + 2048); TRRD(v[2], b_ + 4096); TRRD(v[3], b_ + 6144); TRRD(v[4], b_ + 8192); TRRD(v[5], b_ + 10240); TRRD(v[6], b_ + 12288); TRRD(v[7], b_ + 14336); } while (0)
#define PV_MM(v, d0) do { \
        o[d0] = __builtin_amdgcn_mfma_f32_32x32x16_bf16(pa0, (bf16x8){v[0][0], v[0][1], v[0][2], v[0][3], v[1][0], v[1][1], v[1][2], v[1][3]}, o[d0], 0, 0, 0); \
        o[d0] = __builtin_amdgcn_mfma_f32_32x32x16_bf16(pa1, (bf16x8){v[2][0], v[2][1], v[2][2], v[2][3], v[3][0], v[3][1], v[3][2], v[3][3]}, o[d0], 0, 0, 0); \
        o[d0] = __builtin_amdgcn_mfma_f32_32x32x16_bf16(pa2, (bf16x8){v[4][0], v[4][1], v[4][2], v[4][3], v[5][0], v[5][1], v[5][2], v[5][3]}, o[d0], 0, 0, 0); \
        o[d0] = __builtin_amdgcn_mfma_f32_32x32x16_bf16(pa3, (bf16x8){v[6][0], v[6][1], v[6][2], v[6][3], v[7][0], v[7][1], v[7][2], v[7][3]}, o[d0], 0, 0, 0); } while (0)
#define PV_W8(v) asm volatile("s_waitcnt lgkmcnt(8)" : "+v"(v[0]), "+v"(v[1]), "+v"(v[2]), "+v"(v[3]), "+v"(v[4]), "+v"(v[5]), "+v"(v[6]), "+v"(v[7]) :: "memory")
#define PV_W0(v) asm volatile("s_waitcnt lgkmcnt(0)" : "+v"(v[0]), "+v"(v[1]), "+v"(v[2]), "+v"(v[3]), "+v"(v[4]), "+v"(v[5]), "+v"(v[6]), "+v"(v[7]) :: "memory")
    PV_RD(va, 0); PV_RD(vb, 1); PV_W8(va); SBAR(); PV_MM(va, 0);
    PV_RD(va, 2); PV_W8(vb); SBAR(); PV_MM(vb, 1);
    PV_RD(vb, 3); PV_W8(va); SBAR(); PV_MM(va, 2);
    PV_W0(vb); SBAR(); PV_MM(vb, 3);
#undef PV_W0
#undef PV_W8
#undef PV_MM
#undef PV_RD
#undef TRRD
}

template <int KT, int ND0, bool CAUSAL, bool PIPE>
__device__ __forceinline__ void attn_core(const bf16_t* Qlane, const bf16_t* __restrict__ Kh, int ldk, const bf16_t* __restrict__ Vh, int ldv, int NT, int qpos, int qlo, int kch0,
                                          char* lds, f32x16 (&o)[4], float& l_reg) {
    constexpr int PITCH = KT * 2, SHM_K = KVBLK * PITCH, NKL = KT / 64, CPR = KT / 8;
    const int tid = opaque_tid(), wid = __builtin_amdgcn_readfirstlane(tid >> 6), lane = tid & 63, r32 = lane & 31, hi = lane >> 5;
    char* V_lds = lds; char* K_lds = lds + 2 * SHM_V;
    float* ws = (float*)(lds + 2 * SHM_V + 2 * SHM_K) + wid * 64; float* al_l = ws + 32;
    float m_reg = -1e30f; l_reg = 0.f;
#pragma unroll
    for (int d = 0; d < 4; ++d) o[d] = f32x16{};
    bf16x8 qr[ND0];
#pragma unroll
    for (int d0 = 0; d0 < ND0; ++d0) qr[d0] = *reinterpret_cast<const bf16x8*>(Qlane + d0 * 16);
    const int sr = tid >> 4, sc = (tid & 15) * 8, vst0 = v_st(sr, sc), vst1 = v_st(32 + sr, sc);
    const int vb0 = (int)(uintptr_t)V_lds + v_rd_base(lane);
    int krow[NKL], kcc[NKL];
#pragma unroll
    for (int i = 0; i < NKL; ++i) { const int cid = tid + 512 * i; krow[i] = cid / CPR; kcc[i] = cid - krow[i] * CPR; }
    bf16x8 st_v0, st_v1, st_k[NKL];
#define SLOAD(k0) do { st_v0 = *reinterpret_cast<const bf16x8*>(Vh + (size_t)((k0) + sr) * ldv + sc); st_v1 = *reinterpret_cast<const bf16x8*>(Vh + (size_t)((k0) + 32 + sr) * ldv + sc); \
        _Pragma("unroll") for (int i_ = 0; i_ < NKL; ++i_) st_k[i_] = *reinterpret_cast<const bf16x8*>(Kh + (size_t)((k0) + krow[i_]) * ldk + kcc[i_] * 8); } while (0)
#define SWRITE(b) do { *(bf16x8*)(V_lds + (b) * SHM_V + vst0) = st_v0; *(bf16x8*)(V_lds + (b) * SHM_V + vst1) = st_v1; \
        _Pragma("unroll") for (int i_ = 0; i_ < NKL; ++i_) *(bf16x8*)(K_lds + (b) * SHM_K + kswz<PITCH>(krow[i_], kcc[i_] * 16)) = st_k[i_]; } while (0)
#define RESC(a) do { if (__any((a) < 1.f)) { if (hi == 0) al_l[r32] = (a); asm volatile("s_waitcnt lgkmcnt(0)" ::: "memory"); \
        _Pragma("unroll") for (int d_ = 0; d_ < 4; ++d_) _Pragma("unroll") for (int r = 0; r < 16; ++r) o[d_][r] *= al_l[crow(r, hi)]; } } while (0)
#define MASKT(P0_, P1_, t) do { if (CAUSAL) { const int kb_ = (t) * KVBLK; if (kb_ + KVBLK - 1 > qlo) mask_tile(P0_, P1_, qpos - kb_ - 4 * hi); } } while (0)
    if constexpr (PIPE) {
    f32x16 pA0, pA1, pB0, pB1; float alA, alB; bf16x8 pa0, pa1, pa2, pa3;
    SLOAD(0); VM_WAIT(); SWRITE(0); __syncthreads();
    qkt<PITCH, ND0>(pA0, pA1, K_lds, r32, hi, kch0, qr); MASKT(pA0, pA1, 0); partialSM(pA0, pA1, m_reg, alA);
    SLOAD(KVBLK); VM_WAIT(); SWRITE(1); __syncthreads();
    for (int j = 1; j + 1 < NT; j += 2) {
        SBAR(); qkt<PITCH, ND0>(pB0, pB1, K_lds + SHM_K, r32, hi, kch0, qr);
        finishSM(pA0, pA1, alA, l_reg, pa0, pa1, pa2, pa3); SBAR();
        SLOAD((j + 1) * KVBLK); SBAR();
        pv_tile(o, vb0, pa0, pa1, pa2, pa3); MASKT(pB0, pB1, j); partialSM(pB0, pB1, m_reg, alB);
        __syncthreads(); VM_WAIT(); SWRITE(0);
        RESC(alB); __syncthreads();
        SBAR(); qkt<PITCH, ND0>(pA0, pA1, K_lds, r32, hi, kch0, qr);
        finishSM(pB0, pB1, alB, l_reg, pa0, pa1, pa2, pa3); SBAR();
        SLOAD((j + 2) * KVBLK); SBAR();
        pv_tile(o, vb0 + SHM_V, pa0, pa1, pa2, pa3); MASKT(pA0, pA1, j + 1); partialSM(pA0, pA1, m_reg, alA);
        __syncthreads(); VM_WAIT(); SWRITE(1);
        RESC(alA); __syncthreads();
    }
    SBAR(); qkt<PITCH, ND0>(pB0, pB1, K_lds + SHM_K, r32, hi, kch0, qr);
    finishSM(pA0, pA1, alA, l_reg, pa0, pa1, pa2, pa3); SBAR();
    pv_tile(o, vb0, pa0, pa1, pa2, pa3); MASKT(pB0, pB1, NT - 1); partialSM(pB0, pB1, m_reg, alB);
    RESC(alB);
    finishSM(pB0, pB1, alB, l_reg, pa0, pa1, pa2, pa3); SBAR();
    pv_tile(o, vb0 + SHM_V, pa0, pa1, pa2, pa3);
    } else {
    f32x16 p0, p1; float al; bf16x8 pa0, pa1, pa2, pa3;
    SLOAD(0); VM_WAIT(); SWRITE(0); __syncthreads();
    for (int t = 0; t < NT; t += 2) {
        SBAR(); SLOAD((t + 1) * KVBLK); SBAR();
        qkt<PITCH, ND0>(p0, p1, K_lds, r32, hi, kch0, qr); MASKT(p0, p1, t); partialSM(p0, p1, m_reg, al); RESC(al);
        finishSM(p0, p1, al, l_reg, pa0, pa1, pa2, pa3); SBAR();
        pv_tile(o, vb0, pa0, pa1, pa2, pa3);
        VM_WAIT(); SWRITE(1); __syncthreads();
        SBAR(); if (t + 2 < NT) SLOAD((t + 2) * KVBLK); SBAR();
        qkt<PITCH, ND0>(p0, p1, K_lds + SHM_K, r32, hi, kch0, qr); MASKT(p0, p1, t + 1); partialSM(p0, p1, m_reg, al); RESC(al);
        finishSM(p0, p1, al, l_reg, pa0, pa1, pa2, pa3); SBAR();
        pv_tile(o, vb0 + SHM_V, pa0, pa1, pa2, pa3);
        if (t + 2 < NT) { VM_WAIT(); SWRITE(0); } __syncthreads();
    }
    }
#undef SLOAD
#undef SWRITE
#undef RESC
#undef MASKT
}

template <bool NEGM = true>
__device__ __forceinline__ void partialSM_rel(f32x16& p0, f32x16& p1, float& m_reg, f32x16& negm, float& alpha, bool first) {
    float pmax = p0[0];
#pragma unroll
    for (int r = 1; r < 16; ++r) pmax = fmaxf(pmax, p0[r]);
#pragma unroll
    for (int r = 0; r < 16; ++r) pmax = fmaxf(pmax, p1[r]);
    { auto rr = __builtin_amdgcn_permlane32_swap(__float_as_uint(pmax), __float_as_uint(pmax), false, false); pmax = fmaxf(__uint_as_float(rr[0]), __uint_as_float(rr[1])); }
    if (__builtin_expect(!first && __all(pmax <= THRL), 1)) { alpha = 1.f; }
    else { const float dl = first ? pmax : fmaxf(pmax, 0.f); alpha = first ? 1.f : __builtin_amdgcn_exp2f(-dl); m_reg += dl;
#pragma unroll
        for (int r = 0; r < 16; ++r) { p0[r] -= dl; p1[r] -= dl; }
        if constexpr (NEGM) {
#pragma unroll
            for (int r = 0; r < 16; ++r) negm[r] = -m_reg; } }
#pragma unroll
    for (int r = 0; r < 16; ++r) p0[r] = __builtin_amdgcn_exp2f(p0[r]);
}
template <int PITCH, int ND0>
__device__ __forceinline__ void qkt_rel(f32x16& p0, f32x16& p1, const char* Kb, int r32, int hi, int kch0, const bf16x8* qr, const f32x16& negm) {
    const char* kb[4];
#pragma unroll
    for (int dd = 0; dd < 4; ++dd) kb[dd] = Kb + kswz<PITCH>(r32, (kch0 + dd * 2 + hi) * 16);
#pragma unroll
    for (int d0 = 0; d0 < ND0; ++d0) { const char* a = (PITCH % 256 == 0) ? Kb + kswz<PITCH>(r32, (kch0 + d0 * 2 + hi) * 16) : kb[d0 & 3] + (d0 >> 2) * 128;
        const bf16x8 b0 = *reinterpret_cast<const bf16x8*>(a);
        const bf16x8 b1 = *reinterpret_cast<const bf16x8*>(a + 32 * PITCH);
        p0 = __builtin_amdgcn_mfma_f32_32x32x16_bf16(b0, qr[d0], d0 == 0 ? negm : p0, 0, 0, 0);
        p1 = __builtin_amdgcn_mfma_f32_32x32x16_bf16(b1, qr[d0], d0 == 0 ? negm : p1, 0, 0, 0); }
}

template <int PITCH, int ND0, int PF>
__device__ __forceinline__ void qkt_rel_pf(f32x16& p0, f32x16& p1, const char* Kb, int r32, int hi, int kch0, const bf16x8* qr, const f32x16& negm_) {
    static_assert(PITCH % 256 == 128 || ND0 <= 4, "the +128 B immediate offsets need the 3-bit swizzle");
    f32x16 negm = negm_;
    int kb[4];
#pragma unroll
    for (int dd = 0; dd < 4; ++dd) kb[dd] = (int)(uintptr_t)Kb + kswz<PITCH>(r32, (kch0 + dd * 2 + hi) * 16);
    bf16x8 f[PF + 1][2];
#define KRD(d) do { asm volatile("ds_read_b128 %0, %1 offset:%2" : "=v"(f[(d) % (PF + 1)][0]) : "v"(kb[(d) & 3]), "i"(((d) >> 2) * 128)); \
                    asm volatile("ds_read_b128 %0, %1 offset:%2" : "=v"(f[(d) % (PF + 1)][1]) : "v"(kb[(d) & 3]), "i"(((d) >> 2) * 128 + 32 * PITCH)); } while (0)
#pragma unroll
    for (int d = 0; d < PF && d < ND0; ++d) KRD(d);
#pragma unroll
    for (int d0 = 0; d0 < ND0; ++d0) {
        if (d0 + PF < ND0) KRD(d0 + PF);
        const int ahead = (d0 + PF < ND0 ? PF : ND0 - 1 - d0) * 2;
        if (ahead >= 4) asm volatile("s_waitcnt lgkmcnt(4)" : "+v"(f[d0 % (PF + 1)][0]), "+v"(f[d0 % (PF + 1)][1]));
        else if (ahead == 2) asm volatile("s_waitcnt lgkmcnt(2)" : "+v"(f[d0 % (PF + 1)][0]), "+v"(f[d0 % (PF + 1)][1]));
        else asm volatile("s_waitcnt lgkmcnt(0)" : "+v"(f[d0 % (PF + 1)][0]), "+v"(f[d0 % (PF + 1)][1]));
        if (d0 == 0) {
            asm volatile("s_nop 1\n\tv_mfma_f32_32x32x16_bf16 %0, %1, %2, %3" : "=&v"(p0) : "v"(f[0][0]), "v"(qr[0]), "v"(negm));
            asm volatile("v_mfma_f32_32x32x16_bf16 %0, %1, %2, %3" : "=&v"(p1) : "v"(f[0][1]), "v"(qr[0]), "v"(negm));
        } else {
            p0 = __builtin_amdgcn_mfma_f32_32x32x16_bf16(f[d0 % (PF + 1)][0], qr[d0], p0, 0, 0, 0);
            p1 = __builtin_amdgcn_mfma_f32_32x32x16_bf16(f[d0 % (PF + 1)][1], qr[d0], p1, 0, 0, 0); }
    }
#undef KRD
}

template <int PITCH, int ND0>
__device__ __forceinline__ void pv_qk(f32x16* o, int vb0, bf16x8 pa0, bf16x8 pa1, bf16x8 pa2, bf16x8 pa3,
                                      f32x16& p0, f32x16& p1, const char* Kb, int r32, int hi, int kch0, const bf16x8* qr, const f32x16& negm_) {
    constexpr int PF = 2;
    static_assert(PITCH % 256 == 128 || ND0 <= 4, "the +128 B immediate offsets need the 3-bit swizzle");
    f32x16 negm = negm_;
    s16x4 va[8], vb[8];
    int kb[4];
#pragma unroll
    for (int dd = 0; dd < 4; ++dd) kb[dd] = (int)(uintptr_t)Kb + kswz<PITCH>(r32, (kch0 + dd * 2 + hi) * 16);
    bf16x8 f[PF + 1][2];
#define TRRD(dst, off) asm volatile("ds_read_b64_tr_b16 %0, %1 offset:%2" : "=&v"(dst) : "v"(vb0), "i"(off) : "memory")
#define PV_RD(v, d0) do { constexpr int b_ = v_rd_off(d0, 0, 0); TRRD(v[0], b_); TRRD(v[1], b_ + 2048); TRRD(v[2], b_ + 4096); TRRD(v[3], b_ + 6144); TRRD(v[4], b_ + 8192); TRRD(v[5], b_ + 10240); TRRD(v[6], b_ + 12288); TRRD(v[7], b_ + 14336); } while (0)
#define PV_MM(v, d0) do { \
        o[d0] = __builtin_amdgcn_mfma_f32_32x32x16_bf16(pa0, (bf16x8){v[0][0], v[0][1], v[0][2], v[0][3], v[1][0], v[1][1], v[1][2], v[1][3]}, o[d0], 0, 0, 0); \
        o[d0] = __builtin_amdgcn_mfma_f32_32x32x16_bf16(pa1, (bf16x8){v[2][0], v[2][1], v[2][2], v[2][3], v[3][0], v[3][1], v[3][2], v[3][3]}, o[d0], 0, 0, 0); \
        o[d0] = __builtin_amdgcn_mfma_f32_32x32x16_bf16(pa2, (bf16x8){v[4][0], v[4][1], v[4][2], v[4][3], v[5][0], v[5][1], v[5][2], v[5][3]}, o[d0], 0, 0, 0); \
        o[d0] = __builtin_amdgcn_mfma_f32_32x32x16_bf16(pa3, (bf16x8){v[6][0], v[6][1], v[6][2], v[6][3], v[7][0], v[7][1], v[7][2], v[7][3]}, o[d0], 0, 0, 0); } while (0)
#define PV_WN(v, n) asm volatile("s_waitcnt lgkmcnt(%8)" : "+v"(v[0]), "+v"(v[1]), "+v"(v[2]), "+v"(v[3]), "+v"(v[4]), "+v"(v[5]), "+v"(v[6]), "+v"(v[7]) : "n"(n) : "memory")
#define KRD(d) do { asm volatile("ds_read_b128 %0, %1 offset:%2" : "=v"(f[(d) % (PF + 1)][0]) : "v"(kb[(d) & 3]), "i"(((d) >> 2) * 128) : "memory"); \
                    asm volatile("ds_read_b128 %0, %1 offset:%2" : "=v"(f[(d) % (PF + 1)][1]) : "v"(kb[(d) & 3]), "i"(((d) >> 2) * 128 + 32 * PITCH) : "memory"); } while (0)
#define PV_RDK(v, ks) do { TRRD(v[0], v_rd_off(0, ks, 0)); TRRD(v[1], v_rd_off(0, ks, 1)); TRRD(v[2], v_rd_off(1, ks, 0)); TRRD(v[3], v_rd_off(1, ks, 1)); \
                            TRRD(v[4], v_rd_off(2, ks, 0)); TRRD(v[5], v_rd_off(2, ks, 1)); TRRD(v[6], v_rd_off(3, ks, 0)); TRRD(v[7], v_rd_off(3, ks, 1)); } while (0)
#define PV_MMK(v, pa) do { \
        o[0] = __builtin_amdgcn_mfma_f32_32x32x16_bf16(pa, (bf16x8){v[0][0], v[0][1], v[0][2], v[0][3], v[1][0], v[1][1], v[1][2], v[1][3]}, o[0], 0, 0, 0); \
        o[1] = __builtin_amdgcn_mfma_f32_32x32x16_bf16(pa, (bf16x8){v[2][0], v[2][1], v[2][2], v[2][3], v[3][0], v[3][1], v[3][2], v[3][3]}, o[1], 0, 0, 0); \
        o[2] = __builtin_amdgcn_mfma_f32_32x32x16_bf16(pa, (bf16x8){v[4][0], v[4][1], v[4][2], v[4][3], v[5][0], v[5][1], v[5][2], v[5][3]}, o[2], 0, 0, 0); \
        o[3] = __builtin_amdgcn_mfma_f32_32x32x16_bf16(pa, (bf16x8){v[6][0], v[6][1], v[6][2], v[6][3], v[7][0], v[7][1], v[7][2], v[7][3]}, o[3], 0, 0, 0); } while (0)
    PV_RDK(va, 0); PV_RDK(vb, 1); PV_WN(va, 8); SBAR(); PV_MMK(va, pa0);
    PV_RDK(va, 2); PV_WN(vb, 8); SBAR(); PV_MMK(vb, pa1);
    PV_RDK(vb, 3); PV_WN(va, 8); SBAR(); PV_MMK(va, pa2);
    KRD(0); KRD(1);
    PV_WN(vb, 4); SBAR(); PV_MMK(vb, pa3);
#undef PV_MMK
#undef PV_RDK
    SBAR();
#pragma unroll
    for (int d0 = 0; d0 < ND0; ++d0) {
        if (d0 + PF < ND0) KRD(d0 + PF);
        const int ahead = (d0 + PF < ND0 ? PF : ND0 - 1 - d0) * 2;
        if (ahead >= 4) asm volatile("s_waitcnt lgkmcnt(4)" : "+v"(f[d0 % (PF + 1)][0]), "+v"(f[d0 % (PF + 1)][1]) :: "memory");
        else if (ahead == 2) asm volatile("s_waitcnt lgkmcnt(2)" : "+v"(f[d0 % (PF + 1)][0]), "+v"(f[d0 % (PF + 1)][1]) :: "memory");
        else asm volatile("s_waitcnt lgkmcnt(0)" : "+v"(f[d0 % (PF + 1)][0]), "+v"(f[d0 % (PF + 1)][1]) :: "memory");
        if (d0 == 0) {
            asm volatile("s_nop 1\n\tv_mfma_f32_32x32x16_bf16 %0, %1, %2, %3" : "=&v"(p0) : "v"(f[0][0]), "v"(qr[0]), "v"(negm));
            asm volatile("v_mfma_f32_32x32x16_bf16 %0, %1, %2, %3" : "=&v"(p1) : "v"(f[0][1]), "v"(qr[0]), "v"(negm));
        } else {
            p0 = __builtin_amdgcn_mfma_f32_32x32x16_bf16(f[d0 % (PF + 1)][0], qr[d0], p0, 0, 0, 0);
            p1 = __builtin_amdgcn_mfma_f32_32x32x16_bf16(f[d0 % (PF + 1)][1], qr[d0], p1, 0, 0, 0); }
    }
#undef KRD
#undef PV_WN
#undef PV_MM
#undef PV_RD
#undef TRRD
}

__device__ __forceinline__ void glds16(unsigned lds_addr, const void* sbase, unsigned voff) {
    unsigned keep;
    asm volatile("s_mov_b32 %0, m0\n\ts_mov_b32 m0, %1\n\ts_nop 0\n\tglobal_load_lds_dwordx4 %2, %3\n\ts_mov_b32 m0, %0" : "=&s"(keep) : "s"(lds_addr), "v"(voff), "s"(sbase) : "memory");
}
template <int KT, int ND0, bool CAUSAL>
__device__ __forceinline__ void attn_core_ring(const bf16_t* Qlane, const bf16_t* __restrict__ Kh, int ldk, const bf16_t* __restrict__ Vh, int ldv, int NT, int qpos, int qlo, int kch0,
                                               char* lds, f32x16 (&o)[4], float& l_reg) {
    constexpr int PITCH = KT * 2, SHM_K = KVBLK * PITCH, NKP = SHM_K / 8192, NVP = SHM_V / 8192;
    const int tid = opaque_tid(), wid = __builtin_amdgcn_readfirstlane(tid >> 6), lane = tid & 63, r32 = lane & 31, hi = lane >> 5;
    char* V_lds = lds; char* K_lds = lds + 3 * SHM_V;
    float* ws = (float*)(lds + 3 * SHM_V + 3 * SHM_K) + wid * 64; float* al_l = ws + 32;
    float m_reg = 0.f; l_reg = 0.f; f32x16 negm = f32x16{};
#pragma unroll
    for (int d = 0; d < 4; ++d) o[d] = f32x16{};
    bf16x8 qr[ND0];
#pragma unroll
    for (int d0 = 0; d0 < ND0; ++d0) qr[d0] = *reinterpret_cast<const bf16x8*>(Qlane + d0 * 16);
    const int vb0 = (int)(uintptr_t)V_lds + v_rd_base(lane);
    unsigned koff[NKP], voff[NVP];
#pragma unroll
    for (int i = 0; i < NKP; ++i) { const int a = (wid * NKP + i) * 1024 + lane * 16, row = a / PITCH, cpos = (a - row * PITCH) >> 4, f = kfl<PITCH>(row);
        const int chunk = cpos ^ f; koff[i] = (unsigned)(row * ldk * 2 + chunk * 16); }
#pragma unroll
    for (int i = 0; i < NVP; ++i) { const int a = (wid * NVP + i) * 1024 + lane * 16, sub = a >> 9, rem = a & 511, kk = (sub >> 2) * 8 + (rem >> 6), c = (sub & 3) * 32 + ((rem & 63) >> 1);
        const int k = kk; voff[i] = (unsigned)(k * ldv * 2 + c * 2); }
    const unsigned ldsK = (unsigned)(uintptr_t)K_lds + (unsigned)(wid * NKP) * 1024u, ldsV = (unsigned)(uintptr_t)V_lds + (unsigned)(wid * NVP) * 1024u;
#define DMA_TILE(t, slot) do { const char* kb_ = (const char*)Kh + (size_t)(t) * KVBLK * ldk * 2; const char* vb_ = (const char*)Vh + (size_t)(t) * KVBLK * ldv * 2; \
        _Pragma("unroll") for (int i_ = 0; i_ < NKP; ++i_) glds16(ldsK + (slot) * SHM_K + i_ * 1024, kb_, koff[i_]); \
        _Pragma("unroll") for (int i_ = 0; i_ < NVP; ++i_) glds16(ldsV + (slot) * SHM_V + i_ * 1024, vb_, voff[i_]); } while (0)
#define RING_SYNC(more) do { if (more) asm volatile("s_waitcnt vmcnt(%0)" :: "n"(NKP + NVP) : "memory"); else asm volatile("s_waitcnt vmcnt(0)" ::: "memory"); \
        asm volatile("s_waitcnt lgkmcnt(0)" ::: "memory"); __builtin_amdgcn_s_barrier(); asm volatile("" ::: "memory"); } while (0)
#define RESC(a) do { if (__any((a) < 1.f)) { if (hi == 0) al_l[r32] = (a); asm volatile("s_waitcnt lgkmcnt(0)" ::: "memory"); \
        _Pragma("unroll") for (int d_ = 0; d_ < 4; ++d_) _Pragma("unroll") for (int r = 0; r < 16; ++r) o[d_][r] *= al_l[crow(r, hi)]; } } while (0)
#define MASKT(P0_, P1_, t) do { if (CAUSAL) { const int kb_ = (t) * KVBLK; if (kb_ + KVBLK - 1 > qlo) mask_tile(P0_, P1_, qpos - kb_ - 4 * hi); } } while (0)
    f32x16 p0, p1; float al; bf16x8 pa0, pa1, pa2, pa3;
    asm volatile("s_waitcnt vmcnt(0)" ::: "memory");
#pragma unroll
    for (int d0 = 0; d0 < ND0; ++d0) asm volatile("" : "+v"(qr[d0]));
    DMA_TILE(0, 0); if (NT > 1) DMA_TILE(1, 1);
    RING_SYNC(NT > 1);
    int slot = 0;
    for (int t = 0; t < NT; ++t) {
        const int s2 = slot == 0 ? 2 : slot - 1;
        SBAR(); if (t + 2 < NT) DMA_TILE(t + 2, s2); SBAR();
        qkt_rel_pf<PITCH, ND0, 2>(p0, p1, K_lds + slot * SHM_K, r32, hi, kch0, qr, negm); MASKT(p0, p1, t); partialSM_rel(p0, p1, m_reg, negm, al, t == 0); RESC(al);
        finishSM(p0, p1, al, l_reg, pa0, pa1, pa2, pa3); SBAR();
        pv_tile(o, vb0 + slot * SHM_V, pa0, pa1, pa2, pa3);
        RING_SYNC(t + 2 < NT);
        slot = slot == 2 ? 0 : slot + 1;
    }
#undef DMA_TILE
#undef RING_SYNC
#undef RESC
#undef MASKT
}
template <int KT, int ND0, bool CAUSAL, bool NEGM>
__device__ __forceinline__ void attn_core_pp(const bf16_t* Qlane, const bf16_t* __restrict__ Kh, int ldk, const bf16_t* __restrict__ Vh, int ldv, int NT, int qpos, int qlo, int kch0,
                                             char* lds, f32x16 (&o)[4], float& l_reg) {
    constexpr int PITCH = KT * 2, SHM_K = KVBLK * PITCH, NKP = SHM_K / 8192, NVP = SHM_V / 8192;
    const int tid = opaque_tid(), wid = __builtin_amdgcn_readfirstlane(tid >> 6), lane = tid & 63, r32 = lane & 31, hi = lane >> 5;
    const bool grpB = wid >= 4;
    char* V_lds = lds; char* K_lds = lds + 3 * SHM_V;
    float* ws = (float*)(lds + 3 * SHM_V + 3 * SHM_K) + wid * 64; float* al_l = ws + 32;
    float m_reg = 0.f; l_reg = 0.f; f32x16 negm = f32x16{};
#pragma unroll
    for (int d = 0; d < 4; ++d) o[d] = f32x16{};
    bf16x8 qr[ND0];
#pragma unroll
    for (int d0 = 0; d0 < ND0; ++d0) qr[d0] = *reinterpret_cast<const bf16x8*>(Qlane + d0 * 16);
    const int vb0 = (int)(uintptr_t)V_lds + v_rd_base(lane);
    unsigned koff[NKP], voff[NVP];
#pragma unroll
    for (int i = 0; i < NKP; ++i) { const int a = (wid * NKP + i) * 1024 + lane * 16, row = a / PITCH, cpos = (a - row * PITCH) >> 4, f = kfl<PITCH>(row);
        const int chunk = cpos ^ f; koff[i] = (unsigned)(row * ldk * 2 + chunk * 16); }
#pragma unroll
    for (int i = 0; i < NVP; ++i) { const int a = (wid * NVP + i) * 1024 + lane * 16, sub = a >> 9, rem = a & 511, kk = (sub >> 2) * 8 + (rem >> 6), c = (sub & 3) * 32 + ((rem & 63) >> 1);
        const int k = kk; voff[i] = (unsigned)(k * ldv * 2 + c * 2); }
    const unsigned ldsK = (unsigned)(uintptr_t)K_lds + (unsigned)(wid * NKP) * 1024u, ldsV = (unsigned)(uintptr_t)V_lds + (unsigned)(wid * NVP) * 1024u;
#define DMA_K(t, slot) do { const char* kb_ = (const char*)Kh + (size_t)(t) * KVBLK * ldk * 2; _Pragma("unroll") for (int i_ = 0; i_ < NKP; ++i_) glds16(ldsK + (slot) * SHM_K + i_ * 1024, kb_, koff[i_]); } while (0)
#define DMA_V(t, slot) do { const char* vb_ = (const char*)Vh + (size_t)(t) * KVBLK * ldv * 2; _Pragma("unroll") for (int i_ = 0; i_ < NVP; ++i_) glds16(ldsV + (slot) * SHM_V + i_ * 1024, vb_, voff[i_]); } while (0)
#define ISSUE(u, ksl, vsl) do { if ((u) < NT) DMA_K(u, ksl); if ((u) - 1 < NT) DMA_V((u) - 1, vsl); } while (0)
#define PAIR_WAIT(t) do { if ((t) + 2 < NT) asm volatile("s_waitcnt vmcnt(%0)" :: "n"(NKP + NVP) : "memory"); else if ((t) + 2 == NT) asm volatile("s_waitcnt vmcnt(%0)" :: "n"(NVP) : "memory"); \
        else asm volatile("s_waitcnt vmcnt(0)" ::: "memory"); } while (0)
#define BAR() do { SBAR(); asm volatile("s_waitcnt lgkmcnt(0)" ::: "memory"); __builtin_amdgcn_s_barrier(); asm volatile("" ::: "memory"); SBAR(); } while (0)
#define RESC(a) do { if (__any((a) < 1.f)) { if (hi == 0) al_l[r32] = (a); asm volatile("s_waitcnt lgkmcnt(0)" ::: "memory"); \
        _Pragma("unroll") for (int d_ = 0; d_ < 4; ++d_) _Pragma("unroll") for (int r = 0; r < 16; ++r) o[d_][r] *= al_l[crow(r, hi)]; } } while (0)
#define MASKT(P0_, P1_, t) do { if (CAUSAL) { const int kb_ = (t) * KVBLK; if (kb_ + KVBLK - 1 > qlo) mask_tile(P0_, P1_, qpos - kb_ - 4 * hi); } } while (0)
    f32x16 p0, p1; float al; bf16x8 pa0, pa1, pa2, pa3;
    asm volatile("s_waitcnt vmcnt(0)" ::: "memory");
#pragma unroll
    for (int d0 = 0; d0 < ND0; ++d0) asm volatile("" : "+v"(qr[d0]));
    DMA_K(0, 0);
    if (NT > 1) DMA_K(1, 1);
    DMA_V(0, 0);
    if (NT > 1) asm volatile("s_waitcnt vmcnt(%0)" :: "n"(NKP + NVP) : "memory"); else asm volatile("s_waitcnt vmcnt(%0)" :: "n"(NVP) : "memory");
    BAR();
    if (grpB) { ISSUE(2, 2, 1); BAR(); }
#define QK_(ksl) do { if constexpr (NEGM) qkt_rel_pf<PITCH, ND0, 2>(p0, p1, K_lds + (ksl) * SHM_K, r32, hi, kch0, qr, negm); \
        else { f32x16 c_; const float nm_ = -m_reg; _Pragma("unroll") for (int r = 0; r < 16; ++r) c_[r] = nm_; qkt_rel_pf<PITCH, ND0, 2>(p0, p1, K_lds + (ksl) * SHM_K, r32, hi, kch0, qr, c_); } } while (0)
#define Y_(t_, first_) do { MASKT(p0, p1, t_); partialSM_rel<NEGM>(p0, p1, m_reg, negm, al, first_); RESC(al); finishSM(p0, p1, al, l_reg, pa0, pa1, pa2, pa3); } while (0)
    QK_(0);
    if (grpB) PAIR_WAIT(0);
    BAR();
    if (grpB) ISSUE(3, 0, 2); else ISSUE(2, 2, 1);
    SBAR();
    Y_(0, true);
    if (!grpB) PAIR_WAIT(0);
    BAR();
    int ks = 1;
    for (int t = 1; t < NT; ++t) {
        const int kp = ks == 0 ? 2 : ks - 1, kn = ks == 2 ? 0 : ks + 1;
        if constexpr (NEGM) pv_qk<PITCH, ND0>(o, vb0 + kp * SHM_V, pa0, pa1, pa2, pa3, p0, p1, K_lds + ks * SHM_K, r32, hi, kch0, qr, negm);
        else { f32x16 c_; const float nm_ = -m_reg; _Pragma("unroll") for (int r = 0; r < 16; ++r) c_[r] = nm_; pv_qk<PITCH, ND0>(o, vb0 + kp * SHM_V, pa0, pa1, pa2, pa3, p0, p1, K_lds + ks * SHM_K, r32, hi, kch0, qr, c_); }
#ifdef PROBE_XMFMA
        if constexpr (ND0 == 4) { f32x16 dz_ = f32x16{}; _Pragma("unroll") for (int i_ = 0; i_ < PROBE_XMFMA; ++i_) asm volatile("v_mfma_f32_32x32x16_bf16 %0, %1, %2, %0" : "+v"(dz_) : "v"(qr[0]), "v"(qr[1])); asm volatile("s_nop 15\n\ts_nop 15" :: "v"(dz_)); }
#endif
        if (grpB) PAIR_WAIT(t);
        BAR();
        if (grpB) ISSUE(t + 3, ks, kp); else ISSUE(t + 2, kp, kn);
        SBAR();
        Y_(t, false);
#ifdef PROBE_YEXP
        if constexpr (ND0 == 4) { float dm_ = al; _Pragma("unroll") for (int i_ = 0; i_ < PROBE_YEXP; ++i_) asm volatile("v_exp_f32 %0, %1" : "=v"(dm_) : "v"(al)); asm volatile("" :: "v"(dm_)); }
#endif

        if (!grpB) PAIR_WAIT(t);
        BAR();
        ks = kn;
    }
    pv_tile(o, vb0 + (ks == 0 ? 2 : ks - 1) * SHM_V, pa0, pa1, pa2, pa3);
    BAR();
#undef QK_
#undef Y_
    if (!grpB) BAR();
#undef DMA_K
#undef DMA_V
#undef ISSUE
#undef PAIR_WAIT
#undef BAR
#undef RESC
#undef MASKT
}
__device__ __forceinline__ void normalize_o(f32x16 (&o)[4], float l_reg, float* ws, int r32, int hi) {
    if (hi == 0) ws[r32] = l_reg; asm volatile("s_waitcnt lgkmcnt(0)" ::: "memory");
#pragma unroll
    for (int r = 0; r < 16; ++r) { const float rl = __builtin_amdgcn_rcpf(ws[crow(r, hi)]);
#pragma unroll
        for (int d0 = 0; d0 < 4; ++d0) o[d0][r] *= rl; }
}
__device__ __forceinline__ void store_o_bf16(const f32x16 (&o)[4], bf16_t* Ow, int ldo, int r32, int hi) {
#pragma unroll
    for (int r = 0; r < 16; ++r) { const int orow = crow(r, hi);
#pragma unroll
        for (int d0 = 0; d0 < 4; ++d0) { const float v = o[d0][r]; const float vn = shflx(v, 1, hi * 32 + r32);
            if ((r32 & 1) == 0) *(unsigned*)(Ow + (size_t)orow * ldo + d0 * 32 + r32) = cvt_pk_bf16(v, vn); } }
}
}

constexpr size_t MiB = 1u << 20;
constexpr size_t WS_CTL = 0, CTL_ZERO_BYTES = 128 * 1024;
constexpr size_t WS_SSQ = 1 * MiB;
constexpr size_t WS_W = 4 * MiB, LW_BYTES = 269 * MiB / 2;
constexpr size_t LW_IN = 0, LW_QUP = 44 * MiB, LW_KVUP = LW_QUP + 3 * MiB / 2, LW_GLU = LW_KVUP + 1 * MiB, LW_BR = LW_GLU + 4 * MiB, LW_OUT = LW_BR + 12 * MiB,
                 LW_XQ = LW_OUT + 8 * MiB, LW_XKV = LW_XQ + 2 * MiB, LW_XO = LW_XKV + 4 * MiB, LW_TEXT = LW_XO + 2 * MiB, LW_WSL = LW_TEXT + 40 * MiB;
static_assert(LW_WSL + 16 * MiB == LW_BYTES, "layer weight block");
constexpr size_t WS_FFN = WS_W + 2 * LW_BYTES;
constexpr size_t WS_MOE = WS_FFN + 66 * MiB;
constexpr size_t WS_XS = WS_MOE + 8 * 66 * MiB + 1 * MiB;
static_assert(WS_XS == 868 * MiB, "map");
constexpr size_t WS_XN = WS_XS + 128 * MiB;
constexpr size_t WS_TABD = WS_XN + 64 * MiB, WS_TABM = WS_TABD + 1 * MiB, WS_XKV = WS_TABM + 4 * MiB, WS_MEMB = WS_XKV + 1 * MiB, WS_ROUTE = WS_MEMB + 1 * MiB, WS_ORDER = WS_ROUTE + 1 * MiB;
constexpr size_t WS_A32 = WS_ORDER + 64 * 1024;
constexpr size_t WS_PSQ = WS_ORDER + 1 * MiB;
constexpr size_t WS_MIX = WS_TABD + 12 * MiB;
static_assert(WS_MIX == 1072 * MiB, "map");
constexpr size_t WS_QD = WS_MIX, WS_KD = WS_QD + 32 * MiB, WS_VD = WS_KD + 32 * MiB, WS_MQ = WS_VD + 32 * MiB, WS_MKV = WS_MQ + 16 * MiB, WS_KM = WS_MKV + 8 * MiB, WS_VM = WS_KM + 48 * MiB,
                 WS_QM = WS_VM + 32 * MiB, WS_SU = WS_QM + 48 * MiB, WS_GATES = WS_SU + 40 * MiB, WS_SLOC = WS_GATES + 192 * MiB, WS_YG = WS_SLOC + 16 * MiB, WS_BR = WS_YG + 32 * MiB,
                 WS_TMP = WS_BR + 96 * MiB, WS_MG = WS_TMP + 128 * MiB, WS_XQ = WS_MG + 64 * MiB, WS_XO = WS_XQ + 16 * MiB, WS_XN8 = WS_XO + 16 * MiB  , WS_END = WS_XN8 + 32 * MiB;
static_assert(WS_END == 1952 * MiB, "map");
constexpr size_t WS_XG = WS_MIX, WS_HG = WS_XG + 136 * MiB, WS_OG = WS_HG + 374 * MiB;
static_assert(WS_OG + 272 * MiB <= WS_XQ, "ffn overlay");
constexpr int CW_TMO = 0, CW_DBG = 2, CW_BAR = 4096, CW_ATTQ = 16384, CW_MOECNT = 16640, CW_MOECUR = 16704;

#define XB_TMO      128
#define XB_XCNT(j)  (256  + 64 * (j))
#define XB_XSUB(j)  (1280 + 64 * (j))
#define XB_XGEN(j)  (2304 + 64 * (j))
#define XB_TOP      3328
#define XB_TOPGEN   3392
#define XCD_BAR_WORDS 3456
#define XB_SPIN_CAP (1u << 22)
__device__ __forceinline__ unsigned xb_ld(unsigned* p)              { return __hip_atomic_load(p, __ATOMIC_RELAXED, __HIP_MEMORY_SCOPE_AGENT); }
__device__ __forceinline__ unsigned xb_add(unsigned* p, unsigned v) { return __hip_atomic_fetch_add(p, v, __ATOMIC_RELAXED, __HIP_MEMORY_SCOPE_AGENT); }
__device__ __forceinline__ unsigned xb_xcc_id() { return (unsigned)__builtin_amdgcn_s_getreg((3 << 11) | 20) & 0xFu; }
#define XB_SPIN(cond, bar) do { unsigned _sp = 0; while (cond) { __builtin_amdgcn_s_sleep(1); \
    if ((++_sp & 255u) == 0u) { if (xb_ld(&(bar)[XB_TMO])) break; if (_sp > XB_SPIN_CAP) { atomicAdd(&(bar)[XB_TMO], 1u); break; } } } } while (0)
struct XcdBarrier { unsigned* bar; unsigned x; volatile LAS unsigned* st; };
__device__ __forceinline__ XcdBarrier xcd_barrier_post(unsigned* bar, volatile LAS unsigned* st) {
    XcdBarrier b; b.bar = bar; b.x = xb_xcc_id(); b.st = st;
    if (threadIdx.x == 0) (void)xb_add(&bar[XB_XCNT(b.x)], 1u);
    return b;
}
__device__ __forceinline__ void xcd_barrier_complete(unsigned* bar, unsigned x, unsigned& nloc, unsigned& nx) {
    const unsigned G = gridDim.x * gridDim.y * gridDim.z;
    unsigned sum, cnt, mine, sp = 0u;
    for (;;) {
        sum = 0u; cnt = 0u; mine = 0u;
#pragma nounroll
        for (unsigned j = 0; j < 16; ++j) { const unsigned c = xb_ld(&bar[XB_XCNT(j)]); sum += c; cnt += (c > 0u) ? 1u : 0u; mine = (j == x) ? c : mine; }
        if (sum == G) break;
        __builtin_amdgcn_s_sleep(1);
        if ((++sp & 255u) == 0u) { if (xb_ld(&bar[XB_TMO])) break; if (sp > XB_SPIN_CAP) { atomicAdd(&bar[XB_TMO], 1u); break; } }
    }
    nloc = mine > 0u ? mine : 1u; nx = cnt > 0u ? cnt : 1u;
}
__device__ __forceinline__ void xcd_barrier_setup(const XcdBarrier& b) {
    if (threadIdx.x == 0) { unsigned nloc, nx; xcd_barrier_complete(b.bar, b.x, nloc, nx); b.st[0] = nloc; b.st[1] = nx; }
    __syncthreads();
}
__device__ __forceinline__ void xcd_barrier(const XcdBarrier& b) {
    asm volatile("s_waitcnt vmcnt(0)" ::: "memory");
    __syncthreads();
    if (opaque_tid() == 0) {
        unsigned* bar = b.bar;
        __builtin_amdgcn_s_waitcnt(0);
        const unsigned nloc = b.st[0], nx = b.st[1];
        const unsigned old = xb_add(&bar[XB_XSUB(b.x)], 1u);
        const unsigned gen = old / nloc;
        if (old + 1u == (gen + 1u) * nloc) {
            __builtin_amdgcn_fence(__ATOMIC_RELEASE, "agent");
            asm volatile("s_waitcnt vmcnt(0)" ::: "memory");
            const unsigned og = xb_add(&bar[XB_TOP], 1u);
            const unsigned tg = og / nx;
            if (og + 1u == (tg + 1u) * nx) xb_add(&bar[XB_TOPGEN], 1u);
            else XB_SPIN(xb_ld(&bar[XB_TOPGEN]) == tg, bar);
            __builtin_amdgcn_fence(__ATOMIC_ACQUIRE, "agent");
            xb_add(&bar[XB_XGEN(b.x)], 1u);
            asm volatile("s_waitcnt vmcnt(0)" ::: "memory");
        } else {
            XB_SPIN(xb_ld(&bar[XB_XGEN(b.x)]) == gen, bar);
            __builtin_amdgcn_fence(__ATOMIC_ACQUIRE, "agent");
            asm volatile("s_waitcnt vmcnt(0)" ::: "memory");
        }
    }
    __syncthreads();
}

struct Args { const void* in[35]; float* out; unsigned char* ws; int ph_lo, ph_hi; };
struct PTab { volatile LAS unsigned long long* t; __device__ __forceinline__ const void* operator[](int i) const { const unsigned long long v = t[i];
    const unsigned lo_ = __builtin_amdgcn_readfirstlane((unsigned)v), hi_ = __builtin_amdgcn_readfirstlane((unsigned)(v >> 32)); return (const void*)(GAS const char*)(((unsigned long long)hi_ << 32) | lo_); } };
struct ArgsD { PTab in; unsigned char* ws; };
enum { I_X = 0, I_MEM, I_POS, I_WIN, I_WQUP, I_WKVUP, I_QNG, I_KVNG, I_DLAM, I_SUBLN, I_LRE, I_LIM, I_BRE, I_BIM, I_CRE, I_CIM, I_SSMD, I_LOGDT, I_GLUW, I_WBR, I_WOUT, I_LNMG, I_LNMB,
       I_WXQ, I_WXKV, I_WXO, I_LNXG, I_LNXB, I_FGU, I_FDN, I_ROUTER, I_MGU, I_MDN, I_LNFG, I_LNFB };
constexpr int NPL = 16, NPHASE = 1 + DEPTH * NPL;
constexpr int LDS_BYTES = 147456;
constexpr int LDS_MISC = 131072 + 8192;

__device__ __forceinline__ float lam_init_of(int l) { return l == 0 ? 0.2f : 0.35550906759f; }

struct Mat { const float* src; bf16_t* dst; int K, N, kind; const float* ksc; int kmod; float kmul; int fp8; };
__device__ __forceinline__ int map_row(int kind, int n, int N) {
    if (kind == 0) return n;
    if (kind == 1) {
        if (n < 2048) { const int hc = n & 63; if (hc < 16) return (n - hc) + (hc < 8 ? 2 * hc : 2 * (hc - 8) + 1); return n; }
        if (n < 3840) return n;
        if (n < 3904) { const int hc = n - 3840; return 3840 + (hc < 32 ? 2 * hc : 2 * (hc - 32) + 1); }
        return n + 192;
    }
    if (kind == 2) { const int h = n / 192; int hc = n - h * 192; if (hc >= 128) { const int r = hc - 128; hc = 128 + (r < 32 ? 2 * r : 2 * (r - 32) + 1); } return h * 192 + hc; }
    const int half = N >> 1;
    if (n < half) return (n >> 7) * 256 + (n & 127);
    const int mm = n - half; return (mm >> 7) * 256 + 128 + (mm & 127);
}
__device__ __forceinline__ Mat get_mat(const ArgsD& a, int id) {
    Mat m; m.ksc = nullptr; m.kmod = 1; m.kmul = 1.f; m.kind = 0; m.fp8 = 0;
    unsigned char* ws = a.ws;
    if (id < 22) { const int l = id / 11, k = id % 11; unsigned char* lw = ws + WS_W + (size_t)l * LW_BYTES;
        switch (k) {
        case 0: m.src = (const float*)a.in[I_WIN] + (size_t)l * D * NIN_SRC; m.dst = (bf16_t*)(lw + LW_IN); m.K = D; m.N = NIN_SRC; m.kind = 1; break;
        case 1: m.src = (const float*)a.in[I_WQUP] + (size_t)l * 512 * 1536; m.dst = (bf16_t*)(lw + LW_QUP); m.K = 512; m.N = 1536; m.kind = 2; m.ksc = (const float*)a.in[I_QNG] + l * 512; m.kmod = 512; break;
        case 2: m.src = (const float*)a.in[I_WKVUP] + (size_t)l * 256 * 2048; m.dst = (bf16_t*)(lw + LW_KVUP); m.K = 256; m.N = 2048; m.ksc = (const float*)a.in[I_KVNG] + l * 256; m.kmod = 256; break;
        case 3: m.src = (const float*)a.in[I_GLUW] + (size_t)l * 1024 * 2048; m.dst = (bf16_t*)(lw + LW_GLU); m.K = 1024; m.N = 2048; m.kind = 3; break;
        case 4: m.src = (const float*)a.in[I_WBR] + (size_t)(l * 3 + 0) * 1024 * 2048; m.dst = (bf16_t*)(lw + LW_BR); m.K = 1024; m.N = 2048; m.ksc = (const float*)a.in[I_SUBLN] + l * 128; m.kmod = 128; m.kmul = 1.f - lam_init_of(l); break;
        case 5: m.src = (const float*)a.in[I_WBR] + (size_t)(l * 3 + 1) * 1024 * 2048; m.dst = (bf16_t*)(lw + LW_BR + 4 * MiB); m.K = 1024; m.N = 2048; break;
        case 6: m.src = (const float*)a.in[I_WBR] + (size_t)(l * 3 + 2) * 1024 * 2048; m.dst = (bf16_t*)(lw + LW_BR + 8 * MiB); m.K = 1024; m.N = 2048; break;
        case 7: m.src = (const float*)a.in[I_WOUT] + (size_t)l * 2048 * 2048; m.dst = (bf16_t*)(lw + LW_OUT); m.K = 2048; m.N = 2048; break;
        case 8: m.src = (const float*)a.in[I_WXQ] + (size_t)l * 2048 * 512; m.dst = (bf16_t*)(lw + LW_XQ); m.K = 2048; m.N = 512; break;
        case 9: m.src = (const float*)a.in[I_WXKV] + (size_t)l * 2048 * 1024; m.dst = (bf16_t*)(lw + LW_XKV); m.K = 2048; m.N = 1024; break;
        default: m.src = (const float*)a.in[I_WXO] + (size_t)l * 512 * 2048; m.dst = (bf16_t*)(lw + LW_XO); m.K = 512; m.N = 2048; break;
        }
    } else if (id == 22) { m.src = (const float*)a.in[I_FGU]; m.dst = (bf16_t*)(ws + WS_FFN); m.K = D; m.N = 2 * DFF; m.kind = 3; }
    else if (id == 23) { m.src = (const float*)a.in[I_FDN]; m.dst = (bf16_t*)(ws + WS_FFN + 44 * MiB); m.K = DFF; m.N = D; m.fp8 = 1; m.kmul = 256.f; }
    else { const int e = (id - 24) >> 1;
        m.fp8 = 1;
        if (((id - 24) & 1) == 0) { m.src = (const float*)a.in[I_MGU] + (size_t)e * D * 2 * DFF; m.dst = (bf16_t*)(ws + WS_MOE + (size_t)e * 66 * MiB); m.K = D; m.N = 2 * DFF; m.kind = 3; m.kmul = 64.f; }
        else { m.src = (const float*)a.in[I_MDN] + (size_t)e * DFF * D; m.dst = (bf16_t*)(ws + WS_MOE + (size_t)e * 66 * MiB + 44 * MiB); m.K = DFF; m.N = D; m.kmul = 256.f; }
    }
    return m;
}
constexpr int NMAT = 40;
__device__ __forceinline__ void cvt_item(const Mat& mt, LAS float* scr, int item, int lane) {
    const int nblk = mt.N / 64, kb = item / nblk, nb = item - kb * nblk, k0 = 64 * kb, n0 = 64 * nb;
    const bool g8 = mt.kind == 1 && n0 >= 3072;
    const bool f8 = mt.fp8 || g8; const float kmul = g8 ? 64.f : mt.kmul;
    const int lr = lane >> 4, lc = (lane & 15) * 4;
    f32x4 v[16];
#pragma unroll
    for (int i = 0; i < 16; ++i) v[i] = *(const f32x4*)(mt.src + (size_t)(k0 + 4 * i + lr) * mt.N + n0 + lc);
    if (mt.ksc) {
#pragma unroll
        for (int i = 0; i < 16; ++i) v[i] = v[i] * (mt.ksc[(k0 + 4 * i + lr) % mt.kmod] * mt.kmul); }
    else if (f8) {
#pragma unroll
        for (int i = 0; i < 16; ++i) v[i] = v[i] * kmul; }
#pragma unroll
    for (int i = 0; i < 16; ++i) { LAS float* p = scr + (4 * i + lr) * 65 + lc; p[0] = v[i][0]; p[1] = v[i][1]; p[2] = v[i][2]; p[3] = v[i][3]; }
    LDS_WAIT(); asm volatile("" ::: "memory");
    const int c = lane & 7;
#pragma unroll
    for (int j = 0; j < 8; ++j) { const int n = (lane >> 3) + 8 * j; const LAS float* s = scr + (8 * c) * 65 + n;
        if (f8) { const u32x2 o = pack8_fp8((f32x4){s[0 * 65], s[1 * 65], s[2 * 65], s[3 * 65]}, (f32x4){s[4 * 65], s[5 * 65], s[6 * 65], s[7 * 65]}); const int r_ = map_row(mt.kind, n0 + n, mt.N);
            unsigned char* d8 = g8 ? (unsigned char*)mt.dst + (size_t)NIN_BF * mt.K * 2 + (size_t)(r_ - NIN_BF) * mt.K : (unsigned char*)mt.dst + (size_t)r_ * mt.K;
            *(u32x2*)(d8 + k0 + 8 * c) = o; }
        else { u32x4 o; o.x = cvt_pk_bf16(s[0 * 65], s[1 * 65]); o.y = cvt_pk_bf16(s[2 * 65], s[3 * 65]); o.z = cvt_pk_bf16(s[4 * 65], s[5 * 65]); o.w = cvt_pk_bf16(s[6 * 65], s[7 * 65]);
            *(u32x4*)(mt.dst + (size_t)map_row(mt.kind, n0 + n, mt.N) * mt.K + k0 + 8 * c) = o; } }
    LDS_WAIT(); asm volatile("" ::: "memory");
}
__device__ __forceinline__ void cvt_tile_wg(const Mat& mt, LAS float* scr, int tile, int tid) {
    const int nblk = mt.N / 256, kb = tile / nblk, nb = tile - kb * nblk, k0 = 64 * kb, n0 = 256 * nb;
    const int lane = tid & 63, w = tid >> 6;
    f32x4 v[8];
#pragma unroll
    for (int i = 0; i < 8; ++i) v[i] = *(const f32x4*)(mt.src + (size_t)(k0 + 8 * w + i) * mt.N + n0 + lane * 4);
    if (mt.ksc) {
#pragma unroll
        for (int i = 0; i < 8; ++i) v[i] = v[i] * (mt.ksc[(k0 + 8 * w + i) % mt.kmod] * mt.kmul); }
    else if (mt.fp8) {
#pragma unroll
        for (int i = 0; i < 8; ++i) v[i] = v[i] * mt.kmul; }
#pragma unroll
    for (int i = 0; i < 8; ++i) { LAS float* p = scr + (8 * w + i) * 257 + lane * 4; p[0] = v[i][0]; p[1] = v[i][1]; p[2] = v[i][2]; p[3] = v[i][3]; }
    __syncthreads();
    const int c = tid & 7;
#pragma unroll
    for (int j = 0; j < 4; ++j) { const int n = (tid >> 3) + 64 * j; const LAS float* s = scr + (8 * c) * 257 + n; const int r_ = map_row(mt.kind, n0 + n, mt.N);
        if (mt.fp8) *(u32x2*)((unsigned char*)mt.dst + (size_t)r_ * mt.K + k0 + 8 * c) = pack8_fp8((f32x4){s[0 * 257], s[1 * 257], s[2 * 257], s[3 * 257]}, (f32x4){s[4 * 257], s[5 * 257], s[6 * 257], s[7 * 257]});
        else { u32x4 o; o.x = cvt_pk_bf16(s[0 * 257], s[1 * 257]); o.y = cvt_pk_bf16(s[2 * 257], s[3 * 257]); o.z = cvt_pk_bf16(s[4 * 257], s[5 * 257]); o.w = cvt_pk_bf16(s[6 * 257], s[7 * 257]);
            *(u32x4*)(mt.dst + (size_t)r_ * mt.K + k0 + 8 * c) = o; } }
    __syncthreads();
}
__device__ __forceinline__ void ssm_build(const ArgsD& a, int l, int g, int half, LAS unsigned char* lds) {
    LAS float* Ap = (LAS float*)lds;
    LAS float* Bb = Ap + 33 * 64 * 2;
    LAS float* Cc = Bb + 64 * 16 * 2;
    LAS float* Mk = Cc + 16 * 64 * 2;
    const int tid = opaque_tid();
    const float* lre = (const float*)a.in[I_LRE] + (l * 64 + g) * 64; const float* lim = (const float*)a.in[I_LIM] + (l * 64 + g) * 64;
    const float* bre = (const float*)a.in[I_BRE] + (size_t)(l * 64 + g) * 1024; const float* bim = (const float*)a.in[I_BIM] + (size_t)(l * 64 + g) * 1024;
    const float* cre = (const float*)a.in[I_CRE] + (size_t)(l * 64 + g) * 1024; const float* cim = (const float*)a.in[I_CIM] + (size_t)(l * 64 + g) * 1024;
    const double dt = exp((double)((const float*)a.in[I_LOGDT])[l * 64 + g]);
    for (int idx = tid; idx < 33 * 64; idx += 512) { const int n = idx & 63, k = idx >> 6; const double re = lre[n], im = lim[n];
        const double mag = exp(re * dt * k), ang = im * dt * k; Ap[idx * 2] = (float)(mag * cos(ang)); Ap[idx * 2 + 1] = (float)(mag * sin(ang)); }
    if (tid < 64) { float* a32 = (float*)(a.ws + WS_A32) + (size_t)((l * 64 + g) * 64 + tid) * 2; const double re = lre[tid], im = lim[tid]; const double mag = exp(32.0 * re * dt), ang = 32.0 * im * dt;
        a32[0] = (float)(mag * cos(ang)); a32[1] = (float)(mag * sin(ang)); }
    for (int idx = tid; idx < 1024; idx += 512) { const int n = idx >> 4; const double re = lre[n], im = lim[n]; const double mag = exp(re * dt), ang = im * dt;
        const double lr = mag * cos(ang) - 1.0, li = mag * sin(ang), den = re * re + im * im;
        const double fr_ = (lr * re + li * im) / den, fi_ = (li * re - lr * im) / den; const double br = bre[idx], bi = bim[idx];
        Bb[idx * 2] = (float)(fr_ * br - fi_ * bi); Bb[idx * 2 + 1] = (float)(fr_ * bi + fi_ * br);
        Cc[idx * 2] = cre[idx]; Cc[idx * 2 + 1] = cim[idx]; }
    __syncthreads();
    { const int k = tid >> 4, p = tid & 15; float acc[16];
#pragma unroll
        for (int q = 0; q < 16; ++q) acc[q] = 0.f;
        for (int n = 0; n < 64; ++n) { const float ar = Ap[(k * 64 + n) * 2], ai = Ap[(k * 64 + n) * 2 + 1], cr = Cc[(p * 64 + n) * 2], ci = Cc[(p * 64 + n) * 2 + 1];
            const float ur = cr * ar - ci * ai, ui = cr * ai + ci * ar; const LAS f32x4* bq = (const LAS f32x4*)(Bb + n * 32);
#pragma unroll
            for (int q4 = 0; q4 < 8; ++q4) { const f32x4 bv = bq[q4]; acc[2 * q4] += bv[0] * ur - bv[1] * ui; acc[2 * q4 + 1] += bv[2] * ur - bv[3] * ui; } }
#pragma unroll
        for (int q = 0; q < 16; ++q) Mk[tid * 16 + q] = acc[q]; }
    __syncthreads();
    unsigned char* lw = a.ws + WS_W + (size_t)l * LW_BYTES;
    bf16_t* T = (bf16_t*)(lw + LW_TEXT) + (size_t)g * 512 * SSM_KX; bf16_t* W = (bf16_t*)(lw + LW_WSL) + (size_t)g * 256 * 512;
    for (int it = 0; it < 40; ++it) { const int c = it * 512 + tid, Rl = c / 80, ch = c - Rl * 80, R = 256 * half + Rl, i = R >> 4, p = R & 15; u32x4 w = {0u, 0u, 0u, 0u};
        if (ch < 64) { const int j = ch >> 1, q0 = (ch & 1) * 8;
            if (j <= i) { const LAS float* mp = Mk + ((i - j) * 16 + p) * 16 + q0; w.x = cvt_pk_bf16(mp[0], mp[1]); w.y = cvt_pk_bf16(mp[2], mp[3]); w.z = cvt_pk_bf16(mp[4], mp[5]); w.w = cvt_pk_bf16(mp[6], mp[7]); } }
        else { const int cc = ch - 64; float v[8];
#pragma unroll
            for (int e = 0; e < 4; ++e) { const int n = cc * 4 + e; const float cr = Cc[(p * 64 + n) * 2], ci = Cc[(p * 64 + n) * 2 + 1], ar = Ap[((i + 1) * 64 + n) * 2], ai = Ap[((i + 1) * 64 + n) * 2 + 1];
                v[2 * e] = cr * ar - ci * ai; v[2 * e + 1] = -(cr * ai + ci * ar); }
            w.x = cvt_pk_bf16(v[0], v[1]); w.y = cvt_pk_bf16(v[2], v[3]); w.z = cvt_pk_bf16(v[4], v[5]); w.w = cvt_pk_bf16(v[6], v[7]); }
        *(u32x4*)(T + (size_t)R * SSM_KX + ch * 8) = w; }
    for (int it = 0; it < 16; ++it) { const int c = it * 512 + tid, R = 128 * half + (c >> 6), ch = c & 63; u32x4 w = {0u, 0u, 0u, 0u};
        if (R < 128) { const int n = R >> 1, im = R & 1, j = ch >> 1, q0 = (ch & 1) * 8; float v[8]; const float ar = Ap[((31 - j) * 64 + n) * 2], ai = Ap[((31 - j) * 64 + n) * 2 + 1];
#pragma unroll
            for (int e = 0; e < 8; ++e) { const float br = Bb[(n * 16 + q0 + e) * 2], bi = Bb[(n * 16 + q0 + e) * 2 + 1]; v[e] = im ? (ar * bi + ai * br) : (ar * br - ai * bi); }
            w.x = cvt_pk_bf16(v[0], v[1]); w.y = cvt_pk_bf16(v[2], v[3]); w.z = cvt_pk_bf16(v[4], v[5]); w.w = cvt_pk_bf16(v[6], v[7]); }
        *(u32x4*)(W + (size_t)R * 512 + ch * 8) = w; }
    __syncthreads();
}

struct LnArgs { bf16_t* X; float* outf; unsigned char* outq; const float* g; const float* b;
                const float* og; const int* slot; int* r_e; float* r_w; unsigned* cnt; };
template <int MODE>
__device__ __forceinline__ void ln_phase(const LnArgs& A, LAS unsigned char* lds, int G) {
    const int tid = opaque_tid(), lane = tid & 63, wave = __builtin_amdgcn_readfirstlane(tid >> 6);
    const int gw = blockIdx.x * 8 + wave, NGW = G * 8;
    f32x4 gv[8], bv[8];
    if (MODE != 1) {
#pragma unroll
        for (int j = 0; j < 8; ++j) { gv[j] = *(const f32x4*)(A.g + lane * 8 + 512 * (j >> 1) + 4 * (j & 1)); bv[j] = *(const f32x4*)(A.b + lane * 8 + 512 * (j >> 1) + 4 * (j & 1)); } }
    for (int row = gw; row < M; row += NGW) {
        bf16_t* xr = A.X + (size_t)row * D + lane * 8;
        f32x4 v[8]; float s = 0.f;
#pragma unroll
        for (int j = 0; j < 4; ++j) { const u32x4 w = *(const u32x4*)(xr + 512 * j); v[2 * j] = (f32x4){bf_lo(w.x), bf_hi(w.x), bf_lo(w.y), bf_hi(w.y)}; v[2 * j + 1] = (f32x4){bf_lo(w.z), bf_hi(w.z), bf_lo(w.w), bf_hi(w.w)}; }
        if (MODE == 2) { const int s0 = A.slot[row * 2], s1 = A.slot[row * 2 + 1]; const bf16_t* o0 = (const bf16_t*)A.og + (size_t)s0 * D + lane * 8; const bf16_t* o1 = (const bf16_t*)A.og + (size_t)s1 * D + lane * 8;
#pragma unroll
            for (int j = 0; j < 4; ++j) { const u32x4 a = *(const u32x4*)(o0 + 512 * j), b = *(const u32x4*)(o1 + 512 * j);
                v[2 * j] = v[2 * j] * ALPHA + (f32x4){bf_lo(a.x), bf_hi(a.x), bf_lo(a.y), bf_hi(a.y)} + (f32x4){bf_lo(b.x), bf_hi(b.x), bf_lo(b.y), bf_hi(b.y)};
                v[2 * j + 1] = v[2 * j + 1] * ALPHA + (f32x4){bf_lo(a.z), bf_hi(a.z), bf_lo(a.w), bf_hi(a.w)} + (f32x4){bf_lo(b.z), bf_hi(b.z), bf_lo(b.w), bf_hi(b.w)}; } }
#pragma unroll
        for (int j = 0; j < 8; ++j) s += (v[j][0] + v[j][1]) + (v[j][2] + v[j][3]);
        const float mean = wave_sum(s, lane) * (1.f / D); float s2 = 0.f;
#pragma unroll
        for (int j = 0; j < 8; ++j) { v[j] = v[j] - mean; s2 += (v[j][0] * v[j][0] + v[j][1] * v[j][1]) + (v[j][2] * v[j][2] + v[j][3] * v[j][3]); }
        const float rstd = 1.f / sqrtf(wave_sum(s2, lane) * (1.f / D) + LN_EPS);
#pragma unroll
        for (int j = 0; j < 8; ++j) { if (MODE == 1) { gv[j] = *(const f32x4*)(A.g + lane * 8 + 512 * (j >> 1) + 4 * (j & 1)); bv[j] = *(const f32x4*)(A.b + lane * 8 + 512 * (j >> 1) + 4 * (j & 1)); }
            v[j] = v[j] * rstd * gv[j] + bv[j]; }
        if (A.outf) { float* of = A.outf + (size_t)row * D + lane * 8;
#pragma unroll
            for (int j = 0; j < 8; ++j) *(f32x4*)(of + 512 * (j >> 1) + 4 * (j & 1)) = v[j]; }
        else {
#pragma unroll
            for (int j = 0; j < 4; ++j) *(u32x4*)(xr + 512 * j) = pack8(v[2 * j], v[2 * j + 1]); }
        if (A.outq) { unsigned char* oq = A.outq + (size_t)row * D + lane * 8;
#pragma unroll
            for (int j = 0; j < 4; ++j) *(u32x2*)(oq + 512 * j) = pack8_fp8(v[2 * j], v[2 * j + 1]); }
        if (MODE == 1) {
            const LAS float* wr_ = (const LAS float*)lds;
            int i0 = 0, i1 = 0; float v0 = -__builtin_inff(), v1 = -__builtin_inff();
#pragma unroll 1
            for (int e = 0; e < 8; ++e) { float acc = 0.f;
#pragma unroll
                for (int j = 0; j < 8; ++j) { const f32x4 w = *(const LAS f32x4*)(wr_ + e * D + lane * 8 + 512 * (j >> 1) + 4 * (j & 1)); acc += (v[j][0] * w[0] + v[j][1] * w[1]) + (v[j][2] * w[2] + v[j][3] * w[3]); }
                const float sg = wave_sum(acc, lane);
                if (sg > v0) { v1 = v0; i1 = i0; v0 = sg; i0 = e; } else if (sg > v1) { v1 = sg; i1 = e; } }
            const float w0 = 1.f / (1.f + expf(v1 - v0)), w1 = 1.f - w0;
            if (lane == 0) { A.r_e[row * 2] = i0; A.r_e[row * 2 + 1] = i1; A.r_w[row * 2] = w0; A.r_w[row * 2 + 1] = w1;
                __hip_atomic_fetch_add(A.cnt + i0, 1u, RLX_AGENT); __hip_atomic_fetch_add(A.cnt + i1, 1u, RLX_AGENT); }
        }
    }
}
__device__ __forceinline__ void moe_offsets(const unsigned* cnt, int (&off)[9]) {
    int acc = 0;
#pragma unroll
    for (int e = 0; e < 8; ++e) { off[e] = acc; const int c = (int)__hip_atomic_load(cnt + e, RLX_AGENT); acc += ((c + 255) >> 8) << 8; }
    off[8] = acc;
}

struct AttPtrs { const bf16_t *QD, *KD, *VD, *QM, *KM, *VM; bf16_t *BR0, *BR1; };
__device__ __forceinline__ void mla_unit(const AttPtrs& P, int h, int qb, char* lds) {
    const int tid = opaque_tid(), wid = __builtin_amdgcn_readfirstlane(tid >> 6), lane = tid & 63, r32 = lane & 31, hi = lane >> 5;
    const int q0 = qb * 256 + wid * 32; f32x16 o[4]; float l;
    att::attn_core_pp<192, 12, true, true>(P.QM + (size_t)(q0 + r32) * 1536 + h * 192 + hi * 8, P.KM + h * 192, 1536, P.VM + h * 128, 1024, 4 * (qb + 1), q0 + r32, q0, 0, lds, o, l);
    float* ws = (float*)(lds + 3 * att::SHM_V + 3 * 64 * 384) + wid * 64;
    att::normalize_o(o, l, ws, r32, hi);
    att::store_o_bf16(o, P.BR1 + (size_t)q0 * 1024 + h * 128, 1024, r32, hi);
    __syncthreads();
}
__device__ __forceinline__ void diff_unit(const AttPtrs& P, int h, int qb, float lam, char* lds) {
    const int tid = opaque_tid(), wid = __builtin_amdgcn_readfirstlane(tid >> 6), lane = tid & 63, r32 = lane & 31, hi = lane >> 5;
    const int mp = wid >> 2, w4 = wid & 3, q0 = qb * 128 + w4 * 32; f32x16 o[4]; float l;
    att::attn_core_pp<128, 4, true, true>(P.QD + (size_t)(q0 + r32) * 1024 + h * 128 + mp * 64 + hi * 8, P.KD + h * 128, 1024, P.VD + h * 128, 1024, 2 * (qb + 1), q0 + r32, q0, mp * 8, lds, o, l);
    float* ws = (float*)(lds + 3 * att::SHM_V + 3 * 64 * 256) + wid * 64;
    att::normalize_o(o, l, ws, r32, hi);
    __syncthreads();
    float* xch = (float*)lds + w4 * 4096 + lane;
    if (mp == 1) {
#pragma unroll
        for (int d0 = 0; d0 < 4; ++d0)
#pragma unroll
            for (int r = 0; r < 16; ++r) xch[(d0 * 16 + r) * 64] = o[d0][r];
    }
    __syncthreads();
    if (mp == 0) {
        float ss[16];
#pragma unroll
        for (int r = 0; r < 16; ++r) { float s = 0.f;
#pragma unroll
            for (int d0 = 0; d0 < 4; ++d0) { const float dv = o[d0][r] - lam * xch[(d0 * 16 + r) * 64]; o[d0][r] = dv; s += dv * dv; }
            ss[r] = s; }
#pragma unroll
        for (int r = 0; r < 16; ++r) { float s = ss[r];
#pragma unroll
            for (int off = 1; off < 32; off <<= 1) s += shflx(s, off, lane);
            const float rs = __builtin_amdgcn_rsqf(s * (1.f / 128.f) + RMS_EPS);
#pragma unroll
            for (int d0 = 0; d0 < 4; ++d0) o[d0][r] *= rs; }
        att::store_o_bf16(o, P.BR0 + (size_t)q0 * 1024 + h * 128, 1024, r32, hi);
    }
    __syncthreads();
}
__device__ __forceinline__ void cross_unit(const bf16_t* XQ, const bf16_t* XKV, bf16_t* XO, int h, int qb, char* lds) {
    const int tid = opaque_tid(), wid = __builtin_amdgcn_readfirstlane(tid >> 6), lane = tid & 63, r32 = lane & 31, hi = lane >> 5;
    const int q0 = qb * 256 + wid * 32; f32x16 o[4]; float l;
    att::attn_core<128, 8, false, true>(XQ + (size_t)(q0 + r32) * 512 + h * 128 + hi * 8, XKV + h * 128, 1024, XKV + 512 + h * 128, 1024, 4, 0, 0, 0, lds, o, l);
    float* ws = (float*)(lds + 2 * att::SHM_V + 2 * 64 * 256) + wid * 64;
    att::normalize_o(o, l, ws, r32, hi);
    att::store_o_bf16(o, XO + (size_t)q0 * 512 + h * 128, 512, r32, hi);
    __syncthreads();
}

__global__ void __launch_bounds__(512, 2) fwd_kernel(Args args) {
    extern __shared__ __attribute__((aligned(16))) unsigned char lds_raw[];
    LAS unsigned char* lds = (LAS unsigned char*)lds_raw;
    const int tid = threadIdx.x, lane = tid & 63, wave = __builtin_amdgcn_readfirstlane(tid >> 6);
    const int G = gridDim.x, bx = blockIdx.x;
    unsigned char* ws = (unsigned char*)(GAS unsigned char*)(unsigned long long)args.ws;
    unsigned* ctl = (unsigned*)(ws + WS_CTL);
    volatile LAS unsigned* MISC = (volatile LAS unsigned*)(lds + LDS_MISC);
    if (tid < 32) MISC[tid] = 0u;
    if (lane == 0) ((volatile LAS int*)LDS_WTAB)[__builtin_amdgcn_s_getreg(0x2804)] = wave;
    { volatile LAS unsigned long long* pt = (volatile LAS unsigned long long*)(lds + LDS_MISC + 256); if (tid < 35) pt[tid] = (unsigned long long)args.in[tid]; if (tid == 35) pt[35] = (unsigned long long)args.out; }
    __syncthreads();
    ArgsD ad; ad.in.t = (volatile LAS unsigned long long*)(lds + LDS_MISC + 256); ad.ws = ws;
    const int lo = args.ph_lo, hi = args.ph_hi;
    XcdBarrier bar; bar.bar = ctl + CW_BAR; bar.x = 0; bar.st = nullptr;
    if (hi - lo > 1) { bar = xcd_barrier_post(ctl + CW_BAR, MISC + 8); xcd_barrier_setup(bar); }
#ifndef PH_SEL
#define PH_SEL 0xFFFFFFFFu
#endif
#define INR(k) (lo <= (k) && (k) < hi)
#define IN0() (((PH_SEL) & 1u) && INR(0))
#define INL(j) ((((PH_SEL) >> ((j) + 1)) & 1u) && INR(pb + (j)))
#define SEAM(k) do { if (INR(k) && INR((k) + 1)) xcd_barrier(bar); } while (0)
    const int gw = bx * 8 + wave, NGW = G * 8;
    const int gtid = bx * 512 + tid, NGT = G * 512;

    if (IN0()) {
      {
        { int start = bx;
            for (int id = 0; id < NMAT; ++id) { const Mat mt = get_mat(ad, id); if (mt.kind == 1) continue; const int nit = (mt.K / 64) * (mt.N / 256);
                int it = start; for (; it < nit; it += G) cvt_tile_wg(mt, (LAS float*)lds, it, tid);
                start = it - nit; } }
        { LAS float* scr = (LAS float*)(lds + wave * 16640); int start = gw;
            for (int id = 0; id < 22; id += 11) { const Mat mt = get_mat(ad, id); const int nit = (mt.K / 64) * (mt.N / 64);
                int it = start; for (; it < nit; it += NGW) cvt_item(mt, scr, it, lane);
                start = it - nit; } }
        for (int l = 0; l < DEPTH; ++l) { u32x4* p = (u32x4*)((unsigned char*)(ws + WS_W + (size_t)l * LW_BYTES + LW_IN) + (size_t)NIN_BF * D * 2 + (size_t)(3904 - NIN_BF) * D);
            for (int i = gtid; i < 192 * D / 16; i += NGT) p[i] = (u32x4){0u, 0u, 0u, 0u}; }
        { const float* x = (const float*)ad.in[I_X]; bf16_t* xn = (bf16_t*)(ws + WS_XN);
            unsigned char* x8 = ws + WS_XN8;
            for (size_t i = gtid; i < (size_t)M * D / 8; i += NGT) { const f32x4 a = *(const f32x4*)(x + i * 8), b = *(const f32x4*)(x + i * 8 + 4); *(u32x4*)(xn + i * 8) = pack8(a, b); *(u32x2*)(x8 + i * 8) = pack8_fp8(a, b); }
            const float* mem = (const float*)ad.in[I_MEM]; bf16_t* mb = (bf16_t*)(ws + WS_MEMB);
            for (int i = gtid; i < MEM_LEN * D / 8; i += NGT) { const f32x4 a = *(const f32x4*)(mem + i * 8), b = *(const f32x4*)(mem + i * 8 + 4); *(u32x4*)(mb + i * 8) = pack8(a, b); } }
        { const int* pos = (const int*)ad.in[I_POS]; float* td = (float*)(ws + WS_TABD); float* tm = (float*)(ws + WS_TABM);
            for (int i = gtid; i < M * 40; i += NGT) { const int t = i / 40, k = i - t * 40; const double p = (double)pos[t];
                const double inv = (k < 8) ? exp(-(double)k * (13.122363377404328 / 8.0)) : exp(-(double)(k - 8) * (13.122363377404328 / 32.0));
                const double ang = p * inv; const float c = (float)cos(ang), s = (float)sin(ang);
                if (k < 8) { td[(t * 8 + k) * 2] = c; td[(t * 8 + k) * 2 + 1] = s; } else { tm[(t * 32 + k - 8) * 2] = c; tm[(t * 32 + k - 8) * 2 + 1] = s; } } }
        if (bx == 0 && tid < 192) { int* ord = (int*)(ws + WS_ORDER);
            const int rank = tid < 64 ? 63 - tid : 64 + 127 - (tid - 64);
            const int code = tid < 64 ? ((1 << 16) | (tid << 8)) : ((tid - 64) << 8);
            for (int h = 0; h < 8; ++h) ord[rank * 8 + h] = code | h; }
        __syncthreads();
#ifdef PROBE_SSMB
#pragma nounroll
        for (int rep_ = 0; rep_ < 2; ++rep_)
#endif
        for (int uidx = bx; uidx < DEPTH * 64 * 2; uidx += G) ssm_build(ad, uidx >> 7, (uidx >> 1) & 63, uidx & 1, lds);
        __syncthreads();
      }
    }
    SEAM(0);

    unsigned char* const ws_k = ws; const int bx_k = bx;
    for (int l = 0; l < DEPTH; ++l) {
        const int pb = 1 + l * NPL;
        if (!(lo < pb + NPL && pb < hi)) continue;
        int bx = bx_k; asm volatile("" : "+s"(bx));
        unsigned long long ws_i = (unsigned long long)ws_k; asm volatile("" : "+s"(ws_i)); unsigned char* ws = (unsigned char*)(GAS unsigned char*)ws_i;
#define PH_TID const int tid = opaque_tid(), lane = tid & 63, wave = __builtin_amdgcn_readfirstlane(tid >> 6); const int gw = bx * 8 + wave, NGW = G * 8; (void)lane; (void)wave; (void)gw; (void)NGW
#define lw (ws + WS_W + (size_t)l * LW_BYTES)
#define ssq_q ((float*)(ws + WS_PSQ))
#define ssq_kv (ssq_q + (size_t)8 * M)
#define XS ((float*)(ws + WS_XS))
#define XN ((bf16_t*)(ws + WS_XN))
#define tabd ((const float*)(ws + WS_TABD))
#define tabm ((const float*)(ws + WS_TABM))
#define QD ((bf16_t*)(ws + WS_QD))
#define KD ((bf16_t*)(ws + WS_KD))
#define VD ((bf16_t*)(ws + WS_VD))
#define MQ ((bf16_t*)(ws + WS_MQ))
#define MKV ((bf16_t*)(ws + WS_MKV))
#define KM ((bf16_t*)(ws + WS_KM))
#define VM ((bf16_t*)(ws + WS_VM))
#define QM ((bf16_t*)(ws + WS_QM))
#define SU ((bf16_t*)(ws + WS_SU))
#define GATES ((bf16_t*)(ws + WS_GATES))
#define SLOC ((float*)(ws + WS_SLOC))
#define YG ((bf16_t*)(ws + WS_YG))
#define BR ((bf16_t*)(ws + WS_BR))
#define TMP ((float*)(ws + WS_TMP))
#define MG ((bf16_t*)(ws + WS_MG))
#define XQ ((bf16_t*)(ws + WS_XQ))
#define XO ((bf16_t*)(ws + WS_XO))
#define XKV ((bf16_t*)(ws + WS_XKV) + (size_t)l * 256 * 1024)
#define r_e ((int*)(ws + WS_ROUTE))
#define r_w ((float*)(ws + WS_ROUTE + 128 * 1024))
#define slot ((int*)(ws + WS_ROUTE + 256 * 1024))
#define wslot ((float*)(ws + WS_ROUTE + 384 * 1024))
        if (INL(0)) {
#if !defined(SUBSEL) || (SUBSEL & 1)
            { pg8::Gemm g{XN, (const bf16_t*)(lw + LW_IN), (D) * 2, (D) * 2, (D) * 2, 0}; SchedPlain S; S.init(M / 256, NIN_BF / 256, D, D, G, bx);
              EpiInProj E{QD, KD, VD, MQ, MKV, KM, SU, GATES, ssq_q, ssq_kv, tabd, tabm, 0};
              pg8::gemm_phase(lds, g, S, E); }
            { pg8::Gemm g{ws + WS_XN8, lw + LW_IN + (size_t)NIN_BF * D * 2, D, D, D, 0}; SchedPlain S; S.T.init(M / 256, NIN_G8 / 256); S.G = G; S.c = bx; S.tA = (size_t)256 * D; S.tB = S.tA;
              EpiInProj E{QD, KD, VD, MQ, MKV, KM, SU, GATES, ssq_q, ssq_kv, tabd, tabm, 12};
              pg8::gemm_phase_t<true, 0x7C7C7C7C>(lds, g, S, E); }
#endif
#if !defined(SUBSEL) || (SUBSEL & 2)
            { pg8::Gemm g{(const bf16_t*)(ws + WS_MEMB), (const bf16_t*)(lw + LW_XKV), (D) * 2, (D) * 2, (D) * 2, 0}; SchedPlain S; S.init(1, 4, D, D, G, (bx + 128) % G);
              EpiBf16 E{XKV, 1024, 1.f};
              pg8::gemm_phase(lds, g, S, E); }
#endif
        }
        SEAM(pb + 0);
        if (INL(1)) {
#if !defined(SUBSEL) || (SUBSEL & 1)
            { pg8::Gemm g{MQ, (const bf16_t*)(lw + LW_QUP), (512) * 2, (512) * 2, (512) * 2, 0}; SchedPlain S; S.init(M / 256, 6, 512, 512, G, bx);
              EpiQup E{QM, ssq_q, tabm}; pg8::gemm_phase(lds, g, S, E); }
#endif
#if !defined(SUBSEL) || (SUBSEL & 2)
            { pg8::Gemm g{MKV, (const bf16_t*)(lw + LW_KVUP), (256) * 2, (256) * 2, (256) * 2, 0}; SchedPlain S; S.init(M / 256, 8, 256, 256, G, (bx + 128) % G);
              EpiKVup E{KM, VM, ssq_kv}; pg8::gemm_phase(lds, g, S, E); }
#endif
#if !defined(SUBSEL) || (SUBSEL & 4)
            { pg8::Gemm g{SU, (const bf16_t*)(lw + LW_WSL), (SSM_KX) * 2, (512) * 2, (512) * 2, 0}; SchedBatch S{2, 1, 64, G, (bx + 128) % G  , (size_t)256 * SSM_KX * 2, (size_t)256 * 512 * 2, (size_t)SSM_NCH * SSM_KX * 2, (size_t)256 * 512 * 2};
              EpiSloc E{SLOC}; pg8::gemm_phase(lds, g, S, E); }
#endif
        }
        SEAM(pb + 1);
        if (INL(2)) {
            PH_TID;
            if (bx < 64) { const int g = bx, n = lane, w = wave;
                const float* a32 = (const float*)(ws + WS_A32) + (size_t)((l * 64 + g) * 64 + n) * 2; const float ar = a32[0], ai = a32[1];
                const float* __restrict__ lp = SLOC + ((size_t)g * SSM_NCH + 64 * w) * 128 + 2 * n; bf16_t* __restrict__ sp = SU + ((size_t)g * SSM_NCH + 64 * w) * SSM_KX + 512 + 2 * n;
                float br[64], bi[64]; float sr = 0.f, si = 0.f;
#pragma unroll
                for (int c0 = 0; c0 < 64; c0 += 32) { f32x2 lv[32];
#pragma unroll
                    for (int k = 0; k < 32; ++k) lv[k] = *(const f32x2*)(lp + (size_t)(c0 + k) * 128);
#pragma unroll
                    for (int k = 0; k < 32; ++k) { br[c0 + k] = sr; bi[c0 + k] = si; const float nr = ar * sr - ai * si + lv[k][0], ni = ar * si + ai * sr + lv[k][1]; sr = nr; si = ni; } }
                LAS float* ex = (LAS float*)lds;
                ex[(w * 64 + n) * 2] = sr; ex[(w * 64 + n) * 2 + 1] = si;
                float pr = ar, pi = ai;
#pragma unroll
                for (int q = 0; q < 6; ++q) { const float tr = pr * pr - pi * pi, ti = 2.f * pr * pi; pr = tr; pi = ti; }
                __syncthreads();
                float cr = 0.f, ci = 0.f;
                for (int uu = 0; uu < w; ++uu) { const float er = ex[(uu * 64 + n) * 2], ei = ex[(uu * 64 + n) * 2 + 1]; const float tr = pr * cr - pi * ci + er, ti = pr * ci + pi * cr + ei; cr = tr; ci = ti; }
#pragma unroll
                for (int k = 0; k < 64; ++k) { *(unsigned*)(sp + (size_t)k * SSM_KX) = cvt_pk_bf16(br[k] + cr, bi[k] + ci);
                    const float tr = ar * cr - ai * ci, ti = ar * ci + ai * cr; cr = tr; ci = ti; } }
        }
        SEAM(pb + 2);
        if (INL(3)) {
#if !defined(SUBSEL) || (SUBSEL & 1)
            { pg8::Gemm g{SU, (const bf16_t*)(lw + LW_TEXT), (SSM_KX) * 2, (SSM_KX) * 2, (SSM_KX) * 2, 0}; SchedBatch S{2, 2, 64, G, bx, (size_t)256 * SSM_KX * 2, (size_t)256 * SSM_KX * 2, (size_t)SSM_NCH * SSM_KX * 2, (size_t)512 * SSM_KX * 2};
              EpiSsmY E{YG, SU, (const float*)ad.in[I_SSMD] + l * 1024}; pg8::gemm_phase(lds, g, S, E); }
#endif
            PH_TID;
            const float* dl = (const float*)ad.in[I_DLAM] + l * 256;
            const float lam = expf(wave_sum(dl[lane] * dl[64 + lane], lane)) - expf(wave_sum(dl[128 + lane] * dl[192 + lane], lane)) + lam_init_of(l);
            const AttPtrs P{QD, KD, VD, QM, KM, VM, BR, BR + (size_t)M * 1024};
            const int* ord = (const int*)(ws + WS_ORDER);
            __syncthreads();
#ifndef PROBE_ATT
#define PROBE_ATT 0
#endif
            const unsigned myx = xb_xcc_id() & 7u;
#pragma nounroll
            for (int rep = 0; rep < (PROBE_ATT ? 2 : 1); ++rep)
#pragma nounroll
            for (int sq = 0; sq < 8; ++sq) { const int q = (int)((myx + sq) & 7u);
            if (sq == 1) {
                unsigned cnt_ = 0xFFFFFFFFu; if (tid < 8) cnt_ = __hip_atomic_load(ctl + CW_ATTQ + 64 * l + 32 * rep + tid, RLX_AGENT);
                const unsigned long long live_ = __ballot(cnt_ < 192u);
                if (tid == 0) MISC[1] = (unsigned)live_;
                __syncthreads(); }
            if (sq >= 1 && !((MISC[1] >> q) & 1u)) continue;
            for (;;) {
                if (tid == 0) MISC[0] = __hip_atomic_fetch_add(ctl + CW_ATTQ + 64 * l + 32 * rep + q, 1u, RLX_AGENT);
                __syncthreads();
                const unsigned it = MISC[0];
                __syncthreads();
                if (it >= 192u) break;
                const int code = ord[it * 8 + q], h = code & 255, qb = (code >> 8) & 255;
                if ((code >> 16) && (rep == 0 || (PROBE_ATT & 1))) mla_unit(P, h, qb, (char*)lds_raw);
                if (!(code >> 16) && (rep == 0 || (PROBE_ATT & 2))) diff_unit(P, h, qb, lam, (char*)lds_raw);
            } }
        }
        SEAM(pb + 3);
        if (INL(4)) {
            pg8::Gemm g{YG, (const bf16_t*)(lw + LW_GLU), (1024) * 2, (1024) * 2, (1024) * 2, 0}; SchedPlain S; S.init(M / 256, 8, 1024, 1024, G, bx);
            EpiGated<0> E{BR + (size_t)2 * M * 1024, 1024}; pg8::gemm_phase(lds, g, S, E);
        }
        SEAM(pb + 4);
        if (INL(5)) {
            pg8::Gemm g{BR, (const bf16_t*)(lw + LW_BR), (1024) * 2, (1024) * 2, (1024) * 2, 0}; SchedBranch S; S.T.init(M / 256, 8); S.G = G; S.c = bx; S.tA = (size_t)256 * 1024 * 2; S.tB = S.tA; S.zA = (size_t)M * 1024 * 2; S.zB = (size_t)2048 * 1024 * 2;
            EpiBranch E{GATES, (bf16_t*)TMP, MG}; pg8::gemm_phase(lds, g, S, E);
        }
        SEAM(pb + 5);
        if (INL(6)) {
            pg8::Gemm g{MG, (const bf16_t*)(lw + LW_OUT), (D) * 2, (D) * 2, (D) * 2, 0}; SchedPlain S; S.init(M / 256, 8, D, D, G, bx);
            EpiResid E{XN}; pg8::gemm_phase(lds, g, S, E);
        }
        SEAM(pb + 6);
        if (INL(7)) { const LnArgs A{XN, nullptr, nullptr, (const float*)ad.in[I_LNMG] + l * D, (const float*)ad.in[I_LNMB] + l * D, nullptr, nullptr, nullptr, nullptr, nullptr}; ln_phase<0>(A, lds, G); }
        SEAM(pb + 7);
        if (INL(8)) {
            pg8::Gemm g{XN, (const bf16_t*)(lw + LW_XQ), (D) * 2, (D) * 2, (D) * 2, 0}; SchedPlain S; S.T.init(M / 128, 2); S.G = G; S.c = bx; S.tA = (size_t)128 * D * 2; S.tB = (size_t)256 * D * 2;
            EpiBf16Half E{XQ, 512, C2_X}; pg8::gemm_phase(lds, g, S, E);
        }
        SEAM(pb + 8);
        if (INL(9)) { for (int uidx = bx; uidx < 256; uidx += G) cross_unit(XQ, XKV, XO, uidx & 3, uidx >> 2, (char*)lds_raw); }
        SEAM(pb + 9);
        if (INL(10)) {
            pg8::Gemm g{XO, (const bf16_t*)(lw + LW_XO), (512) * 2, (512) * 2, (512) * 2, 0}; SchedPlain S; S.init(M / 256, 8, 512, 512, G, bx);
            EpiResid E{XN}; pg8::gemm_phase(lds, g, S, E);
        }
        SEAM(pb + 10);
        if (INL(11)) {
            const LnArgs A{XN, nullptr, nullptr, (const float*)ad.in[I_LNXG] + l * D, (const float*)ad.in[I_LNXB] + l * D, nullptr, nullptr, r_e, r_w, ctl + CW_MOECNT};
            if (l == 0) ln_phase<0>(A, lds, G);
            else { PH_TID; const float* rw = (const float*)ad.in[I_ROUTER]; LAS float* wl = (LAS float*)lds;
                for (int i = tid; i < D * 8; i += 512) wl[(i & 7) * D + (i >> 3)] = rw[i];
                __syncthreads(); ln_phase<1>(A, lds, G); __syncthreads(); }
        }
        SEAM(pb + 11);
        if (l == 1) {
            if (INL(12)) { PH_TID; int off[9]; moe_offsets(ctl + CW_MOECNT, off); bf16_t* XG = (bf16_t*)(ws + WS_XG);
                for (int row = gw; row < M; row += NGW) { int s0 = 0, s1 = 0;
                    if (lane == 0) { const int e0 = r_e[row * 2], e1 = r_e[row * 2 + 1];
                        s0 = off[e0] + (int)__hip_atomic_fetch_add(ctl + CW_MOECUR + e0, 1u, RLX_AGENT); s1 = off[e1] + (int)__hip_atomic_fetch_add(ctl + CW_MOECUR + e1, 1u, RLX_AGENT);
                        slot[row * 2] = s0; slot[row * 2 + 1] = s1; wslot[s0] = r_w[row * 2]; wslot[s1] = r_w[row * 2 + 1]; }
                    s0 = __builtin_amdgcn_readfirstlane(s0); s1 = __builtin_amdgcn_readfirstlane(s1);
                    const u32x4* src = (const u32x4*)(XN + (size_t)row * D) + lane; u32x2* d0 = (u32x2*)((unsigned char*)XG + (size_t)s0 * D) + lane; u32x2* d1 = (u32x2*)((unsigned char*)XG + (size_t)s1 * D) + lane;
#pragma unroll
                    for (int j = 0; j < 4; ++j) { const u32x4 v = src[64 * j];
                        const u32x2 q = pack8_fp8((f32x4){bf_lo(v.x), bf_hi(v.x), bf_lo(v.y), bf_hi(v.y)}, (f32x4){bf_lo(v.z), bf_hi(v.z), bf_lo(v.w), bf_hi(v.w)}); d0[64 * j] = q; d1[64 * j] = q; } } }
            SEAM(pb + 12);
        }
        if (INL(13)) {
            if (l == 0) { pg8::Gemm g{XN, (const bf16_t*)(ws + WS_FFN), (D) * 2, (D) * 2, (D) * 2, 0}; SchedPlain S; S.init(M / 256, 44, D, D, G, bx);
                EpiSwigluF8 E{ws + WS_HG, DFF}; pg8::gemm_phase(lds, g, S, E); }
            else { int off[9]; moe_offsets(ctl + CW_MOECNT, off);
                pg8::Gemm g{ws + WS_XG, ws + WS_MOE, D, D, D, 0x7C7C7C7C}; SchedMoe S; S.T.init(off[8] >> 8, 44); S.G = G; S.c = bx; S.tA = (size_t)256 * D; S.tB = S.tA; S.zB = 66 * MiB;
#pragma unroll
                for (int k = 0; k < 7; ++k) S.off[k] = off[k + 1];
                EpiSwigluF8 E{ws + WS_HG, DFF}; pg8::gemm_phase_t<true, 0x7C7C7C7C>(lds, g, S, E); }
        }
        SEAM(pb + 13);
        if (INL(14)) {
            if (l == 0) { pg8::Gemm g{ws + WS_HG, ws + WS_FFN + 44 * MiB, DFF, DFF, DFF, 0x7B7B7B7B}; SchedPlain S; S.init(M / 256, 8, DFF / 2, DFF / 2, G, bx);
                EpiResid E{XN}; pg8::gemm_phase_t<true, 0x7B7B7B7B>(lds, g, S, E); }
            else { int off[9]; moe_offsets(ctl + CW_MOECNT, off);
                pg8::Gemm g{ws + WS_HG, ws + WS_MOE + 44 * MiB, DFF, DFF, DFF, 0x7B7B7B7B}; SchedMoe S; S.T.init(off[8] >> 8, 8); S.G = G; S.c = bx; S.tA = (size_t)256 * DFF; S.tB = S.tA; S.zB = 66 * MiB;
#pragma unroll
                for (int k = 0; k < 7; ++k) S.off[k] = off[k + 1];
                EpiMoeDown E{(bf16_t*)(ws + WS_OG), wslot}; pg8::gemm_phase_t<true, 0x7B7B7B7B>(lds, g, S, E); }
        }
        SEAM(pb + 14);
        if (INL(15)) {
            const LnArgs A{XN, (l == DEPTH - 1) ? (float*)ad.in[35] : nullptr, (l == DEPTH - 1) ? nullptr : ws + WS_XN8, (const float*)ad.in[I_LNFG] + l * D, (const float*)ad.in[I_LNFB] + l * D, (const float*)(ws + WS_OG), slot, nullptr, nullptr, nullptr};
            if (l == 0) ln_phase<0>(A, lds, G); else ln_phase<2>(A, lds, G);
        }
        SEAM(pb + 15);
    }
#undef INR
#undef IN0
#undef INL
#undef SEAM
}

extern "C" void kernel_launch(void* const* d_in, const int* in_sizes, int n_in, void* d_out, int out_size, void* d_ws, size_t ws_size, hipStream_t stream) {
    static int grid = 0;
    if (grid == 0) {
        if (n_in != 35 || out_size != M * D || ws_size < WS_END) { fprintf(stderr, "kernel_launch: shape/workspace mismatch: n_in %d out %d ws %zu (need %zu)\n", n_in, out_size, ws_size, (size_t)WS_END); grid = -1; return; }
        int dev = 0, cus = 0, per_cu = 0;
        if (hipGetDevice(&dev) != hipSuccess || hipDeviceGetAttribute(&cus, hipDeviceAttributeMultiprocessorCount, dev) != hipSuccess) { grid = -1; return; }
        if (hipFuncSetAttribute((const void*)fwd_kernel, hipFuncAttributeMaxDynamicSharedMemorySize, LDS_BYTES) != hipSuccess) { fprintf(stderr, "kernel_launch: hipFuncSetAttribute failed\n"); grid = -1; return; }
        if (hipOccupancyMaxActiveBlocksPerMultiprocessor(&per_cu, (const void*)fwd_kernel, 512, LDS_BYTES) != hipSuccess || per_cu < 1) { fprintf(stderr, "kernel_launch: occupancy query says %d\n", per_cu); }
        (void)hipGetLastError();
        grid = cus;
    }
    if (grid < 0) return;
    if (hipMemsetAsync((char*)d_ws + WS_CTL, 0, CTL_ZERO_BYTES, stream) != hipSuccess) return;
    Args a{};
    for (int i = 0; i < 35; ++i) a.in[i] = d_in[i];
    a.out = (float*)d_out; a.ws = (unsigned char*)d_ws;
#if MK_MULTI
    for (int p = 0; p < NPHASE; ++p) { if (p == 1 + 12) continue; a.ph_lo = p; a.ph_hi = p + 1; hipLaunchKernelGGL(fwd_kernel, dim3(grid), dim3(512), LDS_BYTES, stream, a); }
#else
    a.ph_lo = 0; a.ph_hi = NPHASE;
    hipLaunchKernelGGL(fwd_kernel, dim3(grid), dim3(512), LDS_BYTES, stream, a);
#endif
    const hipError_t le = hipPeekAtLastError();
    if (le != hipSuccess) fprintf(stderr, "kernel_launch: launch failed: %s\n", hipGetErrorName(le));
}
```
